# Optimizing an MI355X kernel written in HIP

```python
import math
import jax, jax.numpy as jnp
from jax import lax
import numpy as np

D_MODEL = 2048
BATCH = 1
SEQ = 8192
DEPTH = 1
DEC_BATCH = 16
DEC_SEQ = 16
PAST_LEN = 2048

CHUNK = 64
D_MIX = D_MODEL
RWKV_DIM = D_MIX // 2
RWKV_HEAD = 64
RWKV_HEADS = RWKV_DIM // RWKV_HEAD
DECAY_LORA = 64
ICLR_LORA = 64
GATE_LORA = 128
RWKV_COLS = 3 * RWKV_DIM + DECAY_LORA + ICLR_LORA + GATE_LORA
RET_DIM = D_MIX - RWKV_DIM
RET_HEADS = 4
RET_HEAD = RET_DIM // RET_HEADS
RET_COLS = 4 * RET_DIM
IN_COLS = RWKV_COLS + RET_COLS
D_FF = ((8 * D_MODEL + 3 * 256 - 1) // (3 * 256)) * 256
ROPE_BASE = 10000.0
RMS_EPS = 1e-6
RWKV_LN_EPS = 64e-5
RET_LN_EPS = 1e-5

kernel_name = "hymba_rwkv7_retnet_streaming_step"


def rms_norm(x, g):
    return x * lax.rsqrt(jnp.mean(x * x, axis=-1, keepdims=True) + RMS_EPS) * g


def head_norm(x, w, b, eps):
    B, T, H, N = x.shape
    mu = jnp.mean(x, axis=-1, keepdims=True)
    xc = x - mu
    var = jnp.mean(xc * xc, axis=-1, keepdims=True)
    return (xc * lax.rsqrt(var + eps)).reshape(B, T, H * N) * w + b


def rotary(x, pos):
    half = x.shape[-1] // 2
    inv = ROPE_BASE ** (-jnp.arange(half, dtype=jnp.float32) / half)
    ang = pos[:, None] * inv[None, :]
    cos = jnp.cos(ang)[None, :, None, :]
    sin = jnp.sin(ang)[None, :, None, :]
    x1, x2 = x[..., :half], x[..., half:]
    return jnp.concatenate([x1 * cos - x2 * sin, x2 * cos + x1 * sin], axis=-1)


def ret_log_gamma():
    return jnp.log(1.0 - jnp.exp2(-5.0 - jnp.arange(RET_HEADS, dtype=jnp.float32)))


def rwkv7_recurrence(r, w, k, v, kk, a, S0):
    def step(S, inp):
        r_t, w_t, k_t, v_t, kk_t, a_t = inp
        sa = jnp.einsum("bhij,bhj->bhi", S, -kk_t)
        S = (S * w_t[:, :, None, :] + sa[..., None] * (kk_t * a_t)[:, :, None, :]
             + v_t[..., None] * k_t[:, :, None, :])
        return S, jnp.einsum("bhij,bhj->bhi", S, r_t)
    xs = tuple(jnp.moveaxis(t, 1, 0) for t in (r, w, k, v, kk, a))
    S_T, o = lax.scan(step, S0, xs)
    return jnp.moveaxis(o, 0, 1), S_T


def rwkv7_mixer(z, shift0, wkv0, mu, w0, w2, a0, a2, g2, k_k, k_a, r_k, ln_w, ln_b):
    B, T, _ = z.shape
    z_prev = jnp.concatenate([shift0, z[:, :-1]], axis=1)
    zs = z + (z_prev - z) * mu
    o1, o2, o3 = RWKV_DIM, 2 * RWKV_DIM, 3 * RWKV_DIM
    o4, o5 = o3 + DECAY_LORA, o3 + DECAY_LORA + ICLR_LORA
    r, k, v = zs[..., :o1], zs[..., o1:o2], zs[..., o2:o3]
    wd, ad, gd = zs[..., o3:o4], zs[..., o4:o5], zs[..., o5:]
    w_log = -jax.nn.softplus(-(w0 + jnp.tanh(wd) @ w2)) - 0.5
    decay = jnp.exp(-jnp.exp(w_log))
    a = jax.nn.sigmoid(a0 + ad @ a2)
    g = jax.nn.sigmoid(gd) @ g2
    hs = lambda t: t.reshape(B, T, RWKV_HEADS, RWKV_HEAD)
    kk = hs(k * k_k)
    kk = kk / jnp.maximum(jnp.sqrt(jnp.sum(kk * kk, axis=-1, keepdims=True)), 1e-12)
    k = k * (1.0 + (a - 1.0) * k_a)
    rh, kh, vh = hs(r), hs(k), hs(v)
    o, S_T = rwkv7_recurrence(rh, hs(decay), kh, vh, kk, hs(a), wkv0)
    o = head_norm(o, ln_w, ln_b, RWKV_LN_EPS)
    bonus = jnp.sum(rh * kh * r_k, axis=-1, keepdims=True) * vh
    o = (o + bonus.reshape(B, T, RWKV_DIM)) * g
    return o, z[:, -1:], S_T


def chunk_retention(q, k, v, S0):
    B, T, H, DK = q.shape
    DV = v.shape[-1]
    C = min(T, CHUNK)
    NC = T // C
    lg = ret_log_gamma()
    q = q.reshape(B, NC, C, H, DK)
    k = k.reshape(B, NC, C, H, DK)
    v = v.reshape(B, NC, C, H, DV)
    idx = jnp.arange(C, dtype=jnp.float32)
    dist = jnp.abs(idx[:, None] - idx[None, :])
    d_intra = jnp.exp(lg[:, None, None] * dist[None])
    scores = jnp.einsum("bnqhd,bnkhd->bnhqk", q, k) * d_intra
    o_intra = jnp.einsum("bnhqk,bnkhe->bnqhe", scores, v)
    k_dec = jnp.exp(lg[None, :] * (C - 1.0 - idx)[:, None])
    kv = jnp.einsum("bnkhd,kh,bnkhe->bnhde", k, k_dec, v)
    c_dec = jnp.exp(lg * C)[None, :, None, None]

    def step(S, kv_n):
        return c_dec * S + kv_n, S
    S_T, S_prev = lax.scan(step, S0, jnp.moveaxis(kv, 1, 0))
    S_prev = jnp.moveaxis(S_prev, 0, 1)
    q_dec = jnp.exp(lg[None, :] * (idx + 1.0)[:, None])
    o_cross = jnp.einsum("bnqhd,qh,bnhde->bnqhe", q, q_dec, S_prev)
    return (o_intra + o_cross).reshape(B, T, H, DV), S_T


def retention_mixer(u, pos, S0, ln_w, ln_b):
    B, T, _ = u.shape
    q, k, v, gate = jnp.split(u, 4, axis=-1)
    hs = lambda t: t.reshape(B, T, RET_HEADS, RET_HEAD)
    qh = rotary(hs(q), pos)
    kh = rotary(hs(k), pos) * (RET_HEAD ** -0.5)
    o, S_T = chunk_retention(qh, kh, hs(v), S0)
    o = head_norm(o, ln_w, ln_b, RET_LN_EPS) * jax.nn.silu(gate)
    return o, S_T


def trunk_layer(x, c, pos, shift0, wkv0, ret0, ada_w, ada_b, g_pre_mix, g_post_mix, g_pre_ffn, g_post_ffn,
                w_in, rwkv_mu, rwkv_w0, rwkv_w2, rwkv_a0, rwkv_a2, rwkv_g2, rwkv_k_k, rwkv_k_a, rwkv_r_k,
                rwkv_ln_w, rwkv_ln_b, ret_ln_w, ret_ln_b, w_out, ffn_w_up, ffn_w_down):
    f32 = jnp.float32
    x = x.astype(f32)
    mod = jax.nn.silu(c.astype(f32)) @ ada_w + ada_b
    sh1, sc1, gt1, sh2, sc2, gt2 = jnp.split(mod[:, None, :], 6, axis=-1)
    h = rms_norm(x, g_pre_mix) * (1.0 + sc1) + sh1
    proj = h @ w_in
    o_rwkv, shift_new, wkv_new = rwkv7_mixer(
        proj[..., :RWKV_COLS], shift0.astype(f32), wkv0.astype(f32), rwkv_mu, rwkv_w0, rwkv_w2,
        rwkv_a0, rwkv_a2, rwkv_g2, rwkv_k_k, rwkv_k_a, rwkv_r_k, rwkv_ln_w, rwkv_ln_b)
    o_ret, ret_new = retention_mixer(proj[..., RWKV_COLS:], pos, ret0.astype(f32), ret_ln_w, ret_ln_b)
    mix = jnp.concatenate([o_rwkv, o_ret], axis=-1) @ w_out
    x = x + gt1 * rms_norm(mix, g_post_mix)
    h = rms_norm(x, g_pre_ffn) * (1.0 + sc2) + sh2
    gu = h @ ffn_w_up
    f = (jax.nn.silu(gu[..., :D_FF]) * gu[..., D_FF:]) @ ffn_w_down
    x = x + gt2 * rms_norm(f, g_post_ffn)
    return x, shift_new, wkv_new, ret_new


def setup_inputs(seed: int = 0) -> dict:
    key = jax.random.key(seed)
    ks = jax.random.split(key, 32)
    f32 = jnp.float32
    L = DEPTH

    def nrm(k, shape, s):
        return s * jax.random.normal(k, shape, f32)
    return {
        "x_prompt": nrm(ks[0], (BATCH, SEQ, D_MODEL), 1.0),
        "x_sample": nrm(ks[1], (DEC_BATCH, DEC_SEQ, D_MODEL), 1.0),
        "c_prompt": nrm(ks[2], (BATCH, D_MODEL), 1.0),
        "c_sample": nrm(ks[3], (DEC_BATCH, D_MODEL), 1.0),
        "state_rwkv_shift": nrm(ks[4], (L, DEC_BATCH, 1, RWKV_COLS), 1.0),
        "state_rwkv_wkv": nrm(ks[5], (L, DEC_BATCH, RWKV_HEADS, RWKV_HEAD, RWKV_HEAD), 0.3),
        "state_ret": nrm(ks[6], (L, DEC_BATCH, RET_HEADS, RET_HEAD, RET_HEAD), 0.5),
        "ada_w": nrm(ks[7], (L, D_MODEL, 6 * D_MODEL), 0.5 * D_MODEL ** -0.5),
        "ada_b": nrm(ks[8], (L, 6 * D_MODEL), 0.1),
        "g_pre_mix": 1.0 + nrm(ks[9], (L, D_MODEL), 0.05),
        "g_post_mix": 1.0 + nrm(ks[10], (L, D_MODEL), 0.05),
        "g_pre_ffn": 1.0 + nrm(ks[11], (L, D_MODEL), 0.05),
        "g_post_ffn": 1.0 + nrm(ks[12], (L, D_MODEL), 0.05),
        "w_in": nrm(ks[13], (L, D_MODEL, IN_COLS), D_MODEL ** -0.5),
        "rwkv_mu": jax.random.uniform(ks[14], (L, RWKV_COLS), f32),
        "rwkv_w0": jax.random.uniform(ks[15], (L, RWKV_DIM), f32, -6.0, -1.0),
        "rwkv_w2": nrm(ks[16], (L, DECAY_LORA, RWKV_DIM), 0.5 * DECAY_LORA ** -0.5),
        "rwkv_a0": nrm(ks[17], (L, RWKV_DIM), 0.5),
        "rwkv_a2": nrm(ks[18], (L, ICLR_LORA, RWKV_DIM), 0.5 * ICLR_LORA ** -0.5),
        "rwkv_g2": nrm(ks[19], (L, GATE_LORA, RWKV_DIM), GATE_LORA ** -0.5),
        "rwkv_k_k": 0.85 + nrm(ks[20], (L, RWKV_DIM), 0.05),
        "rwkv_k_a": 1.0 + nrm(ks[21], (L, RWKV_DIM), 0.05),
        "rwkv_r_k": nrm(ks[22], (L, RWKV_HEADS, RWKV_HEAD), 0.1),
        "rwkv_ln_w": 1.0 + nrm(ks[23], (L, RWKV_DIM), 0.05),
        "rwkv_ln_b": nrm(ks[24], (L, RWKV_DIM), 0.02),
        "ret_ln_w": 1.0 + nrm(ks[25], (L, RET_DIM), 0.05),
        "ret_ln_b": nrm(ks[26], (L, RET_DIM), 0.02),
        "w_out": nrm(ks[27], (L, D_MIX, D_MODEL), D_MIX ** -0.5),
        "ffn_w_up": nrm(ks[28], (L, D_MODEL, 2 * D_FF), D_MODEL ** -0.5),
        "ffn_w_down": nrm(ks[29], (L, D_FF, D_MODEL), D_FF ** -0.5),
    }


def reference(x_prompt, x_sample, c_prompt, c_sample, state_rwkv_shift, state_rwkv_wkv, state_ret,
              ada_w, ada_b, g_pre_mix, g_post_mix, g_pre_ffn, g_post_ffn, w_in, rwkv_mu, rwkv_w0, rwkv_w2,
              rwkv_a0, rwkv_a2, rwkv_g2, rwkv_k_k, rwkv_k_a, rwkv_r_k, rwkv_ln_w, rwkv_ln_b,
              ret_ln_w, ret_ln_b, w_out, ffn_w_up, ffn_w_down):
    f32 = jnp.float32
    Bp, Tp, _ = x_prompt.shape
    Bs, Ts, _ = x_sample.shape
    pos_p = jnp.arange(Tp, dtype=f32)
    pos_s = PAST_LEN + jnp.arange(Ts, dtype=f32)
    shift0_p = jnp.zeros((Bp, 1, RWKV_COLS), f32)
    wkv0_p = jnp.zeros((Bp, RWKV_HEADS, RWKV_HEAD, RWKV_HEAD), f32)
    ret0_p = jnp.zeros((Bp, RET_HEADS, RET_HEAD, RET_HEAD), f32)
    hp, hs_ = x_prompt, x_sample
    sh_p, wk_p, rt_p, sh_s, wk_s, rt_s = [], [], [], [], [], []
    for l in range(DEPTH):
        lp = (ada_w[l], ada_b[l], g_pre_mix[l], g_post_mix[l], g_pre_ffn[l], g_post_ffn[l], w_in[l],
              rwkv_mu[l], rwkv_w0[l], rwkv_w2[l], rwkv_a0[l], rwkv_a2[l], rwkv_g2[l], rwkv_k_k[l],
              rwkv_k_a[l], rwkv_r_k[l], rwkv_ln_w[l], rwkv_ln_b[l], ret_ln_w[l], ret_ln_b[l], w_out[l],
              ffn_w_up[l], ffn_w_down[l])
        hp, a1, a2, a3 = trunk_layer(hp, c_prompt, pos_p, shift0_p, wkv0_p, ret0_p, *lp)
        hs_, b1, b2, b3 = trunk_layer(hs_, c_sample, pos_s, state_rwkv_shift[l], state_rwkv_wkv[l],
                                      state_ret[l], *lp)
        sh_p.append(a1); wk_p.append(a2); rt_p.append(a3)
        sh_s.append(b1); wk_s.append(b2); rt_s.append(b3)
    y_prompt = hp.astype(x_prompt.dtype)
    y_sample = hs_.astype(x_sample.dtype)
    return (y_prompt, y_sample, jnp.stack(sh_p), jnp.stack(wk_p), jnp.stack(rt_p),
            jnp.stack(sh_s), jnp.stack(wk_s), jnp.stack(rt_s))
```

```cpp
#include <hip/hip_runtime.h>
#include <hip/hip_cooperative_groups.h>
#include <cstdio>
#include <cstdint>
namespace cg = cooperative_groups;
namespace pg8 {
#define PG8_LAS __attribute__((address_space(3)))
typedef unsigned short bf16_t;
typedef short bf16x8 __attribute__((ext_vector_type(8)));
typedef float f32x4 __attribute__((ext_vector_type(4)));
typedef unsigned u32x4 __attribute__((ext_vector_type(4)));
constexpr int BM = 256, BK = 64, HALF = 128, HTB = HALF * BK * 2  , STAGE_BYTES = 8 * HTB, NXCD = 8, WGM = 8;

__host__ __device__ __forceinline__ int lds_byte(int r, int c) { const int st = (r >> 4) * 2 + (c >> 5), rr = r & 15, cc = c & 31, ob = rr * 64 + cc * 2; return st * 1024 + (ob ^ (((ob >> 9) & 1) << 5)); }
__host__ __device__ __forceinline__ void stage_rc(int b, int& R, int& C) { const int st = b / 1024, sb = b % 1024, swz = sb ^ (((sb >> 9) & 1) << 5); R = (st >> 1) * 16 + swz / 64; C = (st & 1) * 32 + (swz % 64) / 2; }
__host__ __device__ __forceinline__ int perm32(int rho) { const int n = rho >> 4, i = rho & 15; return 8 * (i >> 2) + 4 * n + (i & 3); }

struct Unit { int pm, pn; };
struct Gemm { const bf16_t* A; const bf16_t* Bt; int M, N, K; };

struct StaticOrder {
    int nM, nN, nwg, G, c;
    __host__ __device__ void init(int M, int N, int G_, int c_) { nM = M / BM; nN = N / BM; nwg = nM * nN; G = G_; c = c_; }
    __host__ __device__ bool next(int i, Unit& u) const {
        const long L = (long)i * G + c; if (L >= nwg) return false;
        int wgid = (int)L; { const int q = nwg / NXCD, r = nwg % NXCD, xcd = wgid % NXCD, off = wgid / NXCD; wgid = (xcd < r ? xcd * (q + 1) : r * (q + 1) + (xcd - r) * q) + off; }
        const int nig = WGM * nN, gid = wgid / nig, fm = gid * WGM, gsz = (nM - fm) < WGM ? (nM - fm) : WGM;
        u.pm = fm + ((wgid % nig) % gsz); u.pn = (wgid % nig) / gsz; return true;
    }
    __device__ __forceinline__ void a_ready(const Unit&) const {}
    __device__ __forceinline__ void done(const Unit&) const {}
};

__device__ __forceinline__ unsigned cvt_pk_bf16(float lo, float hi) { unsigned r; asm volatile("v_cvt_pk_bf16_f32 %0, %1, %2" : "=v"(r) : "v"(lo), "v"(hi)); return r; }
template <class Epi, class Sched, bool ALIGN_EPI = false, bool SP2 = false>
__device__ __forceinline__ void gemm_phase(PG8_LAS unsigned char* lds, const Gemm g, const Sched& S, const Epi& E) {
    const int tid = threadIdx.x, wid = __builtin_amdgcn_readfirstlane(tid >> 6), lane = tid & 63, wr = wid >> 2, wc = wid & 3, fr = lane & 15, fq = lane >> 4;
    const int K = g.K, nt = K / BK;
    unsigned voffA[2], voffB[2];
#pragma unroll
    for (int i = 0; i < 2; ++i) { int R, C; stage_rc(tid * 16 + i * 8192, R, C); const int Rb = Epi::PERM ? ((R & ~31) + perm32(R & 31)) : R;
        voffA[i] = (unsigned)(R * K + C) * 2u; voffB[i] = (unsigned)(Rb * K + C) * 2u; }
    const size_t kstep = (size_t)(BK * 2);
    const size_t hstep = (size_t)HALF * K * 2;
    const size_t tstep = 2 * hstep;
    const unsigned ldsw = (unsigned)wid * 1024u;
    const int aoff = lds_byte(wr * 64 + fr, fq * 8), boff = lds_byte(wc * 32 + fr, fq * 8);
#define PG8_SA(b, h) (((b) * 2 + (h)) * HTB)
#define PG8_SB(b, h) ((4 + (b) * 2 + (h)) * HTB)
#define PG8_STAGE(bufoff, gbase, voff) do { _Pragma("unroll") for (int _i = 0; _i < 2; ++_i) \
        __builtin_amdgcn_global_load_lds((const unsigned*)((const char*)(gbase) + (voff)[_i]), (PG8_LAS unsigned*)(lds + (bufoff) + ldsw + _i * 8192), 16, 0, 0); } while (0)
#define PG8_LDA(dst, b, h) do { _Pragma("unroll") for (int m = 0; m < 4; ++m) _Pragma("unroll") for (int k = 0; k < 2; ++k) dst[m][k] = *(const PG8_LAS bf16x8*)(lds + PG8_SA(b, h) + aoff + m * 2048 + k * 1024); } while (0)
#define PG8_LDB(dst, b, h) do { _Pragma("unroll") for (int n = 0; n < 2; ++n) _Pragma("unroll") for (int k = 0; k < 2; ++k) dst[n][k] = *(const PG8_LAS bf16x8*)(lds + PG8_SB(b, h) + boff + n * 2048 + k * 1024); } while (0)
#define PG8_MMA(ai, bj, At, Bt) do { __builtin_amdgcn_s_setprio(1); _Pragma("unroll") for (int m = 0; m < 4; ++m) _Pragma("unroll") for (int n = 0; n < 2; ++n) _Pragma("unroll") for (int k = 0; k < 2; ++k) \
        acc[ai][bj][m][n] = __builtin_amdgcn_mfma_f32_16x16x32_bf16(Bt[n][k], At[m][k], acc[ai][bj][m][n], 0, 0, 0); __builtin_amdgcn_s_setprio(0); } while (0)
#define PG8_WAIT_V(n) asm volatile("s_waitcnt vmcnt(" #n ")" ::: "memory")
#define PG8_WAIT_L(n) asm volatile("s_waitcnt lgkmcnt(" #n ")" ::: "memory")
#define PG8_BAR __builtin_amdgcn_s_barrier()
#define PG8_SCHED __builtin_amdgcn_sched_barrier(0)
    Unit cur, nxt; int ui = 0;
    if (!S.next(0, cur)) return;
    f32x4 acc[2][2][4][2];
#pragma unroll
    for (int a = 0; a < 2; ++a)
#pragma unroll
        for (int b = 0; b < 2; ++b)
#pragma unroll
            for (int m = 0; m < 4; ++m)
#pragma unroll
                for (int n = 0; n < 2; ++n) acc[a][b][m][n] = (f32x4){0.f, 0.f, 0.f, 0.f};
    bf16x8 At[4][2], B0[2][2], B1[2][2];
    const char* cA = (const char*)g.A + (size_t)cur.pm * tstep; const char* cB = (const char*)g.Bt + (size_t)cur.pn * tstep;
    S.a_ready(cur);
    if constexpr (SP2) {
        PG8_STAGE(PG8_SB(0, 0), cB, voffB); PG8_STAGE(PG8_SB(0, 1), cB + hstep, voffB); PG8_STAGE(PG8_SA(0, 0), cA, voffA); PG8_STAGE(PG8_SA(0, 1), cA + hstep, voffA);
        if (wr == 1) PG8_BAR;
        PG8_WAIT_V(2); PG8_BAR;
        PG8_STAGE(PG8_SB(1, 0), cB + kstep, voffB); PG8_STAGE(PG8_SA(1, 0), cA + kstep, voffA); PG8_STAGE(PG8_SB(1, 1), cB + hstep + kstep, voffB);
        PG8_WAIT_V(6); PG8_BAR;
    } else {
        PG8_STAGE(PG8_SB(0, 0), cB, voffB); PG8_STAGE(PG8_SA(0, 0), cA, voffA); PG8_STAGE(PG8_SB(0, 1), cB + hstep, voffB); PG8_STAGE(PG8_SA(0, 1), cA + hstep, voffA);
        if (wr == 1) PG8_BAR;
        PG8_WAIT_V(4); PG8_BAR;
        PG8_STAGE(PG8_SB(1, 0), cB + kstep, voffB); PG8_STAGE(PG8_SA(1, 0), cA + kstep, voffA); PG8_STAGE(PG8_SB(1, 1), cB + hstep + kstep, voffB);
        PG8_WAIT_V(6); PG8_BAR;
    }
    for (;;) {
        const bool has_next = S.next(ui + 1, nxt);
        const char* nA = has_next ? (const char*)g.A + (size_t)nxt.pm * tstep : cA; const char* nB = has_next ? (const char*)g.Bt + (size_t)nxt.pn * tstep : cB;
        for (int t = 0; t < nt; t += 2) {
            const bool last = (t == nt - 2);
            const char* a1 = cA + (size_t)(t + 1) * kstep;
            const char* a2 = last ? nA : cA + (size_t)(t + 2) * kstep; const char* b2 = last ? nB : cB + (size_t)(t + 2) * kstep;
            const char* a3 = a2 + kstep; const char* b3 = b2 + kstep;
            if (last && has_next) S.a_ready(nxt);
            if constexpr (SP2) {
            PG8_LDB(B0, 0, 0); PG8_LDB(B1, 0, 1); PG8_SCHED; PG8_LDA(At, 0, 0); PG8_STAGE(PG8_SA(1, 1), a1 + hstep, voffA);
            PG8_WAIT_V(8); PG8_WAIT_L(0); PG8_BAR; PG8_MMA(0, 0, At, B0); PG8_MMA(0, 1, At, B1); PG8_BAR; PG8_SCHED;
            PG8_LDA(At, 0, 1); PG8_STAGE(PG8_SB(0, 0), b2, voffB); PG8_STAGE(PG8_SB(0, 1), b2 + hstep, voffB); PG8_STAGE(PG8_SA(0, 0), a2, voffA);
            PG8_WAIT_V(8); PG8_WAIT_L(0); PG8_BAR; PG8_MMA(1, 0, At, B0); PG8_MMA(1, 1, At, B1); PG8_BAR; PG8_SCHED;
            PG8_LDB(B0, 1, 0); PG8_LDB(B1, 1, 1); PG8_SCHED; PG8_LDA(At, 1, 0); PG8_STAGE(PG8_SA(0, 1), a2 + hstep, voffA);
            PG8_WAIT_V(8); PG8_WAIT_L(0); PG8_BAR; PG8_MMA(0, 0, At, B0); PG8_MMA(0, 1, At, B1); PG8_BAR; PG8_SCHED;
            PG8_LDA(At, 1, 1); PG8_STAGE(PG8_SB(1, 0), b3, voffB); PG8_STAGE(PG8_SB(1, 1), b3 + hstep, voffB); PG8_STAGE(PG8_SA(1, 0), a3, voffA);
            PG8_WAIT_V(8); PG8_WAIT_L(0); PG8_BAR; PG8_MMA(1, 0, At, B0); PG8_MMA(1, 1, At, B1); PG8_BAR; PG8_SCHED;
            } else {
            PG8_LDB(B0, 0, 0); PG8_SCHED; PG8_LDA(At, 0, 0); PG8_STAGE(PG8_SA(1, 1), a1 + hstep, voffA);
            PG8_WAIT_L(8); PG8_BAR; PG8_WAIT_L(0); PG8_MMA(0, 0, At, B0); PG8_BAR; PG8_SCHED;
            PG8_LDB(B1, 0, 1); PG8_STAGE(PG8_SB(0, 0), b2, voffB);
            PG8_BAR; PG8_WAIT_L(0); PG8_MMA(0, 1, At, B1); PG8_BAR;
            PG8_LDA(At, 0, 1); PG8_STAGE(PG8_SA(0, 0), a2, voffA);
            PG8_BAR; PG8_WAIT_L(0); PG8_MMA(1, 0, At, B0); PG8_BAR; PG8_SCHED;
            PG8_STAGE(PG8_SB(0, 1), b2 + hstep, voffB);
            PG8_WAIT_V(6); PG8_BAR; PG8_MMA(1, 1, At, B1); PG8_BAR;
            PG8_LDB(B0, 1, 0); PG8_SCHED; PG8_LDA(At, 1, 0); PG8_STAGE(PG8_SA(0, 1), a2 + hstep, voffA);
            PG8_WAIT_L(8); PG8_BAR; PG8_WAIT_L(0); PG8_MMA(0, 0, At, B0); PG8_BAR; PG8_SCHED;
            PG8_LDB(B1, 1, 1); PG8_STAGE(PG8_SB(1, 0), b3, voffB);
            PG8_BAR; PG8_WAIT_L(0); PG8_MMA(0, 1, At, B1); PG8_BAR;
            PG8_LDA(At, 1, 1); PG8_STAGE(PG8_SA(1, 0), a3, voffA);
            PG8_BAR; PG8_WAIT_L(0); PG8_MMA(1, 0, At, B0); PG8_BAR; PG8_SCHED;
            PG8_STAGE(PG8_SB(1, 1), b3 + hstep, voffB);
            PG8_WAIT_V(6); PG8_BAR; PG8_MMA(1, 1, At, B1); PG8_BAR;
            }
        }
        if constexpr (ALIGN_EPI) { if (wr == 0) PG8_BAR; }
        if constexpr (!Epi::AFTER_DRAIN) { E(acc, cur, wr, wc, fr, fq); S.done(cur); }
        if (!has_next) break;
#pragma unroll
        for (int a = 0; a < 2; ++a)
#pragma unroll
            for (int b = 0; b < 2; ++b)
#pragma unroll
                for (int m = 0; m < 4; ++m)
#pragma unroll
                    for (int n = 0; n < 2; ++n) acc[a][b][m][n] = (f32x4){0.f, 0.f, 0.f, 0.f};
        cur = nxt; cA = nA; cB = nB; ++ui;
        if constexpr (ALIGN_EPI) { if (wr == 1) PG8_BAR; }
    }
    PG8_WAIT_V(0);
    if constexpr (!ALIGN_EPI) { if (wr == 0) PG8_BAR; }
    PG8_BAR;
    if constexpr (Epi::AFTER_DRAIN) { E.fused(acc, cur, wr, wc, fr, fq, lds, wid, lane); S.done(cur); }
#undef PG8_SA
#undef PG8_SB
#undef PG8_STAGE
#undef PG8_LDA
#undef PG8_LDB
#undef PG8_MMA
#undef PG8_WAIT_V
#undef PG8_WAIT_L
#undef PG8_BAR
#undef PG8_SCHED
}
}

#ifndef MK_MULTI
#define MK_MULTI 1
#endif
constexpr int D = 2048, TP = 8192, NB = 16, TS = 16, MS = NB * TS, M = TP + MS;
constexpr int RW = 1024, RH = 16, RN = 64, RC = 3328;
constexpr int ED = 1024, EH = 4, EN = 256, EC = 4096, IC = RC + EC;
constexpr int FF = 5632, NSEQ = 17, MODW = 6 * D;
constexpr int LCH = 128, NCH = TP / LCH;
constexpr int RBLK = 256, NRB = TP / RBLK;
constexpr int NPHASE = 14;
constexpr size_t O_Y = 0, O_SHP = (size_t)M * D, O_WKP = O_SHP + RC, O_RTP = O_WKP + 65536, O_SHS = O_RTP + 262144, O_WKS = O_SHS + (size_t)NB * RC, O_RTS = O_WKS + (size_t)NB * 65536, O_END = O_RTS + (size_t)NB * 262144;
constexpr size_t MiB = 1u << 20;
constexpr size_t WS_MOD = 1 * MiB, WS_LORAT = 2 * MiB, WS_WOUTT = 4 * MiB, WS_WINT = 12 * MiB, WS_V = 12 * MiB, WS_H = 41 * MiB, WS_G = 41 * MiB, WS_BON = 58 * MiB,
                 WS_QKVG = 74 * MiB, WS_LOUT = 140 * MiB, WS_PU = 140 * MiB, WS_KVB = 172 * MiB, WS_ACT = 74 * MiB, WS_PREP = 190 * MiB, WS_MIXOUT = 190 * MiB,
                 WS_WUPT = 256 * MiB, WS_WDNT = 300 * MiB, WS_END = 355 * MiB;
constexpr size_t PREP_STRIDE = 33 * MiB;
constexpr size_t DO_Z = 0, DO_LIN = 54 * MiB, DO_SPREV = 0, DO_MIX = 17 * MiB;
constexpr int LDS_BYTES = 147456;

typedef unsigned short bf16;
typedef float f32x2 __attribute__((ext_vector_type(2)));
typedef float f32x4 __attribute__((ext_vector_type(4)));
typedef short bf16x8 __attribute__((ext_vector_type(8)));
typedef unsigned u32x4 __attribute__((ext_vector_type(4)));
typedef unsigned u32x2 __attribute__((ext_vector_type(2)));
#define LDS_WAIT() asm volatile("s_waitcnt lgkmcnt(0)" ::: "memory")

__device__ __forceinline__ float bf2f(unsigned v) { return __builtin_bit_cast(float, v << 16); }
__device__ __forceinline__ unsigned f2bf(float f) { unsigned u = __builtin_bit_cast(unsigned, f); return (u + 0x7fffu + ((u >> 16) & 1u)) >> 16; }
__device__ __forceinline__ unsigned pk2(float lo, float hi) { return f2bf(lo) | (f2bf(hi) << 16); }
__device__ __forceinline__ float wave_sum(float v) {
#pragma unroll
    for (int o = 1; o < 64; o <<= 1) v += __shfl_xor(v, o);
    return v;
}
__device__ __forceinline__ float sigm(float x) { return 1.f / (1.f + __expf(-x)); }
__device__ __forceinline__ int seq_of(int m) { return m < TP ? 0 : 1 + ((m - TP) >> 4); }
__device__ __forceinline__ int tpos_of(int m) { return m < TP ? m : ((m - TP) & 15); }
__device__ __forceinline__ float ret_l2g(int h) { return __log2f(1.0f - exp2f(-5.0f - (float)h)); }

struct EpiProj {
    static constexpr bool PERM = true, AFTER_DRAIN = false;
    bf16* Z; bf16* Q;
    __device__ __forceinline__ void operator()(const f32x4 (&acc)[2][2][4][2], const pg8::Unit& u, int wr, int wc, int fr, int fq) const {
        const int row0 = u.pm * 256 + wr * 64 + fr, pn = u.pn, cl = wc * 32 + 8 * fq;
        if (pn < 13 || pn >= 21) {
            bf16* base = pn < 13 ? Z + pn * 256 + cl : Q + (pn - 13) * 256 + cl; const size_t ld = pn < 13 ? RC : EC;
#pragma unroll
            for (int ai = 0; ai < 2; ++ai)
#pragma unroll
                for (int m = 0; m < 4; ++m) { bf16* rp = base + (size_t)(row0 + ai * 128 + m * 16) * ld;
#pragma unroll
                    for (int bj = 0; bj < 2; ++bj) { const f32x4 v0 = acc[ai][bj][m][0], v1 = acc[ai][bj][m][1]; u32x4 w; w.x = pk2(v0[0], v0[1]); w.y = pk2(v0[2], v0[3]); w.z = pk2(v1[0], v1[1]); w.w = pk2(v1[2], v1[3]);
                        *(u32x4*)(rp + bj * 128) = w; } }
        } else {
            const int sec = pn - 13; bf16* base = Q + sec * 256 + cl; const float sc = sec >= 4 ? 0.0625f : 1.0f;
            float inv[8];
#pragma unroll
            for (int e = 0; e < 8; ++e) inv[e] = exp2f(-(float)(cl + e) * (13.287712379549449f / 128.0f)) * 0.15915494309189535f;
#pragma unroll
            for (int ai = 0; ai < 2; ++ai)
#pragma unroll
                for (int m = 0; m < 4; ++m) { const int row = row0 + ai * 128 + m * 16; bf16* rp = base + (size_t)row * EC;
                    const float pos = row < TP ? (float)row : (float)(2048 + ((row - TP) & 15));
                    float o1[8], o2[8];
#pragma unroll
                    for (int e = 0; e < 8; ++e) { float rev = pos * inv[e]; rev -= floorf(rev); const float sn = __builtin_amdgcn_sinf(rev), cs = __builtin_amdgcn_cosf(rev);
                        const float x1 = acc[ai][0][m][e >> 2][e & 3], x2 = acc[ai][1][m][e >> 2][e & 3];
                        o1[e] = (x1 * cs - x2 * sn) * sc; o2[e] = (x2 * cs + x1 * sn) * sc; }
                    u32x4 w; w.x = pk2(o1[0], o1[1]); w.y = pk2(o1[2], o1[3]); w.z = pk2(o1[4], o1[5]); w.w = pk2(o1[6], o1[7]); *(u32x4*)rp = w;
                    w.x = pk2(o2[0], o2[1]); w.y = pk2(o2[2], o2[3]); w.z = pk2(o2[4], o2[5]); w.w = pk2(o2[6], o2[7]); *(u32x4*)(rp + 128) = w; }
        }
    }
};
struct EpiBf16P {
    static constexpr bool PERM = true, AFTER_DRAIN = false;
    bf16* C; int ldc;
    __device__ __forceinline__ void operator()(const f32x4 (&acc)[2][2][4][2], const pg8::Unit& u, int wr, int wc, int fr, int fq) const {
        const int row0 = u.pm * 256 + wr * 64 + fr; bf16* base = C + u.pn * 256 + wc * 32 + 8 * fq;
#pragma unroll
        for (int ai = 0; ai < 2; ++ai)
#pragma unroll
            for (int m = 0; m < 4; ++m) { bf16* rp = base + (size_t)(row0 + ai * 128 + m * 16) * ldc;
#pragma unroll
                for (int bj = 0; bj < 2; ++bj) { const f32x4 v0 = acc[ai][bj][m][0], v1 = acc[ai][bj][m][1]; u32x4 w; w.x = pk2(v0[0], v0[1]); w.y = pk2(v0[2], v0[3]); w.z = pk2(v1[0], v1[1]); w.w = pk2(v1[2], v1[3]);
                    *(u32x4*)(rp + bj * 128) = w; } }
    }
};
struct EpiF32 {
    static constexpr bool PERM = true, AFTER_DRAIN = false;
    float* C; int ldc;
    __device__ __forceinline__ void operator()(const f32x4 (&acc)[2][2][4][2], const pg8::Unit& u, int wr, int wc, int fr, int fq) const {
        const int row0 = u.pm * 256 + wr * 64 + fr; float* base = C + u.pn * 256 + wc * 32 + 8 * fq;
#pragma unroll
        for (int ai = 0; ai < 2; ++ai)
#pragma unroll
            for (int m = 0; m < 4; ++m) { float* rp = base + (size_t)(row0 + ai * 128 + m * 16) * ldc;
#pragma unroll
                for (int bj = 0; bj < 2; ++bj) { *(f32x4*)(rp + bj * 128) = acc[ai][bj][m][0]; *(f32x4*)(rp + bj * 128 + 4) = acc[ai][bj][m][1]; } }
    }
};
struct EpiSwiglu {
    static constexpr bool PERM = true, AFTER_DRAIN = false;
    bf16* C;
    __device__ __forceinline__ void operator()(const f32x4 (&acc)[2][2][4][2], const pg8::Unit& u, int wr, int wc, int fr, int fq) const {
        const int row0 = u.pm * 256 + wr * 64 + fr; bf16* base = C + u.pn * 128 + wc * 32 + 8 * fq;
#pragma unroll
        for (int ai = 0; ai < 2; ++ai)
#pragma unroll
            for (int m = 0; m < 4; ++m) { float o[8];
#pragma unroll
                for (int e = 0; e < 8; ++e) { const float g = acc[ai][0][m][e >> 2][e & 3], up = acc[ai][1][m][e >> 2][e & 3]; o[e] = g * sigm(g) * up; }
                u32x4 w; w.x = pk2(o[0], o[1]); w.y = pk2(o[2], o[3]); w.z = pk2(o[4], o[5]); w.w = pk2(o[6], o[7]);
                *(u32x4*)(base + (size_t)(row0 + ai * 128 + m * 16) * FF) = w; }
    }
};

__device__ __forceinline__ void transpose_item(const float* __restrict__ W, int K, int N, bf16* WT, int k0, int n0, int dst_row0, float* scr, int lane) {
#pragma unroll 8
    for (int i = 0; i < 32; ++i) { const int kk = 2 * i + (lane >> 5); scr[kk * 33 + (lane & 31)] = W[(size_t)(k0 + kk) * N + n0 + (lane & 31)]; }
    LDS_WAIT();
    const int c = lane & 7;
#pragma unroll
    for (int j = 0; j < 4; ++j) { const int n = (lane >> 3) + 8 * j; const float* s = scr + (8 * c) * 33 + n;
        u32x4 o; o.x = pk2(s[0 * 33], s[1 * 33]); o.y = pk2(s[2 * 33], s[3 * 33]); o.z = pk2(s[4 * 33], s[5 * 33]); o.w = pk2(s[6 * 33], s[7 * 33]);
        *(u32x4*)(WT + (size_t)(dst_row0 + n) * K + k0 + 8 * c) = o; }
    LDS_WAIT();
}

typedef const __attribute__((address_space(4))) f32x2* cf2p;
__device__ __forceinline__ cf2p to_c(const float* p) { return (cf2p)(unsigned long long)p; }
template <int MODE>
__device__ __forceinline__ void rwkv_run(f32x2 (&S)[32], const float* W, const float* NKK, const float* B, const float* K, const float* R, const bf16* Vp, int nsteps, int lane,
                                         const bf16* Gp, const float* BONp, bf16* MIXp, float lnw, float lnb) {
    for (int t = 0; t < nsteps; ++t) {
        const size_t o = (size_t)t * RW;
        cf2p w = to_c(W + o), nk = to_c(NKK + o), b = to_c(B + o), k = to_c(K + o), r = to_c(R + o);
        float v = 0.f; if (MODE != 1) v = bf2f(Vp[o + lane]);
        f32x2 a0 = {0.f, 0.f}, a1 = {0.f, 0.f};
#pragma unroll
        for (int j = 0; j < 32; j += 2) { a0 = __builtin_elementwise_fma(S[j], nk[j], a0); a1 = __builtin_elementwise_fma(S[j + 1], nk[j + 1], a1); }
        const float sa = (a0.x + a0.y) + (a1.x + a1.y);
        const f32x2 sa2 = {sa, sa}, v2 = {v, v};
        f32x2 o0 = {0.f, 0.f}, o1 = {0.f, 0.f};
#pragma unroll
        for (int j = 0; j < 32; ++j) {
            f32x2 s = S[j] * w[j];
            s = __builtin_elementwise_fma(sa2, b[j], s);
            if (MODE != 1) s = __builtin_elementwise_fma(v2, k[j], s);
            S[j] = s;
            if (MODE == 2) { if (j & 1) o1 = __builtin_elementwise_fma(s, r[j], o1); else o0 = __builtin_elementwise_fma(s, r[j], o0); }
        }
        if (MODE == 2) {
            const float ov = (o0.x + o0.y) + (o1.x + o1.y);
            const float mean = wave_sum(ov) * (1.f / 64.f), d = ov - mean, var = wave_sum(d * d) * (1.f / 64.f);
            float y = d * rsqrtf(var + 64e-5f) * lnw + lnb;
            y = (y + BONp[(size_t)t * 16] * v) * bf2f(Gp[o + lane]);
            MIXp[(size_t)t * D + lane] = (bf16)f2bf(y);
        }
    }
}

struct Args { const float* in[30]; float* out; unsigned char* ws; int ph_lo, ph_hi; };
enum { I_XP = 0, I_XS, I_CP, I_CS, I_SSH, I_SWKV, I_SRET, I_ADAW, I_ADAB, I_GPM, I_GPOM, I_GPF, I_GPOF, I_WIN, I_MU, I_W0, I_W2, I_A0, I_A2, I_G2, I_KK, I_KA, I_RK, I_RLW, I_RLB, I_ELW, I_ELB, I_WOUT, I_WUP, I_WDN };

__global__ void __launch_bounds__(512, 2) mk_fwd(Args a) {
    extern __shared__ __attribute__((aligned(16))) unsigned char lds[];
    cg::grid_group grid = cg::this_grid();
    const int tid = threadIdx.x, lane = tid & 63, wave = __builtin_amdgcn_readfirstlane(tid >> 6);
    const int G = gridDim.x, bid = blockIdx.x, gw = bid * 8 + wave, NGW = G * 8;
    const int lo = a.ph_lo, hi = a.ph_hi;
    unsigned char* ws = a.ws; float* out = a.out; unsigned char* dob = (unsigned char*)a.out;
    float* MOD = (float*)(ws + WS_MOD);
    bf16* LORAT = (bf16*)(ws + WS_LORAT); bf16* WOUTT = (bf16*)(ws + WS_WOUTT); bf16* WINT = (bf16*)(ws + WS_WINT); bf16* WUPT = (bf16*)(ws + WS_WUPT); bf16* WDNT = (bf16*)(ws + WS_WDNT);
    bf16* H = (bf16*)(ws + WS_H); bf16* QKVG = (bf16*)(ws + WS_QKVG); bf16* LOUT = (bf16*)(ws + WS_LOUT); bf16* Z = (bf16*)(dob + DO_Z); bf16* LIN = (bf16*)(dob + DO_LIN);
    float* PW = (float*)(ws + WS_PREP); float* PNKK = (float*)(ws + WS_PREP + PREP_STRIDE); float* PB = (float*)(ws + WS_PREP + 2 * PREP_STRIDE); float* PK = (float*)(ws + WS_PREP + 3 * PREP_STRIDE); float* PR = (float*)(ws + WS_PREP + 4 * PREP_STRIDE);
    bf16* PV = (bf16*)(ws + WS_V); bf16* PG = (bf16*)(ws + WS_G); float* BON = (float*)(ws + WS_BON);
    float* PU = (float*)(ws + WS_PU); bf16* KVB = (bf16*)(ws + WS_KVB); bf16* SPREV = (bf16*)(dob + DO_SPREV); bf16* MIX = (bf16*)(dob + DO_MIX);
    float* MIXOUT = (float*)(ws + WS_MIXOUT); bf16* ACT = (bf16*)(ws + WS_ACT);
#ifndef PH_MASK
#define PH_MASK 0x3fff
#endif
#define IN(k) (((PH_MASK >> (k)) & 1) && lo <= (k) && (k) < hi)
#define SEAM(k) do { if (IN(k) && IN((k) + 1)) grid.sync(); } while (0)

    if (IN(0)) {
        float* scr = (float*)lds + wave * (64 * 33 + 16);
        constexpr int IT_WIN = (D / 64) * (IC / 32), IT_WOUT = (D / 64) * (D / 32);
        for (int it = gw; it < IT_WIN + IT_WOUT; it += NGW) {
            if (it < IT_WIN) { const int nb = IC / 32, kb = it / nb, n0 = 32 * (it % nb); transpose_item(a.in[I_WIN], D, IC, WINT, 64 * kb, n0, n0, scr, lane); }
            else { const int r = it - IT_WIN, nb = D / 32, kb = r / nb, n0 = 32 * (r % nb); transpose_item(a.in[I_WOUT], D, D, WOUTT, 64 * kb, n0, n0, scr, lane); }
        }
        for (int idx = bid * 512 + tid; idx < 3072 * 256; idx += G * 512) {
            const int n = idx >> 8, k = idx & 255, sec = n >> 10, nn = n & 1023; float v = 0.f;
            if (sec == 0 && k < 64) v = a.in[I_W2][k * RW + nn];
            else if (sec == 1 && k >= 64 && k < 128) v = a.in[I_A2][(k - 64) * RW + nn];
            else if (sec == 2 && k >= 128) v = a.in[I_G2][(k - 128) * RW + nn];
            LORAT[idx] = (bf16)f2bf(v);
        }
        __syncthreads();
        float* sc = (float*)lds;
        float* accL = (float*)lds + 128 * 20;
        for (int it = bid; it < 48 * 16; it += G) {
            const int cs = it % 48, ks = it / 48, col0 = cs * 256, k0 = ks * 128;
            for (int idx = tid; idx < NSEQ * 128; idx += 512) { const int r = idx >> 7, kk = idx & 127; const float cv = r == 0 ? a.in[I_CP][k0 + kk] : a.in[I_CS][(r - 1) * D + k0 + kk]; sc[kk * 20 + r] = cv * sigm(cv); }
            for (int idx = tid; idx < NSEQ * 256; idx += 512) accL[idx] = 0.f;
            __syncthreads();
            f32x4 acc[NSEQ];
#pragma unroll
            for (int r = 0; r < NSEQ; ++r) acc[r] = (f32x4){0.f, 0.f, 0.f, 0.f};
            const float* wp = a.in[I_ADAW] + (size_t)(k0 + wave * 16) * MODW + col0 + 4 * lane;
#pragma unroll 4
            for (int kk = 0; kk < 16; ++kk) { const f32x4 w4 = *(const f32x4*)(wp + (size_t)kk * MODW); const float* sr = sc + (wave * 16 + kk) * 20;
#pragma unroll
                for (int r = 0; r < NSEQ; ++r) acc[r] += w4 * sr[r]; }
#pragma unroll
            for (int r = 0; r < NSEQ; ++r) {
#pragma unroll
                for (int q = 0; q < 4; ++q) atomicAdd(&accL[r * 256 + 4 * lane + q], acc[r][q]); }
            __syncthreads();
            for (int idx = tid; idx < NSEQ * 256; idx += 512) { const int r = idx >> 8, cc = idx & 255; float v = accL[idx]; if (ks == 0) v += a.in[I_ADAB][col0 + cc]; atomicAdd(&MOD[r * MODW + col0 + cc], v); }
            __syncthreads();
        }
    }
    SEAM(0);
    if (IN(1)) {
        for (int m = gw; m < M; m += NGW) {
            const float* xr = m < TP ? a.in[I_XP] + (size_t)m * D : a.in[I_XS] + (size_t)(m - TP) * D; const float* mod = MOD + seq_of(m) * MODW;
            f32x4 v[8]; float ss = 0.f;
#pragma unroll
            for (int j = 0; j < 8; ++j) { v[j] = *(const f32x4*)(xr + 4 * lane + 256 * j); ss += (v[j].x * v[j].x + v[j].y * v[j].y) + (v[j].z * v[j].z + v[j].w * v[j].w); }
            const float rs = rsqrtf(wave_sum(ss) * (1.f / D) + 1e-6f);
#pragma unroll
            for (int j = 0; j < 8; ++j) { const int c = 4 * lane + 256 * j; const f32x4 g = *(const f32x4*)(a.in[I_GPM] + c), s1 = *(const f32x4*)(mod + D + c), h1 = *(const f32x4*)(mod + c);
                const f32x4 h = v[j] * rs * g * (s1 + 1.f) + h1; u32x2 w; w.x = pk2(h.x, h.y); w.y = pk2(h.z, h.w); *(u32x2*)(H + (size_t)m * D + c) = w; }
        }
    }
    SEAM(1);
    if (IN(2)) {
        pg8::Gemm g{H, WINT, M, IC, D}; pg8::StaticOrder S; S.init(M, IC, G, bid); EpiProj E{Z, QKVG};
        pg8::gemm_phase<EpiProj, pg8::StaticOrder, true, true>((PG8_LAS unsigned char*)lds, g, S, E);
    }
    SEAM(2);
    if (IN(3)) {
        for (int idx = bid * 512 + tid; idx < M * 128; idx += G * 512) {
            const int m = idx >> 7, c2 = (idx & 127) * 2, c = 3072 + c2, tp = tpos_of(m), sq = seq_of(m);
            const unsigned zz = *(const unsigned*)(Z + (size_t)m * RC + c); float z0 = bf2f(zz & 0xffffu), z1 = bf2f(zz >> 16), p0 = 0.f, p1 = 0.f;
            if (tp > 0) { const unsigned pp = *(const unsigned*)(Z + (size_t)(m - 1) * RC + c); p0 = bf2f(pp & 0xffffu); p1 = bf2f(pp >> 16); }
            else if (sq > 0) { p0 = a.in[I_SSH][(size_t)(sq - 1) * RC + c]; p1 = a.in[I_SSH][(size_t)(sq - 1) * RC + c + 1]; }
            z0 = z0 + (p0 - z0) * a.in[I_MU][c]; z1 = z1 + (p1 - z1) * a.in[I_MU][c + 1];
            if (c2 < 64) { z0 = 1.f - 2.f / (__expf(2.f * z0) + 1.f); z1 = 1.f - 2.f / (__expf(2.f * z1) + 1.f); }
            else if (c2 >= 128) { z0 = sigm(z0); z1 = sigm(z1); }
            *(unsigned*)(LIN + (size_t)m * 256 + c2) = pk2(z0, z1);
        }
        for (int idx = bid * 512 + tid; idx < NSEQ * RC; idx += G * 512) { const int s = idx / RC, c = idx % RC; const int m = s == 0 ? TP - 1 : TP + 16 * (s - 1) + 15;
            out[(s == 0 ? O_SHP : O_SHS + (size_t)(s - 1) * RC) + c] = bf2f(Z[(size_t)m * RC + c]); }
    }
    SEAM(3);
    if (IN(4)) {
        int k256 = 256; asm volatile("" : "+s"(k256));
        pg8::Gemm g{LIN, LORAT, M, 3072, k256}; pg8::StaticOrder S; S.init(M, 3072, G, bid); EpiBf16P E{LOUT, 3072};
        pg8::gemm_phase<EpiBf16P, pg8::StaticOrder, true, true>((PG8_LAS unsigned char*)lds, g, S, E);
    }
    SEAM(4);
    if (IN(5)) {
        for (int m = gw; m < M; m += NGW) {
            const int tp = tpos_of(m), sq = seq_of(m); const bf16* zr = Z + (size_t)m * RC; const bf16* zp = zr - RC; const float* sh0 = a.in[I_SSH] + (size_t)(sq > 0 ? sq - 1 : 0) * RC; const bf16* lr = LOUT + (size_t)m * 3072;
            for (int h = 0; h < RH; ++h) {
                const int c = h * 64 + lane; float zs[3];
#pragma unroll
                for (int q = 0; q < 3; ++q) { const int col = q * RW + c; const float z = bf2f(zr[col]); const float p = tp > 0 ? bf2f(zp[col]) : (sq > 0 ? sh0[col] : 0.f); zs[q] = z + (p - z) * a.in[I_MU][col]; }
                const float r = zs[0], k = zs[1], v = zs[2];
                const float w = __expf(-0.6065306597126334f * sigm(a.in[I_W0][c] + bf2f(lr[c])));
                const float av = sigm(a.in[I_A0][c] + bf2f(lr[RW + c]));
                const float kkv = k * a.in[I_KK][c]; const float nrm = sqrtf(wave_sum(kkv * kkv)); const float kk = kkv / fmaxf(nrm, 1e-12f);
                const float k2 = k * (1.f + (av - 1.f) * a.in[I_KA][c]);
                const float bs = wave_sum(r * k2 * a.in[I_RK][c]);
                const size_t o = (size_t)m * RW + c;
                PW[o] = w; PNKK[o] = -kk; PB[o] = kk * av; PK[o] = k2; PR[o] = r; PV[o] = (bf16)f2bf(v); PG[o] = lr[2 * RW + c];
                if (lane == 0) BON[m * 16 + h] = bs;
            }
        }
    }
    SEAM(5);
    if (IN(6)) {
        for (int task = gw; task < RH * NCH * 2; task += NGW) {
            const int part = task & 1, pair = task >> 1, h = pair / NCH, c = pair % NCH;
            const size_t o = (size_t)(c * LCH) * RW + h * 64;
            f32x2 S[32];
#pragma unroll
            for (int j = 0; j < 32; ++j) S[j] = (f32x2){0.f, 0.f};
            if (part) {
#pragma unroll
                for (int j = 0; j < 32; ++j) { S[j].x = (2 * j == lane) ? 1.f : 0.f; S[j].y = (2 * j + 1 == lane) ? 1.f : 0.f; }
                rwkv_run<1>(S, PW + o, PNKK + o, PB + o, PK + o, PR + o, PV + o, LCH, lane, nullptr, nullptr, nullptr, 0.f, 0.f);
            } else rwkv_run<0>(S, PW + o, PNKK + o, PB + o, PK + o, PR + o, PV + o, LCH, lane, nullptr, nullptr, nullptr, 0.f, 0.f);
            float* dst = PU + ((size_t)pair * 2 + (part ? 0 : 1)) * 4096 + lane * 64;
#pragma unroll
            for (int j = 0; j < 16; ++j) *(f32x4*)(dst + 4 * j) = (f32x4){S[2 * j].x, S[2 * j].y, S[2 * j + 1].x, S[2 * j + 1].y};
        }
        bf16* kT = (bf16*)lds;
        bf16* vT = (bf16*)lds + 256 * 72;
        const int fr = lane & 15, fq = lane >> 4;
        for (int it = bid; it < EH * NRB * 2; it += G) {
            const int half = it & 1, blk = (it >> 1) % NRB, h = (it >> 1) / NRB; const float l2g = ret_l2g(h); const int m0 = blk * RBLK;
            f32x4 acc[2][8];
#pragma unroll
            for (int x = 0; x < 2; ++x)
#pragma unroll
                for (int y = 0; y < 8; ++y) acc[x][y] = (f32x4){0.f, 0.f, 0.f, 0.f};
            for (int ts = 0; ts < 4; ++ts) {
                __syncthreads();
#pragma unroll
                for (int i = 0; i < 4; ++i) { const int p = tid + 512 * i, t = p >> 5, dp = p & 31; const u32x4 raw = *(const u32x4*)(QKVG + (size_t)(m0 + ts * 64 + t) * EC + 1024 + h * 256 + dp * 8);
                    const float dec = exp2f(l2g * (float)(255 - (ts * 64 + t)));
#pragma unroll
                    for (int e = 0; e < 4; ++e) { const unsigned w = raw[e]; kT[(dp * 8 + 2 * e) * 72 + t] = (bf16)f2bf(bf2f(w & 0xffffu) * dec); kT[(dp * 8 + 2 * e + 1) * 72 + t] = (bf16)f2bf(bf2f(w >> 16) * dec); } }
#pragma unroll
                for (int i = 0; i < 2; ++i) { const int p = tid + 512 * i, t = p >> 4, ep = p & 15; const u32x4 raw = *(const u32x4*)(QKVG + (size_t)(m0 + ts * 64 + t) * EC + 2048 + h * 256 + half * 128 + ep * 8);
#pragma unroll
                    for (int e = 0; e < 4; ++e) { const unsigned w = raw[e]; vT[(ep * 8 + 2 * e) * 72 + t] = (bf16)(w & 0xffffu); vT[(ep * 8 + 2 * e + 1) * 72 + t] = (bf16)(w >> 16); } }
                __syncthreads();
#pragma unroll
                for (int kk = 0; kk < 2; ++kk) { bf16x8 af[2];
#pragma unroll
                    for (int x = 0; x < 2; ++x) af[x] = *(const bf16x8*)(kT + (32 * wave + 16 * x + fr) * 72 + kk * 32 + fq * 8);
#pragma unroll
                    for (int y = 0; y < 8; ++y) { const bf16x8 bfm = *(const bf16x8*)(vT + (16 * y + fr) * 72 + kk * 32 + fq * 8);
#pragma unroll
                        for (int x = 0; x < 2; ++x) acc[x][y] = __builtin_amdgcn_mfma_f32_16x16x32_bf16(af[x], bfm, acc[x][y], 0, 0, 0); } }
            }
            bf16* dst = KVB + ((size_t)(h * NRB + blk) * 256) * 256;
#pragma unroll
            for (int x = 0; x < 2; ++x)
#pragma unroll
                for (int y = 0; y < 8; ++y) { u32x2 w; w.x = pk2(acc[x][y][0], acc[x][y][1]); w.y = pk2(acc[x][y][2], acc[x][y][3]);
                    *(u32x2*)(dst + (size_t)(half * 128 + 16 * y + fr) * 256 + 32 * wave + 16 * x + fq * 4) = w; }
        }
    }
    SEAM(6);
    if (IN(7)) {
        const int nB = RH * 4;
        if (bid < nB || G <= nB) {
            float* Sb = (float*)lds;
            float* Pb = (float*)lds + 1024;
            for (int it = bid; it < nB; it += G) {
                const int h = it >> 2, g4 = it & 3, i = tid >> 5, j0 = (tid & 31) * 2; const float* pu = PU + (size_t)(h * NCH) * 2 * 4096;
                __syncthreads();
                { const f32x4* src = (const f32x4*)pu; ((f32x4*)Pb)[tid] = src[tid]; ((f32x4*)Pb)[tid + 512] = src[tid + 512]; }
                f32x2 s = {0.f, 0.f};
                f32x2 u = *(const f32x2*)(pu + 4096 + (16 * g4 + i) * 64 + j0);
                for (int c = 0; c < NCH; ++c) {
                    float* Pc = Pb + (c & 1) * 4096; float* Pn = Pb + ((c + 1) & 1) * 4096;
                    *(f32x2*)(Sb + i * 64 + j0) = s;
                    __syncthreads();
                    f32x4 n0 = {0.f, 0.f, 0.f, 0.f}, n1 = n0; f32x2 un = {0.f, 0.f};
                    if (c + 1 < NCH) { const float* pn = pu + (size_t)(c + 1) * 2 * 4096; n0 = ((const f32x4*)pn)[tid]; n1 = ((const f32x4*)pn)[tid + 512]; un = *(const f32x2*)(pn + 4096 + (16 * g4 + i) * 64 + j0); }
                    f32x2 acc = u;
#pragma unroll 8
                    for (int k = 0; k < 64; ++k) { const float sk = Sb[i * 64 + k]; const f32x2 p = *(const f32x2*)(Pc + k * 64 + j0); acc += p * sk; }
                    s = acc;
                    *(f32x2*)((float*)pu + (size_t)c * 2 * 4096 + 4096 + (16 * g4 + i) * 64 + j0) = s;
                    ((f32x4*)Pn)[tid] = n0; ((f32x4*)Pn)[tid + 512] = n1; u = un;
                    __syncthreads();
                }
                *(f32x2*)(out + O_WKP + (size_t)h * 4096 + (16 * g4 + i) * 64 + j0) = s;
            }
        }
        if (bid >= nB || G <= nB) {
            const int nb2 = G <= nB ? G : G - nB, b2 = G <= nB ? bid : bid - nB;
            for (int it = b2 * 512 + tid; it < EH * 256 * 32; it += nb2 * 512) {
                const int h = it >> 13, e = (it >> 5) & 255, d0 = (it & 31) * 8; const float g256 = exp2f(256.f * ret_l2g(h));
                float acc[8];
#pragma unroll
                for (int q = 0; q < 8; ++q) acc[q] = 0.f;
                for (int blk = 0; blk < NRB; ++blk) {
                    const size_t o = ((size_t)(h * NRB + blk) * 256 + e) * 256 + d0;
                    u32x4 w; w.x = pk2(acc[0], acc[1]); w.y = pk2(acc[2], acc[3]); w.z = pk2(acc[4], acc[5]); w.w = pk2(acc[6], acc[7]); *(u32x4*)(SPREV + o) = w;
                    const u32x4 kv = *(const u32x4*)(KVB + o);
#pragma unroll
                    for (int q = 0; q < 4; ++q) { acc[2 * q] = acc[2 * q] * g256 + bf2f(kv[q] & 0xffffu); acc[2 * q + 1] = acc[2 * q + 1] * g256 + bf2f(kv[q] >> 16); }
                }
#pragma unroll
                for (int q = 0; q < 8; ++q) out[O_RTP + (size_t)h * 65536 + (size_t)(d0 + q) * 256 + e] = acc[q];
            }
        }
    }
    SEAM(7);
    if (IN(8)) {
        const int NBC = (G >= 256) ? 160 : G;
        const bool doC = bid < NBC, doR = (G >= 256) ? (bid >= NBC) : true;
#ifndef NO_C
        if (doC) {
            for (int task = gw; task < RH * NCH + NB * RH; task += NBC * 8) {
                f32x2 S[32]; int h, m0, nsteps; float* sdst = nullptr;
                if (task < RH * NCH) { h = task / NCH; const int c = task % NCH; m0 = c * LCH; nsteps = LCH;
                    if (c == 0) {
#pragma unroll
                        for (int j = 0; j < 32; ++j) S[j] = (f32x2){0.f, 0.f};
                    } else { const float* src = PU + ((size_t)(h * NCH + c - 1) * 2 + 1) * 4096 + lane * 64;
#pragma unroll
                        for (int j = 0; j < 16; ++j) { const f32x4 q = *(const f32x4*)(src + 4 * j); S[2 * j] = (f32x2){q.x, q.y}; S[2 * j + 1] = (f32x2){q.z, q.w}; } }
                } else { const int r = task - RH * NCH, b = r / RH; h = r % RH; m0 = TP + 16 * b; nsteps = TS;
                    const float* src = a.in[I_SWKV] + ((size_t)(b * RH + h) * 64 + lane) * 64; sdst = out + O_WKS + ((size_t)(b * RH + h) * 64 + lane) * 64;
#pragma unroll
                    for (int j = 0; j < 16; ++j) { const f32x4 q = *(const f32x4*)(src + 4 * j); S[2 * j] = (f32x2){q.x, q.y}; S[2 * j + 1] = (f32x2){q.z, q.w}; } }
                const size_t o = (size_t)m0 * RW + h * 64;
                rwkv_run<2>(S, PW + o, PNKK + o, PB + o, PK + o, PR + o, PV + o, nsteps, lane, PG + o, BON + (size_t)m0 * 16 + h, MIX + (size_t)m0 * D + h * 64,
                            a.in[I_RLW][h * 64 + lane], a.in[I_RLB][h * 64 + lane]);
                if (sdst) {
#pragma unroll
                    for (int j = 0; j < 16; ++j) *(f32x4*)(sdst + 4 * j) = (f32x4){S[2 * j].x, S[2 * j].y, S[2 * j + 1].x, S[2 * j + 1].y}; }
            }
        }
#endif
        if (doR) {
            const int nb2 = (G >= 256) ? G - NBC : G, b2 = (G >= 256) ? bid - NBC : bid;
            const int fr = lane & 15, fq = lane >> 4;
            for (int it = b2; it < EH * (TP / 64) + NB * EH; it += nb2) {
                __syncthreads();
#ifndef NO_RP
                if (it < EH * (TP / 64)) {
                    const int h = it / (TP / 64), n = it % (TP / 64), blk = n >> 2, i = n & 3, m0 = n * 64; const float l2g = ret_l2g(h);
                    bf16* qL = (bf16*)lds; bf16* kL = qL + 64 * 264; bf16* vT = kL + 64 * 264; bf16* pL = vT + 256 * 72; float* red = (float*)(pL + 64 * 72);
#pragma unroll
                    for (int x = 0; x < 4; ++x) { const int p = tid + 512 * x, t = p >> 5, dp = p & 31; *(u32x4*)(qL + t * 264 + dp * 8) = *(const u32x4*)(QKVG + (size_t)(m0 + t) * EC + h * 256 + dp * 8); }
                    __syncthreads();
                    f32x4 acc[4][2];
#pragma unroll
                    for (int x = 0; x < 4; ++x)
#pragma unroll
                        for (int y = 0; y < 2; ++y) acc[x][y] = (f32x4){0.f, 0.f, 0.f, 0.f};
                    if (blk > 0) {
                        const bf16* sp = SPREV + ((size_t)(h * NRB + blk) * 256) * 256;
#pragma unroll 2
                        for (int kk = 0; kk < 8; ++kk) { bf16x8 bfm[2];
#pragma unroll
                            for (int y = 0; y < 2; ++y) bfm[y] = *(const bf16x8*)(sp + (size_t)(32 * wave + 16 * y + fr) * 256 + kk * 32 + fq * 8);
#pragma unroll
                            for (int x = 0; x < 4; ++x) { const bf16x8 af = *(const bf16x8*)(qL + (16 * x + fr) * 264 + kk * 32 + fq * 8);
#pragma unroll
                                for (int y = 0; y < 2; ++y) acc[x][y] = __builtin_amdgcn_mfma_f32_16x16x32_bf16(af, bfm[y], acc[x][y], 0, 0, 0); } }
#pragma unroll
                        for (int x = 0; x < 4; ++x)
#pragma unroll
                            for (int jj = 0; jj < 4; ++jj) { const float qd = exp2f(l2g * (float)(64 * i + 16 * x + fq * 4 + jj + 1)); acc[x][0][jj] *= qd; acc[x][1][jj] *= qd; }
                    }
                    for (int j = 0; j <= i; ++j) {
                        __syncthreads();
                        const int ms = (blk * 4 + j) * 64;
#pragma unroll
                        for (int x = 0; x < 4; ++x) { const int p = tid + 512 * x, t = p >> 5, dp = p & 31;
                            *(u32x4*)(kL + t * 264 + dp * 8) = *(const u32x4*)(QKVG + (size_t)(ms + t) * EC + 1024 + h * 256 + dp * 8);
                            const u32x4 raw = *(const u32x4*)(QKVG + (size_t)(ms + t) * EC + 2048 + h * 256 + dp * 8);
#pragma unroll
                            for (int e = 0; e < 4; ++e) { const unsigned w = raw[e]; vT[(dp * 8 + 2 * e) * 72 + t] = (bf16)(w & 0xffffu); vT[(dp * 8 + 2 * e + 1) * 72 + t] = (bf16)(w >> 16); } }
                        __syncthreads();
                        { const int tr = wave >> 1, tc0 = (wave & 1) * 2; f32x4 sa[2] = {(f32x4){0.f, 0.f, 0.f, 0.f}, (f32x4){0.f, 0.f, 0.f, 0.f}};
#pragma unroll
                            for (int kk = 0; kk < 8; ++kk) { const bf16x8 af = *(const bf16x8*)(qL + (16 * tr + fr) * 264 + kk * 32 + fq * 8);
#pragma unroll
                                for (int y = 0; y < 2; ++y) { const bf16x8 bfm = *(const bf16x8*)(kL + (16 * (tc0 + y) + fr) * 264 + kk * 32 + fq * 8); sa[y] = __builtin_amdgcn_mfma_f32_16x16x32_bf16(af, bfm, sa[y], 0, 0, 0); } }
#pragma unroll
                            for (int y = 0; y < 2; ++y)
#pragma unroll
                                for (int jj = 0; jj < 4; ++jj) { const int t = 16 * tr + fq * 4 + jj, s = 16 * (tc0 + y) + fr; const int dist = (j < i) ? 64 * (i - j) + t - s : (t > s ? t - s : s - t);
                                    pL[t * 72 + s] = (bf16)f2bf(sa[y][jj] * exp2f(l2g * (float)dist)); } }
                        __syncthreads();
#pragma unroll
                        for (int kk = 0; kk < 2; ++kk) { bf16x8 bfm[2];
#pragma unroll
                            for (int y = 0; y < 2; ++y) bfm[y] = *(const bf16x8*)(vT + (32 * wave + 16 * y + fr) * 72 + kk * 32 + fq * 8);
#pragma unroll
                            for (int x = 0; x < 4; ++x) { const bf16x8 af = *(const bf16x8*)(pL + (16 * x + fr) * 72 + kk * 32 + fq * 8);
#pragma unroll
                                for (int y = 0; y < 2; ++y) acc[x][y] = __builtin_amdgcn_mfma_f32_16x16x32_bf16(af, bfm[y], acc[x][y], 0, 0, 0); } }
                    }
#pragma unroll
                    for (int x = 0; x < 4; ++x)
#pragma unroll
                        for (int jj = 0; jj < 4; ++jj) { float s1 = acc[x][0][jj] + acc[x][1][jj], s2 = acc[x][0][jj] * acc[x][0][jj] + acc[x][1][jj] * acc[x][1][jj];
#pragma unroll
                            for (int o = 1; o < 16; o <<= 1) { s1 += __shfl_xor(s1, o); s2 += __shfl_xor(s2, o); }
                            if (fr == 0) { const int t = 16 * x + fq * 4 + jj; red[(t * 8 + wave) * 2] = s1; red[(t * 8 + wave) * 2 + 1] = s2; } }
                    __syncthreads();
                    float lw[2], lb[2];
#pragma unroll
                    for (int y = 0; y < 2; ++y) { lw[y] = a.in[I_ELW][h * 256 + 32 * wave + 16 * y + fr]; lb[y] = a.in[I_ELB][h * 256 + 32 * wave + 16 * y + fr]; }
#pragma unroll
                    for (int x = 0; x < 4; ++x)
#pragma unroll
                        for (int jj = 0; jj < 4; ++jj) { const int t = 16 * x + fq * 4 + jj; float s1 = 0.f, s2 = 0.f;
#pragma unroll
                            for (int w8 = 0; w8 < 8; ++w8) { s1 += red[(t * 8 + w8) * 2]; s2 += red[(t * 8 + w8) * 2 + 1]; }
                            const float mean = s1 * (1.f / 256.f), var = s2 * (1.f / 256.f) - mean * mean, rstd = rsqrtf(var + 1e-5f);
#pragma unroll
                            for (int y = 0; y < 2; ++y) { const int e = 32 * wave + 16 * y + fr; const float gt = bf2f(QKVG[(size_t)(m0 + t) * EC + 3072 + h * 256 + e]);
                                const float val = ((acc[x][y][jj] - mean) * rstd * lw[y] + lb[y]) * gt * sigm(gt);
                                MIX[(size_t)(m0 + t) * D + RW + h * 256 + e] = (bf16)f2bf(val); } }
                } else
#endif
#ifndef NO_RS
                {
                    const int r = it - EH * (TP / 64), b = r / EH, h = r % EH, m0 = TP + 16 * b; const float l2g = ret_l2g(h);
                    float* qf = (float*)lds; float* kf = qf + 16 * 257; float* vf = kf + 16 * 257; float* pf = vf + 16 * 257; float* red = pf + 256;
                    for (int idx = tid; idx < 16 * 256; idx += 512) { const int t = idx >> 8, dd = idx & 255; const bf16* src = QKVG + (size_t)(m0 + t) * EC + h * 256 + dd;
                        qf[t * 257 + dd] = bf2f(src[0]); kf[t * 257 + dd] = bf2f(src[1024]); vf[t * 257 + dd] = bf2f(src[2048]); }
                    __syncthreads();
                    if (tid < 256) { const int t = tid >> 4, s = tid & 15; float sc = 0.f;
#pragma unroll 4
                        for (int dd = 0; dd < 256; ++dd) sc += qf[t * 257 + dd] * kf[s * 257 + dd];
                        pf[t * 16 + s] = sc * exp2f(l2g * (float)(t > s ? t - s : s - t)); }
                    __syncthreads();
                    const int e = tid & 255, th = tid >> 8; const float* S0 = a.in[I_SRET] + (size_t)(b * EH + h) * 65536;
                    float oc[8];
#pragma unroll
                    for (int tt = 0; tt < 8; ++tt) oc[tt] = 0.f;
#pragma unroll 2
                    for (int dd = 0; dd < 256; ++dd) { const float s0 = S0[(size_t)dd * 256 + e];
#pragma unroll
                        for (int tt = 0; tt < 8; ++tt) oc[tt] += qf[(th * 8 + tt) * 257 + dd] * s0; }
#pragma unroll
                    for (int tt = 0; tt < 8; ++tt) { const int t = th * 8 + tt; float v = oc[tt] * exp2f(l2g * (float)(t + 1));
#pragma unroll 4
                        for (int s = 0; s < 16; ++s) v += pf[t * 16 + s] * vf[s * 257 + e];
                        oc[tt] = v; }
                    { const float g16 = exp2f(16.f * l2g); float* dst = out + O_RTS + (size_t)(b * EH + h) * 65536; float vd[16];
#pragma unroll
                        for (int t = 0; t < 16; ++t) vd[t] = vf[t * 257 + e] * exp2f(l2g * (float)(15 - t));
#pragma unroll 2
                        for (int dd = th * 128; dd < th * 128 + 128; ++dd) { float v = g16 * S0[(size_t)dd * 256 + e];
#pragma unroll
                            for (int t = 0; t < 16; ++t) v += kf[t * 257 + dd] * vd[t];
                            dst[(size_t)dd * 256 + e] = v; } }
#pragma unroll
                    for (int tt = 0; tt < 8; ++tt) { const float s1 = wave_sum(oc[tt]), s2 = wave_sum(oc[tt] * oc[tt]); if (lane == 0) { const int t = th * 8 + tt; red[(t * 4 + (wave & 3)) * 2] = s1; red[(t * 4 + (wave & 3)) * 2 + 1] = s2; } }
                    __syncthreads();
                    const float lw = a.in[I_ELW][h * 256 + e], lb = a.in[I_ELB][h * 256 + e];
#pragma unroll
                    for (int tt = 0; tt < 8; ++tt) { const int t = th * 8 + tt; float s1 = 0.f, s2 = 0.f;
#pragma unroll
                        for (int w4 = 0; w4 < 4; ++w4) { s1 += red[(t * 4 + w4) * 2]; s2 += red[(t * 4 + w4) * 2 + 1]; }
                        const float mean = s1 * (1.f / 256.f), var = s2 * (1.f / 256.f) - mean * mean, rstd = rsqrtf(var + 1e-5f);
                        const float gt = bf2f(QKVG[(size_t)(m0 + t) * EC + 3072 + h * 256 + e]);
                        MIX[(size_t)(m0 + t) * D + RW + h * 256 + e] = (bf16)f2bf(((oc[tt] - mean) * rstd * lw + lb) * gt * sigm(gt)); }
                }
#else
                {}
#endif
            }
        }
    }
    SEAM(8);
    if (IN(9)) {
        pg8::Gemm g{MIX, WOUTT, M, D, D}; pg8::StaticOrder S; S.init(M, D, G, bid); EpiF32 E{MIXOUT, D};
        pg8::gemm_phase<EpiF32, pg8::StaticOrder, true, true>((PG8_LAS unsigned char*)lds, g, S, E);
    }
    SEAM(9);
    if (IN(10)) {
        for (int m = gw; m < M; m += NGW) {
            const float* xr = m < TP ? a.in[I_XP] + (size_t)m * D : a.in[I_XS] + (size_t)(m - TP) * D; const float* mod = MOD + seq_of(m) * MODW; const float* mr = MIXOUT + (size_t)m * D;
            f32x4 v[8]; float ss = 0.f;
#pragma unroll
            for (int j = 0; j < 8; ++j) { v[j] = *(const f32x4*)(mr + 4 * lane + 256 * j); ss += (v[j].x * v[j].x + v[j].y * v[j].y) + (v[j].z * v[j].z + v[j].w * v[j].w); }
            const float rs = rsqrtf(wave_sum(ss) * (1.f / D) + 1e-6f); float s2 = 0.f;
#pragma unroll
            for (int j = 0; j < 8; ++j) { const int c = 4 * lane + 256 * j; const f32x4 g = *(const f32x4*)(a.in[I_GPOM] + c), gt = *(const f32x4*)(mod + 2 * D + c), x = *(const f32x4*)(xr + c);
                v[j] = x + gt * (v[j] * rs * g); *(f32x4*)(out + (size_t)m * D + c) = v[j]; s2 += (v[j].x * v[j].x + v[j].y * v[j].y) + (v[j].z * v[j].z + v[j].w * v[j].w); }
            const float rs2 = rsqrtf(wave_sum(s2) * (1.f / D) + 1e-6f);
#pragma unroll
            for (int j = 0; j < 8; ++j) { const int c = 4 * lane + 256 * j; const f32x4 g = *(const f32x4*)(a.in[I_GPF] + c), s1 = *(const f32x4*)(mod + 4 * D + c), h1 = *(const f32x4*)(mod + 3 * D + c);
                const f32x4 h = v[j] * rs2 * g * (s1 + 1.f) + h1; u32x2 w; w.x = pk2(h.x, h.y); w.y = pk2(h.z, h.w); *(u32x2*)(H + (size_t)m * D + c) = w; }
        }
        float* scr = (float*)lds + wave * (64 * 33 + 16);
        constexpr int IT_UP = (D / 64) * (2 * FF / 32), IT_DN = (FF / 64) * (D / 32);
        for (int it = gw; it < IT_UP + IT_DN; it += NGW) {
            if (it < IT_UP) { const int nb = 2 * FF / 32, kb = it / nb, n0 = 32 * (it % nb); const int nn = n0 < FF ? n0 : n0 - FF; const int dr = 256 * (nn >> 7) + (n0 < FF ? 0 : 128) + (nn & 127);
                transpose_item(a.in[I_WUP], D, 2 * FF, WUPT, 64 * kb, n0, dr, scr, lane); }
            else { const int r = it - IT_UP, nb = D / 32, kb = r / nb, n0 = 32 * (r % nb); transpose_item(a.in[I_WDN], FF, D, WDNT, 64 * kb, n0, n0, scr, lane); }
        }
    }
    SEAM(10);
    if (IN(11)) {
        pg8::Gemm g{H, WUPT, M, 2 * FF, D}; pg8::StaticOrder S; S.init(M, 2 * FF, G, bid); EpiSwiglu E{ACT};
        pg8::gemm_phase<EpiSwiglu, pg8::StaticOrder, true, true>((PG8_LAS unsigned char*)lds, g, S, E);
    }
    SEAM(11);
    if (IN(12)) {
        pg8::Gemm g{ACT, WDNT, M, D, FF}; pg8::StaticOrder S; S.init(M, D, G, bid); EpiF32 E{MIXOUT, D};
        pg8::gemm_phase<EpiF32, pg8::StaticOrder, true, true>((PG8_LAS unsigned char*)lds, g, S, E);
    }
    SEAM(12);
    if (IN(13)) {
        for (int m = gw; m < M; m += NGW) {
            const float* mod = MOD + seq_of(m) * MODW; const float* fr_ = MIXOUT + (size_t)m * D;
            f32x4 v[8]; float ss = 0.f;
#pragma unroll
            for (int j = 0; j < 8; ++j) { v[j] = *(const f32x4*)(fr_ + 4 * lane + 256 * j); ss += (v[j].x * v[j].x + v[j].y * v[j].y) + (v[j].z * v[j].z + v[j].w * v[j].w); }
            const float rs = rsqrtf(wave_sum(ss) * (1.f / D) + 1e-6f);
#pragma unroll
            for (int j = 0; j < 8; ++j) { const int c = 4 * lane + 256 * j; const f32x4 g = *(const f32x4*)(a.in[I_GPOF] + c), gt = *(const f32x4*)(mod + 5 * D + c), x = *(const f32x4*)(out + (size_t)m * D + c);
                *(f32x4*)(out + (size_t)m * D + c) = x + gt * (v[j] * rs * g); }
        }
    }
#undef IN
#undef SEAM
}

extern "C" void kernel_launch(void* const* d_in, const int* in_sizes, int n_in, void* d_out, int out_size, void* d_ws, size_t ws_size, hipStream_t stream) {
    static int grid = 0;
    if (grid == 0) {
        if (n_in != 30 || (size_t)out_size != O_END || ws_size < WS_END) { fprintf(stderr, "kernel_launch: unexpected sizes n_in %d out %d ws %zu\n", n_in, out_size, ws_size); grid = -1; return; }
        int dev = 0, cus = 0, per_cu = 0;
        (void)hipGetDevice(&dev); (void)hipDeviceGetAttribute(&cus, hipDeviceAttributeMultiprocessorCount, dev);
        if (hipFuncSetAttribute((const void*)mk_fwd, hipFuncAttributeMaxDynamicSharedMemorySize, LDS_BYTES) != hipSuccess) { fprintf(stderr, "kernel_launch: hipFuncSetAttribute failed\n"); grid = -1; return; }
        if (hipOccupancyMaxActiveBlocksPerMultiprocessor(&per_cu, (const void*)mk_fwd, 512, LDS_BYTES) != hipSuccess || per_cu < 1) { fprintf(stderr, "kernel_launch: occupancy query says %d\n", per_cu); per_cu = 1; }
        (void)hipGetLastError();
        grid = cus;
        if (grid <= 0) grid = 256;
    }
    if (grid < 0) return;
    (void)hipMemsetAsync((char*)d_ws + WS_MOD, 0, (size_t)NSEQ * MODW * 4, stream);
    Args a{};
    for (int i = 0; i < 30; ++i) a.in[i] = (const float*)d_in[i];
    a.out = (float*)d_out; a.ws = (unsigned char*)d_ws;
#if MK_MULTI
    for (int p = 0; p < NPHASE; ++p) { a.ph_lo = p; a.ph_hi = p + 1; hipLaunchKernelGGL(mk_fwd, dim3(grid), dim3(512), LDS_BYTES, stream, a); }
#else
    a.ph_lo = 0; a.ph_hi = NPHASE;
    void* args[] = {&a};
    hipError_t e = hipLaunchCooperativeKernel((const void*)mk_fwd, dim3(grid), dim3(512), args, LDS_BYTES, stream);
    if (e != hipSuccess) fprintf(stderr, "kernel_launch: cooperative launch failed: %s (grid %d)\n", hipGetErrorString(e), grid);
#endif
}
```

```cpp
#include <hip/hip_runtime.h>
#include <hip/hip_cooperative_groups.h>
#include <cstdio>
#include <cstdint>
namespace cg = cooperative_groups;
namespace pg8 {
#define PG8_LAS __attribute__((address_space(3)))
typedef unsigned short bf16_t;
typedef short bf16x8 __attribute__((ext_vector_type(8)));
typedef float f32x4 __attribute__((ext_vector_type(4)));
typedef unsigned u32x4 __attribute__((ext_vector_type(4)));
constexpr int BM = 256, BK = 64, HALF = 128, HTB = HALF * BK * 2  , STAGE_BYTES = 8 * HTB, NXCD = 8, WGM = 8;

__host__ __device__ __forceinline__ int lds_byte(int r, int c) { const int st = (r >> 4) * 2 + (c >> 5), rr = r & 15, cc = c & 31, ob = rr * 64 + cc * 2; return st * 1024 + (ob ^ (((ob >> 9) & 1) << 5)); }
__host__ __device__ __forceinline__ void stage_rc(int b, int& R, int& C) { const int st = b / 1024, sb = b % 1024, swz = sb ^ (((sb >> 9) & 1) << 5); R = (st >> 1) * 16 + swz / 64; C = (st & 1) * 32 + (swz % 64) / 2; }
__host__ __device__ __forceinline__ int perm32(int rho) { const int n = rho >> 4, i = rho & 15; return 8 * (i >> 2) + 4 * n + (i & 3); }

struct Unit { int pm, pn; };
struct Gemm { const bf16_t* A; const bf16_t* Bt; int M, N, K; };

struct StaticOrder {
    int nM, nN, nwg, G, c;
    __host__ __device__ void init(int M, int N, int G_, int c_) { nM = M / BM; nN = N / BM; nwg = nM * nN; G = G_; c = c_; }
    __host__ __device__ bool next(int i, Unit& u) const {
        const long L = (long)i * G + c; if (L >= nwg) return false;
        int wgid = (int)L; { const int q = nwg / NXCD, r = nwg % NXCD, xcd = wgid % NXCD, off = wgid / NXCD; wgid = (xcd < r ? xcd * (q + 1) : r * (q + 1) + (xcd - r) * q) + off; }
        const int nig = WGM * nN, gid = wgid / nig, fm = gid * WGM, gsz = (nM - fm) < WGM ? (nM - fm) : WGM;
        u.pm = fm + ((wgid % nig) % gsz); u.pn = (wgid % nig) / gsz; return true;
    }
    __device__ __forceinline__ void a_ready(const Unit&) const {}
    __device__ __forceinline__ void done(const Unit&) const {}
};

__device__ __forceinline__ unsigned cvt_pk_bf16(float lo, float hi) { unsigned r; asm volatile("v_cvt_pk_bf16_f32 %0, %1, %2" : "=v"(r) : "v"(lo), "v"(hi)); return r; }
template <class Epi, class Sched, bool ALIGN_EPI = false, bool SP2 = false>
__device__ __forceinline__ void gemm_phase(PG8_LAS unsigned char* lds, const Gemm g, const Sched& S, const Epi& E) {
    const int tid = threadIdx.x, wid = __builtin_amdgcn_readfirstlane(tid >> 6), lane = tid & 63, wr = wid >> 2, wc = wid & 3, fr = lane & 15, fq = lane >> 4;
    const int K = g.K, nt = K / BK;
    unsigned voffA[2], voffB[2];
#pragma unroll
    for (int i = 0; i < 2; ++i) { int R, C; stage_rc(tid * 16 + i * 8192, R, C); const int Rb = Epi::PERM ? ((R & ~31) + perm32(R & 31)) : R;
        voffA[i] = (unsigned)(R * K + C) * 2u; voffB[i] = (unsigned)(Rb * K + C) * 2u; }
    const size_t kstep = (size_t)(BK * 2);
    const size_t hstep = (size_t)HALF * K * 2;
    const size_t tstep = 2 * hstep;
    const unsigned ldsw = (unsigned)wid * 1024u;
    const int aoff = lds_byte(wr * 64 + fr, fq * 8), boff = lds_byte(wc * 32 + fr, fq * 8);
#define PG8_SA(b, h) (((b) * 2 + (h)) * HTB)
#define PG8_SB(b, h) ((4 + (b) * 2 + (h)) * HTB)
#define PG8_STAGE(bufoff, gbase, voff) do { _Pragma("unroll") for (int _i = 0; _i < 2; ++_i) \
        __builtin_amdgcn_global_load_lds((const unsigned*)((const char*)(gbase) + (voff)[_i]), (PG8_LAS unsigned*)(lds + (bufoff) + ldsw + _i * 8192), 16, 0, 0); } while (0)
#define PG8_LDA(dst, b, h) do { _Pragma("unroll") for (int m = 0; m < 4; ++m) _Pragma("unroll") for (int k = 0; k < 2; ++k) dst[m][k] = *(const PG8_LAS bf16x8*)(lds + PG8_SA(b, h) + aoff + m * 2048 + k * 1024); } while (0)
#define PG8_LDB(dst, b, h) do { _Pragma("unroll") for (int n = 0; n < 2; ++n) _Pragma("unroll") for (int k = 0; k < 2; ++k) dst[n][k] = *(const PG8_LAS bf16x8*)(lds + PG8_SB(b, h) + boff + n * 2048 + k * 1024); } while (0)
#define PG8_MMA(ai, bj, At, Bt) do { __builtin_amdgcn_s_setprio(1); _Pragma("unroll") for (int m = 0; m < 4; ++m) _Pragma("unroll") for (int n = 0; n < 2; ++n) _Pragma("unroll") for (int k = 0; k < 2; ++k) \
        acc[ai][bj][m][n] = __builtin_amdgcn_mfma_f32_16x16x32_bf16(Bt[n][k], At[m][k], acc[ai][bj][m][n], 0, 0, 0); __builtin_amdgcn_s_setprio(0); } while (0)
#define PG8_WAIT_V(n) asm volatile("s_waitcnt vmcnt(" #n ")" ::: "memory")
#define PG8_WAIT_L(n) asm volatile("s_waitcnt lgkmcnt(" #n ")" ::: "memory")
#define PG8_BAR __builtin_amdgcn_s_barrier()
#define PG8_SCHED __builtin_amdgcn_sched_barrier(0)
    Unit cur, nxt; int ui = 0;
    if (!S.next(0, cur)) return;
    f32x4 acc[2][2][4][2];
#pragma unroll
    for (int a = 0; a < 2; ++a)
#pragma unroll
        for (int b = 0; b < 2; ++b)
#pragma unroll
            for (int m = 0; m < 4; ++m)
#pragma unroll
                for (int n = 0; n < 2; ++n) acc[a][b][m][n] = (f32x4){0.f, 0.f, 0.f, 0.f};
    bf16x8 At[4][2], B0[2][2], B1[2][2];
    const char* cA = (const char*)g.A + (size_t)cur.pm * tstep; const char* cB = (const char*)g.Bt + (size_t)cur.pn * tstep;
    S.a_ready(cur);
    if constexpr (SP2) {
        PG8_STAGE(PG8_SB(0, 0), cB, voffB); PG8_STAGE(PG8_SB(0, 1), cB + hstep, voffB); PG8_STAGE(PG8_SA(0, 0), cA, voffA); PG8_STAGE(PG8_SA(0, 1), cA + hstep, voffA);
        if (wr == 1) PG8_BAR;
        PG8_WAIT_V(2); PG8_BAR;
        PG8_STAGE(PG8_SB(1, 0), cB + kstep, voffB); PG8_STAGE(PG8_SA(1, 0), cA + kstep, voffA); PG8_STAGE(PG8_SB(1, 1), cB + hstep + kstep, voffB);
        PG8_WAIT_V(6); PG8_BAR;
    } else {
        PG8_STAGE(PG8_SB(0, 0), cB, voffB); PG8_STAGE(PG8_SA(0, 0), cA, voffA); PG8_STAGE(PG8_SB(0, 1), cB + hstep, voffB); PG8_STAGE(PG8_SA(0, 1), cA + hstep, voffA);
        if (wr == 1) PG8_BAR;
        PG8_WAIT_V(4); PG8_BAR;
        PG8_STAGE(PG8_SB(1, 0), cB + kstep, voffB); PG8_STAGE(PG8_SA(1, 0), cA + kstep, voffA); PG8_STAGE(PG8_SB(1, 1), cB + hstep + kstep, voffB);
        PG8_WAIT_V(6); PG8_BAR;
    }
    for (;;) {
        const bool has_next = S.next(ui + 1, nxt);
        const char* nA = has_next ? (const char*)g.A + (size_t)nxt.pm * tstep : cA; const char* nB = has_next ? (const char*)g.Bt + (size_t)nxt.pn * tstep : cB;
        for (int t = 0; t < nt; t += 2) {
            const bool last = (t == nt - 2);
            const char* a1 = cA + (size_t)(t + 1) * kstep;
            const char* a2 = last ? nA : cA + (size_t)(t + 2) * kstep; const char* b2 = last ? nB : cB + (size_t)(t + 2) * kstep;
            const char* a3 = a2 + kstep; const char* b3 = b2 + kstep;
            if (last && has_next) S.a_ready(nxt);
            if constexpr (SP2) {
            PG8_LDB(B0, 0, 0); PG8_LDB(B1, 0, 1); PG8_SCHED; PG8_LDA(At, 0, 0); PG8_STAGE(PG8_SA(1, 1), a1 + hstep, voffA);
            PG8_WAIT_V(8); PG8_WAIT_L(0); PG8_BAR; PG8_MMA(0, 0, At, B0); PG8_MMA(0, 1, At, B1); PG8_BAR; PG8_SCHED;
            PG8_LDA(At, 0, 1); PG8_STAGE(PG8_SB(0, 0), b2, voffB); PG8_STAGE(PG8_SB(0, 1), b2 + hstep, voffB); PG8_STAGE(PG8_SA(0, 0), a2, voffA);
            PG8_WAIT_V(8); PG8_WAIT_L(0); PG8_BAR; PG8_MMA(1, 0, At, B0); PG8_MMA(1, 1, At, B1); PG8_BAR; PG8_SCHED;
            PG8_LDB(B0, 1, 0); PG8_LDB(B1, 1, 1); PG8_SCHED; PG8_LDA(At, 1, 0); PG8_STAGE(PG8_SA(0, 1), a2 + hstep, voffA);
            PG8_WAIT_V(8); PG8_WAIT_L(0); PG8_BAR; PG8_MMA(0, 0, At, B0); PG8_MMA(0, 1, At, B1); PG8_BAR; PG8_SCHED;
            PG8_LDA(At, 1, 1); PG8_STAGE(PG8_SB(1, 0), b3, voffB); PG8_STAGE(PG8_SB(1, 1), b3 + hstep, voffB); PG8_STAGE(PG8_SA(1, 0), a3, voffA);
            PG8_WAIT_V(8); PG8_WAIT_L(0); PG8_BAR; PG8_MMA(1, 0, At, B0); PG8_MMA(1, 1, At, B1); PG8_BAR; PG8_SCHED;
            } else {
            PG8_LDB(B0, 0, 0); PG8_SCHED; PG8_LDA(At, 0, 0); PG8_STAGE(PG8_SA(1, 1), a1 + hstep, voffA);
            PG8_WAIT_L(8); PG8_BAR; PG8_WAIT_L(0); PG8_MMA(0, 0, At, B0); PG8_BAR; PG8_SCHED;
            PG8_LDB(B1, 0, 1); PG8_STAGE(PG8_SB(0, 0), b2, voffB);
            PG8_BAR; PG8_WAIT_L(0); PG8_MMA(0, 1, At, B1); PG8_BAR;
            PG8_LDA(At, 0, 1); PG8_STAGE(PG8_SA(0, 0), a2, voffA);
            PG8_BAR; PG8_WAIT_L(0); PG8_MMA(1, 0, At, B0); PG8_BAR; PG8_SCHED;
            PG8_STAGE(PG8_SB(0, 1), b2 + hstep, voffB);
            PG8_WAIT_V(6); PG8_BAR; PG8_MMA(1, 1, At, B1); PG8_BAR;
            PG8_LDB(B0, 1, 0); PG8_SCHED; PG8_LDA(At, 1, 0); PG8_STAGE(PG8_SA(0, 1), a2 + hstep, voffA);
            PG8_WAIT_L(8); PG8_BAR; PG8_WAIT_L(0); PG8_MMA(0, 0, At, B0); PG8_BAR; PG8_SCHED;
            PG8_LDB(B1, 1, 1); PG8_STAGE(PG8_SB(1, 0), b3, voffB);
            PG8_BAR; PG8_WAIT_L(0); PG8_MMA(0, 1, At, B1); PG8_BAR;
            PG8_LDA(At, 1, 1); PG8_STAGE(PG8_SA(1, 0), a3, voffA);
            PG8_BAR; PG8_WAIT_L(0); PG8_MMA(1, 0, At, B0); PG8_BAR; PG8_SCHED;
            PG8_STAGE(PG8_SB(1, 1), b3 + hstep, voffB);
            PG8_WAIT_V(6); PG8_BAR; PG8_MMA(1, 1, At, B1); PG8_BAR;
            }
        }
        if constexpr (ALIGN_EPI) { if (wr == 0) PG8_BAR; }
        if constexpr (!Epi::AFTER_DRAIN) { E(acc, cur, wr, wc, fr, fq); S.done(cur); }
        if (!has_next) break;
#pragma unroll
        for (int a = 0; a < 2; ++a)
#pragma unroll
            for (int b = 0; b < 2; ++b)
#pragma unroll
                for (int m = 0; m < 4; ++m)
#pragma unroll
                    for (int n = 0; n < 2; ++n) acc[a][b][m][n] = (f32x4){0.f, 0.f, 0.f, 0.f};
        cur = nxt; cA = nA; cB = nB; ++ui;
        if constexpr (ALIGN_EPI) { if (wr == 1) PG8_BAR; }
    }
    PG8_WAIT_V(0);
    if constexpr (!ALIGN_EPI) { if (wr == 0) PG8_BAR; }
    PG8_BAR;
    if constexpr (Epi::AFTER_DRAIN) { E.fused(acc, cur, wr, wc, fr, fq, lds, wid, lane); S.done(cur); }
#undef PG8_SA
#undef PG8_SB
#undef PG8_STAGE
#undef PG8_LDA
#undef PG8_LDB
#undef PG8_MMA
#undef PG8_WAIT_V
#undef PG8_WAIT_L
#undef PG8_BAR
#undef PG8_SCHED
}
}

#ifndef MK_MULTI
#define MK_MULTI 0
#endif
constexpr int D = 2048, TP = 8192, NB = 16, TS = 16, MS = NB * TS, M = TP + MS;
constexpr int RW = 1024, RH = 16, RN = 64, RC = 3328;
constexpr int ED = 1024, EH = 4, EN = 256, EC = 4096, IC = RC + EC;
constexpr int FF = 5632, NSEQ = 17, MODW = 6 * D;
constexpr int LCH = 128, NCH = TP / LCH;
constexpr int RBLK = 256, NRB = TP / RBLK;
constexpr int NPHASE = 14;
constexpr size_t O_Y = 0, O_SHP = (size_t)M * D, O_WKP = O_SHP + RC, O_RTP = O_WKP + 65536, O_SHS = O_RTP + 262144, O_WKS = O_SHS + (size_t)NB * RC, O_RTS = O_WKS + (size_t)NB * 65536, O_END = O_RTS + (size_t)NB * 262144;
constexpr size_t MiB = 1u << 20;
constexpr size_t WS_MOD = 1 * MiB, WS_LORAT = 2 * MiB, WS_WOUTT = 4 * MiB, WS_WINT = 12 * MiB, WS_V = 12 * MiB, WS_H = 41 * MiB, WS_G = 41 * MiB, WS_BON = 58 * MiB,
                 WS_QKVG = 74 * MiB, WS_LOUT = 140 * MiB, WS_PU = 140 * MiB, WS_KVB = 172 * MiB, WS_ACT = 74 * MiB, WS_PREP = 190 * MiB, WS_MIXOUT = 190 * MiB,
                 WS_WUPT = 256 * MiB, WS_WDNT = 300 * MiB, WS_END = 355 * MiB;
constexpr size_t PREP_STRIDE = 33 * MiB;
constexpr size_t DO_Z = 0, DO_LIN = 54 * MiB, DO_SPREV = 0, DO_MIX = 17 * MiB;
constexpr int LDS_BYTES = 147456;

typedef unsigned short bf16;
typedef float f32x2 __attribute__((ext_vector_type(2)));
typedef float f32x4 __attribute__((ext_vector_type(4)));
typedef short bf16x8 __attribute__((ext_vector_type(8)));
typedef unsigned u32x4 __attribute__((ext_vector_type(4)));
typedef unsigned u32x2 __attribute__((ext_vector_type(2)));
#define LDS_WAIT() asm volatile("s_waitcnt lgkmcnt(0)" ::: "memory")

__device__ __forceinline__ float bf2f(unsigned v) { return __builtin_bit_cast(float, v << 16); }
__device__ __forceinline__ unsigned f2bf(float f) { unsigned u = __builtin_bit_cast(unsigned, f); return (u + 0x7fffu + ((u >> 16) & 1u)) >> 16; }
__device__ __forceinline__ unsigned pk2(float lo, float hi) { return f2bf(lo) | (f2bf(hi) << 16); }
__device__ __forceinline__ float wave_sum(float v) {
#pragma unroll
    for (int o = 1; o < 64; o <<= 1) v += __shfl_xor(v, o);
    return v;
}
__device__ __forceinline__ float sigm(float x) { return 1.f / (1.f + __expf(-x)); }
__device__ __forceinline__ int seq_of(int m) { return m < TP ? 0 : 1 + ((m - TP) >> 4); }
__device__ __forceinline__ int tpos_of(int m) { return m < TP ? m : ((m - TP) & 15); }
__device__ __forceinline__ float ret_l2g(int h) { return __log2f(1.0f - exp2f(-5.0f - (float)h)); }

struct EpiProj {
    static constexpr bool PERM = true, AFTER_DRAIN = false;
    bf16* Z; bf16* Q;
    __device__ __forceinline__ void operator()(const f32x4 (&acc)[2][2][4][2], const pg8::Unit& u, int wr, int wc, int fr, int fq) const {
        const int row0 = u.pm * 256 + wr * 64 + fr, pn = u.pn, cl = wc * 32 + 8 * fq;
        if (pn < 13 || pn >= 21) {
            bf16* base = pn < 13 ? Z + pn * 256 + cl : Q + (pn - 13) * 256 + cl; const size_t ld = pn < 13 ? RC : EC;
#pragma unroll
            for (int ai = 0; ai < 2; ++ai)
#pragma unroll
                for (int m = 0; m < 4; ++m) { bf16* rp = base + (size_t)(row0 + ai * 128 + m * 16) * ld;
#pragma unroll
                    for (int bj = 0; bj < 2; ++bj) { const f32x4 v0 = acc[ai][bj][m][0], v1 = acc[ai][bj][m][1]; u32x4 w; w.x = pk2(v0[0], v0[1]); w.y = pk2(v0[2], v0[3]); w.z = pk2(v1[0], v1[1]); w.w = pk2(v1[2], v1[3]);
                        *(u32x4*)(rp + bj * 128) = w; } }
        } else {
            const int sec = pn - 13; bf16* base = Q + sec * 256 + cl; const float sc = sec >= 4 ? 0.0625f : 1.0f;
            float inv[8];
#pragma unroll
            for (int e = 0; e < 8; ++e) inv[e] = exp2f(-(float)(cl + e) * (13.287712379549449f / 128.0f)) * 0.15915494309189535f;
#pragma unroll
            for (int ai = 0; ai < 2; ++ai)
#pragma unroll
                for (int m = 0; m < 4; ++m) { const int row = row0 + ai * 128 + m * 16; bf16* rp = base + (size_t)row * EC;
                    const float pos = row < TP ? (float)row : (float)(2048 + ((row - TP) & 15));
                    float o1[8], o2[8];
#pragma unroll
                    for (int e = 0; e < 8; ++e) { float rev = pos * inv[e]; rev -= floorf(rev); const float sn = __builtin_amdgcn_sinf(rev), cs = __builtin_amdgcn_cosf(rev);
                        const float x1 = acc[ai][0][m][e >> 2][e & 3], x2 = acc[ai][1][m][e >> 2][e & 3];
                        o1[e] = (x1 * cs - x2 * sn) * sc; o2[e] = (x2 * cs + x1 * sn) * sc; }
                    u32x4 w; w.x = pk2(o1[0], o1[1]); w.y = pk2(o1[2], o1[3]); w.z = pk2(o1[4], o1[5]); w.w = pk2(o1[6], o1[7]); *(u32x4*)rp = w;
                    w.x = pk2(o2[0], o2[1]); w.y = pk2(o2[2], o2[3]); w.z = pk2(o2[4], o2[5]); w.w = pk2(o2[6], o2[7]); *(u32x4*)(rp + 128) = w; }
        }
    }
};
struct EpiBf16P {
    static constexpr bool PERM = true, AFTER_DRAIN = false;
    bf16* C; int ldc;
    __device__ __forceinline__ void operator()(const f32x4 (&acc)[2][2][4][2], const pg8::Unit& u, int wr, int wc, int fr, int fq) const {
        const int row0 = u.pm * 256 + wr * 64 + fr; bf16* base = C + u.pn * 256 + wc * 32 + 8 * fq;
#pragma unroll
        for (int ai = 0; ai < 2; ++ai)
#pragma unroll
            for (int m = 0; m < 4; ++m) { bf16* rp = base + (size_t)(row0 + ai * 128 + m * 16) * ldc;
#pragma unroll
                for (int bj = 0; bj < 2; ++bj) { const f32x4 v0 = acc[ai][bj][m][0], v1 = acc[ai][bj][m][1]; u32x4 w; w.x = pk2(v0[0], v0[1]); w.y = pk2(v0[2], v0[3]); w.z = pk2(v1[0], v1[1]); w.w = pk2(v1[2], v1[3]);
                    *(u32x4*)(rp + bj * 128) = w; } }
    }
};
struct EpiF32 {
    static constexpr bool PERM = true, AFTER_DRAIN = false;
    float* C; int ldc;
    __device__ __forceinline__ void operator()(const f32x4 (&acc)[2][2][4][2], const pg8::Unit& u, int wr, int wc, int fr, int fq) const {
        const int row0 = u.pm * 256 + wr * 64 + fr; float* base = C + u.pn * 256 + wc * 32 + 8 * fq;
#pragma unroll
        for (int ai = 0; ai < 2; ++ai)
#pragma unroll
            for (int m = 0; m < 4; ++m) { float* rp = base + (size_t)(row0 + ai * 128 + m * 16) * ldc;
#pragma unroll
                for (int bj = 0; bj < 2; ++bj) { *(f32x4*)(rp + bj * 128) = acc[ai][bj][m][0]; *(f32x4*)(rp + bj * 128 + 4) = acc[ai][bj][m][1]; } }
    }
};
struct EpiSwiglu {
    static constexpr bool PERM = true, AFTER_DRAIN = false;
    bf16* C;
    __device__ __forceinline__ void operator()(const f32x4 (&acc)[2][2][4][2], const pg8::Unit& u, int wr, int wc, int fr, int fq) const {
        const int row0 = u.pm * 256 + wr * 64 + fr; bf16* base = C + u.pn * 128 + wc * 32 + 8 * fq;
#pragma unroll
        for (int ai = 0; ai < 2; ++ai)
#pragma unroll
            for (int m = 0; m < 4; ++m) { float o[8];
#pragma unroll
                for (int e = 0; e < 8; ++e) { const float g = acc[ai][0][m][e >> 2][e & 3], up = acc[ai][1][m][e >> 2][e & 3]; o[e] = g * sigm(g) * up; }
                u32x4 w; w.x = pk2(o[0], o[1]); w.y = pk2(o[2], o[3]); w.z = pk2(o[4], o[5]); w.w = pk2(o[6], o[7]);
                *(u32x4*)(base + (size_t)(row0 + ai * 128 + m * 16) * FF) = w; }
    }
};

__device__ __forceinline__ void transpose_item(const float* __restrict__ W, int K, int N, bf16* WT, int k0, int n0, int dst_row0, float* scr, int lane) {
#pragma unroll 8
    for (int i = 0; i < 32; ++i) { const int kk = 2 * i + (lane >> 5); scr[kk * 33 + (lane & 31)] = W[(size_t)(k0 + kk) * N + n0 + (lane & 31)]; }
    LDS_WAIT();
    const int c = lane & 7;
#pragma unroll
    for (int j = 0; j < 4; ++j) { const int n = (lane >> 3) + 8 * j; const float* s = scr + (8 * c) * 33 + n;
        u32x4 o; o.x = pk2(s[0 * 33], s[1 * 33]); o.y = pk2(s[2 * 33], s[3 * 33]); o.z = pk2(s[4 * 33], s[5 * 33]); o.w = pk2(s[6 * 33], s[7 * 33]);
        *(u32x4*)(WT + (size_t)(dst_row0 + n) * K + k0 + 8 * c) = o; }
    LDS_WAIT();
}

typedef const __attribute__((address_space(4))) f32x2* cf2p;
__device__ __forceinline__ cf2p to_c(const float* p) { return (cf2p)(unsigned long long)p; }
template <int MODE>
__device__ __forceinline__ void rwkv_run(f32x2 (&S)[32], const float* W, const float* NKK, const float* B, const float* K, const float* R, const bf16* Vp, int nsteps, int lane,
                                         const bf16* Gp, const float* BONp, bf16* MIXp, float lnw, float lnb) {
    for (int t = 0; t < nsteps; ++t) {
        const size_t o = (size_t)t * RW;
        cf2p w = to_c(W + o), nk = to_c(NKK + o), b = to_c(B + o), k = to_c(K + o), r = to_c(R + o);
        float v = 0.f; if (MODE != 1) v = bf2f(Vp[o + lane]);
        f32x2 a0 = {0.f, 0.f}, a1 = {0.f, 0.f};
#pragma unroll
        for (int j = 0; j < 32; j += 2) { a0 = __builtin_elementwise_fma(S[j], nk[j], a0); a1 = __builtin_elementwise_fma(S[j + 1], nk[j + 1], a1); }
        const float sa = (a0.x + a0.y) + (a1.x + a1.y);
        const f32x2 sa2 = {sa, sa}, v2 = {v, v};
        f32x2 o0 = {0.f, 0.f}, o1 = {0.f, 0.f};
#pragma unroll
        for (int j = 0; j < 32; ++j) {
            f32x2 s = S[j] * w[j];
            s = __builtin_elementwise_fma(sa2, b[j], s);
            if (MODE != 1) s = __builtin_elementwise_fma(v2, k[j], s);
            S[j] = s;
            if (MODE == 2) { if (j & 1) o1 = __builtin_elementwise_fma(s, r[j], o1); else o0 = __builtin_elementwise_fma(s, r[j], o0); }
        }
        if (MODE == 2) {
            const float ov = (o0.x + o0.y) + (o1.x + o1.y);
            const float mean = wave_sum(ov) * (1.f / 64.f), d = ov - mean, var = wave_sum(d * d) * (1.f / 64.f);
            float y = d * rsqrtf(var + 64e-5f) * lnw + lnb;
            y = (y + BONp[(size_t)t * 16] * v) * bf2f(Gp[o + lane]);
            MIXp[(size_t)t * D + lane] = (bf16)f2bf(y);
        }
    }
}

struct Args { const float* in[30]; float* out; unsigned char* ws; int ph_lo, ph_hi; };
enum { I_XP = 0, I_XS, I_CP, I_CS, I_SSH, I_SWKV, I_SRET, I_ADAW, I_ADAB, I_GPM, I_GPOM, I_GPF, I_GPOF, I_WIN, I_MU, I_W0, I_W2, I_A0, I_A2, I_G2, I_KK, I_KA, I_RK, I_RLW, I_RLB, I_ELW, I_ELB, I_WOUT, I_WUP, I_WDN };

__global__ void __launch_bounds__(512, 2) mk_fwd(Args a) {
    extern __shared__ __attribute__((aligned(16))) unsigned char lds[];
    cg::grid_group grid = cg::this_grid();
    const int tid = threadIdx.x, lane = tid & 63, wave = __builtin_amdgcn_readfirstlane(tid >> 6);
    const int G = gridDim.x, bid = blockIdx.x, gw = bid * 8 + wave, NGW = G * 8;
    const int lo = a.ph_lo, hi = a.ph_hi;
    unsigned char* ws = a.ws; float* out = a.out; unsigned char* dob = (unsigned char*)a.out;
    float* MOD = (float*)(ws + WS_MOD);
    bf16* LORAT = (bf16*)(ws + WS_LORAT); bf16* WOUTT = (bf16*)(ws + WS_WOUTT); bf16* WINT = (bf16*)(ws + WS_WINT); bf16* WUPT = (bf16*)(ws + WS_WUPT); bf16* WDNT = (bf16*)(ws + WS_WDNT);
    bf16* H = (bf16*)(ws + WS_H); bf16* QKVG = (bf16*)(ws + WS_QKVG); bf16* LOUT = (bf16*)(ws + WS_LOUT); bf16* Z = (bf16*)(dob + DO_Z); bf16* LIN = (bf16*)(dob + DO_LIN);
    float* PW = (float*)(ws + WS_PREP); float* PNKK = (float*)(ws + WS_PREP + PREP_STRIDE); float* PB = (float*)(ws + WS_PREP + 2 * PREP_STRIDE); float* PK = (float*)(ws + WS_PREP + 3 * PREP_STRIDE); float* PR = (float*)(ws + WS_PREP + 4 * PREP_STRIDE);
    bf16* PV = (bf16*)(ws + WS_V); bf16* PG = (bf16*)(ws + WS_G); float* BON = (float*)(ws + WS_BON);
    float* PU = (float*)(ws + WS_PU); bf16* KVB = (bf16*)(ws + WS_KVB); bf16* SPREV = (bf16*)(dob + DO_SPREV); bf16* MIX = (bf16*)(dob + DO_MIX);
    float* MIXOUT = (float*)(ws + WS_MIXOUT); bf16* ACT = (bf16*)(ws + WS_ACT);
#ifndef PH_MASK
#define PH_MASK 0x3fff
#endif
#define IN(k) (((PH_MASK >> (k)) & 1) && lo <= (k) && (k) < hi)
#define SEAM(k) do { if (IN(k) && IN((k) + 1)) grid.sync(); } while (0)

    if (IN(0)) {
        float* scr = (float*)lds + wave * (64 * 33 + 16);
        constexpr int IT_WIN = (D / 64) * (IC / 32), IT_WOUT = (D / 64) * (D / 32);
        for (int it = gw; it < IT_WIN + IT_WOUT; it += NGW) {
            if (it < IT_WIN) { const int nb = IC / 32, kb = it / nb, n0 = 32 * (it % nb); transpose_item(a.in[I_WIN], D, IC, WINT, 64 * kb, n0, n0, scr, lane); }
            else { const int r = it - IT_WIN, nb = D / 32, kb = r / nb, n0 = 32 * (r % nb); transpose_item(a.in[I_WOUT], D, D, WOUTT, 64 * kb, n0, n0, scr, lane); }
        }
        for (int idx = bid * 512 + tid; idx < 3072 * 256; idx += G * 512) {
            const int n = idx >> 8, k = idx & 255, sec = n >> 10, nn = n & 1023; float v = 0.f;
            if (sec == 0 && k < 64) v = a.in[I_W2][k * RW + nn];
            else if (sec == 1 && k >= 64 && k < 128) v = a.in[I_A2][(k - 64) * RW + nn];
            else if (sec == 2 && k >= 128) v = a.in[I_G2][(k - 128) * RW + nn];
            LORAT[idx] = (bf16)f2bf(v);
        }
        __syncthreads();
        float* sc = (float*)lds;
        float* accL = (float*)lds + 128 * 20;
        for (int it = bid; it < 48 * 16; it += G) {
            const int cs = it % 48, ks = it / 48, col0 = cs * 256, k0 = ks * 128;
            for (int idx = tid; idx < NSEQ * 128; idx += 512) { const int r = idx >> 7, kk = idx & 127; const float cv = r == 0 ? a.in[I_CP][k0 + kk] : a.in[I_CS][(r - 1) * D + k0 + kk]; sc[kk * 20 + r] = cv * sigm(cv); }
            for (int idx = tid; idx < NSEQ * 256; idx += 512) accL[idx] = 0.f;
            __syncthreads();
            f32x4 acc[NSEQ];
#pragma unroll
            for (int r = 0; r < NSEQ; ++r) acc[r] = (f32x4){0.f, 0.f, 0.f, 0.f};
            const float* wp = a.in[I_ADAW] + (size_t)(k0 + wave * 16) * MODW + col0 + 4 * lane;
#pragma unroll 4
            for (int kk = 0; kk < 16; ++kk) { const f32x4 w4 = *(const f32x4*)(wp + (size_t)kk * MODW); const float* sr = sc + (wave * 16 + kk) * 20;
#pragma unroll
                for (int r = 0; r < NSEQ; ++r) acc[r] += w4 * sr[r]; }
#pragma unroll
            for (int r = 0; r < NSEQ; ++r) {
#pragma unroll
                for (int q = 0; q < 4; ++q) atomicAdd(&accL[r * 256 + 4 * lane + q], acc[r][q]); }
            __syncthreads();
            for (int idx = tid; idx < NSEQ * 256; idx += 512) { const int r = idx >> 8, cc = idx & 255; float v = accL[idx]; if (ks == 0) v += a.in[I_ADAB][col0 + cc]; atomicAdd(&MOD[r * MODW + col0 + cc], v); }
            __syncthreads();
        }
    }
    SEAM(0);
    if (IN(1)) {
        for (int m = gw; m < M; m += NGW) {
            const float* xr = m < TP ? a.in[I_XP] + (size_t)m * D : a.in[I_XS] + (size_t)(m - TP) * D; const float* mod = MOD + seq_of(m) * MODW;
            f32x4 v[8]; float ss = 0.f;
#pragma unroll
            for (int j = 0; j < 8; ++j) { v[j] = *(const f32x4*)(xr + 4 * lane + 256 * j); ss += (v[j].x * v[j].x + v[j].y * v[j].y) + (v[j].z * v[j].z + v[j].w * v[j].w); }
            const float rs = rsqrtf(wave_sum(ss) * (1.f / D) + 1e-6f);
#pragma unroll
            for (int j = 0; j < 8; ++j) { const int c = 4 * lane + 256 * j; const f32x4 g = *(const f32x4*)(a.in[I_GPM] + c), s1 = *(const f32x4*)(mod + D + c), h1 = *(const f32x4*)(mod + c);
                const f32x4 h = v[j] * rs * g * (s1 + 1.f) + h1; u32x2 w; w.x = pk2(h.x, h.y); w.y = pk2(h.z, h.w); *(u32x2*)(H + (size_t)m * D + c) = w; }
        }
    }
    SEAM(1);
    if (IN(2)) {
        pg8::Gemm g{H, WINT, M, IC, D}; pg8::StaticOrder S; S.init(M, IC, G, bid); EpiProj E{Z, QKVG};
        pg8::gemm_phase<EpiProj, pg8::StaticOrder, true, true>((PG8_LAS unsigned char*)lds, g, S, E);
    }
    SEAM(2);
    if (IN(3)) {
        for (int idx = bid * 512 + tid; idx < M * 128; idx += G * 512) {
            const int m = idx >> 7, c2 = (idx & 127) * 2, c = 3072 + c2, tp = tpos_of(m), sq = seq_of(m);
            const unsigned zz = *(const unsigned*)(Z + (size_t)m * RC + c); float z0 = bf2f(zz & 0xffffu), z1 = bf2f(zz >> 16), p0 = 0.f, p1 = 0.f;
            if (tp > 0) { const unsigned pp = *(const unsigned*)(Z + (size_t)(m - 1) * RC + c); p0 = bf2f(pp & 0xffffu); p1 = bf2f(pp >> 16); }
            else if (sq > 0) { p0 = a.in[I_SSH][(size_t)(sq - 1) * RC + c]; p1 = a.in[I_SSH][(size_t)(sq - 1) * RC + c + 1]; }
            z0 = z0 + (p0 - z0) * a.in[I_MU][c]; z1 = z1 + (p1 - z1) * a.in[I_MU][c + 1];
            if (c2 < 64) { z0 = 1.f - 2.f / (__expf(2.f * z0) + 1.f); z1 = 1.f - 2.f / (__expf(2.f * z1) + 1.f); }
            else if (c2 >= 128) { z0 = sigm(z0); z1 = sigm(z1); }
            *(unsigned*)(LIN + (size_t)m * 256 + c2) = pk2(z0, z1);
        }
        for (int idx = bid * 512 + tid; idx < NSEQ * RC; idx += G * 512) { const int s = idx / RC, c = idx % RC; const int m = s == 0 ? TP - 1 : TP + 16 * (s - 1) + 15;
            out[(s == 0 ? O_SHP : O_SHS + (size_t)(s - 1) * RC) + c] = bf2f(Z[(size_t)m * RC + c]); }
    }
    SEAM(3);
    if (IN(4)) {
        int k256 = 256; asm volatile("" : "+s"(k256));
        pg8::Gemm g{LIN, LORAT, M, 3072, k256}; pg8::StaticOrder S; S.init(M, 3072, G, bid); EpiBf16P E{LOUT, 3072};
        pg8::gemm_phase<EpiBf16P, pg8::StaticOrder, true, true>((PG8_LAS unsigned char*)lds, g, S, E);
    }
    SEAM(4);
    if (IN(5)) {
        for (int m = gw; m < M; m += NGW) {
            const int tp = tpos_of(m), sq = seq_of(m); const bf16* zr = Z + (size_t)m * RC; const bf16* zp = zr - RC; const float* sh0 = a.in[I_SSH] + (size_t)(sq > 0 ? sq - 1 : 0) * RC; const bf16* lr = LOUT + (size_t)m * 3072;
            for (int h = 0; h < RH; ++h) {
                const int c = h * 64 + lane; float zs[3];
#pragma unroll
                for (int q = 0; q < 3; ++q) { const int col = q * RW + c; const float z = bf2f(zr[col]); const float p = tp > 0 ? bf2f(zp[col]) : (sq > 0 ? sh0[col] : 0.f); zs[q] = z + (p - z) * a.in[I_MU][col]; }
                const float r = zs[0], k = zs[1], v = zs[2];
                const float w = __expf(-0.6065306597126334f * sigm(a.in[I_W0][c] + bf2f(lr[c])));
                const float av = sigm(a.in[I_A0][c] + bf2f(lr[RW + c]));
                const float kkv = k * a.in[I_KK][c]; const float nrm = sqrtf(wave_sum(kkv * kkv)); const float kk = kkv / fmaxf(nrm, 1e-12f);
                const float k2 = k * (1.f + (av - 1.f) * a.in[I_KA][c]);
                const float bs = wave_sum(r * k2 * a.in[I_RK][c]);
                const size_t o = (size_t)m * RW + c;
                PW[o] = w; PNKK[o] = -kk; PB[o] = kk * av; PK[o] = k2; PR[o] = r; PV[o] = (bf16)f2bf(v); PG[o] = lr[2 * RW + c];
                if (lane == 0) BON[m * 16 + h] = bs;
            }
        }
    }
    SEAM(5);
    if (IN(6)) {
        for (int task = gw; task < RH * NCH * 2; task += NGW) {
            const int part = task & 1, pair = task >> 1, h = pair / NCH, c = pair % NCH;
            const size_t o = (size_t)(c * LCH) * RW + h * 64;
            f32x2 S[32];
#pragma unroll
            for (int j = 0; j < 32; ++j) S[j] = (f32x2){0.f, 0.f};
            if (part) {
#pragma unroll
                for (int j = 0; j < 32; ++j) { S[j].x = (2 * j == lane) ? 1.f : 0.f; S[j].y = (2 * j + 1 == lane) ? 1.f : 0.f; }
                rwkv_run<1>(S, PW + o, PNKK + o, PB + o, PK + o, PR + o, PV + o, LCH, lane, nullptr, nullptr, nullptr, 0.f, 0.f);
            } else rwkv_run<0>(S, PW + o, PNKK + o, PB + o, PK + o, PR + o, PV + o, LCH, lane, nullptr, nullptr, nullptr, 0.f, 0.f);
            float* dst = PU + ((size_t)pair * 2 + (part ? 0 : 1)) * 4096 + lane * 64;
#pragma unroll
            for (int j = 0; j < 16; ++j) *(f32x4*)(dst + 4 * j) = (f32x4){S[2 * j].x, S[2 * j].y, S[2 * j + 1].x, S[2 * j + 1].y};
        }
        bf16* kT = (bf16*)lds;
        bf16* vT = (bf16*)lds + 256 * 72;
        const int fr = lane & 15, fq = lane >> 4;
        for (int it = bid; it < EH * NRB * 2; it += G) {
            const int half = it & 1, blk = (it >> 1) % NRB, h = (it >> 1) / NRB; const float l2g = ret_l2g(h); const int m0 = blk * RBLK;
            f32x4 acc[2][8];
#pragma unroll
            for (int x = 0; x < 2; ++x)
#pragma unroll
                for (int y = 0; y < 8; ++y) acc[x][y] = (f32x4){0.f, 0.f, 0.f, 0.f};
            for (int ts = 0; ts < 4; ++ts) {
                __syncthreads();
#pragma unroll
                for (int i = 0; i < 4; ++i) { const int p = tid + 512 * i, t = p >> 5, dp = p & 31; const u32x4 raw = *(const u32x4*)(QKVG + (size_t)(m0 + ts * 64 + t) * EC + 1024 + h * 256 + dp * 8);
                    const float dec = exp2f(l2g * (float)(255 - (ts * 64 + t)));
#pragma unroll
                    for (int e = 0; e < 4; ++e) { const unsigned w = raw[e]; kT[(dp * 8 + 2 * e) * 72 + t] = (bf16)f2bf(bf2f(w & 0xffffu) * dec); kT[(dp * 8 + 2 * e + 1) * 72 + t] = (bf16)f2bf(bf2f(w >> 16) * dec); } }
#pragma unroll
                for (int i = 0; i < 2; ++i) { const int p = tid + 512 * i, t = p >> 4, ep = p & 15; const u32x4 raw = *(const u32x4*)(QKVG + (size_t)(m0 + ts * 64 + t) * EC + 2048 + h * 256 + half * 128 + ep * 8);
#pragma unroll
                    for (int e = 0; e < 4; ++e) { const unsigned w = raw[e]; vT[(ep * 8 + 2 * e) * 72 + t] = (bf16)(w & 0xffffu); vT[(ep * 8 + 2 * e + 1) * 72 + t] = (bf16)(w >> 16); } }
                __syncthreads();
#pragma unroll
                for (int kk = 0; kk < 2; ++kk) { bf16x8 af[2];
#pragma unroll
                    for (int x = 0; x < 2; ++x) af[x] = *(const bf16x8*)(kT + (32 * wave + 16 * x + fr) * 72 + kk * 32 + fq * 8);
#pragma unroll
                    for (int y = 0; y < 8; ++y) { const bf16x8 bfm = *(const bf16x8*)(vT + (16 * y + fr) * 72 + kk * 32 + fq * 8);
#pragma unroll
                        for (int x = 0; x < 2; ++x) acc[x][y] = __builtin_amdgcn_mfma_f32_16x16x32_bf16(af[x], bfm, acc[x][y], 0, 0, 0); } }
            }
            bf16* dst = KVB + ((size_t)(h * NRB + blk) * 256) * 256;
#pragma unroll
            for (int x = 0; x < 2; ++x)
#pragma unroll
                for (int y = 0; y < 8; ++y) { u32x2 w; w.x = pk2(acc[x][y][0], acc[x][y][1]); w.y = pk2(acc[x][y][2], acc[x][y][3]);
                    *(u32x2*)(dst + (size_t)(half * 128 + 16 * y + fr) * 256 + 32 * wave + 16 * x + fq * 4) = w; }
        }
    }
    SEAM(6);
    if (IN(7)) {
        const int nB = RH * 4;
        if (bid < nB || G <= nB) {
            float* Sb = (float*)lds;
            float* Pb = (float*)lds + 1024;
            for (int it = bid; it < nB; it += G) {
                const int h = it >> 2, g4 = it & 3, i = tid >> 5, j0 = (tid & 31) * 2; const float* pu = PU + (size_t)(h * NCH) * 2 * 4096;
                __syncthreads();
                { const f32x4* src = (const f32x4*)pu; ((f32x4*)Pb)[tid] = src[tid]; ((f32x4*)Pb)[tid + 512] = src[tid + 512]; }
                f32x2 s = {0.f, 0.f};
                f32x2 u = *(const f32x2*)(pu + 4096 + (16 * g4 + i) * 64 + j0);
                for (int c = 0; c < NCH; ++c) {
                    float* Pc = Pb + (c & 1) * 4096; float* Pn = Pb + ((c + 1) & 1) * 4096;
                    *(f32x2*)(Sb + i * 64 + j0) = s;
                    __syncthreads();
                    f32x4 n0 = {0.f, 0.f, 0.f, 0.f}, n1 = n0; f32x2 un = {0.f, 0.f};
                    if (c + 1 < NCH) { const float* pn = pu + (size_t)(c + 1) * 2 * 4096; n0 = ((const f32x4*)pn)[tid]; n1 = ((const f32x4*)pn)[tid + 512]; un = *(const f32x2*)(pn + 4096 + (16 * g4 + i) * 64 + j0); }
                    f32x2 acc = u;
#pragma unroll 8
                    for (int k = 0; k < 64; ++k) { const float sk = Sb[i * 64 + k]; const f32x2 p = *(const f32x2*)(Pc + k * 64 + j0); acc += p * sk; }
                    s = acc;
                    *(f32x2*)((float*)pu + (size_t)c * 2 * 4096 + 4096 + (16 * g4 + i) * 64 + j0) = s;
                    ((f32x4*)Pn)[tid] = n0; ((f32x4*)Pn)[tid + 512] = n1; u = un;
                    __syncthreads();
                }
                *(f32x2*)(out + O_WKP + (size_t)h * 4096 + (16 * g4 + i) * 64 + j0) = s;
            }
        }
        if (bid >= nB || G <= nB) {
            const int nb2 = G <= nB ? G : G - nB, b2 = G <= nB ? bid : bid - nB;
            for (int it = b2 * 512 + tid; it < EH * 256 * 32; it += nb2 * 512) {
                const int h = it >> 13, e = (it >> 5) & 255, d0 = (it & 31) * 8; const float g256 = exp2f(256.f * ret_l2g(h));
                float acc[8];
#pragma unroll
                for (int q = 0; q < 8; ++q) acc[q] = 0.f;
                for (int blk = 0; blk < NRB; ++blk) {
                    const size_t o = ((size_t)(h * NRB + blk) * 256 + e) * 256 + d0;
                    u32x4 w; w.x = pk2(acc[0], acc[1]); w.y = pk2(acc[2], acc[3]); w.z = pk2(acc[4], acc[5]); w.w = pk2(acc[6], acc[7]); *(u32x4*)(SPREV + o) = w;
                    const u32x4 kv = *(const u32x4*)(KVB + o);
#pragma unroll
                    for (int q = 0; q < 4; ++q) { acc[2 * q] = acc[2 * q] * g256 + bf2f(kv[q] & 0xffffu); acc[2 * q + 1] = acc[2 * q + 1] * g256 + bf2f(kv[q] >> 16); }
                }
#pragma unroll
                for (int q = 0; q < 8; ++q) out[O_RTP + (size_t)h * 65536 + (size_t)(d0 + q) * 256 + e] = acc[q];
            }
        }
    }
    SEAM(7);
    if (IN(8)) {
        const int NBC = (G >= 256) ? 160 : G;
        const bool doC = bid < NBC, doR = (G >= 256) ? (bid >= NBC) : true;
#ifndef NO_C
        if (doC) {
            for (int task = gw; task < RH * NCH + NB * RH; task += NBC * 8) {
                f32x2 S[32]; int h, m0, nsteps; float* sdst = nullptr;
                if (task < RH * NCH) { h = task / NCH; const int c = task % NCH; m0 = c * LCH; nsteps = LCH;
                    if (c == 0) {
#pragma unroll
                        for (int j = 0; j < 32; ++j) S[j] = (f32x2){0.f, 0.f};
                    } else { const float* src = PU + ((size_t)(h * NCH + c - 1) * 2 + 1) * 4096 + lane * 64;
#pragma unroll
                        for (int j = 0; j < 16; ++j) { const f32x4 q = *(const f32x4*)(src + 4 * j); S[2 * j] = (f32x2){q.x, q.y}; S[2 * j + 1] = (f32x2){q.z, q.w}; } }
                } else { const int r = task - RH * NCH, b = r / RH; h = r % RH; m0 = TP + 16 * b; nsteps = TS;
                    const float* src = a.in[I_SWKV] + ((size_t)(b * RH + h) * 64 + lane) * 64; sdst = out + O_WKS + ((size_t)(b * RH + h) * 64 + lane) * 64;
#pragma unroll
                    for (int j = 0; j < 16; ++j) { const f32x4 q = *(const f32x4*)(src + 4 * j); S[2 * j] = (f32x2){q.x, q.y}; S[2 * j + 1] = (f32x2){q.z, q.w}; } }
                const size_t o = (size_t)m0 * RW + h * 64;
                rwkv_run<2>(S, PW + o, PNKK + o, PB + o, PK + o, PR + o, PV + o, nsteps, lane, PG + o, BON + (size_t)m0 * 16 + h, MIX + (size_t)m0 * D + h * 64,
                            a.in[I_RLW][h * 64 + lane], a.in[I_RLB][h * 64 + lane]);
                if (sdst) {
#pragma unroll
                    for (int j = 0; j < 16; ++j) *(f32x4*)(sdst + 4 * j) = (f32x4){S[2 * j].x, S[2 * j].y, S[2 * j + 1].x, S[2 * j + 1].y}; }
            }
        }
#endif
        if (doR) {
            const int nb2 = (G >= 256) ? G - NBC : G, b2 = (G >= 256) ? bid - NBC : bid;
            const int fr = lane & 15, fq = lane >> 4;
            for (int it = b2; it < EH * (TP / 64) + NB * EH; it += nb2) {
                __syncthreads();
#ifndef NO_RP
                if (it < EH * (TP / 64)) {
                    const int h = it / (TP / 64), n = it % (TP / 64), blk = n >> 2, i = n & 3, m0 = n * 64; const float l2g = ret_l2g(h);
                    bf16* qL = (bf16*)lds; bf16* kL = qL + 64 * 264; bf16* vT = kL + 64 * 264; bf16* pL = vT + 256 * 72; float* red = (float*)(pL + 64 * 72);
#pragma unroll
                    for (int x = 0; x < 4; ++x) { const int p = tid + 512 * x, t = p >> 5, dp = p & 31; *(u32x4*)(qL + t * 264 + dp * 8) = *(const u32x4*)(QKVG + (size_t)(m0 + t) * EC + h * 256 + dp * 8); }
                    __syncthreads();
                    f32x4 acc[4][2];
#pragma unroll
                    for (int x = 0; x < 4; ++x)
#pragma unroll
                        for (int y = 0; y < 2; ++y) acc[x][y] = (f32x4){0.f, 0.f, 0.f, 0.f};
                    if (blk > 0) {
                        const bf16* sp = SPREV + ((size_t)(h * NRB + blk) * 256) * 256;
#pragma unroll 2
                        for (int kk = 0; kk < 8; ++kk) { bf16x8 bfm[2];
#pragma unroll
                            for (int y = 0; y < 2; ++y) bfm[y] = *(const bf16x8*)(sp + (size_t)(32 * wave + 16 * y + fr) * 256 + kk * 32 + fq * 8);
#pragma unroll
                            for (int x = 0; x < 4; ++x) { const bf16x8 af = *(const bf16x8*)(qL + (16 * x + fr) * 264 + kk * 32 + fq * 8);
#pragma unroll
                                for (int y = 0; y < 2; ++y) acc[x][y] = __builtin_amdgcn_mfma_f32_16x16x32_bf16(af, bfm[y], acc[x][y], 0, 0, 0); } }
#pragma unroll
                        for (int x = 0; x < 4; ++x)
#pragma unroll
                            for (int jj = 0; jj < 4; ++jj) { const float qd = exp2f(l2g * (float)(64 * i + 16 * x + fq * 4 + jj + 1)); acc[x][0][jj] *= qd; acc[x][1][jj] *= qd; }
                    }
                    for (int j = 0; j <= i; ++j) {
                        __syncthreads();
                        const int ms = (blk * 4 + j) * 64;
#pragma unroll
                        for (int x = 0; x < 4; ++x) { const int p = tid + 512 * x, t = p >> 5, dp = p & 31;
                            *(u32x4*)(kL + t * 264 + dp * 8) = *(const u32x4*)(QKVG + (size_t)(ms + t) * EC + 1024 + h * 256 + dp * 8);
                            const u32x4 raw = *(const u32x4*)(QKVG + (size_t)(ms + t) * EC + 2048 + h * 256 + dp * 8);
#pragma unroll
                            for (int e = 0; e < 4; ++e) { const unsigned w = raw[e]; vT[(dp * 8 + 2 * e) * 72 + t] = (bf16)(w & 0xffffu); vT[(dp * 8 + 2 * e + 1) * 72 + t] = (bf16)(w >> 16); } }
                        __syncthreads();
                        { const int tr = wave >> 1, tc0 = (wave & 1) * 2; f32x4 sa[2] = {(f32x4){0.f, 0.f, 0.f, 0.f}, (f32x4){0.f, 0.f, 0.f, 0.f}};
#pragma unroll
                            for (int kk = 0; kk < 8; ++kk) { const bf16x8 af = *(const bf16x8*)(qL + (16 * tr + fr) * 264 + kk * 32 + fq * 8);
#pragma unroll
                                for (int y = 0; y < 2; ++y) { const bf16x8 bfm = *(const bf16x8*)(kL + (16 * (tc0 + y) + fr) * 264 + kk * 32 + fq * 8); sa[y] = __builtin_amdgcn_mfma_f32_16x16x32_bf16(af, bfm, sa[y], 0, 0, 0); } }
#pragma unroll
                            for (int y = 0; y < 2; ++y)
#pragma unroll
                                for (int jj = 0; jj < 4; ++jj) { const int t = 16 * tr + fq * 4 + jj, s = 16 * (tc0 + y) + fr; const int dist = (j < i) ? 64 * (i - j) + t - s : (t > s ? t - s : s - t);
                                    pL[t * 72 + s] = (bf16)f2bf(sa[y][jj] * exp2f(l2g * (float)dist)); } }
                        __syncthreads();
#pragma unroll
                        for (int kk = 0; kk < 2; ++kk) { bf16x8 bfm[2];
#pragma unroll
                            for (int y = 0; y < 2; ++y) bfm[y] = *(const bf16x8*)(vT + (32 * wave + 16 * y + fr) * 72 + kk * 32 + fq * 8);
#pragma unroll
                            for (int x = 0; x < 4; ++x) { const bf16x8 af = *(const bf16x8*)(pL + (16 * x + fr) * 72 + kk * 32 + fq * 8);
#pragma unroll
                                for (int y = 0; y < 2; ++y) acc[x][y] = __builtin_amdgcn_mfma_f32_16x16x32_bf16(af, bfm[y], acc[x][y], 0, 0, 0); } }
                    }
#pragma unroll
                    for (int x = 0; x < 4; ++x)
#pragma unroll
                        for (int jj = 0; jj < 4; ++jj) { float s1 = acc[x][0][jj] + acc[x][1][jj], s2 = acc[x][0][jj] * acc[x][0][jj] + acc[x][1][jj] * acc[x][1][jj];
#pragma unroll
                            for (int o = 1; o < 16; o <<= 1) { s1 += __shfl_xor(s1, o); s2 += __shfl_xor(s2, o); }
                            if (fr == 0) { const int t = 16 * x + fq * 4 + jj; red[(t * 8 + wave) * 2] = s1; red[(t * 8 + wave) * 2 + 1] = s2; } }
                    __syncthreads();
                    float lw[2], lb[2];
#pragma unroll
                    for (int y = 0; y < 2; ++y) { lw[y] = a.in[I_ELW][h * 256 + 32 * wave + 16 * y + fr]; lb[y] = a.in[I_ELB][h * 256 + 32 * wave + 16 * y + fr]; }
#pragma unroll
                    for (int x = 0; x < 4; ++x)
#pragma unroll
                        for (int jj = 0; jj < 4; ++jj) { const int t = 16 * x + fq * 4 + jj; float s1 = 0.f, s2 = 0.f;
#pragma unroll
                            for (int w8 = 0; w8 < 8; ++w8) { s1 += red[(t * 8 + w8) * 2]; s2 += red[(t * 8 + w8) * 2 + 1]; }
                            const float mean = s1 * (1.f / 256.f), var = s2 * (1.f / 256.f) - mean * mean, rstd = rsqrtf(var + 1e-5f);
#pragma unroll
                            for (int y = 0; y < 2; ++y) { const int e = 32 * wave + 16 * y + fr; const float gt = bf2f(QKVG[(size_t)(m0 + t) * EC + 3072 + h * 256 + e]);
                                const float val = ((acc[x][y][jj] - mean) * rstd * lw[y] + lb[y]) * gt * sigm(gt);
                                MIX[(size_t)(m0 + t) * D + RW + h * 256 + e] = (bf16)f2bf(val); } }
                } else
#endif
#ifndef NO_RS
                {
                    const int r = it - EH * (TP / 64), b = r / EH, h = r % EH, m0 = TP + 16 * b; const float l2g = ret_l2g(h);
                    float* qf = (float*)lds; float* kf = qf + 16 * 257; float* vf = kf + 16 * 257; float* pf = vf + 16 * 257; float* red = pf + 256;
                    for (int idx = tid; idx < 16 * 256; idx += 512) { const int t = idx >> 8, dd = idx & 255; const bf16* src = QKVG + (size_t)(m0 + t) * EC + h * 256 + dd;
                        qf[t * 257 + dd] = bf2f(src[0]); kf[t * 257 + dd] = bf2f(src[1024]); vf[t * 257 + dd] = bf2f(src[2048]); }
                    __syncthreads();
                    if (tid < 256) { const int t = tid >> 4, s = tid & 15; float sc = 0.f;
#pragma unroll 4
                        for (int dd = 0; dd < 256; ++dd) sc += qf[t * 257 + dd] * kf[s * 257 + dd];
                        pf[t * 16 + s] = sc * exp2f(l2g * (float)(t > s ? t - s : s - t)); }
                    __syncthreads();
                    const int e = tid & 255, th = tid >> 8; const float* S0 = a.in[I_SRET] + (size_t)(b * EH + h) * 65536;
                    float oc[8];
#pragma unroll
                    for (int tt = 0; tt < 8; ++tt) oc[tt] = 0.f;
#pragma unroll 2
                    for (int dd = 0; dd < 256; ++dd) { const float s0 = S0[(size_t)dd * 256 + e];
#pragma unroll
                        for (int tt = 0; tt < 8; ++tt) oc[tt] += qf[(th * 8 + tt) * 257 + dd] * s0; }
#pragma unroll
                    for (int tt = 0; tt < 8; ++tt) { const int t = th * 8 + tt; float v = oc[tt] * exp2f(l2g * (float)(t + 1));
#pragma unroll 4
                        for (int s = 0; s < 16; ++s) v += pf[t * 16 + s] * vf[s * 257 + e];
                        oc[tt] = v; }
                    { const float g16 = exp2f(16.f * l2g); float* dst = out + O_RTS + (size_t)(b * EH + h) * 65536; float vd[16];
#pragma unroll
                        for (int t = 0; t < 16; ++t) vd[t] = vf[t * 257 + e] * exp2f(l2g * (float)(15 - t));
#pragma unroll 2
                        for (int dd = th * 128; dd < th * 128 + 128; ++dd) { float v = g16 * S0[(size_t)dd * 256 + e];
#pragma unroll
                            for (int t = 0; t < 16; ++t) v += kf[t * 257 + dd] * vd[t];
                            dst[(size_t)dd * 256 + e] = v; } }
#pragma unroll
                    for (int tt = 0; tt < 8; ++tt) { const float s1 = wave_sum(oc[tt]), s2 = wave_sum(oc[tt] * oc[tt]); if (lane == 0) { const int t = th * 8 + tt; red[(t * 4 + (wave & 3)) * 2] = s1; red[(t * 4 + (wave & 3)) * 2 + 1] = s2; } }
                    __syncthreads();
                    const float lw = a.in[I_ELW][h * 256 + e], lb = a.in[I_ELB][h * 256 + e];
#pragma unroll
                    for (int tt = 0; tt < 8; ++tt) { const int t = th * 8 + tt; float s1 = 0.f, s2 = 0.f;
#pragma unroll
                        for (int w4 = 0; w4 < 4; ++w4) { s1 += red[(t * 4 + w4) * 2]; s2 += red[(t * 4 + w4) * 2 + 1]; }
                        const float mean = s1 * (1.f / 256.f), var = s2 * (1.f / 256.f) - mean * mean, rstd = rsqrtf(var + 1e-5f);
                        const float gt = bf2f(QKVG[(size_t)(m0 + t) * EC + 3072 + h * 256 + e]);
                        MIX[(size_t)(m0 + t) * D + RW + h * 256 + e] = (bf16)f2bf(((oc[tt] - mean) * rstd * lw + lb) * gt * sigm(gt)); }
                }
#else
                {}
#endif
            }
        }
    }
    SEAM(8);
    if (IN(9)) {
        pg8::Gemm g{MIX, WOUTT, M, D, D}; pg8::StaticOrder S; S.init(M, D, G, bid); EpiF32 E{MIXOUT, D};
        pg8::gemm_phase<EpiF32, pg8::StaticOrder, true, true>((PG8_LAS unsigned char*)lds, g, S, E);
    }
    SEAM(9);
    if (IN(10)) {
        for (int m = gw; m < M; m += NGW) {
            const float* xr = m < TP ? a.in[I_XP] + (size_t)m * D : a.in[I_XS] + (size_t)(m - TP) * D; const float* mod = MOD + seq_of(m) * MODW; const float* mr = MIXOUT + (size_t)m * D;
            f32x4 v[8]; float ss = 0.f;
#pragma unroll
            for (int j = 0; j < 8; ++j) { v[j] = *(const f32x4*)(mr + 4 * lane + 256 * j); ss += (v[j].x * v[j].x + v[j].y * v[j].y) + (v[j].z * v[j].z + v[j].w * v[j].w); }
            const float rs = rsqrtf(wave_sum(ss) * (1.f / D) + 1e-6f); float s2 = 0.f;
#pragma unroll
            for (int j = 0; j < 8; ++j) { const int c = 4 * lane + 256 * j; const f32x4 g = *(const f32x4*)(a.in[I_GPOM] + c), gt = *(const f32x4*)(mod + 2 * D + c), x = *(const f32x4*)(xr + c);
                v[j] = x + gt * (v[j] * rs * g); *(f32x4*)(out + (size_t)m * D + c) = v[j]; s2 += (v[j].x * v[j].x + v[j].y * v[j].y) + (v[j].z * v[j].z + v[j].w * v[j].w); }
            const float rs2 = rsqrtf(wave_sum(s2) * (1.f / D) + 1e-6f);
#pragma unroll
            for (int j = 0; j < 8; ++j) { const int c = 4 * lane + 256 * j; const f32x4 g = *(const f32x4*)(a.in[I_GPF] + c), s1 = *(const f32x4*)(mod + 4 * D + c), h1 = *(const f32x4*)(mod + 3 * D + c);
                const f32x4 h = v[j] * rs2 * g * (s1 + 1.f) + h1; u32x2 w; w.x = pk2(h.x, h.y); w.y = pk2(h.z, h.w); *(u32x2*)(H + (size_t)m * D + c) = w; }
        }
        float* scr = (float*)lds + wave * (64 * 33 + 16);
        constexpr int IT_UP = (D / 64) * (2 * FF / 32), IT_DN = (FF / 64) * (D / 32);
        for (int it = gw; it < IT_UP + IT_DN; it += NGW) {
            if (it < IT_UP) { const int nb = 2 * FF / 32, kb = it / nb, n0 = 32 * (it % nb); const int nn = n0 < FF ? n0 : n0 - FF; const int dr = 256 * (nn >> 7) + (n0 < FF ? 0 : 128) + (nn & 127);
                transpose_item(a.in[I_WUP], D, 2 * FF, WUPT, 64 * kb, n0, dr, scr, lane); }
            else { const int r = it - IT_UP, nb = D / 32, kb = r / nb, n0 = 32 * (r % nb); transpose_item(a.in[I_WDN], FF, D, WDNT, 64 * kb, n0, n0, scr, lane); }
        }
    }
    SEAM(10);
    if (IN(11)) {
        pg8::Gemm g{H, WUPT, M, 2 * FF, D}; pg8::StaticOrder S; S.init(M, 2 * FF, G, bid); EpiSwiglu E{ACT};
        pg8::gemm_phase<EpiSwiglu, pg8::StaticOrder, true, true>((PG8_LAS unsigned char*)lds, g, S, E);
    }
    SEAM(11);
    if (IN(12)) {
        pg8::Gemm g{ACT, WDNT, M, D, FF}; pg8::StaticOrder S; S.init(M, D, G, bid); EpiF32 E{MIXOUT, D};
        pg8::gemm_phase<EpiF32, pg8::StaticOrder, true, true>((PG8_LAS unsigned char*)lds, g, S, E);
    }
    SEAM(12);
    if (IN(13)) {
        for (int m = gw; m < M; m += NGW) {
            const float* mod = MOD + seq_of(m) * MODW; const float* fr_ = MIXOUT + (size_t)m * D;
            f32x4 v[8]; float ss = 0.f;
#pragma unroll
            for (int j = 0; j < 8; ++j) { v[j] = *(const f32x4*)(fr_ + 4 * lane + 256 * j); ss += (v[j].x * v[j].x + v[j].y * v[j].y) + (v[j].z * v[j].z + v[j].w * v[j].w); }
            const float rs = rsqrtf(wave_sum(ss) * (1.f / D) + 1e-6f);
#pragma unroll
            for (int j = 0; j < 8; ++j) { const int c = 4 * lane + 256 * j; const f32x4 g = *(const f32x4*)(a.in[I_GPOF] + c), gt = *(const f32x4*)(mod + 5 * D + c), x = *(const f32x4*)(out + (size_t)m * D + c);
                *(f32x4*)(out + (size_t)m * D + c) = x + gt * (v[j] * rs * g); }
        }
    }
#undef IN
#undef SEAM
}

extern "C" void kernel_launch(void* const* d_in, const int* in_sizes, int n_in, void* d_out, int out_size, void* d_ws, size_t ws_size, hipStream_t stream) {
    static int grid = 0;
    if (grid == 0) {
        if (n_in != 30 || (size_t)out_size != O_END || ws_size < WS_END) { fprintf(stderr, "kernel_launch: unexpected sizes n_in %d out %d ws %zu\n", n_in, out_size, ws_size); grid = -1; return; }
        int dev = 0, cus = 0, per_cu = 0;
        (void)hipGetDevice(&dev); (void)hipDeviceGetAttribute(&cus, hipDeviceAttributeMultiprocessorCount, dev);
        if (hipFuncSetAttribute((const void*)mk_fwd, hipFuncAttributeMaxDynamicSharedMemorySize, LDS_BYTES) != hipSuccess) { fprintf(stderr, "kernel_launch: hipFuncSetAttribute failed\n"); grid = -1; return; }
        if (hipOccupancyMaxActiveBlocksPerMultiprocessor(&per_cu, (const void*)mk_fwd, 512, LDS_BYTES) != hipSuccess || per_cu < 1) { fprintf(stderr, "kernel_launch: occupancy query says %d\n", per_cu); per_cu = 1; }
        (void)hipGetLastError();
        grid = cus;
        if (grid <= 0) grid = 256;
    }
    if (grid < 0) return;
    (void)hipMemsetAsync((char*)d_ws + WS_MOD, 0, (size_t)NSEQ * MODW * 4, stream);
    Args a{};
    for (int i = 0; i < 30; ++i) a.in[i] = (const float*)d_in[i];
    a.out = (float*)d_out; a.ws = (unsigned char*)d_ws;
#if MK_MULTI
    for (int p = 0; p < NPHASE; ++p) { a.ph_lo = p; a.ph_hi = p + 1; hipLaunchKernelGGL(mk_fwd, dim3(grid), dim3(512), LDS_BYTES, stream, a); }
#else
    a.ph_lo = 0; a.ph_hi = NPHASE;
    void* args[] = {&a};
    hipError_t e = hipLaunchCooperativeKernel((const void*)mk_fwd, dim3(grid), dim3(512), args, LDS_BYTES, stream);
    if (e != hipSuccess) fprintf(stderr, "kernel_launch: cooperative launch failed: %s (grid %d)\n", hipGetErrorString(e), grid);
#endif
}
```

```cpp
#include <hip/hip_runtime.h>
#include <hip/hip_cooperative_groups.h>
#include <cstdio>
#include <cstdint>
namespace cg = cooperative_groups;
namespace pg8 {
#define PG8_LAS __attribute__((address_space(3)))
typedef unsigned short bf16_t;
typedef short bf16x8 __attribute__((ext_vector_type(8)));
typedef float f32x4 __attribute__((ext_vector_type(4)));
typedef unsigned u32x4 __attribute__((ext_vector_type(4)));
constexpr int BM = 256, BK = 64, HALF = 128, HTB = HALF * BK * 2  , STAGE_BYTES = 8 * HTB, NXCD = 8, WGM = 8;

__host__ __device__ __forceinline__ int lds_byte(int r, int c) { const int st = (r >> 4) * 2 + (c >> 5), rr = r & 15, cc = c & 31, ob = rr * 64 + cc * 2; return st * 1024 + (ob ^ (((ob >> 9) & 1) << 5)); }
__host__ __device__ __forceinline__ void stage_rc(int b, int& R, int& C) { const int st = b / 1024, sb = b % 1024, swz = sb ^ (((sb >> 9) & 1) << 5); R = (st >> 1) * 16 + swz / 64; C = (st & 1) * 32 + (swz % 64) / 2; }
__host__ __device__ __forceinline__ int perm32(int rho) { const int n = rho >> 4, i = rho & 15; return 8 * (i >> 2) + 4 * n + (i & 3); }

struct Unit { int pm, pn; };
struct Gemm { const bf16_t* A; const bf16_t* Bt; int M, N, K; };

struct StaticOrder {
    int nM, nN, nwg, G, c;
    __host__ __device__ void init(int M, int N, int G_, int c_) { nM = M / BM; nN = N / BM; nwg = nM * nN; G = G_; c = c_; }
    __host__ __device__ bool next(int i, Unit& u) const {
        const long L = (long)i * G + c; if (L >= nwg) return false;
        int wgid = (int)L; { const int q = nwg / NXCD, r = nwg % NXCD, xcd = wgid % NXCD, off = wgid / NXCD; wgid = (xcd < r ? xcd * (q + 1) : r * (q + 1) + (xcd - r) * q) + off; }
        const int nig = WGM * nN, gid = wgid / nig, fm = gid * WGM, gsz = (nM - fm) < WGM ? (nM - fm) : WGM;
        u.pm = fm + ((wgid % nig) % gsz); u.pn = (wgid % nig) / gsz; return true;
    }
    __device__ __forceinline__ void a_ready(const Unit&) const {}
    __device__ __forceinline__ void done(const Unit&) const {}
};

__device__ __forceinline__ unsigned cvt_pk_bf16(float lo, float hi) { unsigned r; asm volatile("v_cvt_pk_bf16_f32 %0, %1, %2" : "=v"(r) : "v"(lo), "v"(hi)); return r; }
template <class Epi, class Sched, bool ALIGN_EPI = false, bool SP2 = false>
__device__ __forceinline__ void gemm_phase(PG8_LAS unsigned char* lds, const Gemm g, const Sched& S, const Epi& E) {
    const int tid = threadIdx.x, wid = __builtin_amdgcn_readfirstlane(tid >> 6), lane = tid & 63, wr = wid >> 2, wc = wid & 3, fr = lane & 15, fq = lane >> 4;
    const int K = g.K, nt = K / BK;
    unsigned voffA[2], voffB[2];
#pragma unroll
    for (int i = 0; i < 2; ++i) { int R, C; stage_rc(tid * 16 + i * 8192, R, C); const int Rb = Epi::PERM ? ((R & ~31) + perm32(R & 31)) : R;
        voffA[i] = (unsigned)(R * K + C) * 2u; voffB[i] = (unsigned)(Rb * K + C) * 2u; }
    const size_t kstep = (size_t)(BK * 2);
    const size_t hstep = (size_t)HALF * K * 2;
    const size_t tstep = 2 * hstep;
    const unsigned ldsw = (unsigned)wid * 1024u;
    const int aoff = lds_byte(wr * 64 + fr, fq * 8), boff = lds_byte(wc * 32 + fr, fq * 8);
#define PG8_SA(b, h) (((b) * 2 + (h)) * HTB)
#define PG8_SB(b, h) ((4 + (b) * 2 + (h)) * HTB)
#define PG8_STAGE(bufoff, gbase, voff) do { _Pragma("unroll") for (int _i = 0; _i < 2; ++_i) \
        __builtin_amdgcn_global_load_lds((const unsigned*)((const char*)(gbase) + (voff)[_i]), (PG8_LAS unsigned*)(lds + (bufoff) + ldsw + _i * 8192), 16, 0, 0); } while (0)
#define PG8_LDA(dst, b, h) do { _Pragma("unroll") for (int m = 0; m < 4; ++m) _Pragma("unroll") for (int k = 0; k < 2; ++k) dst[m][k] = *(const PG8_LAS bf16x8*)(lds + PG8_SA(b, h) + aoff + m * 2048 + k * 1024); } while (0)
#define PG8_LDB(dst, b, h) do { _Pragma("unroll") for (int n = 0; n < 2; ++n) _Pragma("unroll") for (int k = 0; k < 2; ++k) dst[n][k] = *(const PG8_LAS bf16x8*)(lds + PG8_SB(b, h) + boff + n * 2048 + k * 1024); } while (0)
#define PG8_MMA(ai, bj, At, Bt) do { __builtin_amdgcn_s_setprio(1); _Pragma("unroll") for (int m = 0; m < 4; ++m) _Pragma("unroll") for (int n = 0; n < 2; ++n) _Pragma("unroll") for (int k = 0; k < 2; ++k) \
        acc[ai][bj][m][n] = __builtin_amdgcn_mfma_f32_16x16x32_bf16(Bt[n][k], At[m][k], acc[ai][bj][m][n], 0, 0, 0); __builtin_amdgcn_s_setprio(0); } while (0)
#define PG8_WAIT_V(n) asm volatile("s_waitcnt vmcnt(" #n ")" ::: "memory")
#define PG8_WAIT_L(n) asm volatile("s_waitcnt lgkmcnt(" #n ")" ::: "memory")
#define PG8_BAR __builtin_amdgcn_s_barrier()
#define PG8_SCHED __builtin_amdgcn_sched_barrier(0)
    Unit cur, nxt; int ui = 0;
    if (!S.next(0, cur)) return;
    f32x4 acc[2][2][4][2];
#pragma unroll
    for (int a = 0; a < 2; ++a)
#pragma unroll
        for (int b = 0; b < 2; ++b)
#pragma unroll
            for (int m = 0; m < 4; ++m)
#pragma unroll
                for (int n = 0; n < 2; ++n) acc[a][b][m][n] = (f32x4){0.f, 0.f, 0.f, 0.f};
    bf16x8 At[4][2], B0[2][2], B1[2][2];
    const char* cA = (const char*)g.A + (size_t)cur.pm * tstep; const char* cB = (const char*)g.Bt + (size_t)cur.pn * tstep;
    S.a_ready(cur);
    if constexpr (SP2) {
        PG8_STAGE(PG8_SB(0, 0), cB, voffB); PG8_STAGE(PG8_SB(0, 1), cB + hstep, voffB); PG8_STAGE(PG8_SA(0, 0), cA, voffA); PG8_STAGE(PG8_SA(0, 1), cA + hstep, voffA);
        if (wr == 1) PG8_BAR;
        PG8_WAIT_V(2); PG8_BAR;
        PG8_STAGE(PG8_SB(1, 0), cB + kstep, voffB); PG8_STAGE(PG8_SA(1, 0), cA + kstep, voffA); PG8_STAGE(PG8_SB(1, 1), cB + hstep + kstep, voffB);
        PG8_WAIT_V(6); PG8_BAR;
    } else {
        PG8_STAGE(PG8_SB(0, 0), cB, voffB); PG8_STAGE(PG8_SA(0, 0), cA, voffA); PG8_STAGE(PG8_SB(0, 1), cB + hstep, voffB); PG8_STAGE(PG8_SA(0, 1), cA + hstep, voffA);
        if (wr == 1) PG8_BAR;
        PG8_WAIT_V(4); PG8_BAR;
        PG8_STAGE(PG8_SB(1, 0), cB + kstep, voffB); PG8_STAGE(PG8_SA(1, 0), cA + kstep, voffA); PG8_STAGE(PG8_SB(1, 1), cB + hstep + kstep, voffB);
        PG8_WAIT_V(6); PG8_BAR;
    }
    for (;;) {
        const bool has_next = S.next(ui + 1, nxt);
        const char* nA = has_next ? (const char*)g.A + (size_t)nxt.pm * tstep : cA; const char* nB = has_next ? (const char*)g.Bt + (size_t)nxt.pn * tstep : cB;
        for (int t = 0; t < nt; t += 2) {
            const bool last = (t == nt - 2);
            const char* a1 = cA + (size_t)(t + 1) * kstep;
            const char* a2 = last ? nA : cA + (size_t)(t + 2) * kstep; const char* b2 = last ? nB : cB + (size_t)(t + 2) * kstep;
            const char* a3 = a2 + kstep; const char* b3 = b2 + kstep;
            if (last && has_next) S.a_ready(nxt);
            if constexpr (SP2) {
            PG8_LDB(B0, 0, 0); PG8_LDB(B1, 0, 1); PG8_SCHED; PG8_LDA(At, 0, 0); PG8_STAGE(PG8_SA(1, 1), a1 + hstep, voffA);
            PG8_WAIT_V(8); PG8_WAIT_L(0); PG8_BAR; PG8_MMA(0, 0, At, B0); PG8_MMA(0, 1, At, B1); PG8_BAR; PG8_SCHED;
            PG8_LDA(At, 0, 1); PG8_STAGE(PG8_SB(0, 0), b2, voffB); PG8_STAGE(PG8_SB(0, 1), b2 + hstep, voffB); PG8_STAGE(PG8_SA(0, 0), a2, voffA);
            PG8_WAIT_V(8); PG8_WAIT_L(0); PG8_BAR; PG8_MMA(1, 0, At, B0); PG8_MMA(1, 1, At, B1); PG8_BAR; PG8_SCHED;
            PG8_LDB(B0, 1, 0); PG8_LDB(B1, 1, 1); PG8_SCHED; PG8_LDA(At, 1, 0); PG8_STAGE(PG8_SA(0, 1), a2 + hstep, voffA);
            PG8_WAIT_V(8); PG8_WAIT_L(0); PG8_BAR; PG8_MMA(0, 0, At, B0); PG8_MMA(0, 1, At, B1); PG8_BAR; PG8_SCHED;
            PG8_LDA(At, 1, 1); PG8_STAGE(PG8_SB(1, 0), b3, voffB); PG8_STAGE(PG8_SB(1, 1), b3 + hstep, voffB); PG8_STAGE(PG8_SA(1, 0), a3, voffA);
            PG8_WAIT_V(8); PG8_WAIT_L(0); PG8_BAR; PG8_MMA(1, 0, At, B0); PG8_MMA(1, 1, At, B1); PG8_BAR; PG8_SCHED;
            } else {
            PG8_LDB(B0, 0, 0); PG8_SCHED; PG8_LDA(At, 0, 0); PG8_STAGE(PG8_SA(1, 1), a1 + hstep, voffA);
            PG8_WAIT_L(8); PG8_BAR; PG8_WAIT_L(0); PG8_MMA(0, 0, At, B0); PG8_BAR; PG8_SCHED;
            PG8_LDB(B1, 0, 1); PG8_STAGE(PG8_SB(0, 0), b2, voffB);
            PG8_BAR; PG8_WAIT_L(0); PG8_MMA(0, 1, At, B1); PG8_BAR;
            PG8_LDA(At, 0, 1); PG8_STAGE(PG8_SA(0, 0), a2, voffA);
            PG8_BAR; PG8_WAIT_L(0); PG8_MMA(1, 0, At, B0); PG8_BAR; PG8_SCHED;
            PG8_STAGE(PG8_SB(0, 1), b2 + hstep, voffB);
            PG8_WAIT_V(6); PG8_BAR; PG8_MMA(1, 1, At, B1); PG8_BAR;
            PG8_LDB(B0, 1, 0); PG8_SCHED; PG8_LDA(At, 1, 0); PG8_STAGE(PG8_SA(0, 1), a2 + hstep, voffA);
            PG8_WAIT_L(8); PG8_BAR; PG8_WAIT_L(0); PG8_MMA(0, 0, At, B0); PG8_BAR; PG8_SCHED;
            PG8_LDB(B1, 1, 1); PG8_STAGE(PG8_SB(1, 0), b3, voffB);
            PG8_BAR; PG8_WAIT_L(0); PG8_MMA(0, 1, At, B1); PG8_BAR;
            PG8_LDA(At, 1, 1); PG8_STAGE(PG8_SA(1, 0), a3, voffA);
            PG8_BAR; PG8_WAIT_L(0); PG8_MMA(1, 0, At, B0); PG8_BAR; PG8_SCHED;
            PG8_STAGE(PG8_SB(1, 1), b3 + hstep, voffB);
            PG8_WAIT_V(6); PG8_BAR; PG8_MMA(1, 1, At, B1); PG8_BAR;
            }
        }
        if constexpr (ALIGN_EPI) { if (wr == 0) PG8_BAR; }
        if constexpr (!Epi::AFTER_DRAIN) { E(acc, cur, wr, wc, fr, fq); S.done(cur); }
        if (!has_next) break;
#pragma unroll
        for (int a = 0; a < 2; ++a)
#pragma unroll
            for (int b = 0; b < 2; ++b)
#pragma unroll
                for (int m = 0; m < 4; ++m)
#pragma unroll
                    for (int n = 0; n < 2; ++n) acc[a][b][m][n] = (f32x4){0.f, 0.f, 0.f, 0.f};
        cur = nxt; cA = nA; cB = nB; ++ui;
        if constexpr (ALIGN_EPI) { if (wr == 1) PG8_BAR; }
    }
    PG8_WAIT_V(0);
    if constexpr (!ALIGN_EPI) { if (wr == 0) PG8_BAR; }
    PG8_BAR;
    if constexpr (Epi::AFTER_DRAIN) { E.fused(acc, cur, wr, wc, fr, fq, lds, wid, lane); S.done(cur); }
#undef PG8_SA
#undef PG8_SB
#undef PG8_STAGE
#undef PG8_LDA
#undef PG8_LDB
#undef PG8_MMA
#undef PG8_WAIT_V
#undef PG8_WAIT_L
#undef PG8_BAR
#undef PG8_SCHED
}
}

#ifndef MK_MULTI
#define MK_MULTI 0
#endif
constexpr int D = 2048, TP = 8192, NB = 16, TS = 16, MS = NB * TS, M = TP + MS;
constexpr int RW = 1024, RH = 16, RN = 64, RC = 3328;
constexpr int ED = 1024, EH = 4, EN = 256, EC = 4096, IC = RC + EC;
constexpr int FF = 5632, NSEQ = 17, MODW = 6 * D;
constexpr int LCH = 128, NCH = TP / LCH;
constexpr int RBLK = 256, NRB = TP / RBLK;
constexpr int NPHASE = 14;
constexpr size_t O_Y = 0, O_SHP = (size_t)M * D, O_WKP = O_SHP + RC, O_RTP = O_WKP + 65536, O_SHS = O_RTP + 262144, O_WKS = O_SHS + (size_t)NB * RC, O_RTS = O_WKS + (size_t)NB * 65536, O_END = O_RTS + (size_t)NB * 262144;
constexpr size_t MiB = 1u << 20;
constexpr size_t WS_MOD = 1 * MiB, WS_LORAT = 2 * MiB, WS_WOUTT = 4 * MiB, WS_WINT = 12 * MiB, WS_V = 12 * MiB, WS_H = 41 * MiB, WS_G = 41 * MiB, WS_BON = 58 * MiB,
                 WS_QKVG = 74 * MiB, WS_LOUT = 140 * MiB, WS_PU = 140 * MiB, WS_KVB = 172 * MiB, WS_ACT = 74 * MiB, WS_PREP = 190 * MiB, WS_MIXOUT = 190 * MiB,
                 WS_WUPT = 256 * MiB, WS_WDNT = 300 * MiB, WS_END = 355 * MiB;
constexpr size_t PREP_STRIDE = 33 * MiB;
constexpr size_t DO_Z = 0, DO_LIN = 54 * MiB, DO_SPREV = 0, DO_MIX = 17 * MiB;
constexpr int LDS_BYTES = 147456;

typedef unsigned short bf16;
typedef float f32x2 __attribute__((ext_vector_type(2)));
typedef float f32x4 __attribute__((ext_vector_type(4)));
typedef short bf16x8 __attribute__((ext_vector_type(8)));
typedef unsigned u32x4 __attribute__((ext_vector_type(4)));
typedef unsigned u32x2 __attribute__((ext_vector_type(2)));
#define LDS_WAIT() asm volatile("s_waitcnt lgkmcnt(0)" ::: "memory")

__device__ __forceinline__ float bf2f(unsigned v) { return __builtin_bit_cast(float, v << 16); }
__device__ __forceinline__ unsigned f2bf(float f) { unsigned u = __builtin_bit_cast(unsigned, f); return (u + 0x7fffu + ((u >> 16) & 1u)) >> 16; }
__device__ __forceinline__ unsigned pk2(float lo, float hi) { return f2bf(lo) | (f2bf(hi) << 16); }
__device__ __forceinline__ float wave_sum(float v) {
#pragma unroll
    for (int o = 1; o < 64; o <<= 1) v += __shfl_xor(v, o);
    return v;
}
__device__ __forceinline__ float sigm(float x) { return 1.f / (1.f + __expf(-x)); }
__device__ __forceinline__ int seq_of(int m) { return m < TP ? 0 : 1 + ((m - TP) >> 4); }
__device__ __forceinline__ int tpos_of(int m) { return m < TP ? m : ((m - TP) & 15); }
__device__ __forceinline__ float ret_l2g(int h) { return __log2f(1.0f - exp2f(-5.0f - (float)h)); }

struct EpiProj {
    static constexpr bool PERM = true, AFTER_DRAIN = false;
    bf16* Z; bf16* Q;
    __device__ __forceinline__ void operator()(const f32x4 (&acc)[2][2][4][2], const pg8::Unit& u, int wr, int wc, int fr, int fq) const {
        const int row0 = u.pm * 256 + wr * 64 + fr, pn = u.pn, cl = wc * 32 + 8 * fq;
        if (pn < 13 || pn >= 21) {
            bf16* base = pn < 13 ? Z + pn * 256 + cl : Q + (pn - 13) * 256 + cl; const size_t ld = pn < 13 ? RC : EC;
#pragma unroll
            for (int ai = 0; ai < 2; ++ai)
#pragma unroll
                for (int m = 0; m < 4; ++m) { bf16* rp = base + (size_t)(row0 + ai * 128 + m * 16) * ld;
#pragma unroll
                    for (int bj = 0; bj < 2; ++bj) { const f32x4 v0 = acc[ai][bj][m][0], v1 = acc[ai][bj][m][1]; u32x4 w; w.x = pk2(v0[0], v0[1]); w.y = pk2(v0[2], v0[3]); w.z = pk2(v1[0], v1[1]); w.w = pk2(v1[2], v1[3]);
                        *(u32x4*)(rp + bj * 128) = w; } }
        } else {
            const int sec = pn - 13; bf16* base = Q + sec * 256 + cl; const float sc = sec >= 4 ? 0.0625f : 1.0f;
            float inv[8];
#pragma unroll
            for (int e = 0; e < 8; ++e) inv[e] = exp2f(-(float)(cl + e) * (13.287712379549449f / 128.0f)) * 0.15915494309189535f;
#pragma unroll
            for (int ai = 0; ai < 2; ++ai)
#pragma unroll
                for (int m = 0; m < 4; ++m) { const int row = row0 + ai * 128 + m * 16; bf16* rp = base + (size_t)row * EC;
                    const float pos = row < TP ? (float)row : (float)(2048 + ((row - TP) & 15));
                    float o1[8], o2[8];
#pragma unroll
                    for (int e = 0; e < 8; ++e) { float rev = pos * inv[e]; rev -= floorf(rev); const float sn = __builtin_amdgcn_sinf(rev), cs = __builtin_amdgcn_cosf(rev);
                        const float x1 = acc[ai][0][m][e >> 2][e & 3], x2 = acc[ai][1][m][e >> 2][e & 3];
                        o1[e] = (x1 * cs - x2 * sn) * sc; o2[e] = (x2 * cs + x1 * sn) * sc; }
                    u32x4 w; w.x = pk2(o1[0], o1[1]); w.y = pk2(o1[2], o1[3]); w.z = pk2(o1[4], o1[5]); w.w = pk2(o1[6], o1[7]); *(u32x4*)rp = w;
                    w.x = pk2(o2[0], o2[1]); w.y = pk2(o2[2], o2[3]); w.z = pk2(o2[4], o2[5]); w.w = pk2(o2[6], o2[7]); *(u32x4*)(rp + 128) = w; }
        }
    }
};
struct EpiBf16P {
    static constexpr bool PERM = true, AFTER_DRAIN = false;
    bf16* C; int ldc;
    __device__ __forceinline__ void operator()(const f32x4 (&acc)[2][2][4][2], const pg8::Unit& u, int wr, int wc, int fr, int fq) const {
        const int row0 = u.pm * 256 + wr * 64 + fr; bf16* base = C + u.pn * 256 + wc * 32 + 8 * fq;
#pragma unroll
        for (int ai = 0; ai < 2; ++ai)
#pragma unroll
            for (int m = 0; m < 4; ++m) { bf16* rp = base + (size_t)(row0 + ai * 128 + m * 16) * ldc;
#pragma unroll
                for (int bj = 0; bj < 2; ++bj) { const f32x4 v0 = acc[ai][bj][m][0], v1 = acc[ai][bj][m][1]; u32x4 w; w.x = pk2(v0[0], v0[1]); w.y = pk2(v0[2], v0[3]); w.z = pk2(v1[0], v1[1]); w.w = pk2(v1[2], v1[3]);
                    *(u32x4*)(rp + bj * 128) = w; } }
    }
};
struct EpiF32 {
    static constexpr bool PERM = true, AFTER_DRAIN = false;
    float* C; int ldc;
    __device__ __forceinline__ void operator()(const f32x4 (&acc)[2][2][4][2], const pg8::Unit& u, int wr, int wc, int fr, int fq) const {
        const int row0 = u.pm * 256 + wr * 64 + fr; float* base = C + u.pn * 256 + wc * 32 + 8 * fq;
#pragma unroll
        for (int ai = 0; ai < 2; ++ai)
#pragma unroll
            for (int m = 0; m < 4; ++m) { float* rp = base + (size_t)(row0 + ai * 128 + m * 16) * ldc;
#pragma unroll
                for (int bj = 0; bj < 2; ++bj) { *(f32x4*)(rp + bj * 128) = acc[ai][bj][m][0]; *(f32x4*)(rp + bj * 128 + 4) = acc[ai][bj][m][1]; } }
    }
};
struct EpiSwiglu {
    static constexpr bool PERM = true, AFTER_DRAIN = false;
    bf16* C;
    __device__ __forceinline__ void operator()(const f32x4 (&acc)[2][2][4][2], const pg8::Unit& u, int wr, int wc, int fr, int fq) const {
        const int row0 = u.pm * 256 + wr * 64 + fr; bf16* base = C + u.pn * 128 + wc * 32 + 8 * fq;
#pragma unroll
        for (int ai = 0; ai < 2; ++ai)
#pragma unroll
            for (int m = 0; m < 4; ++m) { float o[8];
#pragma unroll
                for (int e = 0; e < 8; ++e) { const float g = acc[ai][0][m][e >> 2][e & 3], up = acc[ai][1][m][e >> 2][e & 3]; o[e] = g * sigm(g) * up; }
                u32x4 w; w.x = pk2(o[0], o[1]); w.y = pk2(o[2], o[3]); w.z = pk2(o[4], o[5]); w.w = pk2(o[6], o[7]);
                *(u32x4*)(base + (size_t)(row0 + ai * 128 + m * 16) * FF) = w; }
    }
};

__device__ __forceinline__ void transpose_item(const float* __restrict__ W, int K, int N, bf16* WT, int k0, int n0, int dst_row0, float* scr, int lane) {
#pragma unroll 8
    for (int i = 0; i < 32; ++i) { const int kk = 2 * i + (lane >> 5); scr[kk * 33 + (lane & 31)] = W[(size_t)(k0 + kk) * N + n0 + (lane & 31)]; }
    LDS_WAIT();
    const int c = lane & 7;
#pragma unroll
    for (int j = 0; j < 4; ++j) { const int n = (lane >> 3) + 8 * j; const float* s = scr + (8 * c) * 33 + n;
        u32x4 o; o.x = pk2(s[0 * 33], s[1 * 33]); o.y = pk2(s[2 * 33], s[3 * 33]); o.z = pk2(s[4 * 33], s[5 * 33]); o.w = pk2(s[6 * 33], s[7 * 33]);
        *(u32x4*)(WT + (size_t)(dst_row0 + n) * K + k0 + 8 * c) = o; }
    LDS_WAIT();
}

typedef const __attribute__((address_space(4))) f32x2* cf2p;
__device__ __forceinline__ cf2p to_c(const float* p) { return (cf2p)(unsigned long long)p; }
#define DPPF(old, src, ctrl, rmask) __builtin_bit_cast(float, __builtin_amdgcn_update_dpp(__builtin_bit_cast(int, (float)(old)), __builtin_bit_cast(int, (float)(src)), (ctrl), (rmask), 0xF, false))
__device__ __forceinline__ float wave_sum_u(float v) {
    v += DPPF(0.f, v, 0xB1, 0xF); v += DPPF(0.f, v, 0x4E, 0xF); v += DPPF(0.f, v, 0x124, 0xF); v += DPPF(0.f, v, 0x128, 0xF);
    v += DPPF(0.f, v, 0x142, 0xA); v += DPPF(0.f, v, 0x143, 0xC);
    return __builtin_bit_cast(float, __builtin_amdgcn_readlane(__builtin_bit_cast(int, v), 63));
}
constexpr int RW_PF = 6;
template <int MODE>
__device__ __forceinline__ void rwkv_run(f32x2 (&S)[32], const float* W, const float* NKK, const float* B, const float* K, const float* R, const bf16* Vp, int nsteps, int lane,
                                         const bf16* Gp, const float* BONp, bf16* MIXp, float lnw, float lnb) {
    constexpr int NPF = MODE == 2 ? 20 : (MODE == 0 ? 16 : 12);
    const int pa = lane >> 2; const float* pfp = (pa == 0 ? W : pa == 1 ? NKK : pa == 2 ? B : pa == 3 ? K : R) + (lane & 3) * 16;
    float vn = 0.f, gn = 0.f, bn = 0.f;
    if (MODE != 1) vn = bf2f(Vp[lane]);
    if (MODE == 2) { gn = bf2f(Gp[lane]); bn = BONp[0]; }
    if (lane < NPF) {
#pragma unroll
        for (int q = 1; q < RW_PF; ++q) if (q < nsteps) (void)*(volatile const float*)(pfp + (size_t)q * RW);
    }
    for (int t = 0; t < nsteps; ++t) {
        const size_t o = (size_t)t * RW;
        cf2p w = to_c(W + o), nk = to_c(NKK + o), b = to_c(B + o), k = to_c(K + o), r = to_c(R + o);
        const float v = vn, gv = gn, bon = bn;
        { const int t1 = t + 1 < nsteps ? t + 1 : t; const size_t o1 = (size_t)t1 * RW;
          if (MODE != 1) vn = bf2f(Vp[o1 + lane]);
          if (MODE == 2) { gn = bf2f(Gp[o1 + lane]); bn = BONp[(size_t)t1 * 16]; }
          const int tp = t + RW_PF < nsteps ? t + RW_PF : nsteps - 1;
          if (lane < NPF) (void)*(volatile const float*)(pfp + (size_t)tp * RW); }
        f32x2 a0 = {0.f, 0.f}, a1 = {0.f, 0.f};
#pragma unroll
        for (int j = 0; j < 32; j += 2) { a0 = __builtin_elementwise_fma(S[j], nk[j], a0); a1 = __builtin_elementwise_fma(S[j + 1], nk[j + 1], a1); }
        const float sa = (a0.x + a0.y) + (a1.x + a1.y);
        const f32x2 sa2 = {sa, sa}, v2 = {v, v};
        f32x2 o0 = {0.f, 0.f}, o1 = {0.f, 0.f};
#pragma unroll
        for (int j = 0; j < 32; ++j) {
            f32x2 s = S[j] * w[j];
            s = __builtin_elementwise_fma(sa2, b[j], s);
            if (MODE != 1) s = __builtin_elementwise_fma(v2, k[j], s);
            S[j] = s;
            if (MODE == 2) { if (j & 1) o1 = __builtin_elementwise_fma(s, r[j], o1); else o0 = __builtin_elementwise_fma(s, r[j], o0); }
        }
        if (MODE == 2) {
            const float ov = (o0.x + o0.y) + (o1.x + o1.y);
            const float mean = wave_sum_u(ov) * (1.f / 64.f), d = ov - mean, var = wave_sum_u(d * d) * (1.f / 64.f);
            float y = d * rsqrtf(var + 64e-5f) * lnw + lnb;
            y = (y + bon * v) * gv;
            MIXp[(size_t)t * D + lane] = (bf16)f2bf(y);
        }
    }
}

constexpr int RL_B = 8;
template <int MODE> struct RL { static constexpr int NV = MODE == 2 ? 5 : (MODE == 0 ? 4 : 3); static constexpr int REC = NV * 64, BUF = RL_B * REC + (MODE != 1 ? 256 : 0) + (MODE == 2 ? 256 + 16 : 0); };
#define SBAR() __builtin_amdgcn_sched_barrier(0)
template <int MODE>
__device__ __forceinline__ void rwkv_lds(f32x2 (&S)[32], const float* W, const float* NKK, const float* B, const float* K, const float* R, const bf16* Vp, int nsteps, int lane,
                                         const bf16* Gp, const float* BONp, bf16* MIXp, float lnw, float lnb, float* wl) {
    constexpr int NV = RL<MODE>::NV, REC = RL<MODE>::REC;
    const int ls = lane >> 4, lc = (lane & 15) * 4;
    f32x4 st[NV][2]; u32x4 sv = {0u, 0u, 0u, 0u}, sg = {0u, 0u, 0u, 0u}; float sb = 0.f;
#define RL_ISSUE(bt) do { const size_t ob = (size_t)((bt) * RL_B) * RW; \
        _Pragma("unroll") for (int q = 0; q < 2; ++q) { const size_t oo = ob + (size_t)(ls + 4 * q) * RW + lc; \
            st[0][q] = *(const f32x4*)(W + oo); st[1][q] = *(const f32x4*)(NKK + oo); st[2][q] = *(const f32x4*)(B + oo); if (NV >= 4) st[NV >= 4 ? 3 : 0][q] = *(const f32x4*)(K + oo); if (NV == 5) st[NV - 1][q] = *(const f32x4*)(R + oo); } \
        if (MODE != 1) sv = *(const u32x4*)(Vp + ob + (size_t)(lane >> 3) * RW + (lane & 7) * 8); \
        if (MODE == 2) { sg = *(const u32x4*)(Gp + ob + (size_t)(lane >> 3) * RW + (lane & 7) * 8); if (lane < RL_B) sb = BONp[(size_t)((bt) * RL_B + lane) * 16]; } } while (0)
#define RL_COMMIT() do { \
        _Pragma("unroll") for (int q = 0; q < 2; ++q) _Pragma("unroll") for (int v = 0; v < NV; ++v) *(f32x4*)(wl + (ls + 4 * q) * REC + v * 64 + lc) = st[v][q]; \
        if (MODE != 1) *(u32x4*)((bf16*)(wl + RL_B * REC) + (lane >> 3) * 64 + (lane & 7) * 8) = sv; \
        if (MODE == 2) { *(u32x4*)((bf16*)(wl + RL_B * REC + 256) + (lane >> 3) * 64 + (lane & 7) * 8) = sg; if (lane < RL_B) wl[RL_B * REC + 512 + lane] = sb; } } while (0)
    const int nb = nsteps / RL_B;
    RL_ISSUE(0); RL_COMMIT();
    for (int bt = 0; bt < nb; ++bt) {
        if (bt + 1 < nb) RL_ISSUE(bt + 1);
#pragma unroll 1
        for (int s = 0; s < RL_B; ++s) {
            const f32x2* w = (const f32x2*)(wl + s * REC); const f32x2* nk = w + 32; const f32x2* b = w + 64; const f32x2* k = w + 96; const f32x2* r = w + 128;
            float v = 0.f, gv = 0.f, bon = 0.f;
            if (MODE != 1) v = bf2f(((const bf16*)(wl + RL_B * REC))[s * 64 + lane]);
            if (MODE == 2) { gv = bf2f(((const bf16*)(wl + RL_B * REC + 256))[s * 64 + lane]); bon = wl[RL_B * REC + 512 + s]; }
            f32x2 nA[8], nB[8]; f32x2 a0 = {0.f, 0.f}, a1 = {0.f, 0.f};
#pragma unroll
            for (int p = 0; p < 8; ++p) nA[p] = nk[p];
#pragma unroll
            for (int g = 0; g < 4; ++g) {
                if (g < 3) {
#pragma unroll
                    for (int p = 0; p < 8; ++p) { if (g & 1) nA[p] = nk[8 * (g + 1) + p]; else nB[p] = nk[8 * (g + 1) + p]; } }
                SBAR();
#pragma unroll
                for (int p = 0; p < 8; p += 2) { a0 = __builtin_elementwise_fma(S[8 * g + p], (g & 1) ? nB[p] : nA[p], a0); a1 = __builtin_elementwise_fma(S[8 * g + p + 1], (g & 1) ? nB[p + 1] : nA[p + 1], a1); }
                SBAR();
            }
            const float sa = (a0.x + a0.y) + (a1.x + a1.y);
            const f32x2 sa2 = {sa, sa}, v2 = {v, v};
            f32x2 uw[2][4], ub[2][4], uk[2][4], ur[2][4]; f32x2 o0 = {0.f, 0.f}, o1 = {0.f, 0.f};
#pragma unroll
            for (int p = 0; p < 4; ++p) { uw[0][p] = w[p]; ub[0][p] = b[p]; if (MODE != 1) uk[0][p] = k[p]; if (MODE == 2) ur[0][p] = r[p]; }
#pragma unroll
            for (int g = 0; g < 8; ++g) {
                if (g < 7) {
#pragma unroll
                    for (int p = 0; p < 4; ++p) { uw[(g + 1) & 1][p] = w[4 * (g + 1) + p]; ub[(g + 1) & 1][p] = b[4 * (g + 1) + p]; if (MODE != 1) uk[(g + 1) & 1][p] = k[4 * (g + 1) + p]; if (MODE == 2) ur[(g + 1) & 1][p] = r[4 * (g + 1) + p]; } }
                SBAR();
#pragma unroll
                for (int p = 0; p < 4; ++p) { const int j = 4 * g + p;
                    f32x2 x = S[j] * uw[g & 1][p]; x = __builtin_elementwise_fma(sa2, ub[g & 1][p], x); if (MODE != 1) x = __builtin_elementwise_fma(v2, uk[g & 1][p], x); S[j] = x;
                    if (MODE == 2) { if (p & 1) o1 = __builtin_elementwise_fma(x, ur[g & 1][p], o1); else o0 = __builtin_elementwise_fma(x, ur[g & 1][p], o0); } }
                SBAR();
            }
            if (MODE == 2) {
                const float ov = (o0.x + o0.y) + (o1.x + o1.y);
                const float mean = wave_sum_u(ov) * (1.f / 64.f), d = ov - mean, var = wave_sum_u(d * d) * (1.f / 64.f);
                float y = d * rsqrtf(var + 64e-5f) * lnw + lnb;
                y = (y + bon * v) * gv;
                MIXp[(size_t)(bt * RL_B + s) * D + lane] = (bf16)f2bf(y);
            }
        }
        if (bt + 1 < nb) RL_COMMIT();
    }
#undef RL_ISSUE
#undef RL_COMMIT
}

struct Args { const float* in[30]; float* out; unsigned char* ws; int ph_lo, ph_hi; };
enum { I_XP = 0, I_XS, I_CP, I_CS, I_SSH, I_SWKV, I_SRET, I_ADAW, I_ADAB, I_GPM, I_GPOM, I_GPF, I_GPOF, I_WIN, I_MU, I_W0, I_W2, I_A0, I_A2, I_G2, I_KK, I_KA, I_RK, I_RLW, I_RLB, I_ELW, I_ELB, I_WOUT, I_WUP, I_WDN };

__global__ void __launch_bounds__(512, 2) mk_fwd(Args a) {
    extern __shared__ __attribute__((aligned(16))) unsigned char lds[];
    cg::grid_group grid = cg::this_grid();
    const int tid = threadIdx.x, lane = tid & 63, wave = __builtin_amdgcn_readfirstlane(tid >> 6);
    const int G = gridDim.x, bid = blockIdx.x, gw = bid * 8 + wave, NGW = G * 8;
    const int lo = a.ph_lo, hi = a.ph_hi;
    unsigned char* ws = a.ws; float* out = a.out; unsigned char* dob = (unsigned char*)a.out;
    float* MOD = (float*)(ws + WS_MOD);
    bf16* LORAT = (bf16*)(ws + WS_LORAT); bf16* WOUTT = (bf16*)(ws + WS_WOUTT); bf16* WINT = (bf16*)(ws + WS_WINT); bf16* WUPT = (bf16*)(ws + WS_WUPT); bf16* WDNT = (bf16*)(ws + WS_WDNT);
    bf16* H = (bf16*)(ws + WS_H); bf16* QKVG = (bf16*)(ws + WS_QKVG); bf16* LOUT = (bf16*)(ws + WS_LOUT); bf16* Z = (bf16*)(dob + DO_Z); bf16* LIN = (bf16*)(dob + DO_LIN);
    float* PW = (float*)(ws + WS_PREP); float* PNKK = (float*)(ws + WS_PREP + PREP_STRIDE); float* PB = (float*)(ws + WS_PREP + 2 * PREP_STRIDE); float* PK = (float*)(ws + WS_PREP + 3 * PREP_STRIDE); float* PR = (float*)(ws + WS_PREP + 4 * PREP_STRIDE);
    bf16* PV = (bf16*)(ws + WS_V); bf16* PG = (bf16*)(ws + WS_G); float* BON = (float*)(ws + WS_BON);
    float* PU = (float*)(ws + WS_PU); bf16* KVB = (bf16*)(ws + WS_KVB); bf16* SPREV = (bf16*)(dob + DO_SPREV); bf16* MIX = (bf16*)(dob + DO_MIX);
    float* MIXOUT = (float*)(ws + WS_MIXOUT); bf16* ACT = (bf16*)(ws + WS_ACT);
#ifndef DUP_PHASE
#define DUP_PHASE -1
#endif
#ifndef PH_MASK
#define PH_MASK 0x3fff
#endif
#define IN(k) (((PH_MASK >> (k)) & 1) && lo <= (k) && (k) < hi)
#ifndef TS_PROBE
#define TS_PROBE -1
#endif
    unsigned long long* TSW = (unsigned long long*)ws;
    if (TS_PROBE >= 0 && bid == 0 && tid == 0) TSW[0] = __builtin_amdgcn_s_memrealtime();
#define SEAM(k) do { if (IN(k) && IN((k) + 1)) grid.sync(); if (TS_PROBE >= 0 && bid == 0 && tid == 0) TSW[1 + (k)] = __builtin_amdgcn_s_memrealtime(); } while (0)

    if (IN(0)) for (int rep = 0; rep < (DUP_PHASE == 0 ? 2 : 1); ++rep) {
        float* scr = (float*)lds + wave * (64 * 33 + 16);
        constexpr int IT_WIN = (D / 64) * (IC / 32), IT_WOUT = (D / 64) * (D / 32);
        for (int it = gw; it < IT_WIN + IT_WOUT; it += NGW) {
            if (it < IT_WIN) { const int nb = IC / 32, kb = it / nb, n0 = 32 * (it % nb); transpose_item(a.in[I_WIN], D, IC, WINT, 64 * kb, n0, n0, scr, lane); }
            else { const int r = it - IT_WIN, nb = D / 32, kb = r / nb, n0 = 32 * (r % nb); transpose_item(a.in[I_WOUT], D, D, WOUTT, 64 * kb, n0, n0, scr, lane); }
        }
        for (int idx = bid * 512 + tid; idx < 3072 * 256; idx += G * 512) {
            const int n = idx >> 8, k = idx & 255, sec = n >> 10, nn = n & 1023; float v = 0.f;
            if (sec == 0 && k < 64) v = a.in[I_W2][k * RW + nn];
            else if (sec == 1 && k >= 64 && k < 128) v = a.in[I_A2][(k - 64) * RW + nn];
            else if (sec == 2 && k >= 128) v = a.in[I_G2][(k - 128) * RW + nn];
            LORAT[idx] = (bf16)f2bf(v);
        }
        __syncthreads();
        float* sc = (float*)lds;
        float* accL = (float*)lds + 128 * 20;
        for (int it = bid; it < 48 * 16; it += G) {
            const int cs = it % 48, ks = it / 48, col0 = cs * 256, k0 = ks * 128;
            for (int idx = tid; idx < NSEQ * 128; idx += 512) { const int r = idx >> 7, kk = idx & 127; const float cv = r == 0 ? a.in[I_CP][k0 + kk] : a.in[I_CS][(r - 1) * D + k0 + kk]; sc[kk * 20 + r] = cv * sigm(cv); }
            for (int idx = tid; idx < NSEQ * 256; idx += 512) accL[idx] = 0.f;
            __syncthreads();
            f32x4 acc[NSEQ];
#pragma unroll
            for (int r = 0; r < NSEQ; ++r) acc[r] = (f32x4){0.f, 0.f, 0.f, 0.f};
            const float* wp = a.in[I_ADAW] + (size_t)(k0 + wave * 16) * MODW + col0 + 4 * lane;
#pragma unroll 4
            for (int kk = 0; kk < 16; ++kk) { const f32x4 w4 = *(const f32x4*)(wp + (size_t)kk * MODW); const float* sr = sc + (wave * 16 + kk) * 20;
#pragma unroll
                for (int r = 0; r < NSEQ; ++r) acc[r] += w4 * sr[r]; }
#pragma unroll
            for (int r = 0; r < NSEQ; ++r) {
#pragma unroll
                for (int q = 0; q < 4; ++q) atomicAdd(&accL[r * 256 + 4 * lane + q], acc[r][q]); }
            __syncthreads();
            for (int idx = tid; idx < NSEQ * 256; idx += 512) { const int r = idx >> 8, cc = idx & 255; float v = accL[idx]; if (ks == 0) v += a.in[I_ADAB][col0 + cc]; atomicAdd(&MOD[r * MODW + col0 + cc], v); }
            __syncthreads();
        }
    }
    SEAM(0);
    if (IN(1)) for (int rep = 0; rep < (DUP_PHASE == 1 ? 2 : 1); ++rep) {
        for (int m = gw; m < M; m += NGW) {
            const float* xr = m < TP ? a.in[I_XP] + (size_t)m * D : a.in[I_XS] + (size_t)(m - TP) * D; const float* mod = MOD + seq_of(m) * MODW;
            f32x4 v[8]; float ss = 0.f;
#pragma unroll
            for (int j = 0; j < 8; ++j) { v[j] = *(const f32x4*)(xr + 4 * lane + 256 * j); ss += (v[j].x * v[j].x + v[j].y * v[j].y) + (v[j].z * v[j].z + v[j].w * v[j].w); }
            const float rs = rsqrtf(wave_sum(ss) * (1.f / D) + 1e-6f);
#pragma unroll
            for (int j = 0; j < 8; ++j) { const int c = 4 * lane + 256 * j; const f32x4 g = *(const f32x4*)(a.in[I_GPM] + c), s1 = *(const f32x4*)(mod + D + c), h1 = *(const f32x4*)(mod + c);
                const f32x4 h = v[j] * rs * g * (s1 + 1.f) + h1; u32x2 w; w.x = pk2(h.x, h.y); w.y = pk2(h.z, h.w); *(u32x2*)(H + (size_t)m * D + c) = w; }
        }
    }
    SEAM(1);
    if (IN(2)) for (int rep = 0; rep < (DUP_PHASE == 2 ? 2 : 1); ++rep) {
        pg8::Gemm g{H, WINT, M, IC, D}; pg8::StaticOrder S; S.init(M, IC, G, bid); EpiProj E{Z, QKVG};
        pg8::gemm_phase<EpiProj, pg8::StaticOrder, true, true>((PG8_LAS unsigned char*)lds, g, S, E);
    }
    SEAM(2);
    if (IN(3)) for (int rep = 0; rep < (DUP_PHASE == 3 ? 2 : 1); ++rep) {
        for (int idx = bid * 512 + tid; idx < M * 128; idx += G * 512) {
            const int m = idx >> 7, c2 = (idx & 127) * 2, c = 3072 + c2, tp = tpos_of(m), sq = seq_of(m);
            const unsigned zz = *(const unsigned*)(Z + (size_t)m * RC + c); float z0 = bf2f(zz & 0xffffu), z1 = bf2f(zz >> 16), p0 = 0.f, p1 = 0.f;
            if (tp > 0) { const unsigned pp = *(const unsigned*)(Z + (size_t)(m - 1) * RC + c); p0 = bf2f(pp & 0xffffu); p1 = bf2f(pp >> 16); }
            else if (sq > 0) { p0 = a.in[I_SSH][(size_t)(sq - 1) * RC + c]; p1 = a.in[I_SSH][(size_t)(sq - 1) * RC + c + 1]; }
            z0 = z0 + (p0 - z0) * a.in[I_MU][c]; z1 = z1 + (p1 - z1) * a.in[I_MU][c + 1];
            if (c2 < 64) { z0 = 1.f - 2.f / (__expf(2.f * z0) + 1.f); z1 = 1.f - 2.f / (__expf(2.f * z1) + 1.f); }
            else if (c2 >= 128) { z0 = sigm(z0); z1 = sigm(z1); }
            *(unsigned*)(LIN + (size_t)m * 256 + c2) = pk2(z0, z1);
        }
        for (int idx = bid * 512 + tid; idx < NSEQ * RC; idx += G * 512) { const int s = idx / RC, c = idx % RC; const int m = s == 0 ? TP - 1 : TP + 16 * (s - 1) + 15;
            out[(s == 0 ? O_SHP : O_SHS + (size_t)(s - 1) * RC) + c] = bf2f(Z[(size_t)m * RC + c]); }
    }
    SEAM(3);
    if (IN(4)) for (int rep = 0; rep < (DUP_PHASE == 4 ? 2 : 1); ++rep) {
        int k256 = 256; asm volatile("" : "+s"(k256));
        pg8::Gemm g{LIN, LORAT, M, 3072, k256}; pg8::StaticOrder S; S.init(M, 3072, G, bid); EpiBf16P E{LOUT, 3072};
        pg8::gemm_phase<EpiBf16P, pg8::StaticOrder, true, true>((PG8_LAS unsigned char*)lds, g, S, E);
    }
    SEAM(4);
    if (IN(5)) for (int rep = 0; rep < (DUP_PHASE == 5 ? 2 : 1); ++rep) {
        float* prm = (float*)lds;
        __syncthreads();
        for (int idx = tid; idx < RW; idx += 512) { prm[idx] = a.in[I_MU][idx]; prm[RW + idx] = a.in[I_MU][RW + idx]; prm[2 * RW + idx] = a.in[I_MU][2 * RW + idx]; prm[3 * RW + idx] = a.in[I_W0][idx];
            prm[4 * RW + idx] = a.in[I_A0][idx]; prm[5 * RW + idx] = a.in[I_KK][idx]; prm[6 * RW + idx] = a.in[I_KA][idx]; prm[7 * RW + idx] = a.in[I_RK][idx]; }
        __syncthreads();
        for (int m = gw; m < M; m += NGW) {
            const int tp = tpos_of(m), sq = seq_of(m);
#pragma unroll 1
            for (int hp = 0; hp < 2; ++hp) {
                const int hd = hp * 8 + (lane >> 3), c0 = hd * 64 + (lane & 7) * 8;
                const bf16* zr = Z + (size_t)m * RC + c0; const bf16* lr = LOUT + (size_t)m * 3072 + c0; const float* sh0 = a.in[I_SSH] + (size_t)(sq > 0 ? sq - 1 : 0) * RC + c0;
                float zs[3][8];
#pragma unroll
                for (int q = 0; q < 3; ++q) {
                    const u32x4 ca = *(const u32x4*)(zr + q * RW); float pv[8];
                    if (tp > 0) { const u32x4 pa2 = *(const u32x4*)(zr - RC + q * RW);
#pragma unroll
                        for (int e = 0; e < 4; ++e) { pv[2 * e] = bf2f(pa2[e] & 0xffffu); pv[2 * e + 1] = bf2f(pa2[e] >> 16); } }
                    else if (sq > 0) { const f32x4 f0 = *(const f32x4*)(sh0 + q * RW), f1 = *(const f32x4*)(sh0 + q * RW + 4);
                        pv[0] = f0.x; pv[1] = f0.y; pv[2] = f0.z; pv[3] = f0.w; pv[4] = f1.x; pv[5] = f1.y; pv[6] = f1.z; pv[7] = f1.w; }
                    else {
#pragma unroll
                        for (int e = 0; e < 8; ++e) pv[e] = 0.f; }
                    const float* mu = prm + q * RW + c0;
#pragma unroll
                    for (int e = 0; e < 4; ++e) { const float z0 = bf2f(ca[e] & 0xffffu), z1 = bf2f(ca[e] >> 16);
                        zs[q][2 * e] = z0 + (pv[2 * e] - z0) * mu[2 * e]; zs[q][2 * e + 1] = z1 + (pv[2 * e + 1] - z1) * mu[2 * e + 1]; }
                }
                const u32x4 wa = *(const u32x4*)(lr), aa = *(const u32x4*)(lr + RW), ga = *(const u32x4*)(lr + 2 * RW);
                float wv[8], av[8], kkv[8], k2[8]; float s1 = 0.f, s2 = 0.f;
#pragma unroll
                for (int e = 0; e < 8; ++e) {
                    const float lwv = bf2f((e & 1) ? (wa[e >> 1] >> 16) : (wa[e >> 1] & 0xffffu)), lav = bf2f((e & 1) ? (aa[e >> 1] >> 16) : (aa[e >> 1] & 0xffffu));
                    wv[e] = __expf(-0.6065306597126334f * sigm(prm[3 * RW + c0 + e] + lwv));
                    av[e] = sigm(prm[4 * RW + c0 + e] + lav);
                    kkv[e] = zs[1][e] * prm[5 * RW + c0 + e]; s1 += kkv[e] * kkv[e];
                    k2[e] = zs[1][e] * (1.f + (av[e] - 1.f) * prm[6 * RW + c0 + e]); s2 += zs[0][e] * k2[e] * prm[7 * RW + c0 + e];
                }
                s1 += DPPF(0.f, s1, 0xB1, 0xF); s1 += DPPF(0.f, s1, 0x4E, 0xF); s1 += DPPF(0.f, s1, 0x141, 0xF);
                s2 += DPPF(0.f, s2, 0xB1, 0xF); s2 += DPPF(0.f, s2, 0x4E, 0xF); s2 += DPPF(0.f, s2, 0x141, 0xF);
                const float inrm = 1.f / fmaxf(sqrtf(s1), 1e-12f);
                const size_t o = (size_t)m * RW + c0;
#pragma unroll
                for (int e = 0; e < 2; ++e) {
                    const float k0 = kkv[4 * e] * inrm, k1 = kkv[4 * e + 1] * inrm, k2_ = kkv[4 * e + 2] * inrm, k3 = kkv[4 * e + 3] * inrm;
                    *(f32x4*)(PW + o + 4 * e) = (f32x4){wv[4 * e], wv[4 * e + 1], wv[4 * e + 2], wv[4 * e + 3]};
                    *(f32x4*)(PNKK + o + 4 * e) = (f32x4){-k0, -k1, -k2_, -k3};
                    *(f32x4*)(PB + o + 4 * e) = (f32x4){k0 * av[4 * e], k1 * av[4 * e + 1], k2_ * av[4 * e + 2], k3 * av[4 * e + 3]};
                    *(f32x4*)(PK + o + 4 * e) = (f32x4){k2[4 * e], k2[4 * e + 1], k2[4 * e + 2], k2[4 * e + 3]};
                    *(f32x4*)(PR + o + 4 * e) = (f32x4){zs[0][4 * e], zs[0][4 * e + 1], zs[0][4 * e + 2], zs[0][4 * e + 3]};
                }
                { u32x4 va;
#pragma unroll
                  for (int e = 0; e < 4; ++e) va[e] = pk2(zs[2][2 * e], zs[2][2 * e + 1]);
                  *(u32x4*)(PV + o) = va; *(u32x4*)(PG + o) = ga; }
                if ((lane & 7) == 0) BON[m * 16 + hd] = s2;
            }
        }
    }
    SEAM(5);
    if (IN(6)) for (int rep = 0; rep < (DUP_PHASE == 6 ? 2 : 1); ++rep) {
        {
            float* wl = (float*)lds + wave * RL<0>::BUF;
            for (int task = gw; task < RH * NCH * 2; task += NGW) {
                const int part = task & 1, pair = task >> 1, h = pair / NCH, c = pair % NCH; const size_t o = (size_t)(c * LCH) * RW + h * 64;
                f32x2 S[32];
                if (part) {
#pragma unroll
                    for (int j = 0; j < 32; ++j) { S[j].x = (2 * j == lane) ? 1.f : 0.f; S[j].y = (2 * j + 1 == lane) ? 1.f : 0.f; }
                    rwkv_lds<1>(S, PW + o, PNKK + o, PB + o, PK + o, PR + o, PV + o, LCH, lane, nullptr, nullptr, nullptr, 0.f, 0.f, wl);
                } else {
#pragma unroll
                    for (int j = 0; j < 32; ++j) S[j] = (f32x2){0.f, 0.f};
                    rwkv_lds<0>(S, PW + o, PNKK + o, PB + o, PK + o, PR + o, PV + o, LCH, lane, nullptr, nullptr, nullptr, 0.f, 0.f, wl);
                }
                float* dst = PU + ((size_t)pair * 2 + (part ? 0 : 1)) * 4096 + lane * 64;
#pragma unroll
                for (int j = 0; j < 16; ++j) *(f32x4*)(dst + 4 * j) = (f32x4){S[2 * j].x, S[2 * j].y, S[2 * j + 1].x, S[2 * j + 1].y};
            }
        }
        __syncthreads();
        bf16* kT = (bf16*)lds;
        bf16* vT = (bf16*)lds + 256 * 72;
        const int fr = lane & 15, fq = lane >> 4;
        for (int it = bid; it < EH * NRB * 2; it += G) {
            const int half = it & 1, blk = (it >> 1) % NRB, h = (it >> 1) / NRB; const float l2g = ret_l2g(h); const int m0 = blk * RBLK;
            f32x4 acc[2][8];
#pragma unroll
            for (int x = 0; x < 2; ++x)
#pragma unroll
                for (int y = 0; y < 8; ++y) acc[x][y] = (f32x4){0.f, 0.f, 0.f, 0.f};
            for (int ts = 0; ts < 4; ++ts) {
                __syncthreads();
#pragma unroll
                for (int i = 0; i < 4; ++i) { const int t = lane, dp = wave + 8 * i; const u32x4 raw = *(const u32x4*)(QKVG + (size_t)(m0 + ts * 64 + t) * EC + 1024 + h * 256 + dp * 8);
                    const float dec = exp2f(l2g * (float)(255 - (ts * 64 + t)));
#pragma unroll
                    for (int e = 0; e < 4; ++e) { const unsigned w = raw[e]; kT[(dp * 8 + 2 * e) * 72 + t] = (bf16)f2bf(bf2f(w & 0xffffu) * dec); kT[(dp * 8 + 2 * e + 1) * 72 + t] = (bf16)f2bf(bf2f(w >> 16) * dec); } }
#pragma unroll
                for (int i = 0; i < 2; ++i) { const int t = lane, ep = wave + 8 * i; const u32x4 raw = *(const u32x4*)(QKVG + (size_t)(m0 + ts * 64 + t) * EC + 2048 + h * 256 + half * 128 + ep * 8);
#pragma unroll
                    for (int e = 0; e < 4; ++e) { const unsigned w = raw[e]; vT[(ep * 8 + 2 * e) * 72 + t] = (bf16)(w & 0xffffu); vT[(ep * 8 + 2 * e + 1) * 72 + t] = (bf16)(w >> 16); } }
                __syncthreads();
#pragma unroll
                for (int kk = 0; kk < 2; ++kk) { bf16x8 af[2];
#pragma unroll
                    for (int x = 0; x < 2; ++x) af[x] = *(const bf16x8*)(kT + (32 * wave + 16 * x + fr) * 72 + kk * 32 + fq * 8);
#pragma unroll
                    for (int y = 0; y < 8; ++y) { const bf16x8 bfm = *(const bf16x8*)(vT + (16 * y + fr) * 72 + kk * 32 + fq * 8);
#pragma unroll
                        for (int x = 0; x < 2; ++x) acc[x][y] = __builtin_amdgcn_mfma_f32_16x16x32_bf16(af[x], bfm, acc[x][y], 0, 0, 0); } }
            }
            bf16* dst = KVB + ((size_t)(h * NRB + blk) * 256) * 256;
#pragma unroll
            for (int x = 0; x < 2; ++x)
#pragma unroll
                for (int y = 0; y < 8; ++y) { u32x2 w; w.x = pk2(acc[x][y][0], acc[x][y][1]); w.y = pk2(acc[x][y][2], acc[x][y][3]);
                    *(u32x2*)(dst + (size_t)(half * 128 + 16 * y + fr) * 256 + 32 * wave + 16 * x + fq * 4) = w; }
        }
    }
    SEAM(6);
    if (IN(7)) for (int rep = 0; rep < (DUP_PHASE == 7 ? 2 : 1); ++rep) {
        const int nB = RH * 4;
        if (bid < nB || G <= nB) {
            float* Sb = (float*)lds;
            float* Pb = (float*)lds + 1024;
            for (int it = bid; it < nB; it += G) {
                const int h = it >> 2, g4 = it & 3, i = tid >> 5, j0 = (tid & 31) * 2; const float* pu = PU + (size_t)(h * NCH) * 2 * 4096;
                __syncthreads();
                { const f32x4* src = (const f32x4*)pu; ((f32x4*)Pb)[tid] = src[tid]; ((f32x4*)Pb)[tid + 512] = src[tid + 512]; }
                f32x2 s = {0.f, 0.f};
                f32x2 u = *(const f32x2*)(pu + 4096 + (16 * g4 + i) * 64 + j0);
                for (int c = 0; c < NCH; ++c) {
                    float* Pc = Pb + (c & 1) * 4096; float* Pn = Pb + ((c + 1) & 1) * 4096;
                    *(f32x2*)(Sb + i * 64 + j0) = s;
                    __syncthreads();
                    f32x4 n0 = {0.f, 0.f, 0.f, 0.f}, n1 = n0; f32x2 un = {0.f, 0.f};
                    if (c + 1 < NCH) { const float* pn = pu + (size_t)(c + 1) * 2 * 4096; n0 = ((const f32x4*)pn)[tid]; n1 = ((const f32x4*)pn)[tid + 512]; un = *(const f32x2*)(pn + 4096 + (16 * g4 + i) * 64 + j0); }
                    f32x2 acc = u;
#pragma unroll 8
                    for (int k = 0; k < 64; ++k) { const float sk = Sb[i * 64 + k]; const f32x2 p = *(const f32x2*)(Pc + k * 64 + j0); acc += p * sk; }
                    s = acc;
                    *(f32x2*)((float*)pu + (size_t)c * 2 * 4096 + 4096 + (16 * g4 + i) * 64 + j0) = s;
                    ((f32x4*)Pn)[tid] = n0; ((f32x4*)Pn)[tid + 512] = n1; u = un;
                    __syncthreads();
                }
                *(f32x2*)(out + O_WKP + (size_t)h * 4096 + (16 * g4 + i) * 64 + j0) = s;
            }
        }
        if (bid >= nB || G <= nB) {
            const int nb2 = G <= nB ? G : G - nB, b2 = G <= nB ? bid : bid - nB;
            for (int it = b2 * 512 + tid; it < EH * 256 * 32; it += nb2 * 512) {
                const int h = it >> 13, e = (it >> 5) & 255, d0 = (it & 31) * 8; const float g256 = exp2f(256.f * ret_l2g(h));
                float acc[8];
#pragma unroll
                for (int q = 0; q < 8; ++q) acc[q] = 0.f;
                for (int blk = 0; blk < NRB; ++blk) {
                    const size_t o = ((size_t)(h * NRB + blk) * 256 + e) * 256 + d0;
                    u32x4 w; w.x = pk2(acc[0], acc[1]); w.y = pk2(acc[2], acc[3]); w.z = pk2(acc[4], acc[5]); w.w = pk2(acc[6], acc[7]); *(u32x4*)(SPREV + o) = w;
                    const u32x4 kv = *(const u32x4*)(KVB + o);
#pragma unroll
                    for (int q = 0; q < 4; ++q) { acc[2 * q] = acc[2 * q] * g256 + bf2f(kv[q] & 0xffffu); acc[2 * q + 1] = acc[2 * q + 1] * g256 + bf2f(kv[q] >> 16); }
                }
#pragma unroll
                for (int q = 0; q < 8; ++q) out[O_RTP + (size_t)h * 65536 + (size_t)(d0 + q) * 256 + e] = acc[q];
            }
        }
    }
    SEAM(7);
    if (IN(8)) for (int rep = 0; rep < (DUP_PHASE == 8 ? 2 : 1); ++rep) {
        if (wave < 5) {
            float* wl = (float*)lds + wave * RL<2>::BUF;
            const int ntask = wave < 4 ? RH * NCH : NB * RH;
            for (int task = wave < 4 ? bid * 4 + wave : bid; task < ntask; task += (wave < 4 ? G * 4 : G)) {
                f32x2 S[32]; int h, m0, nsteps; float* sdst = nullptr;
                if (wave < 4) { h = task / NCH; const int c = task % NCH; m0 = c * LCH; nsteps = LCH;
                    if (c == 0) {
#pragma unroll
                        for (int j = 0; j < 32; ++j) S[j] = (f32x2){0.f, 0.f};
                    } else { const float* src = PU + ((size_t)(h * NCH + c - 1) * 2 + 1) * 4096 + lane * 64;
#pragma unroll
                        for (int j = 0; j < 16; ++j) { const f32x4 q = *(const f32x4*)(src + 4 * j); S[2 * j] = (f32x2){q.x, q.y}; S[2 * j + 1] = (f32x2){q.z, q.w}; } }
                } else { const int b = task / RH; h = task % RH; m0 = TP + 16 * b; nsteps = TS;
                    const float* src = a.in[I_SWKV] + ((size_t)(b * RH + h) * 64 + lane) * 64; sdst = out + O_WKS + ((size_t)(b * RH + h) * 64 + lane) * 64;
#pragma unroll
                    for (int j = 0; j < 16; ++j) { const f32x4 q = *(const f32x4*)(src + 4 * j); S[2 * j] = (f32x2){q.x, q.y}; S[2 * j + 1] = (f32x2){q.z, q.w}; } }
                const size_t o = (size_t)m0 * RW + h * 64;
                rwkv_lds<2>(S, PW + o, PNKK + o, PB + o, PK + o, PR + o, PV + o, nsteps, lane, PG + o, BON + (size_t)m0 * 16 + h, MIX + (size_t)m0 * D + h * 64,
                            a.in[I_RLW][h * 64 + lane], a.in[I_RLB][h * 64 + lane], wl);
                if (sdst) {
#pragma unroll
                    for (int j = 0; j < 16; ++j) *(f32x4*)(sdst + 4 * j) = (f32x4){S[2 * j].x, S[2 * j].y, S[2 * j + 1].x, S[2 * j + 1].y}; }
            }
        }
        {
            const int nb2 = G, b2 = bid;
            const int fr = lane & 15, fq = lane >> 4;
            for (int it = b2; it < EH * (TP / 64) + NB * EH; it += nb2) {
                __syncthreads();
#ifndef NO_RP
                if (it < EH * (TP / 64)) {
                    const int h = it / (TP / 64), n = it % (TP / 64), blk = n >> 2, i = n & 3, m0 = n * 64; const float l2g = ret_l2g(h);
                    bf16* qL = (bf16*)lds; bf16* kL = qL + 64 * 264; bf16* vT = kL + 64 * 264; bf16* pL = vT + 256 * 72; float* red = (float*)(pL + 64 * 72);
#pragma unroll
                    for (int x = 0; x < 4; ++x) { const int p = tid + 512 * x, t = p >> 5, dp = p & 31; *(u32x4*)(qL + t * 264 + dp * 8) = *(const u32x4*)(QKVG + (size_t)(m0 + t) * EC + h * 256 + dp * 8); }
                    __syncthreads();
                    f32x4 acc[4][2];
#pragma unroll
                    for (int x = 0; x < 4; ++x)
#pragma unroll
                        for (int y = 0; y < 2; ++y) acc[x][y] = (f32x4){0.f, 0.f, 0.f, 0.f};
                    if (blk > 0) {
                        const bf16* sp = SPREV + ((size_t)(h * NRB + blk) * 256) * 256;
#pragma unroll 2
                        for (int kk = 0; kk < 8; ++kk) { bf16x8 bfm[2];
#pragma unroll
                            for (int y = 0; y < 2; ++y) bfm[y] = *(const bf16x8*)(sp + (size_t)(32 * wave + 16 * y + fr) * 256 + kk * 32 + fq * 8);
#pragma unroll
                            for (int x = 0; x < 4; ++x) { const bf16x8 af = *(const bf16x8*)(qL + (16 * x + fr) * 264 + kk * 32 + fq * 8);
#pragma unroll
                                for (int y = 0; y < 2; ++y) acc[x][y] = __builtin_amdgcn_mfma_f32_16x16x32_bf16(af, bfm[y], acc[x][y], 0, 0, 0); } }
#pragma unroll
                        for (int x = 0; x < 4; ++x)
#pragma unroll
                            for (int jj = 0; jj < 4; ++jj) { const float qd = exp2f(l2g * (float)(64 * i + 16 * x + fq * 4 + jj + 1)); acc[x][0][jj] *= qd; acc[x][1][jj] *= qd; }
                    }
                    for (int j = 0; j <= i; ++j) {
                        __syncthreads();
                        const int ms = (blk * 4 + j) * 64;
#pragma unroll
                        for (int x = 0; x < 4; ++x) { const int p = tid + 512 * x, t = p >> 5, dp = p & 31;
                            *(u32x4*)(kL + t * 264 + dp * 8) = *(const u32x4*)(QKVG + (size_t)(ms + t) * EC + 1024 + h * 256 + dp * 8); }
#pragma unroll
                        for (int x = 0; x < 4; ++x) { const int t = lane, dp = wave + 8 * x;
                            const u32x4 raw = *(const u32x4*)(QKVG + (size_t)(ms + t) * EC + 2048 + h * 256 + dp * 8);
#pragma unroll
                            for (int e = 0; e < 4; ++e) { const unsigned w = raw[e]; vT[(dp * 8 + 2 * e) * 72 + t] = (bf16)(w & 0xffffu); vT[(dp * 8 + 2 * e + 1) * 72 + t] = (bf16)(w >> 16); } }
                        __syncthreads();
                        { const int tr = wave >> 1, tc0 = (wave & 1) * 2; f32x4 sa[2] = {(f32x4){0.f, 0.f, 0.f, 0.f}, (f32x4){0.f, 0.f, 0.f, 0.f}};
#pragma unroll
                            for (int kk = 0; kk < 8; ++kk) { const bf16x8 af = *(const bf16x8*)(qL + (16 * tr + fr) * 264 + kk * 32 + fq * 8);
#pragma unroll
                                for (int y = 0; y < 2; ++y) { const bf16x8 bfm = *(const bf16x8*)(kL + (16 * (tc0 + y) + fr) * 264 + kk * 32 + fq * 8); sa[y] = __builtin_amdgcn_mfma_f32_16x16x32_bf16(af, bfm, sa[y], 0, 0, 0); } }
#pragma unroll
                            for (int y = 0; y < 2; ++y)
#pragma unroll
                                for (int jj = 0; jj < 4; ++jj) { const int t = 16 * tr + fq * 4 + jj, s = 16 * (tc0 + y) + fr; const int dist = (j < i) ? 64 * (i - j) + t - s : (t > s ? t - s : s - t);
                                    pL[t * 72 + s] = (bf16)f2bf(sa[y][jj] * exp2f(l2g * (float)dist)); } }
                        __syncthreads();
#pragma unroll
                        for (int kk = 0; kk < 2; ++kk) { bf16x8 bfm[2];
#pragma unroll
                            for (int y = 0; y < 2; ++y) bfm[y] = *(const bf16x8*)(vT + (32 * wave + 16 * y + fr) * 72 + kk * 32 + fq * 8);
#pragma unroll
                            for (int x = 0; x < 4; ++x) { const bf16x8 af = *(const bf16x8*)(pL + (16 * x + fr) * 72 + kk * 32 + fq * 8);
#pragma unroll
                                for (int y = 0; y < 2; ++y) acc[x][y] = __builtin_amdgcn_mfma_f32_16x16x32_bf16(af, bfm[y], acc[x][y], 0, 0, 0); } }
                    }
#pragma unroll
                    for (int x = 0; x < 4; ++x)
#pragma unroll
                        for (int jj = 0; jj < 4; ++jj) { float s1 = acc[x][0][jj] + acc[x][1][jj], s2 = acc[x][0][jj] * acc[x][0][jj] + acc[x][1][jj] * acc[x][1][jj];
#pragma unroll
                            for (int o = 1; o < 16; o <<= 1) { s1 += __shfl_xor(s1, o); s2 += __shfl_xor(s2, o); }
                            if (fr == 0) { const int t = 16 * x + fq * 4 + jj; red[(t * 8 + wave) * 2] = s1; red[(t * 8 + wave) * 2 + 1] = s2; } }
                    __syncthreads();
                    float lw[2], lb[2];
#pragma unroll
                    for (int y = 0; y < 2; ++y) { lw[y] = a.in[I_ELW][h * 256 + 32 * wave + 16 * y + fr]; lb[y] = a.in[I_ELB][h * 256 + 32 * wave + 16 * y + fr]; }
#pragma unroll
                    for (int x = 0; x < 4; ++x)
#pragma unroll
                        for (int jj = 0; jj < 4; ++jj) { const int t = 16 * x + fq * 4 + jj; float s1 = 0.f, s2 = 0.f;
#pragma unroll
                            for (int w8 = 0; w8 < 8; ++w8) { s1 += red[(t * 8 + w8) * 2]; s2 += red[(t * 8 + w8) * 2 + 1]; }
                            const float mean = s1 * (1.f / 256.f), var = s2 * (1.f / 256.f) - mean * mean, rstd = rsqrtf(var + 1e-5f);
#pragma unroll
                            for (int y = 0; y < 2; ++y) { const int e = 32 * wave + 16 * y + fr; const float gt = bf2f(QKVG[(size_t)(m0 + t) * EC + 3072 + h * 256 + e]);
                                const float val = ((acc[x][y][jj] - mean) * rstd * lw[y] + lb[y]) * gt * sigm(gt);
                                MIX[(size_t)(m0 + t) * D + RW + h * 256 + e] = (bf16)f2bf(val); } }
                } else
#endif
#ifndef NO_RS
                {
                    const int r = it - EH * (TP / 64), b = r / EH, h = r % EH, m0 = TP + 16 * b; const float l2g = ret_l2g(h);
                    float* qf = (float*)lds; float* kf = qf + 16 * 257; float* vf = kf + 16 * 257; float* pf = vf + 16 * 257; float* red = pf + 256;
                    for (int idx = tid; idx < 16 * 256; idx += 512) { const int t = idx >> 8, dd = idx & 255; const bf16* src = QKVG + (size_t)(m0 + t) * EC + h * 256 + dd;
                        qf[t * 257 + dd] = bf2f(src[0]); kf[t * 257 + dd] = bf2f(src[1024]); vf[t * 257 + dd] = bf2f(src[2048]); }
                    __syncthreads();
                    if (tid < 256) { const int t = tid >> 4, s = tid & 15; float sc = 0.f;
#pragma unroll 4
                        for (int dd = 0; dd < 256; ++dd) sc += qf[t * 257 + dd] * kf[s * 257 + dd];
                        pf[t * 16 + s] = sc * exp2f(l2g * (float)(t > s ? t - s : s - t)); }
                    __syncthreads();
                    const int e = tid & 255, th = tid >> 8; const float* S0 = a.in[I_SRET] + (size_t)(b * EH + h) * 65536;
                    float oc[8];
#pragma unroll
                    for (int tt = 0; tt < 8; ++tt) oc[tt] = 0.f;
#pragma unroll 2
                    for (int dd = 0; dd < 256; ++dd) { const float s0 = S0[(size_t)dd * 256 + e];
#pragma unroll
                        for (int tt = 0; tt < 8; ++tt) oc[tt] += qf[(th * 8 + tt) * 257 + dd] * s0; }
#pragma unroll
                    for (int tt = 0; tt < 8; ++tt) { const int t = th * 8 + tt; float v = oc[tt] * exp2f(l2g * (float)(t + 1));
#pragma unroll 4
                        for (int s = 0; s < 16; ++s) v += pf[t * 16 + s] * vf[s * 257 + e];
                        oc[tt] = v; }
                    { const float g16 = exp2f(16.f * l2g); float* dst = out + O_RTS + (size_t)(b * EH + h) * 65536; float vd[16];
#pragma unroll
                        for (int t = 0; t < 16; ++t) vd[t] = vf[t * 257 + e] * exp2f(l2g * (float)(15 - t));
#pragma unroll 2
                        for (int dd = th * 128; dd < th * 128 + 128; ++dd) { float v = g16 * S0[(size_t)dd * 256 + e];
#pragma unroll
                            for (int t = 0; t < 16; ++t) v += kf[t * 257 + dd] * vd[t];
                            dst[(size_t)dd * 256 + e] = v; } }
#pragma unroll
                    for (int tt = 0; tt < 8; ++tt) { const float s1 = wave_sum(oc[tt]), s2 = wave_sum(oc[tt] * oc[tt]); if (lane == 0) { const int t = th * 8 + tt; red[(t * 4 + (wave & 3)) * 2] = s1; red[(t * 4 + (wave & 3)) * 2 + 1] = s2; } }
                    __syncthreads();
                    const float lw = a.in[I_ELW][h * 256 + e], lb = a.in[I_ELB][h * 256 + e];
#pragma unroll
                    for (int tt = 0; tt < 8; ++tt) { const int t = th * 8 + tt; float s1 = 0.f, s2 = 0.f;
#pragma unroll
                        for (int w4 = 0; w4 < 4; ++w4) { s1 += red[(t * 4 + w4) * 2]; s2 += red[(t * 4 + w4) * 2 + 1]; }
                        const float mean = s1 * (1.f / 256.f), var = s2 * (1.f / 256.f) - mean * mean, rstd = rsqrtf(var + 1e-5f);
                        const float gt = bf2f(QKVG[(size_t)(m0 + t) * EC + 3072 + h * 256 + e]);
                        MIX[(size_t)(m0 + t) * D + RW + h * 256 + e] = (bf16)f2bf(((oc[tt] - mean) * rstd * lw + lb) * gt * sigm(gt)); }
                }
#else
                {}
#endif
            }
        }
    }
    SEAM(8);
    if (IN(9)) for (int rep = 0; rep < (DUP_PHASE == 9 ? 2 : 1); ++rep) {
        pg8::Gemm g{MIX, WOUTT, M, D, D}; pg8::StaticOrder S; S.init(M, D, G, bid); EpiF32 E{MIXOUT, D};
        pg8::gemm_phase<EpiF32, pg8::StaticOrder, true, true>((PG8_LAS unsigned char*)lds, g, S, E);
    }
    SEAM(9);
    if (IN(10)) for (int rep = 0; rep < (DUP_PHASE == 10 ? 2 : 1); ++rep) {
        for (int m = gw; m < M; m += NGW) {
            const float* xr = m < TP ? a.in[I_XP] + (size_t)m * D : a.in[I_XS] + (size_t)(m - TP) * D; const float* mod = MOD + seq_of(m) * MODW; const float* mr = MIXOUT + (size_t)m * D;
            f32x4 v[8]; float ss = 0.f;
#pragma unroll
            for (int j = 0; j < 8; ++j) { v[j] = *(const f32x4*)(mr + 4 * lane + 256 * j); ss += (v[j].x * v[j].x + v[j].y * v[j].y) + (v[j].z * v[j].z + v[j].w * v[j].w); }
            const float rs = rsqrtf(wave_sum(ss) * (1.f / D) + 1e-6f); float s2 = 0.f;
#pragma unroll
            for (int j = 0; j < 8; ++j) { const int c = 4 * lane + 256 * j; const f32x4 g = *(const f32x4*)(a.in[I_GPOM] + c), gt = *(const f32x4*)(mod + 2 * D + c), x = *(const f32x4*)(xr + c);
                v[j] = x + gt * (v[j] * rs * g); *(f32x4*)(out + (size_t)m * D + c) = v[j]; s2 += (v[j].x * v[j].x + v[j].y * v[j].y) + (v[j].z * v[j].z + v[j].w * v[j].w); }
            const float rs2 = rsqrtf(wave_sum(s2) * (1.f / D) + 1e-6f);
#pragma unroll
            for (int j = 0; j < 8; ++j) { const int c = 4 * lane + 256 * j; const f32x4 g = *(const f32x4*)(a.in[I_GPF] + c), s1 = *(const f32x4*)(mod + 4 * D + c), h1 = *(const f32x4*)(mod + 3 * D + c);
                const f32x4 h = v[j] * rs2 * g * (s1 + 1.f) + h1; u32x2 w; w.x = pk2(h.x, h.y); w.y = pk2(h.z, h.w); *(u32x2*)(H + (size_t)m * D + c) = w; }
        }
        float* scr = (float*)lds + wave * (64 * 33 + 16);
        constexpr int IT_UP = (D / 64) * (2 * FF / 32), IT_DN = (FF / 64) * (D / 32);
        for (int it = gw; it < IT_UP + IT_DN; it += NGW) {
            if (it < IT_UP) { const int nb = 2 * FF / 32, kb = it / nb, n0 = 32 * (it % nb); const int nn = n0 < FF ? n0 : n0 - FF; const int dr = 256 * (nn >> 7) + (n0 < FF ? 0 : 128) + (nn & 127);
                transpose_item(a.in[I_WUP], D, 2 * FF, WUPT, 64 * kb, n0, dr, scr, lane); }
            else { const int r = it - IT_UP, nb = D / 32, kb = r / nb, n0 = 32 * (r % nb); transpose_item(a.in[I_WDN], FF, D, WDNT, 64 * kb, n0, n0, scr, lane); }
        }
    }
    SEAM(10);
    if (IN(11)) for (int rep = 0; rep < (DUP_PHASE == 11 ? 2 : 1); ++rep) {
        pg8::Gemm g{H, WUPT, M, 2 * FF, D}; pg8::StaticOrder S; S.init(M, 2 * FF, G, bid); EpiSwiglu E{ACT};
        pg8::gemm_phase<EpiSwiglu, pg8::StaticOrder, true, true>((PG8_LAS unsigned char*)lds, g, S, E);
    }
    SEAM(11);
    if (IN(12)) for (int rep = 0; rep < (DUP_PHASE == 12 ? 2 : 1); ++rep) {
        pg8::Gemm g{ACT, WDNT, M, D, FF}; pg8::StaticOrder S; S.init(M, D, G, bid); EpiF32 E{MIXOUT, D};
        pg8::gemm_phase<EpiF32, pg8::StaticOrder, true, true>((PG8_LAS unsigned char*)lds, g, S, E);
    }
    SEAM(12);
    if (IN(13)) for (int rep = 0; rep < (DUP_PHASE == 13 ? 2 : 1); ++rep) {
        for (int m = gw; m < M; m += NGW) {
            const float* mod = MOD + seq_of(m) * MODW; const float* fr_ = MIXOUT + (size_t)m * D;
            f32x4 v[8]; float ss = 0.f;
#pragma unroll
            for (int j = 0; j < 8; ++j) { v[j] = *(const f32x4*)(fr_ + 4 * lane + 256 * j); ss += (v[j].x * v[j].x + v[j].y * v[j].y) + (v[j].z * v[j].z + v[j].w * v[j].w); }
            const float rs = rsqrtf(wave_sum(ss) * (1.f / D) + 1e-6f);
#pragma unroll
            for (int j = 0; j < 8; ++j) { const int c = 4 * lane + 256 * j; const f32x4 g = *(const f32x4*)(a.in[I_GPOF] + c), gt = *(const f32x4*)(mod + 5 * D + c), x = *(const f32x4*)(out + (size_t)m * D + c);
                *(f32x4*)(out + (size_t)m * D + c) = x + gt * (v[j] * rs * g); }
        }
    }
    if (TS_PROBE >= 0) {
        SEAM(13);
        if (bid == 0) { __syncthreads(); const float us = (float)(TSW[1 + TS_PROBE] - TSW[TS_PROBE]) * 0.01f; const float eps = sqrtf(us * 1e-4f);
            for (int c = tid; c < RC; c += 512) out[O_SHP + c] *= (1.f + eps); }
    }
#undef IN
#undef SEAM
}

extern "C" void kernel_launch(void* const* d_in, const int* in_sizes, int n_in, void* d_out, int out_size, void* d_ws, size_t ws_size, hipStream_t stream) {
    static int grid = 0;
    if (grid == 0) {
        if (n_in != 30 || (size_t)out_size != O_END || ws_size < WS_END) { fprintf(stderr, "kernel_launch: unexpected sizes n_in %d out %d ws %zu\n", n_in, out_size, ws_size); grid = -1; return; }
        int dev = 0, cus = 0, per_cu = 0;
        (void)hipGetDevice(&dev); (void)hipDeviceGetAttribute(&cus, hipDeviceAttributeMultiprocessorCount, dev);
        if (hipFuncSetAttribute((const void*)mk_fwd, hipFuncAttributeMaxDynamicSharedMemorySize, LDS_BYTES) != hipSuccess) { fprintf(stderr, "kernel_launch: hipFuncSetAttribute failed\n"); grid = -1; return; }
        if (hipOccupancyMaxActiveBlocksPerMultiprocessor(&per_cu, (const void*)mk_fwd, 512, LDS_BYTES) != hipSuccess || per_cu < 1) { fprintf(stderr, "kernel_launch: occupancy query says %d\n", per_cu); per_cu = 1; }
        (void)hipGetLastError();
        grid = cus;
        if (grid <= 0) grid = 256;
    }
    if (grid < 0) return;
    (void)hipMemsetAsync((char*)d_ws + WS_MOD, 0, (size_t)NSEQ * MODW * 4, stream);
    Args a{};
    for (int i = 0; i < 30; ++i) a.in[i] = (const float*)d_in[i];
    a.out = (float*)d_out; a.ws = (unsigned char*)d_ws;
#if MK_MULTI
    for (int p = 0; p < NPHASE; ++p) { a.ph_lo = p; a.ph_hi = p + 1; hipLaunchKernelGGL(mk_fwd, dim3(grid), dim3(512), LDS_BYTES, stream, a); }
#else
    a.ph_lo = 0; a.ph_hi = NPHASE;
    void* args[] = {&a};
    hipError_t e = hipLaunchCooperativeKernel((const void*)mk_fwd, dim3(grid), dim3(512), args, LDS_BYTES, stream);
    if (e != hipSuccess) fprintf(stderr, "kernel_launch: cooperative launch failed: %s (grid %d)\n", hipGetErrorString(e), grid);
#endif
}
```

```cpp
#include <hip/hip_runtime.h>
#include <hip/hip_cooperative_groups.h>
#include <cstdio>
#include <cstdint>
namespace cg = cooperative_groups;
namespace pg8 {
#define PG8_LAS __attribute__((address_space(3)))
typedef unsigned short bf16_t;
typedef short bf16x8 __attribute__((ext_vector_type(8)));
typedef float f32x4 __attribute__((ext_vector_type(4)));
typedef unsigned u32x4 __attribute__((ext_vector_type(4)));
constexpr int BM = 256, BK = 64, HALF = 128, HTB = HALF * BK * 2  , STAGE_BYTES = 8 * HTB, NXCD = 8, WGM = 8;

__host__ __device__ __forceinline__ int lds_byte(int r, int c) { const int st = (r >> 4) * 2 + (c >> 5), rr = r & 15, cc = c & 31, ob = rr * 64 + cc * 2; return st * 1024 + (ob ^ (((ob >> 9) & 1) << 5)); }
__host__ __device__ __forceinline__ void stage_rc(int b, int& R, int& C) { const int st = b / 1024, sb = b % 1024, swz = sb ^ (((sb >> 9) & 1) << 5); R = (st >> 1) * 16 + swz / 64; C = (st & 1) * 32 + (swz % 64) / 2; }
__host__ __device__ __forceinline__ int perm32(int rho) { const int n = rho >> 4, i = rho & 15; return 8 * (i >> 2) + 4 * n + (i & 3); }

struct Unit { int pm, pn; };
struct Gemm { const bf16_t* A; const bf16_t* Bt; int M, N, K, ld; };

struct OneUnit {
    int pm, pn; bool active;
    __device__ __forceinline__ bool next(int i, Unit& u) const { if (i > 0 || !active) return false; u.pm = pm; u.pn = pn; return true; }
    __device__ __forceinline__ void a_ready(const Unit&) const {}
    __device__ __forceinline__ void done(const Unit&) const {}
};
struct StaticOrder {
    int nM, nN, nwg, G, c;
    __host__ __device__ void init(int M, int N, int G_, int c_) { nM = M / BM; nN = N / BM; nwg = nM * nN; G = G_; c = c_; }
    __host__ __device__ bool next(int i, Unit& u) const {
        const long L = (long)i * G + c; if (L >= nwg) return false;
        int wgid = (int)L; { const int q = nwg / NXCD, r = nwg % NXCD, xcd = wgid % NXCD, off = wgid / NXCD; wgid = (xcd < r ? xcd * (q + 1) : r * (q + 1) + (xcd - r) * q) + off; }
        const int nig = WGM * nN, gid = wgid / nig, fm = gid * WGM, gsz = (nM - fm) < WGM ? (nM - fm) : WGM;
        u.pm = fm + ((wgid % nig) % gsz); u.pn = (wgid % nig) / gsz; return true;
    }
    __device__ __forceinline__ void a_ready(const Unit&) const {}
    __device__ __forceinline__ void done(const Unit&) const {}
};

__device__ __forceinline__ unsigned cvt_pk_bf16(float lo, float hi) { unsigned r; asm volatile("v_cvt_pk_bf16_f32 %0, %1, %2" : "=v"(r) : "v"(lo), "v"(hi)); return r; }
template <class Epi, class Sched, bool ALIGN_EPI = false, bool SP2 = false>
__device__ __forceinline__ void gemm_phase(PG8_LAS unsigned char* lds, const Gemm g, const Sched& S, const Epi& E) {
    const int tid = threadIdx.x, wid = __builtin_amdgcn_readfirstlane(tid >> 6), lane = tid & 63, wr = wid >> 2, wc = wid & 3, fr = lane & 15, fq = lane >> 4;
    const int K = g.K, nt = K / BK;
    unsigned voffA[2], voffB[2];
#pragma unroll
    for (int i = 0; i < 2; ++i) { int R, C; stage_rc(tid * 16 + i * 8192, R, C); const int Rb = Epi::PERM ? ((R & ~31) + perm32(R & 31)) : R;
        voffA[i] = (unsigned)(R * g.ld + C) * 2u; voffB[i] = (unsigned)(Rb * g.ld + C) * 2u; }
    const size_t kstep = (size_t)(BK * 2);
    const size_t hstep = (size_t)HALF * g.ld * 2;
    const size_t tstep = 2 * hstep;
    const unsigned ldsw = (unsigned)wid * 1024u;
    const int aoff = lds_byte(wr * 64 + fr, fq * 8), boff = lds_byte(wc * 32 + fr, fq * 8);
#define PG8_SA(b, h) (((b) * 2 + (h)) * HTB)
#define PG8_SB(b, h) ((4 + (b) * 2 + (h)) * HTB)
#define PG8_STAGE(bufoff, gbase, voff) do { _Pragma("unroll") for (int _i = 0; _i < 2; ++_i) \
        __builtin_amdgcn_global_load_lds((const unsigned*)((const char*)(gbase) + (voff)[_i]), (PG8_LAS unsigned*)(lds + (bufoff) + ldsw + _i * 8192), 16, 0, 0); } while (0)
#define PG8_LDA(dst, b, h) do { _Pragma("unroll") for (int m = 0; m < 4; ++m) _Pragma("unroll") for (int k = 0; k < 2; ++k) dst[m][k] = *(const PG8_LAS bf16x8*)(lds + PG8_SA(b, h) + aoff + m * 2048 + k * 1024); } while (0)
#define PG8_LDB(dst, b, h) do { _Pragma("unroll") for (int n = 0; n < 2; ++n) _Pragma("unroll") for (int k = 0; k < 2; ++k) dst[n][k] = *(const PG8_LAS bf16x8*)(lds + PG8_SB(b, h) + boff + n * 2048 + k * 1024); } while (0)
#define PG8_MMA(ai, bj, At, Bt) do { __builtin_amdgcn_s_setprio(1); _Pragma("unroll") for (int m = 0; m < 4; ++m) _Pragma("unroll") for (int n = 0; n < 2; ++n) _Pragma("unroll") for (int k = 0; k < 2; ++k) \
        acc[ai][bj][m][n] = __builtin_amdgcn_mfma_f32_16x16x32_bf16(Bt[n][k], At[m][k], acc[ai][bj][m][n], 0, 0, 0); __builtin_amdgcn_s_setprio(0); } while (0)
#define PG8_WAIT_V(n) asm volatile("s_waitcnt vmcnt(" #n ")" ::: "memory")
#define PG8_WAIT_L(n) asm volatile("s_waitcnt lgkmcnt(" #n ")" ::: "memory")
#define PG8_BAR __builtin_amdgcn_s_barrier()
#define PG8_SCHED __builtin_amdgcn_sched_barrier(0)
    Unit cur, nxt; int ui = 0;
    if (!S.next(0, cur)) return;
    f32x4 acc[2][2][4][2];
#pragma unroll
    for (int a = 0; a < 2; ++a)
#pragma unroll
        for (int b = 0; b < 2; ++b)
#pragma unroll
            for (int m = 0; m < 4; ++m)
#pragma unroll
                for (int n = 0; n < 2; ++n) acc[a][b][m][n] = (f32x4){0.f, 0.f, 0.f, 0.f};
    bf16x8 At[4][2], B0[2][2], B1[2][2];
    const char* cA = (const char*)g.A + (size_t)cur.pm * tstep; const char* cB = (const char*)g.Bt + (size_t)cur.pn * tstep;
    S.a_ready(cur);
    if constexpr (SP2) {
        PG8_STAGE(PG8_SB(0, 0), cB, voffB); PG8_STAGE(PG8_SB(0, 1), cB + hstep, voffB); PG8_STAGE(PG8_SA(0, 0), cA, voffA); PG8_STAGE(PG8_SA(0, 1), cA + hstep, voffA);
        if (wr == 1) PG8_BAR;
        PG8_WAIT_V(2); PG8_BAR;
        PG8_STAGE(PG8_SB(1, 0), cB + kstep, voffB); PG8_STAGE(PG8_SA(1, 0), cA + kstep, voffA); PG8_STAGE(PG8_SB(1, 1), cB + hstep + kstep, voffB);
        PG8_WAIT_V(6); PG8_BAR;
    } else {
        PG8_STAGE(PG8_SB(0, 0), cB, voffB); PG8_STAGE(PG8_SA(0, 0), cA, voffA); PG8_STAGE(PG8_SB(0, 1), cB + hstep, voffB); PG8_STAGE(PG8_SA(0, 1), cA + hstep, voffA);
        if (wr == 1) PG8_BAR;
        PG8_WAIT_V(4); PG8_BAR;
        PG8_STAGE(PG8_SB(1, 0), cB + kstep, voffB); PG8_STAGE(PG8_SA(1, 0), cA + kstep, voffA); PG8_STAGE(PG8_SB(1, 1), cB + hstep + kstep, voffB);
        PG8_WAIT_V(6); PG8_BAR;
    }
    for (;;) {
        const bool has_next = S.next(ui + 1, nxt);
        const char* nA = has_next ? (const char*)g.A + (size_t)nxt.pm * tstep : cA; const char* nB = has_next ? (const char*)g.Bt + (size_t)nxt.pn * tstep : cB;
        for (int t = 0; t < nt; t += 2) {
            const bool last = (t == nt - 2);
            const char* a1 = cA + (size_t)(t + 1) * kstep;
            const char* a2 = last ? nA : cA + (size_t)(t + 2) * kstep; const char* b2 = last ? nB : cB + (size_t)(t + 2) * kstep;
            const char* a3 = a2 + kstep; const char* b3 = b2 + kstep;
            if (last && has_next) S.a_ready(nxt);
            if constexpr (SP2) {
            PG8_LDB(B0, 0, 0); PG8_LDB(B1, 0, 1); PG8_SCHED; PG8_LDA(At, 0, 0); PG8_STAGE(PG8_SA(1, 1), a1 + hstep, voffA);
            PG8_WAIT_V(8); PG8_WAIT_L(0); PG8_BAR; PG8_MMA(0, 0, At, B0); PG8_MMA(0, 1, At, B1); PG8_BAR; PG8_SCHED;
            PG8_LDA(At, 0, 1); PG8_STAGE(PG8_SB(0, 0), b2, voffB); PG8_STAGE(PG8_SB(0, 1), b2 + hstep, voffB); PG8_STAGE(PG8_SA(0, 0), a2, voffA);
            PG8_WAIT_V(8); PG8_WAIT_L(0); PG8_BAR; PG8_MMA(1, 0, At, B0); PG8_MMA(1, 1, At, B1); PG8_BAR; PG8_SCHED;
            PG8_LDB(B0, 1, 0); PG8_LDB(B1, 1, 1); PG8_SCHED; PG8_LDA(At, 1, 0); PG8_STAGE(PG8_SA(0, 1), a2 + hstep, voffA);
            PG8_WAIT_V(8); PG8_WAIT_L(0); PG8_BAR; PG8_MMA(0, 0, At, B0); PG8_MMA(0, 1, At, B1); PG8_BAR; PG8_SCHED;
            PG8_LDA(At, 1, 1); PG8_STAGE(PG8_SB(1, 0), b3, voffB); PG8_STAGE(PG8_SB(1, 1), b3 + hstep, voffB); PG8_STAGE(PG8_SA(1, 0), a3, voffA);
            PG8_WAIT_V(8); PG8_WAIT_L(0); PG8_BAR; PG8_MMA(1, 0, At, B0); PG8_MMA(1, 1, At, B1); PG8_BAR; PG8_SCHED;
            } else {
            PG8_LDB(B0, 0, 0); PG8_SCHED; PG8_LDA(At, 0, 0); PG8_STAGE(PG8_SA(1, 1), a1 + hstep, voffA);
            PG8_WAIT_L(8); PG8_BAR; PG8_WAIT_L(0); PG8_MMA(0, 0, At, B0); PG8_BAR; PG8_SCHED;
            PG8_LDB(B1, 0, 1); PG8_STAGE(PG8_SB(0, 0), b2, voffB);
            PG8_BAR; PG8_WAIT_L(0); PG8_MMA(0, 1, At, B1); PG8_BAR;
            PG8_LDA(At, 0, 1); PG8_STAGE(PG8_SA(0, 0), a2, voffA);
            PG8_BAR; PG8_WAIT_L(0); PG8_MMA(1, 0, At, B0); PG8_BAR; PG8_SCHED;
            PG8_STAGE(PG8_SB(0, 1), b2 + hstep, voffB);
            PG8_WAIT_V(6); PG8_BAR; PG8_MMA(1, 1, At, B1); PG8_BAR;
            PG8_LDB(B0, 1, 0); PG8_SCHED; PG8_LDA(At, 1, 0); PG8_STAGE(PG8_SA(0, 1), a2 + hstep, voffA);
            PG8_WAIT_L(8); PG8_BAR; PG8_WAIT_L(0); PG8_MMA(0, 0, At, B0); PG8_BAR; PG8_SCHED;
            PG8_LDB(B1, 1, 1); PG8_STAGE(PG8_SB(1, 0), b3, voffB);
            PG8_BAR; PG8_WAIT_L(0); PG8_MMA(0, 1, At, B1); PG8_BAR;
            PG8_LDA(At, 1, 1); PG8_STAGE(PG8_SA(1, 0), a3, voffA);
            PG8_BAR; PG8_WAIT_L(0); PG8_MMA(1, 0, At, B0); PG8_BAR; PG8_SCHED;
            PG8_STAGE(PG8_SB(1, 1), b3 + hstep, voffB);
            PG8_WAIT_V(6); PG8_BAR; PG8_MMA(1, 1, At, B1); PG8_BAR;
            }
        }
        if constexpr (ALIGN_EPI) { if (wr == 0) PG8_BAR; }
        if constexpr (!Epi::AFTER_DRAIN) { E(acc, cur, wr, wc, fr, fq); S.done(cur); }
        if (!has_next) break;
#pragma unroll
        for (int a = 0; a < 2; ++a)
#pragma unroll
            for (int b = 0; b < 2; ++b)
#pragma unroll
                for (int m = 0; m < 4; ++m)
#pragma unroll
                    for (int n = 0; n < 2; ++n) acc[a][b][m][n] = (f32x4){0.f, 0.f, 0.f, 0.f};
        cur = nxt; cA = nA; cB = nB; ++ui;
        if constexpr (ALIGN_EPI) { if (wr == 1) PG8_BAR; }
    }
    PG8_WAIT_V(0);
    if constexpr (!ALIGN_EPI) { if (wr == 0) PG8_BAR; }
    PG8_BAR;
    if constexpr (Epi::AFTER_DRAIN) { E.fused(acc, cur, wr, wc, fr, fq, lds, wid, lane); S.done(cur); }
#undef PG8_SA
#undef PG8_SB
#undef PG8_STAGE
#undef PG8_LDA
#undef PG8_LDB
#undef PG8_MMA
#undef PG8_WAIT_V
#undef PG8_WAIT_L
#undef PG8_BAR
#undef PG8_SCHED
}
}

#ifndef MK_MULTI
#define MK_MULTI 0
#endif
constexpr int D = 2048, TP = 8192, NB = 16, TS = 16, MS = NB * TS, M = TP + MS;
constexpr int RW = 1024, RH = 16, RN = 64, RC = 3328;
constexpr int ED = 1024, EH = 4, EN = 256, EC = 4096, IC = RC + EC;
constexpr int FF = 5632, NSEQ = 17, MODW = 6 * D;
constexpr int LCH = 128, NCH = TP / LCH;
constexpr int RBLK = 256, NRB = TP / RBLK;
constexpr int NPHASE = 14;
constexpr size_t O_Y = 0, O_SHP = (size_t)M * D, O_WKP = O_SHP + RC, O_RTP = O_WKP + 65536, O_SHS = O_RTP + 262144, O_WKS = O_SHS + (size_t)NB * RC, O_RTS = O_WKS + (size_t)NB * 65536, O_END = O_RTS + (size_t)NB * 262144;
constexpr size_t MiB = 1u << 20;
constexpr size_t WS_MOD = 1 * MiB, WS_LORAT = 2 * MiB, WS_WOUTT = 4 * MiB, WS_WINT = 12 * MiB, WS_V = 12 * MiB, WS_H = 41 * MiB, WS_G = 41 * MiB, WS_BON = 58 * MiB,
                 WS_QKVG = 74 * MiB, WS_LOUT = 140 * MiB, WS_PU = 140 * MiB, WS_KVB = 172 * MiB, WS_ACT = 74 * MiB, WS_PREP = 190 * MiB, WS_MIXOUT = 190 * MiB,
                 WS_WUPT = 256 * MiB, WS_WDNT = 300 * MiB, WS_PART9 = 330 * MiB, WS_PART12 = 256 * MiB, WS_END = 355 * MiB;
constexpr size_t WS_ADAT = 190 * MiB, WS_SC = 239 * MiB, WS_MODP = 240 * MiB;
constexpr int KS9 = 4, KS12 = 11;
constexpr size_t PREP_STRIDE = 33 * MiB;
constexpr size_t DO_Z = 0, DO_LIN = 54 * MiB, DO_SPREV = 0, DO_MIX = 17 * MiB;
constexpr int LDS_BYTES = 147456;

typedef unsigned short bf16;
typedef float f32x2 __attribute__((ext_vector_type(2)));
typedef float f32x4 __attribute__((ext_vector_type(4)));
typedef short bf16x8 __attribute__((ext_vector_type(8)));
typedef unsigned u32x4 __attribute__((ext_vector_type(4)));
typedef unsigned u32x2 __attribute__((ext_vector_type(2)));
#define LDS_WAIT() asm volatile("s_waitcnt lgkmcnt(0)" ::: "memory")

__device__ __forceinline__ float bf2f(unsigned v) { return __builtin_bit_cast(float, v << 16); }
__device__ __forceinline__ unsigned f2bf(float f) { unsigned u = __builtin_bit_cast(unsigned, f); return (u + 0x7fffu + ((u >> 16) & 1u)) >> 16; }
__device__ __forceinline__ unsigned pk2(float lo, float hi) { return f2bf(lo) | (f2bf(hi) << 16); }
__device__ __forceinline__ float wave_sum(float v) {
#pragma unroll
    for (int o = 1; o < 64; o <<= 1) v += __shfl_xor(v, o);
    return v;
}
__device__ __forceinline__ float sigm(float x) { return 1.f / (1.f + __expf(-x)); }
__device__ __forceinline__ int seq_of(int m) { return m < TP ? 0 : 1 + ((m - TP) >> 4); }
__device__ __forceinline__ int tpos_of(int m) { return m < TP ? m : ((m - TP) & 15); }
__device__ __forceinline__ float ret_l2g(int h) { return __log2f(1.0f - exp2f(-5.0f - (float)h)); }

struct EpiProj {
    static constexpr bool PERM = true, AFTER_DRAIN = false;
    bf16* Z; bf16* Q;
    __device__ __forceinline__ void operator()(const f32x4 (&acc)[2][2][4][2], const pg8::Unit& u, int wr, int wc, int fr, int fq) const {
        const int row0 = u.pm * 256 + wr * 64 + fr, pn = u.pn, cl = wc * 32 + 8 * fq;
        if (pn < 13 || pn >= 21) {
            bf16* base = pn < 13 ? Z + pn * 256 + cl : Q + (pn - 13) * 256 + cl; const size_t ld = pn < 13 ? RC : EC;
#pragma unroll
            for (int ai = 0; ai < 2; ++ai)
#pragma unroll
                for (int m = 0; m < 4; ++m) { bf16* rp = base + (size_t)(row0 + ai * 128 + m * 16) * ld;
#pragma unroll
                    for (int bj = 0; bj < 2; ++bj) { const f32x4 v0 = acc[ai][bj][m][0], v1 = acc[ai][bj][m][1]; u32x4 w; w.x = pk2(v0[0], v0[1]); w.y = pk2(v0[2], v0[3]); w.z = pk2(v1[0], v1[1]); w.w = pk2(v1[2], v1[3]);
                        *(u32x4*)(rp + bj * 128) = w; } }
        } else {
            const int sec = pn - 13; bf16* base = Q + sec * 256 + cl; const float sc = sec >= 4 ? 0.0625f : 1.0f;
            float inv[8];
#pragma unroll
            for (int e = 0; e < 8; ++e) inv[e] = exp2f(-(float)(cl + e) * (13.287712379549449f / 128.0f)) * 0.15915494309189535f;
#pragma unroll
            for (int ai = 0; ai < 2; ++ai)
#pragma unroll
                for (int m = 0; m < 4; ++m) { const int row = row0 + ai * 128 + m * 16; bf16* rp = base + (size_t)row * EC;
                    const float pos = row < TP ? (float)row : (float)(2048 + ((row - TP) & 15));
                    float o1[8], o2[8];
#pragma unroll
                    for (int e = 0; e < 8; ++e) { float rev = pos * inv[e]; rev -= floorf(rev); const float sn = __builtin_amdgcn_sinf(rev), cs = __builtin_amdgcn_cosf(rev);
                        const float x1 = acc[ai][0][m][e >> 2][e & 3], x2 = acc[ai][1][m][e >> 2][e & 3];
                        o1[e] = (x1 * cs - x2 * sn) * sc; o2[e] = (x2 * cs + x1 * sn) * sc; }
                    u32x4 w; w.x = pk2(o1[0], o1[1]); w.y = pk2(o1[2], o1[3]); w.z = pk2(o1[4], o1[5]); w.w = pk2(o1[6], o1[7]); *(u32x4*)rp = w;
                    w.x = pk2(o2[0], o2[1]); w.y = pk2(o2[2], o2[3]); w.z = pk2(o2[4], o2[5]); w.w = pk2(o2[6], o2[7]); *(u32x4*)(rp + 128) = w; }
        }
    }
};
struct EpiBf16P {
    static constexpr bool PERM = true, AFTER_DRAIN = false;
    bf16* C; int ldc;
    __device__ __forceinline__ void operator()(const f32x4 (&acc)[2][2][4][2], const pg8::Unit& u, int wr, int wc, int fr, int fq) const {
        const int row0 = u.pm * 256 + wr * 64 + fr; bf16* base = C + u.pn * 256 + wc * 32 + 8 * fq;
#pragma unroll
        for (int ai = 0; ai < 2; ++ai)
#pragma unroll
            for (int m = 0; m < 4; ++m) { bf16* rp = base + (size_t)(row0 + ai * 128 + m * 16) * ldc;
#pragma unroll
                for (int bj = 0; bj < 2; ++bj) { const f32x4 v0 = acc[ai][bj][m][0], v1 = acc[ai][bj][m][1]; u32x4 w; w.x = pk2(v0[0], v0[1]); w.y = pk2(v0[2], v0[3]); w.z = pk2(v1[0], v1[1]); w.w = pk2(v1[2], v1[3]);
                    *(u32x4*)(rp + bj * 128) = w; } }
    }
};
struct EpiF32 {
    static constexpr bool PERM = true, AFTER_DRAIN = false;
    float* C; int ldc;
    __device__ __forceinline__ void operator()(const f32x4 (&acc)[2][2][4][2], const pg8::Unit& u, int wr, int wc, int fr, int fq) const {
        const int row0 = u.pm * 256 + wr * 64 + fr; float* base = C + u.pn * 256 + wc * 32 + 8 * fq;
#pragma unroll
        for (int ai = 0; ai < 2; ++ai)
#pragma unroll
            for (int m = 0; m < 4; ++m) { float* rp = base + (size_t)(row0 + ai * 128 + m * 16) * ldc;
#pragma unroll
                for (int bj = 0; bj < 2; ++bj) { *(f32x4*)(rp + bj * 128) = acc[ai][bj][m][0]; *(f32x4*)(rp + bj * 128 + 4) = acc[ai][bj][m][1]; } }
    }
};
struct EpiSwiglu {
    static constexpr bool PERM = true, AFTER_DRAIN = false;
    bf16* C;
    __device__ __forceinline__ void operator()(const f32x4 (&acc)[2][2][4][2], const pg8::Unit& u, int wr, int wc, int fr, int fq) const {
        const int row0 = u.pm * 256 + wr * 64 + fr; bf16* base = C + u.pn * 128 + wc * 32 + 8 * fq;
#pragma unroll
        for (int ai = 0; ai < 2; ++ai)
#pragma unroll
            for (int m = 0; m < 4; ++m) { float o[8];
#pragma unroll
                for (int e = 0; e < 8; ++e) { const float g = acc[ai][0][m][e >> 2][e & 3], up = acc[ai][1][m][e >> 2][e & 3]; o[e] = g * sigm(g) * up; }
                u32x4 w; w.x = pk2(o[0], o[1]); w.y = pk2(o[2], o[3]); w.z = pk2(o[4], o[5]); w.w = pk2(o[6], o[7]);
                *(u32x4*)(base + (size_t)(row0 + ai * 128 + m * 16) * FF) = w; }
    }
};
struct EpiMod {
    static constexpr bool PERM = true, AFTER_DRAIN = false;
    float* C; int ldc;
    __device__ __forceinline__ void operator()(const f32x4 (&acc)[2][2][4][2], const pg8::Unit& u, int wr, int wc, int fr, int fq) const {
        if (wr != 0) return;
        float* base = C + u.pn * 256 + wc * 32 + 8 * fq;
#pragma unroll
        for (int m = 0; m < 2; ++m) { const int row = 16 * m + fr; if (row < NSEQ) { float* rp = base + (size_t)row * ldc;
#pragma unroll
            for (int bj = 0; bj < 2; ++bj) { *(f32x4*)(rp + bj * 128) = acc[0][bj][m][0]; *(f32x4*)(rp + bj * 128 + 4) = acc[0][bj][m][1]; } } }
    }
};

__device__ __forceinline__ void transpose_item(const float* __restrict__ W, int K, int N, bf16* WT, int k0, int n0, int dst_row0, float* scr, int lane) {
#pragma unroll 8
    for (int i = 0; i < 32; ++i) { const int kk = 2 * i + (lane >> 5); scr[kk * 33 + (lane & 31)] = W[(size_t)(k0 + kk) * N + n0 + (lane & 31)]; }
    LDS_WAIT();
    const int c = lane & 7;
#pragma unroll
    for (int j = 0; j < 4; ++j) { const int n = (lane >> 3) + 8 * j; const float* s = scr + (8 * c) * 33 + n;
        u32x4 o; o.x = pk2(s[0 * 33], s[1 * 33]); o.y = pk2(s[2 * 33], s[3 * 33]); o.z = pk2(s[4 * 33], s[5 * 33]); o.w = pk2(s[6 * 33], s[7 * 33]);
        *(u32x4*)(WT + (size_t)(dst_row0 + n) * K + k0 + 8 * c) = o; }
    LDS_WAIT();
}

typedef const __attribute__((address_space(4))) f32x2* cf2p;
__device__ __forceinline__ cf2p to_c(const float* p) { return (cf2p)(unsigned long long)p; }
#define DPPF(old, src, ctrl, rmask) __builtin_bit_cast(float, __builtin_amdgcn_update_dpp(__builtin_bit_cast(int, (float)(old)), __builtin_bit_cast(int, (float)(src)), (ctrl), (rmask), 0xF, false))
__device__ __forceinline__ float wave_sum_u(float v) {
    v += DPPF(0.f, v, 0xB1, 0xF); v += DPPF(0.f, v, 0x4E, 0xF); v += DPPF(0.f, v, 0x124, 0xF); v += DPPF(0.f, v, 0x128, 0xF);
    v += DPPF(0.f, v, 0x142, 0xA); v += DPPF(0.f, v, 0x143, 0xC);
    return __builtin_bit_cast(float, __builtin_amdgcn_readlane(__builtin_bit_cast(int, v), 63));
}
constexpr int RW_PF = 6;
template <int MODE>
__device__ __forceinline__ void rwkv_run(f32x2 (&S)[32], const float* W, const float* NKK, const float* B, const float* K, const float* R, const bf16* Vp, int nsteps, int lane,
                                         const bf16* Gp, const float* BONp, bf16* MIXp, float lnw, float lnb) {
    constexpr int NPF = MODE == 2 ? 20 : (MODE == 0 ? 16 : 12);
    const int pa = lane >> 2; const float* pfp = (pa == 0 ? W : pa == 1 ? NKK : pa == 2 ? B : pa == 3 ? K : R) + (lane & 3) * 16;
    float vn = 0.f, gn = 0.f, bn = 0.f;
    if (MODE != 1) vn = bf2f(Vp[lane]);
    if (MODE == 2) { gn = bf2f(Gp[lane]); bn = BONp[0]; }
    if (lane < NPF) {
#pragma unroll
        for (int q = 1; q < RW_PF; ++q) if (q < nsteps) (void)*(volatile const float*)(pfp + (size_t)q * RW);
    }
    for (int t = 0; t < nsteps; ++t) {
        const size_t o = (size_t)t * RW;
        cf2p w = to_c(W + o), nk = to_c(NKK + o), b = to_c(B + o), k = to_c(K + o), r = to_c(R + o);
        const float v = vn, gv = gn, bon = bn;
        { const int t1 = t + 1 < nsteps ? t + 1 : t; const size_t o1 = (size_t)t1 * RW;
          if (MODE != 1) vn = bf2f(Vp[o1 + lane]);
          if (MODE == 2) { gn = bf2f(Gp[o1 + lane]); bn = BONp[(size_t)t1 * 16]; }
          const int tp = t + RW_PF < nsteps ? t + RW_PF : nsteps - 1;
          if (lane < NPF) (void)*(volatile const float*)(pfp + (size_t)tp * RW); }
        f32x2 a0 = {0.f, 0.f}, a1 = {0.f, 0.f};
#pragma unroll
        for (int j = 0; j < 32; j += 2) { a0 = __builtin_elementwise_fma(S[j], nk[j], a0); a1 = __builtin_elementwise_fma(S[j + 1], nk[j + 1], a1); }
        const float sa = (a0.x + a0.y) + (a1.x + a1.y);
        const f32x2 sa2 = {sa, sa}, v2 = {v, v};
        f32x2 o0 = {0.f, 0.f}, o1 = {0.f, 0.f};
#pragma unroll
        for (int j = 0; j < 32; ++j) {
            f32x2 s = S[j] * w[j];
            s = __builtin_elementwise_fma(sa2, b[j], s);
            if (MODE != 1) s = __builtin_elementwise_fma(v2, k[j], s);
            S[j] = s;
            if (MODE == 2) { if (j & 1) o1 = __builtin_elementwise_fma(s, r[j], o1); else o0 = __builtin_elementwise_fma(s, r[j], o0); }
        }
        if (MODE == 2) {
            const float ov = (o0.x + o0.y) + (o1.x + o1.y);
            const float mean = wave_sum_u(ov) * (1.f / 64.f), d = ov - mean, var = wave_sum_u(d * d) * (1.f / 64.f);
            float y = d * rsqrtf(var + 64e-5f) * lnw + lnb;
            y = (y + bon * v) * gv;
            MIXp[(size_t)t * D + lane] = (bf16)f2bf(y);
        }
    }
}

constexpr int RL_B = 8;
template <int MODE> struct RL { static constexpr int NV = MODE == 2 ? 5 : (MODE == 0 ? 4 : 3); static constexpr int REC = NV * 64, BUF = RL_B * REC + (MODE != 1 ? 256 : 0) + (MODE == 2 ? 256 + 16 : 0); };
#define SBAR() __builtin_amdgcn_sched_barrier(0)
template <int MODE>
__device__ __forceinline__ void rwkv_lds(f32x2 (&S)[32], const float* W, const float* NKK, const float* B, const float* K, const float* R, const bf16* Vp, int nsteps, int lane,
                                         const bf16* Gp, const float* BONp, bf16* MIXp, float lnw, float lnb, float* wl) {
    constexpr int NV = RL<MODE>::NV, REC = RL<MODE>::REC;
    const int ls = lane >> 4, lc = (lane & 15) * 4;
    f32x4 st[NV][2]; u32x4 sv = {0u, 0u, 0u, 0u}, sg = {0u, 0u, 0u, 0u}; float sb = 0.f;
#define RL_ISSUE(bt) do { const size_t ob = (size_t)((bt) * RL_B) * RW; \
        _Pragma("unroll") for (int q = 0; q < 2; ++q) { const size_t oo = ob + (size_t)(ls + 4 * q) * RW + lc; \
            st[0][q] = *(const f32x4*)(W + oo); st[1][q] = *(const f32x4*)(NKK + oo); st[2][q] = *(const f32x4*)(B + oo); if (NV >= 4) st[NV >= 4 ? 3 : 0][q] = *(const f32x4*)(K + oo); if (NV == 5) st[NV - 1][q] = *(const f32x4*)(R + oo); } \
        if (MODE != 1) sv = *(const u32x4*)(Vp + ob + (size_t)(lane >> 3) * RW + (lane & 7) * 8); \
        if (MODE == 2) { sg = *(const u32x4*)(Gp + ob + (size_t)(lane >> 3) * RW + (lane & 7) * 8); if (lane < RL_B) sb = BONp[(size_t)((bt) * RL_B + lane) * 16]; } } while (0)
#define RL_COMMIT() do { \
        _Pragma("unroll") for (int q = 0; q < 2; ++q) _Pragma("unroll") for (int v = 0; v < NV; ++v) *(f32x4*)(wl + (ls + 4 * q) * REC + v * 64 + lc) = st[v][q]; \
        if (MODE != 1) *(u32x4*)((bf16*)(wl + RL_B * REC) + (lane >> 3) * 64 + (lane & 7) * 8) = sv; \
        if (MODE == 2) { *(u32x4*)((bf16*)(wl + RL_B * REC + 256) + (lane >> 3) * 64 + (lane & 7) * 8) = sg; if (lane < RL_B) wl[RL_B * REC + 512 + lane] = sb; } } while (0)
    const int nb = nsteps / RL_B;
    RL_ISSUE(0); RL_COMMIT();
    for (int bt = 0; bt < nb; ++bt) {
        if (bt + 1 < nb) RL_ISSUE(bt + 1);
#pragma unroll 1
        for (int s = 0; s < RL_B; ++s) {
            const f32x2* w = (const f32x2*)(wl + s * REC); const f32x2* nk = w + 32; const f32x2* b = w + 64; const f32x2* k = w + 96; const f32x2* r = w + 128;
            float v = 0.f, gv = 0.f, bon = 0.f;
            if (MODE != 1) v = bf2f(((const bf16*)(wl + RL_B * REC))[s * 64 + lane]);
            if (MODE == 2) { gv = bf2f(((const bf16*)(wl + RL_B * REC + 256))[s * 64 + lane]); bon = wl[RL_B * REC + 512 + s]; }
            f32x2 nA[8], nB[8]; f32x2 a0 = {0.f, 0.f}, a1 = {0.f, 0.f};
#pragma unroll
            for (int p = 0; p < 8; ++p) nA[p] = nk[p];
#pragma unroll
            for (int g = 0; g < 4; ++g) {
                if (g < 3) {
#pragma unroll
                    for (int p = 0; p < 8; ++p) { if (g & 1) nA[p] = nk[8 * (g + 1) + p]; else nB[p] = nk[8 * (g + 1) + p]; } }
                SBAR();
#pragma unroll
                for (int p = 0; p < 8; p += 2) { a0 = __builtin_elementwise_fma(S[8 * g + p], (g & 1) ? nB[p] : nA[p], a0); a1 = __builtin_elementwise_fma(S[8 * g + p + 1], (g & 1) ? nB[p + 1] : nA[p + 1], a1); }
                SBAR();
            }
            const float sa = (a0.x + a0.y) + (a1.x + a1.y);
            const f32x2 sa2 = {sa, sa}, v2 = {v, v};
            f32x2 uw[2][4], ub[2][4], uk[2][4], ur[2][4]; f32x2 o0 = {0.f, 0.f}, o1 = {0.f, 0.f};
#pragma unroll
            for (int p = 0; p < 4; ++p) { uw[0][p] = w[p]; ub[0][p] = b[p]; if (MODE != 1) uk[0][p] = k[p]; if (MODE == 2) ur[0][p] = r[p]; }
#pragma unroll
            for (int g = 0; g < 8; ++g) {
                if (g < 7) {
#pragma unroll
                    for (int p = 0; p < 4; ++p) { uw[(g + 1) & 1][p] = w[4 * (g + 1) + p]; ub[(g + 1) & 1][p] = b[4 * (g + 1) + p]; if (MODE != 1) uk[(g + 1) & 1][p] = k[4 * (g + 1) + p]; if (MODE == 2) ur[(g + 1) & 1][p] = r[4 * (g + 1) + p]; } }
                SBAR();
#pragma unroll
                for (int p = 0; p < 4; ++p) { const int j = 4 * g + p;
                    f32x2 x = S[j] * uw[g & 1][p]; x = __builtin_elementwise_fma(sa2, ub[g & 1][p], x); if (MODE != 1) x = __builtin_elementwise_fma(v2, uk[g & 1][p], x); S[j] = x;
                    if (MODE == 2) { if (p & 1) o1 = __builtin_elementwise_fma(x, ur[g & 1][p], o1); else o0 = __builtin_elementwise_fma(x, ur[g & 1][p], o0); } }
                SBAR();
            }
            if (MODE == 2) {
                const float ov = (o0.x + o0.y) + (o1.x + o1.y);
                const float mean = wave_sum_u(ov) * (1.f / 64.f), d = ov - mean, var = wave_sum_u(d * d) * (1.f / 64.f);
                float y = d * rsqrtf(var + 64e-5f) * lnw + lnb;
                y = (y + bon * v) * gv;
                MIXp[(size_t)(bt * RL_B + s) * D + lane] = (bf16)f2bf(y);
            }
        }
        if (bt + 1 < nb) RL_COMMIT();
    }
#undef RL_ISSUE
#undef RL_COMMIT
}
#define LAS __attribute__((address_space(3)))

#define XB_TMO      128
#define XB_XCNT(j)  (256  + 64 * (j))
#define XB_XSUB(j)  (1280 + 64 * (j))
#define XB_XGEN(j)  (2304 + 64 * (j))
#define XB_TOP      3328
#define XB_TOPGEN   3392
#define XCD_BAR_WORDS 3456
#define XB_SPIN_CAP (1u << 18)

__device__ __forceinline__ unsigned xb_ld(unsigned* p)              { return __hip_atomic_load(p, __ATOMIC_RELAXED, __HIP_MEMORY_SCOPE_AGENT); }
__device__ __forceinline__ unsigned xb_add(unsigned* p, unsigned v) { return __hip_atomic_fetch_add(p, v, __ATOMIC_RELAXED, __HIP_MEMORY_SCOPE_AGENT); }
__device__ __forceinline__ unsigned xb_xcc_id() { return (unsigned)__builtin_amdgcn_s_getreg((3 << 11) | 20) & 0xFu; }
#define XB_SPIN(cond, bar) do { unsigned _sp = 0; while (cond) { __builtin_amdgcn_s_sleep(1); \
    if ((++_sp & 255u) == 0u) { if (xb_ld(&(bar)[XB_TMO])) break; if (_sp > XB_SPIN_CAP) { atomicAdd(&(bar)[XB_TMO], 1u); break; } } } } while (0)

struct XcdBarrier {
    unsigned* bar; unsigned x;
    volatile LAS unsigned* st;
};

__device__ __forceinline__ XcdBarrier xcd_barrier_post(unsigned* bar, volatile LAS unsigned* st) {
    XcdBarrier b; b.bar = bar; b.x = xb_xcc_id(); b.st = st;
    if (threadIdx.x == 0) (void)xb_add(&bar[XB_XCNT(b.x)], 1u);
    return b;
}
__device__ __forceinline__ void xcd_barrier_complete(unsigned* bar, unsigned x, unsigned& nloc, unsigned& nx) {
    const unsigned G = gridDim.x * gridDim.y * gridDim.z;
    unsigned sum, cnt, mine, sp = 0u;
    for (;;) {
        sum = 0u; cnt = 0u; mine = 0u;
#pragma unroll
        for (unsigned j = 0; j < 16; ++j) { const unsigned c = xb_ld(&bar[XB_XCNT(j)]); sum += c; cnt += (c > 0u) ? 1u : 0u; mine = (j == x) ? c : mine; }
        if (sum == G) break;
        __builtin_amdgcn_s_sleep(1);
        if ((++sp & 255u) == 0u) { if (xb_ld(&bar[XB_TMO])) break; if (sp > XB_SPIN_CAP) { atomicAdd(&bar[XB_TMO], 1u); break; } }
    }
    nloc = mine > 0u ? mine : 1u; nx = cnt > 0u ? cnt : 1u;
}

__device__ __forceinline__ void xcd_barrier(const XcdBarrier& b) {
    asm volatile("s_waitcnt vmcnt(0)" ::: "memory");
    __syncthreads();
    if (threadIdx.x == 0) {
        unsigned* bar = b.bar;
        __builtin_amdgcn_s_waitcnt(0);
        unsigned nloc = b.st[0], nx = b.st[1];
        if (nloc == 0u) { xcd_barrier_complete(bar, b.x, nloc, nx); b.st[0] = nloc; b.st[1] = nx; }
        const unsigned old = xb_add(&bar[XB_XSUB(b.x)], 1u);
        const unsigned gen = old / nloc;
        if (old + 1u == (gen + 1u) * nloc) {
            __builtin_amdgcn_fence(__ATOMIC_RELEASE, "agent");
            asm volatile("s_waitcnt vmcnt(0)" ::: "memory");
            const unsigned og = xb_add(&bar[XB_TOP], 1u);
            const unsigned tg = og / nx;
            if (og + 1u == (tg + 1u) * nx) xb_add(&bar[XB_TOPGEN], 1u);
            else XB_SPIN(xb_ld(&bar[XB_TOPGEN]) == tg, bar);
            __builtin_amdgcn_fence(__ATOMIC_ACQUIRE, "agent");
            xb_add(&bar[XB_XGEN(b.x)], 1u);
            asm volatile("s_waitcnt vmcnt(0)" ::: "memory");
        } else {
            XB_SPIN(xb_ld(&bar[XB_XGEN(b.x)]) == gen, bar);
            __builtin_amdgcn_fence(__ATOMIC_ACQUIRE, "agent");
            asm volatile("s_waitcnt vmcnt(0)" ::: "memory");
        }
    }
    __syncthreads();
}


struct Args { const float* in[30]; float* out; unsigned char* ws; int ph_lo, ph_hi; };
enum { I_XP = 0, I_XS, I_CP, I_CS, I_SSH, I_SWKV, I_SRET, I_ADAW, I_ADAB, I_GPM, I_GPOM, I_GPF, I_GPOF, I_WIN, I_MU, I_W0, I_W2, I_A0, I_A2, I_G2, I_KK, I_KA, I_RK, I_RLW, I_RLB, I_ELW, I_ELB, I_WOUT, I_WUP, I_WDN };

__global__ void __launch_bounds__(512, 2) mk_fwd(Args a) {
    extern __shared__ __attribute__((aligned(16))) unsigned char lds[];
    cg::grid_group grid = cg::this_grid();
    const int tid = threadIdx.x, lane = tid & 63, wave = __builtin_amdgcn_readfirstlane(tid >> 6);
    const int G = gridDim.x, bid = blockIdx.x, gw = bid * 8 + wave, NGW = G * 8;
    const int lo = a.ph_lo, hi = a.ph_hi;
    volatile LAS unsigned* xst = (volatile LAS unsigned*)((LAS unsigned char*)lds + LDS_BYTES - 16);
    if (tid < 2) xst[tid] = 0u;
    __syncthreads();
    XcdBarrier xb = xcd_barrier_post((unsigned*)(a.ws + 65536), xst);
    unsigned char* ws = a.ws; float* out = a.out; unsigned char* dob = (unsigned char*)a.out;
    float* MOD = (float*)(ws + WS_MOD);
    bf16* LORAT = (bf16*)(ws + WS_LORAT); bf16* WOUTT = (bf16*)(ws + WS_WOUTT); bf16* WINT = (bf16*)(ws + WS_WINT); bf16* WUPT = (bf16*)(ws + WS_WUPT); bf16* WDNT = (bf16*)(ws + WS_WDNT);
    bf16* H = (bf16*)(ws + WS_H); bf16* QKVG = (bf16*)(ws + WS_QKVG); bf16* LOUT = (bf16*)(ws + WS_LOUT); bf16* Z = (bf16*)(dob + DO_Z); bf16* LIN = (bf16*)(dob + DO_LIN);
    float* PW = (float*)(ws + WS_PREP); float* PNKK = (float*)(ws + WS_PREP + PREP_STRIDE); float* PB = (float*)(ws + WS_PREP + 2 * PREP_STRIDE); float* PK = (float*)(ws + WS_PREP + 3 * PREP_STRIDE); float* PR = (float*)(ws + WS_PREP + 4 * PREP_STRIDE);
    bf16* PV = (bf16*)(ws + WS_V); bf16* PG = (bf16*)(ws + WS_G); float* BON = (float*)(ws + WS_BON);
    float* PU = (float*)(ws + WS_PU); bf16* KVB = (bf16*)(ws + WS_KVB); bf16* SPREV = (bf16*)(dob + DO_SPREV); bf16* MIX = (bf16*)(dob + DO_MIX);
    float* MIXOUT = (float*)(ws + WS_MIXOUT); bf16* ACT = (bf16*)(ws + WS_ACT);
#ifndef DUP_PHASE
#define DUP_PHASE -1
#endif
#ifndef PH_MASK
#define PH_MASK 0x3fff
#endif
#define IN(k) (((PH_MASK >> (k)) & 1) && lo <= (k) && (k) < hi)
#ifndef TS_PROBE
#define TS_PROBE -1
#endif
    unsigned long long* TSW = (unsigned long long*)ws;
    if (TS_PROBE >= 0 && bid == 0 && tid == 0) TSW[0] = __builtin_amdgcn_s_memrealtime();
#define MID(n) do { if (TS_PROBE >= 0 && bid == 0) { __syncthreads(); if (tid == 0) TSW[32 + (n)] = __builtin_amdgcn_s_memrealtime(); } } while (0)
#define SEAM(k) do { if (IN(k) && IN((k) + 1)) { if ((k) == 0) grid.sync(); else xcd_barrier(xb); } if (TS_PROBE >= 0 && bid == 0 && tid == 0) TSW[1 + (k)] = __builtin_amdgcn_s_memrealtime(); } while (0)

    if (IN(0)) for (int rep = 0; rep < (DUP_PHASE == 0 ? 2 : 1); ++rep) {
        MID(0);
        float* scr = (float*)lds + wave * (64 * 33 + 16);
        constexpr int IT_WIN = (D / 64) * (IC / 32), IT_WOUT = (D / 64) * (D / 32), IT_ADA = (D / 64) * (MODW / 32);
        bf16* ADAT = (bf16*)(ws + WS_ADAT); bf16* SC = (bf16*)(ws + WS_SC);
        for (int it = gw; it < IT_WIN + IT_WOUT + IT_ADA; it += NGW) {
            if (it < IT_WIN) { const int nb = IC / 32, kb = it / nb, n0 = 32 * (it % nb); transpose_item(a.in[I_WIN], D, IC, WINT, 64 * kb, n0, n0, scr, lane); }
            else if (it < IT_WIN + IT_WOUT) { const int r = it - IT_WIN, nb = D / 32, kb = r / nb, n0 = 32 * (r % nb); transpose_item(a.in[I_WOUT], D, D, WOUTT, 64 * kb, n0, n0, scr, lane); }
            else { const int r = it - IT_WIN - IT_WOUT, nb = MODW / 32, kb = r / nb, n0 = 32 * (r % nb); transpose_item(a.in[I_ADAW], D, MODW, ADAT, 64 * kb, n0, n0, scr, lane); }
        }
        MID(1);
        for (int idx = bid * 512 + tid; idx < 3072 * 256; idx += G * 512) {
            const int n = idx >> 8, k = idx & 255, sec = n >> 10, nn = n & 1023; float v = 0.f;
            if (sec == 0 && k < 64) v = a.in[I_W2][k * RW + nn];
            else if (sec == 1 && k >= 64 && k < 128) v = a.in[I_A2][(k - 64) * RW + nn];
            else if (sec == 2 && k >= 128) v = a.in[I_G2][(k - 128) * RW + nn];
            LORAT[idx] = (bf16)f2bf(v);
        }
        for (int idx = bid * 512 + tid; idx < 256 * D; idx += G * 512) { const int r = idx / D, k = idx % D; float v = 0.f;
            if (r < NSEQ) { const float cv = r == 0 ? a.in[I_CP][k] : a.in[I_CS][(r - 1) * D + k]; v = cv * sigm(cv); }
            SC[idx] = (bf16)f2bf(v); }
        MID(2);
    }
    if (IN(0)) MID(3);
    SEAM(0);
    if (IN(1)) {
        { const int sl = bid / 48; pg8::Gemm g{(const bf16*)(ws + WS_SC) + sl * 512, (const bf16*)(ws + WS_ADAT) + sl * 512, 256, MODW, 512, D}; pg8::OneUnit S{0, bid % 48, bid < 192};
          EpiMod E{(float*)(ws + WS_MODP) + (size_t)sl * NSEQ * MODW, MODW};
          pg8::gemm_phase<EpiMod, pg8::OneUnit, false, true>((PG8_LAS unsigned char*)lds, g, S, E); }
        xcd_barrier(xb);
        const float* MODP = (const float*)(ws + WS_MODP);
        for (int idx = bid * 512 + tid; idx < NSEQ * MODW; idx += G * 512) { float v = a.in[I_ADAB][idx % MODW];
#pragma unroll
            for (int q = 0; q < 4; ++q) v += MODP[(size_t)q * NSEQ * MODW + idx];
            MOD[idx] = v; }
        xcd_barrier(xb);
    }
    if (IN(1)) for (int rep = 0; rep < (DUP_PHASE == 1 ? 2 : 1); ++rep) {
        for (int m = gw; m < M; m += NGW) {
            const float* xr = m < TP ? a.in[I_XP] + (size_t)m * D : a.in[I_XS] + (size_t)(m - TP) * D; const float* mod = MOD + seq_of(m) * MODW;
            f32x4 v[8]; float ss = 0.f;
#pragma unroll
            for (int j = 0; j < 8; ++j) { v[j] = *(const f32x4*)(xr + 4 * lane + 256 * j); ss += (v[j].x * v[j].x + v[j].y * v[j].y) + (v[j].z * v[j].z + v[j].w * v[j].w); }
            const float rs = rsqrtf(wave_sum(ss) * (1.f / D) + 1e-6f);
#pragma unroll
            for (int j = 0; j < 8; ++j) { const int c = 4 * lane + 256 * j; const f32x4 g = *(const f32x4*)(a.in[I_GPM] + c), s1 = *(const f32x4*)(mod + D + c), h1 = *(const f32x4*)(mod + c);
                const f32x4 h = v[j] * rs * g * (s1 + 1.f) + h1; u32x2 w; w.x = pk2(h.x, h.y); w.y = pk2(h.z, h.w); *(u32x2*)(H + (size_t)m * D + c) = w; }
        }
    }
    SEAM(1);
    if (IN(2)) for (int rep = 0; rep < (DUP_PHASE == 2 ? 2 : 1); ++rep) {
        pg8::Gemm g{H, WINT, M, IC, D, D}; pg8::StaticOrder S; S.init(M, IC, G, bid); EpiProj E{Z, QKVG};
        pg8::gemm_phase<EpiProj, pg8::StaticOrder, true, true>((PG8_LAS unsigned char*)lds, g, S, E);
    }
    SEAM(2);
    if (IN(3)) for (int rep = 0; rep < (DUP_PHASE == 3 ? 2 : 1); ++rep) {
        for (int idx = bid * 512 + tid; idx < M * 128; idx += G * 512) {
            const int m = idx >> 7, c2 = (idx & 127) * 2, c = 3072 + c2, tp = tpos_of(m), sq = seq_of(m);
            const unsigned zz = *(const unsigned*)(Z + (size_t)m * RC + c); float z0 = bf2f(zz & 0xffffu), z1 = bf2f(zz >> 16), p0 = 0.f, p1 = 0.f;
            if (tp > 0) { const unsigned pp = *(const unsigned*)(Z + (size_t)(m - 1) * RC + c); p0 = bf2f(pp & 0xffffu); p1 = bf2f(pp >> 16); }
            else if (sq > 0) { p0 = a.in[I_SSH][(size_t)(sq - 1) * RC + c]; p1 = a.in[I_SSH][(size_t)(sq - 1) * RC + c + 1]; }
            z0 = z0 + (p0 - z0) * a.in[I_MU][c]; z1 = z1 + (p1 - z1) * a.in[I_MU][c + 1];
            if (c2 < 64) { z0 = 1.f - 2.f / (__expf(2.f * z0) + 1.f); z1 = 1.f - 2.f / (__expf(2.f * z1) + 1.f); }
            else if (c2 >= 128) { z0 = sigm(z0); z1 = sigm(z1); }
            *(unsigned*)(LIN + (size_t)m * 256 + c2) = pk2(z0, z1);
        }
        for (int idx = bid * 512 + tid; idx < NSEQ * RC; idx += G * 512) { const int s = idx / RC, c = idx % RC; const int m = s == 0 ? TP - 1 : TP + 16 * (s - 1) + 15;
            out[(s == 0 ? O_SHP : O_SHS + (size_t)(s - 1) * RC) + c] = bf2f(Z[(size_t)m * RC + c]); }
    }
    SEAM(3);
    if (IN(4)) for (int rep = 0; rep < (DUP_PHASE == 4 ? 2 : 1); ++rep) {
        int k256 = 256; asm volatile("" : "+s"(k256));
        pg8::Gemm g{LIN, LORAT, M, 3072, k256, k256}; pg8::StaticOrder S; S.init(M, 3072, G, bid); EpiBf16P E{LOUT, 3072};
        pg8::gemm_phase<EpiBf16P, pg8::StaticOrder, true, true>((PG8_LAS unsigned char*)lds, g, S, E);
    }
    SEAM(4);
    if (IN(5)) for (int rep = 0; rep < (DUP_PHASE == 5 ? 2 : 1); ++rep) {
        float* prm = (float*)lds;
        __syncthreads();
        for (int idx = tid; idx < RW; idx += 512) { prm[idx] = a.in[I_MU][idx]; prm[RW + idx] = a.in[I_MU][RW + idx]; prm[2 * RW + idx] = a.in[I_MU][2 * RW + idx]; prm[3 * RW + idx] = a.in[I_W0][idx];
            prm[4 * RW + idx] = a.in[I_A0][idx]; prm[5 * RW + idx] = a.in[I_KK][idx]; prm[6 * RW + idx] = a.in[I_KA][idx]; prm[7 * RW + idx] = a.in[I_RK][idx]; }
        __syncthreads();
        for (int m = gw; m < M; m += NGW) {
            const int tp = tpos_of(m), sq = seq_of(m);
#pragma unroll 1
            for (int hp = 0; hp < 2; ++hp) {
                const int hd = hp * 8 + (lane >> 3), c0 = hd * 64 + (lane & 7) * 8;
                const bf16* zr = Z + (size_t)m * RC + c0; const bf16* lr = LOUT + (size_t)m * 3072 + c0; const float* sh0 = a.in[I_SSH] + (size_t)(sq > 0 ? sq - 1 : 0) * RC + c0;
                float zs[3][8];
#pragma unroll
                for (int q = 0; q < 3; ++q) {
                    const u32x4 ca = *(const u32x4*)(zr + q * RW); float pv[8];
                    if (tp > 0) { const u32x4 pa2 = *(const u32x4*)(zr - RC + q * RW);
#pragma unroll
                        for (int e = 0; e < 4; ++e) { pv[2 * e] = bf2f(pa2[e] & 0xffffu); pv[2 * e + 1] = bf2f(pa2[e] >> 16); } }
                    else if (sq > 0) { const f32x4 f0 = *(const f32x4*)(sh0 + q * RW), f1 = *(const f32x4*)(sh0 + q * RW + 4);
                        pv[0] = f0.x; pv[1] = f0.y; pv[2] = f0.z; pv[3] = f0.w; pv[4] = f1.x; pv[5] = f1.y; pv[6] = f1.z; pv[7] = f1.w; }
                    else {
#pragma unroll
                        for (int e = 0; e < 8; ++e) pv[e] = 0.f; }
                    const float* mu = prm + q * RW + c0;
#pragma unroll
                    for (int e = 0; e < 4; ++e) { const float z0 = bf2f(ca[e] & 0xffffu), z1 = bf2f(ca[e] >> 16);
                        zs[q][2 * e] = z0 + (pv[2 * e] - z0) * mu[2 * e]; zs[q][2 * e + 1] = z1 + (pv[2 * e + 1] - z1) * mu[2 * e + 1]; }
                }
                const u32x4 wa = *(const u32x4*)(lr), aa = *(const u32x4*)(lr + RW), ga = *(const u32x4*)(lr + 2 * RW);
                float wv[8], av[8], kkv[8], k2[8]; float s1 = 0.f, s2 = 0.f;
#pragma unroll
                for (int e = 0; e < 8; ++e) {
                    const float lwv = bf2f((e & 1) ? (wa[e >> 1] >> 16) : (wa[e >> 1] & 0xffffu)), lav = bf2f((e & 1) ? (aa[e >> 1] >> 16) : (aa[e >> 1] & 0xffffu));
                    wv[e] = __expf(-0.6065306597126334f * sigm(prm[3 * RW + c0 + e] + lwv));
                    av[e] = sigm(prm[4 * RW + c0 + e] + lav);
                    kkv[e] = zs[1][e] * prm[5 * RW + c0 + e]; s1 += kkv[e] * kkv[e];
                    k2[e] = zs[1][e] * (1.f + (av[e] - 1.f) * prm[6 * RW + c0 + e]); s2 += zs[0][e] * k2[e] * prm[7 * RW + c0 + e];
                }
                s1 += DPPF(0.f, s1, 0xB1, 0xF); s1 += DPPF(0.f, s1, 0x4E, 0xF); s1 += DPPF(0.f, s1, 0x141, 0xF);
                s2 += DPPF(0.f, s2, 0xB1, 0xF); s2 += DPPF(0.f, s2, 0x4E, 0xF); s2 += DPPF(0.f, s2, 0x141, 0xF);
                const float inrm = 1.f / fmaxf(sqrtf(s1), 1e-12f);
                const size_t o = (size_t)m * RW + c0;
#pragma unroll
                for (int e = 0; e < 2; ++e) {
                    const float k0 = kkv[4 * e] * inrm, k1 = kkv[4 * e + 1] * inrm, k2_ = kkv[4 * e + 2] * inrm, k3 = kkv[4 * e + 3] * inrm;
                    *(f32x4*)(PW + o + 4 * e) = (f32x4){wv[4 * e], wv[4 * e + 1], wv[4 * e + 2], wv[4 * e + 3]};
                    *(f32x4*)(PNKK + o + 4 * e) = (f32x4){-k0, -k1, -k2_, -k3};
                    *(f32x4*)(PB + o + 4 * e) = (f32x4){k0 * av[4 * e], k1 * av[4 * e + 1], k2_ * av[4 * e + 2], k3 * av[4 * e + 3]};
                    *(f32x4*)(PK + o + 4 * e) = (f32x4){k2[4 * e], k2[4 * e + 1], k2[4 * e + 2], k2[4 * e + 3]};
                    *(f32x4*)(PR + o + 4 * e) = (f32x4){zs[0][4 * e], zs[0][4 * e + 1], zs[0][4 * e + 2], zs[0][4 * e + 3]};
                }
                { u32x4 va;
#pragma unroll
                  for (int e = 0; e < 4; ++e) va[e] = pk2(zs[2][2 * e], zs[2][2 * e + 1]);
                  *(u32x4*)(PV + o) = va; *(u32x4*)(PG + o) = ga; }
                if ((lane & 7) == 0) BON[m * 16 + hd] = s2;
            }
        }
    }
    SEAM(5);
    if (IN(6)) for (int rep = 0; rep < (DUP_PHASE == 6 ? 2 : 1); ++rep) {
        MID(4);
        {
            float* wl = (float*)lds + wave * RL<0>::BUF;
            for (int task = gw; task < RH * NCH * 2; task += NGW) {
                const int part = task & 1, pair = task >> 1, h = pair / NCH, c = pair % NCH; const size_t o = (size_t)(c * LCH) * RW + h * 64;
                f32x2 S[32];
                if (part) {
#pragma unroll
                    for (int j = 0; j < 32; ++j) { S[j].x = (2 * j == lane) ? 1.f : 0.f; S[j].y = (2 * j + 1 == lane) ? 1.f : 0.f; }
                    rwkv_lds<1>(S, PW + o, PNKK + o, PB + o, PK + o, PR + o, PV + o, LCH, lane, nullptr, nullptr, nullptr, 0.f, 0.f, wl);
                } else {
#pragma unroll
                    for (int j = 0; j < 32; ++j) S[j] = (f32x2){0.f, 0.f};
                    rwkv_lds<0>(S, PW + o, PNKK + o, PB + o, PK + o, PR + o, PV + o, LCH, lane, nullptr, nullptr, nullptr, 0.f, 0.f, wl);
                }
                float* dst = PU + ((size_t)pair * 2 + (part ? 0 : 1)) * 4096 + lane * 64;
#pragma unroll
                for (int j = 0; j < 16; ++j) *(f32x4*)(dst + 4 * j) = (f32x4){S[2 * j].x, S[2 * j].y, S[2 * j + 1].x, S[2 * j + 1].y};
            }
        }
        __syncthreads();
        MID(5);
        bf16* kT = (bf16*)lds;
        bf16* vT = (bf16*)lds + 256 * 72;
        const int fr = lane & 15, fq = lane >> 4;
        for (int it = bid; it < EH * NRB * 2; it += G) {
            const int half = it & 1, blk = (it >> 1) % NRB, h = (it >> 1) / NRB; const float l2g = ret_l2g(h); const int m0 = blk * RBLK;
            f32x4 acc[2][8];
#pragma unroll
            for (int x = 0; x < 2; ++x)
#pragma unroll
                for (int y = 0; y < 8; ++y) acc[x][y] = (f32x4){0.f, 0.f, 0.f, 0.f};
            for (int ts = 0; ts < 4; ++ts) {
                __syncthreads();
#pragma unroll
                for (int i = 0; i < 4; ++i) { const int t = lane, dp = wave + 8 * i; const u32x4 raw = *(const u32x4*)(QKVG + (size_t)(m0 + ts * 64 + t) * EC + 1024 + h * 256 + dp * 8);
                    const float dec = exp2f(l2g * (float)(255 - (ts * 64 + t)));
#pragma unroll
                    for (int e = 0; e < 4; ++e) { const unsigned w = raw[e]; kT[(dp * 8 + 2 * e) * 72 + t] = (bf16)f2bf(bf2f(w & 0xffffu) * dec); kT[(dp * 8 + 2 * e + 1) * 72 + t] = (bf16)f2bf(bf2f(w >> 16) * dec); } }
#pragma unroll
                for (int i = 0; i < 2; ++i) { const int t = lane, ep = wave + 8 * i; const u32x4 raw = *(const u32x4*)(QKVG + (size_t)(m0 + ts * 64 + t) * EC + 2048 + h * 256 + half * 128 + ep * 8);
#pragma unroll
                    for (int e = 0; e < 4; ++e) { const unsigned w = raw[e]; vT[(ep * 8 + 2 * e) * 72 + t] = (bf16)(w & 0xffffu); vT[(ep * 8 + 2 * e + 1) * 72 + t] = (bf16)(w >> 16); } }
                __syncthreads();
#pragma unroll
                for (int kk = 0; kk < 2; ++kk) { bf16x8 af[2];
#pragma unroll
                    for (int x = 0; x < 2; ++x) af[x] = *(const bf16x8*)(kT + (32 * wave + 16 * x + fr) * 72 + kk * 32 + fq * 8);
#pragma unroll
                    for (int y = 0; y < 8; ++y) { const bf16x8 bfm = *(const bf16x8*)(vT + (16 * y + fr) * 72 + kk * 32 + fq * 8);
#pragma unroll
                        for (int x = 0; x < 2; ++x) acc[x][y] = __builtin_amdgcn_mfma_f32_16x16x32_bf16(af[x], bfm, acc[x][y], 0, 0, 0); } }
            }
            bf16* dst = KVB + ((size_t)(h * NRB + blk) * 256) * 256;
#pragma unroll
            for (int x = 0; x < 2; ++x)
#pragma unroll
                for (int y = 0; y < 8; ++y) { u32x2 w; w.x = pk2(acc[x][y][0], acc[x][y][1]); w.y = pk2(acc[x][y][2], acc[x][y][3]);
                    *(u32x2*)(dst + (size_t)(half * 128 + 16 * y + fr) * 256 + 32 * wave + 16 * x + fq * 4) = w; }
        }
    }
    if (IN(6)) MID(6);
    SEAM(6);
    if (IN(7)) for (int rep = 0; rep < (DUP_PHASE == 7 ? 2 : 1); ++rep) {
        const int nB = RH * 4;
        if (bid < nB || G <= nB) {
            float* Sb = (float*)lds;
            float* Pb = (float*)lds + 1024;
            for (int it = bid; it < nB; it += G) {
                const int h = it >> 2, g4 = it & 3, i = tid >> 5, j0 = (tid & 31) * 2; const float* pu = PU + (size_t)(h * NCH) * 2 * 4096;
                __syncthreads();
                { const f32x4* src = (const f32x4*)pu; ((f32x4*)Pb)[tid] = src[tid]; ((f32x4*)Pb)[tid + 512] = src[tid + 512]; }
                f32x2 s = {0.f, 0.f};
                f32x2 u = *(const f32x2*)(pu + 4096 + (16 * g4 + i) * 64 + j0);
                for (int c = 0; c < NCH; ++c) {
                    float* Pc = Pb + (c & 1) * 4096; float* Pn = Pb + ((c + 1) & 1) * 4096;
                    *(f32x2*)(Sb + i * 64 + j0) = s;
                    __syncthreads();
                    f32x4 n0 = {0.f, 0.f, 0.f, 0.f}, n1 = n0; f32x2 un = {0.f, 0.f};
                    if (c + 1 < NCH) { const float* pn = pu + (size_t)(c + 1) * 2 * 4096; n0 = ((const f32x4*)pn)[tid]; n1 = ((const f32x4*)pn)[tid + 512]; un = *(const f32x2*)(pn + 4096 + (16 * g4 + i) * 64 + j0); }
                    f32x2 acc = u;
#pragma unroll 8
                    for (int k = 0; k < 64; ++k) { const float sk = Sb[i * 64 + k]; const f32x2 p = *(const f32x2*)(Pc + k * 64 + j0); acc += p * sk; }
                    s = acc;
                    *(f32x2*)((float*)pu + (size_t)c * 2 * 4096 + 4096 + (16 * g4 + i) * 64 + j0) = s;
                    ((f32x4*)Pn)[tid] = n0; ((f32x4*)Pn)[tid + 512] = n1; u = un;
                    __syncthreads();
                }
                *(f32x2*)(out + O_WKP + (size_t)h * 4096 + (16 * g4 + i) * 64 + j0) = s;
            }
        }
        if (bid >= nB || G <= nB) {
            const int nb2 = G <= nB ? G : G - nB, b2 = G <= nB ? bid : bid - nB;
            for (int it = b2 * 512 + tid; it < EH * 256 * 32; it += nb2 * 512) {
                const int h = it >> 13, e = (it >> 5) & 255, d0 = (it & 31) * 8; const float g256 = exp2f(256.f * ret_l2g(h));
                float acc[8];
#pragma unroll
                for (int q = 0; q < 8; ++q) acc[q] = 0.f;
                for (int blk = 0; blk < NRB; ++blk) {
                    const size_t o = ((size_t)(h * NRB + blk) * 256 + e) * 256 + d0;
                    u32x4 w; w.x = pk2(acc[0], acc[1]); w.y = pk2(acc[2], acc[3]); w.z = pk2(acc[4], acc[5]); w.w = pk2(acc[6], acc[7]); *(u32x4*)(SPREV + o) = w;
                    const u32x4 kv = *(const u32x4*)(KVB + o);
#pragma unroll
                    for (int q = 0; q < 4; ++q) { acc[2 * q] = acc[2 * q] * g256 + bf2f(kv[q] & 0xffffu); acc[2 * q + 1] = acc[2 * q + 1] * g256 + bf2f(kv[q] >> 16); }
                }
#pragma unroll
                for (int q = 0; q < 8; ++q) out[O_RTP + (size_t)h * 65536 + (size_t)(d0 + q) * 256 + e] = acc[q];
            }
        }
    }
    if (IN(7)) MID(10);
    SEAM(7);
    if (IN(8)) for (int rep = 0; rep < (DUP_PHASE == 8 ? 2 : 1); ++rep) {
        MID(7);
        if (wave < 5) {
            float* wl = (float*)lds + wave * RL<2>::BUF;
            const int ntask = wave < 4 ? RH * NCH : NB * RH;
            for (int task = wave < 4 ? bid * 4 + wave : bid; task < ntask; task += (wave < 4 ? G * 4 : G)) {
                f32x2 S[32]; int h, m0, nsteps; float* sdst = nullptr;
                if (wave < 4) { h = task / NCH; const int c = task % NCH; m0 = c * LCH; nsteps = LCH;
                    if (c == 0) {
#pragma unroll
                        for (int j = 0; j < 32; ++j) S[j] = (f32x2){0.f, 0.f};
                    } else { const float* src = PU + ((size_t)(h * NCH + c - 1) * 2 + 1) * 4096 + lane * 64;
#pragma unroll
                        for (int j = 0; j < 16; ++j) { const f32x4 q = *(const f32x4*)(src + 4 * j); S[2 * j] = (f32x2){q.x, q.y}; S[2 * j + 1] = (f32x2){q.z, q.w}; } }
                } else { const int b = task / RH; h = task % RH; m0 = TP + 16 * b; nsteps = TS;
                    const float* src = a.in[I_SWKV] + ((size_t)(b * RH + h) * 64 + lane) * 64; sdst = out + O_WKS + ((size_t)(b * RH + h) * 64 + lane) * 64;
#pragma unroll
                    for (int j = 0; j < 16; ++j) { const f32x4 q = *(const f32x4*)(src + 4 * j); S[2 * j] = (f32x2){q.x, q.y}; S[2 * j + 1] = (f32x2){q.z, q.w}; } }
                const size_t o = (size_t)m0 * RW + h * 64;
                rwkv_lds<2>(S, PW + o, PNKK + o, PB + o, PK + o, PR + o, PV + o, nsteps, lane, PG + o, BON + (size_t)m0 * 16 + h, MIX + (size_t)m0 * D + h * 64,
                            a.in[I_RLW][h * 64 + lane], a.in[I_RLB][h * 64 + lane], wl);
                if (sdst) {
#pragma unroll
                    for (int j = 0; j < 16; ++j) *(f32x4*)(sdst + 4 * j) = (f32x4){S[2 * j].x, S[2 * j].y, S[2 * j + 1].x, S[2 * j + 1].y}; }
            }
        }
        MID(8);
        {
            const int nb2 = G, b2 = bid;
            const int fr = lane & 15, fq = lane >> 4;
            for (int it = b2; it < EH * (TP / 64) + NB * EH; it += nb2) {
                __syncthreads();
#ifndef NO_RP
                if (it < EH * (TP / 64)) {
                    const int h = it / (TP / 64), n = it % (TP / 64), blk = n >> 2, i = n & 3, m0 = n * 64; const float l2g = ret_l2g(h);
                    bf16* qL = (bf16*)lds; bf16* kL = qL + 64 * 264; bf16* vT = kL + 64 * 264; bf16* pL = vT + 256 * 72; float* red = (float*)(pL + 64 * 72);
#pragma unroll
                    for (int x = 0; x < 4; ++x) { const int p = tid + 512 * x, t = p >> 5, dp = p & 31; *(u32x4*)(qL + t * 264 + dp * 8) = *(const u32x4*)(QKVG + (size_t)(m0 + t) * EC + h * 256 + dp * 8); }
                    __syncthreads();
                    f32x4 acc[4][2];
#pragma unroll
                    for (int x = 0; x < 4; ++x)
#pragma unroll
                        for (int y = 0; y < 2; ++y) acc[x][y] = (f32x4){0.f, 0.f, 0.f, 0.f};
                    if (blk > 0) {
                        const bf16* sp = SPREV + ((size_t)(h * NRB + blk) * 256) * 256;
#pragma unroll 2
                        for (int kk = 0; kk < 8; ++kk) { bf16x8 bfm[2];
#pragma unroll
                            for (int y = 0; y < 2; ++y) bfm[y] = *(const bf16x8*)(sp + (size_t)(32 * wave + 16 * y + fr) * 256 + kk * 32 + fq * 8);
#pragma unroll
                            for (int x = 0; x < 4; ++x) { const bf16x8 af = *(const bf16x8*)(qL + (16 * x + fr) * 264 + kk * 32 + fq * 8);
#pragma unroll
                                for (int y = 0; y < 2; ++y) acc[x][y] = __builtin_amdgcn_mfma_f32_16x16x32_bf16(af, bfm[y], acc[x][y], 0, 0, 0); } }
#pragma unroll
                        for (int x = 0; x < 4; ++x)
#pragma unroll
                            for (int jj = 0; jj < 4; ++jj) { const float qd = exp2f(l2g * (float)(64 * i + 16 * x + fq * 4 + jj + 1)); acc[x][0][jj] *= qd; acc[x][1][jj] *= qd; }
                    }
                    for (int j = 0; j <= i; ++j) {
                        __syncthreads();
                        const int ms = (blk * 4 + j) * 64;
#pragma unroll
                        for (int x = 0; x < 4; ++x) { const int p = tid + 512 * x, t = p >> 5, dp = p & 31;
                            *(u32x4*)(kL + t * 264 + dp * 8) = *(const u32x4*)(QKVG + (size_t)(ms + t) * EC + 1024 + h * 256 + dp * 8); }
#pragma unroll
                        for (int x = 0; x < 4; ++x) { const int t = lane, dp = wave + 8 * x;
                            const u32x4 raw = *(const u32x4*)(QKVG + (size_t)(ms + t) * EC + 2048 + h * 256 + dp * 8);
#pragma unroll
                            for (int e = 0; e < 4; ++e) { const unsigned w = raw[e]; vT[(dp * 8 + 2 * e) * 72 + t] = (bf16)(w & 0xffffu); vT[(dp * 8 + 2 * e + 1) * 72 + t] = (bf16)(w >> 16); } }
                        __syncthreads();
                        { const int tr = wave >> 1, tc0 = (wave & 1) * 2; f32x4 sa[2] = {(f32x4){0.f, 0.f, 0.f, 0.f}, (f32x4){0.f, 0.f, 0.f, 0.f}};
#pragma unroll
                            for (int kk = 0; kk < 8; ++kk) { const bf16x8 af = *(const bf16x8*)(qL + (16 * tr + fr) * 264 + kk * 32 + fq * 8);
#pragma unroll
                                for (int y = 0; y < 2; ++y) { const bf16x8 bfm = *(const bf16x8*)(kL + (16 * (tc0 + y) + fr) * 264 + kk * 32 + fq * 8); sa[y] = __builtin_amdgcn_mfma_f32_16x16x32_bf16(af, bfm, sa[y], 0, 0, 0); } }
#pragma unroll
                            for (int y = 0; y < 2; ++y)
#pragma unroll
                                for (int jj = 0; jj < 4; ++jj) { const int t = 16 * tr + fq * 4 + jj, s = 16 * (tc0 + y) + fr; const int dist = (j < i) ? 64 * (i - j) + t - s : (t > s ? t - s : s - t);
                                    pL[t * 72 + s] = (bf16)f2bf(sa[y][jj] * exp2f(l2g * (float)dist)); } }
                        __syncthreads();
#pragma unroll
                        for (int kk = 0; kk < 2; ++kk) { bf16x8 bfm[2];
#pragma unroll
                            for (int y = 0; y < 2; ++y) bfm[y] = *(const bf16x8*)(vT + (32 * wave + 16 * y + fr) * 72 + kk * 32 + fq * 8);
#pragma unroll
                            for (int x = 0; x < 4; ++x) { const bf16x8 af = *(const bf16x8*)(pL + (16 * x + fr) * 72 + kk * 32 + fq * 8);
#pragma unroll
                                for (int y = 0; y < 2; ++y) acc[x][y] = __builtin_amdgcn_mfma_f32_16x16x32_bf16(af, bfm[y], acc[x][y], 0, 0, 0); } }
                    }
#pragma unroll
                    for (int x = 0; x < 4; ++x)
#pragma unroll
                        for (int jj = 0; jj < 4; ++jj) { float s1 = acc[x][0][jj] + acc[x][1][jj], s2 = acc[x][0][jj] * acc[x][0][jj] + acc[x][1][jj] * acc[x][1][jj];
#pragma unroll
                            for (int o = 1; o < 16; o <<= 1) { s1 += __shfl_xor(s1, o); s2 += __shfl_xor(s2, o); }
                            if (fr == 0) { const int t = 16 * x + fq * 4 + jj; red[(t * 8 + wave) * 2] = s1; red[(t * 8 + wave) * 2 + 1] = s2; } }
                    __syncthreads();
                    float lw[2], lb[2];
#pragma unroll
                    for (int y = 0; y < 2; ++y) { lw[y] = a.in[I_ELW][h * 256 + 32 * wave + 16 * y + fr]; lb[y] = a.in[I_ELB][h * 256 + 32 * wave + 16 * y + fr]; }
#pragma unroll
                    for (int x = 0; x < 4; ++x)
#pragma unroll
                        for (int jj = 0; jj < 4; ++jj) { const int t = 16 * x + fq * 4 + jj; float s1 = 0.f, s2 = 0.f;
#pragma unroll
                            for (int w8 = 0; w8 < 8; ++w8) { s1 += red[(t * 8 + w8) * 2]; s2 += red[(t * 8 + w8) * 2 + 1]; }
                            const float mean = s1 * (1.f / 256.f), var = s2 * (1.f / 256.f) - mean * mean, rstd = rsqrtf(var + 1e-5f);
#pragma unroll
                            for (int y = 0; y < 2; ++y) { const int e = 32 * wave + 16 * y + fr; const float gt = bf2f(QKVG[(size_t)(m0 + t) * EC + 3072 + h * 256 + e]);
                                const float val = ((acc[x][y][jj] - mean) * rstd * lw[y] + lb[y]) * gt * sigm(gt);
                                MIX[(size_t)(m0 + t) * D + RW + h * 256 + e] = (bf16)f2bf(val); } }
                } else
#endif
#ifndef NO_RS
                {
                    const int r = it - EH * (TP / 64), b = r / EH, h = r % EH, m0 = TP + 16 * b; const float l2g = ret_l2g(h);
                    float* qf = (float*)lds; float* kf = qf + 16 * 257; float* vf = kf + 16 * 257; float* pf = vf + 16 * 257; float* red = pf + 256;
                    for (int idx = tid; idx < 16 * 256; idx += 512) { const int t = idx >> 8, dd = idx & 255; const bf16* src = QKVG + (size_t)(m0 + t) * EC + h * 256 + dd;
                        qf[t * 257 + dd] = bf2f(src[0]); kf[t * 257 + dd] = bf2f(src[1024]); vf[t * 257 + dd] = bf2f(src[2048]); }
                    __syncthreads();
                    if (tid < 256) { const int t = tid >> 4, s = tid & 15; float sc = 0.f;
#pragma unroll 4
                        for (int dd = 0; dd < 256; ++dd) sc += qf[t * 257 + dd] * kf[s * 257 + dd];
                        pf[t * 16 + s] = sc * exp2f(l2g * (float)(t > s ? t - s : s - t)); }
                    __syncthreads();
                    const int e = tid & 255, th = tid >> 8; const float* S0 = a.in[I_SRET] + (size_t)(b * EH + h) * 65536;
                    float oc[8];
#pragma unroll
                    for (int tt = 0; tt < 8; ++tt) oc[tt] = 0.f;
#pragma unroll 2
                    for (int dd = 0; dd < 256; ++dd) { const float s0 = S0[(size_t)dd * 256 + e];
#pragma unroll
                        for (int tt = 0; tt < 8; ++tt) oc[tt] += qf[(th * 8 + tt) * 257 + dd] * s0; }
#pragma unroll
                    for (int tt = 0; tt < 8; ++tt) { const int t = th * 8 + tt; float v = oc[tt] * exp2f(l2g * (float)(t + 1));
#pragma unroll 4
                        for (int s = 0; s < 16; ++s) v += pf[t * 16 + s] * vf[s * 257 + e];
                        oc[tt] = v; }
                    { const float g16 = exp2f(16.f * l2g); float* dst = out + O_RTS + (size_t)(b * EH + h) * 65536; float vd[16];
#pragma unroll
                        for (int t = 0; t < 16; ++t) vd[t] = vf[t * 257 + e] * exp2f(l2g * (float)(15 - t));
#pragma unroll 2
                        for (int dd = th * 128; dd < th * 128 + 128; ++dd) { float v = g16 * S0[(size_t)dd * 256 + e];
#pragma unroll
                            for (int t = 0; t < 16; ++t) v += kf[t * 257 + dd] * vd[t];
                            dst[(size_t)dd * 256 + e] = v; } }
#pragma unroll
                    for (int tt = 0; tt < 8; ++tt) { const float s1 = wave_sum(oc[tt]), s2 = wave_sum(oc[tt] * oc[tt]); if (lane == 0) { const int t = th * 8 + tt; red[(t * 4 + (wave & 3)) * 2] = s1; red[(t * 4 + (wave & 3)) * 2 + 1] = s2; } }
                    __syncthreads();
                    const float lw = a.in[I_ELW][h * 256 + e], lb = a.in[I_ELB][h * 256 + e];
#pragma unroll
                    for (int tt = 0; tt < 8; ++tt) { const int t = th * 8 + tt; float s1 = 0.f, s2 = 0.f;
#pragma unroll
                        for (int w4 = 0; w4 < 4; ++w4) { s1 += red[(t * 4 + w4) * 2]; s2 += red[(t * 4 + w4) * 2 + 1]; }
                        const float mean = s1 * (1.f / 256.f), var = s2 * (1.f / 256.f) - mean * mean, rstd = rsqrtf(var + 1e-5f);
                        const float gt = bf2f(QKVG[(size_t)(m0 + t) * EC + 3072 + h * 256 + e]);
                        MIX[(size_t)(m0 + t) * D + RW + h * 256 + e] = (bf16)f2bf(((oc[tt] - mean) * rstd * lw + lb) * gt * sigm(gt)); }
                }
#else
                {}
#endif
            }
        }
    }
    if (IN(8)) MID(9);
    SEAM(8);
    if (IN(9)) for (int rep = 0; rep < (DUP_PHASE == 9 ? 2 : 1); ++rep) {
        { pg8::Gemm g{MIX, WOUTT, TP, D, D, D}; pg8::StaticOrder S; S.init(TP, D, G, bid); EpiF32 E{MIXOUT, D};
          pg8::gemm_phase<EpiF32, pg8::StaticOrder, true, true>((PG8_LAS unsigned char*)lds, g, S, E); }
        { const int sl = bid >> 3; pg8::Gemm g{MIX + (size_t)TP * D + sl * 512, WOUTT + sl * 512, MS, D, 512, D}; pg8::OneUnit S{0, bid & 7, bid < 8 * KS9}; EpiF32 E{(float*)(ws + WS_PART9) + (size_t)sl * MS * D, D};
          pg8::gemm_phase<EpiF32, pg8::OneUnit, false, true>((PG8_LAS unsigned char*)lds, g, S, E); }
    }
    SEAM(9);
    if (IN(10)) for (int rep = 0; rep < (DUP_PHASE == 10 ? 2 : 1); ++rep) {
        for (int m = gw; m < M; m += NGW) {
            const float* xr = m < TP ? a.in[I_XP] + (size_t)m * D : a.in[I_XS] + (size_t)(m - TP) * D; const float* mod = MOD + seq_of(m) * MODW; const float* mr = MIXOUT + (size_t)m * D;
            f32x4 v[8]; float ss = 0.f;
#pragma unroll
            for (int j = 0; j < 8; ++j) {
                if (m < TP) v[j] = *(const f32x4*)(mr + 4 * lane + 256 * j);
                else { const float* pr = (const float*)(ws + WS_PART9) + (size_t)(m - TP) * D + 4 * lane + 256 * j; v[j] = *(const f32x4*)pr;
#pragma unroll
                    for (int q = 1; q < KS9; ++q) v[j] += *(const f32x4*)(pr + (size_t)q * MS * D); }
                ss += (v[j].x * v[j].x + v[j].y * v[j].y) + (v[j].z * v[j].z + v[j].w * v[j].w); }
            const float rs = rsqrtf(wave_sum(ss) * (1.f / D) + 1e-6f); float s2 = 0.f;
#pragma unroll
            for (int j = 0; j < 8; ++j) { const int c = 4 * lane + 256 * j; const f32x4 g = *(const f32x4*)(a.in[I_GPOM] + c), gt = *(const f32x4*)(mod + 2 * D + c), x = *(const f32x4*)(xr + c);
                v[j] = x + gt * (v[j] * rs * g); *(f32x4*)(out + (size_t)m * D + c) = v[j]; s2 += (v[j].x * v[j].x + v[j].y * v[j].y) + (v[j].z * v[j].z + v[j].w * v[j].w); }
            const float rs2 = rsqrtf(wave_sum(s2) * (1.f / D) + 1e-6f);
#pragma unroll
            for (int j = 0; j < 8; ++j) { const int c = 4 * lane + 256 * j; const f32x4 g = *(const f32x4*)(a.in[I_GPF] + c), s1 = *(const f32x4*)(mod + 4 * D + c), h1 = *(const f32x4*)(mod + 3 * D + c);
                const f32x4 h = v[j] * rs2 * g * (s1 + 1.f) + h1; u32x2 w; w.x = pk2(h.x, h.y); w.y = pk2(h.z, h.w); *(u32x2*)(H + (size_t)m * D + c) = w; }
        }
        float* scr = (float*)lds + wave * (64 * 33 + 16);
        constexpr int IT_UP = (D / 64) * (2 * FF / 32), IT_DN = (FF / 64) * (D / 32);
        for (int it = gw; it < IT_UP + IT_DN; it += NGW) {
            if (it < IT_UP) { const int nb = 2 * FF / 32, kb = it / nb, n0 = 32 * (it % nb); const int nn = n0 < FF ? n0 : n0 - FF; const int dr = 256 * (nn >> 7) + (n0 < FF ? 0 : 128) + (nn & 127);
                transpose_item(a.in[I_WUP], D, 2 * FF, WUPT, 64 * kb, n0, dr, scr, lane); }
            else { const int r = it - IT_UP, nb = D / 32, kb = r / nb, n0 = 32 * (r % nb); transpose_item(a.in[I_WDN], FF, D, WDNT, 64 * kb, n0, n0, scr, lane); }
        }
    }
    SEAM(10);
    if (IN(11)) for (int rep = 0; rep < (DUP_PHASE == 11 ? 2 : 1); ++rep) {
        pg8::Gemm g{H, WUPT, M, 2 * FF, D, D}; pg8::StaticOrder S; S.init(M, 2 * FF, G, bid); EpiSwiglu E{ACT};
        pg8::gemm_phase<EpiSwiglu, pg8::StaticOrder, true, true>((PG8_LAS unsigned char*)lds, g, S, E);
    }
    SEAM(11);
    if (IN(12)) for (int rep = 0; rep < (DUP_PHASE == 12 ? 2 : 1); ++rep) {
        { pg8::Gemm g{ACT, WDNT, TP, D, FF, FF}; pg8::StaticOrder S; S.init(TP, D, G, bid); EpiF32 E{MIXOUT, D};
          pg8::gemm_phase<EpiF32, pg8::StaticOrder, true, true>((PG8_LAS unsigned char*)lds, g, S, E); }
        { const int sl = bid >> 3; pg8::Gemm g{ACT + (size_t)TP * FF + sl * 512, WDNT + sl * 512, MS, D, 512, FF}; pg8::OneUnit S{0, bid & 7, bid < 8 * KS12}; EpiF32 E{(float*)(ws + WS_PART12) + (size_t)sl * MS * D, D};
          pg8::gemm_phase<EpiF32, pg8::OneUnit, false, true>((PG8_LAS unsigned char*)lds, g, S, E); }
    }
    SEAM(12);
    if (IN(13)) for (int rep = 0; rep < (DUP_PHASE == 13 ? 2 : 1); ++rep) {
        for (int m = gw; m < M; m += NGW) {
            const float* mod = MOD + seq_of(m) * MODW; const float* fr_ = MIXOUT + (size_t)m * D;
            f32x4 v[8]; float ss = 0.f;
#pragma unroll
            for (int j = 0; j < 8; ++j) {
                if (m < TP) v[j] = *(const f32x4*)(fr_ + 4 * lane + 256 * j);
                else { const float* pr = (const float*)(ws + WS_PART12) + (size_t)(m - TP) * D + 4 * lane + 256 * j; v[j] = *(const f32x4*)pr;
#pragma unroll
                    for (int q = 1; q < KS12; ++q) v[j] += *(const f32x4*)(pr + (size_t)q * MS * D); }
                ss += (v[j].x * v[j].x + v[j].y * v[j].y) + (v[j].z * v[j].z + v[j].w * v[j].w); }
            const float rs = rsqrtf(wave_sum(ss) * (1.f / D) + 1e-6f);
#pragma unroll
            for (int j = 0; j < 8; ++j) { const int c = 4 * lane + 256 * j; const f32x4 g = *(const f32x4*)(a.in[I_GPOF] + c), gt = *(const f32x4*)(mod + 5 * D + c), x = *(const f32x4*)(out + (size_t)m * D + c);
                *(f32x4*)(out + (size_t)m * D + c) = x + gt * (v[j] * rs * g); }
        }
    }
    if (TS_PROBE >= 0) {
        xcd_barrier(xb);
        if (bid == 0 && tid == 0) TSW[14] = __builtin_amdgcn_s_memrealtime();
        if (bid == 0) { __syncthreads(); const float us = TS_PROBE >= 100 ? (float)(TSW[32 + TS_PROBE - 100] - TSW[32 + TS_PROBE - 101]) * 0.01f : (float)(TSW[1 + TS_PROBE] - TSW[TS_PROBE]) * 0.01f; const float eps = sqrtf(us * 1e-4f);
            for (int c = tid; c < RC; c += 512) out[O_SHP + c] *= (1.f + eps); }
    }
#undef IN
#undef SEAM
}

extern "C" void kernel_launch(void* const* d_in, const int* in_sizes, int n_in, void* d_out, int out_size, void* d_ws, size_t ws_size, hipStream_t stream) {
    static int grid = 0;
    if (grid == 0) {
        if (n_in != 30 || (size_t)out_size != O_END || ws_size < WS_END) { fprintf(stderr, "kernel_launch: unexpected sizes n_in %d out %d ws %zu\n", n_in, out_size, ws_size); grid = -1; return; }
        int dev = 0, cus = 0, per_cu = 0;
        (void)hipGetDevice(&dev); (void)hipDeviceGetAttribute(&cus, hipDeviceAttributeMultiprocessorCount, dev);
        if (hipFuncSetAttribute((const void*)mk_fwd, hipFuncAttributeMaxDynamicSharedMemorySize, LDS_BYTES) != hipSuccess) { fprintf(stderr, "kernel_launch: hipFuncSetAttribute failed\n"); grid = -1; return; }
        if (hipOccupancyMaxActiveBlocksPerMultiprocessor(&per_cu, (const void*)mk_fwd, 512, LDS_BYTES) != hipSuccess || per_cu < 1) { fprintf(stderr, "kernel_launch: occupancy query says %d\n", per_cu); per_cu = 1; }
        (void)hipGetLastError();
        grid = cus;
        if (grid <= 0) grid = 256;
    }
    if (grid < 0) return;
    (void)hipMemsetAsync((char*)d_ws + 65536, 0, XCD_BAR_WORDS * 4, stream);
    Args a{};
    for (int i = 0; i < 30; ++i) a.in[i] = (const float*)d_in[i];
    a.out = (float*)d_out; a.ws = (unsigned char*)d_ws;
#if MK_MULTI
    for (int p = 0; p < NPHASE; ++p) { a.ph_lo = p; a.ph_hi = p + 1; hipLaunchKernelGGL(mk_fwd, dim3(grid), dim3(512), LDS_BYTES, stream, a); }
#else
    a.ph_lo = 0; a.ph_hi = NPHASE;
    void* args[] = {&a};
    hipError_t e = hipLaunchCooperativeKernel((const void*)mk_fwd, dim3(grid), dim3(512), args, LDS_BYTES, stream);
    if (e != hipSuccess) fprintf(stderr, "kernel_launch: cooperative launch failed: %s (grid %d)\n", hipGetErrorString(e), grid);
#endif
}
```

```cpp
#include <hip/hip_runtime.h>
#include <hip/hip_cooperative_groups.h>
#include <cstdio>
#include <cstdint>
namespace cg = cooperative_groups;
namespace pg8 {
#define PG8_LAS __attribute__((address_space(3)))
typedef unsigned short bf16_t;
typedef short bf16x8 __attribute__((ext_vector_type(8)));
typedef float f32x4 __attribute__((ext_vector_type(4)));
typedef unsigned u32x4 __attribute__((ext_vector_type(4)));
constexpr int BM = 256, BK = 64, HALF = 128, HTB = HALF * BK * 2  , STAGE_BYTES = 8 * HTB, NXCD = 8, WGM = 8;

__host__ __device__ __forceinline__ int lds_byte(int r, int c) { const int st = (r >> 4) * 2 + (c >> 5), rr = r & 15, cc = c & 31, ob = rr * 64 + cc * 2; return st * 1024 + (ob ^ (((ob >> 9) & 1) << 5)); }
__host__ __device__ __forceinline__ void stage_rc(int b, int& R, int& C) { const int st = b / 1024, sb = b % 1024, swz = sb ^ (((sb >> 9) & 1) << 5); R = (st >> 1) * 16 + swz / 64; C = (st & 1) * 32 + (swz % 64) / 2; }
__host__ __device__ __forceinline__ int perm32(int rho) { const int n = rho >> 4, i = rho & 15; return 8 * (i >> 2) + 4 * n + (i & 3); }

struct Unit { int pm, pn; };
struct Gemm { const bf16_t* A; const bf16_t* Bt; int M, N, K, ld; };

struct OneUnit {
    int pm, pn; bool active;
    __device__ __forceinline__ bool next(int i, Unit& u) const { if (i > 0 || !active) return false; u.pm = pm; u.pn = pn; return true; }
    __device__ __forceinline__ void a_ready(const Unit&) const {}
    __device__ __forceinline__ void done(const Unit&) const {}
};
struct StaticOrder {
    int nM, nN, nwg, G, c;
    __host__ __device__ void init(int M, int N, int G_, int c_) { nM = M / BM; nN = N / BM; nwg = nM * nN; G = G_; c = c_; }
    __host__ __device__ bool next(int i, Unit& u) const {
        const long L = (long)i * G + c; if (L >= nwg) return false;
        int wgid = (int)L; { const int q = nwg / NXCD, r = nwg % NXCD, xcd = wgid % NXCD, off = wgid / NXCD; wgid = (xcd < r ? xcd * (q + 1) : r * (q + 1) + (xcd - r) * q) + off; }
        const int nig = WGM * nN, gid = wgid / nig, fm = gid * WGM, gsz = (nM - fm) < WGM ? (nM - fm) : WGM;
        u.pm = fm + ((wgid % nig) % gsz); u.pn = (wgid % nig) / gsz; return true;
    }
    __device__ __forceinline__ void a_ready(const Unit&) const {}
    __device__ __forceinline__ void done(const Unit&) const {}
};

__device__ __forceinline__ unsigned cvt_pk_bf16(float lo, float hi) { unsigned r; asm volatile("v_cvt_pk_bf16_f32 %0, %1, %2" : "=v"(r) : "v"(lo), "v"(hi)); return r; }
template <class Epi, class Sched, bool ALIGN_EPI = false, bool SP2 = false>
__device__ __forceinline__ void gemm_phase(PG8_LAS unsigned char* lds, const Gemm g, const Sched& S, const Epi& E) {
    const int tid = threadIdx.x, wid = __builtin_amdgcn_readfirstlane(tid >> 6), lane = tid & 63, wr = wid >> 2, wc = wid & 3, fr = lane & 15, fq = lane >> 4;
    const int K = g.K, nt = K / BK;
    unsigned voffA[2], voffB[2];
#pragma unroll
    for (int i = 0; i < 2; ++i) { int R, C; stage_rc(tid * 16 + i * 8192, R, C); const int Rb = Epi::PERM ? ((R & ~31) + perm32(R & 31)) : R;
        voffA[i] = (unsigned)(R * g.ld + C) * 2u; voffB[i] = (unsigned)(Rb * g.ld + C) * 2u; }
    const size_t kstep = (size_t)(BK * 2);
    const size_t hstep = (size_t)HALF * g.ld * 2;
    const size_t tstep = 2 * hstep;
    const unsigned ldsw = (unsigned)wid * 1024u;
    const int aoff = lds_byte(wr * 64 + fr, fq * 8), boff = lds_byte(wc * 32 + fr, fq * 8);
#define PG8_SA(b, h) (((b) * 2 + (h)) * HTB)
#define PG8_SB(b, h) ((4 + (b) * 2 + (h)) * HTB)
#define PG8_STAGE(bufoff, gbase, voff) do { _Pragma("unroll") for (int _i = 0; _i < 2; ++_i) \
        __builtin_amdgcn_global_load_lds((const unsigned*)((const char*)(gbase) + (voff)[_i]), (PG8_LAS unsigned*)(lds + (bufoff) + ldsw + _i * 8192), 16, 0, 0); } while (0)
#define PG8_LDA(dst, b, h) do { _Pragma("unroll") for (int m = 0; m < 4; ++m) _Pragma("unroll") for (int k = 0; k < 2; ++k) dst[m][k] = *(const PG8_LAS bf16x8*)(lds + PG8_SA(b, h) + aoff + m * 2048 + k * 1024); } while (0)
#define PG8_LDB(dst, b, h) do { _Pragma("unroll") for (int n = 0; n < 2; ++n) _Pragma("unroll") for (int k = 0; k < 2; ++k) dst[n][k] = *(const PG8_LAS bf16x8*)(lds + PG8_SB(b, h) + boff + n * 2048 + k * 1024); } while (0)
#define PG8_MMA(ai, bj, At, Bt) do { __builtin_amdgcn_s_setprio(1); _Pragma("unroll") for (int m = 0; m < 4; ++m) _Pragma("unroll") for (int n = 0; n < 2; ++n) _Pragma("unroll") for (int k = 0; k < 2; ++k) \
        acc[ai][bj][m][n] = __builtin_amdgcn_mfma_f32_16x16x32_bf16(Bt[n][k], At[m][k], acc[ai][bj][m][n], 0, 0, 0); __builtin_amdgcn_s_setprio(0); } while (0)
#define PG8_WAIT_V(n) asm volatile("s_waitcnt vmcnt(" #n ")" ::: "memory")
#define PG8_WAIT_L(n) asm volatile("s_waitcnt lgkmcnt(" #n ")" ::: "memory")
#define PG8_BAR __builtin_amdgcn_s_barrier()
#define PG8_SCHED __builtin_amdgcn_sched_barrier(0)
    Unit cur, nxt; int ui = 0;
    if (!S.next(0, cur)) return;
    f32x4 acc[2][2][4][2];
#pragma unroll
    for (int a = 0; a < 2; ++a)
#pragma unroll
        for (int b = 0; b < 2; ++b)
#pragma unroll
            for (int m = 0; m < 4; ++m)
#pragma unroll
                for (int n = 0; n < 2; ++n) acc[a][b][m][n] = (f32x4){0.f, 0.f, 0.f, 0.f};
    bf16x8 At[4][2], B0[2][2], B1[2][2];
    const char* cA = (const char*)g.A + (size_t)cur.pm * tstep; const char* cB = (const char*)g.Bt + (size_t)cur.pn * tstep;
    S.a_ready(cur);
    if constexpr (SP2) {
        PG8_STAGE(PG8_SB(0, 0), cB, voffB); PG8_STAGE(PG8_SB(0, 1), cB + hstep, voffB); PG8_STAGE(PG8_SA(0, 0), cA, voffA); PG8_STAGE(PG8_SA(0, 1), cA + hstep, voffA);
        if (wr == 1) PG8_BAR;
        PG8_WAIT_V(2); PG8_BAR;
        PG8_STAGE(PG8_SB(1, 0), cB + kstep, voffB); PG8_STAGE(PG8_SA(1, 0), cA + kstep, voffA); PG8_STAGE(PG8_SB(1, 1), cB + hstep + kstep, voffB);
        PG8_WAIT_V(6); PG8_BAR;
    } else {
        PG8_STAGE(PG8_SB(0, 0), cB, voffB); PG8_STAGE(PG8_SA(0, 0), cA, voffA); PG8_STAGE(PG8_SB(0, 1), cB + hstep, voffB); PG8_STAGE(PG8_SA(0, 1), cA + hstep, voffA);
        if (wr == 1) PG8_BAR;
        PG8_WAIT_V(4); PG8_BAR;
        PG8_STAGE(PG8_SB(1, 0), cB + kstep, voffB); PG8_STAGE(PG8_SA(1, 0), cA + kstep, voffA); PG8_STAGE(PG8_SB(1, 1), cB + hstep + kstep, voffB);
        PG8_WAIT_V(6); PG8_BAR;
    }
    for (;;) {
        const bool has_next = S.next(ui + 1, nxt);
        const char* nA = has_next ? (const char*)g.A + (size_t)nxt.pm * tstep : cA; const char* nB = has_next ? (const char*)g.Bt + (size_t)nxt.pn * tstep : cB;
        for (int t = 0; t < nt; t += 2) {
            const bool last = (t == nt - 2);
            const char* a1 = cA + (size_t)(t + 1) * kstep;
            const char* a2 = last ? nA : cA + (size_t)(t + 2) * kstep; const char* b2 = last ? nB : cB + (size_t)(t + 2) * kstep;
            const char* a3 = a2 + kstep; const char* b3 = b2 + kstep;
            if (last && has_next) S.a_ready(nxt);
            if constexpr (SP2) {
            PG8_LDB(B0, 0, 0); PG8_LDB(B1, 0, 1); PG8_SCHED; PG8_LDA(At, 0, 0); PG8_STAGE(PG8_SA(1, 1), a1 + hstep, voffA);
            PG8_WAIT_V(8); PG8_WAIT_L(0); PG8_BAR; PG8_MMA(0, 0, At, B0); PG8_MMA(0, 1, At, B1); PG8_BAR; PG8_SCHED;
            PG8_LDA(At, 0, 1); PG8_STAGE(PG8_SB(0, 0), b2, voffB); PG8_STAGE(PG8_SB(0, 1), b2 + hstep, voffB); PG8_STAGE(PG8_SA(0, 0), a2, voffA);
            PG8_WAIT_V(8); PG8_WAIT_L(0); PG8_BAR; PG8_MMA(1, 0, At, B0); PG8_MMA(1, 1, At, B1); PG8_BAR; PG8_SCHED;
            PG8_LDB(B0, 1, 0); PG8_LDB(B1, 1, 1); PG8_SCHED; PG8_LDA(At, 1, 0); PG8_STAGE(PG8_SA(0, 1), a2 + hstep, voffA);
            PG8_WAIT_V(8); PG8_WAIT_L(0); PG8_BAR; PG8_MMA(0, 0, At, B0); PG8_MMA(0, 1, At, B1); PG8_BAR; PG8_SCHED;
            PG8_LDA(At, 1, 1); PG8_STAGE(PG8_SB(1, 0), b3, voffB); PG8_STAGE(PG8_SB(1, 1), b3 + hstep, voffB); PG8_STAGE(PG8_SA(1, 0), a3, voffA);
            PG8_WAIT_V(8); PG8_WAIT_L(0); PG8_BAR; PG8_MMA(1, 0, At, B0); PG8_MMA(1, 1, At, B1); PG8_BAR; PG8_SCHED;
            } else {
            PG8_LDB(B0, 0, 0); PG8_SCHED; PG8_LDA(At, 0, 0); PG8_STAGE(PG8_SA(1, 1), a1 + hstep, voffA);
            PG8_WAIT_L(8); PG8_BAR; PG8_WAIT_L(0); PG8_MMA(0, 0, At, B0); PG8_BAR; PG8_SCHED;
            PG8_LDB(B1, 0, 1); PG8_STAGE(PG8_SB(0, 0), b2, voffB);
            PG8_BAR; PG8_WAIT_L(0); PG8_MMA(0, 1, At, B1); PG8_BAR;
            PG8_LDA(At, 0, 1); PG8_STAGE(PG8_SA(0, 0), a2, voffA);
            PG8_BAR; PG8_WAIT_L(0); PG8_MMA(1, 0, At, B0); PG8_BAR; PG8_SCHED;
            PG8_STAGE(PG8_SB(0, 1), b2 + hstep, voffB);
            PG8_WAIT_V(6); PG8_BAR; PG8_MMA(1, 1, At, B1); PG8_BAR;
            PG8_LDB(B0, 1, 0); PG8_SCHED; PG8_LDA(At, 1, 0); PG8_STAGE(PG8_SA(0, 1), a2 + hstep, voffA);
            PG8_WAIT_L(8); PG8_BAR; PG8_WAIT_L(0); PG8_MMA(0, 0, At, B0); PG8_BAR; PG8_SCHED;
            PG8_LDB(B1, 1, 1); PG8_STAGE(PG8_SB(1, 0), b3, voffB);
            PG8_BAR; PG8_WAIT_L(0); PG8_MMA(0, 1, At, B1); PG8_BAR;
            PG8_LDA(At, 1, 1); PG8_STAGE(PG8_SA(1, 0), a3, voffA);
            PG8_BAR; PG8_WAIT_L(0); PG8_MMA(1, 0, At, B0); PG8_BAR; PG8_SCHED;
            PG8_STAGE(PG8_SB(1, 1), b3 + hstep, voffB);
            PG8_WAIT_V(6); PG8_BAR; PG8_MMA(1, 1, At, B1); PG8_BAR;
            }
        }
        if constexpr (ALIGN_EPI) { if (wr == 0) PG8_BAR; }
        if constexpr (!Epi::AFTER_DRAIN) { E(acc, cur, wr, wc, fr, fq); S.done(cur); }
        if (!has_next) break;
#pragma unroll
        for (int a = 0; a < 2; ++a)
#pragma unroll
            for (int b = 0; b < 2; ++b)
#pragma unroll
                for (int m = 0; m < 4; ++m)
#pragma unroll
                    for (int n = 0; n < 2; ++n) acc[a][b][m][n] = (f32x4){0.f, 0.f, 0.f, 0.f};
        cur = nxt; cA = nA; cB = nB; ++ui;
        if constexpr (ALIGN_EPI) { if (wr == 1) PG8_BAR; }
    }
    PG8_WAIT_V(0);
    if constexpr (!ALIGN_EPI) { if (wr == 0) PG8_BAR; }
    PG8_BAR;
    if constexpr (Epi::AFTER_DRAIN) { E.fused(acc, cur, wr, wc, fr, fq, lds, wid, lane); S.done(cur); }
#undef PG8_SA
#undef PG8_SB
#undef PG8_STAGE
#undef PG8_LDA
#undef PG8_LDB
#undef PG8_MMA
#undef PG8_WAIT_V
#undef PG8_WAIT_L
#undef PG8_BAR
#undef PG8_SCHED
}
}

#ifndef MK_MULTI
#define MK_MULTI 0
#endif
constexpr int D = 2048, TP = 8192, NB = 16, TS = 16, MS = NB * TS, M = TP + MS;
constexpr int RW = 1024, RH = 16, RN = 64, RC = 3328;
constexpr int ED = 1024, EH = 4, EN = 256, EC = 4096, IC = RC + EC;
constexpr int FF = 5632, NSEQ = 17, MODW = 6 * D;
constexpr int LCH = 128, NCH = TP / LCH;
constexpr int RBLK = 256, NRB = TP / RBLK;
constexpr int NPHASE = 14;
constexpr size_t O_Y = 0, O_SHP = (size_t)M * D, O_WKP = O_SHP + RC, O_RTP = O_WKP + 65536, O_SHS = O_RTP + 262144, O_WKS = O_SHS + (size_t)NB * RC, O_RTS = O_WKS + (size_t)NB * 65536, O_END = O_RTS + (size_t)NB * 262144;
constexpr size_t MiB = 1u << 20;
constexpr size_t WS_MOD = 1 * MiB, WS_LORAT = 2 * MiB, WS_WOUTT = 4 * MiB, WS_WINT = 12 * MiB, WS_V = 12 * MiB, WS_H = 41 * MiB, WS_G = 41 * MiB, WS_BON = 58 * MiB,
                 WS_QKVG = 74 * MiB, WS_LOUT = 140 * MiB, WS_PU = 140 * MiB, WS_KVB = 172 * MiB, WS_ACT = 74 * MiB, WS_PREP = 190 * MiB, WS_MIXOUT = 190 * MiB,
                 WS_WUPT = 256 * MiB, WS_WDNT = 300 * MiB, WS_PART9 = 330 * MiB, WS_PART12 = 256 * MiB, WS_END = 355 * MiB;
constexpr size_t WS_ADAT = 190 * MiB, WS_SC = 239 * MiB, WS_MODP = 240 * MiB;
constexpr int KS9 = 4, KS12 = 11;
constexpr size_t PREP_STRIDE = 33 * MiB;
constexpr size_t DO_Z = 0, DO_LIN = 54 * MiB, DO_SPREV = 0, DO_MIX = 17 * MiB;
constexpr int LDS_BYTES = 147456;

typedef unsigned short bf16;
typedef float f32x2 __attribute__((ext_vector_type(2)));
typedef float f32x4 __attribute__((ext_vector_type(4)));
typedef short bf16x8 __attribute__((ext_vector_type(8)));
typedef unsigned u32x4 __attribute__((ext_vector_type(4)));
typedef unsigned u32x2 __attribute__((ext_vector_type(2)));
#define LDS_WAIT() asm volatile("s_waitcnt lgkmcnt(0)" ::: "memory")

__device__ __forceinline__ float bf2f(unsigned v) { return __builtin_bit_cast(float, v << 16); }
__device__ __forceinline__ unsigned f2bf(float f) { unsigned u = __builtin_bit_cast(unsigned, f); return (u + 0x7fffu + ((u >> 16) & 1u)) >> 16; }
__device__ __forceinline__ unsigned pk2(float lo, float hi) { return f2bf(lo) | (f2bf(hi) << 16); }
__device__ __forceinline__ float wave_sum(float v) {
#pragma unroll
    for (int o = 1; o < 64; o <<= 1) v += __shfl_xor(v, o);
    return v;
}
__device__ __forceinline__ float sigm(float x) { return 1.f / (1.f + __expf(-x)); }
__device__ __forceinline__ int seq_of(int m) { return m < TP ? 0 : 1 + ((m - TP) >> 4); }
__device__ __forceinline__ int tpos_of(int m) { return m < TP ? m : ((m - TP) & 15); }
__device__ __forceinline__ float ret_l2g(int h) { return __log2f(1.0f - exp2f(-5.0f - (float)h)); }

struct EpiProj {
    static constexpr bool PERM = true, AFTER_DRAIN = false;
    bf16* Z; bf16* Q;
    __device__ __forceinline__ void operator()(const f32x4 (&acc)[2][2][4][2], const pg8::Unit& u, int wr, int wc, int fr, int fq) const {
        const int row0 = u.pm * 256 + wr * 64 + fr, pn = u.pn, cl = wc * 32 + 8 * fq;
        if (pn < 13 || pn >= 21) {
            bf16* base = pn < 13 ? Z + pn * 256 + cl : Q + (pn - 13) * 256 + cl; const size_t ld = pn < 13 ? RC : EC;
#pragma unroll
            for (int ai = 0; ai < 2; ++ai)
#pragma unroll
                for (int m = 0; m < 4; ++m) { bf16* rp = base + (size_t)(row0 + ai * 128 + m * 16) * ld;
#pragma unroll
                    for (int bj = 0; bj < 2; ++bj) { const f32x4 v0 = acc[ai][bj][m][0], v1 = acc[ai][bj][m][1]; u32x4 w; w.x = pk2(v0[0], v0[1]); w.y = pk2(v0[2], v0[3]); w.z = pk2(v1[0], v1[1]); w.w = pk2(v1[2], v1[3]);
                        *(u32x4*)(rp + bj * 128) = w; } }
        } else {
            const int sec = pn - 13; bf16* base = Q + sec * 256 + cl; const float sc = sec >= 4 ? 0.0625f : 1.0f;
            float inv[8];
#pragma unroll
            for (int e = 0; e < 8; ++e) inv[e] = exp2f(-(float)(cl + e) * (13.287712379549449f / 128.0f)) * 0.15915494309189535f;
#pragma unroll
            for (int ai = 0; ai < 2; ++ai)
#pragma unroll
                for (int m = 0; m < 4; ++m) { const int row = row0 + ai * 128 + m * 16; bf16* rp = base + (size_t)row * EC;
                    const float pos = row < TP ? (float)row : (float)(2048 + ((row - TP) & 15));
                    float o1[8], o2[8];
#pragma unroll
                    for (int e = 0; e < 8; ++e) { float rev = pos * inv[e]; rev -= floorf(rev); const float sn = __builtin_amdgcn_sinf(rev), cs = __builtin_amdgcn_cosf(rev);
                        const float x1 = acc[ai][0][m][e >> 2][e & 3], x2 = acc[ai][1][m][e >> 2][e & 3];
                        o1[e] = (x1 * cs - x2 * sn) * sc; o2[e] = (x2 * cs + x1 * sn) * sc; }
                    u32x4 w; w.x = pk2(o1[0], o1[1]); w.y = pk2(o1[2], o1[3]); w.z = pk2(o1[4], o1[5]); w.w = pk2(o1[6], o1[7]); *(u32x4*)rp = w;
                    w.x = pk2(o2[0], o2[1]); w.y = pk2(o2[2], o2[3]); w.z = pk2(o2[4], o2[5]); w.w = pk2(o2[6], o2[7]); *(u32x4*)(rp + 128) = w; }
        }
    }
};
struct EpiBf16P {
    static constexpr bool PERM = true, AFTER_DRAIN = false;
    bf16* C; int ldc;
    __device__ __forceinline__ void operator()(const f32x4 (&acc)[2][2][4][2], const pg8::Unit& u, int wr, int wc, int fr, int fq) const {
        const int row0 = u.pm * 256 + wr * 64 + fr; bf16* base = C + u.pn * 256 + wc * 32 + 8 * fq;
#pragma unroll
        for (int ai = 0; ai < 2; ++ai)
#pragma unroll
            for (int m = 0; m < 4; ++m) { bf16* rp = base + (size_t)(row0 + ai * 128 + m * 16) * ldc;
#pragma unroll
                for (int bj = 0; bj < 2; ++bj) { const f32x4 v0 = acc[ai][bj][m][0], v1 = acc[ai][bj][m][1]; u32x4 w; w.x = pk2(v0[0], v0[1]); w.y = pk2(v0[2], v0[3]); w.z = pk2(v1[0], v1[1]); w.w = pk2(v1[2], v1[3]);
                    *(u32x4*)(rp + bj * 128) = w; } }
    }
};
struct EpiF32 {
    static constexpr bool PERM = true, AFTER_DRAIN = false;
    float* C; int ldc;
    __device__ __forceinline__ void operator()(const f32x4 (&acc)[2][2][4][2], const pg8::Unit& u, int wr, int wc, int fr, int fq) const {
        const int row0 = u.pm * 256 + wr * 64 + fr; float* base = C + u.pn * 256 + wc * 32 + 8 * fq;
#pragma unroll
        for (int ai = 0; ai < 2; ++ai)
#pragma unroll
            for (int m = 0; m < 4; ++m) { float* rp = base + (size_t)(row0 + ai * 128 + m * 16) * ldc;
#pragma unroll
                for (int bj = 0; bj < 2; ++bj) { *(f32x4*)(rp + bj * 128) = acc[ai][bj][m][0]; *(f32x4*)(rp + bj * 128 + 4) = acc[ai][bj][m][1]; } }
    }
};
struct EpiSwiglu {
    static constexpr bool PERM = true, AFTER_DRAIN = false;
    bf16* C;
    __device__ __forceinline__ void operator()(const f32x4 (&acc)[2][2][4][2], const pg8::Unit& u, int wr, int wc, int fr, int fq) const {
        const int row0 = u.pm * 256 + wr * 64 + fr; bf16* base = C + u.pn * 128 + wc * 32 + 8 * fq;
#pragma unroll
        for (int ai = 0; ai < 2; ++ai)
#pragma unroll
            for (int m = 0; m < 4; ++m) { float o[8];
#pragma unroll
                for (int e = 0; e < 8; ++e) { const float g = acc[ai][0][m][e >> 2][e & 3], up = acc[ai][1][m][e >> 2][e & 3]; o[e] = g * sigm(g) * up; }
                u32x4 w; w.x = pk2(o[0], o[1]); w.y = pk2(o[2], o[3]); w.z = pk2(o[4], o[5]); w.w = pk2(o[6], o[7]);
                *(u32x4*)(base + (size_t)(row0 + ai * 128 + m * 16) * FF) = w; }
    }
};
struct EpiMod {
    static constexpr bool PERM = true, AFTER_DRAIN = false;
    float* C; int ldc;
    __device__ __forceinline__ void operator()(const f32x4 (&acc)[2][2][4][2], const pg8::Unit& u, int wr, int wc, int fr, int fq) const {
        if (wr != 0) return;
        float* base = C + u.pn * 256 + wc * 32 + 8 * fq;
#pragma unroll
        for (int m = 0; m < 2; ++m) { const int row = 16 * m + fr; if (row < NSEQ) { float* rp = base + (size_t)row * ldc;
#pragma unroll
            for (int bj = 0; bj < 2; ++bj) { *(f32x4*)(rp + bj * 128) = acc[0][bj][m][0]; *(f32x4*)(rp + bj * 128 + 4) = acc[0][bj][m][1]; } } }
    }
};

__device__ __forceinline__ void transpose_item(const float* __restrict__ W, int K, int N, bf16* WT, int k0, int n0, int dst_row0, float* scr, int lane) {
#pragma unroll 8
    for (int i = 0; i < 32; ++i) { const int kk = 2 * i + (lane >> 5); scr[kk * 33 + (lane & 31)] = W[(size_t)(k0 + kk) * N + n0 + (lane & 31)]; }
    LDS_WAIT();
    const int c = lane & 7;
#pragma unroll
    for (int j = 0; j < 4; ++j) { const int n = (lane >> 3) + 8 * j; const float* s = scr + (8 * c) * 33 + n;
        u32x4 o; o.x = pk2(s[0 * 33], s[1 * 33]); o.y = pk2(s[2 * 33], s[3 * 33]); o.z = pk2(s[4 * 33], s[5 * 33]); o.w = pk2(s[6 * 33], s[7 * 33]);
        *(u32x4*)(WT + (size_t)(dst_row0 + n) * K + k0 + 8 * c) = o; }
    LDS_WAIT();
}

typedef const __attribute__((address_space(4))) f32x2* cf2p;
__device__ __forceinline__ cf2p to_c(const float* p) { return (cf2p)(unsigned long long)p; }
#define DPPF(old, src, ctrl, rmask) __builtin_bit_cast(float, __builtin_amdgcn_update_dpp(__builtin_bit_cast(int, (float)(old)), __builtin_bit_cast(int, (float)(src)), (ctrl), (rmask), 0xF, false))
__device__ __forceinline__ float wave_sum_u(float v) {
    v += DPPF(0.f, v, 0xB1, 0xF); v += DPPF(0.f, v, 0x4E, 0xF); v += DPPF(0.f, v, 0x124, 0xF); v += DPPF(0.f, v, 0x128, 0xF);
    v += DPPF(0.f, v, 0x142, 0xA); v += DPPF(0.f, v, 0x143, 0xC);
    return __builtin_bit_cast(float, __builtin_amdgcn_readlane(__builtin_bit_cast(int, v), 63));
}
constexpr int RW_PF = 6;
template <int MODE>
__device__ __forceinline__ void rwkv_run(f32x2 (&S)[32], const float* W, const float* NKK, const float* B, const float* K, const float* R, const bf16* Vp, int nsteps, int lane,
                                         const bf16* Gp, const float* BONp, bf16* MIXp, float lnw, float lnb) {
    constexpr int NPF = MODE == 2 ? 20 : (MODE == 0 ? 16 : 12);
    const int pa = lane >> 2; const float* pfp = (pa == 0 ? W : pa == 1 ? NKK : pa == 2 ? B : pa == 3 ? K : R) + (lane & 3) * 16;
    float vn = 0.f, gn = 0.f, bn = 0.f;
    if (MODE != 1) vn = bf2f(Vp[lane]);
    if (MODE == 2) { gn = bf2f(Gp[lane]); bn = BONp[0]; }
    if (lane < NPF) {
#pragma unroll
        for (int q = 1; q < RW_PF; ++q) if (q < nsteps) (void)*(volatile const float*)(pfp + (size_t)q * RW);
    }
    for (int t = 0; t < nsteps; ++t) {
        const size_t o = (size_t)t * RW;
        cf2p w = to_c(W + o), nk = to_c(NKK + o), b = to_c(B + o), k = to_c(K + o), r = to_c(R + o);
        const float v = vn, gv = gn, bon = bn;
        { const int t1 = t + 1 < nsteps ? t + 1 : t; const size_t o1 = (size_t)t1 * RW;
          if (MODE != 1) vn = bf2f(Vp[o1 + lane]);
          if (MODE == 2) { gn = bf2f(Gp[o1 + lane]); bn = BONp[(size_t)t1 * 16]; }
          const int tp = t + RW_PF < nsteps ? t + RW_PF : nsteps - 1;
          if (lane < NPF) (void)*(volatile const float*)(pfp + (size_t)tp * RW); }
        f32x2 a0 = {0.f, 0.f}, a1 = {0.f, 0.f};
#pragma unroll
        for (int j = 0; j < 32; j += 2) { a0 = __builtin_elementwise_fma(S[j], nk[j], a0); a1 = __builtin_elementwise_fma(S[j + 1], nk[j + 1], a1); }
        const float sa = (a0.x + a0.y) + (a1.x + a1.y);
        const f32x2 sa2 = {sa, sa}, v2 = {v, v};
        f32x2 o0 = {0.f, 0.f}, o1 = {0.f, 0.f};
#pragma unroll
        for (int j = 0; j < 32; ++j) {
            f32x2 s = S[j] * w[j];
            s = __builtin_elementwise_fma(sa2, b[j], s);
            if (MODE != 1) s = __builtin_elementwise_fma(v2, k[j], s);
            S[j] = s;
            if (MODE == 2) { if (j & 1) o1 = __builtin_elementwise_fma(s, r[j], o1); else o0 = __builtin_elementwise_fma(s, r[j], o0); }
        }
        if (MODE == 2) {
            const float ov = (o0.x + o0.y) + (o1.x + o1.y);
            const float mean = wave_sum_u(ov) * (1.f / 64.f), d = ov - mean, var = wave_sum_u(d * d) * (1.f / 64.f);
            float y = d * rsqrtf(var + 64e-5f) * lnw + lnb;
            y = (y + bon * v) * gv;
            MIXp[(size_t)t * D + lane] = (bf16)f2bf(y);
        }
    }
}

constexpr int RL_B = 8;
template <int MODE> struct RL { static constexpr int NV = MODE == 2 ? 5 : (MODE == 0 ? 4 : 3); static constexpr int REC = NV * 64, BUF = RL_B * REC + (MODE != 1 ? 256 : 0) + (MODE == 2 ? 256 + 16 : 0); };
#define SBAR() __builtin_amdgcn_sched_barrier(0)
template <int MODE>
__device__ __forceinline__ void rwkv_lds(f32x2 (&S)[32], const float* W, const float* NKK, const float* B, const float* K, const float* R, const bf16* Vp, int nsteps, int lane,
                                         const bf16* Gp, const float* BONp, bf16* MIXp, float lnw, float lnb, float* wl) {
    constexpr int NV = RL<MODE>::NV, REC = RL<MODE>::REC;
    const int ls = lane >> 4, lc = (lane & 15) * 4;
    f32x4 st[NV][2]; u32x4 sv = {0u, 0u, 0u, 0u}, sg = {0u, 0u, 0u, 0u}; float sb = 0.f;
#define RL_ISSUE(bt) do { const size_t ob = (size_t)((bt) * RL_B) * RW; \
        _Pragma("unroll") for (int q = 0; q < 2; ++q) { const size_t oo = ob + (size_t)(ls + 4 * q) * RW + lc; \
            st[0][q] = *(const f32x4*)(W + oo); st[1][q] = *(const f32x4*)(NKK + oo); st[2][q] = *(const f32x4*)(B + oo); if (NV >= 4) st[NV >= 4 ? 3 : 0][q] = *(const f32x4*)(K + oo); if (NV == 5) st[NV - 1][q] = *(const f32x4*)(R + oo); } \
        if (MODE != 1) sv = *(const u32x4*)(Vp + ob + (size_t)(lane >> 3) * RW + (lane & 7) * 8); \
        if (MODE == 2) { sg = *(const u32x4*)(Gp + ob + (size_t)(lane >> 3) * RW + (lane & 7) * 8); if (lane < RL_B) sb = BONp[(size_t)((bt) * RL_B + lane) * 16]; } } while (0)
#define RL_COMMIT() do { \
        _Pragma("unroll") for (int q = 0; q < 2; ++q) _Pragma("unroll") for (int v = 0; v < NV; ++v) *(f32x4*)(wl + (ls + 4 * q) * REC + v * 64 + lc) = st[v][q]; \
        if (MODE != 1) *(u32x4*)((bf16*)(wl + RL_B * REC) + (lane >> 3) * 64 + (lane & 7) * 8) = sv; \
        if (MODE == 2) { *(u32x4*)((bf16*)(wl + RL_B * REC + 256) + (lane >> 3) * 64 + (lane & 7) * 8) = sg; if (lane < RL_B) wl[RL_B * REC + 512 + lane] = sb; } } while (0)
    const int nb = nsteps / RL_B;
    RL_ISSUE(0); RL_COMMIT();
    for (int bt = 0; bt < nb; ++bt) {
        if (bt + 1 < nb) RL_ISSUE(bt + 1);
#pragma unroll 1
        for (int s = 0; s < RL_B; ++s) {
            const f32x2* w = (const f32x2*)(wl + s * REC); const f32x2* nk = w + 32; const f32x2* b = w + 64; const f32x2* k = w + 96; const f32x2* r = w + 128;
            float v = 0.f, gv = 0.f, bon = 0.f;
            if (MODE != 1) v = bf2f(((const bf16*)(wl + RL_B * REC))[s * 64 + lane]);
            if (MODE == 2) { gv = bf2f(((const bf16*)(wl + RL_B * REC + 256))[s * 64 + lane]); bon = wl[RL_B * REC + 512 + s]; }
            f32x2 nA[8], nB[8]; f32x2 a0 = {0.f, 0.f}, a1 = {0.f, 0.f};
#pragma unroll
            for (int p = 0; p < 8; ++p) nA[p] = nk[p];
#pragma unroll
            for (int g = 0; g < 4; ++g) {
                if (g < 3) {
#pragma unroll
                    for (int p = 0; p < 8; ++p) { if (g & 1) nA[p] = nk[8 * (g + 1) + p]; else nB[p] = nk[8 * (g + 1) + p]; } }
                SBAR();
#pragma unroll
                for (int p = 0; p < 8; p += 2) { a0 = __builtin_elementwise_fma(S[8 * g + p], (g & 1) ? nB[p] : nA[p], a0); a1 = __builtin_elementwise_fma(S[8 * g + p + 1], (g & 1) ? nB[p + 1] : nA[p + 1], a1); }
                SBAR();
            }
            const float sa = (a0.x + a0.y) + (a1.x + a1.y);
            const f32x2 sa2 = {sa, sa}, v2 = {v, v};
            f32x2 uw[2][4], ub[2][4], uk[2][4], ur[2][4]; f32x2 o0 = {0.f, 0.f}, o1 = {0.f, 0.f};
#pragma unroll
            for (int p = 0; p < 4; ++p) { uw[0][p] = w[p]; ub[0][p] = b[p]; if (MODE != 1) uk[0][p] = k[p]; if (MODE == 2) ur[0][p] = r[p]; }
#pragma unroll
            for (int g = 0; g < 8; ++g) {
                if (g < 7) {
#pragma unroll
                    for (int p = 0; p < 4; ++p) { uw[(g + 1) & 1][p] = w[4 * (g + 1) + p]; ub[(g + 1) & 1][p] = b[4 * (g + 1) + p]; if (MODE != 1) uk[(g + 1) & 1][p] = k[4 * (g + 1) + p]; if (MODE == 2) ur[(g + 1) & 1][p] = r[4 * (g + 1) + p]; } }
                SBAR();
#pragma unroll
                for (int p = 0; p < 4; ++p) { const int j = 4 * g + p;
                    f32x2 x = S[j] * uw[g & 1][p]; x = __builtin_elementwise_fma(sa2, ub[g & 1][p], x); if (MODE != 1) x = __builtin_elementwise_fma(v2, uk[g & 1][p], x); S[j] = x;
                    if (MODE == 2) { if (p & 1) o1 = __builtin_elementwise_fma(x, ur[g & 1][p], o1); else o0 = __builtin_elementwise_fma(x, ur[g & 1][p], o0); } }
                SBAR();
            }
            if (MODE == 2) {
                const float ov = (o0.x + o0.y) + (o1.x + o1.y);
                const float mean = wave_sum_u(ov) * (1.f / 64.f), d = ov - mean, var = wave_sum_u(d * d) * (1.f / 64.f);
                float y = d * rsqrtf(var + 64e-5f) * lnw + lnb;
                y = (y + bon * v) * gv;
                MIXp[(size_t)(bt * RL_B + s) * D + lane] = (bf16)f2bf(y);
            }
        }
        if (bt + 1 < nb) RL_COMMIT();
    }
#undef RL_ISSUE
#undef RL_COMMIT
}
#define LAS __attribute__((address_space(3)))

#define XB_TMO      128
#define XB_XCNT(j)  (256  + 64 * (j))
#define XB_XSUB(j)  (1280 + 64 * (j))
#define XB_XGEN(j)  (2304 + 64 * (j))
#define XB_TOP      3328
#define XB_TOPGEN   3392
#define XCD_BAR_WORDS 3456
#define XB_SPIN_CAP (1u << 18)

__device__ __forceinline__ unsigned xb_ld(unsigned* p)              { return __hip_atomic_load(p, __ATOMIC_RELAXED, __HIP_MEMORY_SCOPE_AGENT); }
__device__ __forceinline__ unsigned xb_add(unsigned* p, unsigned v) { return __hip_atomic_fetch_add(p, v, __ATOMIC_RELAXED, __HIP_MEMORY_SCOPE_AGENT); }
__device__ __forceinline__ unsigned xb_xcc_id() { return (unsigned)__builtin_amdgcn_s_getreg((3 << 11) | 20) & 0xFu; }
#define XB_SPIN(cond, bar) do { unsigned _sp = 0; while (cond) { __builtin_amdgcn_s_sleep(1); \
    if ((++_sp & 255u) == 0u) { if (xb_ld(&(bar)[XB_TMO])) break; if (_sp > XB_SPIN_CAP) { atomicAdd(&(bar)[XB_TMO], 1u); break; } } } } while (0)

struct XcdBarrier {
    unsigned* bar; unsigned x;
    volatile LAS unsigned* st;
};

__device__ __forceinline__ XcdBarrier xcd_barrier_post(unsigned* bar, volatile LAS unsigned* st) {
    XcdBarrier b; b.bar = bar; b.x = xb_xcc_id(); b.st = st;
    if (threadIdx.x == 0) (void)xb_add(&bar[XB_XCNT(b.x)], 1u);
    return b;
}
__device__ __forceinline__ void xcd_barrier_complete(unsigned* bar, unsigned x, unsigned& nloc, unsigned& nx) {
    const unsigned G = gridDim.x * gridDim.y * gridDim.z;
    unsigned sum, cnt, mine, sp = 0u;
    for (;;) {
        sum = 0u; cnt = 0u; mine = 0u;
#pragma unroll
        for (unsigned j = 0; j < 16; ++j) { const unsigned c = xb_ld(&bar[XB_XCNT(j)]); sum += c; cnt += (c > 0u) ? 1u : 0u; mine = (j == x) ? c : mine; }
        if (sum == G) break;
        __builtin_amdgcn_s_sleep(1);
        if ((++sp & 255u) == 0u) { if (xb_ld(&bar[XB_TMO])) break; if (sp > XB_SPIN_CAP) { atomicAdd(&bar[XB_TMO], 1u); break; } }
    }
    nloc = mine > 0u ? mine : 1u; nx = cnt > 0u ? cnt : 1u;
}

__device__ __forceinline__ void xcd_barrier(const XcdBarrier& b) {
    asm volatile("s_waitcnt vmcnt(0)" ::: "memory");
    __syncthreads();
    if (threadIdx.x == 0) {
        unsigned* bar = b.bar;
        __builtin_amdgcn_s_waitcnt(0);
        unsigned nloc = b.st[0], nx = b.st[1];
        if (nloc == 0u) { xcd_barrier_complete(bar, b.x, nloc, nx); b.st[0] = nloc; b.st[1] = nx; }
        const unsigned old = xb_add(&bar[XB_XSUB(b.x)], 1u);
        const unsigned gen = old / nloc;
        if (old + 1u == (gen + 1u) * nloc) {
            __builtin_amdgcn_fence(__ATOMIC_RELEASE, "agent");
            asm volatile("s_waitcnt vmcnt(0)" ::: "memory");
            const unsigned og = xb_add(&bar[XB_TOP], 1u);
            const unsigned tg = og / nx;
            if (og + 1u == (tg + 1u) * nx) xb_add(&bar[XB_TOPGEN], 1u);
            else XB_SPIN(xb_ld(&bar[XB_TOPGEN]) == tg, bar);
            __builtin_amdgcn_fence(__ATOMIC_ACQUIRE, "agent");
            xb_add(&bar[XB_XGEN(b.x)], 1u);
            asm volatile("s_waitcnt vmcnt(0)" ::: "memory");
        } else {
            XB_SPIN(xb_ld(&bar[XB_XGEN(b.x)]) == gen, bar);
            __builtin_amdgcn_fence(__ATOMIC_ACQUIRE, "agent");
            asm volatile("s_waitcnt vmcnt(0)" ::: "memory");
        }
    }
    __syncthreads();
}


struct Args { const float* in[30]; float* out; unsigned char* ws; int ph_lo, ph_hi; };
enum { I_XP = 0, I_XS, I_CP, I_CS, I_SSH, I_SWKV, I_SRET, I_ADAW, I_ADAB, I_GPM, I_GPOM, I_GPF, I_GPOF, I_WIN, I_MU, I_W0, I_W2, I_A0, I_A2, I_G2, I_KK, I_KA, I_RK, I_RLW, I_RLB, I_ELW, I_ELB, I_WOUT, I_WUP, I_WDN };

__global__ void __launch_bounds__(512, 2) mk_fwd(Args a) {
    extern __shared__ __attribute__((aligned(16))) unsigned char lds[];
    cg::grid_group grid = cg::this_grid();
    const int tid = threadIdx.x, lane = tid & 63, wave = __builtin_amdgcn_readfirstlane(tid >> 6);
    const int G = gridDim.x, bid = blockIdx.x, gw = bid * 8 + wave, NGW = G * 8;
    const int lo = a.ph_lo, hi = a.ph_hi;
    volatile LAS unsigned* xst = (volatile LAS unsigned*)((LAS unsigned char*)lds + LDS_BYTES - 16);
    if (tid < 2) xst[tid] = 0u;
    __syncthreads();
    XcdBarrier xb = xcd_barrier_post((unsigned*)(a.ws + 65536), xst);
    unsigned char* ws = a.ws; float* out = a.out; unsigned char* dob = (unsigned char*)a.out;
    float* MOD = (float*)(ws + WS_MOD);
    bf16* LORAT = (bf16*)(ws + WS_LORAT); bf16* WOUTT = (bf16*)(ws + WS_WOUTT); bf16* WINT = (bf16*)(ws + WS_WINT); bf16* WUPT = (bf16*)(ws + WS_WUPT); bf16* WDNT = (bf16*)(ws + WS_WDNT);
    bf16* H = (bf16*)(ws + WS_H); bf16* QKVG = (bf16*)(ws + WS_QKVG); bf16* LOUT = (bf16*)(ws + WS_LOUT); bf16* Z = (bf16*)(dob + DO_Z); bf16* LIN = (bf16*)(dob + DO_LIN);
    float* PW = (float*)(ws + WS_PREP); float* PNKK = (float*)(ws + WS_PREP + PREP_STRIDE); float* PB = (float*)(ws + WS_PREP + 2 * PREP_STRIDE); float* PK = (float*)(ws + WS_PREP + 3 * PREP_STRIDE); float* PR = (float*)(ws + WS_PREP + 4 * PREP_STRIDE);
    bf16* PV = (bf16*)(ws + WS_V); bf16* PG = (bf16*)(ws + WS_G); float* BON = (float*)(ws + WS_BON);
    float* PU = (float*)(ws + WS_PU); bf16* KVB = (bf16*)(ws + WS_KVB); bf16* SPREV = (bf16*)(dob + DO_SPREV); bf16* MIX = (bf16*)(dob + DO_MIX);
    float* MIXOUT = (float*)(ws + WS_MIXOUT); bf16* ACT = (bf16*)(ws + WS_ACT);
#ifndef DUP_PHASE
#define DUP_PHASE -1
#endif
#ifndef PH_MASK
#define PH_MASK 0x3fff
#endif
#define IN(k) (((PH_MASK >> (k)) & 1) && lo <= (k) && (k) < hi)
#ifndef TS_PROBE
#define TS_PROBE -1
#endif
    unsigned long long* TSW = (unsigned long long*)ws;
    if (TS_PROBE >= 0 && bid == 0 && tid == 0) TSW[0] = __builtin_amdgcn_s_memrealtime();
#define MID(n) do { if (TS_PROBE >= 0 && bid == 0) { __syncthreads(); if (tid == 0) TSW[32 + (n)] = __builtin_amdgcn_s_memrealtime(); } } while (0)
#define SEAM(k) do { if (IN(k) && IN((k) + 1)) { if ((k) == 0) grid.sync(); else xcd_barrier(xb); } if (TS_PROBE >= 0 && bid == 0 && tid == 0) TSW[1 + (k)] = __builtin_amdgcn_s_memrealtime(); } while (0)

    if (IN(0)) for (int rep = 0; rep < (DUP_PHASE == 0 ? 2 : 1); ++rep) {
        MID(0);
        float* scr = (float*)lds + wave * (64 * 33 + 16);
        constexpr int IT_WIN = (D / 64) * (IC / 32), IT_WOUT = (D / 64) * (D / 32), IT_ADA = (D / 64) * (MODW / 32);
        bf16* ADAT = (bf16*)(ws + WS_ADAT); bf16* SC = (bf16*)(ws + WS_SC);
        for (int it = gw; it < IT_WIN + IT_WOUT + IT_ADA; it += NGW) {
            if (it < IT_WIN) { const int nb = IC / 32, kb = it / nb, n0 = 32 * (it % nb); transpose_item(a.in[I_WIN], D, IC, WINT, 64 * kb, n0, n0, scr, lane); }
            else if (it < IT_WIN + IT_WOUT) { const int r = it - IT_WIN, nb = D / 32, kb = r / nb, n0 = 32 * (r % nb); transpose_item(a.in[I_WOUT], D, D, WOUTT, 64 * kb, n0, n0, scr, lane); }
            else { const int r = it - IT_WIN - IT_WOUT, nb = MODW / 32, kb = r / nb, n0 = 32 * (r % nb); transpose_item(a.in[I_ADAW], D, MODW, ADAT, 64 * kb, n0, n0, scr, lane); }
        }
        MID(1);
        for (int idx = bid * 512 + tid; idx < 3072 * 256; idx += G * 512) {
            const int n = idx >> 8, k = idx & 255, sec = n >> 10, nn = n & 1023; float v = 0.f;
            if (sec == 0 && k < 64) v = a.in[I_W2][k * RW + nn];
            else if (sec == 1 && k >= 64 && k < 128) v = a.in[I_A2][(k - 64) * RW + nn];
            else if (sec == 2 && k >= 128) v = a.in[I_G2][(k - 128) * RW + nn];
            LORAT[idx] = (bf16)f2bf(v);
        }
        for (int idx = bid * 512 + tid; idx < 256 * D; idx += G * 512) { const int r = idx / D, k = idx % D; float v = 0.f;
            if (r < NSEQ) { const float cv = r == 0 ? a.in[I_CP][k] : a.in[I_CS][(r - 1) * D + k]; v = cv * sigm(cv); }
            SC[idx] = (bf16)f2bf(v); }
        MID(2);
    }
    if (IN(0)) MID(3);
    SEAM(0);
    if (IN(1)) {
        { const int sl = bid / 48; pg8::Gemm g{(const bf16*)(ws + WS_SC) + sl * 512, (const bf16*)(ws + WS_ADAT) + sl * 512, 256, MODW, 512, D}; pg8::OneUnit S{0, bid % 48, bid < 192};
          EpiMod E{(float*)(ws + WS_MODP) + (size_t)sl * NSEQ * MODW, MODW};
          pg8::gemm_phase<EpiMod, pg8::OneUnit, false, true>((PG8_LAS unsigned char*)lds, g, S, E); }
        xcd_barrier(xb);
        const float* MODP = (const float*)(ws + WS_MODP);
        for (int idx = bid * 512 + tid; idx < NSEQ * MODW; idx += G * 512) { float v = a.in[I_ADAB][idx % MODW];
#pragma unroll
            for (int q = 0; q < 4; ++q) v += MODP[(size_t)q * NSEQ * MODW + idx];
            MOD[idx] = v; }
        xcd_barrier(xb);
    }
    if (IN(1)) for (int rep = 0; rep < (DUP_PHASE == 1 ? 2 : 1); ++rep) {
        for (int m = gw; m < M; m += NGW) {
            const float* xr = m < TP ? a.in[I_XP] + (size_t)m * D : a.in[I_XS] + (size_t)(m - TP) * D; const float* mod = MOD + seq_of(m) * MODW;
            f32x4 v[8]; float ss = 0.f;
#pragma unroll
            for (int j = 0; j < 8; ++j) { v[j] = *(const f32x4*)(xr + 4 * lane + 256 * j); ss += (v[j].x * v[j].x + v[j].y * v[j].y) + (v[j].z * v[j].z + v[j].w * v[j].w); }
            const float rs = rsqrtf(wave_sum(ss) * (1.f / D) + 1e-6f);
#pragma unroll
            for (int j = 0; j < 8; ++j) { const int c = 4 * lane + 256 * j; const f32x4 g = *(const f32x4*)(a.in[I_GPM] + c), s1 = *(const f32x4*)(mod + D + c), h1 = *(const f32x4*)(mod + c);
                const f32x4 h = v[j] * rs * g * (s1 + 1.f) + h1; u32x2 w; w.x = pk2(h.x, h.y); w.y = pk2(h.z, h.w); *(u32x2*)(H + (size_t)m * D + c) = w; }
        }
    }
    SEAM(1);
    if (IN(2)) for (int rep = 0; rep < (DUP_PHASE == 2 ? 2 : 1); ++rep) {
        pg8::Gemm g{H, WINT, M, IC, D, D}; pg8::StaticOrder S; S.init(M, IC, G, bid); EpiProj E{Z, QKVG};
        pg8::gemm_phase<EpiProj, pg8::StaticOrder, true, true>((PG8_LAS unsigned char*)lds, g, S, E);
    }
    SEAM(2);
    if (IN(3)) for (int rep = 0; rep < (DUP_PHASE == 3 ? 2 : 1); ++rep) {
        for (int idx = bid * 512 + tid; idx < M * 128; idx += G * 512) {
            const int m = idx >> 7, c2 = (idx & 127) * 2, c = 3072 + c2, tp = tpos_of(m), sq = seq_of(m);
            const unsigned zz = *(const unsigned*)(Z + (size_t)m * RC + c); float z0 = bf2f(zz & 0xffffu), z1 = bf2f(zz >> 16), p0 = 0.f, p1 = 0.f;
            if (tp > 0) { const unsigned pp = *(const unsigned*)(Z + (size_t)(m - 1) * RC + c); p0 = bf2f(pp & 0xffffu); p1 = bf2f(pp >> 16); }
            else if (sq > 0) { p0 = a.in[I_SSH][(size_t)(sq - 1) * RC + c]; p1 = a.in[I_SSH][(size_t)(sq - 1) * RC + c + 1]; }
            z0 = z0 + (p0 - z0) * a.in[I_MU][c]; z1 = z1 + (p1 - z1) * a.in[I_MU][c + 1];
            if (c2 < 64) { z0 = 1.f - 2.f / (__expf(2.f * z0) + 1.f); z1 = 1.f - 2.f / (__expf(2.f * z1) + 1.f); }
            else if (c2 >= 128) { z0 = sigm(z0); z1 = sigm(z1); }
            *(unsigned*)(LIN + (size_t)m * 256 + c2) = pk2(z0, z1);
        }
        for (int idx = bid * 512 + tid; idx < NSEQ * RC; idx += G * 512) { const int s = idx / RC, c = idx % RC; const int m = s == 0 ? TP - 1 : TP + 16 * (s - 1) + 15;
            out[(s == 0 ? O_SHP : O_SHS + (size_t)(s - 1) * RC) + c] = bf2f(Z[(size_t)m * RC + c]); }
    }
    SEAM(3);
    if (IN(4)) for (int rep = 0; rep < (DUP_PHASE == 4 ? 2 : 1); ++rep) {
        int k256 = 256; asm volatile("" : "+s"(k256));
        pg8::Gemm g{LIN, LORAT, M, 3072, k256, k256}; pg8::StaticOrder S; S.init(M, 3072, G, bid); EpiBf16P E{LOUT, 3072};
        pg8::gemm_phase<EpiBf16P, pg8::StaticOrder, true, true>((PG8_LAS unsigned char*)lds, g, S, E);
    }
    SEAM(4);
    if (IN(5)) for (int rep = 0; rep < (DUP_PHASE == 5 ? 2 : 1); ++rep) {
        float* prm = (float*)lds;
        __syncthreads();
        for (int idx = tid; idx < RW; idx += 512) { prm[idx] = a.in[I_MU][idx]; prm[RW + idx] = a.in[I_MU][RW + idx]; prm[2 * RW + idx] = a.in[I_MU][2 * RW + idx]; prm[3 * RW + idx] = a.in[I_W0][idx];
            prm[4 * RW + idx] = a.in[I_A0][idx]; prm[5 * RW + idx] = a.in[I_KK][idx]; prm[6 * RW + idx] = a.in[I_KA][idx]; prm[7 * RW + idx] = a.in[I_RK][idx]; }
        __syncthreads();
        for (int m = gw; m < M; m += NGW) {
            const int tp = tpos_of(m), sq = seq_of(m);
#pragma unroll 1
            for (int hp = 0; hp < 2; ++hp) {
                const int hd = hp * 8 + (lane >> 3), c0 = hd * 64 + (lane & 7) * 8;
                const bf16* zr = Z + (size_t)m * RC + c0; const bf16* lr = LOUT + (size_t)m * 3072 + c0; const float* sh0 = a.in[I_SSH] + (size_t)(sq > 0 ? sq - 1 : 0) * RC + c0;
                float zs[3][8];
#pragma unroll
                for (int q = 0; q < 3; ++q) {
                    const u32x4 ca = *(const u32x4*)(zr + q * RW); float pv[8];
                    if (tp > 0) { const u32x4 pa2 = *(const u32x4*)(zr - RC + q * RW);
#pragma unroll
                        for (int e = 0; e < 4; ++e) { pv[2 * e] = bf2f(pa2[e] & 0xffffu); pv[2 * e + 1] = bf2f(pa2[e] >> 16); } }
                    else if (sq > 0) { const f32x4 f0 = *(const f32x4*)(sh0 + q * RW), f1 = *(const f32x4*)(sh0 + q * RW + 4);
                        pv[0] = f0.x; pv[1] = f0.y; pv[2] = f0.z; pv[3] = f0.w; pv[4] = f1.x; pv[5] = f1.y; pv[6] = f1.z; pv[7] = f1.w; }
                    else {
#pragma unroll
                        for (int e = 0; e < 8; ++e) pv[e] = 0.f; }
                    const float* mu = prm + q * RW + c0;
#pragma unroll
                    for (int e = 0; e < 4; ++e) { const float z0 = bf2f(ca[e] & 0xffffu), z1 = bf2f(ca[e] >> 16);
                        zs[q][2 * e] = z0 + (pv[2 * e] - z0) * mu[2 * e]; zs[q][2 * e + 1] = z1 + (pv[2 * e + 1] - z1) * mu[2 * e + 1]; }
                }
                const u32x4 wa = *(const u32x4*)(lr), aa = *(const u32x4*)(lr + RW), ga = *(const u32x4*)(lr + 2 * RW);
                float wv[8], av[8], kkv[8], k2[8]; float s1 = 0.f, s2 = 0.f;
#pragma unroll
                for (int e = 0; e < 8; ++e) {
                    const float lwv = bf2f((e & 1) ? (wa[e >> 1] >> 16) : (wa[e >> 1] & 0xffffu)), lav = bf2f((e & 1) ? (aa[e >> 1] >> 16) : (aa[e >> 1] & 0xffffu));
                    wv[e] = __expf(-0.6065306597126334f * sigm(prm[3 * RW + c0 + e] + lwv));
                    av[e] = sigm(prm[4 * RW + c0 + e] + lav);
                    kkv[e] = zs[1][e] * prm[5 * RW + c0 + e]; s1 += kkv[e] * kkv[e];
                    k2[e] = zs[1][e] * (1.f + (av[e] - 1.f) * prm[6 * RW + c0 + e]); s2 += zs[0][e] * k2[e] * prm[7 * RW + c0 + e];
                }
                s1 += DPPF(0.f, s1, 0xB1, 0xF); s1 += DPPF(0.f, s1, 0x4E, 0xF); s1 += DPPF(0.f, s1, 0x141, 0xF);
                s2 += DPPF(0.f, s2, 0xB1, 0xF); s2 += DPPF(0.f, s2, 0x4E, 0xF); s2 += DPPF(0.f, s2, 0x141, 0xF);
                const float inrm = 1.f / fmaxf(sqrtf(s1), 1e-12f);
                const size_t o = (size_t)m * RW + c0;
#pragma unroll
                for (int e = 0; e < 2; ++e) {
                    const float k0 = kkv[4 * e] * inrm, k1 = kkv[4 * e + 1] * inrm, k2_ = kkv[4 * e + 2] * inrm, k3 = kkv[4 * e + 3] * inrm;
                    *(f32x4*)(PW + o + 4 * e) = (f32x4){wv[4 * e], wv[4 * e + 1], wv[4 * e + 2], wv[4 * e + 3]};
                    *(f32x4*)(PNKK + o + 4 * e) = (f32x4){-k0, -k1, -k2_, -k3};
                    *(f32x4*)(PB + o + 4 * e) = (f32x4){k0 * av[4 * e], k1 * av[4 * e + 1], k2_ * av[4 * e + 2], k3 * av[4 * e + 3]};
                    *(f32x4*)(PK + o + 4 * e) = (f32x4){k2[4 * e], k2[4 * e + 1], k2[4 * e + 2], k2[4 * e + 3]};
                    *(f32x4*)(PR + o + 4 * e) = (f32x4){zs[0][4 * e], zs[0][4 * e + 1], zs[0][4 * e + 2], zs[0][4 * e + 3]};
                }
                { u32x4 va;
#pragma unroll
                  for (int e = 0; e < 4; ++e) va[e] = pk2(zs[2][2 * e], zs[2][2 * e + 1]);
                  *(u32x4*)(PV + o) = va; *(u32x4*)(PG + o) = ga; }
                if ((lane & 7) == 0) BON[m * 16 + hd] = s2;
            }
        }
    }
    SEAM(5);
    if (IN(6)) for (int rep = 0; rep < (DUP_PHASE == 6 ? 2 : 1); ++rep) {
        MID(4);
        {
            float* wl = (float*)lds + wave * RL<0>::BUF;
            for (int task = gw; task < RH * NCH * 2; task += NGW) {
                const int part = task & 1, pair = task >> 1, h = pair / NCH, c = pair % NCH; const size_t o = (size_t)(c * LCH) * RW + h * 64;
                f32x2 S[32];
                if (part) {
#pragma unroll
                    for (int j = 0; j < 32; ++j) { S[j].x = (2 * j == lane) ? 1.f : 0.f; S[j].y = (2 * j + 1 == lane) ? 1.f : 0.f; }
                    rwkv_lds<1>(S, PW + o, PNKK + o, PB + o, PK + o, PR + o, PV + o, LCH, lane, nullptr, nullptr, nullptr, 0.f, 0.f, wl);
                } else {
#pragma unroll
                    for (int j = 0; j < 32; ++j) S[j] = (f32x2){0.f, 0.f};
                    rwkv_lds<0>(S, PW + o, PNKK + o, PB + o, PK + o, PR + o, PV + o, LCH, lane, nullptr, nullptr, nullptr, 0.f, 0.f, wl);
                }
                float* dst = PU + ((size_t)pair * 2 + (part ? 0 : 1)) * 4096 + lane * 64;
#pragma unroll
                for (int j = 0; j < 16; ++j) *(f32x4*)(dst + 4 * j) = (f32x4){S[2 * j].x, S[2 * j].y, S[2 * j + 1].x, S[2 * j + 1].y};
            }
        }
        __syncthreads();
        MID(5);
        bf16* kT = (bf16*)lds;
        bf16* vT = (bf16*)lds + 256 * 72;
        const int fr = lane & 15, fq = lane >> 4;
        for (int it = bid; it < EH * NRB * 2; it += G) {
            const int half = it & 1, blk = (it >> 1) % NRB, h = (it >> 1) / NRB; const float l2g = ret_l2g(h); const int m0 = blk * RBLK;
            f32x4 acc[2][8];
#pragma unroll
            for (int x = 0; x < 2; ++x)
#pragma unroll
                for (int y = 0; y < 8; ++y) acc[x][y] = (f32x4){0.f, 0.f, 0.f, 0.f};
            for (int ts = 0; ts < 4; ++ts) {
                __syncthreads();
#pragma unroll
                for (int i = 0; i < 4; ++i) { const int t = lane, dp = wave + 8 * i; const u32x4 raw = *(const u32x4*)(QKVG + (size_t)(m0 + ts * 64 + t) * EC + 1024 + h * 256 + dp * 8);
                    const float dec = exp2f(l2g * (float)(255 - (ts * 64 + t)));
#pragma unroll
                    for (int e = 0; e < 4; ++e) { const unsigned w = raw[e]; kT[(dp * 8 + 2 * e) * 72 + t] = (bf16)f2bf(bf2f(w & 0xffffu) * dec); kT[(dp * 8 + 2 * e + 1) * 72 + t] = (bf16)f2bf(bf2f(w >> 16) * dec); } }
#pragma unroll
                for (int i = 0; i < 2; ++i) { const int t = lane, ep = wave + 8 * i; const u32x4 raw = *(const u32x4*)(QKVG + (size_t)(m0 + ts * 64 + t) * EC + 2048 + h * 256 + half * 128 + ep * 8);
#pragma unroll
                    for (int e = 0; e < 4; ++e) { const unsigned w = raw[e]; vT[(ep * 8 + 2 * e) * 72 + t] = (bf16)(w & 0xffffu); vT[(ep * 8 + 2 * e + 1) * 72 + t] = (bf16)(w >> 16); } }
                __syncthreads();
#pragma unroll
                for (int kk = 0; kk < 2; ++kk) { bf16x8 af[2];
#pragma unroll
                    for (int x = 0; x < 2; ++x) af[x] = *(const bf16x8*)(kT + (32 * wave + 16 * x + fr) * 72 + kk * 32 + fq * 8);
#pragma unroll
                    for (int y = 0; y < 8; ++y) { const bf16x8 bfm = *(const bf16x8*)(vT + (16 * y + fr) * 72 + kk * 32 + fq * 8);
#pragma unroll
                        for (int x = 0; x < 2; ++x) acc[x][y] = __builtin_amdgcn_mfma_f32_16x16x32_bf16(af[x], bfm, acc[x][y], 0, 0, 0); } }
            }
            bf16* dst = KVB + ((size_t)(h * NRB + blk) * 256) * 256;
#pragma unroll
            for (int x = 0; x < 2; ++x)
#pragma unroll
                for (int y = 0; y < 8; ++y) { u32x2 w; w.x = pk2(acc[x][y][0], acc[x][y][1]); w.y = pk2(acc[x][y][2], acc[x][y][3]);
                    *(u32x2*)(dst + (size_t)(half * 128 + 16 * y + fr) * 256 + 32 * wave + 16 * x + fq * 4) = w; }
        }
    }
    if (IN(6)) MID(6);
    SEAM(6);
    if (IN(7)) for (int rep = 0; rep < (DUP_PHASE == 7 ? 2 : 1); ++rep) {
        const int nB = RH * 4;
        if (bid < nB || G <= nB) {
            float* Sb = (float*)lds;
            const int fr = lane & 15, fq = lane >> 4;
            for (int it = bid; it < nB; it += G) {
                const int h = it >> 2, g4 = it & 3; float* pu = PU + (size_t)(h * NCH) * 2 * 4096;
                __syncthreads();
                for (int idx = tid; idx < 16 * 65; idx += 512) Sb[idx] = 0.f;
                __syncthreads();
                if (wave < 4) {
                    float pa[16], pb[16]; f32x4 ua, ub;
#define PB_LOAD(dst, du, c) do { const float* pp = pu + (size_t)(c) * 2 * 4096; _Pragma("unroll") for (int kk = 0; kk < 16; ++kk) dst[kk] = pp[(4 * kk + fq) * 64 + 16 * wave + fr]; \
                        _Pragma("unroll") for (int jj = 0; jj < 4; ++jj) du[jj] = pp[4096 + (16 * g4 + 4 * fq + jj) * 64 + 16 * wave + fr]; } while (0)
                    PB_LOAD(pa, ua, 0); PB_LOAD(pb, ub, 1);
                    for (int c = 0; c < NCH; ++c) {
                        const float* Sc = Sb + (c & 1) * (16 * 65); float* Sn = Sb + ((c + 1) & 1) * (16 * 65);
                        f32x4 acc = ua, ac1 = {0.f, 0.f, 0.f, 0.f}, ac2 = ac1, ac3 = ac1;
#pragma unroll
                        for (int kk = 0; kk < 16; kk += 4) { acc = __builtin_amdgcn_mfma_f32_16x16x4f32(Sc[fr * 65 + 4 * kk + fq], pa[kk], acc, 0, 0, 0);
                            ac1 = __builtin_amdgcn_mfma_f32_16x16x4f32(Sc[fr * 65 + 4 * (kk + 1) + fq], pa[kk + 1], ac1, 0, 0, 0);
                            ac2 = __builtin_amdgcn_mfma_f32_16x16x4f32(Sc[fr * 65 + 4 * (kk + 2) + fq], pa[kk + 2], ac2, 0, 0, 0);
                            ac3 = __builtin_amdgcn_mfma_f32_16x16x4f32(Sc[fr * 65 + 4 * (kk + 3) + fq], pa[kk + 3], ac3, 0, 0, 0); }
                        acc = (acc + ac1) + (ac2 + ac3);
#pragma unroll
                        for (int jj = 0; jj < 4; ++jj) { Sn[(4 * fq + jj) * 65 + 16 * wave + fr] = acc[jj]; pu[(size_t)c * 2 * 4096 + 4096 + (16 * g4 + 4 * fq + jj) * 64 + 16 * wave + fr] = acc[jj]; }
                        if (c + 1 == NCH) {
#pragma unroll
                            for (int jj = 0; jj < 4; ++jj) out[O_WKP + (size_t)h * 4096 + (16 * g4 + 4 * fq + jj) * 64 + 16 * wave + fr] = acc[jj]; }
#pragma unroll
                        for (int kk = 0; kk < 16; ++kk) pa[kk] = pb[kk];
                        ua = ub;
                        if (c + 2 < NCH) PB_LOAD(pb, ub, c + 2);
                        asm volatile("s_waitcnt lgkmcnt(0)" ::: "memory");
                        __builtin_amdgcn_s_barrier();
                    }
#undef PB_LOAD
                } else {
                    for (int c = 0; c < NCH; ++c) __builtin_amdgcn_s_barrier();
                }
            }
        }
        if (bid >= nB || G <= nB) {
            const int nb2 = G <= nB ? G : G - nB, b2 = G <= nB ? bid : bid - nB;
            for (int it = b2 * 512 + tid; it < EH * 256 * 32; it += nb2 * 512) {
                const int h = it >> 13, e = (it >> 5) & 255, d0 = (it & 31) * 8; const float g256 = exp2f(256.f * ret_l2g(h));
                float acc[8];
#pragma unroll
                for (int q = 0; q < 8; ++q) acc[q] = 0.f;
                u32x4 kvr[NRB];
#pragma unroll
                for (int blk = 0; blk < NRB; ++blk) kvr[blk] = *(const u32x4*)(KVB + ((size_t)(h * NRB + blk) * 256 + e) * 256 + d0);
#pragma unroll
                for (int blk = 0; blk < NRB; ++blk) {
                    const size_t o = ((size_t)(h * NRB + blk) * 256 + e) * 256 + d0;
                    u32x4 w; w.x = pk2(acc[0], acc[1]); w.y = pk2(acc[2], acc[3]); w.z = pk2(acc[4], acc[5]); w.w = pk2(acc[6], acc[7]); *(u32x4*)(SPREV + o) = w;
                    const u32x4 kv = kvr[blk];
#pragma unroll
                    for (int q = 0; q < 4; ++q) { acc[2 * q] = acc[2 * q] * g256 + bf2f(kv[q] & 0xffffu); acc[2 * q + 1] = acc[2 * q + 1] * g256 + bf2f(kv[q] >> 16); }
                }
#pragma unroll
                for (int q = 0; q < 8; ++q) out[O_RTP + (size_t)h * 65536 + (size_t)(d0 + q) * 256 + e] = acc[q];
            }
        }
    }
    if (IN(7)) MID(10);
    SEAM(7);
    if (IN(8)) for (int rep = 0; rep < (DUP_PHASE == 8 ? 2 : 1); ++rep) {
        MID(7);
        if (wave < 5) {
            float* wl = (float*)lds + wave * RL<2>::BUF;
            const int ntask = wave < 4 ? RH * NCH : NB * RH;
            for (int task = wave < 4 ? bid * 4 + wave : bid; task < ntask; task += (wave < 4 ? G * 4 : G)) {
                f32x2 S[32]; int h, m0, nsteps; float* sdst = nullptr;
                if (wave < 4) { h = task / NCH; const int c = task % NCH; m0 = c * LCH; nsteps = LCH;
                    if (c == 0) {
#pragma unroll
                        for (int j = 0; j < 32; ++j) S[j] = (f32x2){0.f, 0.f};
                    } else { const float* src = PU + ((size_t)(h * NCH + c - 1) * 2 + 1) * 4096 + lane * 64;
#pragma unroll
                        for (int j = 0; j < 16; ++j) { const f32x4 q = *(const f32x4*)(src + 4 * j); S[2 * j] = (f32x2){q.x, q.y}; S[2 * j + 1] = (f32x2){q.z, q.w}; } }
                } else { const int b = task / RH; h = task % RH; m0 = TP + 16 * b; nsteps = TS;
                    const float* src = a.in[I_SWKV] + ((size_t)(b * RH + h) * 64 + lane) * 64; sdst = out + O_WKS + ((size_t)(b * RH + h) * 64 + lane) * 64;
#pragma unroll
                    for (int j = 0; j < 16; ++j) { const f32x4 q = *(const f32x4*)(src + 4 * j); S[2 * j] = (f32x2){q.x, q.y}; S[2 * j + 1] = (f32x2){q.z, q.w}; } }
                const size_t o = (size_t)m0 * RW + h * 64;
                rwkv_lds<2>(S, PW + o, PNKK + o, PB + o, PK + o, PR + o, PV + o, nsteps, lane, PG + o, BON + (size_t)m0 * 16 + h, MIX + (size_t)m0 * D + h * 64,
                            a.in[I_RLW][h * 64 + lane], a.in[I_RLB][h * 64 + lane], wl);
                if (sdst) {
#pragma unroll
                    for (int j = 0; j < 16; ++j) *(f32x4*)(sdst + 4 * j) = (f32x4){S[2 * j].x, S[2 * j].y, S[2 * j + 1].x, S[2 * j + 1].y}; }
            }
        }
        MID(8);
        {
            const int nb2 = G, b2 = bid;
            const int fr = lane & 15, fq = lane >> 4;
            for (int it0 = b2; it0 < EH * (TP / 64) + NB * EH * 4; it0 += nb2) {
                const int it = (nb2 == 256 && it0 >= 256 && it0 < 512) ? 767 - it0 : it0;
                __syncthreads();
#ifndef NO_RP
                if (it < EH * (TP / 64)) {
                    const int h = it / (TP / 64), n = it % (TP / 64), blk = n >> 2, i = n & 3, m0 = n * 64; const float l2g = ret_l2g(h);
                    bf16* qL = (bf16*)lds; bf16* kL = qL + 64 * 264; bf16* vT = kL + 64 * 264; bf16* pL = vT + 256 * 72; float* red = (float*)(pL + 64 * 72);
#pragma unroll
                    for (int x = 0; x < 4; ++x) { const int p = tid + 512 * x, t = p >> 5, dp = p & 31; *(u32x4*)(qL + t * 264 + dp * 8) = *(const u32x4*)(QKVG + (size_t)(m0 + t) * EC + h * 256 + dp * 8); }
                    __syncthreads();
                    if (it0 == b2 + nb2) MID(11);
                    f32x4 acc[4][2];
#pragma unroll
                    for (int x = 0; x < 4; ++x)
#pragma unroll
                        for (int y = 0; y < 2; ++y) acc[x][y] = (f32x4){0.f, 0.f, 0.f, 0.f};
                    if (blk > 0) {
                        const bf16* sp = SPREV + ((size_t)(h * NRB + blk) * 256) * 256;
#pragma unroll 2
                        for (int kk = 0; kk < 8; ++kk) { bf16x8 bfm[2];
#pragma unroll
                            for (int y = 0; y < 2; ++y) bfm[y] = *(const bf16x8*)(sp + (size_t)(32 * wave + 16 * y + fr) * 256 + kk * 32 + fq * 8);
#pragma unroll
                            for (int x = 0; x < 4; ++x) { const bf16x8 af = *(const bf16x8*)(qL + (16 * x + fr) * 264 + kk * 32 + fq * 8);
#pragma unroll
                                for (int y = 0; y < 2; ++y) acc[x][y] = __builtin_amdgcn_mfma_f32_16x16x32_bf16(af, bfm[y], acc[x][y], 0, 0, 0); } }
#pragma unroll
                        for (int x = 0; x < 4; ++x)
#pragma unroll
                            for (int jj = 0; jj < 4; ++jj) { const float qd = exp2f(l2g * (float)(64 * i + 16 * x + fq * 4 + jj + 1)); acc[x][0][jj] *= qd; acc[x][1][jj] *= qd; }
                    }
                    if (it0 == b2 + nb2) MID(12);
                    for (int j = 0; j <= i; ++j) {
                        __syncthreads();
                        const int ms = (blk * 4 + j) * 64;
#pragma unroll
                        for (int x = 0; x < 4; ++x) { const int p = tid + 512 * x, t = p >> 5, dp = p & 31;
                            *(u32x4*)(kL + t * 264 + dp * 8) = *(const u32x4*)(QKVG + (size_t)(ms + t) * EC + 1024 + h * 256 + dp * 8); }
#pragma unroll
                        for (int x = 0; x < 4; ++x) { const int t = lane, dp = wave + 8 * x;
                            const u32x4 raw = *(const u32x4*)(QKVG + (size_t)(ms + t) * EC + 2048 + h * 256 + dp * 8);
#pragma unroll
                            for (int e = 0; e < 4; ++e) { const unsigned w = raw[e]; vT[(dp * 8 + 2 * e) * 72 + t] = (bf16)(w & 0xffffu); vT[(dp * 8 + 2 * e + 1) * 72 + t] = (bf16)(w >> 16); } }
                        __syncthreads();
                        { const int tr = wave >> 1, tc0 = (wave & 1) * 2; f32x4 sa[2] = {(f32x4){0.f, 0.f, 0.f, 0.f}, (f32x4){0.f, 0.f, 0.f, 0.f}};
#pragma unroll
                            for (int kk = 0; kk < 8; ++kk) { const bf16x8 af = *(const bf16x8*)(qL + (16 * tr + fr) * 264 + kk * 32 + fq * 8);
#pragma unroll
                                for (int y = 0; y < 2; ++y) { const bf16x8 bfm = *(const bf16x8*)(kL + (16 * (tc0 + y) + fr) * 264 + kk * 32 + fq * 8); sa[y] = __builtin_amdgcn_mfma_f32_16x16x32_bf16(af, bfm, sa[y], 0, 0, 0); } }
#pragma unroll
                            for (int y = 0; y < 2; ++y)
#pragma unroll
                                for (int jj = 0; jj < 4; ++jj) { const int t = 16 * tr + fq * 4 + jj, s = 16 * (tc0 + y) + fr; const int dist = (j < i) ? 64 * (i - j) + t - s : (t > s ? t - s : s - t);
                                    pL[t * 72 + s] = (bf16)f2bf(sa[y][jj] * exp2f(l2g * (float)dist)); } }
                        __syncthreads();
#pragma unroll
                        for (int kk = 0; kk < 2; ++kk) { bf16x8 bfm[2];
#pragma unroll
                            for (int y = 0; y < 2; ++y) bfm[y] = *(const bf16x8*)(vT + (32 * wave + 16 * y + fr) * 72 + kk * 32 + fq * 8);
#pragma unroll
                            for (int x = 0; x < 4; ++x) { const bf16x8 af = *(const bf16x8*)(pL + (16 * x + fr) * 72 + kk * 32 + fq * 8);
#pragma unroll
                                for (int y = 0; y < 2; ++y) acc[x][y] = __builtin_amdgcn_mfma_f32_16x16x32_bf16(af, bfm[y], acc[x][y], 0, 0, 0); } }
                    }
                    if (it0 == b2 + nb2) MID(13);
#pragma unroll
                    for (int x = 0; x < 4; ++x)
#pragma unroll
                        for (int jj = 0; jj < 4; ++jj) { float s1 = acc[x][0][jj] + acc[x][1][jj], s2 = acc[x][0][jj] * acc[x][0][jj] + acc[x][1][jj] * acc[x][1][jj];
#pragma unroll
                            for (int o = 1; o < 16; o <<= 1) { s1 += __shfl_xor(s1, o); s2 += __shfl_xor(s2, o); }
                            if (fr == 0) { const int t = 16 * x + fq * 4 + jj; red[(t * 8 + wave) * 2] = s1; red[(t * 8 + wave) * 2 + 1] = s2; } }
                    __syncthreads();
                    float lw[2], lb[2];
#pragma unroll
                    for (int y = 0; y < 2; ++y) { lw[y] = a.in[I_ELW][h * 256 + 32 * wave + 16 * y + fr]; lb[y] = a.in[I_ELB][h * 256 + 32 * wave + 16 * y + fr]; }
#pragma unroll
                    for (int x = 0; x < 4; ++x)
#pragma unroll
                        for (int jj = 0; jj < 4; ++jj) { const int t = 16 * x + fq * 4 + jj; float s1 = 0.f, s2 = 0.f;
#pragma unroll
                            for (int w8 = 0; w8 < 8; ++w8) { s1 += red[(t * 8 + w8) * 2]; s2 += red[(t * 8 + w8) * 2 + 1]; }
                            const float mean = s1 * (1.f / 256.f), var = s2 * (1.f / 256.f) - mean * mean, rstd = rsqrtf(var + 1e-5f);
#pragma unroll
                            for (int y = 0; y < 2; ++y) { const int e = 32 * wave + 16 * y + fr; const float gt = bf2f(QKVG[(size_t)(m0 + t) * EC + 3072 + h * 256 + e]);
                                const float val = ((acc[x][y][jj] - mean) * rstd * lw[y] + lb[y]) * gt * sigm(gt);
                                MIX[(size_t)(m0 + t) * D + RW + h * 256 + e] = (bf16)f2bf(val); } }
                    if (it0 == b2 + nb2) MID(14);
                } else
#endif
#ifndef NO_RS
                {
                    const int r = it - EH * (TP / 64), tq = r & 3, b = (r >> 2) / EH, h = (r >> 2) % EH, m0 = TP + 16 * b; const float l2g = ret_l2g(h);
                    float* qf = (float*)lds; float* kf = qf + 4 * 260; float* vf = kf + 16 * 257; float* pf = vf + 16 * 257; float* red = pf + 64;
                    for (int idx = tid; idx < 16 * 256; idx += 512) { const int t = idx >> 8, dd = idx & 255; const bf16* src = QKVG + (size_t)(m0 + t) * EC + h * 256 + dd;
                        if ((t >> 2) == tq) qf[(t & 3) * 260 + dd] = bf2f(src[0]);
                        kf[t * 257 + dd] = bf2f(src[1024]); vf[t * 257 + dd] = bf2f(src[2048]); }
                    __syncthreads();
                    if (tid < 64) { const int tl = tid >> 4, s = tid & 15, t = 4 * tq + tl; float sc = 0.f;
#pragma unroll 4
                        for (int dd = 0; dd < 256; ++dd) sc += qf[tl * 260 + dd] * kf[s * 257 + dd];
                        pf[tl * 16 + s] = sc * exp2f(l2g * (float)(t > s ? t - s : s - t)); }
                    __syncthreads();
                    const int e = tid & 255, th = tid >> 8; const float* S0 = a.in[I_SRET] + (size_t)(b * EH + h) * 65536;
                    float oc[2] = {0.f, 0.f};
#pragma unroll 4
                    for (int dd = 0; dd < 256; dd += 4) { const f32x4 qa = *(const f32x4*)(qf + (2 * th) * 260 + dd), qb = *(const f32x4*)(qf + (2 * th + 1) * 260 + dd);
                        const float s0 = S0[(size_t)dd * 256 + e], s1 = S0[(size_t)(dd + 1) * 256 + e], s2 = S0[(size_t)(dd + 2) * 256 + e], s3 = S0[(size_t)(dd + 3) * 256 + e];
                        oc[0] += qa.x * s0 + qa.y * s1 + qa.z * s2 + qa.w * s3; oc[1] += qb.x * s0 + qb.y * s1 + qb.z * s2 + qb.w * s3; }
#pragma unroll
                    for (int tt = 0; tt < 2; ++tt) { const int tl = 2 * th + tt, t = 4 * tq + tl; float v = oc[tt] * exp2f(l2g * (float)(t + 1));
#pragma unroll 4
                        for (int s = 0; s < 16; ++s) v += pf[tl * 16 + s] * vf[s * 257 + e];
                        oc[tt] = v; }
                    { const float g16 = exp2f(16.f * l2g); float* dst = out + O_RTS + (size_t)(b * EH + h) * 65536; float vd[16];
#pragma unroll
                        for (int t = 0; t < 16; ++t) vd[t] = vf[t * 257 + e] * exp2f(l2g * (float)(15 - t));
#pragma unroll 4
                        for (int dd = 64 * tq + 32 * th; dd < 64 * tq + 32 * th + 32; ++dd) { float v = g16 * S0[(size_t)dd * 256 + e];
#pragma unroll
                            for (int t = 0; t < 16; ++t) v += kf[t * 257 + dd] * vd[t];
                            dst[(size_t)dd * 256 + e] = v; } }
#pragma unroll
                    for (int tt = 0; tt < 2; ++tt) { const float s1 = wave_sum(oc[tt]), s2 = wave_sum(oc[tt] * oc[tt]); if (lane == 0) { const int tl = 2 * th + tt; red[(tl * 4 + (wave & 3)) * 2] = s1; red[(tl * 4 + (wave & 3)) * 2 + 1] = s2; } }
                    __syncthreads();
                    const float lw = a.in[I_ELW][h * 256 + e], lb = a.in[I_ELB][h * 256 + e];
#pragma unroll
                    for (int tt = 0; tt < 2; ++tt) { const int tl = 2 * th + tt, t = 4 * tq + tl; float s1 = 0.f, s2 = 0.f;
#pragma unroll
                        for (int w4 = 0; w4 < 4; ++w4) { s1 += red[(tl * 4 + w4) * 2]; s2 += red[(tl * 4 + w4) * 2 + 1]; }
                        const float mean = s1 * (1.f / 256.f), var = s2 * (1.f / 256.f) - mean * mean, rstd = rsqrtf(var + 1e-5f);
                        const float gt = bf2f(QKVG[(size_t)(m0 + t) * EC + 3072 + h * 256 + e]);
                        MIX[(size_t)(m0 + t) * D + RW + h * 256 + e] = (bf16)f2bf(((oc[tt] - mean) * rstd * lw + lb) * gt * sigm(gt)); }
                }
#else
                {}
#endif
            }
        }
    }
    if (IN(8)) MID(9);
    SEAM(8);
    if (IN(9)) for (int rep = 0; rep < (DUP_PHASE == 9 ? 2 : 1); ++rep) {
        { pg8::Gemm g{MIX, WOUTT, TP, D, D, D}; pg8::StaticOrder S; S.init(TP, D, G, bid); EpiF32 E{MIXOUT, D};
          pg8::gemm_phase<EpiF32, pg8::StaticOrder, true, true>((PG8_LAS unsigned char*)lds, g, S, E); }
        { const int sl = bid >> 3; pg8::Gemm g{MIX + (size_t)TP * D + sl * 512, WOUTT + sl * 512, MS, D, 512, D}; pg8::OneUnit S{0, bid & 7, bid < 8 * KS9}; EpiF32 E{(float*)(ws + WS_PART9) + (size_t)sl * MS * D, D};
          pg8::gemm_phase<EpiF32, pg8::OneUnit, false, true>((PG8_LAS unsigned char*)lds, g, S, E); }
    }
    SEAM(9);
    if (IN(10)) for (int rep = 0; rep < (DUP_PHASE == 10 ? 2 : 1); ++rep) {
        for (int m = gw; m < M; m += NGW) {
            const float* xr = m < TP ? a.in[I_XP] + (size_t)m * D : a.in[I_XS] + (size_t)(m - TP) * D; const float* mod = MOD + seq_of(m) * MODW; const float* mr = MIXOUT + (size_t)m * D;
            f32x4 v[8]; float ss = 0.f;
#pragma unroll
            for (int j = 0; j < 8; ++j) {
                if (m < TP) v[j] = *(const f32x4*)(mr + 4 * lane + 256 * j);
                else { const float* pr = (const float*)(ws + WS_PART9) + (size_t)(m - TP) * D + 4 * lane + 256 * j; v[j] = *(const f32x4*)pr;
#pragma unroll
                    for (int q = 1; q < KS9; ++q) v[j] += *(const f32x4*)(pr + (size_t)q * MS * D); }
                ss += (v[j].x * v[j].x + v[j].y * v[j].y) + (v[j].z * v[j].z + v[j].w * v[j].w); }
            const float rs = rsqrtf(wave_sum(ss) * (1.f / D) + 1e-6f); float s2 = 0.f;
#pragma unroll
            for (int j = 0; j < 8; ++j) { const int c = 4 * lane + 256 * j; const f32x4 g = *(const f32x4*)(a.in[I_GPOM] + c), gt = *(const f32x4*)(mod + 2 * D + c), x = *(const f32x4*)(xr + c);
                v[j] = x + gt * (v[j] * rs * g); *(f32x4*)(out + (size_t)m * D + c) = v[j]; s2 += (v[j].x * v[j].x + v[j].y * v[j].y) + (v[j].z * v[j].z + v[j].w * v[j].w); }
            const float rs2 = rsqrtf(wave_sum(s2) * (1.f / D) + 1e-6f);
#pragma unroll
            for (int j = 0; j < 8; ++j) { const int c = 4 * lane + 256 * j; const f32x4 g = *(const f32x4*)(a.in[I_GPF] + c), s1 = *(const f32x4*)(mod + 4 * D + c), h1 = *(const f32x4*)(mod + 3 * D + c);
                const f32x4 h = v[j] * rs2 * g * (s1 + 1.f) + h1; u32x2 w; w.x = pk2(h.x, h.y); w.y = pk2(h.z, h.w); *(u32x2*)(H + (size_t)m * D + c) = w; }
        }
        float* scr = (float*)lds + wave * (64 * 33 + 16);
        constexpr int IT_UP = (D / 64) * (2 * FF / 32), IT_DN = (FF / 64) * (D / 32);
        for (int it = gw; it < IT_UP + IT_DN; it += NGW) {
            if (it < IT_UP) { const int nb = 2 * FF / 32, kb = it / nb, n0 = 32 * (it % nb); const int nn = n0 < FF ? n0 : n0 - FF; const int dr = 256 * (nn >> 7) + (n0 < FF ? 0 : 128) + (nn & 127);
                transpose_item(a.in[I_WUP], D, 2 * FF, WUPT, 64 * kb, n0, dr, scr, lane); }
            else { const int r = it - IT_UP, nb = D / 32, kb = r / nb, n0 = 32 * (r % nb); transpose_item(a.in[I_WDN], FF, D, WDNT, 64 * kb, n0, n0, scr, lane); }
        }
    }
    SEAM(10);
    if (IN(11)) for (int rep = 0; rep < (DUP_PHASE == 11 ? 2 : 1); ++rep) {
        pg8::Gemm g{H, WUPT, M, 2 * FF, D, D}; pg8::StaticOrder S; S.init(M, 2 * FF, G, bid); EpiSwiglu E{ACT};
        pg8::gemm_phase<EpiSwiglu, pg8::StaticOrder, true, true>((PG8_LAS unsigned char*)lds, g, S, E);
    }
    SEAM(11);
    if (IN(12)) for (int rep = 0; rep < (DUP_PHASE == 12 ? 2 : 1); ++rep) {
        { pg8::Gemm g{ACT, WDNT, TP, D, FF, FF}; pg8::StaticOrder S; S.init(TP, D, G, bid); EpiF32 E{MIXOUT, D};
          pg8::gemm_phase<EpiF32, pg8::StaticOrder, true, true>((PG8_LAS unsigned char*)lds, g, S, E); }
        { const int sl = bid >> 3; pg8::Gemm g{ACT + (size_t)TP * FF + sl * 512, WDNT + sl * 512, MS, D, 512, FF}; pg8::OneUnit S{0, bid & 7, bid < 8 * KS12}; EpiF32 E{(float*)(ws + WS_PART12) + (size_t)sl * MS * D, D};
          pg8::gemm_phase<EpiF32, pg8::OneUnit, false, true>((PG8_LAS unsigned char*)lds, g, S, E); }
    }
    SEAM(12);
    if (IN(13)) for (int rep = 0; rep < (DUP_PHASE == 13 ? 2 : 1); ++rep) {
        for (int m = gw; m < M; m += NGW) {
            const float* mod = MOD + seq_of(m) * MODW; const float* fr_ = MIXOUT + (size_t)m * D;
            f32x4 v[8]; float ss = 0.f;
#pragma unroll
            for (int j = 0; j < 8; ++j) {
                if (m < TP) v[j] = *(const f32x4*)(fr_ + 4 * lane + 256 * j);
                else { const float* pr = (const float*)(ws + WS_PART12) + (size_t)(m - TP) * D + 4 * lane + 256 * j; v[j] = *(const f32x4*)pr;
#pragma unroll
                    for (int q = 1; q < KS12; ++q) v[j] += *(const f32x4*)(pr + (size_t)q * MS * D); }
                ss += (v[j].x * v[j].x + v[j].y * v[j].y) + (v[j].z * v[j].z + v[j].w * v[j].w); }
            const float rs = rsqrtf(wave_sum(ss) * (1.f / D) + 1e-6f);
#pragma unroll
            for (int j = 0; j < 8; ++j) { const int c = 4 * lane + 256 * j; const f32x4 g = *(const f32x4*)(a.in[I_GPOF] + c), gt = *(const f32x4*)(mod + 5 * D + c), x = *(const f32x4*)(out + (size_t)m * D + c);
                *(f32x4*)(out + (size_t)m * D + c) = x + gt * (v[j] * rs * g); }
        }
    }
    if (TS_PROBE >= 0) {
        xcd_barrier(xb);
        if (bid == 0 && tid == 0) TSW[14] = __builtin_amdgcn_s_memrealtime();
        if (bid == 0) { __syncthreads(); const float us = TS_PROBE >= 100 ? (float)(TSW[32 + TS_PROBE - 100] - TSW[32 + TS_PROBE - 101]) * 0.01f : (float)(TSW[1 + TS_PROBE] - TSW[TS_PROBE]) * 0.01f; const float eps = sqrtf(us * 1e-4f);
            for (int c = tid; c < RC; c += 512) out[O_SHP + c] *= (1.f + eps); }
    }
#undef IN
#undef SEAM
}

extern "C" void kernel_launch(void* const* d_in, const int* in_sizes, int n_in, void* d_out, int out_size, void* d_ws, size_t ws_size, hipStream_t stream) {
    static int grid = 0;
    if (grid == 0) {
        if (n_in != 30 || (size_t)out_size != O_END || ws_size < WS_END) { fprintf(stderr, "kernel_launch: unexpected sizes n_in %d out %d ws %zu\n", n_in, out_size, ws_size); grid = -1; return; }
        int dev = 0, cus = 0, per_cu = 0;
        (void)hipGetDevice(&dev); (void)hipDeviceGetAttribute(&cus, hipDeviceAttributeMultiprocessorCount, dev);
        if (hipFuncSetAttribute((const void*)mk_fwd, hipFuncAttributeMaxDynamicSharedMemorySize, LDS_BYTES) != hipSuccess) { fprintf(stderr, "kernel_launch: hipFuncSetAttribute failed\n"); grid = -1; return; }
        if (hipOccupancyMaxActiveBlocksPerMultiprocessor(&per_cu, (const void*)mk_fwd, 512, LDS_BYTES) != hipSuccess || per_cu < 1) { fprintf(stderr, "kernel_launch: occupancy query says %d\n", per_cu); per_cu = 1; }
        (void)hipGetLastError();
        grid = cus;
        if (grid <= 0) grid = 256;
    }
    if (grid < 0) return;
    (void)hipMemsetAsync((char*)d_ws + 65536, 0, XCD_BAR_WORDS * 4, stream);
    Args a{};
    for (int i = 0; i < 30; ++i) a.in[i] = (const float*)d_in[i];
    a.out = (float*)d_out; a.ws = (unsigned char*)d_ws;
#if MK_MULTI
    for (int p = 0; p < NPHASE; ++p) { a.ph_lo = p; a.ph_hi = p + 1; hipLaunchKernelGGL(mk_fwd, dim3(grid), dim3(512), LDS_BYTES, stream, a); }
#else
    a.ph_lo = 0; a.ph_hi = NPHASE;
    void* args[] = {&a};
    hipError_t e = hipLaunchCooperativeKernel((const void*)mk_fwd, dim3(grid), dim3(512), args, LDS_BYTES, stream);
    if (e != hipSuccess) fprintf(stderr, "kernel_launch: cooperative launch failed: %s (grid %d)\n", hipGetErrorString(e), grid);
#endif
}
```

```cpp
#include <hip/hip_runtime.h>
#include <hip/hip_cooperative_groups.h>
#include <cstdio>
#include <cstdint>
namespace cg = cooperative_groups;
namespace pg8 {
#define PG8_LAS __attribute__((address_space(3)))
typedef unsigned short bf16_t;
typedef short bf16x8 __attribute__((ext_vector_type(8)));
typedef float f32x4 __attribute__((ext_vector_type(4)));
typedef unsigned u32x4 __attribute__((ext_vector_type(4)));
constexpr int BM = 256, BK = 64, HALF = 128, HTB = HALF * BK * 2  , STAGE_BYTES = 8 * HTB, NXCD = 8, WGM = 8;

__host__ __device__ __forceinline__ int lds_byte(int r, int c) { const int st = (r >> 4) * 2 + (c >> 5), rr = r & 15, cc = c & 31, ob = rr * 64 + cc * 2; return st * 1024 + (ob ^ (((ob >> 9) & 1) << 5)); }
__host__ __device__ __forceinline__ void stage_rc(int b, int& R, int& C) { const int st = b / 1024, sb = b % 1024, swz = sb ^ (((sb >> 9) & 1) << 5); R = (st >> 1) * 16 + swz / 64; C = (st & 1) * 32 + (swz % 64) / 2; }
__host__ __device__ __forceinline__ int perm32(int rho) { const int n = rho >> 4, i = rho & 15; return 8 * (i >> 2) + 4 * n + (i & 3); }

struct Unit { int pm, pn; };
struct Gemm { const bf16_t* A; const bf16_t* Bt; int M, N, K, ld; };

struct OneUnit {
    int pm, pn; bool active;
    __device__ __forceinline__ bool next(int i, Unit& u) const { if (i > 0 || !active) return false; u.pm = pm; u.pn = pn; return true; }
    __device__ __forceinline__ void a_ready(const Unit&) const {}
    __device__ __forceinline__ void done(const Unit&) const {}
};
struct StaticOrder {
    int nM, nN, nwg, G, c;
    __host__ __device__ void init(int M, int N, int G_, int c_) { nM = M / BM; nN = N / BM; nwg = nM * nN; G = G_; c = c_; }
    __host__ __device__ bool next(int i, Unit& u) const {
        const long L = (long)i * G + c; if (L >= nwg) return false;
        int wgid = (int)L; { const int q = nwg / NXCD, r = nwg % NXCD, xcd = wgid % NXCD, off = wgid / NXCD; wgid = (xcd < r ? xcd * (q + 1) : r * (q + 1) + (xcd - r) * q) + off; }
        const int nig = WGM * nN, gid = wgid / nig, fm = gid * WGM, gsz = (nM - fm) < WGM ? (nM - fm) : WGM;
        u.pm = fm + ((wgid % nig) % gsz); u.pn = (wgid % nig) / gsz; return true;
    }
    __device__ __forceinline__ void a_ready(const Unit&) const {}
    __device__ __forceinline__ void done(const Unit&) const {}
};

__device__ __forceinline__ unsigned cvt_pk_bf16(float lo, float hi) { unsigned r; asm volatile("v_cvt_pk_bf16_f32 %0, %1, %2" : "=v"(r) : "v"(lo), "v"(hi)); return r; }
template <class Epi, class Sched, bool ALIGN_EPI = false, bool SP2 = false>
__device__ __forceinline__ void gemm_phase(PG8_LAS unsigned char* lds, const Gemm g, const Sched& S, const Epi& E) {
    const int tid = threadIdx.x, wid = __builtin_amdgcn_readfirstlane(tid >> 6), lane = tid & 63, wr = wid >> 2, wc = wid & 3, fr = lane & 15, fq = lane >> 4;
    const int K = g.K, nt = K / BK;
    unsigned voffA[2], voffB[2];
#pragma unroll
    for (int i = 0; i < 2; ++i) { int R, C; stage_rc(tid * 16 + i * 8192, R, C); const int Rb = Epi::PERM ? ((R & ~31) + perm32(R & 31)) : R;
        voffA[i] = (unsigned)(R * g.ld + C) * 2u; voffB[i] = (unsigned)(Rb * g.ld + C) * 2u; }
    const size_t kstep = (size_t)(BK * 2);
    const size_t hstep = (size_t)HALF * g.ld * 2;
    const size_t tstep = 2 * hstep;
    const unsigned ldsw = (unsigned)wid * 1024u;
    const int aoff = lds_byte(wr * 64 + fr, fq * 8), boff = lds_byte(wc * 32 + fr, fq * 8);
#define PG8_SA(b, h) (((b) * 2 + (h)) * HTB)
#define PG8_SB(b, h) ((4 + (b) * 2 + (h)) * HTB)
#define PG8_STAGE(bufoff, gbase, voff) do { _Pragma("unroll") for (int _i = 0; _i < 2; ++_i) \
        __builtin_amdgcn_global_load_lds((const unsigned*)((const char*)(gbase) + (voff)[_i]), (PG8_LAS unsigned*)(lds + (bufoff) + ldsw + _i * 8192), 16, 0, 0); } while (0)
#define PG8_LDA(dst, b, h) do { _Pragma("unroll") for (int m = 0; m < 4; ++m) _Pragma("unroll") for (int k = 0; k < 2; ++k) dst[m][k] = *(const PG8_LAS bf16x8*)(lds + PG8_SA(b, h) + aoff + m * 2048 + k * 1024); } while (0)
#define PG8_LDB(dst, b, h) do { _Pragma("unroll") for (int n = 0; n < 2; ++n) _Pragma("unroll") for (int k = 0; k < 2; ++k) dst[n][k] = *(const PG8_LAS bf16x8*)(lds + PG8_SB(b, h) + boff + n * 2048 + k * 1024); } while (0)
#define PG8_MMA(ai, bj, At, Bt) do { __builtin_amdgcn_s_setprio(1); _Pragma("unroll") for (int m = 0; m < 4; ++m) _Pragma("unroll") for (int n = 0; n < 2; ++n) _Pragma("unroll") for (int k = 0; k < 2; ++k) \
        acc[ai][bj][m][n] = __builtin_amdgcn_mfma_f32_16x16x32_bf16(Bt[n][k], At[m][k], acc[ai][bj][m][n], 0, 0, 0); __builtin_amdgcn_s_setprio(0); } while (0)
#define PG8_WAIT_V(n) asm volatile("s_waitcnt vmcnt(" #n ")" ::: "memory")
#define PG8_WAIT_L(n) asm volatile("s_waitcnt lgkmcnt(" #n ")" ::: "memory")
#define PG8_BAR __builtin_amdgcn_s_barrier()
#define PG8_SCHED __builtin_amdgcn_sched_barrier(0)
    Unit cur, nxt; int ui = 0;
    if (!S.next(0, cur)) return;
    f32x4 acc[2][2][4][2];
#pragma unroll
    for (int a = 0; a < 2; ++a)
#pragma unroll
        for (int b = 0; b < 2; ++b)
#pragma unroll
            for (int m = 0; m < 4; ++m)
#pragma unroll
                for (int n = 0; n < 2; ++n) acc[a][b][m][n] = (f32x4){0.f, 0.f, 0.f, 0.f};
    bf16x8 At[4][2], B0[2][2], B1[2][2];
    const char* cA = (const char*)g.A + (size_t)cur.pm * tstep; const char* cB = (const char*)g.Bt + (size_t)cur.pn * tstep;
    S.a_ready(cur);
    if constexpr (SP2) {
        PG8_STAGE(PG8_SB(0, 0), cB, voffB); PG8_STAGE(PG8_SB(0, 1), cB + hstep, voffB); PG8_STAGE(PG8_SA(0, 0), cA, voffA); PG8_STAGE(PG8_SA(0, 1), cA + hstep, voffA);
        if (wr == 1) PG8_BAR;
        PG8_WAIT_V(2); PG8_BAR;
        PG8_STAGE(PG8_SB(1, 0), cB + kstep, voffB); PG8_STAGE(PG8_SA(1, 0), cA + kstep, voffA); PG8_STAGE(PG8_SB(1, 1), cB + hstep + kstep, voffB);
        PG8_WAIT_V(6); PG8_BAR;
    } else {
        PG8_STAGE(PG8_SB(0, 0), cB, voffB); PG8_STAGE(PG8_SA(0, 0), cA, voffA); PG8_STAGE(PG8_SB(0, 1), cB + hstep, voffB); PG8_STAGE(PG8_SA(0, 1), cA + hstep, voffA);
        if (wr == 1) PG8_BAR;
        PG8_WAIT_V(4); PG8_BAR;
        PG8_STAGE(PG8_SB(1, 0), cB + kstep, voffB); PG8_STAGE(PG8_SA(1, 0), cA + kstep, voffA); PG8_STAGE(PG8_SB(1, 1), cB + hstep + kstep, voffB);
        PG8_WAIT_V(6); PG8_BAR;
    }
    for (;;) {
        const bool has_next = S.next(ui + 1, nxt);
        const char* nA = has_next ? (const char*)g.A + (size_t)nxt.pm * tstep : cA; const char* nB = has_next ? (const char*)g.Bt + (size_t)nxt.pn * tstep : cB;
        for (int t = 0; t < nt; t += 2) {
            const bool last = (t == nt - 2);
            const char* a1 = cA + (size_t)(t + 1) * kstep;
            const char* a2 = last ? nA : cA + (size_t)(t + 2) * kstep; const char* b2 = last ? nB : cB + (size_t)(t + 2) * kstep;
            const char* a3 = a2 + kstep; const char* b3 = b2 + kstep;
            if (last && has_next) S.a_ready(nxt);
            if constexpr (SP2) {
            PG8_LDB(B0, 0, 0); PG8_LDB(B1, 0, 1); PG8_SCHED; PG8_LDA(At, 0, 0); PG8_STAGE(PG8_SA(1, 1), a1 + hstep, voffA);
            PG8_WAIT_V(8); PG8_WAIT_L(0); PG8_BAR; PG8_MMA(0, 0, At, B0); PG8_MMA(0, 1, At, B1); PG8_BAR; PG8_SCHED;
            PG8_LDA(At, 0, 1); PG8_STAGE(PG8_SB(0, 0), b2, voffB); PG8_STAGE(PG8_SB(0, 1), b2 + hstep, voffB); PG8_STAGE(PG8_SA(0, 0), a2, voffA);
            PG8_WAIT_V(8); PG8_WAIT_L(0); PG8_BAR; PG8_MMA(1, 0, At, B0); PG8_MMA(1, 1, At, B1); PG8_BAR; PG8_SCHED;
            PG8_LDB(B0, 1, 0); PG8_LDB(B1, 1, 1); PG8_SCHED; PG8_LDA(At, 1, 0); PG8_STAGE(PG8_SA(0, 1), a2 + hstep, voffA);
            PG8_WAIT_V(8); PG8_WAIT_L(0); PG8_BAR; PG8_MMA(0, 0, At, B0); PG8_MMA(0, 1, At, B1); PG8_BAR; PG8_SCHED;
            PG8_LDA(At, 1, 1); PG8_STAGE(PG8_SB(1, 0), b3, voffB); PG8_STAGE(PG8_SB(1, 1), b3 + hstep, voffB); PG8_STAGE(PG8_SA(1, 0), a3, voffA);
            PG8_WAIT_V(8); PG8_WAIT_L(0); PG8_BAR; PG8_MMA(1, 0, At, B0); PG8_MMA(1, 1, At, B1); PG8_BAR; PG8_SCHED;
            } else {
            PG8_LDB(B0, 0, 0); PG8_SCHED; PG8_LDA(At, 0, 0); PG8_STAGE(PG8_SA(1, 1), a1 + hstep, voffA);
            PG8_WAIT_L(8); PG8_BAR; PG8_WAIT_L(0); PG8_MMA(0, 0, At, B0); PG8_BAR; PG8_SCHED;
            PG8_LDB(B1, 0, 1); PG8_STAGE(PG8_SB(0, 0), b2, voffB);
            PG8_BAR; PG8_WAIT_L(0); PG8_MMA(0, 1, At, B1); PG8_BAR;
            PG8_LDA(At, 0, 1); PG8_STAGE(PG8_SA(0, 0), a2, voffA);
            PG8_BAR; PG8_WAIT_L(0); PG8_MMA(1, 0, At, B0); PG8_BAR; PG8_SCHED;
            PG8_STAGE(PG8_SB(0, 1), b2 + hstep, voffB);
            PG8_WAIT_V(6); PG8_BAR; PG8_MMA(1, 1, At, B1); PG8_BAR;
            PG8_LDB(B0, 1, 0); PG8_SCHED; PG8_LDA(At, 1, 0); PG8_STAGE(PG8_SA(0, 1), a2 + hstep, voffA);
            PG8_WAIT_L(8); PG8_BAR; PG8_WAIT_L(0); PG8_MMA(0, 0, At, B0); PG8_BAR; PG8_SCHED;
            PG8_LDB(B1, 1, 1); PG8_STAGE(PG8_SB(1, 0), b3, voffB);
            PG8_BAR; PG8_WAIT_L(0); PG8_MMA(0, 1, At, B1); PG8_BAR;
            PG8_LDA(At, 1, 1); PG8_STAGE(PG8_SA(1, 0), a3, voffA);
            PG8_BAR; PG8_WAIT_L(0); PG8_MMA(1, 0, At, B0); PG8_BAR; PG8_SCHED;
            PG8_STAGE(PG8_SB(1, 1), b3 + hstep, voffB);
            PG8_WAIT_V(6); PG8_BAR; PG8_MMA(1, 1, At, B1); PG8_BAR;
            }
        }
        if constexpr (ALIGN_EPI) { if (wr == 0) PG8_BAR; }
        if constexpr (!Epi::AFTER_DRAIN) { E(acc, cur, wr, wc, fr, fq); S.done(cur); }
        if (!has_next) break;
#pragma unroll
        for (int a = 0; a < 2; ++a)
#pragma unroll
            for (int b = 0; b < 2; ++b)
#pragma unroll
                for (int m = 0; m < 4; ++m)
#pragma unroll
                    for (int n = 0; n < 2; ++n) acc[a][b][m][n] = (f32x4){0.f, 0.f, 0.f, 0.f};
        cur = nxt; cA = nA; cB = nB; ++ui;
        if constexpr (ALIGN_EPI) { if (wr == 1) PG8_BAR; }
    }
    PG8_WAIT_V(0);
    if constexpr (!ALIGN_EPI) { if (wr == 0) PG8_BAR; }
    PG8_BAR;
    if constexpr (Epi::AFTER_DRAIN) { E.fused(acc, cur, wr, wc, fr, fq, lds, wid, lane); S.done(cur); }
#undef PG8_SA
#undef PG8_SB
#undef PG8_STAGE
#undef PG8_LDA
#undef PG8_LDB
#undef PG8_MMA
#undef PG8_WAIT_V
#undef PG8_WAIT_L
#undef PG8_BAR
#undef PG8_SCHED
}
}

constexpr int D = 2048, TP = 8192, NB = 16, TS = 16, MS = NB * TS, M = TP + MS;
constexpr int RW = 1024, RH = 16, RN = 64, RC = 3328;
constexpr int ED = 1024, EH = 4, EN = 256, EC = 4096, IC = RC + EC;
constexpr int FF = 5632, NSEQ = 17, MODW = 6 * D;
constexpr int LCH = 128, NCH = TP / LCH;
constexpr int RBLK = 256, NRB = TP / RBLK;
constexpr int NPHASE = 14;
constexpr size_t O_Y = 0, O_SHP = (size_t)M * D, O_WKP = O_SHP + RC, O_RTP = O_WKP + 65536, O_SHS = O_RTP + 262144, O_WKS = O_SHS + (size_t)NB * RC, O_RTS = O_WKS + (size_t)NB * 65536, O_END = O_RTS + (size_t)NB * 262144;
constexpr size_t MiB = 1u << 20;
constexpr size_t WS_MOD = 1 * MiB, WS_LORAT = 2 * MiB, WS_WOUTT = 4 * MiB, WS_WINT = 12 * MiB, WS_V = 12 * MiB, WS_H = 41 * MiB, WS_G = 41 * MiB, WS_BON = 58 * MiB,
                 WS_QKVG = 74 * MiB, WS_LOUT = 140 * MiB, WS_PU = 140 * MiB, WS_KVB = 172 * MiB, WS_ACT = 74 * MiB, WS_PREP = 190 * MiB, WS_MIXOUT = 190 * MiB,
                 WS_WUPT = 256 * MiB, WS_WDNT = 300 * MiB, WS_PART9 = 330 * MiB, WS_PART12 = 256 * MiB, WS_END = 355 * MiB;
constexpr size_t WS_ADAT = 190 * MiB, WS_SC = 239 * MiB, WS_MODP = 240 * MiB;
constexpr int KS9 = 4, KS12 = 11;
constexpr size_t PREP_STRIDE = 33 * MiB;
constexpr size_t DO_Z = 0, DO_LIN = 54 * MiB, DO_SPREV = 0, DO_MIX = 17 * MiB;
constexpr int LDS_BYTES = 147456;

typedef unsigned short bf16;
typedef float f32x2 __attribute__((ext_vector_type(2)));
typedef float f32x4 __attribute__((ext_vector_type(4)));
typedef short bf16x8 __attribute__((ext_vector_type(8)));
typedef unsigned u32x4 __attribute__((ext_vector_type(4)));
typedef unsigned u32x2 __attribute__((ext_vector_type(2)));
#define LDS_WAIT() asm volatile("s_waitcnt lgkmcnt(0)" ::: "memory")

__device__ __forceinline__ float bf2f(unsigned v) { return __builtin_bit_cast(float, v << 16); }
__device__ __forceinline__ unsigned f2bf(float f) { unsigned u = __builtin_bit_cast(unsigned, f); return (u + 0x7fffu + ((u >> 16) & 1u)) >> 16; }
__device__ __forceinline__ unsigned pk2(float lo, float hi) { return f2bf(lo) | (f2bf(hi) << 16); }
__device__ __forceinline__ float wave_sum(float v) {
#pragma unroll
    for (int o = 1; o < 64; o <<= 1) v += __shfl_xor(v, o);
    return v;
}
__device__ __forceinline__ float sigm(float x) { return 1.f / (1.f + __expf(-x)); }
__device__ __forceinline__ int seq_of(int m) { return m < TP ? 0 : 1 + ((m - TP) >> 4); }
__device__ __forceinline__ int tpos_of(int m) { return m < TP ? m : ((m - TP) & 15); }
__device__ __forceinline__ float ret_l2g(int h) { return __log2f(1.0f - exp2f(-5.0f - (float)h)); }

struct EpiProj {
    static constexpr bool PERM = true, AFTER_DRAIN = false;
    bf16* Z; bf16* Q;
    __device__ __forceinline__ void operator()(const f32x4 (&acc)[2][2][4][2], const pg8::Unit& u, int wr, int wc, int fr, int fq) const {
        const int row0 = u.pm * 256 + wr * 64 + fr, pn = u.pn, cl = wc * 32 + 8 * fq;
        if (pn < 13 || pn >= 21) {
            bf16* base = pn < 13 ? Z + pn * 256 + cl : Q + (pn - 13) * 256 + cl; const size_t ld = pn < 13 ? RC : EC;
#pragma unroll
            for (int ai = 0; ai < 2; ++ai)
#pragma unroll
                for (int m = 0; m < 4; ++m) { bf16* rp = base + (size_t)(row0 + ai * 128 + m * 16) * ld;
#pragma unroll
                    for (int bj = 0; bj < 2; ++bj) { const f32x4 v0 = acc[ai][bj][m][0], v1 = acc[ai][bj][m][1]; u32x4 w; w.x = pk2(v0[0], v0[1]); w.y = pk2(v0[2], v0[3]); w.z = pk2(v1[0], v1[1]); w.w = pk2(v1[2], v1[3]);
                        *(u32x4*)(rp + bj * 128) = w; } }
        } else {
            const int sec = pn - 13; bf16* base = Q + sec * 256 + cl; const float sc = sec >= 4 ? 0.0625f : 1.0f;
            float inv[8];
#pragma unroll
            for (int e = 0; e < 8; ++e) inv[e] = exp2f(-(float)(cl + e) * (13.287712379549449f / 128.0f)) * 0.15915494309189535f;
#pragma unroll
            for (int ai = 0; ai < 2; ++ai)
#pragma unroll
                for (int m = 0; m < 4; ++m) { const int row = row0 + ai * 128 + m * 16; bf16* rp = base + (size_t)row * EC;
                    const float pos = row < TP ? (float)row : (float)(2048 + ((row - TP) & 15));
                    float o1[8], o2[8];
#pragma unroll
                    for (int e = 0; e < 8; ++e) { float rev = pos * inv[e]; rev -= floorf(rev); const float sn = __builtin_amdgcn_sinf(rev), cs = __builtin_amdgcn_cosf(rev);
                        const float x1 = acc[ai][0][m][e >> 2][e & 3], x2 = acc[ai][1][m][e >> 2][e & 3];
                        o1[e] = (x1 * cs - x2 * sn) * sc; o2[e] = (x2 * cs + x1 * sn) * sc; }
                    u32x4 w; w.x = pk2(o1[0], o1[1]); w.y = pk2(o1[2], o1[3]); w.z = pk2(o1[4], o1[5]); w.w = pk2(o1[6], o1[7]); *(u32x4*)rp = w;
                    w.x = pk2(o2[0], o2[1]); w.y = pk2(o2[2], o2[3]); w.z = pk2(o2[4], o2[5]); w.w = pk2(o2[6], o2[7]); *(u32x4*)(rp + 128) = w; }
        }
    }
};
struct EpiBf16P {
    static constexpr bool PERM = true, AFTER_DRAIN = false;
    bf16* C; int ldc;
    __device__ __forceinline__ void operator()(const f32x4 (&acc)[2][2][4][2], const pg8::Unit& u, int wr, int wc, int fr, int fq) const {
        const int row0 = u.pm * 256 + wr * 64 + fr; bf16* base = C + u.pn * 256 + wc * 32 + 8 * fq;
#pragma unroll
        for (int ai = 0; ai < 2; ++ai)
#pragma unroll
            for (int m = 0; m < 4; ++m) { bf16* rp = base + (size_t)(row0 + ai * 128 + m * 16) * ldc;
#pragma unroll
                for (int bj = 0; bj < 2; ++bj) { const f32x4 v0 = acc[ai][bj][m][0], v1 = acc[ai][bj][m][1]; u32x4 w; w.x = pk2(v0[0], v0[1]); w.y = pk2(v0[2], v0[3]); w.z = pk2(v1[0], v1[1]); w.w = pk2(v1[2], v1[3]);
                    *(u32x4*)(rp + bj * 128) = w; } }
    }
};
struct EpiF32 {
    static constexpr bool PERM = true, AFTER_DRAIN = false;
    float* C; int ldc;
    __device__ __forceinline__ void operator()(const f32x4 (&acc)[2][2][4][2], const pg8::Unit& u, int wr, int wc, int fr, int fq) const {
        const int row0 = u.pm * 256 + wr * 64 + fr; float* base = C + u.pn * 256 + wc * 32 + 8 * fq;
#pragma unroll
        for (int ai = 0; ai < 2; ++ai)
#pragma unroll
            for (int m = 0; m < 4; ++m) { float* rp = base + (size_t)(row0 + ai * 128 + m * 16) * ldc;
#pragma unroll
                for (int bj = 0; bj < 2; ++bj) { *(f32x4*)(rp + bj * 128) = acc[ai][bj][m][0]; *(f32x4*)(rp + bj * 128 + 4) = acc[ai][bj][m][1]; } }
    }
};
struct EpiSwiglu {
    static constexpr bool PERM = true, AFTER_DRAIN = false;
    bf16* C;
    __device__ __forceinline__ void operator()(const f32x4 (&acc)[2][2][4][2], const pg8::Unit& u, int wr, int wc, int fr, int fq) const {
        const int row0 = u.pm * 256 + wr * 64 + fr; bf16* base = C + u.pn * 128 + wc * 32 + 8 * fq;
#pragma unroll
        for (int ai = 0; ai < 2; ++ai)
#pragma unroll
            for (int m = 0; m < 4; ++m) { float o[8];
#pragma unroll
                for (int e = 0; e < 8; ++e) { const float g = acc[ai][0][m][e >> 2][e & 3], up = acc[ai][1][m][e >> 2][e & 3]; o[e] = g * sigm(g) * up; }
                u32x4 w; w.x = pk2(o[0], o[1]); w.y = pk2(o[2], o[3]); w.z = pk2(o[4], o[5]); w.w = pk2(o[6], o[7]);
                *(u32x4*)(base + (size_t)(row0 + ai * 128 + m * 16) * FF) = w; }
    }
};
struct EpiMod {
    static constexpr bool PERM = true, AFTER_DRAIN = false;
    float* C; int ldc;
    __device__ __forceinline__ void operator()(const f32x4 (&acc)[2][2][4][2], const pg8::Unit& u, int wr, int wc, int fr, int fq) const {
        if (wr != 0) return;
        float* base = C + u.pn * 256 + wc * 32 + 8 * fq;
#pragma unroll
        for (int m = 0; m < 2; ++m) { const int row = 16 * m + fr; if (row < NSEQ) { float* rp = base + (size_t)row * ldc;
#pragma unroll
            for (int bj = 0; bj < 2; ++bj) { *(f32x4*)(rp + bj * 128) = acc[0][bj][m][0]; *(f32x4*)(rp + bj * 128 + 4) = acc[0][bj][m][1]; } } }
    }
};

__device__ __forceinline__ void transpose_item(const float* __restrict__ W, int K, int N, bf16* WT, int k0, int n0, int dst_row0, float* scr, int lane) {
#pragma unroll 8
    for (int i = 0; i < 32; ++i) { const int kk = 2 * i + (lane >> 5); scr[kk * 33 + (lane & 31)] = W[(size_t)(k0 + kk) * N + n0 + (lane & 31)]; }
    LDS_WAIT();
    const int c = lane & 7;
#pragma unroll
    for (int j = 0; j < 4; ++j) { const int n = (lane >> 3) + 8 * j; const float* s = scr + (8 * c) * 33 + n;
        u32x4 o; o.x = pk2(s[0 * 33], s[1 * 33]); o.y = pk2(s[2 * 33], s[3 * 33]); o.z = pk2(s[4 * 33], s[5 * 33]); o.w = pk2(s[6 * 33], s[7 * 33]);
        *(u32x4*)(WT + (size_t)(dst_row0 + n) * K + k0 + 8 * c) = o; }
    LDS_WAIT();
}

typedef const __attribute__((address_space(4))) f32x2* cf2p;
__device__ __forceinline__ cf2p to_c(const float* p) { return (cf2p)(unsigned long long)p; }
#define DPPF(old, src, ctrl, rmask) __builtin_bit_cast(float, __builtin_amdgcn_update_dpp(__builtin_bit_cast(int, (float)(old)), __builtin_bit_cast(int, (float)(src)), (ctrl), (rmask), 0xF, false))
__device__ __forceinline__ float wave_sum_u(float v) {
    v += DPPF(0.f, v, 0xB1, 0xF); v += DPPF(0.f, v, 0x4E, 0xF); v += DPPF(0.f, v, 0x124, 0xF); v += DPPF(0.f, v, 0x128, 0xF);
    v += DPPF(0.f, v, 0x142, 0xA); v += DPPF(0.f, v, 0x143, 0xC);
    return __builtin_bit_cast(float, __builtin_amdgcn_readlane(__builtin_bit_cast(int, v), 63));
}
constexpr int RW_PF = 6;
template <int MODE>
__device__ __forceinline__ void rwkv_run(f32x2 (&S)[32], const float* W, const float* NKK, const float* B, const float* K, const float* R, const bf16* Vp, int nsteps, int lane,
                                         const bf16* Gp, const float* BONp, bf16* MIXp, float lnw, float lnb) {
    constexpr int NPF = MODE == 2 ? 20 : (MODE == 0 ? 16 : 12);
    const int pa = lane >> 2; const float* pfp = (pa == 0 ? W : pa == 1 ? NKK : pa == 2 ? B : pa == 3 ? K : R) + (lane & 3) * 16;
    float vn = 0.f, gn = 0.f, bn = 0.f;
    if (MODE != 1) vn = bf2f(Vp[lane]);
    if (MODE == 2) { gn = bf2f(Gp[lane]); bn = BONp[0]; }
    if (lane < NPF) {
#pragma unroll
        for (int q = 1; q < RW_PF; ++q) if (q < nsteps) (void)*(volatile const float*)(pfp + (size_t)q * RW);
    }
    for (int t = 0; t < nsteps; ++t) {
        const size_t o = (size_t)t * RW;
        cf2p w = to_c(W + o), nk = to_c(NKK + o), b = to_c(B + o), k = to_c(K + o), r = to_c(R + o);
        const float v = vn, gv = gn, bon = bn;
        { const int t1 = t + 1 < nsteps ? t + 1 : t; const size_t o1 = (size_t)t1 * RW;
          if (MODE != 1) vn = bf2f(Vp[o1 + lane]);
          if (MODE == 2) { gn = bf2f(Gp[o1 + lane]); bn = BONp[(size_t)t1 * 16]; }
          const int tp = t + RW_PF < nsteps ? t + RW_PF : nsteps - 1;
          if (lane < NPF) (void)*(volatile const float*)(pfp + (size_t)tp * RW); }
        f32x2 a0 = {0.f, 0.f}, a1 = {0.f, 0.f};
#pragma unroll
        for (int j = 0; j < 32; j += 2) { a0 = __builtin_elementwise_fma(S[j], nk[j], a0); a1 = __builtin_elementwise_fma(S[j + 1], nk[j + 1], a1); }
        const float sa = (a0.x + a0.y) + (a1.x + a1.y);
        const f32x2 sa2 = {sa, sa}, v2 = {v, v};
        f32x2 o0 = {0.f, 0.f}, o1 = {0.f, 0.f};
#pragma unroll
        for (int j = 0; j < 32; ++j) {
            f32x2 s = S[j] * w[j];
            s = __builtin_elementwise_fma(sa2, b[j], s);
            if (MODE != 1) s = __builtin_elementwise_fma(v2, k[j], s);
            S[j] = s;
            if (MODE == 2) { if (j & 1) o1 = __builtin_elementwise_fma(s, r[j], o1); else o0 = __builtin_elementwise_fma(s, r[j], o0); }
        }
        if (MODE == 2) {
            const float ov = (o0.x + o0.y) + (o1.x + o1.y);
            const float mean = wave_sum_u(ov) * (1.f / 64.f), d = ov - mean, var = wave_sum_u(d * d) * (1.f / 64.f);
            float y = d * rsqrtf(var + 64e-5f) * lnw + lnb;
            y = (y + bon * v) * gv;
            MIXp[(size_t)t * D + lane] = (bf16)f2bf(y);
        }
    }
}

constexpr int RL_B = 8;
template <int MODE> struct RL { static constexpr int NV = MODE == 2 ? 5 : (MODE == 0 ? 4 : 3); static constexpr int REC = NV * 64, BUF = RL_B * REC + (MODE != 1 ? 256 : 0) + (MODE == 2 ? 256 + 16 : 0); };
#define SBAR() __builtin_amdgcn_sched_barrier(0)
template <int MODE>
__device__ __forceinline__ void rwkv_lds(f32x2 (&S)[32], const float* W, const float* NKK, const float* B, const float* K, const float* R, const bf16* Vp, int nsteps, int lane,
                                         const bf16* Gp, const float* BONp, bf16* MIXp, float lnw, float lnb, float* wl) {
    constexpr int NV = RL<MODE>::NV, REC = RL<MODE>::REC;
    const int ls = lane >> 4, lc = (lane & 15) * 4;
    f32x4 st[NV][2]; u32x4 sv = {0u, 0u, 0u, 0u}, sg = {0u, 0u, 0u, 0u}; float sb = 0.f;
#define RL_ISSUE(bt) do { const size_t ob = (size_t)((bt) * RL_B) * RW; \
        _Pragma("unroll") for (int q = 0; q < 2; ++q) { const size_t oo = ob + (size_t)(ls + 4 * q) * RW + lc; \
            st[0][q] = *(const f32x4*)(W + oo); st[1][q] = *(const f32x4*)(NKK + oo); st[2][q] = *(const f32x4*)(B + oo); if (NV >= 4) st[NV >= 4 ? 3 : 0][q] = *(const f32x4*)(K + oo); if (NV == 5) st[NV - 1][q] = *(const f32x4*)(R + oo); } \
        if (MODE != 1) sv = *(const u32x4*)(Vp + ob + (size_t)(lane >> 3) * RW + (lane & 7) * 8); \
        if (MODE == 2) { sg = *(const u32x4*)(Gp + ob + (size_t)(lane >> 3) * RW + (lane & 7) * 8); if (lane < RL_B) sb = BONp[(size_t)((bt) * RL_B + lane) * 16]; } } while (0)
#define RL_COMMIT() do { \
        _Pragma("unroll") for (int q = 0; q < 2; ++q) _Pragma("unroll") for (int v = 0; v < NV; ++v) *(f32x4*)(wl + (ls + 4 * q) * REC + v * 64 + lc) = st[v][q]; \
        if (MODE != 1) *(u32x4*)((bf16*)(wl + RL_B * REC) + (lane >> 3) * 64 + (lane & 7) * 8) = sv; \
        if (MODE == 2) { *(u32x4*)((bf16*)(wl + RL_B * REC + 256) + (lane >> 3) * 64 + (lane & 7) * 8) = sg; if (lane < RL_B) wl[RL_B * REC + 512 + lane] = sb; } } while (0)
    const int nb = nsteps / RL_B;
    RL_ISSUE(0); RL_COMMIT();
    for (int bt = 0; bt < nb; ++bt) {
        if (bt + 1 < nb) RL_ISSUE(bt + 1);
#pragma unroll 1
        for (int s = 0; s < RL_B; ++s) {
            const f32x2* w = (const f32x2*)(wl + s * REC); const f32x2* nk = w + 32; const f32x2* b = w + 64; const f32x2* k = w + 96; const f32x2* r = w + 128;
            float v = 0.f, gv = 0.f, bon = 0.f;
            if (MODE != 1) v = bf2f(((const bf16*)(wl + RL_B * REC))[s * 64 + lane]);
            if (MODE == 2) { gv = bf2f(((const bf16*)(wl + RL_B * REC + 256))[s * 64 + lane]); bon = wl[RL_B * REC + 512 + s]; }
            f32x2 nA[8], nB[8]; f32x2 a0 = {0.f, 0.f}, a1 = {0.f, 0.f};
#pragma unroll
            for (int p = 0; p < 8; ++p) nA[p] = nk[p];
#pragma unroll
            for (int g = 0; g < 4; ++g) {
                if (g < 3) {
#pragma unroll
                    for (int p = 0; p < 8; ++p) { if (g & 1) nA[p] = nk[8 * (g + 1) + p]; else nB[p] = nk[8 * (g + 1) + p]; } }
                SBAR();
#pragma unroll
                for (int p = 0; p < 8; p += 2) { a0 = __builtin_elementwise_fma(S[8 * g + p], (g & 1) ? nB[p] : nA[p], a0); a1 = __builtin_elementwise_fma(S[8 * g + p + 1], (g & 1) ? nB[p + 1] : nA[p + 1], a1); }
                SBAR();
            }
            const float sa = (a0.x + a0.y) + (a1.x + a1.y);
            const f32x2 sa2 = {sa, sa}, v2 = {v, v};
            f32x2 uw[2][4], ub[2][4], uk[2][4], ur[2][4]; f32x2 o0 = {0.f, 0.f}, o1 = {0.f, 0.f};
#pragma unroll
            for (int p = 0; p < 4; ++p) { uw[0][p] = w[p]; ub[0][p] = b[p]; if (MODE != 1) uk[0][p] = k[p]; if (MODE == 2) ur[0][p] = r[p]; }
#pragma unroll
            for (int g = 0; g < 8; ++g) {
                if (g < 7) {
#pragma unroll
                    for (int p = 0; p < 4; ++p) { uw[(g + 1) & 1][p] = w[4 * (g + 1) + p]; ub[(g + 1) & 1][p] = b[4 * (g + 1) + p]; if (MODE != 1) uk[(g + 1) & 1][p] = k[4 * (g + 1) + p]; if (MODE == 2) ur[(g + 1) & 1][p] = r[4 * (g + 1) + p]; } }
                SBAR();
#pragma unroll
                for (int p = 0; p < 4; ++p) { const int j = 4 * g + p;
                    f32x2 x = S[j] * uw[g & 1][p]; x = __builtin_elementwise_fma(sa2, ub[g & 1][p], x); if (MODE != 1) x = __builtin_elementwise_fma(v2, uk[g & 1][p], x); S[j] = x;
                    if (MODE == 2) { if (p & 1) o1 = __builtin_elementwise_fma(x, ur[g & 1][p], o1); else o0 = __builtin_elementwise_fma(x, ur[g & 1][p], o0); } }
                SBAR();
            }
            if (MODE == 2) {
                const float ov = (o0.x + o0.y) + (o1.x + o1.y);
                const float mean = wave_sum_u(ov) * (1.f / 64.f), d = ov - mean, var = wave_sum_u(d * d) * (1.f / 64.f);
                float y = d * rsqrtf(var + 64e-5f) * lnw + lnb;
                y = (y + bon * v) * gv;
                MIXp[(size_t)(bt * RL_B + s) * D + lane] = (bf16)f2bf(y);
            }
        }
        if (bt + 1 < nb) RL_COMMIT();
    }
#undef RL_ISSUE
#undef RL_COMMIT
}
#define LAS __attribute__((address_space(3)))

#define XB_TMO      128
#define XB_XCNT(j)  (256  + 64 * (j))
#define XB_XSUB(j)  (1280 + 64 * (j))
#define XB_XGEN(j)  (2304 + 64 * (j))
#define XB_TOP      3328
#define XB_TOPGEN   3392
#define XCD_BAR_WORDS 3456
#define XB_SPIN_CAP (1u << 18)

__device__ __forceinline__ unsigned xb_ld(unsigned* p)              { return __hip_atomic_load(p, __ATOMIC_RELAXED, __HIP_MEMORY_SCOPE_AGENT); }
__device__ __forceinline__ unsigned xb_add(unsigned* p, unsigned v) { return __hip_atomic_fetch_add(p, v, __ATOMIC_RELAXED, __HIP_MEMORY_SCOPE_AGENT); }
__device__ __forceinline__ unsigned xb_xcc_id() { return (unsigned)__builtin_amdgcn_s_getreg((3 << 11) | 20) & 0xFu; }
#define XB_SPIN(cond, bar) do { unsigned _sp = 0; while (cond) { __builtin_amdgcn_s_sleep(1); \
    if ((++_sp & 255u) == 0u) { if (xb_ld(&(bar)[XB_TMO])) break; if (_sp > XB_SPIN_CAP) { atomicAdd(&(bar)[XB_TMO], 1u); break; } } } } while (0)

struct XcdBarrier {
    unsigned* bar; unsigned x;
    volatile LAS unsigned* st;
};

__device__ __forceinline__ XcdBarrier xcd_barrier_post(unsigned* bar, volatile LAS unsigned* st) {
    XcdBarrier b; b.bar = bar; b.x = xb_xcc_id(); b.st = st;
    if (threadIdx.x == 0) (void)xb_add(&bar[XB_XCNT(b.x)], 1u);
    return b;
}
__device__ __forceinline__ void xcd_barrier_complete(unsigned* bar, unsigned x, unsigned& nloc, unsigned& nx) {
    const unsigned G = gridDim.x * gridDim.y * gridDim.z;
    unsigned sum, cnt, mine, sp = 0u;
    for (;;) {
        sum = 0u; cnt = 0u; mine = 0u;
#pragma unroll
        for (unsigned j = 0; j < 16; ++j) { const unsigned c = xb_ld(&bar[XB_XCNT(j)]); sum += c; cnt += (c > 0u) ? 1u : 0u; mine = (j == x) ? c : mine; }
        if (sum == G) break;
        __builtin_amdgcn_s_sleep(1);
        if ((++sp & 255u) == 0u) { if (xb_ld(&bar[XB_TMO])) break; if (sp > XB_SPIN_CAP) { atomicAdd(&bar[XB_TMO], 1u); break; } }
    }
    nloc = mine > 0u ? mine : 1u; nx = cnt > 0u ? cnt : 1u;
}

__device__ __forceinline__ void xcd_barrier(const XcdBarrier& b) {
    asm volatile("s_waitcnt vmcnt(0)" ::: "memory");
    __syncthreads();
    if (threadIdx.x == 0) {
        unsigned* bar = b.bar;
        __builtin_amdgcn_s_waitcnt(0);
        unsigned nloc = b.st[0], nx = b.st[1];
        if (nloc == 0u) { xcd_barrier_complete(bar, b.x, nloc, nx); b.st[0] = nloc; b.st[1] = nx; }
        const unsigned old = xb_add(&bar[XB_XSUB(b.x)], 1u);
        const unsigned gen = old / nloc;
        if (old + 1u == (gen + 1u) * nloc) {
            __builtin_amdgcn_fence(__ATOMIC_RELEASE, "agent");
            asm volatile("s_waitcnt vmcnt(0)" ::: "memory");
            const unsigned og = xb_add(&bar[XB_TOP], 1u);
            const unsigned tg = og / nx;
            if (og + 1u == (tg + 1u) * nx) xb_add(&bar[XB_TOPGEN], 1u);
            else XB_SPIN(xb_ld(&bar[XB_TOPGEN]) == tg, bar);
            __builtin_amdgcn_fence(__ATOMIC_ACQUIRE, "agent");
            xb_add(&bar[XB_XGEN(b.x)], 1u);
            asm volatile("s_waitcnt vmcnt(0)" ::: "memory");
        } else {
            XB_SPIN(xb_ld(&bar[XB_XGEN(b.x)]) == gen, bar);
            __builtin_amdgcn_fence(__ATOMIC_ACQUIRE, "agent");
            asm volatile("s_waitcnt vmcnt(0)" ::: "memory");
        }
    }
    __syncthreads();
}


struct Args { const float* in[30]; float* out; unsigned char* ws; int ph_lo, ph_hi; };
enum { I_XP = 0, I_XS, I_CP, I_CS, I_SSH, I_SWKV, I_SRET, I_ADAW, I_ADAB, I_GPM, I_GPOM, I_GPF, I_GPOF, I_WIN, I_MU, I_W0, I_W2, I_A0, I_A2, I_G2, I_KK, I_KA, I_RK, I_RLW, I_RLB, I_ELW, I_ELB, I_WOUT, I_WUP, I_WDN };

__global__ void __launch_bounds__(512, 2) mk_fwd(Args a) {
    extern __shared__ __attribute__((aligned(16))) unsigned char lds[];
    cg::grid_group grid = cg::this_grid();
    const int tid = threadIdx.x, lane = tid & 63, wave = __builtin_amdgcn_readfirstlane(tid >> 6);
    const int G = gridDim.x, bid = blockIdx.x, gw = bid * 8 + wave, NGW = G * 8;
    const int lo = a.ph_lo, hi = a.ph_hi;
    volatile LAS unsigned* xst = (volatile LAS unsigned*)((LAS unsigned char*)lds + LDS_BYTES - 16);
    if (tid < 2) xst[tid] = 0u;
    __syncthreads();
    XcdBarrier xb = xcd_barrier_post((unsigned*)(a.ws + 65536), xst);
    unsigned char* ws = a.ws; float* out = a.out; unsigned char* dob = (unsigned char*)a.out;
    float* MOD = (float*)(ws + WS_MOD);
    bf16* LORAT = (bf16*)(ws + WS_LORAT); bf16* WOUTT = (bf16*)(ws + WS_WOUTT); bf16* WINT = (bf16*)(ws + WS_WINT); bf16* WUPT = (bf16*)(ws + WS_WUPT); bf16* WDNT = (bf16*)(ws + WS_WDNT);
    bf16* H = (bf16*)(ws + WS_H); bf16* QKVG = (bf16*)(ws + WS_QKVG); bf16* LOUT = (bf16*)(ws + WS_LOUT); bf16* Z = (bf16*)(dob + DO_Z); bf16* LIN = (bf16*)(dob + DO_LIN);
    float* PW = (float*)(ws + WS_PREP); float* PNKK = (float*)(ws + WS_PREP + PREP_STRIDE); float* PB = (float*)(ws + WS_PREP + 2 * PREP_STRIDE); float* PK = (float*)(ws + WS_PREP + 3 * PREP_STRIDE); float* PR = (float*)(ws + WS_PREP + 4 * PREP_STRIDE);
    bf16* PV = (bf16*)(ws + WS_V); bf16* PG = (bf16*)(ws + WS_G); float* BON = (float*)(ws + WS_BON);
    float* PU = (float*)(ws + WS_PU); bf16* KVB = (bf16*)(ws + WS_KVB); bf16* SPREV = (bf16*)(dob + DO_SPREV); bf16* MIX = (bf16*)(dob + DO_MIX);
    float* MIXOUT = (float*)(ws + WS_MIXOUT); bf16* ACT = (bf16*)(ws + WS_ACT);
#ifndef DUP_PHASE
#define DUP_PHASE -1
#endif
#ifndef PH_MASK
#define PH_MASK 0x3fff
#endif
#define IN(k) (((PH_MASK >> (k)) & 1) && lo <= (k) && (k) < hi)
#ifndef TS_PROBE
#define TS_PROBE -1
#endif
    unsigned long long* TSW = (unsigned long long*)ws;
    if (TS_PROBE >= 0 && bid == 0 && tid == 0) TSW[0] = __builtin_amdgcn_s_memrealtime();
#define MID(n) do { if (TS_PROBE >= 0 && bid == 0) { __syncthreads(); if (tid == 0) TSW[32 + (n)] = __builtin_amdgcn_s_memrealtime(); } } while (0)
#define SEAM(k) do { if (IN(k) && IN((k) + 1)) { if ((k) == 0) grid.sync(); else xcd_barrier(xb); } if (TS_PROBE >= 0 && bid == 0 && tid == 0) TSW[1 + (k)] = __builtin_amdgcn_s_memrealtime(); } while (0)

    if (IN(0)) for (int rep = 0; rep < (DUP_PHASE == 0 ? 2 : 1); ++rep) {
        MID(0);
        float* scr = (float*)lds + wave * (64 * 33 + 16);
        constexpr int IT_WIN = (D / 64) * (IC / 32), IT_WOUT = (D / 64) * (D / 32), IT_ADA = (D / 64) * (MODW / 32);
        bf16* ADAT = (bf16*)(ws + WS_ADAT); bf16* SC = (bf16*)(ws + WS_SC);
        for (int it = gw; it < IT_WIN + IT_WOUT + IT_ADA; it += NGW) {
            if (it < IT_WIN) { const int nb = IC / 32, kb = it / nb, n0 = 32 * (it % nb); transpose_item(a.in[I_WIN], D, IC, WINT, 64 * kb, n0, n0, scr, lane); }
            else if (it < IT_WIN + IT_WOUT) { const int r = it - IT_WIN, nb = D / 32, kb = r / nb, n0 = 32 * (r % nb); transpose_item(a.in[I_WOUT], D, D, WOUTT, 64 * kb, n0, n0, scr, lane); }
            else { const int r = it - IT_WIN - IT_WOUT, nb = MODW / 32, kb = r / nb, n0 = 32 * (r % nb); transpose_item(a.in[I_ADAW], D, MODW, ADAT, 64 * kb, n0, n0, scr, lane); }
        }
        MID(1);
        for (int idx = bid * 512 + tid; idx < 3072 * 256; idx += G * 512) {
            const int n = idx >> 8, k = idx & 255, sec = n >> 10, nn = n & 1023; float v = 0.f;
            if (sec == 0 && k < 64) v = a.in[I_W2][k * RW + nn];
            else if (sec == 1 && k >= 64 && k < 128) v = a.in[I_A2][(k - 64) * RW + nn];
            else if (sec == 2 && k >= 128) v = a.in[I_G2][(k - 128) * RW + nn];
            LORAT[idx] = (bf16)f2bf(v);
        }
        for (int idx = bid * 512 + tid; idx < 256 * D; idx += G * 512) { const int r = idx / D, k = idx % D; float v = 0.f;
            if (r < NSEQ) { const float cv = r == 0 ? a.in[I_CP][k] : a.in[I_CS][(r - 1) * D + k]; v = cv * sigm(cv); }
            SC[idx] = (bf16)f2bf(v); }
        MID(2);
    }
    if (IN(0)) MID(3);
    SEAM(0);
    if (IN(1)) {
        { const int sl = bid / 48; pg8::Gemm g{(const bf16*)(ws + WS_SC) + sl * 512, (const bf16*)(ws + WS_ADAT) + sl * 512, 256, MODW, 512, D}; pg8::OneUnit S{0, bid % 48, bid < 192};
          EpiMod E{(float*)(ws + WS_MODP) + (size_t)sl * NSEQ * MODW, MODW};
          pg8::gemm_phase<EpiMod, pg8::OneUnit, false, true>((PG8_LAS unsigned char*)lds, g, S, E); }
        xcd_barrier(xb);
        const float* MODP = (const float*)(ws + WS_MODP);
        for (int idx = bid * 512 + tid; idx < NSEQ * MODW; idx += G * 512) { float v = a.in[I_ADAB][idx % MODW];
#pragma unroll
            for (int q = 0; q < 4; ++q) v += MODP[(size_t)q * NSEQ * MODW + idx];
            MOD[idx] = v; }
        xcd_barrier(xb);
    }
    if (IN(1)) for (int rep = 0; rep < (DUP_PHASE == 1 ? 2 : 1); ++rep) {
        for (int m = gw; m < M; m += NGW) {
            const float* xr = m < TP ? a.in[I_XP] + (size_t)m * D : a.in[I_XS] + (size_t)(m - TP) * D; const float* mod = MOD + seq_of(m) * MODW;
            f32x4 v[8]; float ss = 0.f;
#pragma unroll
            for (int j = 0; j < 8; ++j) { v[j] = *(const f32x4*)(xr + 4 * lane + 256 * j); ss += (v[j].x * v[j].x + v[j].y * v[j].y) + (v[j].z * v[j].z + v[j].w * v[j].w); }
            const float rs = rsqrtf(wave_sum(ss) * (1.f / D) + 1e-6f);
#pragma unroll
            for (int j = 0; j < 8; ++j) { const int c = 4 * lane + 256 * j; const f32x4 g = *(const f32x4*)(a.in[I_GPM] + c), s1 = *(const f32x4*)(mod + D + c), h1 = *(const f32x4*)(mod + c);
                const f32x4 h = v[j] * rs * g * (s1 + 1.f) + h1; u32x2 w; w.x = pk2(h.x, h.y); w.y = pk2(h.z, h.w); *(u32x2*)(H + (size_t)m * D + c) = w; }
        }
    }
    SEAM(1);
    if (IN(2)) for (int rep = 0; rep < (DUP_PHASE == 2 ? 2 : 1); ++rep) {
        pg8::Gemm g{H, WINT, M, IC, D, D}; pg8::StaticOrder S; S.init(M, IC, G, bid); EpiProj E{Z, QKVG};
        pg8::gemm_phase<EpiProj, pg8::StaticOrder, true, true>((PG8_LAS unsigned char*)lds, g, S, E);
    }
    SEAM(2);
    if (IN(3)) for (int rep = 0; rep < (DUP_PHASE == 3 ? 2 : 1); ++rep) {
        for (int idx = bid * 512 + tid; idx < M * 128; idx += G * 512) {
            const int m = idx >> 7, c2 = (idx & 127) * 2, c = 3072 + c2, tp = tpos_of(m), sq = seq_of(m);
            const unsigned zz = *(const unsigned*)(Z + (size_t)m * RC + c); float z0 = bf2f(zz & 0xffffu), z1 = bf2f(zz >> 16), p0 = 0.f, p1 = 0.f;
            if (tp > 0) { const unsigned pp = *(const unsigned*)(Z + (size_t)(m - 1) * RC + c); p0 = bf2f(pp & 0xffffu); p1 = bf2f(pp >> 16); }
            else if (sq > 0) { p0 = a.in[I_SSH][(size_t)(sq - 1) * RC + c]; p1 = a.in[I_SSH][(size_t)(sq - 1) * RC + c + 1]; }
            z0 = z0 + (p0 - z0) * a.in[I_MU][c]; z1 = z1 + (p1 - z1) * a.in[I_MU][c + 1];
            if (c2 < 64) { z0 = 1.f - 2.f / (__expf(2.f * z0) + 1.f); z1 = 1.f - 2.f / (__expf(2.f * z1) + 1.f); }
            else if (c2 >= 128) { z0 = sigm(z0); z1 = sigm(z1); }
            *(unsigned*)(LIN + (size_t)m * 256 + c2) = pk2(z0, z1);
        }
        for (int idx = bid * 512 + tid; idx < NSEQ * RC; idx += G * 512) { const int s = idx / RC, c = idx % RC; const int m = s == 0 ? TP - 1 : TP + 16 * (s - 1) + 15;
            out[(s == 0 ? O_SHP : O_SHS + (size_t)(s - 1) * RC) + c] = bf2f(Z[(size_t)m * RC + c]); }
    }
    SEAM(3);
    if (IN(4)) for (int rep = 0; rep < (DUP_PHASE == 4 ? 2 : 1); ++rep) {
        int k256 = 256; asm volatile("" : "+s"(k256));
        pg8::Gemm g{LIN, LORAT, M, 3072, k256, k256}; pg8::StaticOrder S; S.init(M, 3072, G, bid); EpiBf16P E{LOUT, 3072};
        pg8::gemm_phase<EpiBf16P, pg8::StaticOrder, true, true>((PG8_LAS unsigned char*)lds, g, S, E);
    }
    SEAM(4);
    if (IN(5)) for (int rep = 0; rep < (DUP_PHASE == 5 ? 2 : 1); ++rep) {
        float* prm = (float*)lds;
        __syncthreads();
        for (int idx = tid; idx < RW; idx += 512) { prm[idx] = a.in[I_MU][idx]; prm[RW + idx] = a.in[I_MU][RW + idx]; prm[2 * RW + idx] = a.in[I_MU][2 * RW + idx]; prm[3 * RW + idx] = a.in[I_W0][idx];
            prm[4 * RW + idx] = a.in[I_A0][idx]; prm[5 * RW + idx] = a.in[I_KK][idx]; prm[6 * RW + idx] = a.in[I_KA][idx]; prm[7 * RW + idx] = a.in[I_RK][idx]; }
        __syncthreads();
        for (int m = gw; m < M; m += NGW) {
            const int tp = tpos_of(m), sq = seq_of(m);
#pragma unroll 1
            for (int hp = 0; hp < 2; ++hp) {
                const int hd = hp * 8 + (lane >> 3), c0 = hd * 64 + (lane & 7) * 8;
                const bf16* zr = Z + (size_t)m * RC + c0; const bf16* lr = LOUT + (size_t)m * 3072 + c0; const float* sh0 = a.in[I_SSH] + (size_t)(sq > 0 ? sq - 1 : 0) * RC + c0;
                float zs[3][8];
#pragma unroll
                for (int q = 0; q < 3; ++q) {
                    const u32x4 ca = *(const u32x4*)(zr + q * RW); float pv[8];
                    if (tp > 0) { const u32x4 pa2 = *(const u32x4*)(zr - RC + q * RW);
#pragma unroll
                        for (int e = 0; e < 4; ++e) { pv[2 * e] = bf2f(pa2[e] & 0xffffu); pv[2 * e + 1] = bf2f(pa2[e] >> 16); } }
                    else if (sq > 0) { const f32x4 f0 = *(const f32x4*)(sh0 + q * RW), f1 = *(const f32x4*)(sh0 + q * RW + 4);
                        pv[0] = f0.x; pv[1] = f0.y; pv[2] = f0.z; pv[3] = f0.w; pv[4] = f1.x; pv[5] = f1.y; pv[6] = f1.z; pv[7] = f1.w; }
                    else {
#pragma unroll
                        for (int e = 0; e < 8; ++e) pv[e] = 0.f; }
                    const float* mu = prm + q * RW + c0;
#pragma unroll
                    for (int e = 0; e < 4; ++e) { const float z0 = bf2f(ca[e] & 0xffffu), z1 = bf2f(ca[e] >> 16);
                        zs[q][2 * e] = z0 + (pv[2 * e] - z0) * mu[2 * e]; zs[q][2 * e + 1] = z1 + (pv[2 * e + 1] - z1) * mu[2 * e + 1]; }
                }
                const u32x4 wa = *(const u32x4*)(lr), aa = *(const u32x4*)(lr + RW), ga = *(const u32x4*)(lr + 2 * RW);
                float wv[8], av[8], kkv[8], k2[8]; float s1 = 0.f, s2 = 0.f;
#pragma unroll
                for (int e = 0; e < 8; ++e) {
                    const float lwv = bf2f((e & 1) ? (wa[e >> 1] >> 16) : (wa[e >> 1] & 0xffffu)), lav = bf2f((e & 1) ? (aa[e >> 1] >> 16) : (aa[e >> 1] & 0xffffu));
                    wv[e] = __expf(-0.6065306597126334f * sigm(prm[3 * RW + c0 + e] + lwv));
                    av[e] = sigm(prm[4 * RW + c0 + e] + lav);
                    kkv[e] = zs[1][e] * prm[5 * RW + c0 + e]; s1 += kkv[e] * kkv[e];
                    k2[e] = zs[1][e] * (1.f + (av[e] - 1.f) * prm[6 * RW + c0 + e]); s2 += zs[0][e] * k2[e] * prm[7 * RW + c0 + e];
                }
                s1 += DPPF(0.f, s1, 0xB1, 0xF); s1 += DPPF(0.f, s1, 0x4E, 0xF); s1 += DPPF(0.f, s1, 0x141, 0xF);
                s2 += DPPF(0.f, s2, 0xB1, 0xF); s2 += DPPF(0.f, s2, 0x4E, 0xF); s2 += DPPF(0.f, s2, 0x141, 0xF);
                const float inrm = 1.f / fmaxf(sqrtf(s1), 1e-12f);
                const size_t o = (size_t)m * RW + c0;
#pragma unroll
                for (int e = 0; e < 2; ++e) {
                    const float k0 = kkv[4 * e] * inrm, k1 = kkv[4 * e + 1] * inrm, k2_ = kkv[4 * e + 2] * inrm, k3 = kkv[4 * e + 3] * inrm;
                    *(f32x4*)(PW + o + 4 * e) = (f32x4){wv[4 * e], wv[4 * e + 1], wv[4 * e + 2], wv[4 * e + 3]};
                    *(f32x4*)(PNKK + o + 4 * e) = (f32x4){-k0, -k1, -k2_, -k3};
                    *(f32x4*)(PB + o + 4 * e) = (f32x4){k0 * av[4 * e], k1 * av[4 * e + 1], k2_ * av[4 * e + 2], k3 * av[4 * e + 3]};
                    *(f32x4*)(PK + o + 4 * e) = (f32x4){k2[4 * e], k2[4 * e + 1], k2[4 * e + 2], k2[4 * e + 3]};
                    *(f32x4*)(PR + o + 4 * e) = (f32x4){zs[0][4 * e], zs[0][4 * e + 1], zs[0][4 * e + 2], zs[0][4 * e + 3]};
                }
                { u32x4 va;
#pragma unroll
                  for (int e = 0; e < 4; ++e) va[e] = pk2(zs[2][2 * e], zs[2][2 * e + 1]);
                  *(u32x4*)(PV + o) = va; *(u32x4*)(PG + o) = ga; }
                if ((lane & 7) == 0) BON[m * 16 + hd] = s2;
            }
        }
    }
    SEAM(5);
    if (IN(6)) for (int rep = 0; rep < (DUP_PHASE == 6 ? 2 : 1); ++rep) {
        MID(4);
        {
            float* wl = (float*)lds + wave * RL<0>::BUF;
            for (int task = gw; task < RH * NCH * 2; task += NGW) {
                const int part = task & 1, pair = task >> 1, h = pair / NCH, c = pair % NCH; const size_t o = (size_t)(c * LCH) * RW + h * 64;
                f32x2 S[32];
                if (part) {
#pragma unroll
                    for (int j = 0; j < 32; ++j) { S[j].x = (2 * j == lane) ? 1.f : 0.f; S[j].y = (2 * j + 1 == lane) ? 1.f : 0.f; }
                    rwkv_lds<1>(S, PW + o, PNKK + o, PB + o, PK + o, PR + o, PV + o, LCH, lane, nullptr, nullptr, nullptr, 0.f, 0.f, wl);
                } else {
#pragma unroll
                    for (int j = 0; j < 32; ++j) S[j] = (f32x2){0.f, 0.f};
                    rwkv_lds<0>(S, PW + o, PNKK + o, PB + o, PK + o, PR + o, PV + o, LCH, lane, nullptr, nullptr, nullptr, 0.f, 0.f, wl);
                }
                float* dst = PU + ((size_t)pair * 2 + (part ? 0 : 1)) * 4096 + lane * 64;
#pragma unroll
                for (int j = 0; j < 16; ++j) *(f32x4*)(dst + 4 * j) = (f32x4){S[2 * j].x, S[2 * j].y, S[2 * j + 1].x, S[2 * j + 1].y};
            }
        }
        __syncthreads();
        MID(5);
        bf16* kT = (bf16*)lds;
        bf16* vT = (bf16*)lds + 256 * 72;
        const int fr = lane & 15, fq = lane >> 4;
        for (int it = bid; it < EH * NRB * 2; it += G) {
            const int half = it & 1, blk = (it >> 1) % NRB, h = (it >> 1) / NRB; const float l2g = ret_l2g(h); const int m0 = blk * RBLK;
            f32x4 acc[2][8];
#pragma unroll
            for (int x = 0; x < 2; ++x)
#pragma unroll
                for (int y = 0; y < 8; ++y) acc[x][y] = (f32x4){0.f, 0.f, 0.f, 0.f};
            for (int ts = 0; ts < 4; ++ts) {
                __syncthreads();
#pragma unroll
                for (int i = 0; i < 4; ++i) { const int t = lane, dp = wave + 8 * i; const u32x4 raw = *(const u32x4*)(QKVG + (size_t)(m0 + ts * 64 + t) * EC + 1024 + h * 256 + dp * 8);
                    const float dec = exp2f(l2g * (float)(255 - (ts * 64 + t)));
#pragma unroll
                    for (int e = 0; e < 4; ++e) { const unsigned w = raw[e]; kT[(dp * 8 + 2 * e) * 72 + t] = (bf16)f2bf(bf2f(w & 0xffffu) * dec); kT[(dp * 8 + 2 * e + 1) * 72 + t] = (bf16)f2bf(bf2f(w >> 16) * dec); } }
#pragma unroll
                for (int i = 0; i < 2; ++i) { const int t = lane, ep = wave + 8 * i; const u32x4 raw = *(const u32x4*)(QKVG + (size_t)(m0 + ts * 64 + t) * EC + 2048 + h * 256 + half * 128 + ep * 8);
#pragma unroll
                    for (int e = 0; e < 4; ++e) { const unsigned w = raw[e]; vT[(ep * 8 + 2 * e) * 72 + t] = (bf16)(w & 0xffffu); vT[(ep * 8 + 2 * e + 1) * 72 + t] = (bf16)(w >> 16); } }
                __syncthreads();
#pragma unroll
                for (int kk = 0; kk < 2; ++kk) { bf16x8 af[2];
#pragma unroll
                    for (int x = 0; x < 2; ++x) af[x] = *(const bf16x8*)(kT + (32 * wave + 16 * x + fr) * 72 + kk * 32 + fq * 8);
#pragma unroll
                    for (int y = 0; y < 8; ++y) { const bf16x8 bfm = *(const bf16x8*)(vT + (16 * y + fr) * 72 + kk * 32 + fq * 8);
#pragma unroll
                        for (int x = 0; x < 2; ++x) acc[x][y] = __builtin_amdgcn_mfma_f32_16x16x32_bf16(af[x], bfm, acc[x][y], 0, 0, 0); } }
            }
            bf16* dst = KVB + ((size_t)(h * NRB + blk) * 256) * 256;
#pragma unroll
            for (int x = 0; x < 2; ++x)
#pragma unroll
                for (int y = 0; y < 8; ++y) { u32x2 w; w.x = pk2(acc[x][y][0], acc[x][y][1]); w.y = pk2(acc[x][y][2], acc[x][y][3]);
                    *(u32x2*)(dst + (size_t)(half * 128 + 16 * y + fr) * 256 + 32 * wave + 16 * x + fq * 4) = w; }
        }
    }
    if (IN(6)) MID(6);
    SEAM(6);
    if (IN(7)) for (int rep = 0; rep < (DUP_PHASE == 7 ? 2 : 1); ++rep) {
        const int nB = RH * 4;
        if (bid < nB || G <= nB) {
            float* Sb = (float*)lds;
            const int fr = lane & 15, fq = lane >> 4;
            for (int it = bid; it < nB; it += G) {
                const int h = it >> 2, g4 = it & 3; float* pu = PU + (size_t)(h * NCH) * 2 * 4096;
                __syncthreads();
                for (int idx = tid; idx < 16 * 65; idx += 512) Sb[idx] = 0.f;
                __syncthreads();
                if (wave < 4) {
                    float pa[16], pb[16]; f32x4 ua, ub;
#define PB_LOAD(dst, du, c) do { const float* pp = pu + (size_t)(c) * 2 * 4096; _Pragma("unroll") for (int kk = 0; kk < 16; ++kk) dst[kk] = pp[(4 * kk + fq) * 64 + 16 * wave + fr]; \
                        _Pragma("unroll") for (int jj = 0; jj < 4; ++jj) du[jj] = pp[4096 + (16 * g4 + 4 * fq + jj) * 64 + 16 * wave + fr]; } while (0)
                    PB_LOAD(pa, ua, 0); PB_LOAD(pb, ub, 1);
                    for (int c = 0; c < NCH; ++c) {
                        const float* Sc = Sb + (c & 1) * (16 * 65); float* Sn = Sb + ((c + 1) & 1) * (16 * 65);
                        f32x4 acc = ua, ac1 = {0.f, 0.f, 0.f, 0.f}, ac2 = ac1, ac3 = ac1;
#pragma unroll
                        for (int kk = 0; kk < 16; kk += 4) { acc = __builtin_amdgcn_mfma_f32_16x16x4f32(Sc[fr * 65 + 4 * kk + fq], pa[kk], acc, 0, 0, 0);
                            ac1 = __builtin_amdgcn_mfma_f32_16x16x4f32(Sc[fr * 65 + 4 * (kk + 1) + fq], pa[kk + 1], ac1, 0, 0, 0);
                            ac2 = __builtin_amdgcn_mfma_f32_16x16x4f32(Sc[fr * 65 + 4 * (kk + 2) + fq], pa[kk + 2], ac2, 0, 0, 0);
                            ac3 = __builtin_amdgcn_mfma_f32_16x16x4f32(Sc[fr * 65 + 4 * (kk + 3) + fq], pa[kk + 3], ac3, 0, 0, 0); }
                        acc = (acc + ac1) + (ac2 + ac3);
#pragma unroll
                        for (int jj = 0; jj < 4; ++jj) { Sn[(4 * fq + jj) * 65 + 16 * wave + fr] = acc[jj]; pu[(size_t)c * 2 * 4096 + 4096 + (16 * g4 + 4 * fq + jj) * 64 + 16 * wave + fr] = acc[jj]; }
                        if (c + 1 == NCH) {
#pragma unroll
                            for (int jj = 0; jj < 4; ++jj) out[O_WKP + (size_t)h * 4096 + (16 * g4 + 4 * fq + jj) * 64 + 16 * wave + fr] = acc[jj]; }
#pragma unroll
                        for (int kk = 0; kk < 16; ++kk) pa[kk] = pb[kk];
                        ua = ub;
                        if (c + 2 < NCH) PB_LOAD(pb, ub, c + 2);
                        asm volatile("s_waitcnt lgkmcnt(0)" ::: "memory");
                        __builtin_amdgcn_s_barrier();
                    }
#undef PB_LOAD
                } else {
                    for (int c = 0; c < NCH; ++c) __builtin_amdgcn_s_barrier();
                }
            }
        }
        if (bid >= nB || G <= nB) {
            const int nb2 = G <= nB ? G : G - nB, b2 = G <= nB ? bid : bid - nB;
            for (int it = b2 * 512 + tid; it < EH * 256 * 32; it += nb2 * 512) {
                const int h = it >> 13, e = (it >> 5) & 255, d0 = (it & 31) * 8; const float g256 = exp2f(256.f * ret_l2g(h));
                float acc[8];
#pragma unroll
                for (int q = 0; q < 8; ++q) acc[q] = 0.f;
                u32x4 kvr[NRB];
#pragma unroll
                for (int blk = 0; blk < NRB; ++blk) kvr[blk] = *(const u32x4*)(KVB + ((size_t)(h * NRB + blk) * 256 + e) * 256 + d0);
#pragma unroll
                for (int blk = 0; blk < NRB; ++blk) {
                    const size_t o = ((size_t)(h * NRB + blk) * 256 + e) * 256 + d0;
                    u32x4 w; w.x = pk2(acc[0], acc[1]); w.y = pk2(acc[2], acc[3]); w.z = pk2(acc[4], acc[5]); w.w = pk2(acc[6], acc[7]); *(u32x4*)(SPREV + o) = w;
                    const u32x4 kv = kvr[blk];
#pragma unroll
                    for (int q = 0; q < 4; ++q) { acc[2 * q] = acc[2 * q] * g256 + bf2f(kv[q] & 0xffffu); acc[2 * q + 1] = acc[2 * q + 1] * g256 + bf2f(kv[q] >> 16); }
                }
#pragma unroll
                for (int q = 0; q < 8; ++q) out[O_RTP + (size_t)h * 65536 + (size_t)(d0 + q) * 256 + e] = acc[q];
            }
        }
    }
    if (IN(7)) MID(10);
    SEAM(7);
    if (IN(8)) for (int rep = 0; rep < (DUP_PHASE == 8 ? 2 : 1); ++rep) {
        MID(7);
        if (wave < 5) {
            float* wl = (float*)lds + wave * RL<2>::BUF;
            const int ntask = wave < 4 ? RH * NCH : NB * RH;
            for (int task = wave < 4 ? bid * 4 + wave : bid; task < ntask; task += (wave < 4 ? G * 4 : G)) {
                f32x2 S[32]; int h, m0, nsteps; float* sdst = nullptr;
                if (wave < 4) { h = task / NCH; const int c = task % NCH; m0 = c * LCH; nsteps = LCH;
                    if (c == 0) {
#pragma unroll
                        for (int j = 0; j < 32; ++j) S[j] = (f32x2){0.f, 0.f};
                    } else { const float* src = PU + ((size_t)(h * NCH + c - 1) * 2 + 1) * 4096 + lane * 64;
#pragma unroll
                        for (int j = 0; j < 16; ++j) { const f32x4 q = *(const f32x4*)(src + 4 * j); S[2 * j] = (f32x2){q.x, q.y}; S[2 * j + 1] = (f32x2){q.z, q.w}; } }
                } else { const int b = task / RH; h = task % RH; m0 = TP + 16 * b; nsteps = TS;
                    const float* src = a.in[I_SWKV] + ((size_t)(b * RH + h) * 64 + lane) * 64; sdst = out + O_WKS + ((size_t)(b * RH + h) * 64 + lane) * 64;
#pragma unroll
                    for (int j = 0; j < 16; ++j) { const f32x4 q = *(const f32x4*)(src + 4 * j); S[2 * j] = (f32x2){q.x, q.y}; S[2 * j + 1] = (f32x2){q.z, q.w}; } }
                const size_t o = (size_t)m0 * RW + h * 64;
                rwkv_lds<2>(S, PW + o, PNKK + o, PB + o, PK + o, PR + o, PV + o, nsteps, lane, PG + o, BON + (size_t)m0 * 16 + h, MIX + (size_t)m0 * D + h * 64,
                            a.in[I_RLW][h * 64 + lane], a.in[I_RLB][h * 64 + lane], wl);
                if (sdst) {
#pragma unroll
                    for (int j = 0; j < 16; ++j) *(f32x4*)(sdst + 4 * j) = (f32x4){S[2 * j].x, S[2 * j].y, S[2 * j + 1].x, S[2 * j + 1].y}; }
            }
        }
        MID(8);
        {
            const int nb2 = G, b2 = bid;
            const int fr = lane & 15, fq = lane >> 4;
            for (int it0 = b2; it0 < EH * (TP / 64) + NB * EH * 4; it0 += nb2) {
                const int it = (nb2 == 256 && it0 >= 256 && it0 < 512) ? 767 - it0 : it0;
                __syncthreads();
#ifndef NO_RP
                if (it < EH * (TP / 64)) {
                    const int h = it / (TP / 64), n = it % (TP / 64), blk = n >> 2, i = n & 3, m0 = n * 64; const float l2g = ret_l2g(h);
                    bf16* qL = (bf16*)lds; bf16* kL = qL + 64 * 264; bf16* vT = kL + 64 * 264; bf16* pL = vT + 256 * 72; float* red = (float*)(pL + 64 * 72);
#pragma unroll
                    for (int x = 0; x < 4; ++x) { const int p = tid + 512 * x, t = p >> 5, dp = p & 31; *(u32x4*)(qL + t * 264 + dp * 8) = *(const u32x4*)(QKVG + (size_t)(m0 + t) * EC + h * 256 + dp * 8); }
                    __syncthreads();
                    if (it0 == b2 + nb2) MID(11);
                    f32x4 acc[4][2];
#pragma unroll
                    for (int x = 0; x < 4; ++x)
#pragma unroll
                        for (int y = 0; y < 2; ++y) acc[x][y] = (f32x4){0.f, 0.f, 0.f, 0.f};
                    if (blk > 0) {
                        const bf16* sp = SPREV + ((size_t)(h * NRB + blk) * 256) * 256;
#pragma unroll 2
                        for (int kk = 0; kk < 8; ++kk) { bf16x8 bfm[2];
#pragma unroll
                            for (int y = 0; y < 2; ++y) bfm[y] = *(const bf16x8*)(sp + (size_t)(32 * wave + 16 * y + fr) * 256 + kk * 32 + fq * 8);
#pragma unroll
                            for (int x = 0; x < 4; ++x) { const bf16x8 af = *(const bf16x8*)(qL + (16 * x + fr) * 264 + kk * 32 + fq * 8);
#pragma unroll
                                for (int y = 0; y < 2; ++y) acc[x][y] = __builtin_amdgcn_mfma_f32_16x16x32_bf16(af, bfm[y], acc[x][y], 0, 0, 0); } }
#pragma unroll
                        for (int x = 0; x < 4; ++x)
#pragma unroll
                            for (int jj = 0; jj < 4; ++jj) { const float qd = exp2f(l2g * (float)(64 * i + 16 * x + fq * 4 + jj + 1)); acc[x][0][jj] *= qd; acc[x][1][jj] *= qd; }
                    }
                    if (it0 == b2 + nb2) MID(12);
                    for (int j = 0; j <= i; ++j) {
                        __syncthreads();
                        const int ms = (blk * 4 + j) * 64;
#pragma unroll
                        for (int x = 0; x < 4; ++x) { const int p = tid + 512 * x, t = p >> 5, dp = p & 31;
                            *(u32x4*)(kL + t * 264 + dp * 8) = *(const u32x4*)(QKVG + (size_t)(ms + t) * EC + 1024 + h * 256 + dp * 8); }
#pragma unroll
                        for (int x = 0; x < 4; ++x) { const int t = lane, dp = wave + 8 * x;
                            const u32x4 raw = *(const u32x4*)(QKVG + (size_t)(ms + t) * EC + 2048 + h * 256 + dp * 8);
#pragma unroll
                            for (int e = 0; e < 4; ++e) { const unsigned w = raw[e]; vT[(dp * 8 + 2 * e) * 72 + t] = (bf16)(w & 0xffffu); vT[(dp * 8 + 2 * e + 1) * 72 + t] = (bf16)(w >> 16); } }
                        __syncthreads();
                        { const int tr = wave >> 1, tc0 = (wave & 1) * 2; f32x4 sa[2] = {(f32x4){0.f, 0.f, 0.f, 0.f}, (f32x4){0.f, 0.f, 0.f, 0.f}};
#pragma unroll
                            for (int kk = 0; kk < 8; ++kk) { const bf16x8 af = *(const bf16x8*)(qL + (16 * tr + fr) * 264 + kk * 32 + fq * 8);
#pragma unroll
                                for (int y = 0; y < 2; ++y) { const bf16x8 bfm = *(const bf16x8*)(kL + (16 * (tc0 + y) + fr) * 264 + kk * 32 + fq * 8); sa[y] = __builtin_amdgcn_mfma_f32_16x16x32_bf16(af, bfm, sa[y], 0, 0, 0); } }
#pragma unroll
                            for (int y = 0; y < 2; ++y)
#pragma unroll
                                for (int jj = 0; jj < 4; ++jj) { const int t = 16 * tr + fq * 4 + jj, s = 16 * (tc0 + y) + fr; const int dist = (j < i) ? 64 * (i - j) + t - s : (t > s ? t - s : s - t);
                                    pL[t * 72 + s] = (bf16)f2bf(sa[y][jj] * exp2f(l2g * (float)dist)); } }
                        __syncthreads();
#pragma unroll
                        for (int kk = 0; kk < 2; ++kk) { bf16x8 bfm[2];
#pragma unroll
                            for (int y = 0; y < 2; ++y) bfm[y] = *(const bf16x8*)(vT + (32 * wave + 16 * y + fr) * 72 + kk * 32 + fq * 8);
#pragma unroll
                            for (int x = 0; x < 4; ++x) { const bf16x8 af = *(const bf16x8*)(pL + (16 * x + fr) * 72 + kk * 32 + fq * 8);
#pragma unroll
                                for (int y = 0; y < 2; ++y) acc[x][y] = __builtin_amdgcn_mfma_f32_16x16x32_bf16(af, bfm[y], acc[x][y], 0, 0, 0); } }
                    }
                    if (it0 == b2 + nb2) MID(13);
#pragma unroll
                    for (int x = 0; x < 4; ++x)
#pragma unroll
                        for (int jj = 0; jj < 4; ++jj) { float s1 = acc[x][0][jj] + acc[x][1][jj], s2 = acc[x][0][jj] * acc[x][0][jj] + acc[x][1][jj] * acc[x][1][jj];
#pragma unroll
                            for (int o = 1; o < 16; o <<= 1) { s1 += __shfl_xor(s1, o); s2 += __shfl_xor(s2, o); }
                            if (fr == 0) { const int t = 16 * x + fq * 4 + jj; red[(t * 8 + wave) * 2] = s1; red[(t * 8 + wave) * 2 + 1] = s2; } }
                    __syncthreads();
                    float lw[2], lb[2];
#pragma unroll
                    for (int y = 0; y < 2; ++y) { lw[y] = a.in[I_ELW][h * 256 + 32 * wave + 16 * y + fr]; lb[y] = a.in[I_ELB][h * 256 + 32 * wave + 16 * y + fr]; }
#pragma unroll
                    for (int x = 0; x < 4; ++x)
#pragma unroll
                        for (int jj = 0; jj < 4; ++jj) { const int t = 16 * x + fq * 4 + jj; float s1 = 0.f, s2 = 0.f;
#pragma unroll
                            for (int w8 = 0; w8 < 8; ++w8) { s1 += red[(t * 8 + w8) * 2]; s2 += red[(t * 8 + w8) * 2 + 1]; }
                            const float mean = s1 * (1.f / 256.f), var = s2 * (1.f / 256.f) - mean * mean, rstd = rsqrtf(var + 1e-5f);
#pragma unroll
                            for (int y = 0; y < 2; ++y) { const int e = 32 * wave + 16 * y + fr; const float gt = bf2f(QKVG[(size_t)(m0 + t) * EC + 3072 + h * 256 + e]);
                                const float val = ((acc[x][y][jj] - mean) * rstd * lw[y] + lb[y]) * gt * sigm(gt);
                                MIX[(size_t)(m0 + t) * D + RW + h * 256 + e] = (bf16)f2bf(val); } }
                    if (it0 == b2 + nb2) MID(14);
                } else
#endif
#ifndef NO_RS
                {
                    const int r = it - EH * (TP / 64), tq = r & 3, b = (r >> 2) / EH, h = (r >> 2) % EH, m0 = TP + 16 * b; const float l2g = ret_l2g(h);
                    float* qf = (float*)lds; float* kf = qf + 4 * 260; float* vf = kf + 16 * 257; float* pf = vf + 16 * 257; float* red = pf + 64;
                    for (int idx = tid; idx < 16 * 256; idx += 512) { const int t = idx >> 8, dd = idx & 255; const bf16* src = QKVG + (size_t)(m0 + t) * EC + h * 256 + dd;
                        if ((t >> 2) == tq) qf[(t & 3) * 260 + dd] = bf2f(src[0]);
                        kf[t * 257 + dd] = bf2f(src[1024]); vf[t * 257 + dd] = bf2f(src[2048]); }
                    __syncthreads();
                    if (tid < 64) { const int tl = tid >> 4, s = tid & 15, t = 4 * tq + tl; float sc = 0.f;
#pragma unroll 4
                        for (int dd = 0; dd < 256; ++dd) sc += qf[tl * 260 + dd] * kf[s * 257 + dd];
                        pf[tl * 16 + s] = sc * exp2f(l2g * (float)(t > s ? t - s : s - t)); }
                    __syncthreads();
                    const int e = tid & 255, th = tid >> 8; const float* S0 = a.in[I_SRET] + (size_t)(b * EH + h) * 65536;
                    float oc[2] = {0.f, 0.f};
#pragma unroll 4
                    for (int dd = 0; dd < 256; dd += 4) { const f32x4 qa = *(const f32x4*)(qf + (2 * th) * 260 + dd), qb = *(const f32x4*)(qf + (2 * th + 1) * 260 + dd);
                        const float s0 = S0[(size_t)dd * 256 + e], s1 = S0[(size_t)(dd + 1) * 256 + e], s2 = S0[(size_t)(dd + 2) * 256 + e], s3 = S0[(size_t)(dd + 3) * 256 + e];
                        oc[0] += qa.x * s0 + qa.y * s1 + qa.z * s2 + qa.w * s3; oc[1] += qb.x * s0 + qb.y * s1 + qb.z * s2 + qb.w * s3; }
#pragma unroll
                    for (int tt = 0; tt < 2; ++tt) { const int tl = 2 * th + tt, t = 4 * tq + tl; float v = oc[tt] * exp2f(l2g * (float)(t + 1));
#pragma unroll 4
                        for (int s = 0; s < 16; ++s) v += pf[tl * 16 + s] * vf[s * 257 + e];
                        oc[tt] = v; }
                    { const float g16 = exp2f(16.f * l2g); float* dst = out + O_RTS + (size_t)(b * EH + h) * 65536; float vd[16];
#pragma unroll
                        for (int t = 0; t < 16; ++t) vd[t] = vf[t * 257 + e] * exp2f(l2g * (float)(15 - t));
#pragma unroll 4
                        for (int dd = 64 * tq + 32 * th; dd < 64 * tq + 32 * th + 32; ++dd) { float v = g16 * S0[(size_t)dd * 256 + e];
#pragma unroll
                            for (int t = 0; t < 16; ++t) v += kf[t * 257 + dd] * vd[t];
                            dst[(size_t)dd * 256 + e] = v; } }
#pragma unroll
                    for (int tt = 0; tt < 2; ++tt) { const float s1 = wave_sum(oc[tt]), s2 = wave_sum(oc[tt] * oc[tt]); if (lane == 0) { const int tl = 2 * th + tt; red[(tl * 4 + (wave & 3)) * 2] = s1; red[(tl * 4 + (wave & 3)) * 2 + 1] = s2; } }
                    __syncthreads();
                    const float lw = a.in[I_ELW][h * 256 + e], lb = a.in[I_ELB][h * 256 + e];
#pragma unroll
                    for (int tt = 0; tt < 2; ++tt) { const int tl = 2 * th + tt, t = 4 * tq + tl; float s1 = 0.f, s2 = 0.f;
#pragma unroll
                        for (int w4 = 0; w4 < 4; ++w4) { s1 += red[(tl * 4 + w4) * 2]; s2 += red[(tl * 4 + w4) * 2 + 1]; }
                        const float mean = s1 * (1.f / 256.f), var = s2 * (1.f / 256.f) - mean * mean, rstd = rsqrtf(var + 1e-5f);
                        const float gt = bf2f(QKVG[(size_t)(m0 + t) * EC + 3072 + h * 256 + e]);
                        MIX[(size_t)(m0 + t) * D + RW + h * 256 + e] = (bf16)f2bf(((oc[tt] - mean) * rstd * lw + lb) * gt * sigm(gt)); }
                }
#else
                {}
#endif
            }
        }
    }
    if (IN(8)) MID(9);
    SEAM(8);
    if (IN(9)) for (int rep = 0; rep < (DUP_PHASE == 9 ? 2 : 1); ++rep) {
        { pg8::Gemm g{MIX, WOUTT, TP, D, D, D}; pg8::StaticOrder S; S.init(TP, D, G, bid); EpiF32 E{MIXOUT, D};
          pg8::gemm_phase<EpiF32, pg8::StaticOrder, true, true>((PG8_LAS unsigned char*)lds, g, S, E); }
        { const int sl = bid >> 3; pg8::Gemm g{MIX + (size_t)TP * D + sl * 512, WOUTT + sl * 512, MS, D, 512, D}; pg8::OneUnit S{0, bid & 7, bid < 8 * KS9}; EpiF32 E{(float*)(ws + WS_PART9) + (size_t)sl * MS * D, D};
          pg8::gemm_phase<EpiF32, pg8::OneUnit, false, true>((PG8_LAS unsigned char*)lds, g, S, E); }
    }
    SEAM(9);
    if (IN(10)) for (int rep = 0; rep < (DUP_PHASE == 10 ? 2 : 1); ++rep) {
        for (int m = gw; m < M; m += NGW) {
            const float* xr = m < TP ? a.in[I_XP] + (size_t)m * D : a.in[I_XS] + (size_t)(m - TP) * D; const float* mod = MOD + seq_of(m) * MODW; const float* mr = MIXOUT + (size_t)m * D;
            f32x4 v[8]; float ss = 0.f;
#pragma unroll
            for (int j = 0; j < 8; ++j) {
                if (m < TP) v[j] = *(const f32x4*)(mr + 4 * lane + 256 * j);
                else { const float* pr = (const float*)(ws + WS_PART9) + (size_t)(m - TP) * D + 4 * lane + 256 * j; v[j] = *(const f32x4*)pr;
#pragma unroll
                    for (int q = 1; q < KS9; ++q) v[j] += *(const f32x4*)(pr + (size_t)q * MS * D); }
                ss += (v[j].x * v[j].x + v[j].y * v[j].y) + (v[j].z * v[j].z + v[j].w * v[j].w); }
            const float rs = rsqrtf(wave_sum(ss) * (1.f / D) + 1e-6f); float s2 = 0.f;
#pragma unroll
            for (int j = 0; j < 8; ++j) { const int c = 4 * lane + 256 * j; const f32x4 g = *(const f32x4*)(a.in[I_GPOM] + c), gt = *(const f32x4*)(mod + 2 * D + c), x = *(const f32x4*)(xr + c);
                v[j] = x + gt * (v[j] * rs * g); *(f32x4*)(out + (size_t)m * D + c) = v[j]; s2 += (v[j].x * v[j].x + v[j].y * v[j].y) + (v[j].z * v[j].z + v[j].w * v[j].w); }
            const float rs2 = rsqrtf(wave_sum(s2) * (1.f / D) + 1e-6f);
#pragma unroll
            for (int j = 0; j < 8; ++j) { const int c = 4 * lane + 256 * j; const f32x4 g = *(const f32x4*)(a.in[I_GPF] + c), s1 = *(const f32x4*)(mod + 4 * D + c), h1 = *(const f32x4*)(mod + 3 * D + c);
                const f32x4 h = v[j] * rs2 * g * (s1 + 1.f) + h1; u32x2 w; w.x = pk2(h.x, h.y); w.y = pk2(h.z, h.w); *(u32x2*)(H + (size_t)m * D + c) = w; }
        }
        float* scr = (float*)lds + wave * (64 * 33 + 16);
        constexpr int IT_UP = (D / 64) * (2 * FF / 32), IT_DN = (FF / 64) * (D / 32);
        for (int it = gw; it < IT_UP + IT_DN; it += NGW) {
            if (it < IT_UP) { const int nb = 2 * FF / 32, kb = it / nb, n0 = 32 * (it % nb); const int nn = n0 < FF ? n0 : n0 - FF; const int dr = 256 * (nn >> 7) + (n0 < FF ? 0 : 128) + (nn & 127);
                transpose_item(a.in[I_WUP], D, 2 * FF, WUPT, 64 * kb, n0, dr, scr, lane); }
            else { const int r = it - IT_UP, nb = D / 32, kb = r / nb, n0 = 32 * (r % nb); transpose_item(a.in[I_WDN], FF, D, WDNT, 64 * kb, n0, n0, scr, lane); }
        }
    }
    SEAM(10);
    if (IN(11)) for (int rep = 0; rep < (DUP_PHASE == 11 ? 2 : 1); ++rep) {
        pg8::Gemm g{H, WUPT, M, 2 * FF, D, D}; pg8::StaticOrder S; S.init(M, 2 * FF, G, bid); EpiSwiglu E{ACT};
        pg8::gemm_phase<EpiSwiglu, pg8::StaticOrder, true, true>((PG8_LAS unsigned char*)lds, g, S, E);
    }
    SEAM(11);
    if (IN(12)) for (int rep = 0; rep < (DUP_PHASE == 12 ? 2 : 1); ++rep) {
        { pg8::Gemm g{ACT, WDNT, TP, D, FF, FF}; pg8::StaticOrder S; S.init(TP, D, G, bid); EpiF32 E{MIXOUT, D};
          pg8::gemm_phase<EpiF32, pg8::StaticOrder, true, true>((PG8_LAS unsigned char*)lds, g, S, E); }
        { const int sl = bid >> 3; pg8::Gemm g{ACT + (size_t)TP * FF + sl * 512, WDNT + sl * 512, MS, D, 512, FF}; pg8::OneUnit S{0, bid & 7, bid < 8 * KS12}; EpiF32 E{(float*)(ws + WS_PART12) + (size_t)sl * MS * D, D};
          pg8::gemm_phase<EpiF32, pg8::OneUnit, false, true>((PG8_LAS unsigned char*)lds, g, S, E); }
    }
    SEAM(12);
    if (IN(13)) for (int rep = 0; rep < (DUP_PHASE == 13 ? 2 : 1); ++rep) {
        for (int m = gw; m < M; m += NGW) {
            const float* mod = MOD + seq_of(m) * MODW; const float* fr_ = MIXOUT + (size_t)m * D;
            f32x4 v[8]; float ss = 0.f;
#pragma unroll
            for (int j = 0; j < 8; ++j) {
                if (m < TP) v[j] = *(const f32x4*)(fr_ + 4 * lane + 256 * j);
                else { const float* pr = (const float*)(ws + WS_PART12) + (size_t)(m - TP) * D + 4 * lane + 256 * j; v[j] = *(const f32x4*)pr;
#pragma unroll
                    for (int q = 1; q < KS12; ++q) v[j] += *(const f32x4*)(pr + (size_t)q * MS * D); }
                ss += (v[j].x * v[j].x + v[j].y * v[j].y) + (v[j].z * v[j].z + v[j].w * v[j].w); }
            const float rs = rsqrtf(wave_sum(ss) * (1.f / D) + 1e-6f);
#pragma unroll
            for (int j = 0; j < 8; ++j) { const int c = 4 * lane + 256 * j; const f32x4 g = *(const f32x4*)(a.in[I_GPOF] + c), gt = *(const f32x4*)(mod + 5 * D + c), x = *(const f32x4*)(out + (size_t)m * D + c);
                *(f32x4*)(out + (size_t)m * D + c) = x + gt * (v[j] * rs * g); }
        }
    }
    if (TS_PROBE >= 0) {
        xcd_barrier(xb);
        if (bid == 0 && tid == 0) TSW[14] = __builtin_amdgcn_s_memrealtime();
        if (bid == 0) { __syncthreads(); const float us = TS_PROBE >= 100 ? (float)(TSW[32 + TS_PROBE - 100] - TSW[32 + TS_PROBE - 101]) * 0.01f : (float)(TSW[1 + TS_PROBE] - TSW[TS_PROBE]) * 0.01f; const float eps = sqrtf(us * 1e-4f);
            for (int c = tid; c < RC; c += 512) out[O_SHP + c] *= (1.f + eps); }
    }
#undef IN
#undef SEAM
}

extern "C" void kernel_launch(void* const* d_in, const int* in_sizes, int n_in, void* d_out, int out_size, void* d_ws, size_t ws_size, hipStream_t stream) {
    static int grid = 0;
    if (grid == 0) {
        if (n_in != 30 || (size_t)out_size != O_END || ws_size < WS_END) { fprintf(stderr, "kernel_launch: unexpected sizes n_in %d out %d ws %zu\n", n_in, out_size, ws_size); grid = -1; return; }
        int dev = 0, cus = 0, per_cu = 0;
        (void)hipGetDevice(&dev); (void)hipDeviceGetAttribute(&cus, hipDeviceAttributeMultiprocessorCount, dev);
        if (hipFuncSetAttribute((const void*)mk_fwd, hipFuncAttributeMaxDynamicSharedMemorySize, LDS_BYTES) != hipSuccess) { fprintf(stderr, "kernel_launch: hipFuncSetAttribute failed\n"); grid = -1; return; }
        if (hipOccupancyMaxActiveBlocksPerMultiprocessor(&per_cu, (const void*)mk_fwd, 512, LDS_BYTES) != hipSuccess || per_cu < 1) { fprintf(stderr, "kernel_launch: occupancy query says %d\n", per_cu); per_cu = 1; }
        (void)hipGetLastError();
        grid = cus;
        if (grid <= 0) grid = 256;
    }
    if (grid < 0) return;
    (void)hipMemsetAsync((char*)d_ws + 65536, 0, XCD_BAR_WORDS * 4, stream);
    Args a{};
    for (int i = 0; i < 30; ++i) a.in[i] = (const float*)d_in[i];
    a.out = (float*)d_out; a.ws = (unsigned char*)d_ws;
    a.ph_lo = 0; a.ph_hi = NPHASE;
    void* args[] = {&a};
    hipError_t e = hipLaunchCooperativeKernel((const void*)mk_fwd, dim3(grid), dim3(512), args, LDS_BYTES, stream);
    if (e != hipSuccess) fprintf(stderr, "kernel_launch: cooperative launch failed: %s (grid %d)\n", hipGetErrorString(e), grid);
}
```

```cpp
#include <hip/hip_runtime.h>
#include <hip/hip_cooperative_groups.h>
#include <cstdio>
#include <cstdint>
namespace cg = cooperative_groups;
namespace pg8 {
#define PG8_LAS __attribute__((address_space(3)))
typedef unsigned short bf16_t;
typedef short bf16x8 __attribute__((ext_vector_type(8)));
typedef float f32x4 __attribute__((ext_vector_type(4)));
typedef unsigned u32x4 __attribute__((ext_vector_type(4)));
constexpr int BM = 256, BK = 64, HALF = 128, HTB = HALF * BK * 2  , STAGE_BYTES = 8 * HTB, NXCD = 8, WGM = 8;

__host__ __device__ __forceinline__ int lds_byte(int r, int c) { const int st = (r >> 4) * 2 + (c >> 5), rr = r & 15, cc = c & 31, ob = rr * 64 + cc * 2; return st * 1024 + (ob ^ (((ob >> 9) & 1) << 5)); }
__host__ __device__ __forceinline__ void stage_rc(int b, int& R, int& C) { const int st = b / 1024, sb = b % 1024, swz = sb ^ (((sb >> 9) & 1) << 5); R = (st >> 1) * 16 + swz / 64; C = (st & 1) * 32 + (swz % 64) / 2; }
__host__ __device__ __forceinline__ int perm32(int rho) { const int n = rho >> 4, i = rho & 15; return 8 * (i >> 2) + 4 * n + (i & 3); }

struct Unit { int pm, pn; };
struct Gemm { const bf16_t* A; const bf16_t* Bt; int M, N, K, ld; };

struct OneUnit {
    int pm, pn; bool active;
    __device__ __forceinline__ bool next(int i, Unit& u) const { if (i > 0 || !active) return false; u.pm = pm; u.pn = pn; return true; }
    __device__ __forceinline__ void a_ready(const Unit&) const {}
    __device__ __forceinline__ void done(const Unit&) const {}
};
struct StaticOrder {
    int nM, nN, nwg, G, c;
    __host__ __device__ void init(int M, int N, int G_, int c_) { nM = M / BM; nN = N / BM; nwg = nM * nN; G = G_; c = c_; }
    __host__ __device__ bool next(int i, Unit& u) const {
        const long L = (long)i * G + c; if (L >= nwg) return false;
        int wgid = (int)L; { const int q = nwg / NXCD, r = nwg % NXCD, xcd = wgid % NXCD, off = wgid / NXCD; wgid = (xcd < r ? xcd * (q + 1) : r * (q + 1) + (xcd - r) * q) + off; }
        const int nig = WGM * nN, gid = wgid / nig, fm = gid * WGM, gsz = (nM - fm) < WGM ? (nM - fm) : WGM;
        u.pm = fm + ((wgid % nig) % gsz); u.pn = (wgid % nig) / gsz; return true;
    }
    __device__ __forceinline__ void a_ready(const Unit&) const {}
    __device__ __forceinline__ void done(const Unit&) const {}
};

__device__ __forceinline__ unsigned cvt_pk_bf16(float lo, float hi) { unsigned r; asm volatile("v_cvt_pk_bf16_f32 %0, %1, %2" : "=v"(r) : "v"(lo), "v"(hi)); return r; }
template <class Epi, class Sched, bool ALIGN_EPI = false, bool SP2 = false>
__device__ __forceinline__ void gemm_phase(PG8_LAS unsigned char* lds, const Gemm g, const Sched& S, const Epi& E) {
    const int tid = threadIdx.x, wid = __builtin_amdgcn_readfirstlane(tid >> 6), lane = tid & 63, wr = wid >> 2, wc = wid & 3, fr = lane & 15, fq = lane >> 4;
    const int K = g.K, nt = K / BK;
    unsigned voffA[2], voffB[2];
#pragma unroll
    for (int i = 0; i < 2; ++i) { int R, C; stage_rc(tid * 16 + i * 8192, R, C); const int Rb = Epi::PERM ? ((R & ~31) + perm32(R & 31)) : R;
        voffA[i] = (unsigned)(R * g.ld + C) * 2u; voffB[i] = (unsigned)(Rb * g.ld + C) * 2u; }
    const size_t kstep = (size_t)(BK * 2);
    const size_t hstep = (size_t)HALF * g.ld * 2;
    const size_t tstep = 2 * hstep;
    const unsigned ldsw = (unsigned)wid * 1024u;
    const int aoff = lds_byte(wr * 64 + fr, fq * 8), boff = lds_byte(wc * 32 + fr, fq * 8);
#define PG8_SA(b, h) (((b) * 2 + (h)) * HTB)
#define PG8_SB(b, h) ((4 + (b) * 2 + (h)) * HTB)
#define PG8_STAGE(bufoff, gbase, voff) do { _Pragma("unroll") for (int _i = 0; _i < 2; ++_i) \
        __builtin_amdgcn_global_load_lds((const unsigned*)((const char*)(gbase) + (voff)[_i]), (PG8_LAS unsigned*)(lds + (bufoff) + ldsw + _i * 8192), 16, 0, 0); } while (0)
#define PG8_LDA(dst, b, h) do { _Pragma("unroll") for (int m = 0; m < 4; ++m) _Pragma("unroll") for (int k = 0; k < 2; ++k) dst[m][k] = *(const PG8_LAS bf16x8*)(lds + PG8_SA(b, h) + aoff + m * 2048 + k * 1024); } while (0)
#define PG8_LDB(dst, b, h) do { _Pragma("unroll") for (int n = 0; n < 2; ++n) _Pragma("unroll") for (int k = 0; k < 2; ++k) dst[n][k] = *(const PG8_LAS bf16x8*)(lds + PG8_SB(b, h) + boff + n * 2048 + k * 1024); } while (0)
#define PG8_MMA(ai, bj, At, Bt) do { __builtin_amdgcn_s_setprio(1); _Pragma("unroll") for (int m = 0; m < 4; ++m) _Pragma("unroll") for (int n = 0; n < 2; ++n) _Pragma("unroll") for (int k = 0; k < 2; ++k) \
        acc[ai][bj][m][n] = __builtin_amdgcn_mfma_f32_16x16x32_bf16(Bt[n][k], At[m][k], acc[ai][bj][m][n], 0, 0, 0); __builtin_amdgcn_s_setprio(0); } while (0)
#define PG8_WAIT_V(n) asm volatile("s_waitcnt vmcnt(" #n ")" ::: "memory")
#define PG8_WAIT_L(n) asm volatile("s_waitcnt lgkmcnt(" #n ")" ::: "memory")
#define PG8_BAR __builtin_amdgcn_s_barrier()
#define PG8_SCHED __builtin_amdgcn_sched_barrier(0)
    Unit cur, nxt; int ui = 0;
    if (!S.next(0, cur)) return;
    f32x4 acc[2][2][4][2];
#pragma unroll
    for (int a = 0; a < 2; ++a)
#pragma unroll
        for (int b = 0; b < 2; ++b)
#pragma unroll
            for (int m = 0; m < 4; ++m)
#pragma unroll
                for (int n = 0; n < 2; ++n) acc[a][b][m][n] = (f32x4){0.f, 0.f, 0.f, 0.f};
    bf16x8 At[4][2], B0[2][2], B1[2][2];
    const char* cA = (const char*)g.A + (size_t)cur.pm * tstep; const char* cB = (const char*)g.Bt + (size_t)cur.pn * tstep;
    S.a_ready(cur);
    if constexpr (SP2) {
        PG8_STAGE(PG8_SB(0, 0), cB, voffB); PG8_STAGE(PG8_SB(0, 1), cB + hstep, voffB); PG8_STAGE(PG8_SA(0, 0), cA, voffA); PG8_STAGE(PG8_SA(0, 1), cA + hstep, voffA);
        if (wr == 1) PG8_BAR;
        PG8_WAIT_V(2); PG8_BAR;
        PG8_STAGE(PG8_SB(1, 0), cB + kstep, voffB); PG8_STAGE(PG8_SA(1, 0), cA + kstep, voffA); PG8_STAGE(PG8_SB(1, 1), cB + hstep + kstep, voffB);
        PG8_WAIT_V(6); PG8_BAR;
    } else {
        PG8_STAGE(PG8_SB(0, 0), cB, voffB); PG8_STAGE(PG8_SA(0, 0), cA, voffA); PG8_STAGE(PG8_SB(0, 1), cB + hstep, voffB); PG8_STAGE(PG8_SA(0, 1), cA + hstep, voffA);
        if (wr == 1) PG8_BAR;
        PG8_WAIT_V(4); PG8_BAR;
        PG8_STAGE(PG8_SB(1, 0), cB + kstep, voffB); PG8_STAGE(PG8_SA(1, 0), cA + kstep, voffA); PG8_STAGE(PG8_SB(1, 1), cB + hstep + kstep, voffB);
        PG8_WAIT_V(6); PG8_BAR;
    }
    for (;;) {
        const bool has_next = S.next(ui + 1, nxt);
        const char* nA = has_next ? (const char*)g.A + (size_t)nxt.pm * tstep : cA; const char* nB = has_next ? (const char*)g.Bt + (size_t)nxt.pn * tstep : cB;
        for (int t = 0; t < nt; t += 2) {
            const bool last = (t == nt - 2);
            const char* a1 = cA + (size_t)(t + 1) * kstep;
            const char* a2 = last ? nA : cA + (size_t)(t + 2) * kstep; const char* b2 = last ? nB : cB + (size_t)(t + 2) * kstep;
            const char* a3 = a2 + kstep; const char* b3 = b2 + kstep;
            if (last && has_next) S.a_ready(nxt);
            if constexpr (SP2) {
            PG8_LDB(B0, 0, 0); PG8_LDB(B1, 0, 1); PG8_SCHED; PG8_LDA(At, 0, 0); PG8_STAGE(PG8_SA(1, 1), a1 + hstep, voffA);
            PG8_WAIT_V(8); PG8_WAIT_L(0); PG8_BAR; PG8_MMA(0, 0, At, B0); PG8_MMA(0, 1, At, B1); PG8_BAR; PG8_SCHED;
            PG8_LDA(At, 0, 1); PG8_STAGE(PG8_SB(0, 0), b2, voffB); PG8_STAGE(PG8_SB(0, 1), b2 + hstep, voffB); PG8_STAGE(PG8_SA(0, 0), a2, voffA);
            PG8_WAIT_V(8); PG8_WAIT_L(0); PG8_BAR; PG8_MMA(1, 0, At, B0); PG8_MMA(1, 1, At, B1); PG8_BAR; PG8_SCHED;
            PG8_LDB(B0, 1, 0); PG8_LDB(B1, 1, 1); PG8_SCHED; PG8_LDA(At, 1, 0); PG8_STAGE(PG8_SA(0, 1), a2 + hstep, voffA);
            PG8_WAIT_V(8); PG8_WAIT_L(0); PG8_BAR; PG8_MMA(0, 0, At, B0); PG8_MMA(0, 1, At, B1); PG8_BAR; PG8_SCHED;
            PG8_LDA(At, 1, 1); PG8_STAGE(PG8_SB(1, 0), b3, voffB); PG8_STAGE(PG8_SB(1, 1), b3 + hstep, voffB); PG8_STAGE(PG8_SA(1, 0), a3, voffA);
            PG8_WAIT_V(8); PG8_WAIT_L(0); PG8_BAR; PG8_MMA(1, 0, At, B0); PG8_MMA(1, 1, At, B1); PG8_BAR; PG8_SCHED;
            } else {
            PG8_LDB(B0, 0, 0); PG8_SCHED; PG8_LDA(At, 0, 0); PG8_STAGE(PG8_SA(1, 1), a1 + hstep, voffA);
            PG8_WAIT_L(8); PG8_BAR; PG8_WAIT_L(0); PG8_MMA(0, 0, At, B0); PG8_BAR; PG8_SCHED;
            PG8_LDB(B1, 0, 1); PG8_STAGE(PG8_SB(0, 0), b2, voffB);
            PG8_BAR; PG8_WAIT_L(0); PG8_MMA(0, 1, At, B1); PG8_BAR;
            PG8_LDA(At, 0, 1); PG8_STAGE(PG8_SA(0, 0), a2, voffA);
            PG8_BAR; PG8_WAIT_L(0); PG8_MMA(1, 0, At, B0); PG8_BAR; PG8_SCHED;
            PG8_STAGE(PG8_SB(0, 1), b2 + hstep, voffB);
            PG8_WAIT_V(6); PG8_BAR; PG8_MMA(1, 1, At, B1); PG8_BAR;
            PG8_LDB(B0, 1, 0); PG8_SCHED; PG8_LDA(At, 1, 0); PG8_STAGE(PG8_SA(0, 1), a2 + hstep, voffA);
            PG8_WAIT_L(8); PG8_BAR; PG8_WAIT_L(0); PG8_MMA(0, 0, At, B0); PG8_BAR; PG8_SCHED;
            PG8_LDB(B1, 1, 1); PG8_STAGE(PG8_SB(1, 0), b3, voffB);
            PG8_BAR; PG8_WAIT_L(0); PG8_MMA(0, 1, At, B1); PG8_BAR;
            PG8_LDA(At, 1, 1); PG8_STAGE(PG8_SA(1, 0), a3, voffA);
            PG8_BAR; PG8_WAIT_L(0); PG8_MMA(1, 0, At, B0); PG8_BAR; PG8_SCHED;
            PG8_STAGE(PG8_SB(1, 1), b3 + hstep, voffB);
            PG8_WAIT_V(6); PG8_BAR; PG8_MMA(1, 1, At, B1); PG8_BAR;
            }
        }
        if constexpr (ALIGN_EPI) { if (wr == 0) PG8_BAR; }
        if constexpr (!Epi::AFTER_DRAIN) { E(acc, cur, wr, wc, fr, fq); S.done(cur); }
        if (!has_next) break;
#pragma unroll
        for (int a = 0; a < 2; ++a)
#pragma unroll
            for (int b = 0; b < 2; ++b)
#pragma unroll
                for (int m = 0; m < 4; ++m)
#pragma unroll
                    for (int n = 0; n < 2; ++n) acc[a][b][m][n] = (f32x4){0.f, 0.f, 0.f, 0.f};
        cur = nxt; cA = nA; cB = nB; ++ui;
        if constexpr (ALIGN_EPI) { if (wr == 1) PG8_BAR; }
    }
    PG8_WAIT_V(0);
    if constexpr (!ALIGN_EPI) { if (wr == 0) PG8_BAR; }
    PG8_BAR;
    if constexpr (Epi::AFTER_DRAIN) { E.fused(acc, cur, wr, wc, fr, fq, lds, wid, lane); S.done(cur); }
#undef PG8_SA
#undef PG8_SB
#undef PG8_STAGE
#undef PG8_LDA
#undef PG8_LDB
#undef PG8_MMA
#undef PG8_WAIT_V
#undef PG8_WAIT_L
#undef PG8_BAR
#undef PG8_SCHED
}
}

constexpr int D = 2048, TP = 8192, NB = 16, TS = 16, MS = NB * TS, M = TP + MS;
constexpr int RW = 1024, RH = 16, RN = 64, RC = 3328;
constexpr int ED = 1024, EH = 4, EN = 256, EC = 4096, IC = RC + EC;
constexpr int FF = 5632, NSEQ = 17, MODW = 6 * D;
constexpr int LCH = 128, NCH = TP / LCH;
constexpr int RBLK = 256, NRB = TP / RBLK;
constexpr int NPHASE = 14;
constexpr size_t O_Y = 0, O_SHP = (size_t)M * D, O_WKP = O_SHP + RC, O_RTP = O_WKP + 65536, O_SHS = O_RTP + 262144, O_WKS = O_SHS + (size_t)NB * RC, O_RTS = O_WKS + (size_t)NB * 65536, O_END = O_RTS + (size_t)NB * 262144;
constexpr size_t MiB = 1u << 20;
constexpr size_t WS_MOD = 1 * MiB, WS_LORAT = 2 * MiB, WS_WOUTT = 4 * MiB, WS_WINT = 12 * MiB, WS_V = 12 * MiB, WS_H = 41 * MiB, WS_G = 41 * MiB, WS_BON = 58 * MiB,
                 WS_QKVG = 74 * MiB, WS_LOUT = 140 * MiB, WS_PU = 140 * MiB, WS_KVB = 172 * MiB, WS_ACT = 74 * MiB, WS_PREP = 190 * MiB, WS_MIXOUT = 190 * MiB,
                 WS_WUPT = 256 * MiB, WS_WDNT = 300 * MiB, WS_PART9 = 330 * MiB, WS_PART12 = 256 * MiB, WS_END = 355 * MiB;
constexpr size_t WS_ADAT = 190 * MiB, WS_SC = 239 * MiB, WS_MODP = 240 * MiB;
constexpr int KS9 = 4, KS12 = 11;
constexpr size_t PREP_STRIDE = 33 * MiB;
constexpr size_t DO_Z = 0, DO_LIN = 54 * MiB, DO_SPREV = 0, DO_MIX = 17 * MiB;
constexpr int LDS_BYTES = 147456;

typedef unsigned short bf16;
typedef float f32x2 __attribute__((ext_vector_type(2)));
typedef float f32x4 __attribute__((ext_vector_type(4)));
typedef short bf16x8 __attribute__((ext_vector_type(8)));
typedef unsigned u32x4 __attribute__((ext_vector_type(4)));
typedef unsigned u32x2 __attribute__((ext_vector_type(2)));
#define LDS_WAIT() asm volatile("s_waitcnt lgkmcnt(0)" ::: "memory")

__device__ __forceinline__ float bf2f(unsigned v) { return __builtin_bit_cast(float, v << 16); }
__device__ __forceinline__ unsigned f2bf(float f) { unsigned u = __builtin_bit_cast(unsigned, f); return (u + 0x7fffu + ((u >> 16) & 1u)) >> 16; }
__device__ __forceinline__ unsigned pk2(float lo, float hi) { return f2bf(lo) | (f2bf(hi) << 16); }
__device__ __forceinline__ float wave_sum(float v) {
#pragma unroll
    for (int o = 1; o < 64; o <<= 1) v += __shfl_xor(v, o);
    return v;
}
__device__ __forceinline__ float sigm(float x) { return 1.f / (1.f + __expf(-x)); }
__device__ __forceinline__ int seq_of(int m) { return m < TP ? 0 : 1 + ((m - TP) >> 4); }
__device__ __forceinline__ int tpos_of(int m) { return m < TP ? m : ((m - TP) & 15); }
__device__ __forceinline__ float ret_l2g(int h) { return __log2f(1.0f - exp2f(-5.0f - (float)h)); }

struct EpiProj {
    static constexpr bool PERM = true, AFTER_DRAIN = false;
    bf16* Z; bf16* Q;
    __device__ __forceinline__ void operator()(const f32x4 (&acc)[2][2][4][2], const pg8::Unit& u, int wr, int wc, int fr, int fq) const {
        const int row0 = u.pm * 256 + wr * 64 + fr, pn = u.pn, cl = wc * 32 + 8 * fq;
        if (pn < 13 || pn >= 21) {
            bf16* base = pn < 13 ? Z + pn * 256 + cl : Q + (pn - 13) * 256 + cl; const size_t ld = pn < 13 ? RC : EC;
#pragma unroll
            for (int ai = 0; ai < 2; ++ai)
#pragma unroll
                for (int m = 0; m < 4; ++m) { bf16* rp = base + (size_t)(row0 + ai * 128 + m * 16) * ld;
#pragma unroll
                    for (int bj = 0; bj < 2; ++bj) { const f32x4 v0 = acc[ai][bj][m][0], v1 = acc[ai][bj][m][1]; u32x4 w; w.x = pk2(v0[0], v0[1]); w.y = pk2(v0[2], v0[3]); w.z = pk2(v1[0], v1[1]); w.w = pk2(v1[2], v1[3]);
                        *(u32x4*)(rp + bj * 128) = w; } }
        } else {
            const int sec = pn - 13; bf16* base = Q + sec * 256 + cl; const float sc = sec >= 4 ? 0.0625f : 1.0f;
            float inv[8];
#pragma unroll
            for (int e = 0; e < 8; ++e) inv[e] = exp2f(-(float)(cl + e) * (13.287712379549449f / 128.0f)) * 0.15915494309189535f;
#pragma unroll
            for (int ai = 0; ai < 2; ++ai)
#pragma unroll
                for (int m = 0; m < 4; ++m) { const int row = row0 + ai * 128 + m * 16; bf16* rp = base + (size_t)row * EC;
                    const float pos = row < TP ? (float)row : (float)(2048 + ((row - TP) & 15));
                    float o1[8], o2[8];
#pragma unroll
                    for (int e = 0; e < 8; ++e) { float rev = pos * inv[e]; rev -= floorf(rev); const float sn = __builtin_amdgcn_sinf(rev), cs = __builtin_amdgcn_cosf(rev);
                        const float x1 = acc[ai][0][m][e >> 2][e & 3], x2 = acc[ai][1][m][e >> 2][e & 3];
                        o1[e] = (x1 * cs - x2 * sn) * sc; o2[e] = (x2 * cs + x1 * sn) * sc; }
                    u32x4 w; w.x = pk2(o1[0], o1[1]); w.y = pk2(o1[2], o1[3]); w.z = pk2(o1[4], o1[5]); w.w = pk2(o1[6], o1[7]); *(u32x4*)rp = w;
                    w.x = pk2(o2[0], o2[1]); w.y = pk2(o2[2], o2[3]); w.z = pk2(o2[4], o2[5]); w.w = pk2(o2[6], o2[7]); *(u32x4*)(rp + 128) = w; }
        }
    }
};
struct EpiBf16P {
    static constexpr bool PERM = true, AFTER_DRAIN = false;
    bf16* C; int ldc;
    __device__ __forceinline__ void operator()(const f32x4 (&acc)[2][2][4][2], const pg8::Unit& u, int wr, int wc, int fr, int fq) const {
        const int row0 = u.pm * 256 + wr * 64 + fr; bf16* base = C + u.pn * 256 + wc * 32 + 8 * fq;
#pragma unroll
        for (int ai = 0; ai < 2; ++ai)
#pragma unroll
            for (int m = 0; m < 4; ++m) { bf16* rp = base + (size_t)(row0 + ai * 128 + m * 16) * ldc;
#pragma unroll
                for (int bj = 0; bj < 2; ++bj) { const f32x4 v0 = acc[ai][bj][m][0], v1 = acc[ai][bj][m][1]; u32x4 w; w.x = pk2(v0[0], v0[1]); w.y = pk2(v0[2], v0[3]); w.z = pk2(v1[0], v1[1]); w.w = pk2(v1[2], v1[3]);
                    *(u32x4*)(rp + bj * 128) = w; } }
    }
};
struct EpiF32 {
    static constexpr bool PERM = true, AFTER_DRAIN = false;
    float* C; int ldc;
    __device__ __forceinline__ void operator()(const f32x4 (&acc)[2][2][4][2], const pg8::Unit& u, int wr, int wc, int fr, int fq) const {
        const int row0 = u.pm * 256 + wr * 64 + fr; float* base = C + u.pn * 256 + wc * 32 + 8 * fq;
#pragma unroll
        for (int ai = 0; ai < 2; ++ai)
#pragma unroll
            for (int m = 0; m < 4; ++m) { float* rp = base + (size_t)(row0 + ai * 128 + m * 16) * ldc;
#pragma unroll
                for (int bj = 0; bj < 2; ++bj) { *(f32x4*)(rp + bj * 128) = acc[ai][bj][m][0]; *(f32x4*)(rp + bj * 128 + 4) = acc[ai][bj][m][1]; } }
    }
};
struct EpiSwiglu {
    static constexpr bool PERM = true, AFTER_DRAIN = false;
    bf16* C;
    __device__ __forceinline__ void operator()(const f32x4 (&acc)[2][2][4][2], const pg8::Unit& u, int wr, int wc, int fr, int fq) const {
        const int row0 = u.pm * 256 + wr * 64 + fr; bf16* base = C + u.pn * 128 + wc * 32 + 8 * fq;
#pragma unroll
        for (int ai = 0; ai < 2; ++ai)
#pragma unroll
            for (int m = 0; m < 4; ++m) { float o[8];
#pragma unroll
                for (int e = 0; e < 8; ++e) { const float g = acc[ai][0][m][e >> 2][e & 3], up = acc[ai][1][m][e >> 2][e & 3]; o[e] = g * sigm(g) * up; }
                u32x4 w; w.x = pk2(o[0], o[1]); w.y = pk2(o[2], o[3]); w.z = pk2(o[4], o[5]); w.w = pk2(o[6], o[7]);
                *(u32x4*)(base + (size_t)(row0 + ai * 128 + m * 16) * FF) = w; }
    }
};
struct EpiMod {
    static constexpr bool PERM = true, AFTER_DRAIN = false;
    float* C; int ldc;
    __device__ __forceinline__ void operator()(const f32x4 (&acc)[2][2][4][2], const pg8::Unit& u, int wr, int wc, int fr, int fq) const {
        if (wr != 0) return;
        float* base = C + u.pn * 256 + wc * 32 + 8 * fq;
#pragma unroll
        for (int m = 0; m < 2; ++m) { const int row = 16 * m + fr; if (row < NSEQ) { float* rp = base + (size_t)row * ldc;
#pragma unroll
            for (int bj = 0; bj < 2; ++bj) { *(f32x4*)(rp + bj * 128) = acc[0][bj][m][0]; *(f32x4*)(rp + bj * 128 + 4) = acc[0][bj][m][1]; } } }
    }
};

__device__ __forceinline__ void transpose_item(const float* __restrict__ W, int K, int N, bf16* WT, int k0, int n0, int dst_row0, float* scr, int lane) {
#pragma unroll 8
    for (int i = 0; i < 32; ++i) { const int kk = 2 * i + (lane >> 5); scr[kk * 33 + (lane & 31)] = W[(size_t)(k0 + kk) * N + n0 + (lane & 31)]; }
    LDS_WAIT();
    const int c = lane & 7;
#pragma unroll
    for (int j = 0; j < 4; ++j) { const int n = (lane >> 3) + 8 * j; const float* s = scr + (8 * c) * 33 + n;
        u32x4 o; o.x = pk2(s[0 * 33], s[1 * 33]); o.y = pk2(s[2 * 33], s[3 * 33]); o.z = pk2(s[4 * 33], s[5 * 33]); o.w = pk2(s[6 * 33], s[7 * 33]);
        *(u32x4*)(WT + (size_t)(dst_row0 + n) * K + k0 + 8 * c) = o; }
    LDS_WAIT();
}

typedef const __attribute__((address_space(4))) f32x2* cf2p;
__device__ __forceinline__ cf2p to_c(const float* p) { return (cf2p)(unsigned long long)p; }
#define DPPF(old, src, ctrl, rmask) __builtin_bit_cast(float, __builtin_amdgcn_update_dpp(__builtin_bit_cast(int, (float)(old)), __builtin_bit_cast(int, (float)(src)), (ctrl), (rmask), 0xF, false))
__device__ __forceinline__ float wave_sum_u(float v) {
    v += DPPF(0.f, v, 0xB1, 0xF); v += DPPF(0.f, v, 0x4E, 0xF); v += DPPF(0.f, v, 0x124, 0xF); v += DPPF(0.f, v, 0x128, 0xF);
    v += DPPF(0.f, v, 0x142, 0xA); v += DPPF(0.f, v, 0x143, 0xC);
    return __builtin_bit_cast(float, __builtin_amdgcn_readlane(__builtin_bit_cast(int, v), 63));
}
constexpr int RW_PF = 6;
template <int MODE>
__device__ __forceinline__ void rwkv_run(f32x2 (&S)[32], const float* W, const float* NKK, const float* B, const float* K, const float* R, const bf16* Vp, int nsteps, int lane,
                                         const bf16* Gp, const float* BONp, bf16* MIXp, float lnw, float lnb) {
    constexpr int NPF = MODE == 2 ? 20 : (MODE == 0 ? 16 : 12);
    const int pa = lane >> 2; const float* pfp = (pa == 0 ? W : pa == 1 ? NKK : pa == 2 ? B : pa == 3 ? K : R) + (lane & 3) * 16;
    float vn = 0.f, gn = 0.f, bn = 0.f;
    if (MODE != 1) vn = bf2f(Vp[lane]);
    if (MODE == 2) { gn = bf2f(Gp[lane]); bn = BONp[0]; }
    if (lane < NPF) {
#pragma unroll
        for (int q = 1; q < RW_PF; ++q) if (q < nsteps) (void)*(volatile const float*)(pfp + (size_t)q * RW);
    }
    for (int t = 0; t < nsteps; ++t) {
        const size_t o = (size_t)t * RW;
        cf2p w = to_c(W + o), nk = to_c(NKK + o), b = to_c(B + o), k = to_c(K + o), r = to_c(R + o);
        const float v = vn, gv = gn, bon = bn;
        { const int t1 = t + 1 < nsteps ? t + 1 : t; const size_t o1 = (size_t)t1 * RW;
          if (MODE != 1) vn = bf2f(Vp[o1 + lane]);
          if (MODE == 2) { gn = bf2f(Gp[o1 + lane]); bn = BONp[(size_t)t1 * 16]; }
          const int tp = t + RW_PF < nsteps ? t + RW_PF : nsteps - 1;
          if (lane < NPF) (void)*(volatile const float*)(pfp + (size_t)tp * RW); }
        f32x2 a0 = {0.f, 0.f}, a1 = {0.f, 0.f};
#pragma unroll
        for (int j = 0; j < 32; j += 2) { a0 = __builtin_elementwise_fma(S[j], nk[j], a0); a1 = __builtin_elementwise_fma(S[j + 1], nk[j + 1], a1); }
        const float sa = (a0.x + a0.y) + (a1.x + a1.y);
        const f32x2 sa2 = {sa, sa}, v2 = {v, v};
        f32x2 o0 = {0.f, 0.f}, o1 = {0.f, 0.f};
#pragma unroll
        for (int j = 0; j < 32; ++j) {
            f32x2 s = S[j] * w[j];
            s = __builtin_elementwise_fma(sa2, b[j], s);
            if (MODE != 1) s = __builtin_elementwise_fma(v2, k[j], s);
            S[j] = s;
            if (MODE == 2) { if (j & 1) o1 = __builtin_elementwise_fma(s, r[j], o1); else o0 = __builtin_elementwise_fma(s, r[j], o0); }
        }
        if (MODE == 2) {
            const float ov = (o0.x + o0.y) + (o1.x + o1.y);
            const float mean = wave_sum_u(ov) * (1.f / 64.f), d = ov - mean, var = wave_sum_u(d * d) * (1.f / 64.f);
            float y = d * rsqrtf(var + 64e-5f) * lnw + lnb;
            y = (y + bon * v) * gv;
            MIXp[(size_t)t * D + lane] = (bf16)f2bf(y);
        }
    }
}

constexpr int RL_B = 8;
template <int MODE> struct RL { static constexpr int NV = MODE == 2 ? 5 : (MODE == 0 ? 4 : 3); static constexpr int REC = NV * 64, BUF = RL_B * REC + (MODE != 1 ? 256 : 0) + (MODE == 2 ? 256 + 16 : 0); };
#define SBAR() __builtin_amdgcn_sched_barrier(0)
template <int MODE>
__device__ __forceinline__ void rwkv_lds(f32x2 (&S)[32], const float* W, const float* NKK, const float* B, const float* K, const float* R, const bf16* Vp, int nsteps, int lane,
                                         const bf16* Gp, const float* BONp, bf16* MIXp, float lnw, float lnb, float* wl) {
    constexpr int NV = RL<MODE>::NV, REC = RL<MODE>::REC;
    const int ls = lane >> 4, lc = (lane & 15) * 4;
    f32x4 st[NV][2]; u32x4 sv = {0u, 0u, 0u, 0u}, sg = {0u, 0u, 0u, 0u}; float sb = 0.f;
#define RL_ISSUE(bt) do { const size_t ob = (size_t)((bt) * RL_B) * RW; \
        _Pragma("unroll") for (int q = 0; q < 2; ++q) { const size_t oo = ob + (size_t)(ls + 4 * q) * RW + lc; \
            st[0][q] = *(const f32x4*)(W + oo); st[1][q] = *(const f32x4*)(NKK + oo); st[2][q] = *(const f32x4*)(B + oo); if (NV >= 4) st[NV >= 4 ? 3 : 0][q] = *(const f32x4*)(K + oo); if (NV == 5) st[NV - 1][q] = *(const f32x4*)(R + oo); } \
        if (MODE != 1) sv = *(const u32x4*)(Vp + ob + (size_t)(lane >> 3) * RW + (lane & 7) * 8); \
        if (MODE == 2) { sg = *(const u32x4*)(Gp + ob + (size_t)(lane >> 3) * RW + (lane & 7) * 8); if (lane < RL_B) sb = BONp[(size_t)((bt) * RL_B + lane) * 16]; } } while (0)
#define RL_COMMIT() do { \
        _Pragma("unroll") for (int q = 0; q < 2; ++q) _Pragma("unroll") for (int v = 0; v < NV; ++v) *(f32x4*)(wl + (ls + 4 * q) * REC + v * 64 + lc) = st[v][q]; \
        if (MODE != 1) *(u32x4*)((bf16*)(wl + RL_B * REC) + (lane >> 3) * 64 + (lane & 7) * 8) = sv; \
        if (MODE == 2) { *(u32x4*)((bf16*)(wl + RL_B * REC + 256) + (lane >> 3) * 64 + (lane & 7) * 8) = sg; if (lane < RL_B) wl[RL_B * REC + 512 + lane] = sb; } } while (0)
    const int nb = nsteps / RL_B;
    RL_ISSUE(0); RL_COMMIT();
    for (int bt = 0; bt < nb; ++bt) {
        if (bt + 1 < nb) RL_ISSUE(bt + 1);
#pragma unroll 1
        for (int s = 0; s < RL_B; ++s) {
            const f32x2* w = (const f32x2*)(wl + s * REC); const f32x2* nk = w + 32; const f32x2* b = w + 64; const f32x2* k = w + 96; const f32x2* r = w + 128;
            float v = 0.f, gv = 0.f, bon = 0.f;
            if (MODE != 1) v = bf2f(((const bf16*)(wl + RL_B * REC))[s * 64 + lane]);
            if (MODE == 2) { gv = bf2f(((const bf16*)(wl + RL_B * REC + 256))[s * 64 + lane]); bon = wl[RL_B * REC + 512 + s]; }
            f32x2 nA[8], nB[8]; f32x2 a0 = {0.f, 0.f}, a1 = {0.f, 0.f};
#pragma unroll
            for (int p = 0; p < 8; ++p) nA[p] = nk[p];
#pragma unroll
            for (int g = 0; g < 4; ++g) {
                if (g < 3) {
#pragma unroll
                    for (int p = 0; p < 8; ++p) { if (g & 1) nA[p] = nk[8 * (g + 1) + p]; else nB[p] = nk[8 * (g + 1) + p]; } }
                SBAR();
#pragma unroll
                for (int p = 0; p < 8; p += 2) { a0 = __builtin_elementwise_fma(S[8 * g + p], (g & 1) ? nB[p] : nA[p], a0); a1 = __builtin_elementwise_fma(S[8 * g + p + 1], (g & 1) ? nB[p + 1] : nA[p + 1], a1); }
                SBAR();
            }
            const float sa = (a0.x + a0.y) + (a1.x + a1.y);
            const f32x2 sa2 = {sa, sa}, v2 = {v, v};
            f32x2 uw[2][4], ub[2][4], uk[2][4], ur[2][4]; f32x2 o0 = {0.f, 0.f}, o1 = {0.f, 0.f};
#pragma unroll
            for (int p = 0; p < 4; ++p) { uw[0][p] = w[p]; ub[0][p] = b[p]; if (MODE != 1) uk[0][p] = k[p]; if (MODE == 2) ur[0][p] = r[p]; }
#pragma unroll
            for (int g = 0; g < 8; ++g) {
                if (g < 7) {
#pragma unroll
                    for (int p = 0; p < 4; ++p) { uw[(g + 1) & 1][p] = w[4 * (g + 1) + p]; ub[(g + 1) & 1][p] = b[4 * (g + 1) + p]; if (MODE != 1) uk[(g + 1) & 1][p] = k[4 * (g + 1) + p]; if (MODE == 2) ur[(g + 1) & 1][p] = r[4 * (g + 1) + p]; } }
                SBAR();
#pragma unroll
                for (int p = 0; p < 4; ++p) { const int j = 4 * g + p;
                    f32x2 x = S[j] * uw[g & 1][p]; x = __builtin_elementwise_fma(sa2, ub[g & 1][p], x); if (MODE != 1) x = __builtin_elementwise_fma(v2, uk[g & 1][p], x); S[j] = x;
                    if (MODE == 2) { if (p & 1) o1 = __builtin_elementwise_fma(x, ur[g & 1][p], o1); else o0 = __builtin_elementwise_fma(x, ur[g & 1][p], o0); } }
                SBAR();
            }
            if (MODE == 2) {
                const float ov = (o0.x + o0.y) + (o1.x + o1.y);
                const float mean = wave_sum_u(ov) * (1.f / 64.f), d = ov - mean, var = wave_sum_u(d * d) * (1.f / 64.f);
                float y = d * rsqrtf(var + 64e-5f) * lnw + lnb;
                y = (y + bon * v) * gv;
                MIXp[(size_t)(bt * RL_B + s) * D + lane] = (bf16)f2bf(y);
            }
        }
        if (bt + 1 < nb) RL_COMMIT();
    }
#undef RL_ISSUE
#undef RL_COMMIT
}
#define LAS __attribute__((address_space(3)))

#define XB_TMO      128
#define XB_XCNT(j)  (256  + 64 * (j))
#define XB_XSUB(j)  (1280 + 64 * (j))
#define XB_XGEN(j)  (2304 + 64 * (j))
#define XB_TOP      3328
#define XB_TOPGEN   3392
#define XCD_BAR_WORDS 3456
#define XB_SPIN_CAP (1u << 18)

__device__ __forceinline__ unsigned xb_ld(unsigned* p)              { return __hip_atomic_load(p, __ATOMIC_RELAXED, __HIP_MEMORY_SCOPE_AGENT); }
__device__ __forceinline__ unsigned xb_add(unsigned* p, unsigned v) { return __hip_atomic_fetch_add(p, v, __ATOMIC_RELAXED, __HIP_MEMORY_SCOPE_AGENT); }
__device__ __forceinline__ unsigned xb_xcc_id() { return (unsigned)__builtin_amdgcn_s_getreg((3 << 11) | 20) & 0xFu; }
#define XB_SPIN(cond, bar) do { unsigned _sp = 0; while (cond) { __builtin_amdgcn_s_sleep(1); \
    if ((++_sp & 255u) == 0u) { if (xb_ld(&(bar)[XB_TMO])) break; if (_sp > XB_SPIN_CAP) { atomicAdd(&(bar)[XB_TMO], 1u); break; } } } } while (0)

struct XcdBarrier {
    unsigned* bar; unsigned x;
    volatile LAS unsigned* st;
};

__device__ __forceinline__ XcdBarrier xcd_barrier_post(unsigned* bar, volatile LAS unsigned* st) {
    XcdBarrier b; b.bar = bar; b.x = xb_xcc_id(); b.st = st;
    if (threadIdx.x == 0) (void)xb_add(&bar[XB_XCNT(b.x)], 1u);
    return b;
}
__device__ __forceinline__ void xcd_barrier_complete(unsigned* bar, unsigned x, unsigned& nloc, unsigned& nx) {
    const unsigned G = gridDim.x * gridDim.y * gridDim.z;
    unsigned sum, cnt, mine, sp = 0u;
    for (;;) {
        sum = 0u; cnt = 0u; mine = 0u;
#pragma unroll
        for (unsigned j = 0; j < 16; ++j) { const unsigned c = xb_ld(&bar[XB_XCNT(j)]); sum += c; cnt += (c > 0u) ? 1u : 0u; mine = (j == x) ? c : mine; }
        if (sum == G) break;
        __builtin_amdgcn_s_sleep(1);
        if ((++sp & 255u) == 0u) { if (xb_ld(&bar[XB_TMO])) break; if (sp > XB_SPIN_CAP) { atomicAdd(&bar[XB_TMO], 1u); break; } }
    }
    nloc = mine > 0u ? mine : 1u; nx = cnt > 0u ? cnt : 1u;
}

__device__ __forceinline__ void xcd_barrier(const XcdBarrier& b) {
    asm volatile("s_waitcnt vmcnt(0)" ::: "memory");
    __syncthreads();
    if (threadIdx.x == 0) {
        unsigned* bar = b.bar;
        __builtin_amdgcn_s_waitcnt(0);
        unsigned nloc = b.st[0], nx = b.st[1];
        if (nloc == 0u) { xcd_barrier_complete(bar, b.x, nloc, nx); b.st[0] = nloc; b.st[1] = nx; }
        const unsigned old = xb_add(&bar[XB_XSUB(b.x)], 1u);
        const unsigned gen = old / nloc;
        if (old + 1u == (gen + 1u) * nloc) {
            __builtin_amdgcn_fence(__ATOMIC_RELEASE, "agent");
            asm volatile("s_waitcnt vmcnt(0)" ::: "memory");
            const unsigned og = xb_add(&bar[XB_TOP], 1u);
            const unsigned tg = og / nx;
            if (og + 1u == (tg + 1u) * nx) xb_add(&bar[XB_TOPGEN], 1u);
            else XB_SPIN(xb_ld(&bar[XB_TOPGEN]) == tg, bar);
            __builtin_amdgcn_fence(__ATOMIC_ACQUIRE, "agent");
            xb_add(&bar[XB_XGEN(b.x)], 1u);
            asm volatile("s_waitcnt vmcnt(0)" ::: "memory");
        } else {
            XB_SPIN(xb_ld(&bar[XB_XGEN(b.x)]) == gen, bar);
            __builtin_amdgcn_fence(__ATOMIC_ACQUIRE, "agent");
            asm volatile("s_waitcnt vmcnt(0)" ::: "memory");
        }
    }
    __syncthreads();
}


struct Args { const float* in[30]; float* out; unsigned char* ws; int ph_lo, ph_hi; };
enum { I_XP = 0, I_XS, I_CP, I_CS, I_SSH, I_SWKV, I_SRET, I_ADAW, I_ADAB, I_GPM, I_GPOM, I_GPF, I_GPOF, I_WIN, I_MU, I_W0, I_W2, I_A0, I_A2, I_G2, I_KK, I_KA, I_RK, I_RLW, I_RLB, I_ELW, I_ELB, I_WOUT, I_WUP, I_WDN };

__global__ void __launch_bounds__(512, 2) mk_fwd(Args a) {
    extern __shared__ __attribute__((aligned(16))) unsigned char lds[];
    cg::grid_group grid = cg::this_grid();
    const int tid = threadIdx.x, lane = tid & 63, wave = __builtin_amdgcn_readfirstlane(tid >> 6);
    const int G = gridDim.x, bid = blockIdx.x, gw = bid * 8 + wave, NGW = G * 8;
    const int lo = a.ph_lo, hi = a.ph_hi;
    volatile LAS unsigned* xst = (volatile LAS unsigned*)((LAS unsigned char*)lds + LDS_BYTES - 16);
    if (tid < 2) xst[tid] = 0u;
    __syncthreads();
    XcdBarrier xb = xcd_barrier_post((unsigned*)(a.ws + 65536), xst);
    unsigned char* ws = a.ws; float* out = a.out; unsigned char* dob = (unsigned char*)a.out;
    float* MOD = (float*)(ws + WS_MOD);
    bf16* LORAT = (bf16*)(ws + WS_LORAT); bf16* WOUTT = (bf16*)(ws + WS_WOUTT); bf16* WINT = (bf16*)(ws + WS_WINT); bf16* WUPT = (bf16*)(ws + WS_WUPT); bf16* WDNT = (bf16*)(ws + WS_WDNT);
    bf16* H = (bf16*)(ws + WS_H); bf16* QKVG = (bf16*)(ws + WS_QKVG); bf16* LOUT = (bf16*)(ws + WS_LOUT); bf16* Z = (bf16*)(dob + DO_Z); bf16* LIN = (bf16*)(dob + DO_LIN);
    float* PW = (float*)(ws + WS_PREP); float* PNKK = (float*)(ws + WS_PREP + PREP_STRIDE); float* PB = (float*)(ws + WS_PREP + 2 * PREP_STRIDE); float* PK = (float*)(ws + WS_PREP + 3 * PREP_STRIDE); float* PR = (float*)(ws + WS_PREP + 4 * PREP_STRIDE);
    bf16* PV = (bf16*)(ws + WS_V); bf16* PG = (bf16*)(ws + WS_G); float* BON = (float*)(ws + WS_BON);
    float* PU = (float*)(ws + WS_PU); bf16* KVB = (bf16*)(ws + WS_KVB); bf16* SPREV = (bf16*)(dob + DO_SPREV); bf16* MIX = (bf16*)(dob + DO_MIX);
    float* MIXOUT = (float*)(ws + WS_MIXOUT); bf16* ACT = (bf16*)(ws + WS_ACT);
#ifndef DUP_PHASE
#define DUP_PHASE -1
#endif
#ifndef PH_MASK
#define PH_MASK 0x3fff
#endif
#define IN(k) (((PH_MASK >> (k)) & 1) && lo <= (k) && (k) < hi)
#ifndef TS_PROBE
#define TS_PROBE -1
#endif
    unsigned long long* TSW = (unsigned long long*)ws;
    if (TS_PROBE >= 0 && bid == 0 && tid == 0) TSW[0] = __builtin_amdgcn_s_memrealtime();
#define MID(n) do { if (TS_PROBE >= 0 && bid == 0) { __syncthreads(); if (tid == 0) TSW[32 + (n)] = __builtin_amdgcn_s_memrealtime(); } } while (0)
#define SEAM(k) do { if (IN(k) && IN((k) + 1)) { if ((k) == 0) grid.sync(); else xcd_barrier(xb); } if (TS_PROBE >= 0 && bid == 0 && tid == 0) TSW[1 + (k)] = __builtin_amdgcn_s_memrealtime(); } while (0)

    if (IN(0)) for (int rep = 0; rep < (DUP_PHASE == 0 ? 2 : 1); ++rep) {
        MID(0);
        float* scr = (float*)lds + wave * (64 * 33 + 16);
        constexpr int IT_WIN = (D / 64) * (IC / 32), IT_WOUT = (D / 64) * (D / 32), IT_ADA = (D / 64) * (MODW / 32);
        bf16* ADAT = (bf16*)(ws + WS_ADAT); bf16* SC = (bf16*)(ws + WS_SC);
        for (int it = gw; it < IT_WIN + IT_WOUT + IT_ADA; it += NGW) {
            if (it < IT_WIN) { const int nb = IC / 32, kb = it / nb, n0 = 32 * (it % nb); transpose_item(a.in[I_WIN], D, IC, WINT, 64 * kb, n0, n0, scr, lane); }
            else if (it < IT_WIN + IT_WOUT) { const int r = it - IT_WIN, nb = D / 32, kb = r / nb, n0 = 32 * (r % nb); transpose_item(a.in[I_WOUT], D, D, WOUTT, 64 * kb, n0, n0, scr, lane); }
            else { const int r = it - IT_WIN - IT_WOUT, nb = MODW / 32, kb = r / nb, n0 = 32 * (r % nb); transpose_item(a.in[I_ADAW], D, MODW, ADAT, 64 * kb, n0, n0, scr, lane); }
        }
        MID(1);
        for (int idx = bid * 512 + tid; idx < 3072 * 256; idx += G * 512) {
            const int n = idx >> 8, k = idx & 255, sec = n >> 10, nn = n & 1023; float v = 0.f;
            if (sec == 0 && k < 64) v = a.in[I_W2][k * RW + nn];
            else if (sec == 1 && k >= 64 && k < 128) v = a.in[I_A2][(k - 64) * RW + nn];
            else if (sec == 2 && k >= 128) v = a.in[I_G2][(k - 128) * RW + nn];
            LORAT[idx] = (bf16)f2bf(v);
        }
        for (int idx = bid * 512 + tid; idx < 256 * D; idx += G * 512) { const int r = idx / D, k = idx % D; float v = 0.f;
            if (r < NSEQ) { const float cv = r == 0 ? a.in[I_CP][k] : a.in[I_CS][(r - 1) * D + k]; v = cv * sigm(cv); }
            SC[idx] = (bf16)f2bf(v); }
        MID(2);
    }
    if (IN(0)) MID(3);
    SEAM(0);
    if (IN(1)) {
        { const int sl = bid / 48; pg8::Gemm g{(const bf16*)(ws + WS_SC) + sl * 512, (const bf16*)(ws + WS_ADAT) + sl * 512, 256, MODW, 512, D}; pg8::OneUnit S{0, bid % 48, bid < 192};
          EpiMod E{(float*)(ws + WS_MODP) + (size_t)sl * NSEQ * MODW, MODW};
          pg8::gemm_phase<EpiMod, pg8::OneUnit, false, true>((PG8_LAS unsigned char*)lds, g, S, E); }
        xcd_barrier(xb);
        const float* MODP = (const float*)(ws + WS_MODP);
        for (int idx = bid * 512 + tid; idx < NSEQ * MODW; idx += G * 512) { float v = a.in[I_ADAB][idx % MODW];
#pragma unroll
            for (int q = 0; q < 4; ++q) v += MODP[(size_t)q * NSEQ * MODW + idx];
            MOD[idx] = v; }
        xcd_barrier(xb);
    }
    if (IN(1)) for (int rep = 0; rep < (DUP_PHASE == 1 ? 2 : 1); ++rep) {
        for (int m = gw; m < M; m += NGW) {
            const float* xr = m < TP ? a.in[I_XP] + (size_t)m * D : a.in[I_XS] + (size_t)(m - TP) * D; const float* mod = MOD + seq_of(m) * MODW;
            f32x4 v[8]; float ss = 0.f;
#pragma unroll
            for (int j = 0; j < 8; ++j) { v[j] = *(const f32x4*)(xr + 4 * lane + 256 * j); ss += (v[j].x * v[j].x + v[j].y * v[j].y) + (v[j].z * v[j].z + v[j].w * v[j].w); }
            const float rs = rsqrtf(wave_sum(ss) * (1.f / D) + 1e-6f);
#pragma unroll
            for (int j = 0; j < 8; ++j) { const int c = 4 * lane + 256 * j; const f32x4 g = *(const f32x4*)(a.in[I_GPM] + c), s1 = *(const f32x4*)(mod + D + c), h1 = *(const f32x4*)(mod + c);
                const f32x4 h = v[j] * rs * g * (s1 + 1.f) + h1; u32x2 w; w.x = pk2(h.x, h.y); w.y = pk2(h.z, h.w); *(u32x2*)(H + (size_t)m * D + c) = w; }
        }
    }
    SEAM(1);
    if (IN(2)) for (int rep = 0; rep < (DUP_PHASE == 2 ? 2 : 1); ++rep) {
        pg8::Gemm g{H, WINT, M, IC, D, D}; pg8::StaticOrder S; S.init(M, IC, G, bid); EpiProj E{Z, QKVG};
        pg8::gemm_phase<EpiProj, pg8::StaticOrder, true, true>((PG8_LAS unsigned char*)lds, g, S, E);
    }
    SEAM(2);
    if (IN(3)) for (int rep = 0; rep < (DUP_PHASE == 3 ? 2 : 1); ++rep) {
        for (int idx = bid * 512 + tid; idx < M * 128; idx += G * 512) {
            const int m = idx >> 7, c2 = (idx & 127) * 2, c = 3072 + c2, tp = tpos_of(m), sq = seq_of(m);
            const unsigned zz = *(const unsigned*)(Z + (size_t)m * RC + c); float z0 = bf2f(zz & 0xffffu), z1 = bf2f(zz >> 16), p0 = 0.f, p1 = 0.f;
            if (tp > 0) { const unsigned pp = *(const unsigned*)(Z + (size_t)(m - 1) * RC + c); p0 = bf2f(pp & 0xffffu); p1 = bf2f(pp >> 16); }
            else if (sq > 0) { p0 = a.in[I_SSH][(size_t)(sq - 1) * RC + c]; p1 = a.in[I_SSH][(size_t)(sq - 1) * RC + c + 1]; }
            z0 = z0 + (p0 - z0) * a.in[I_MU][c]; z1 = z1 + (p1 - z1) * a.in[I_MU][c + 1];
            if (c2 < 64) { z0 = 1.f - 2.f / (__expf(2.f * z0) + 1.f); z1 = 1.f - 2.f / (__expf(2.f * z1) + 1.f); }
            else if (c2 >= 128) { z0 = sigm(z0); z1 = sigm(z1); }
            *(unsigned*)(LIN + (size_t)m * 256 + c2) = pk2(z0, z1);
        }
        for (int idx = bid * 512 + tid; idx < NSEQ * RC; idx += G * 512) { const int s = idx / RC, c = idx % RC; const int m = s == 0 ? TP - 1 : TP + 16 * (s - 1) + 15;
            out[(s == 0 ? O_SHP : O_SHS + (size_t)(s - 1) * RC) + c] = bf2f(Z[(size_t)m * RC + c]); }
    }
    SEAM(3);
    if (IN(4)) for (int rep = 0; rep < (DUP_PHASE == 4 ? 2 : 1); ++rep) {
        int k256 = 256; asm volatile("" : "+s"(k256));
        pg8::Gemm g{LIN, LORAT, M, 3072, k256, k256}; pg8::StaticOrder S; S.init(M, 3072, G, bid); EpiBf16P E{LOUT, 3072};
        pg8::gemm_phase<EpiBf16P, pg8::StaticOrder, true, true>((PG8_LAS unsigned char*)lds, g, S, E);
    }
    SEAM(4);
    if (IN(5)) for (int rep = 0; rep < (DUP_PHASE == 5 ? 2 : 1); ++rep) {
        float* prm = (float*)lds;
        __syncthreads();
        for (int idx = tid; idx < RW; idx += 512) { prm[idx] = a.in[I_MU][idx]; prm[RW + idx] = a.in[I_MU][RW + idx]; prm[2 * RW + idx] = a.in[I_MU][2 * RW + idx]; prm[3 * RW + idx] = a.in[I_W0][idx];
            prm[4 * RW + idx] = a.in[I_A0][idx]; prm[5 * RW + idx] = a.in[I_KK][idx]; prm[6 * RW + idx] = a.in[I_KA][idx]; prm[7 * RW + idx] = a.in[I_RK][idx]; }
        __syncthreads();
        for (int m = gw; m < M; m += NGW) {
            const int tp = tpos_of(m), sq = seq_of(m);
#pragma unroll 1
            for (int hp = 0; hp < 2; ++hp) {
                const int hd = hp * 8 + (lane >> 3), c0 = hd * 64 + (lane & 7) * 8;
                const bf16* zr = Z + (size_t)m * RC + c0; const bf16* lr = LOUT + (size_t)m * 3072 + c0; const float* sh0 = a.in[I_SSH] + (size_t)(sq > 0 ? sq - 1 : 0) * RC + c0;
                float zs[3][8];
#pragma unroll
                for (int q = 0; q < 3; ++q) {
                    const u32x4 ca = *(const u32x4*)(zr + q * RW); float pv[8];
                    if (tp > 0) { const u32x4 pa2 = *(const u32x4*)(zr - RC + q * RW);
#pragma unroll
                        for (int e = 0; e < 4; ++e) { pv[2 * e] = bf2f(pa2[e] & 0xffffu); pv[2 * e + 1] = bf2f(pa2[e] >> 16); } }
                    else if (sq > 0) { const f32x4 f0 = *(const f32x4*)(sh0 + q * RW), f1 = *(const f32x4*)(sh0 + q * RW + 4);
                        pv[0] = f0.x; pv[1] = f0.y; pv[2] = f0.z; pv[3] = f0.w; pv[4] = f1.x; pv[5] = f1.y; pv[6] = f1.z; pv[7] = f1.w; }
                    else {
#pragma unroll
                        for (int e = 0; e < 8; ++e) pv[e] = 0.f; }
                    const float* mu = prm + q * RW + c0;
#pragma unroll
                    for (int e = 0; e < 4; ++e) { const float z0 = bf2f(ca[e] & 0xffffu), z1 = bf2f(ca[e] >> 16);
                        zs[q][2 * e] = z0 + (pv[2 * e] - z0) * mu[2 * e]; zs[q][2 * e + 1] = z1 + (pv[2 * e + 1] - z1) * mu[2 * e + 1]; }
                }
                const u32x4 wa = *(const u32x4*)(lr), aa = *(const u32x4*)(lr + RW), ga = *(const u32x4*)(lr + 2 * RW);
                float wv[8], av[8], kkv[8], k2[8]; float s1 = 0.f, s2 = 0.f;
#pragma unroll
                for (int e = 0; e < 8; ++e) {
                    const float lwv = bf2f((e & 1) ? (wa[e >> 1] >> 16) : (wa[e >> 1] & 0xffffu)), lav = bf2f((e & 1) ? (aa[e >> 1] >> 16) : (aa[e >> 1] & 0xffffu));
                    wv[e] = __expf(-0.6065306597126334f * sigm(prm[3 * RW + c0 + e] + lwv));
                    av[e] = sigm(prm[4 * RW + c0 + e] + lav);
                    kkv[e] = zs[1][e] * prm[5 * RW + c0 + e]; s1 += kkv[e] * kkv[e];
                    k2[e] = zs[1][e] * (1.f + (av[e] - 1.f) * prm[6 * RW + c0 + e]); s2 += zs[0][e] * k2[e] * prm[7 * RW + c0 + e];
                }
                s1 += DPPF(0.f, s1, 0xB1, 0xF); s1 += DPPF(0.f, s1, 0x4E, 0xF); s1 += DPPF(0.f, s1, 0x141, 0xF);
                s2 += DPPF(0.f, s2, 0xB1, 0xF); s2 += DPPF(0.f, s2, 0x4E, 0xF); s2 += DPPF(0.f, s2, 0x141, 0xF);
                const float inrm = 1.f / fmaxf(sqrtf(s1), 1e-12f);
                const size_t o = (size_t)m * RW + c0;
#pragma unroll
                for (int e = 0; e < 2; ++e) {
                    const float k0 = kkv[4 * e] * inrm, k1 = kkv[4 * e + 1] * inrm, k2_ = kkv[4 * e + 2] * inrm, k3 = kkv[4 * e + 3] * inrm;
                    *(f32x4*)(PW + o + 4 * e) = (f32x4){wv[4 * e], wv[4 * e + 1], wv[4 * e + 2], wv[4 * e + 3]};
                    *(f32x4*)(PNKK + o + 4 * e) = (f32x4){-k0, -k1, -k2_, -k3};
                    *(f32x4*)(PB + o + 4 * e) = (f32x4){k0 * av[4 * e], k1 * av[4 * e + 1], k2_ * av[4 * e + 2], k3 * av[4 * e + 3]};
                    *(f32x4*)(PK + o + 4 * e) = (f32x4){k2[4 * e], k2[4 * e + 1], k2[4 * e + 2], k2[4 * e + 3]};
                    *(f32x4*)(PR + o + 4 * e) = (f32x4){zs[0][4 * e], zs[0][4 * e + 1], zs[0][4 * e + 2], zs[0][4 * e + 3]};
                }
                { u32x4 va;
#pragma unroll
                  for (int e = 0; e < 4; ++e) va[e] = pk2(zs[2][2 * e], zs[2][2 * e + 1]);
                  *(u32x4*)(PV + o) = va; *(u32x4*)(PG + o) = ga; }
                if ((lane & 7) == 0) BON[m * 16 + hd] = s2;
            }
        }
    }
    SEAM(5);
    if (IN(6)) for (int rep = 0; rep < (DUP_PHASE == 6 ? 2 : 1); ++rep) {
        MID(4);
        {
            float* wl = (float*)lds + wave * RL<0>::BUF;
            for (int task = gw; task < RH * NCH * 2; task += NGW) {
                const int part = task & 1, pair = task >> 1, h = pair / NCH, c = pair % NCH; const size_t o = (size_t)(c * LCH) * RW + h * 64;
                f32x2 S[32];
                if (part) {
#pragma unroll
                    for (int j = 0; j < 32; ++j) { S[j].x = (2 * j == lane) ? 1.f : 0.f; S[j].y = (2 * j + 1 == lane) ? 1.f : 0.f; }
                    rwkv_lds<1>(S, PW + o, PNKK + o, PB + o, PK + o, PR + o, PV + o, LCH, lane, nullptr, nullptr, nullptr, 0.f, 0.f, wl);
                } else {
#pragma unroll
                    for (int j = 0; j < 32; ++j) S[j] = (f32x2){0.f, 0.f};
                    rwkv_lds<0>(S, PW + o, PNKK + o, PB + o, PK + o, PR + o, PV + o, LCH, lane, nullptr, nullptr, nullptr, 0.f, 0.f, wl);
                }
                float* dst = PU + ((size_t)pair * 2 + (part ? 0 : 1)) * 4096 + lane * 64;
#pragma unroll
                for (int j = 0; j < 16; ++j) *(f32x4*)(dst + 4 * j) = (f32x4){S[2 * j].x, S[2 * j].y, S[2 * j + 1].x, S[2 * j + 1].y};
            }
        }
        __syncthreads();
        MID(5);
        bf16* kT = (bf16*)lds;
        bf16* vT = (bf16*)lds + 256 * 72;
        const int fr = lane & 15, fq = lane >> 4;
        for (int it = bid; it < EH * NRB * 2; it += G) {
            const int half = it & 1, blk = (it >> 1) % NRB, h = (it >> 1) / NRB; const float l2g = ret_l2g(h); const int m0 = blk * RBLK;
            f32x4 acc[2][8];
#pragma unroll
            for (int x = 0; x < 2; ++x)
#pragma unroll
                for (int y = 0; y < 8; ++y) acc[x][y] = (f32x4){0.f, 0.f, 0.f, 0.f};
            for (int ts = 0; ts < 4; ++ts) {
                __syncthreads();
#pragma unroll
                for (int i = 0; i < 4; ++i) { const int t = lane, dp = wave + 8 * i; const u32x4 raw = *(const u32x4*)(QKVG + (size_t)(m0 + ts * 64 + t) * EC + 1024 + h * 256 + dp * 8);
                    const float dec = exp2f(l2g * (float)(255 - (ts * 64 + t)));
#pragma unroll
                    for (int e = 0; e < 4; ++e) { const unsigned w = raw[e]; kT[(dp * 8 + 2 * e) * 72 + t] = (bf16)f2bf(bf2f(w & 0xffffu) * dec); kT[(dp * 8 + 2 * e + 1) * 72 + t] = (bf16)f2bf(bf2f(w >> 16) * dec); } }
#pragma unroll
                for (int i = 0; i < 2; ++i) { const int t = lane, ep = wave + 8 * i; const u32x4 raw = *(const u32x4*)(QKVG + (size_t)(m0 + ts * 64 + t) * EC + 2048 + h * 256 + half * 128 + ep * 8);
#pragma unroll
                    for (int e = 0; e < 4; ++e) { const unsigned w = raw[e]; vT[(ep * 8 + 2 * e) * 72 + t] = (bf16)(w & 0xffffu); vT[(ep * 8 + 2 * e + 1) * 72 + t] = (bf16)(w >> 16); } }
                __syncthreads();
#pragma unroll
                for (int kk = 0; kk < 2; ++kk) { bf16x8 af[2];
#pragma unroll
                    for (int x = 0; x < 2; ++x) af[x] = *(const bf16x8*)(kT + (32 * wave + 16 * x + fr) * 72 + kk * 32 + fq * 8);
#pragma unroll
                    for (int y = 0; y < 8; ++y) { const bf16x8 bfm = *(const bf16x8*)(vT + (16 * y + fr) * 72 + kk * 32 + fq * 8);
#pragma unroll
                        for (int x = 0; x < 2; ++x) acc[x][y] = __builtin_amdgcn_mfma_f32_16x16x32_bf16(af[x], bfm, acc[x][y], 0, 0, 0); } }
            }
            bf16* dst = KVB + ((size_t)(h * NRB + blk) * 256) * 256;
#pragma unroll
            for (int x = 0; x < 2; ++x)
#pragma unroll
                for (int y = 0; y < 8; ++y) { u32x2 w; w.x = pk2(acc[x][y][0], acc[x][y][1]); w.y = pk2(acc[x][y][2], acc[x][y][3]);
                    *(u32x2*)(dst + (size_t)(half * 128 + 16 * y + fr) * 256 + 32 * wave + 16 * x + fq * 4) = w; }
        }
    }
    if (IN(6)) MID(6);
    SEAM(6);
    if (IN(7)) for (int rep = 0; rep < (DUP_PHASE == 7 ? 2 : 1); ++rep) {
        const int nB = RH * 4;
        if (bid < nB || G <= nB) {
            float* Sb = (float*)lds;
            const int fr = lane & 15, fq = lane >> 4;
            for (int it = bid; it < nB; it += G) {
                const int h = it >> 2, g4 = it & 3; float* pu = PU + (size_t)(h * NCH) * 2 * 4096;
                __syncthreads();
                for (int idx = tid; idx < 16 * 65; idx += 512) Sb[idx] = 0.f;
                __syncthreads();
                if (wave < 4) {
                    float pa[16], pb[16]; f32x4 ua, ub;
#define PB_LOAD(dst, du, c) do { const float* pp = pu + (size_t)(c) * 2 * 4096; _Pragma("unroll") for (int kk = 0; kk < 16; ++kk) dst[kk] = pp[(4 * kk + fq) * 64 + 16 * wave + fr]; \
                        _Pragma("unroll") for (int jj = 0; jj < 4; ++jj) du[jj] = pp[4096 + (16 * g4 + 4 * fq + jj) * 64 + 16 * wave + fr]; } while (0)
                    PB_LOAD(pa, ua, 0); PB_LOAD(pb, ub, 1);
                    for (int c = 0; c < NCH; ++c) {
                        const float* Sc = Sb + (c & 1) * (16 * 65); float* Sn = Sb + ((c + 1) & 1) * (16 * 65);
                        f32x4 acc = ua, ac1 = {0.f, 0.f, 0.f, 0.f}, ac2 = ac1, ac3 = ac1;
#pragma unroll
                        for (int kk = 0; kk < 16; kk += 4) { acc = __builtin_amdgcn_mfma_f32_16x16x4f32(Sc[fr * 65 + 4 * kk + fq], pa[kk], acc, 0, 0, 0);
                            ac1 = __builtin_amdgcn_mfma_f32_16x16x4f32(Sc[fr * 65 + 4 * (kk + 1) + fq], pa[kk + 1], ac1, 0, 0, 0);
                            ac2 = __builtin_amdgcn_mfma_f32_16x16x4f32(Sc[fr * 65 + 4 * (kk + 2) + fq], pa[kk + 2], ac2, 0, 0, 0);
                            ac3 = __builtin_amdgcn_mfma_f32_16x16x4f32(Sc[fr * 65 + 4 * (kk + 3) + fq], pa[kk + 3], ac3, 0, 0, 0); }
                        acc = (acc + ac1) + (ac2 + ac3);
#pragma unroll
                        for (int jj = 0; jj < 4; ++jj) { Sn[(4 * fq + jj) * 65 + 16 * wave + fr] = acc[jj]; pu[(size_t)c * 2 * 4096 + 4096 + (16 * g4 + 4 * fq + jj) * 64 + 16 * wave + fr] = acc[jj]; }
                        if (c + 1 == NCH) {
#pragma unroll
                            for (int jj = 0; jj < 4; ++jj) out[O_WKP + (size_t)h * 4096 + (16 * g4 + 4 * fq + jj) * 64 + 16 * wave + fr] = acc[jj]; }
#pragma unroll
                        for (int kk = 0; kk < 16; ++kk) pa[kk] = pb[kk];
                        ua = ub;
                        if (c + 2 < NCH) PB_LOAD(pb, ub, c + 2);
                        asm volatile("s_waitcnt lgkmcnt(0)" ::: "memory");
                        __builtin_amdgcn_s_barrier();
                    }
#undef PB_LOAD
                } else {
                    for (int c = 0; c < NCH; ++c) __builtin_amdgcn_s_barrier();
                }
            }
        }
        if (bid >= nB || G <= nB) {
            const int nb2 = G <= nB ? G : G - nB, b2 = G <= nB ? bid : bid - nB;
            for (int it = b2 * 512 + tid; it < EH * 256 * 32; it += nb2 * 512) {
                const int h = it >> 13, e = (it >> 5) & 255, d0 = (it & 31) * 8; const float g256 = exp2f(256.f * ret_l2g(h));
                float acc[8];
#pragma unroll
                for (int q = 0; q < 8; ++q) acc[q] = 0.f;
                u32x4 kvr[NRB];
#pragma unroll
                for (int blk = 0; blk < NRB; ++blk) kvr[blk] = *(const u32x4*)(KVB + ((size_t)(h * NRB + blk) * 256 + e) * 256 + d0);
#pragma unroll
                for (int blk = 0; blk < NRB; ++blk) {
                    const size_t o = ((size_t)(h * NRB + blk) * 256 + e) * 256 + d0;
                    u32x4 w; w.x = pk2(acc[0], acc[1]); w.y = pk2(acc[2], acc[3]); w.z = pk2(acc[4], acc[5]); w.w = pk2(acc[6], acc[7]); *(u32x4*)(SPREV + o) = w;
                    const u32x4 kv = kvr[blk];
#pragma unroll
                    for (int q = 0; q < 4; ++q) { acc[2 * q] = acc[2 * q] * g256 + bf2f(kv[q] & 0xffffu); acc[2 * q + 1] = acc[2 * q + 1] * g256 + bf2f(kv[q] >> 16); }
                }
#pragma unroll
                for (int q = 0; q < 8; ++q) out[O_RTP + (size_t)h * 65536 + (size_t)(d0 + q) * 256 + e] = acc[q];
            }
            asm volatile("s_waitcnt vmcnt(0)" ::: "memory");
            __syncthreads();
            if (tid == 0) {
                unsigned* cw = (unsigned*)(a.ws + 65536) + XCD_BAR_WORDS + 64;
                __builtin_amdgcn_fence(__ATOMIC_RELEASE, "agent");
                asm volatile("s_waitcnt vmcnt(0)" ::: "memory");
                (void)xb_add(cw, 1u);
            }
        }
        {
            const int nscan = G <= nB ? G : G - nB;
            unsigned* cw = (unsigned*)(a.ws + 65536) + XCD_BAR_WORDS + 64; unsigned* cq = cw + 32;
            if (tid == 0) {
                unsigned sp = 0u; while (xb_ld(cw) < (unsigned)nscan) { __builtin_amdgcn_s_sleep(1); if (++sp > (1u << 22)) break; }
                __builtin_amdgcn_fence(__ATOMIC_ACQUIRE, "agent");
                asm volatile("s_waitcnt vmcnt(0)" ::: "memory");
            }
            __syncthreads();
            {
                const int fr = lane & 15, fq = lane >> 4;
                for (;;) {
                    __syncthreads();
                    if (tid == 0) xst[2] = xb_add(cq, 1u);
                    __syncthreads();
                    const int qi = (int)xst[2];
                    if (qi >= EH * (TP / 64)) break;
                    const int it = ((qi & 127) >> 5) * (TP / 64) + (qi & 31) * 4 + (3 - (qi >> 7));
                    {
                    const int h = it / (TP / 64), n = it % (TP / 64), blk = n >> 2, i = n & 3, m0 = n * 64; const float l2g = ret_l2g(h);
                    bf16* qL = (bf16*)lds; bf16* kL = qL + 64 * 264; bf16* vT = kL + 64 * 264; bf16* pL = vT + 256 * 72; float* red = (float*)(pL + 64 * 72);
#pragma unroll
                    for (int x = 0; x < 4; ++x) { const int p = tid + 512 * x, t = p >> 5, dp = p & 31; *(u32x4*)(qL + t * 264 + dp * 8) = *(const u32x4*)(QKVG + (size_t)(m0 + t) * EC + h * 256 + dp * 8); }
                    __syncthreads();
                    f32x4 acc[4][2];
#pragma unroll
                    for (int x = 0; x < 4; ++x)
#pragma unroll
                        for (int y = 0; y < 2; ++y) acc[x][y] = (f32x4){0.f, 0.f, 0.f, 0.f};
                    if (blk > 0) {
                        const bf16* sp = SPREV + ((size_t)(h * NRB + blk) * 256) * 256;
#pragma unroll 2
                        for (int kk = 0; kk < 8; ++kk) { bf16x8 bfm[2];
#pragma unroll
                            for (int y = 0; y < 2; ++y) bfm[y] = *(const bf16x8*)(sp + (size_t)(32 * wave + 16 * y + fr) * 256 + kk * 32 + fq * 8);
#pragma unroll
                            for (int x = 0; x < 4; ++x) { const bf16x8 af = *(const bf16x8*)(qL + (16 * x + fr) * 264 + kk * 32 + fq * 8);
#pragma unroll
                                for (int y = 0; y < 2; ++y) acc[x][y] = __builtin_amdgcn_mfma_f32_16x16x32_bf16(af, bfm[y], acc[x][y], 0, 0, 0); } }
#pragma unroll
                        for (int x = 0; x < 4; ++x)
#pragma unroll
                            for (int jj = 0; jj < 4; ++jj) { const float qd = exp2f(l2g * (float)(64 * i + 16 * x + fq * 4 + jj + 1)); acc[x][0][jj] *= qd; acc[x][1][jj] *= qd; }
                    }
                    for (int j = 0; j <= i; ++j) {
                        __syncthreads();
                        const int ms = (blk * 4 + j) * 64;
#pragma unroll
                        for (int x = 0; x < 4; ++x) { const int p = tid + 512 * x, t = p >> 5, dp = p & 31;
                            *(u32x4*)(kL + t * 264 + dp * 8) = *(const u32x4*)(QKVG + (size_t)(ms + t) * EC + 1024 + h * 256 + dp * 8); }
#pragma unroll
                        for (int x = 0; x < 4; ++x) { const int t = lane, dp = wave + 8 * x;
                            const u32x4 raw = *(const u32x4*)(QKVG + (size_t)(ms + t) * EC + 2048 + h * 256 + dp * 8);
#pragma unroll
                            for (int e = 0; e < 4; ++e) { const unsigned w = raw[e]; vT[(dp * 8 + 2 * e) * 72 + t] = (bf16)(w & 0xffffu); vT[(dp * 8 + 2 * e + 1) * 72 + t] = (bf16)(w >> 16); } }
                        __syncthreads();
                        { const int tr = wave >> 1, tc0 = (wave & 1) * 2; f32x4 sa[2] = {(f32x4){0.f, 0.f, 0.f, 0.f}, (f32x4){0.f, 0.f, 0.f, 0.f}};
#pragma unroll
                            for (int kk = 0; kk < 8; ++kk) { const bf16x8 af = *(const bf16x8*)(qL + (16 * tr + fr) * 264 + kk * 32 + fq * 8);
#pragma unroll
                                for (int y = 0; y < 2; ++y) { const bf16x8 bfm = *(const bf16x8*)(kL + (16 * (tc0 + y) + fr) * 264 + kk * 32 + fq * 8); sa[y] = __builtin_amdgcn_mfma_f32_16x16x32_bf16(af, bfm, sa[y], 0, 0, 0); } }
#pragma unroll
                            for (int y = 0; y < 2; ++y)
#pragma unroll
                                for (int jj = 0; jj < 4; ++jj) { const int t = 16 * tr + fq * 4 + jj, s = 16 * (tc0 + y) + fr; const int dist = (j < i) ? 64 * (i - j) + t - s : (t > s ? t - s : s - t);
                                    pL[t * 72 + s] = (bf16)f2bf(sa[y][jj] * exp2f(l2g * (float)dist)); } }
                        __syncthreads();
#pragma unroll
                        for (int kk = 0; kk < 2; ++kk) { bf16x8 bfm[2];
#pragma unroll
                            for (int y = 0; y < 2; ++y) bfm[y] = *(const bf16x8*)(vT + (32 * wave + 16 * y + fr) * 72 + kk * 32 + fq * 8);
#pragma unroll
                            for (int x = 0; x < 4; ++x) { const bf16x8 af = *(const bf16x8*)(pL + (16 * x + fr) * 72 + kk * 32 + fq * 8);
#pragma unroll
                                for (int y = 0; y < 2; ++y) acc[x][y] = __builtin_amdgcn_mfma_f32_16x16x32_bf16(af, bfm[y], acc[x][y], 0, 0, 0); } }
                    }
#pragma unroll
                    for (int x = 0; x < 4; ++x)
#pragma unroll
                        for (int jj = 0; jj < 4; ++jj) { float s1 = acc[x][0][jj] + acc[x][1][jj], s2 = acc[x][0][jj] * acc[x][0][jj] + acc[x][1][jj] * acc[x][1][jj];
#pragma unroll
                            for (int o = 1; o < 16; o <<= 1) { s1 += __shfl_xor(s1, o); s2 += __shfl_xor(s2, o); }
                            if (fr == 0) { const int t = 16 * x + fq * 4 + jj; red[(t * 8 + wave) * 2] = s1; red[(t * 8 + wave) * 2 + 1] = s2; } }
                    __syncthreads();
                    float lw[2], lb[2];
#pragma unroll
                    for (int y = 0; y < 2; ++y) { lw[y] = a.in[I_ELW][h * 256 + 32 * wave + 16 * y + fr]; lb[y] = a.in[I_ELB][h * 256 + 32 * wave + 16 * y + fr]; }
#pragma unroll
                    for (int x = 0; x < 4; ++x)
#pragma unroll
                        for (int jj = 0; jj < 4; ++jj) { const int t = 16 * x + fq * 4 + jj; float s1 = 0.f, s2 = 0.f;
#pragma unroll
                            for (int w8 = 0; w8 < 8; ++w8) { s1 += red[(t * 8 + w8) * 2]; s2 += red[(t * 8 + w8) * 2 + 1]; }
                            const float mean = s1 * (1.f / 256.f), var = s2 * (1.f / 256.f) - mean * mean, rstd = rsqrtf(var + 1e-5f);
#pragma unroll
                            for (int y = 0; y < 2; ++y) { const int e = 32 * wave + 16 * y + fr; const float gt = bf2f(QKVG[(size_t)(m0 + t) * EC + 3072 + h * 256 + e]);
                                const float val = ((acc[x][y][jj] - mean) * rstd * lw[y] + lb[y]) * gt * sigm(gt);
                                MIX[(size_t)(m0 + t) * D + RW + h * 256 + e] = (bf16)f2bf(val); } }

                    }
                }
            }
        }
    }
    if (IN(7)) MID(10);
    SEAM(7);
    if (IN(8)) for (int rep = 0; rep < (DUP_PHASE == 8 ? 2 : 1); ++rep) {
        MID(7);
        if (wave < 5) {
            float* wl = (float*)lds + wave * RL<2>::BUF;
            const int ntask = wave < 4 ? RH * NCH : NB * RH;
            for (int task = wave < 4 ? bid * 4 + wave : bid; task < ntask; task += (wave < 4 ? G * 4 : G)) {
                f32x2 S[32]; int h, m0, nsteps; float* sdst = nullptr;
                if (wave < 4) { h = task / NCH; const int c = task % NCH; m0 = c * LCH; nsteps = LCH;
                    if (c == 0) {
#pragma unroll
                        for (int j = 0; j < 32; ++j) S[j] = (f32x2){0.f, 0.f};
                    } else { const float* src = PU + ((size_t)(h * NCH + c - 1) * 2 + 1) * 4096 + lane * 64;
#pragma unroll
                        for (int j = 0; j < 16; ++j) { const f32x4 q = *(const f32x4*)(src + 4 * j); S[2 * j] = (f32x2){q.x, q.y}; S[2 * j + 1] = (f32x2){q.z, q.w}; } }
                } else { const int b = task / RH; h = task % RH; m0 = TP + 16 * b; nsteps = TS;
                    const float* src = a.in[I_SWKV] + ((size_t)(b * RH + h) * 64 + lane) * 64; sdst = out + O_WKS + ((size_t)(b * RH + h) * 64 + lane) * 64;
#pragma unroll
                    for (int j = 0; j < 16; ++j) { const f32x4 q = *(const f32x4*)(src + 4 * j); S[2 * j] = (f32x2){q.x, q.y}; S[2 * j + 1] = (f32x2){q.z, q.w}; } }
                const size_t o = (size_t)m0 * RW + h * 64;
                rwkv_lds<2>(S, PW + o, PNKK + o, PB + o, PK + o, PR + o, PV + o, nsteps, lane, PG + o, BON + (size_t)m0 * 16 + h, MIX + (size_t)m0 * D + h * 64,
                            a.in[I_RLW][h * 64 + lane], a.in[I_RLB][h * 64 + lane], wl);
                if (sdst) {
#pragma unroll
                    for (int j = 0; j < 16; ++j) *(f32x4*)(sdst + 4 * j) = (f32x4){S[2 * j].x, S[2 * j].y, S[2 * j + 1].x, S[2 * j + 1].y}; }
            }
        }
        MID(8);
        {
            const int nb2 = G, b2 = bid;
            const int fr = lane & 15, fq = lane >> 4;
            for (int it0 = b2; it0 < NB * EH * 4; it0 += nb2) {
                const int it = EH * (TP / 64) + it0;
                __syncthreads();
#ifndef NO_RS
                {
                    const int r = it - EH * (TP / 64), tq = r & 3, b = (r >> 2) / EH, h = (r >> 2) % EH, m0 = TP + 16 * b; const float l2g = ret_l2g(h);
                    float* qf = (float*)lds; float* kf = qf + 4 * 260; float* vf = kf + 16 * 257; float* pf = vf + 16 * 257; float* red = pf + 64;
                    for (int idx = tid; idx < 16 * 256; idx += 512) { const int t = idx >> 8, dd = idx & 255; const bf16* src = QKVG + (size_t)(m0 + t) * EC + h * 256 + dd;
                        if ((t >> 2) == tq) qf[(t & 3) * 260 + dd] = bf2f(src[0]);
                        kf[t * 257 + dd] = bf2f(src[1024]); vf[t * 257 + dd] = bf2f(src[2048]); }
                    __syncthreads();
                    if (tid < 64) { const int tl = tid >> 4, s = tid & 15, t = 4 * tq + tl; float sc = 0.f;
#pragma unroll 4
                        for (int dd = 0; dd < 256; ++dd) sc += qf[tl * 260 + dd] * kf[s * 257 + dd];
                        pf[tl * 16 + s] = sc * exp2f(l2g * (float)(t > s ? t - s : s - t)); }
                    __syncthreads();
                    const int e = tid & 255, th = tid >> 8; const float* S0 = a.in[I_SRET] + (size_t)(b * EH + h) * 65536;
                    float oc[2] = {0.f, 0.f};
#pragma unroll 4
                    for (int dd = 0; dd < 256; dd += 4) { const f32x4 qa = *(const f32x4*)(qf + (2 * th) * 260 + dd), qb = *(const f32x4*)(qf + (2 * th + 1) * 260 + dd);
                        const float s0 = S0[(size_t)dd * 256 + e], s1 = S0[(size_t)(dd + 1) * 256 + e], s2 = S0[(size_t)(dd + 2) * 256 + e], s3 = S0[(size_t)(dd + 3) * 256 + e];
                        oc[0] += qa.x * s0 + qa.y * s1 + qa.z * s2 + qa.w * s3; oc[1] += qb.x * s0 + qb.y * s1 + qb.z * s2 + qb.w * s3; }
#pragma unroll
                    for (int tt = 0; tt < 2; ++tt) { const int tl = 2 * th + tt, t = 4 * tq + tl; float v = oc[tt] * exp2f(l2g * (float)(t + 1));
#pragma unroll 4
                        for (int s = 0; s < 16; ++s) v += pf[tl * 16 + s] * vf[s * 257 + e];
                        oc[tt] = v; }
                    { const float g16 = exp2f(16.f * l2g); float* dst = out + O_RTS + (size_t)(b * EH + h) * 65536; float vd[16];
#pragma unroll
                        for (int t = 0; t < 16; ++t) vd[t] = vf[t * 257 + e] * exp2f(l2g * (float)(15 - t));
#pragma unroll 4
                        for (int dd = 64 * tq + 32 * th; dd < 64 * tq + 32 * th + 32; ++dd) { float v = g16 * S0[(size_t)dd * 256 + e];
#pragma unroll
                            for (int t = 0; t < 16; ++t) v += kf[t * 257 + dd] * vd[t];
                            dst[(size_t)dd * 256 + e] = v; } }
#pragma unroll
                    for (int tt = 0; tt < 2; ++tt) { const float s1 = wave_sum(oc[tt]), s2 = wave_sum(oc[tt] * oc[tt]); if (lane == 0) { const int tl = 2 * th + tt; red[(tl * 4 + (wave & 3)) * 2] = s1; red[(tl * 4 + (wave & 3)) * 2 + 1] = s2; } }
                    __syncthreads();
                    const float lw = a.in[I_ELW][h * 256 + e], lb = a.in[I_ELB][h * 256 + e];
#pragma unroll
                    for (int tt = 0; tt < 2; ++tt) { const int tl = 2 * th + tt, t = 4 * tq + tl; float s1 = 0.f, s2 = 0.f;
#pragma unroll
                        for (int w4 = 0; w4 < 4; ++w4) { s1 += red[(tl * 4 + w4) * 2]; s2 += red[(tl * 4 + w4) * 2 + 1]; }
                        const float mean = s1 * (1.f / 256.f), var = s2 * (1.f / 256.f) - mean * mean, rstd = rsqrtf(var + 1e-5f);
                        const float gt = bf2f(QKVG[(size_t)(m0 + t) * EC + 3072 + h * 256 + e]);
                        MIX[(size_t)(m0 + t) * D + RW + h * 256 + e] = (bf16)f2bf(((oc[tt] - mean) * rstd * lw + lb) * gt * sigm(gt)); }
                }
#else
                {}
#endif
            }
        }
    }
    if (IN(8)) MID(9);
    SEAM(8);
    if (IN(9)) for (int rep = 0; rep < (DUP_PHASE == 9 ? 2 : 1); ++rep) {
        { pg8::Gemm g{MIX, WOUTT, TP, D, D, D}; pg8::StaticOrder S; S.init(TP, D, G, bid); EpiF32 E{MIXOUT, D};
          pg8::gemm_phase<EpiF32, pg8::StaticOrder, true, true>((PG8_LAS unsigned char*)lds, g, S, E); }
        { const int sl = bid >> 3; pg8::Gemm g{MIX + (size_t)TP * D + sl * 512, WOUTT + sl * 512, MS, D, 512, D}; pg8::OneUnit S{0, bid & 7, bid < 8 * KS9}; EpiF32 E{(float*)(ws + WS_PART9) + (size_t)sl * MS * D, D};
          pg8::gemm_phase<EpiF32, pg8::OneUnit, false, true>((PG8_LAS unsigned char*)lds, g, S, E); }
    }
    SEAM(9);
    if (IN(10)) for (int rep = 0; rep < (DUP_PHASE == 10 ? 2 : 1); ++rep) {
        for (int m = gw; m < M; m += NGW) {
            const float* xr = m < TP ? a.in[I_XP] + (size_t)m * D : a.in[I_XS] + (size_t)(m - TP) * D; const float* mod = MOD + seq_of(m) * MODW; const float* mr = MIXOUT + (size_t)m * D;
            f32x4 v[8]; float ss = 0.f;
#pragma unroll
            for (int j = 0; j < 8; ++j) {
                if (m < TP) v[j] = *(const f32x4*)(mr + 4 * lane + 256 * j);
                else { const float* pr = (const float*)(ws + WS_PART9) + (size_t)(m - TP) * D + 4 * lane + 256 * j; v[j] = *(const f32x4*)pr;
#pragma unroll
                    for (int q = 1; q < KS9; ++q) v[j] += *(const f32x4*)(pr + (size_t)q * MS * D); }
                ss += (v[j].x * v[j].x + v[j].y * v[j].y) + (v[j].z * v[j].z + v[j].w * v[j].w); }
            const float rs = rsqrtf(wave_sum(ss) * (1.f / D) + 1e-6f); float s2 = 0.f;
#pragma unroll
            for (int j = 0; j < 8; ++j) { const int c = 4 * lane + 256 * j; const f32x4 g = *(const f32x4*)(a.in[I_GPOM] + c), gt = *(const f32x4*)(mod + 2 * D + c), x = *(const f32x4*)(xr + c);
                v[j] = x + gt * (v[j] * rs * g); *(f32x4*)(out + (size_t)m * D + c) = v[j]; s2 += (v[j].x * v[j].x + v[j].y * v[j].y) + (v[j].z * v[j].z + v[j].w * v[j].w); }
            const float rs2 = rsqrtf(wave_sum(s2) * (1.f / D) + 1e-6f);
#pragma unroll
            for (int j = 0; j < 8; ++j) { const int c = 4 * lane + 256 * j; const f32x4 g = *(const f32x4*)(a.in[I_GPF] + c), s1 = *(const f32x4*)(mod + 4 * D + c), h1 = *(const f32x4*)(mod + 3 * D + c);
                const f32x4 h = v[j] * rs2 * g * (s1 + 1.f) + h1; u32x2 w; w.x = pk2(h.x, h.y); w.y = pk2(h.z, h.w); *(u32x2*)(H + (size_t)m * D + c) = w; }
        }
        float* scr = (float*)lds + wave * (64 * 33 + 16);
        constexpr int IT_UP = (D / 64) * (2 * FF / 32), IT_DN = (FF / 64) * (D / 32);
        for (int it = gw; it < IT_UP + IT_DN; it += NGW) {
            if (it < IT_UP) { const int nb = 2 * FF / 32, kb = it / nb, n0 = 32 * (it % nb); const int nn = n0 < FF ? n0 : n0 - FF; const int dr = 256 * (nn >> 7) + (n0 < FF ? 0 : 128) + (nn & 127);
                transpose_item(a.in[I_WUP], D, 2 * FF, WUPT, 64 * kb, n0, dr, scr, lane); }
            else { const int r = it - IT_UP, nb = D / 32, kb = r / nb, n0 = 32 * (r % nb); transpose_item(a.in[I_WDN], FF, D, WDNT, 64 * kb, n0, n0, scr, lane); }
        }
    }
    SEAM(10);
    if (IN(11)) for (int rep = 0; rep < (DUP_PHASE == 11 ? 2 : 1); ++rep) {
        pg8::Gemm g{H, WUPT, M, 2 * FF, D, D}; pg8::StaticOrder S; S.init(M, 2 * FF, G, bid); EpiSwiglu E{ACT};
        pg8::gemm_phase<EpiSwiglu, pg8::StaticOrder, true, true>((PG8_LAS unsigned char*)lds, g, S, E);
    }
    SEAM(11);
    if (IN(12)) for (int rep = 0; rep < (DUP_PHASE == 12 ? 2 : 1); ++rep) {
        { pg8::Gemm g{ACT, WDNT, TP, D, FF, FF}; pg8::StaticOrder S; S.init(TP, D, G, bid); EpiF32 E{MIXOUT, D};
          pg8::gemm_phase<EpiF32, pg8::StaticOrder, true, true>((PG8_LAS unsigned char*)lds, g, S, E); }
        { const int sl = bid >> 3; pg8::Gemm g{ACT + (size_t)TP * FF + sl * 512, WDNT + sl * 512, MS, D, 512, FF}; pg8::OneUnit S{0, bid & 7, bid < 8 * KS12}; EpiF32 E{(float*)(ws + WS_PART12) + (size_t)sl * MS * D, D};
          pg8::gemm_phase<EpiF32, pg8::OneUnit, false, true>((PG8_LAS unsigned char*)lds, g, S, E); }
    }
    SEAM(12);
    if (IN(13)) for (int rep = 0; rep < (DUP_PHASE == 13 ? 2 : 1); ++rep) {
        for (int m = gw; m < M; m += NGW) {
            const float* mod = MOD + seq_of(m) * MODW; const float* fr_ = MIXOUT + (size_t)m * D;
            f32x4 v[8]; float ss = 0.f;
#pragma unroll
            for (int j = 0; j < 8; ++j) {
                if (m < TP) v[j] = *(const f32x4*)(fr_ + 4 * lane + 256 * j);
                else { const float* pr = (const float*)(ws + WS_PART12) + (size_t)(m - TP) * D + 4 * lane + 256 * j; v[j] = *(const f32x4*)pr;
#pragma unroll
                    for (int q = 1; q < KS12; ++q) v[j] += *(const f32x4*)(pr + (size_t)q * MS * D); }
                ss += (v[j].x * v[j].x + v[j].y * v[j].y) + (v[j].z * v[j].z + v[j].w * v[j].w); }
            const float rs = rsqrtf(wave_sum(ss) * (1.f / D) + 1e-6f);
#pragma unroll
            for (int j = 0; j < 8; ++j) { const int c = 4 * lane + 256 * j; const f32x4 g = *(const f32x4*)(a.in[I_GPOF] + c), gt = *(const f32x4*)(mod + 5 * D + c), x = *(const f32x4*)(out + (size_t)m * D + c);
                *(f32x4*)(out + (size_t)m * D + c) = x + gt * (v[j] * rs * g); }
        }
    }
    if (TS_PROBE >= 0) {
        xcd_barrier(xb);
        if (bid == 0 && tid == 0) TSW[14] = __builtin_amdgcn_s_memrealtime();
        if (bid == 0) { __syncthreads(); const float us = TS_PROBE >= 100 ? (float)(TSW[32 + TS_PROBE - 100] - TSW[32 + TS_PROBE - 101]) * 0.01f : (float)(TSW[1 + TS_PROBE] - TSW[TS_PROBE]) * 0.01f; const float eps = sqrtf(us * 1e-4f);
            for (int c = tid; c < RC; c += 512) out[O_SHP + c] *= (1.f + eps); }
    }
#undef IN
#undef SEAM
}

extern "C" void kernel_launch(void* const* d_in, const int* in_sizes, int n_in, void* d_out, int out_size, void* d_ws, size_t ws_size, hipStream_t stream) {
    static int grid = 0;
    if (grid == 0) {
        if (n_in != 30 || (size_t)out_size != O_END || ws_size < WS_END) { fprintf(stderr, "kernel_launch: unexpected sizes n_in %d out %d ws %zu\n", n_in, out_size, ws_size); grid = -1; return; }
        int dev = 0, cus = 0, per_cu = 0;
        (void)hipGetDevice(&dev); (void)hipDeviceGetAttribute(&cus, hipDeviceAttributeMultiprocessorCount, dev);
        if (hipFuncSetAttribute((const void*)mk_fwd, hipFuncAttributeMaxDynamicSharedMemorySize, LDS_BYTES) != hipSuccess) { fprintf(stderr, "kernel_launch: hipFuncSetAttribute failed\n"); grid = -1; return; }
        if (hipOccupancyMaxActiveBlocksPerMultiprocessor(&per_cu, (const void*)mk_fwd, 512, LDS_BYTES) != hipSuccess || per_cu < 1) { fprintf(stderr, "kernel_launch: occupancy query says %d\n", per_cu); per_cu = 1; }
        (void)hipGetLastError();
        grid = cus;
        if (grid <= 0) grid = 256;
    }
    if (grid < 0) return;
    (void)hipMemsetAsync((char*)d_ws + 65536, 0, XCD_BAR_WORDS * 4 + 512, stream);
    Args a{};
    for (int i = 0; i < 30; ++i) a.in[i] = (const float*)d_in[i];
    a.out = (float*)d_out; a.ws = (unsigned char*)d_ws;
    a.ph_lo = 0; a.ph_hi = NPHASE;
    void* args[] = {&a};
    hipError_t e = hipLaunchCooperativeKernel((const void*)mk_fwd, dim3(grid), dim3(512), args, LDS_BYTES, stream);
    if (e != hipSuccess) fprintf(stderr, "kernel_launch: cooperative launch failed: %s (grid %d)\n", hipGetErrorString(e), grid);
}
```

```cpp
#include <hip/hip_runtime.h>
#include <hip/hip_cooperative_groups.h>
#include <cstdio>
#include <cstdint>
namespace cg = cooperative_groups;
namespace pg8 {
#define PG8_LAS __attribute__((address_space(3)))
typedef unsigned short bf16_t;
typedef short bf16x8 __attribute__((ext_vector_type(8)));
typedef float f32x4 __attribute__((ext_vector_type(4)));
typedef unsigned u32x4 __attribute__((ext_vector_type(4)));
constexpr int BM = 256, BK = 64, HALF = 128, HTB = HALF * BK * 2  , STAGE_BYTES = 8 * HTB, NXCD = 8, WGM = 8;

__host__ __device__ __forceinline__ int lds_byte(int r, int c) { const int st = (r >> 4) * 2 + (c >> 5), rr = r & 15, cc = c & 31, ob = rr * 64 + cc * 2; return st * 1024 + (ob ^ (((ob >> 9) & 1) << 5)); }
__host__ __device__ __forceinline__ void stage_rc(int b, int& R, int& C) { const int st = b / 1024, sb = b % 1024, swz = sb ^ (((sb >> 9) & 1) << 5); R = (st >> 1) * 16 + swz / 64; C = (st & 1) * 32 + (swz % 64) / 2; }
__host__ __device__ __forceinline__ int perm32(int rho) { const int n = rho >> 4, i = rho & 15; return 8 * (i >> 2) + 4 * n + (i & 3); }

struct Unit { int pm, pn; };
struct Gemm { const bf16_t* A; const bf16_t* Bt; int M, N, K, ld; };

struct OneUnit {
    int pm, pn; bool active;
    __device__ __forceinline__ bool next(int i, Unit& u) const { if (i > 0 || !active) return false; u.pm = pm; u.pn = pn; return true; }
    __device__ __forceinline__ void a_ready(const Unit&) const {}
    __device__ __forceinline__ void done(const Unit&) const {}
};
struct StaticOrder {
    int nM, nN, nwg, G, c;
    __host__ __device__ void init(int M, int N, int G_, int c_) { nM = M / BM; nN = N / BM; nwg = nM * nN; G = G_; c = c_; }
    __host__ __device__ bool next(int i, Unit& u) const {
        const long L = (long)i * G + c; if (L >= nwg) return false;
        int wgid = (int)L; { const int q = nwg / NXCD, r = nwg % NXCD, xcd = wgid % NXCD, off = wgid / NXCD; wgid = (xcd < r ? xcd * (q + 1) : r * (q + 1) + (xcd - r) * q) + off; }
        const int nig = WGM * nN, gid = wgid / nig, fm = gid * WGM, gsz = (nM - fm) < WGM ? (nM - fm) : WGM;
        u.pm = fm + ((wgid % nig) % gsz); u.pn = (wgid % nig) / gsz; return true;
    }
    __device__ __forceinline__ void a_ready(const Unit&) const {}
    __device__ __forceinline__ void done(const Unit&) const {}
};

__device__ __forceinline__ unsigned cvt_pk_bf16(float lo, float hi) { unsigned r; asm volatile("v_cvt_pk_bf16_f32 %0, %1, %2" : "=v"(r) : "v"(lo), "v"(hi)); return r; }
template <class Epi, class Sched, bool ALIGN_EPI = false, bool SP2 = false>
__device__ __forceinline__ void gemm_phase(PG8_LAS unsigned char* lds, const Gemm g, const Sched& S, const Epi& E) {
    const int tid = threadIdx.x, wid = __builtin_amdgcn_readfirstlane(tid >> 6), lane = tid & 63, wr = wid >> 2, wc = wid & 3, fr = lane & 15, fq = lane >> 4;
    const int K = g.K, nt = K / BK;
    unsigned voffA[2], voffB[2];
#pragma unroll
    for (int i = 0; i < 2; ++i) { int R, C; stage_rc(tid * 16 + i * 8192, R, C); const int Rb = Epi::PERM ? ((R & ~31) + perm32(R & 31)) : R;
        voffA[i] = (unsigned)(R * g.ld + C) * 2u; voffB[i] = (unsigned)(Rb * g.ld + C) * 2u; }
    const size_t kstep = (size_t)(BK * 2);
    const size_t hstep = (size_t)HALF * g.ld * 2;
    const size_t tstep = 2 * hstep;
    const unsigned ldsw = (unsigned)wid * 1024u;
    const int aoff = lds_byte(wr * 64 + fr, fq * 8), boff = lds_byte(wc * 32 + fr, fq * 8);
#define PG8_SA(b, h) (((b) * 2 + (h)) * HTB)
#define PG8_SB(b, h) ((4 + (b) * 2 + (h)) * HTB)
#define PG8_STAGE(bufoff, gbase, voff) do { _Pragma("unroll") for (int _i = 0; _i < 2; ++_i) \
        __builtin_amdgcn_global_load_lds((const unsigned*)((const char*)(gbase) + (voff)[_i]), (PG8_LAS unsigned*)(lds + (bufoff) + ldsw + _i * 8192), 16, 0, 0); } while (0)
#define PG8_LDA(dst, b, h) do { _Pragma("unroll") for (int m = 0; m < 4; ++m) _Pragma("unroll") for (int k = 0; k < 2; ++k) dst[m][k] = *(const PG8_LAS bf16x8*)(lds + PG8_SA(b, h) + aoff + m * 2048 + k * 1024); } while (0)
#define PG8_LDB(dst, b, h) do { _Pragma("unroll") for (int n = 0; n < 2; ++n) _Pragma("unroll") for (int k = 0; k < 2; ++k) dst[n][k] = *(const PG8_LAS bf16x8*)(lds + PG8_SB(b, h) + boff + n * 2048 + k * 1024); } while (0)
#define PG8_MMA(ai, bj, At, Bt) do { __builtin_amdgcn_s_setprio(1); _Pragma("unroll") for (int m = 0; m < 4; ++m) _Pragma("unroll") for (int n = 0; n < 2; ++n) _Pragma("unroll") for (int k = 0; k < 2; ++k) \
        acc[ai][bj][m][n] = __builtin_amdgcn_mfma_f32_16x16x32_bf16(Bt[n][k], At[m][k], acc[ai][bj][m][n], 0, 0, 0); __builtin_amdgcn_s_setprio(0); } while (0)
#define PG8_WAIT_V(n) asm volatile("s_waitcnt vmcnt(" #n ")" ::: "memory")
#define PG8_WAIT_L(n) asm volatile("s_waitcnt lgkmcnt(" #n ")" ::: "memory")
#define PG8_BAR __builtin_amdgcn_s_barrier()
#define PG8_SCHED __builtin_amdgcn_sched_barrier(0)
    Unit cur, nxt; int ui = 0;
    if (!S.next(0, cur)) return;
    f32x4 acc[2][2][4][2];
#pragma unroll
    for (int a = 0; a < 2; ++a)
#pragma unroll
        for (int b = 0; b < 2; ++b)
#pragma unroll
            for (int m = 0; m < 4; ++m)
#pragma unroll
                for (int n = 0; n < 2; ++n) acc[a][b][m][n] = (f32x4){0.f, 0.f, 0.f, 0.f};
    bf16x8 At[4][2], B0[2][2], B1[2][2];
    const char* cA = (const char*)g.A + (size_t)cur.pm * tstep; const char* cB = (const char*)g.Bt + (size_t)cur.pn * tstep;
    S.a_ready(cur);
    if constexpr (SP2) {
        PG8_STAGE(PG8_SB(0, 0), cB, voffB); PG8_STAGE(PG8_SB(0, 1), cB + hstep, voffB); PG8_STAGE(PG8_SA(0, 0), cA, voffA); PG8_STAGE(PG8_SA(0, 1), cA + hstep, voffA);
        if (wr == 1) PG8_BAR;
        PG8_WAIT_V(2); PG8_BAR;
        PG8_STAGE(PG8_SB(1, 0), cB + kstep, voffB); PG8_STAGE(PG8_SA(1, 0), cA + kstep, voffA); PG8_STAGE(PG8_SB(1, 1), cB + hstep + kstep, voffB);
        PG8_WAIT_V(6); PG8_BAR;
    } else {
        PG8_STAGE(PG8_SB(0, 0), cB, voffB); PG8_STAGE(PG8_SA(0, 0), cA, voffA); PG8_STAGE(PG8_SB(0, 1), cB + hstep, voffB); PG8_STAGE(PG8_SA(0, 1), cA + hstep, voffA);
        if (wr == 1) PG8_BAR;
        PG8_WAIT_V(4); PG8_BAR;
        PG8_STAGE(PG8_SB(1, 0), cB + kstep, voffB); PG8_STAGE(PG8_SA(1, 0), cA + kstep, voffA); PG8_STAGE(PG8_SB(1, 1), cB + hstep + kstep, voffB);
        PG8_WAIT_V(6); PG8_BAR;
    }
    for (;;) {
        const bool has_next = S.next(ui + 1, nxt);
        const char* nA = has_next ? (const char*)g.A + (size_t)nxt.pm * tstep : cA; const char* nB = has_next ? (const char*)g.Bt + (size_t)nxt.pn * tstep : cB;
        for (int t = 0; t < nt; t += 2) {
            const bool last = (t == nt - 2);
            const char* a1 = cA + (size_t)(t + 1) * kstep;
            const char* a2 = last ? nA : cA + (size_t)(t + 2) * kstep; const char* b2 = last ? nB : cB + (size_t)(t + 2) * kstep;
            const char* a3 = a2 + kstep; const char* b3 = b2 + kstep;
            if (last && has_next) S.a_ready(nxt);
            if constexpr (SP2) {
            PG8_LDB(B0, 0, 0); PG8_LDB(B1, 0, 1); PG8_SCHED; PG8_LDA(At, 0, 0); PG8_STAGE(PG8_SA(1, 1), a1 + hstep, voffA);
            PG8_WAIT_V(8); PG8_WAIT_L(0); PG8_BAR; PG8_MMA(0, 0, At, B0); PG8_MMA(0, 1, At, B1); PG8_BAR; PG8_SCHED;
            PG8_LDA(At, 0, 1); PG8_STAGE(PG8_SB(0, 0), b2, voffB); PG8_STAGE(PG8_SB(0, 1), b2 + hstep, voffB); PG8_STAGE(PG8_SA(0, 0), a2, voffA);
            PG8_WAIT_V(8); PG8_WAIT_L(0); PG8_BAR; PG8_MMA(1, 0, At, B0); PG8_MMA(1, 1, At, B1); PG8_BAR; PG8_SCHED;
            PG8_LDB(B0, 1, 0); PG8_LDB(B1, 1, 1); PG8_SCHED; PG8_LDA(At, 1, 0); PG8_STAGE(PG8_SA(0, 1), a2 + hstep, voffA);
            PG8_WAIT_V(8); PG8_WAIT_L(0); PG8_BAR; PG8_MMA(0, 0, At, B0); PG8_MMA(0, 1, At, B1); PG8_BAR; PG8_SCHED;
            PG8_LDA(At, 1, 1); PG8_STAGE(PG8_SB(1, 0), b3, voffB); PG8_STAGE(PG8_SB(1, 1), b3 + hstep, voffB); PG8_STAGE(PG8_SA(1, 0), a3, voffA);
            PG8_WAIT_V(8); PG8_WAIT_L(0); PG8_BAR; PG8_MMA(1, 0, At, B0); PG8_MMA(1, 1, At, B1); PG8_BAR; PG8_SCHED;
            } else {
            PG8_LDB(B0, 0, 0); PG8_SCHED; PG8_LDA(At, 0, 0); PG8_STAGE(PG8_SA(1, 1), a1 + hstep, voffA);
            PG8_WAIT_L(8); PG8_BAR; PG8_WAIT_L(0); PG8_MMA(0, 0, At, B0); PG8_BAR; PG8_SCHED;
            PG8_LDB(B1, 0, 1); PG8_STAGE(PG8_SB(0, 0), b2, voffB);
            PG8_BAR; PG8_WAIT_L(0); PG8_MMA(0, 1, At, B1); PG8_BAR;
            PG8_LDA(At, 0, 1); PG8_STAGE(PG8_SA(0, 0), a2, voffA);
            PG8_BAR; PG8_WAIT_L(0); PG8_MMA(1, 0, At, B0); PG8_BAR; PG8_SCHED;
            PG8_STAGE(PG8_SB(0, 1), b2 + hstep, voffB);
            PG8_WAIT_V(6); PG8_BAR; PG8_MMA(1, 1, At, B1); PG8_BAR;
            PG8_LDB(B0, 1, 0); PG8_SCHED; PG8_LDA(At, 1, 0); PG8_STAGE(PG8_SA(0, 1), a2 + hstep, voffA);
            PG8_WAIT_L(8); PG8_BAR; PG8_WAIT_L(0); PG8_MMA(0, 0, At, B0); PG8_BAR; PG8_SCHED;
            PG8_LDB(B1, 1, 1); PG8_STAGE(PG8_SB(1, 0), b3, voffB);
            PG8_BAR; PG8_WAIT_L(0); PG8_MMA(0, 1, At, B1); PG8_BAR;
            PG8_LDA(At, 1, 1); PG8_STAGE(PG8_SA(1, 0), a3, voffA);
            PG8_BAR; PG8_WAIT_L(0); PG8_MMA(1, 0, At, B0); PG8_BAR; PG8_SCHED;
            PG8_STAGE(PG8_SB(1, 1), b3 + hstep, voffB);
            PG8_WAIT_V(6); PG8_BAR; PG8_MMA(1, 1, At, B1); PG8_BAR;
            }
        }
        if constexpr (ALIGN_EPI) { if (wr == 0) PG8_BAR; }
        if constexpr (!Epi::AFTER_DRAIN) { E(acc, cur, wr, wc, fr, fq); S.done(cur); }
        if (!has_next) break;
#pragma unroll
        for (int a = 0; a < 2; ++a)
#pragma unroll
            for (int b = 0; b < 2; ++b)
#pragma unroll
                for (int m = 0; m < 4; ++m)
#pragma unroll
                    for (int n = 0; n < 2; ++n) acc[a][b][m][n] = (f32x4){0.f, 0.f, 0.f, 0.f};
        cur = nxt; cA = nA; cB = nB; ++ui;
        if constexpr (ALIGN_EPI) { if (wr == 1) PG8_BAR; }
    }
    PG8_WAIT_V(0);
    if constexpr (!ALIGN_EPI) { if (wr == 0) PG8_BAR; }
    PG8_BAR;
    if constexpr (Epi::AFTER_DRAIN) { E.fused(acc, cur, wr, wc, fr, fq, lds, wid, lane); S.done(cur); }
#undef PG8_SA
#undef PG8_SB
#undef PG8_STAGE
#undef PG8_LDA
#undef PG8_LDB
#undef PG8_MMA
#undef PG8_WAIT_V
#undef PG8_WAIT_L
#undef PG8_BAR
#undef PG8_SCHED
}
}

constexpr int D = 2048, TP = 8192, NB = 16, TS = 16, MS = NB * TS, M = TP + MS;
constexpr int RW = 1024, RH = 16, RN = 64, RC = 3328;
constexpr int ED = 1024, EH = 4, EN = 256, EC = 4096, IC = RC + EC;
constexpr int FF = 5632, NSEQ = 17, MODW = 6 * D;
constexpr int LCH = 128, NCH = TP / LCH;
constexpr int RBLK = 256, NRB = TP / RBLK;
constexpr int NPHASE = 14;
constexpr size_t O_Y = 0, O_SHP = (size_t)M * D, O_WKP = O_SHP + RC, O_RTP = O_WKP + 65536, O_SHS = O_RTP + 262144, O_WKS = O_SHS + (size_t)NB * RC, O_RTS = O_WKS + (size_t)NB * 65536, O_END = O_RTS + (size_t)NB * 262144;
constexpr size_t MiB = 1u << 20;
constexpr size_t WS_MOD = 1 * MiB, WS_LORAT = 2 * MiB, WS_WOUTT = 4 * MiB, WS_WINT = 12 * MiB, WS_V = 12 * MiB, WS_H = 41 * MiB, WS_G = 41 * MiB, WS_BON = 58 * MiB,
                 WS_QKVG = 74 * MiB, WS_LOUT = 140 * MiB, WS_PU = 140 * MiB, WS_KVB = 172 * MiB, WS_ACT = 74 * MiB, WS_PREP = 190 * MiB, WS_MIXOUT = 190 * MiB,
                 WS_WUPT = 256 * MiB, WS_WDNT = 300 * MiB, WS_PART9 = 330 * MiB, WS_PART12 = 256 * MiB, WS_END = 355 * MiB;
constexpr size_t WS_ADAT = 190 * MiB, WS_SC = 239 * MiB, WS_MODP = 240 * MiB;
constexpr int KS9 = 4, KS12 = 11;
constexpr size_t PREP_STRIDE = 33 * MiB;
constexpr size_t DO_Z = 0, DO_LIN = 54 * MiB, DO_SPREV = 0, DO_MIX = 17 * MiB;
constexpr int LDS_BYTES = 147456;

typedef unsigned short bf16;
typedef float f32x2 __attribute__((ext_vector_type(2)));
typedef float f32x4 __attribute__((ext_vector_type(4)));
typedef short bf16x8 __attribute__((ext_vector_type(8)));
typedef unsigned u32x4 __attribute__((ext_vector_type(4)));
typedef unsigned u32x2 __attribute__((ext_vector_type(2)));
#define LDS_WAIT() asm volatile("s_waitcnt lgkmcnt(0)" ::: "memory")

__device__ __forceinline__ float bf2f(unsigned v) { return __builtin_bit_cast(float, v << 16); }
__device__ __forceinline__ unsigned f2bf(float f) { unsigned u = __builtin_bit_cast(unsigned, f); return (u + 0x7fffu + ((u >> 16) & 1u)) >> 16; }
__device__ __forceinline__ unsigned pk2(float lo, float hi) { return f2bf(lo) | (f2bf(hi) << 16); }
__device__ __forceinline__ float wave_sum(float v) {
#pragma unroll
    for (int o = 1; o < 64; o <<= 1) v += __shfl_xor(v, o);
    return v;
}
__device__ __forceinline__ float sigm(float x) { return 1.f / (1.f + __expf(-x)); }
__device__ __forceinline__ int seq_of(int m) { return m < TP ? 0 : 1 + ((m - TP) >> 4); }
__device__ __forceinline__ int tpos_of(int m) { return m < TP ? m : ((m - TP) & 15); }
__device__ __forceinline__ float ret_l2g(int h) { return __log2f(1.0f - exp2f(-5.0f - (float)h)); }

struct EpiProj {
    static constexpr bool PERM = true, AFTER_DRAIN = false;
    bf16* Z; bf16* Q;
    __device__ __forceinline__ void operator()(const f32x4 (&acc)[2][2][4][2], const pg8::Unit& u, int wr, int wc, int fr, int fq) const {
        const int row0 = u.pm * 256 + wr * 64 + fr, pn = u.pn, cl = wc * 32 + 8 * fq;
        if (pn < 13 || pn >= 21) {
            bf16* base = pn < 13 ? Z + pn * 256 + cl : Q + (pn - 13) * 256 + cl; const size_t ld = pn < 13 ? RC : EC;
#pragma unroll
            for (int ai = 0; ai < 2; ++ai)
#pragma unroll
                for (int m = 0; m < 4; ++m) { bf16* rp = base + (size_t)(row0 + ai * 128 + m * 16) * ld;
#pragma unroll
                    for (int bj = 0; bj < 2; ++bj) { const f32x4 v0 = acc[ai][bj][m][0], v1 = acc[ai][bj][m][1]; u32x4 w; w.x = pk2(v0[0], v0[1]); w.y = pk2(v0[2], v0[3]); w.z = pk2(v1[0], v1[1]); w.w = pk2(v1[2], v1[3]);
                        *(u32x4*)(rp + bj * 128) = w; } }
        } else {
            const int sec = pn - 13; bf16* base = Q + sec * 256 + cl; const float sc = sec >= 4 ? 0.0625f : 1.0f;
            float inv[8];
#pragma unroll
            for (int e = 0; e < 8; ++e) inv[e] = exp2f(-(float)(cl + e) * (13.287712379549449f / 128.0f)) * 0.15915494309189535f;
#pragma unroll
            for (int ai = 0; ai < 2; ++ai)
#pragma unroll
                for (int m = 0; m < 4; ++m) { const int row = row0 + ai * 128 + m * 16; bf16* rp = base + (size_t)row * EC;
                    const float pos = row < TP ? (float)row : (float)(2048 + ((row - TP) & 15));
                    float o1[8], o2[8];
#pragma unroll
                    for (int e = 0; e < 8; ++e) { float rev = pos * inv[e]; rev -= floorf(rev); const float sn = __builtin_amdgcn_sinf(rev), cs = __builtin_amdgcn_cosf(rev);
                        const float x1 = acc[ai][0][m][e >> 2][e & 3], x2 = acc[ai][1][m][e >> 2][e & 3];
                        o1[e] = (x1 * cs - x2 * sn) * sc; o2[e] = (x2 * cs + x1 * sn) * sc; }
                    u32x4 w; w.x = pk2(o1[0], o1[1]); w.y = pk2(o1[2], o1[3]); w.z = pk2(o1[4], o1[5]); w.w = pk2(o1[6], o1[7]); *(u32x4*)rp = w;
                    w.x = pk2(o2[0], o2[1]); w.y = pk2(o2[2], o2[3]); w.z = pk2(o2[4], o2[5]); w.w = pk2(o2[6], o2[7]); *(u32x4*)(rp + 128) = w; }
        }
    }
};
struct EpiBf16P {
    static constexpr bool PERM = true, AFTER_DRAIN = false;
    bf16* C; int ldc;
    __device__ __forceinline__ void operator()(const f32x4 (&acc)[2][2][4][2], const pg8::Unit& u, int wr, int wc, int fr, int fq) const {
        const int row0 = u.pm * 256 + wr * 64 + fr; bf16* base = C + u.pn * 256 + wc * 32 + 8 * fq;
#pragma unroll
        for (int ai = 0; ai < 2; ++ai)
#pragma unroll
            for (int m = 0; m < 4; ++m) { bf16* rp = base + (size_t)(row0 + ai * 128 + m * 16) * ldc;
#pragma unroll
                for (int bj = 0; bj < 2; ++bj) { const f32x4 v0 = acc[ai][bj][m][0], v1 = acc[ai][bj][m][1]; u32x4 w; w.x = pk2(v0[0], v0[1]); w.y = pk2(v0[2], v0[3]); w.z = pk2(v1[0], v1[1]); w.w = pk2(v1[2], v1[3]);
                    *(u32x4*)(rp + bj * 128) = w; } }
    }
};
struct EpiF32 {
    static constexpr bool PERM = true, AFTER_DRAIN = false;
    float* C; int ldc;
    __device__ __forceinline__ void operator()(const f32x4 (&acc)[2][2][4][2], const pg8::Unit& u, int wr, int wc, int fr, int fq) const {
        const int row0 = u.pm * 256 + wr * 64 + fr; float* base = C + u.pn * 256 + wc * 32 + 8 * fq;
#pragma unroll
        for (int ai = 0; ai < 2; ++ai)
#pragma unroll
            for (int m = 0; m < 4; ++m) { float* rp = base + (size_t)(row0 + ai * 128 + m * 16) * ldc;
#pragma unroll
                for (int bj = 0; bj < 2; ++bj) { *(f32x4*)(rp + bj * 128) = acc[ai][bj][m][0]; *(f32x4*)(rp + bj * 128 + 4) = acc[ai][bj][m][1]; } }
    }
};
struct EpiSwiglu {
    static constexpr bool PERM = true, AFTER_DRAIN = false;
    bf16* C;
    __device__ __forceinline__ void operator()(const f32x4 (&acc)[2][2][4][2], const pg8::Unit& u, int wr, int wc, int fr, int fq) const {
        const int row0 = u.pm * 256 + wr * 64 + fr; bf16* base = C + u.pn * 128 + wc * 32 + 8 * fq;
#pragma unroll
        for (int ai = 0; ai < 2; ++ai)
#pragma unroll
            for (int m = 0; m < 4; ++m) { float o[8];
#pragma unroll
                for (int e = 0; e < 8; ++e) { const float g = acc[ai][0][m][e >> 2][e & 3], up = acc[ai][1][m][e >> 2][e & 3]; o[e] = g * sigm(g) * up; }
                u32x4 w; w.x = pk2(o[0], o[1]); w.y = pk2(o[2], o[3]); w.z = pk2(o[4], o[5]); w.w = pk2(o[6], o[7]);
                *(u32x4*)(base + (size_t)(row0 + ai * 128 + m * 16) * FF) = w; }
    }
};
struct EpiMod {
    static constexpr bool PERM = true, AFTER_DRAIN = false;
    float* C; int ldc;
    __device__ __forceinline__ void operator()(const f32x4 (&acc)[2][2][4][2], const pg8::Unit& u, int wr, int wc, int fr, int fq) const {
        if (wr != 0) return;
        float* base = C + u.pn * 256 + wc * 32 + 8 * fq;
#pragma unroll
        for (int m = 0; m < 2; ++m) { const int row = 16 * m + fr; if (row < NSEQ) { float* rp = base + (size_t)row * ldc;
#pragma unroll
            for (int bj = 0; bj < 2; ++bj) { *(f32x4*)(rp + bj * 128) = acc[0][bj][m][0]; *(f32x4*)(rp + bj * 128 + 4) = acc[0][bj][m][1]; } } }
    }
};

__device__ __forceinline__ void transpose_item(const float* __restrict__ W, int K, int N, bf16* WT, int k0, int n0, int dst_row0, float* scr, int lane) {
#pragma unroll 8
    for (int i = 0; i < 32; ++i) { const int kk = 2 * i + (lane >> 5); scr[kk * 33 + (lane & 31)] = W[(size_t)(k0 + kk) * N + n0 + (lane & 31)]; }
    LDS_WAIT();
    const int c = lane & 7;
#pragma unroll
    for (int j = 0; j < 4; ++j) { const int n = (lane >> 3) + 8 * j; const float* s = scr + (8 * c) * 33 + n;
        u32x4 o; o.x = pk2(s[0 * 33], s[1 * 33]); o.y = pk2(s[2 * 33], s[3 * 33]); o.z = pk2(s[4 * 33], s[5 * 33]); o.w = pk2(s[6 * 33], s[7 * 33]);
        *(u32x4*)(WT + (size_t)(dst_row0 + n) * K + k0 + 8 * c) = o; }
    LDS_WAIT();
}

typedef const __attribute__((address_space(4))) f32x2* cf2p;
__device__ __forceinline__ cf2p to_c(const float* p) { return (cf2p)(unsigned long long)p; }
#define DPPF(old, src, ctrl, rmask) __builtin_bit_cast(float, __builtin_amdgcn_update_dpp(__builtin_bit_cast(int, (float)(old)), __builtin_bit_cast(int, (float)(src)), (ctrl), (rmask), 0xF, false))
__device__ __forceinline__ float wave_sum_u(float v) {
    v += DPPF(0.f, v, 0xB1, 0xF); v += DPPF(0.f, v, 0x4E, 0xF); v += DPPF(0.f, v, 0x124, 0xF); v += DPPF(0.f, v, 0x128, 0xF);
    v += DPPF(0.f, v, 0x142, 0xA); v += DPPF(0.f, v, 0x143, 0xC);
    return __builtin_bit_cast(float, __builtin_amdgcn_readlane(__builtin_bit_cast(int, v), 63));
}
constexpr int RW_PF = 6;
template <int MODE>
__device__ __forceinline__ void rwkv_run(f32x2 (&S)[32], const float* W, const float* NKK, const float* B, const float* K, const float* R, const bf16* Vp, int nsteps, int lane,
                                         const bf16* Gp, const float* BONp, bf16* MIXp, float lnw, float lnb) {
    constexpr int NPF = MODE == 2 ? 20 : (MODE == 0 ? 16 : 12);
    const int pa = lane >> 2; const float* pfp = (pa == 0 ? W : pa == 1 ? NKK : pa == 2 ? B : pa == 3 ? K : R) + (lane & 3) * 16;
    float vn = 0.f, gn = 0.f, bn = 0.f;
    if (MODE != 1) vn = bf2f(Vp[lane]);
    if (MODE == 2) { gn = bf2f(Gp[lane]); bn = BONp[0]; }
    if (lane < NPF) {
#pragma unroll
        for (int q = 1; q < RW_PF; ++q) if (q < nsteps) (void)*(volatile const float*)(pfp + (size_t)q * RW);
    }
    for (int t = 0; t < nsteps; ++t) {
        const size_t o = (size_t)t * RW;
        cf2p w = to_c(W + o), nk = to_c(NKK + o), b = to_c(B + o), k = to_c(K + o), r = to_c(R + o);
        const float v = vn, gv = gn, bon = bn;
        { const int t1 = t + 1 < nsteps ? t + 1 : t; const size_t o1 = (size_t)t1 * RW;
          if (MODE != 1) vn = bf2f(Vp[o1 + lane]);
          if (MODE == 2) { gn = bf2f(Gp[o1 + lane]); bn = BONp[(size_t)t1 * 16]; }
          const int tp = t + RW_PF < nsteps ? t + RW_PF : nsteps - 1;
          if (lane < NPF) (void)*(volatile const float*)(pfp + (size_t)tp * RW); }
        f32x2 a0 = {0.f, 0.f}, a1 = {0.f, 0.f};
#pragma unroll
        for (int j = 0; j < 32; j += 2) { a0 = __builtin_elementwise_fma(S[j], nk[j], a0); a1 = __builtin_elementwise_fma(S[j + 1], nk[j + 1], a1); }
        const float sa = (a0.x + a0.y) + (a1.x + a1.y);
        const f32x2 sa2 = {sa, sa}, v2 = {v, v};
        f32x2 o0 = {0.f, 0.f}, o1 = {0.f, 0.f};
#pragma unroll
        for (int j = 0; j < 32; ++j) {
            f32x2 s = S[j] * w[j];
            s = __builtin_elementwise_fma(sa2, b[j], s);
            if (MODE != 1) s = __builtin_elementwise_fma(v2, k[j], s);
            S[j] = s;
            if (MODE == 2) { if (j & 1) o1 = __builtin_elementwise_fma(s, r[j], o1); else o0 = __builtin_elementwise_fma(s, r[j], o0); }
        }
        if (MODE == 2) {
            const float ov = (o0.x + o0.y) + (o1.x + o1.y);
            const float mean = wave_sum_u(ov) * (1.f / 64.f), d = ov - mean, var = wave_sum_u(d * d) * (1.f / 64.f);
            float y = d * rsqrtf(var + 64e-5f) * lnw + lnb;
            y = (y + bon * v) * gv;
            MIXp[(size_t)t * D + lane] = (bf16)f2bf(y);
        }
    }
}

constexpr int RL_B = 8;
template <int MODE> struct RL { static constexpr int NV = MODE == 2 ? 5 : (MODE == 0 ? 4 : 3); static constexpr int REC = NV * 64, BUF = RL_B * REC + (MODE != 1 ? 256 : 0) + (MODE == 2 ? 256 + 16 : 0); };
#define SBAR() __builtin_amdgcn_sched_barrier(0)
template <int MODE>
__device__ __forceinline__ void rwkv_lds(f32x2 (&S)[32], const float* W, const float* NKK, const float* B, const float* K, const float* R, const bf16* Vp, int nsteps, int lane,
                                         const bf16* Gp, const float* BONp, bf16* MIXp, float lnw, float lnb, float* wl) {
    constexpr int NV = RL<MODE>::NV, REC = RL<MODE>::REC;
    const int ls = lane >> 4, lc = (lane & 15) * 4;
    f32x4 st[NV][2]; u32x4 sv = {0u, 0u, 0u, 0u}, sg = {0u, 0u, 0u, 0u}; float sb = 0.f;
#define RL_ISSUE(bt) do { const size_t ob = (size_t)((bt) * RL_B) * RW; \
        _Pragma("unroll") for (int q = 0; q < 2; ++q) { const size_t oo = ob + (size_t)(ls + 4 * q) * RW + lc; \
            st[0][q] = *(const f32x4*)(W + oo); st[1][q] = *(const f32x4*)(NKK + oo); st[2][q] = *(const f32x4*)(B + oo); if (NV >= 4) st[NV >= 4 ? 3 : 0][q] = *(const f32x4*)(K + oo); if (NV == 5) st[NV - 1][q] = *(const f32x4*)(R + oo); } \
        if (MODE != 1) sv = *(const u32x4*)(Vp + ob + (size_t)(lane >> 3) * RW + (lane & 7) * 8); \
        if (MODE == 2) { sg = *(const u32x4*)(Gp + ob + (size_t)(lane >> 3) * RW + (lane & 7) * 8); if (lane < RL_B) sb = BONp[(size_t)((bt) * RL_B + lane) * 16]; } } while (0)
#define RL_COMMIT() do { \
        _Pragma("unroll") for (int q = 0; q < 2; ++q) _Pragma("unroll") for (int v = 0; v < NV; ++v) *(f32x4*)(wl + (ls + 4 * q) * REC + v * 64 + lc) = st[v][q]; \
        if (MODE != 1) *(u32x4*)((bf16*)(wl + RL_B * REC) + (lane >> 3) * 64 + (lane & 7) * 8) = sv; \
        if (MODE == 2) { *(u32x4*)((bf16*)(wl + RL_B * REC + 256) + (lane >> 3) * 64 + (lane & 7) * 8) = sg; if (lane < RL_B) wl[RL_B * REC + 512 + lane] = sb; } } while (0)
    const int nb = nsteps / RL_B;
    RL_ISSUE(0); RL_COMMIT();
    for (int bt = 0; bt < nb; ++bt) {
        if (bt + 1 < nb) RL_ISSUE(bt + 1);
#pragma unroll 1
        for (int s = 0; s < RL_B; ++s) {
            const f32x2* w = (const f32x2*)(wl + s * REC); const f32x2* nk = w + 32; const f32x2* b = w + 64; const f32x2* k = w + 96; const f32x2* r = w + 128;
            float v = 0.f, gv = 0.f, bon = 0.f;
            if (MODE != 1) v = bf2f(((const bf16*)(wl + RL_B * REC))[s * 64 + lane]);
            if (MODE == 2) { gv = bf2f(((const bf16*)(wl + RL_B * REC + 256))[s * 64 + lane]); bon = wl[RL_B * REC + 512 + s]; }
            f32x2 nA[8], nB[8]; f32x2 a0 = {0.f, 0.f}, a1 = {0.f, 0.f};
#pragma unroll
            for (int p = 0; p < 8; ++p) nA[p] = nk[p];
#pragma unroll
            for (int g = 0; g < 4; ++g) {
                if (g < 3) {
#pragma unroll
                    for (int p = 0; p < 8; ++p) { if (g & 1) nA[p] = nk[8 * (g + 1) + p]; else nB[p] = nk[8 * (g + 1) + p]; } }
                SBAR();
#pragma unroll
                for (int p = 0; p < 8; p += 2) { a0 = __builtin_elementwise_fma(S[8 * g + p], (g & 1) ? nB[p] : nA[p], a0); a1 = __builtin_elementwise_fma(S[8 * g + p + 1], (g & 1) ? nB[p + 1] : nA[p + 1], a1); }
                SBAR();
            }
            const float sa = (a0.x + a0.y) + (a1.x + a1.y);
            const f32x2 sa2 = {sa, sa}, v2 = {v, v};
            f32x2 uw[2][4], ub[2][4], uk[2][4], ur[2][4]; f32x2 o0 = {0.f, 0.f}, o1 = {0.f, 0.f};
#pragma unroll
            for (int p = 0; p < 4; ++p) { uw[0][p] = w[p]; ub[0][p] = b[p]; if (MODE != 1) uk[0][p] = k[p]; if (MODE == 2) ur[0][p] = r[p]; }
#pragma unroll
            for (int g = 0; g < 8; ++g) {
                if (g < 7) {
#pragma unroll
                    for (int p = 0; p < 4; ++p) { uw[(g + 1) & 1][p] = w[4 * (g + 1) + p]; ub[(g + 1) & 1][p] = b[4 * (g + 1) + p]; if (MODE != 1) uk[(g + 1) & 1][p] = k[4 * (g + 1) + p]; if (MODE == 2) ur[(g + 1) & 1][p] = r[4 * (g + 1) + p]; } }
                SBAR();
#pragma unroll
                for (int p = 0; p < 4; ++p) { const int j = 4 * g + p;
                    f32x2 x = S[j] * uw[g & 1][p]; x = __builtin_elementwise_fma(sa2, ub[g & 1][p], x); if (MODE != 1) x = __builtin_elementwise_fma(v2, uk[g & 1][p], x); S[j] = x;
                    if (MODE == 2) { if (p & 1) o1 = __builtin_elementwise_fma(x, ur[g & 1][p], o1); else o0 = __builtin_elementwise_fma(x, ur[g & 1][p], o0); } }
                SBAR();
            }
            if (MODE == 2) {
                const float ov = (o0.x + o0.y) + (o1.x + o1.y);
                const float mean = wave_sum_u(ov) * (1.f / 64.f), d = ov - mean, var = wave_sum_u(d * d) * (1.f / 64.f);
                float y = d * rsqrtf(var + 64e-5f) * lnw + lnb;
                y = (y + bon * v) * gv;
                MIXp[(size_t)(bt * RL_B + s) * D + lane] = (bf16)f2bf(y);
            }
        }
        if (bt + 1 < nb) RL_COMMIT();
    }
#undef RL_ISSUE
#undef RL_COMMIT
}
#define LAS __attribute__((address_space(3)))

#define XB_TMO      128
#define XB_XCNT(j)  (256  + 64 * (j))
#define XB_XSUB(j)  (1280 + 64 * (j))
#define XB_XGEN(j)  (2304 + 64 * (j))
#define XB_TOP      3328
#define XB_TOPGEN   3392
#define XCD_BAR_WORDS 3456
#define XB_SPIN_CAP (1u << 18)

__device__ __forceinline__ unsigned xb_ld(unsigned* p)              { return __hip_atomic_load(p, __ATOMIC_RELAXED, __HIP_MEMORY_SCOPE_AGENT); }
__device__ __forceinline__ unsigned xb_add(unsigned* p, unsigned v) { return __hip_atomic_fetch_add(p, v, __ATOMIC_RELAXED, __HIP_MEMORY_SCOPE_AGENT); }
__device__ __forceinline__ unsigned xb_xcc_id() { return (unsigned)__builtin_amdgcn_s_getreg((3 << 11) | 20) & 0xFu; }
#define XB_SPIN(cond, bar) do { unsigned _sp = 0; while (cond) { __builtin_amdgcn_s_sleep(1); \
    if ((++_sp & 255u) == 0u) { if (xb_ld(&(bar)[XB_TMO])) break; if (_sp > XB_SPIN_CAP) { atomicAdd(&(bar)[XB_TMO], 1u); break; } } } } while (0)

struct XcdBarrier {
    unsigned* bar; unsigned x;
    volatile LAS unsigned* st;
};

__device__ __forceinline__ XcdBarrier xcd_barrier_post(unsigned* bar, volatile LAS unsigned* st) {
    XcdBarrier b; b.bar = bar; b.x = xb_xcc_id(); b.st = st;
    if (threadIdx.x == 0) (void)xb_add(&bar[XB_XCNT(b.x)], 1u);
    return b;
}
__device__ __forceinline__ void xcd_barrier_complete(unsigned* bar, unsigned x, unsigned& nloc, unsigned& nx) {
    const unsigned G = gridDim.x * gridDim.y * gridDim.z;
    unsigned sum, cnt, mine, sp = 0u;
    for (;;) {
        sum = 0u; cnt = 0u; mine = 0u;
#pragma unroll
        for (unsigned j = 0; j < 16; ++j) { const unsigned c = xb_ld(&bar[XB_XCNT(j)]); sum += c; cnt += (c > 0u) ? 1u : 0u; mine = (j == x) ? c : mine; }
        if (sum == G) break;
        __builtin_amdgcn_s_sleep(1);
        if ((++sp & 255u) == 0u) { if (xb_ld(&bar[XB_TMO])) break; if (sp > XB_SPIN_CAP) { atomicAdd(&bar[XB_TMO], 1u); break; } }
    }
    nloc = mine > 0u ? mine : 1u; nx = cnt > 0u ? cnt : 1u;
}

__device__ __forceinline__ void xcd_barrier(const XcdBarrier& b) {
    asm volatile("s_waitcnt vmcnt(0)" ::: "memory");
    __syncthreads();
    if (threadIdx.x == 0) {
        unsigned* bar = b.bar;
        __builtin_amdgcn_s_waitcnt(0);
        unsigned nloc = b.st[0], nx = b.st[1];
        if (nloc == 0u) { xcd_barrier_complete(bar, b.x, nloc, nx); b.st[0] = nloc; b.st[1] = nx; }
        const unsigned old = xb_add(&bar[XB_XSUB(b.x)], 1u);
        const unsigned gen = old / nloc;
        if (old + 1u == (gen + 1u) * nloc) {
            __builtin_amdgcn_fence(__ATOMIC_RELEASE, "agent");
            asm volatile("s_waitcnt vmcnt(0)" ::: "memory");
            const unsigned og = xb_add(&bar[XB_TOP], 1u);
            const unsigned tg = og / nx;
            if (og + 1u == (tg + 1u) * nx) xb_add(&bar[XB_TOPGEN], 1u);
            else XB_SPIN(xb_ld(&bar[XB_TOPGEN]) == tg, bar);
            __builtin_amdgcn_fence(__ATOMIC_ACQUIRE, "agent");
            xb_add(&bar[XB_XGEN(b.x)], 1u);
            asm volatile("s_waitcnt vmcnt(0)" ::: "memory");
        } else {
            XB_SPIN(xb_ld(&bar[XB_XGEN(b.x)]) == gen, bar);
            __builtin_amdgcn_fence(__ATOMIC_ACQUIRE, "agent");
            asm volatile("s_waitcnt vmcnt(0)" ::: "memory");
        }
    }
    __syncthreads();
}


struct Args { const float* in[30]; float* out; unsigned char* ws; int ph_lo, ph_hi; };
enum { I_XP = 0, I_XS, I_CP, I_CS, I_SSH, I_SWKV, I_SRET, I_ADAW, I_ADAB, I_GPM, I_GPOM, I_GPF, I_GPOF, I_WIN, I_MU, I_W0, I_W2, I_A0, I_A2, I_G2, I_KK, I_KA, I_RK, I_RLW, I_RLB, I_ELW, I_ELB, I_WOUT, I_WUP, I_WDN };

__global__ void __launch_bounds__(512, 2) mk_fwd(Args a) {
    extern __shared__ __attribute__((aligned(16))) unsigned char lds[];
    cg::grid_group grid = cg::this_grid();
    const int tid = threadIdx.x, lane = tid & 63, wave = __builtin_amdgcn_readfirstlane(tid >> 6);
    const int G = gridDim.x, bid = blockIdx.x, gw = bid * 8 + wave, NGW = G * 8;
    const int lo = a.ph_lo, hi = a.ph_hi;
    volatile LAS unsigned* xst = (volatile LAS unsigned*)((LAS unsigned char*)lds + LDS_BYTES - 16);
    if (tid < 2) xst[tid] = 0u;
    __syncthreads();
    XcdBarrier xb = xcd_barrier_post((unsigned*)(a.ws + 65536), xst);
    unsigned char* ws = a.ws; float* out = a.out; unsigned char* dob = (unsigned char*)a.out;
    float* MOD = (float*)(ws + WS_MOD);
    bf16* LORAT = (bf16*)(ws + WS_LORAT); bf16* WOUTT = (bf16*)(ws + WS_WOUTT); bf16* WINT = (bf16*)(ws + WS_WINT); bf16* WUPT = (bf16*)(ws + WS_WUPT); bf16* WDNT = (bf16*)(ws + WS_WDNT);
    bf16* H = (bf16*)(ws + WS_H); bf16* QKVG = (bf16*)(ws + WS_QKVG); bf16* LOUT = (bf16*)(ws + WS_LOUT); bf16* Z = (bf16*)(dob + DO_Z); bf16* LIN = (bf16*)(dob + DO_LIN);
    float* PW = (float*)(ws + WS_PREP); float* PNKK = (float*)(ws + WS_PREP + PREP_STRIDE); float* PB = (float*)(ws + WS_PREP + 2 * PREP_STRIDE); float* PK = (float*)(ws + WS_PREP + 3 * PREP_STRIDE); float* PR = (float*)(ws + WS_PREP + 4 * PREP_STRIDE);
    bf16* PV = (bf16*)(ws + WS_V); bf16* PG = (bf16*)(ws + WS_G); float* BON = (float*)(ws + WS_BON);
    float* PU = (float*)(ws + WS_PU); bf16* KVB = (bf16*)(ws + WS_KVB); bf16* SPREV = (bf16*)(dob + DO_SPREV); bf16* MIX = (bf16*)(dob + DO_MIX);
    float* MIXOUT = (float*)(ws + WS_MIXOUT); bf16* ACT = (bf16*)(ws + WS_ACT);
#ifndef DUP_PHASE
#define DUP_PHASE -1
#endif
#ifndef PH_MASK
#define PH_MASK 0x3fff
#endif
#define IN(k) (((PH_MASK >> (k)) & 1) && lo <= (k) && (k) < hi)
#ifndef TS_PROBE
#define TS_PROBE -1
#endif
    unsigned long long* TSW = (unsigned long long*)ws;
    if (TS_PROBE >= 0 && bid == 0 && tid == 0) TSW[0] = __builtin_amdgcn_s_memrealtime();
#define MID(n) do { if (TS_PROBE >= 0 && bid == 0) { __syncthreads(); if (tid == 0) TSW[32 + (n)] = __builtin_amdgcn_s_memrealtime(); } } while (0)
#define SEAM(k) do { if (IN(k) && IN((k) + 1)) { if ((k) == 0) grid.sync(); else xcd_barrier(xb); } if (TS_PROBE >= 0 && bid == 0 && tid == 0) TSW[1 + (k)] = __builtin_amdgcn_s_memrealtime(); } while (0)

    if (IN(0)) for (int rep = 0; rep < (DUP_PHASE == 0 ? 2 : 1); ++rep) {
        MID(0);
        float* scr = (float*)lds + wave * (64 * 33 + 16);
        constexpr int IT_WIN = (D / 64) * (IC / 32), IT_WOUT = (D / 64) * (D / 32), IT_ADA = (D / 64) * (MODW / 32);
        bf16* ADAT = (bf16*)(ws + WS_ADAT); bf16* SC = (bf16*)(ws + WS_SC);
        for (int it = gw; it < IT_WIN + IT_WOUT + IT_ADA; it += NGW) {
            if (it < IT_WIN) { const int nb = IC / 32, kb = it / nb, n0 = 32 * (it % nb); transpose_item(a.in[I_WIN], D, IC, WINT, 64 * kb, n0, n0, scr, lane); }
            else if (it < IT_WIN + IT_WOUT) { const int r = it - IT_WIN, nb = D / 32, kb = r / nb, n0 = 32 * (r % nb); transpose_item(a.in[I_WOUT], D, D, WOUTT, 64 * kb, n0, n0, scr, lane); }
            else { const int r = it - IT_WIN - IT_WOUT, nb = MODW / 32, kb = r / nb, n0 = 32 * (r % nb); transpose_item(a.in[I_ADAW], D, MODW, ADAT, 64 * kb, n0, n0, scr, lane); }
        }
        MID(1);
        for (int idx = bid * 512 + tid; idx < 3072 * 256; idx += G * 512) {
            const int n = idx >> 8, k = idx & 255, sec = n >> 10, nn = n & 1023; float v = 0.f;
            if (sec == 0 && k < 64) v = a.in[I_W2][k * RW + nn];
            else if (sec == 1 && k >= 64 && k < 128) v = a.in[I_A2][(k - 64) * RW + nn];
            else if (sec == 2 && k >= 128) v = a.in[I_G2][(k - 128) * RW + nn];
            LORAT[idx] = (bf16)f2bf(v);
        }
        for (int idx = bid * 512 + tid; idx < 256 * D; idx += G * 512) { const int r = idx / D, k = idx % D; float v = 0.f;
            if (r < NSEQ) { const float cv = r == 0 ? a.in[I_CP][k] : a.in[I_CS][(r - 1) * D + k]; v = cv * sigm(cv); }
            SC[idx] = (bf16)f2bf(v); }
        MID(2);
    }
    if (IN(0)) MID(3);
    SEAM(0);
    if (IN(1)) {
        { const int sl = bid / 48; pg8::Gemm g{(const bf16*)(ws + WS_SC) + sl * 512, (const bf16*)(ws + WS_ADAT) + sl * 512, 256, MODW, 512, D}; pg8::OneUnit S{0, bid % 48, bid < 192};
          EpiMod E{(float*)(ws + WS_MODP) + (size_t)sl * NSEQ * MODW, MODW};
          pg8::gemm_phase<EpiMod, pg8::OneUnit, false, true>((PG8_LAS unsigned char*)lds, g, S, E); }
        xcd_barrier(xb);
        const float* MODP = (const float*)(ws + WS_MODP);
        for (int idx = bid * 512 + tid; idx < NSEQ * MODW; idx += G * 512) { float v = a.in[I_ADAB][idx % MODW];
#pragma unroll
            for (int q = 0; q < 4; ++q) v += MODP[(size_t)q * NSEQ * MODW + idx];
            MOD[idx] = v; }
        xcd_barrier(xb);
    }
    if (IN(1)) for (int rep = 0; rep < (DUP_PHASE == 1 ? 2 : 1); ++rep) {
        for (int m = gw; m < M; m += NGW) {
            const float* xr = m < TP ? a.in[I_XP] + (size_t)m * D : a.in[I_XS] + (size_t)(m - TP) * D; const float* mod = MOD + seq_of(m) * MODW;
            f32x4 v[8]; float ss = 0.f;
#pragma unroll
            for (int j = 0; j < 8; ++j) { v[j] = *(const f32x4*)(xr + 4 * lane + 256 * j); ss += (v[j].x * v[j].x + v[j].y * v[j].y) + (v[j].z * v[j].z + v[j].w * v[j].w); }
            const float rs = rsqrtf(wave_sum(ss) * (1.f / D) + 1e-6f);
#pragma unroll
            for (int j = 0; j < 8; ++j) { const int c = 4 * lane + 256 * j; const f32x4 g = *(const f32x4*)(a.in[I_GPM] + c), s1 = *(const f32x4*)(mod + D + c), h1 = *(const f32x4*)(mod + c);
                const f32x4 h = v[j] * rs * g * (s1 + 1.f) + h1; u32x2 w; w.x = pk2(h.x, h.y); w.y = pk2(h.z, h.w); *(u32x2*)(H + (size_t)m * D + c) = w; }
        }
    }
    SEAM(1);
    if (IN(2)) for (int rep = 0; rep < (DUP_PHASE == 2 ? 2 : 1); ++rep) {
        pg8::Gemm g{H, WINT, M, IC, D, D}; pg8::StaticOrder S; S.init(M, IC, G, bid); EpiProj E{Z, QKVG};
        pg8::gemm_phase<EpiProj, pg8::StaticOrder, true, true>((PG8_LAS unsigned char*)lds, g, S, E);
    }
    SEAM(2);
    if (IN(3)) for (int rep = 0; rep < (DUP_PHASE == 3 ? 2 : 1); ++rep) {
        for (int idx = bid * 512 + tid; idx < M * 128; idx += G * 512) {
            const int m = idx >> 7, c2 = (idx & 127) * 2, c = 3072 + c2, tp = tpos_of(m), sq = seq_of(m);
            const unsigned zz = *(const unsigned*)(Z + (size_t)m * RC + c); float z0 = bf2f(zz & 0xffffu), z1 = bf2f(zz >> 16), p0 = 0.f, p1 = 0.f;
            if (tp > 0) { const unsigned pp = *(const unsigned*)(Z + (size_t)(m - 1) * RC + c); p0 = bf2f(pp & 0xffffu); p1 = bf2f(pp >> 16); }
            else if (sq > 0) { p0 = a.in[I_SSH][(size_t)(sq - 1) * RC + c]; p1 = a.in[I_SSH][(size_t)(sq - 1) * RC + c + 1]; }
            z0 = z0 + (p0 - z0) * a.in[I_MU][c]; z1 = z1 + (p1 - z1) * a.in[I_MU][c + 1];
            if (c2 < 64) { z0 = 1.f - 2.f / (__expf(2.f * z0) + 1.f); z1 = 1.f - 2.f / (__expf(2.f * z1) + 1.f); }
            else if (c2 >= 128) { z0 = sigm(z0); z1 = sigm(z1); }
            *(unsigned*)(LIN + (size_t)m * 256 + c2) = pk2(z0, z1);
        }
        for (int idx = bid * 512 + tid; idx < NSEQ * RC; idx += G * 512) { const int s = idx / RC, c = idx % RC; const int m = s == 0 ? TP - 1 : TP + 16 * (s - 1) + 15;
            out[(s == 0 ? O_SHP : O_SHS + (size_t)(s - 1) * RC) + c] = bf2f(Z[(size_t)m * RC + c]); }
    }
    SEAM(3);
    if (IN(4)) for (int rep = 0; rep < (DUP_PHASE == 4 ? 2 : 1); ++rep) {
        int k256 = 256; asm volatile("" : "+s"(k256));
        pg8::Gemm g{LIN, LORAT, M, 3072, k256, k256}; pg8::StaticOrder S; S.init(M, 3072, G, bid); EpiBf16P E{LOUT, 3072};
        pg8::gemm_phase<EpiBf16P, pg8::StaticOrder, true, true>((PG8_LAS unsigned char*)lds, g, S, E);
    }
    SEAM(4);
    if (IN(5)) for (int rep = 0; rep < (DUP_PHASE == 5 ? 2 : 1); ++rep) {
        float* prm = (float*)lds;
        __syncthreads();
        for (int idx = tid; idx < RW; idx += 512) { prm[idx] = a.in[I_MU][idx]; prm[RW + idx] = a.in[I_MU][RW + idx]; prm[2 * RW + idx] = a.in[I_MU][2 * RW + idx]; prm[3 * RW + idx] = a.in[I_W0][idx];
            prm[4 * RW + idx] = a.in[I_A0][idx]; prm[5 * RW + idx] = a.in[I_KK][idx]; prm[6 * RW + idx] = a.in[I_KA][idx]; prm[7 * RW + idx] = a.in[I_RK][idx]; }
        __syncthreads();
        for (int m = gw; m < M; m += NGW) {
            const int tp = tpos_of(m), sq = seq_of(m);
#pragma unroll 1
            for (int hp = 0; hp < 2; ++hp) {
                const int hd = hp * 8 + (lane >> 3), c0 = hd * 64 + (lane & 7) * 8;
                const bf16* zr = Z + (size_t)m * RC + c0; const bf16* lr = LOUT + (size_t)m * 3072 + c0; const float* sh0 = a.in[I_SSH] + (size_t)(sq > 0 ? sq - 1 : 0) * RC + c0;
                float zs[3][8];
#pragma unroll
                for (int q = 0; q < 3; ++q) {
                    const u32x4 ca = *(const u32x4*)(zr + q * RW); float pv[8];
                    if (tp > 0) { const u32x4 pa2 = *(const u32x4*)(zr - RC + q * RW);
#pragma unroll
                        for (int e = 0; e < 4; ++e) { pv[2 * e] = bf2f(pa2[e] & 0xffffu); pv[2 * e + 1] = bf2f(pa2[e] >> 16); } }
                    else if (sq > 0) { const f32x4 f0 = *(const f32x4*)(sh0 + q * RW), f1 = *(const f32x4*)(sh0 + q * RW + 4);
                        pv[0] = f0.x; pv[1] = f0.y; pv[2] = f0.z; pv[3] = f0.w; pv[4] = f1.x; pv[5] = f1.y; pv[6] = f1.z; pv[7] = f1.w; }
                    else {
#pragma unroll
                        for (int e = 0; e < 8; ++e) pv[e] = 0.f; }
                    const float* mu = prm + q * RW + c0;
#pragma unroll
                    for (int e = 0; e < 4; ++e) { const float z0 = bf2f(ca[e] & 0xffffu), z1 = bf2f(ca[e] >> 16);
                        zs[q][2 * e] = z0 + (pv[2 * e] - z0) * mu[2 * e]; zs[q][2 * e + 1] = z1 + (pv[2 * e + 1] - z1) * mu[2 * e + 1]; }
                }
                const u32x4 wa = *(const u32x4*)(lr), aa = *(const u32x4*)(lr + RW), ga = *(const u32x4*)(lr + 2 * RW);
                float wv[8], av[8], kkv[8], k2[8]; float s1 = 0.f, s2 = 0.f;
#pragma unroll
                for (int e = 0; e < 8; ++e) {
                    const float lwv = bf2f((e & 1) ? (wa[e >> 1] >> 16) : (wa[e >> 1] & 0xffffu)), lav = bf2f((e & 1) ? (aa[e >> 1] >> 16) : (aa[e >> 1] & 0xffffu));
                    wv[e] = __expf(-0.6065306597126334f * sigm(prm[3 * RW + c0 + e] + lwv));
                    av[e] = sigm(prm[4 * RW + c0 + e] + lav);
                    kkv[e] = zs[1][e] * prm[5 * RW + c0 + e]; s1 += kkv[e] * kkv[e];
                    k2[e] = zs[1][e] * (1.f + (av[e] - 1.f) * prm[6 * RW + c0 + e]); s2 += zs[0][e] * k2[e] * prm[7 * RW + c0 + e];
                }
                s1 += DPPF(0.f, s1, 0xB1, 0xF); s1 += DPPF(0.f, s1, 0x4E, 0xF); s1 += DPPF(0.f, s1, 0x141, 0xF);
                s2 += DPPF(0.f, s2, 0xB1, 0xF); s2 += DPPF(0.f, s2, 0x4E, 0xF); s2 += DPPF(0.f, s2, 0x141, 0xF);
                const float inrm = 1.f / fmaxf(sqrtf(s1), 1e-12f);
                const size_t o = (size_t)m * RW + c0;
#pragma unroll
                for (int e = 0; e < 2; ++e) {
                    const float k0 = kkv[4 * e] * inrm, k1 = kkv[4 * e + 1] * inrm, k2_ = kkv[4 * e + 2] * inrm, k3 = kkv[4 * e + 3] * inrm;
                    *(f32x4*)(PW + o + 4 * e) = (f32x4){wv[4 * e], wv[4 * e + 1], wv[4 * e + 2], wv[4 * e + 3]};
                    *(f32x4*)(PNKK + o + 4 * e) = (f32x4){-k0, -k1, -k2_, -k3};
                    *(f32x4*)(PB + o + 4 * e) = (f32x4){k0 * av[4 * e], k1 * av[4 * e + 1], k2_ * av[4 * e + 2], k3 * av[4 * e + 3]};
                    *(f32x4*)(PK + o + 4 * e) = (f32x4){k2[4 * e], k2[4 * e + 1], k2[4 * e + 2], k2[4 * e + 3]};
                    *(f32x4*)(PR + o + 4 * e) = (f32x4){zs[0][4 * e], zs[0][4 * e + 1], zs[0][4 * e + 2], zs[0][4 * e + 3]};
                }
                { u32x4 va;
#pragma unroll
                  for (int e = 0; e < 4; ++e) va[e] = pk2(zs[2][2 * e], zs[2][2 * e + 1]);
                  *(u32x4*)(PV + o) = va; *(u32x4*)(PG + o) = ga; }
                if ((lane & 7) == 0) BON[m * 16 + hd] = s2;
            }
        }
    }
    SEAM(5);
    if (IN(6)) for (int rep = 0; rep < (DUP_PHASE == 6 ? 2 : 1); ++rep) {
        MID(4);
        {
            float* wl = (float*)lds + wave * RL<0>::BUF;
            for (int task = gw; task < RH * NCH * 2; task += NGW) {
                const int part = task & 1, pair = task >> 1, h = pair / NCH, c = pair % NCH; const size_t o = (size_t)(c * LCH) * RW + h * 64;
                f32x2 S[32];
                if (part) {
#pragma unroll
                    for (int j = 0; j < 32; ++j) { S[j].x = (2 * j == lane) ? 1.f : 0.f; S[j].y = (2 * j + 1 == lane) ? 1.f : 0.f; }
                    rwkv_lds<1>(S, PW + o, PNKK + o, PB + o, PK + o, PR + o, PV + o, LCH, lane, nullptr, nullptr, nullptr, 0.f, 0.f, wl);
                } else {
#pragma unroll
                    for (int j = 0; j < 32; ++j) S[j] = (f32x2){0.f, 0.f};
                    rwkv_lds<0>(S, PW + o, PNKK + o, PB + o, PK + o, PR + o, PV + o, LCH, lane, nullptr, nullptr, nullptr, 0.f, 0.f, wl);
                }
                float* dst = PU + ((size_t)pair * 2 + (part ? 0 : 1)) * 4096 + lane * 64;
#pragma unroll
                for (int j = 0; j < 16; ++j) *(f32x4*)(dst + 4 * j) = (f32x4){S[2 * j].x, S[2 * j].y, S[2 * j + 1].x, S[2 * j + 1].y};
            }
        }
        __syncthreads();
        MID(5);
        bf16* kT = (bf16*)lds;
        bf16* vT = (bf16*)lds + 256 * 72;
        const int fr = lane & 15, fq = lane >> 4;
        for (int it = bid; it < EH * NRB * 2; it += G) {
            const int half = it & 1, blk = (it >> 1) % NRB, h = (it >> 1) / NRB; const float l2g = ret_l2g(h); const int m0 = blk * RBLK;
            f32x4 acc[2][8];
#pragma unroll
            for (int x = 0; x < 2; ++x)
#pragma unroll
                for (int y = 0; y < 8; ++y) acc[x][y] = (f32x4){0.f, 0.f, 0.f, 0.f};
            for (int ts = 0; ts < 4; ++ts) {
                __syncthreads();
#pragma unroll
                for (int i = 0; i < 4; ++i) { const int t = lane, dp = wave + 8 * i; const u32x4 raw = *(const u32x4*)(QKVG + (size_t)(m0 + ts * 64 + t) * EC + 1024 + h * 256 + dp * 8);
                    const float dec = exp2f(l2g * (float)(255 - (ts * 64 + t)));
#pragma unroll
                    for (int e = 0; e < 4; ++e) { const unsigned w = raw[e]; kT[(dp * 8 + 2 * e) * 72 + t] = (bf16)f2bf(bf2f(w & 0xffffu) * dec); kT[(dp * 8 + 2 * e + 1) * 72 + t] = (bf16)f2bf(bf2f(w >> 16) * dec); } }
#pragma unroll
                for (int i = 0; i < 2; ++i) { const int t = lane, ep = wave + 8 * i; const u32x4 raw = *(const u32x4*)(QKVG + (size_t)(m0 + ts * 64 + t) * EC + 2048 + h * 256 + half * 128 + ep * 8);
#pragma unroll
                    for (int e = 0; e < 4; ++e) { const unsigned w = raw[e]; vT[(ep * 8 + 2 * e) * 72 + t] = (bf16)(w & 0xffffu); vT[(ep * 8 + 2 * e + 1) * 72 + t] = (bf16)(w >> 16); } }
                __syncthreads();
#pragma unroll
                for (int kk = 0; kk < 2; ++kk) { bf16x8 af[2];
#pragma unroll
                    for (int x = 0; x < 2; ++x) af[x] = *(const bf16x8*)(kT + (32 * wave + 16 * x + fr) * 72 + kk * 32 + fq * 8);
#pragma unroll
                    for (int y = 0; y < 8; ++y) { const bf16x8 bfm = *(const bf16x8*)(vT + (16 * y + fr) * 72 + kk * 32 + fq * 8);
#pragma unroll
                        for (int x = 0; x < 2; ++x) acc[x][y] = __builtin_amdgcn_mfma_f32_16x16x32_bf16(af[x], bfm, acc[x][y], 0, 0, 0); } }
            }
            bf16* dst = KVB + ((size_t)(h * NRB + blk) * 256) * 256;
#pragma unroll
            for (int x = 0; x < 2; ++x)
#pragma unroll
                for (int y = 0; y < 8; ++y) { u32x2 w; w.x = pk2(acc[x][y][0], acc[x][y][1]); w.y = pk2(acc[x][y][2], acc[x][y][3]);
                    *(u32x2*)(dst + (size_t)(half * 128 + 16 * y + fr) * 256 + 32 * wave + 16 * x + fq * 4) = w; }
        }
    }
    if (IN(6)) MID(6);
    SEAM(6);
    if (IN(7)) for (int rep = 0; rep < (DUP_PHASE == 7 ? 2 : 1); ++rep) {
        const int nB = RH * 4;
        if (bid < nB || G <= nB) {
            float* Sb = (float*)lds;
            const int fr = lane & 15, fq = lane >> 4;
            for (int it = bid; it < nB; it += G) {
                const int h = it >> 2, g4 = it & 3; float* pu = PU + (size_t)(h * NCH) * 2 * 4096;
                __syncthreads();
                for (int idx = tid; idx < 16 * 65; idx += 512) Sb[idx] = 0.f;
                __syncthreads();
                if (wave < 4) {
                    float pa[16], pb[16]; f32x4 ua, ub;
#define PB_LOAD(dst, du, c) do { const float* pp = pu + (size_t)(c) * 2 * 4096; _Pragma("unroll") for (int kk = 0; kk < 16; ++kk) dst[kk] = pp[(4 * kk + fq) * 64 + 16 * wave + fr]; \
                        _Pragma("unroll") for (int jj = 0; jj < 4; ++jj) du[jj] = pp[4096 + (16 * g4 + 4 * fq + jj) * 64 + 16 * wave + fr]; } while (0)
                    PB_LOAD(pa, ua, 0); PB_LOAD(pb, ub, 1);
                    for (int c = 0; c < NCH; ++c) {
                        const float* Sc = Sb + (c & 1) * (16 * 65); float* Sn = Sb + ((c + 1) & 1) * (16 * 65);
                        f32x4 acc = ua, ac1 = {0.f, 0.f, 0.f, 0.f}, ac2 = ac1, ac3 = ac1;
#pragma unroll
                        for (int kk = 0; kk < 16; kk += 4) { acc = __builtin_amdgcn_mfma_f32_16x16x4f32(Sc[fr * 65 + 4 * kk + fq], pa[kk], acc, 0, 0, 0);
                            ac1 = __builtin_amdgcn_mfma_f32_16x16x4f32(Sc[fr * 65 + 4 * (kk + 1) + fq], pa[kk + 1], ac1, 0, 0, 0);
                            ac2 = __builtin_amdgcn_mfma_f32_16x16x4f32(Sc[fr * 65 + 4 * (kk + 2) + fq], pa[kk + 2], ac2, 0, 0, 0);
                            ac3 = __builtin_amdgcn_mfma_f32_16x16x4f32(Sc[fr * 65 + 4 * (kk + 3) + fq], pa[kk + 3], ac3, 0, 0, 0); }
                        acc = (acc + ac1) + (ac2 + ac3);
#pragma unroll
                        for (int jj = 0; jj < 4; ++jj) { Sn[(4 * fq + jj) * 65 + 16 * wave + fr] = acc[jj]; pu[(size_t)c * 2 * 4096 + 4096 + (16 * g4 + 4 * fq + jj) * 64 + 16 * wave + fr] = acc[jj]; }
                        if (c + 1 == NCH) {
#pragma unroll
                            for (int jj = 0; jj < 4; ++jj) out[O_WKP + (size_t)h * 4096 + (16 * g4 + 4 * fq + jj) * 64 + 16 * wave + fr] = acc[jj]; }
#pragma unroll
                        for (int kk = 0; kk < 16; ++kk) pa[kk] = pb[kk];
                        ua = ub;
                        if (c + 2 < NCH) PB_LOAD(pb, ub, c + 2);
                        asm volatile("s_waitcnt lgkmcnt(0)" ::: "memory");
                        __builtin_amdgcn_s_barrier();
                    }
#undef PB_LOAD
                } else {
                    for (int c = 0; c < NCH; ++c) __builtin_amdgcn_s_barrier();
                }
            }
        }
        if (bid >= nB || G <= nB) {
            const int nb2 = G <= nB ? G : G - nB, b2 = G <= nB ? bid : bid - nB;
            for (int it = b2 * 512 + tid; it < EH * 256 * 32; it += nb2 * 512) {
                const int h = it >> 13, e = (it >> 5) & 255, d0 = (it & 31) * 8; const float g256 = exp2f(256.f * ret_l2g(h));
                float acc[8];
#pragma unroll
                for (int q = 0; q < 8; ++q) acc[q] = 0.f;
                u32x4 kvr[NRB];
#pragma unroll
                for (int blk = 0; blk < NRB; ++blk) kvr[blk] = *(const u32x4*)(KVB + ((size_t)(h * NRB + blk) * 256 + e) * 256 + d0);
#pragma unroll
                for (int blk = 0; blk < NRB; ++blk) {
                    const size_t o = ((size_t)(h * NRB + blk) * 256 + e) * 256 + d0;
                    u32x4 w; w.x = pk2(acc[0], acc[1]); w.y = pk2(acc[2], acc[3]); w.z = pk2(acc[4], acc[5]); w.w = pk2(acc[6], acc[7]); *(u32x4*)(SPREV + o) = w;
                    const u32x4 kv = kvr[blk];
#pragma unroll
                    for (int q = 0; q < 4; ++q) { acc[2 * q] = acc[2 * q] * g256 + bf2f(kv[q] & 0xffffu); acc[2 * q + 1] = acc[2 * q + 1] * g256 + bf2f(kv[q] >> 16); }
                }
#pragma unroll
                for (int q = 0; q < 8; ++q) out[O_RTP + (size_t)h * 65536 + (size_t)(d0 + q) * 256 + e] = acc[q];
            }
            asm volatile("s_waitcnt vmcnt(0)" ::: "memory");
            __syncthreads();
            if (tid == 0) {
                unsigned* cw = (unsigned*)(a.ws + 65536) + XCD_BAR_WORDS + 64;
                __builtin_amdgcn_fence(__ATOMIC_RELEASE, "agent");
                asm volatile("s_waitcnt vmcnt(0)" ::: "memory");
                (void)xb_add(cw, 1u);
            }
        }
        {
            const int nscan = G <= nB ? G : G - nB;
            unsigned* cw = (unsigned*)(a.ws + 65536) + XCD_BAR_WORDS + 64; unsigned* cq = cw + 32;
            if (tid == 0) {
                unsigned sp = 0u; while (xb_ld(cw) < (unsigned)nscan) { __builtin_amdgcn_s_sleep(1); if (++sp > (1u << 22)) break; }
                __builtin_amdgcn_fence(__ATOMIC_ACQUIRE, "agent");
                asm volatile("s_waitcnt vmcnt(0)" ::: "memory");
            }
            __syncthreads();
            {
                const int fr = lane & 15, fq = lane >> 4;
                for (;;) {
                    __syncthreads();
                    if (tid == 0) xst[2] = xb_add(cq, 1u);
                    __syncthreads();
                    const int qi = (int)xst[2];
                    if (qi >= EH * (TP / 64)) break;
                    const int it = ((qi & 127) >> 5) * (TP / 64) + (qi & 31) * 4 + (3 - (qi >> 7));
                    {
                    const int h = it / (TP / 64), n = it % (TP / 64), blk = n >> 2, i = n & 3, m0 = n * 64; const float l2g = ret_l2g(h);
                    bf16* qL = (bf16*)lds; bf16* kL = qL + 64 * 264; bf16* vT = kL + 64 * 264; bf16* pL = vT + 256 * 72; float* red = (float*)(pL + 64 * 72);
#pragma unroll
                    for (int x = 0; x < 4; ++x) { const int p = tid + 512 * x, t = p >> 5, dp = p & 31; *(u32x4*)(qL + t * 264 + dp * 8) = *(const u32x4*)(QKVG + (size_t)(m0 + t) * EC + h * 256 + dp * 8); }
                    __syncthreads();
                    f32x4 acc[4][2];
#pragma unroll
                    for (int x = 0; x < 4; ++x)
#pragma unroll
                        for (int y = 0; y < 2; ++y) acc[x][y] = (f32x4){0.f, 0.f, 0.f, 0.f};
                    if (blk > 0) {
                        const bf16* sp = SPREV + ((size_t)(h * NRB + blk) * 256) * 256;
#pragma unroll 2
                        for (int kk = 0; kk < 8; ++kk) { bf16x8 bfm[2];
#pragma unroll
                            for (int y = 0; y < 2; ++y) bfm[y] = *(const bf16x8*)(sp + (size_t)(32 * wave + 16 * y + fr) * 256 + kk * 32 + fq * 8);
#pragma unroll
                            for (int x = 0; x < 4; ++x) { const bf16x8 af = *(const bf16x8*)(qL + (16 * x + fr) * 264 + kk * 32 + fq * 8);
#pragma unroll
                                for (int y = 0; y < 2; ++y) acc[x][y] = __builtin_amdgcn_mfma_f32_16x16x32_bf16(af, bfm[y], acc[x][y], 0, 0, 0); } }
#pragma unroll
                        for (int x = 0; x < 4; ++x)
#pragma unroll
                            for (int jj = 0; jj < 4; ++jj) { const float qd = exp2f(l2g * (float)(64 * i + 16 * x + fq * 4 + jj + 1)); acc[x][0][jj] *= qd; acc[x][1][jj] *= qd; }
                    }
                    for (int j = 0; j <= i; ++j) {
                        __syncthreads();
                        const int ms = (blk * 4 + j) * 64;
#pragma unroll
                        for (int x = 0; x < 4; ++x) { const int p = tid + 512 * x, t = p >> 5, dp = p & 31;
                            *(u32x4*)(kL + t * 264 + dp * 8) = *(const u32x4*)(QKVG + (size_t)(ms + t) * EC + 1024 + h * 256 + dp * 8); }
#pragma unroll
                        for (int x = 0; x < 4; ++x) { const int t = lane, dp = wave + 8 * x;
                            const u32x4 raw = *(const u32x4*)(QKVG + (size_t)(ms + t) * EC + 2048 + h * 256 + dp * 8);
#pragma unroll
                            for (int e = 0; e < 4; ++e) { const unsigned w = raw[e]; vT[(dp * 8 + 2 * e) * 72 + t] = (bf16)(w & 0xffffu); vT[(dp * 8 + 2 * e + 1) * 72 + t] = (bf16)(w >> 16); } }
                        __syncthreads();
                        { const int tr = wave >> 1, tc0 = (wave & 1) * 2; f32x4 sa[2] = {(f32x4){0.f, 0.f, 0.f, 0.f}, (f32x4){0.f, 0.f, 0.f, 0.f}};
#pragma unroll
                            for (int kk = 0; kk < 8; ++kk) { const bf16x8 af = *(const bf16x8*)(qL + (16 * tr + fr) * 264 + kk * 32 + fq * 8);
#pragma unroll
                                for (int y = 0; y < 2; ++y) { const bf16x8 bfm = *(const bf16x8*)(kL + (16 * (tc0 + y) + fr) * 264 + kk * 32 + fq * 8); sa[y] = __builtin_amdgcn_mfma_f32_16x16x32_bf16(af, bfm, sa[y], 0, 0, 0); } }
#pragma unroll
                            for (int y = 0; y < 2; ++y)
#pragma unroll
                                for (int jj = 0; jj < 4; ++jj) { const int t = 16 * tr + fq * 4 + jj, s = 16 * (tc0 + y) + fr; const int dist = (j < i) ? 64 * (i - j) + t - s : (t > s ? t - s : s - t);
                                    pL[t * 72 + s] = (bf16)f2bf(sa[y][jj] * exp2f(l2g * (float)dist)); } }
                        __syncthreads();
#pragma unroll
                        for (int kk = 0; kk < 2; ++kk) { bf16x8 bfm[2];
#pragma unroll
                            for (int y = 0; y < 2; ++y) bfm[y] = *(const bf16x8*)(vT + (32 * wave + 16 * y + fr) * 72 + kk * 32 + fq * 8);
#pragma unroll
                            for (int x = 0; x < 4; ++x) { const bf16x8 af = *(const bf16x8*)(pL + (16 * x + fr) * 72 + kk * 32 + fq * 8);
#pragma unroll
                                for (int y = 0; y < 2; ++y) acc[x][y] = __builtin_amdgcn_mfma_f32_16x16x32_bf16(af, bfm[y], acc[x][y], 0, 0, 0); } }
                    }
                    const int et = tid >> 3, e0 = (tid & 7) * 32;
                    u32x4 g4[4];
#pragma unroll
                    for (int q4 = 0; q4 < 4; ++q4) g4[q4] = *(const u32x4*)(QKVG + (size_t)(m0 + et) * EC + 3072 + h * 256 + e0 + 8 * q4);
                    __syncthreads();
                    float* OT = (float*)lds;
#pragma unroll
                    for (int x = 0; x < 4; ++x)
#pragma unroll
                        for (int y = 0; y < 2; ++y)
#pragma unroll
                            for (int jj = 0; jj < 4; ++jj) OT[(16 * x + fq * 4 + jj) * 260 + 32 * wave + 16 * y + fr] = acc[x][y][jj];
                    __syncthreads();
                    f32x4 ov[8]; float s1 = 0.f, s2 = 0.f;
#pragma unroll
                    for (int q8 = 0; q8 < 8; ++q8) { ov[q8] = *(const f32x4*)(OT + et * 260 + e0 + 4 * q8); s1 += (ov[q8].x + ov[q8].y) + (ov[q8].z + ov[q8].w);
                        s2 += (ov[q8].x * ov[q8].x + ov[q8].y * ov[q8].y) + (ov[q8].z * ov[q8].z + ov[q8].w * ov[q8].w); }
                    s1 += DPPF(0.f, s1, 0xB1, 0xF); s1 += DPPF(0.f, s1, 0x4E, 0xF); s1 += DPPF(0.f, s1, 0x141, 0xF);
                    s2 += DPPF(0.f, s2, 0xB1, 0xF); s2 += DPPF(0.f, s2, 0x4E, 0xF); s2 += DPPF(0.f, s2, 0x141, 0xF);
                    const float mean = s1 * (1.f / 256.f), var = s2 * (1.f / 256.f) - mean * mean, rstd = rsqrtf(var + 1e-5f);
                    const float* lwp = a.in[I_ELW] + h * 256 + e0; const float* lbp = a.in[I_ELB] + h * 256 + e0;
                    bf16* mp = MIX + (size_t)(m0 + et) * D + RW + h * 256 + e0;
#pragma unroll
                    for (int q4 = 0; q4 < 4; ++q4) { float o8[8];
#pragma unroll
                        for (int hh = 0; hh < 2; ++hh) { const f32x4 w4 = *(const f32x4*)(lwp + 8 * q4 + 4 * hh), b4 = *(const f32x4*)(lbp + 8 * q4 + 4 * hh); const f32x4 vv = ov[2 * q4 + hh];
                            const unsigned ga = g4[q4][2 * hh], gb = g4[q4][2 * hh + 1]; const float t0 = bf2f(ga & 0xffffu), t1 = bf2f(ga >> 16), t2 = bf2f(gb & 0xffffu), t3 = bf2f(gb >> 16);
                            o8[4 * hh] = ((vv.x - mean) * rstd * w4.x + b4.x) * t0 * sigm(t0); o8[4 * hh + 1] = ((vv.y - mean) * rstd * w4.y + b4.y) * t1 * sigm(t1);
                            o8[4 * hh + 2] = ((vv.z - mean) * rstd * w4.z + b4.z) * t2 * sigm(t2); o8[4 * hh + 3] = ((vv.w - mean) * rstd * w4.w + b4.w) * t3 * sigm(t3); }
                        u32x4 w; w.x = pk2(o8[0], o8[1]); w.y = pk2(o8[2], o8[3]); w.z = pk2(o8[4], o8[5]); w.w = pk2(o8[6], o8[7]); *(u32x4*)(mp + 8 * q4) = w; }

                    }
                }
            }
        }
    }
    if (IN(7)) MID(10);
    SEAM(7);
    if (IN(8)) for (int rep = 0; rep < (DUP_PHASE == 8 ? 2 : 1); ++rep) {
        MID(7);
        if (wave < 5) {
            float* wl = (float*)lds + wave * RL<2>::BUF;
            const int ntask = wave < 4 ? RH * NCH : NB * RH;
            for (int task = wave < 4 ? bid * 4 + wave : bid; task < ntask; task += (wave < 4 ? G * 4 : G)) {
                f32x2 S[32]; int h, m0, nsteps; float* sdst = nullptr;
                if (wave < 4) { h = task / NCH; const int c = task % NCH; m0 = c * LCH; nsteps = LCH;
                    if (c == 0) {
#pragma unroll
                        for (int j = 0; j < 32; ++j) S[j] = (f32x2){0.f, 0.f};
                    } else { const float* src = PU + ((size_t)(h * NCH + c - 1) * 2 + 1) * 4096 + lane * 64;
#pragma unroll
                        for (int j = 0; j < 16; ++j) { const f32x4 q = *(const f32x4*)(src + 4 * j); S[2 * j] = (f32x2){q.x, q.y}; S[2 * j + 1] = (f32x2){q.z, q.w}; } }
                } else { const int b = task / RH; h = task % RH; m0 = TP + 16 * b; nsteps = TS;
                    const float* src = a.in[I_SWKV] + ((size_t)(b * RH + h) * 64 + lane) * 64; sdst = out + O_WKS + ((size_t)(b * RH + h) * 64 + lane) * 64;
#pragma unroll
                    for (int j = 0; j < 16; ++j) { const f32x4 q = *(const f32x4*)(src + 4 * j); S[2 * j] = (f32x2){q.x, q.y}; S[2 * j + 1] = (f32x2){q.z, q.w}; } }
                const size_t o = (size_t)m0 * RW + h * 64;
                rwkv_lds<2>(S, PW + o, PNKK + o, PB + o, PK + o, PR + o, PV + o, nsteps, lane, PG + o, BON + (size_t)m0 * 16 + h, MIX + (size_t)m0 * D + h * 64,
                            a.in[I_RLW][h * 64 + lane], a.in[I_RLB][h * 64 + lane], wl);
                if (sdst) {
#pragma unroll
                    for (int j = 0; j < 16; ++j) *(f32x4*)(sdst + 4 * j) = (f32x4){S[2 * j].x, S[2 * j].y, S[2 * j + 1].x, S[2 * j + 1].y}; }
            }
        }
        MID(8);
        {
            const int nb2 = G, b2 = bid;
            const int fr = lane & 15, fq = lane >> 4;
            for (int it0 = b2; it0 < NB * EH * 4; it0 += nb2) {
                const int it = EH * (TP / 64) + it0;
                __syncthreads();
#ifndef NO_RS
                {
                    const int r = it - EH * (TP / 64), tq = r & 3, b = (r >> 2) / EH, h = (r >> 2) % EH, m0 = TP + 16 * b; const float l2g = ret_l2g(h);
                    float* qf = (float*)lds; float* kf = qf + 4 * 260; float* vf = kf + 16 * 257; float* pf = vf + 16 * 257; float* red = pf + 64;
                    for (int idx = tid; idx < 16 * 256; idx += 512) { const int t = idx >> 8, dd = idx & 255; const bf16* src = QKVG + (size_t)(m0 + t) * EC + h * 256 + dd;
                        if ((t >> 2) == tq) qf[(t & 3) * 260 + dd] = bf2f(src[0]);
                        kf[t * 257 + dd] = bf2f(src[1024]); vf[t * 257 + dd] = bf2f(src[2048]); }
                    __syncthreads();
                    if (tid < 64) { const int tl = tid >> 4, s = tid & 15, t = 4 * tq + tl; float sc = 0.f;
#pragma unroll 4
                        for (int dd = 0; dd < 256; ++dd) sc += qf[tl * 260 + dd] * kf[s * 257 + dd];
                        pf[tl * 16 + s] = sc * exp2f(l2g * (float)(t > s ? t - s : s - t)); }
                    __syncthreads();
                    const int e = tid & 255, th = tid >> 8; const float* S0 = a.in[I_SRET] + (size_t)(b * EH + h) * 65536;
                    float oc[2] = {0.f, 0.f};
#pragma unroll 4
                    for (int dd = 0; dd < 256; dd += 4) { const f32x4 qa = *(const f32x4*)(qf + (2 * th) * 260 + dd), qb = *(const f32x4*)(qf + (2 * th + 1) * 260 + dd);
                        const float s0 = S0[(size_t)dd * 256 + e], s1 = S0[(size_t)(dd + 1) * 256 + e], s2 = S0[(size_t)(dd + 2) * 256 + e], s3 = S0[(size_t)(dd + 3) * 256 + e];
                        oc[0] += qa.x * s0 + qa.y * s1 + qa.z * s2 + qa.w * s3; oc[1] += qb.x * s0 + qb.y * s1 + qb.z * s2 + qb.w * s3; }
#pragma unroll
                    for (int tt = 0; tt < 2; ++tt) { const int tl = 2 * th + tt, t = 4 * tq + tl; float v = oc[tt] * exp2f(l2g * (float)(t + 1));
#pragma unroll 4
                        for (int s = 0; s < 16; ++s) v += pf[tl * 16 + s] * vf[s * 257 + e];
                        oc[tt] = v; }
                    { const float g16 = exp2f(16.f * l2g); float* dst = out + O_RTS + (size_t)(b * EH + h) * 65536; float vd[16];
#pragma unroll
                        for (int t = 0; t < 16; ++t) vd[t] = vf[t * 257 + e] * exp2f(l2g * (float)(15 - t));
#pragma unroll 4
                        for (int dd = 64 * tq + 32 * th; dd < 64 * tq + 32 * th + 32; ++dd) { float v = g16 * S0[(size_t)dd * 256 + e];
#pragma unroll
                            for (int t = 0; t < 16; ++t) v += kf[t * 257 + dd] * vd[t];
                            dst[(size_t)dd * 256 + e] = v; } }
#pragma unroll
                    for (int tt = 0; tt < 2; ++tt) { const float s1 = wave_sum(oc[tt]), s2 = wave_sum(oc[tt] * oc[tt]); if (lane == 0) { const int tl = 2 * th + tt; red[(tl * 4 + (wave & 3)) * 2] = s1; red[(tl * 4 + (wave & 3)) * 2 + 1] = s2; } }
                    __syncthreads();
                    const float lw = a.in[I_ELW][h * 256 + e], lb = a.in[I_ELB][h * 256 + e];
#pragma unroll
                    for (int tt = 0; tt < 2; ++tt) { const int tl = 2 * th + tt, t = 4 * tq + tl; float s1 = 0.f, s2 = 0.f;
#pragma unroll
                        for (int w4 = 0; w4 < 4; ++w4) { s1 += red[(tl * 4 + w4) * 2]; s2 += red[(tl * 4 + w4) * 2 + 1]; }
                        const float mean = s1 * (1.f / 256.f), var = s2 * (1.f / 256.f) - mean * mean, rstd = rsqrtf(var + 1e-5f);
                        const float gt = bf2f(QKVG[(size_t)(m0 + t) * EC + 3072 + h * 256 + e]);
                        MIX[(size_t)(m0 + t) * D + RW + h * 256 + e] = (bf16)f2bf(((oc[tt] - mean) * rstd * lw + lb) * gt * sigm(gt)); }
                }
#else
                {}
#endif
            }
        }
    }
    if (IN(8)) MID(9);
    SEAM(8);
    if (IN(9)) for (int rep = 0; rep < (DUP_PHASE == 9 ? 2 : 1); ++rep) {
        { pg8::Gemm g{MIX, WOUTT, TP, D, D, D}; pg8::StaticOrder S; S.init(TP, D, G, bid); EpiF32 E{MIXOUT, D};
          pg8::gemm_phase<EpiF32, pg8::StaticOrder, true, true>((PG8_LAS unsigned char*)lds, g, S, E); }
        { const int sl = bid >> 3; pg8::Gemm g{MIX + (size_t)TP * D + sl * 512, WOUTT + sl * 512, MS, D, 512, D}; pg8::OneUnit S{0, bid & 7, bid < 8 * KS9}; EpiF32 E{(float*)(ws + WS_PART9) + (size_t)sl * MS * D, D};
          pg8::gemm_phase<EpiF32, pg8::OneUnit, false, true>((PG8_LAS unsigned char*)lds, g, S, E); }
    }
    SEAM(9);
    if (IN(10)) for (int rep = 0; rep < (DUP_PHASE == 10 ? 2 : 1); ++rep) {
        for (int m = gw; m < M; m += NGW) {
            const float* xr = m < TP ? a.in[I_XP] + (size_t)m * D : a.in[I_XS] + (size_t)(m - TP) * D; const float* mod = MOD + seq_of(m) * MODW; const float* mr = MIXOUT + (size_t)m * D;
            f32x4 v[8]; float ss = 0.f;
#pragma unroll
            for (int j = 0; j < 8; ++j) {
                if (m < TP) v[j] = *(const f32x4*)(mr + 4 * lane + 256 * j);
                else { const float* pr = (const float*)(ws + WS_PART9) + (size_t)(m - TP) * D + 4 * lane + 256 * j; v[j] = *(const f32x4*)pr;
#pragma unroll
                    for (int q = 1; q < KS9; ++q) v[j] += *(const f32x4*)(pr + (size_t)q * MS * D); }
                ss += (v[j].x * v[j].x + v[j].y * v[j].y) + (v[j].z * v[j].z + v[j].w * v[j].w); }
            const float rs = rsqrtf(wave_sum(ss) * (1.f / D) + 1e-6f); float s2 = 0.f;
#pragma unroll
            for (int j = 0; j < 8; ++j) { const int c = 4 * lane + 256 * j; const f32x4 g = *(const f32x4*)(a.in[I_GPOM] + c), gt = *(const f32x4*)(mod + 2 * D + c), x = *(const f32x4*)(xr + c);
                v[j] = x + gt * (v[j] * rs * g); *(f32x4*)(out + (size_t)m * D + c) = v[j]; s2 += (v[j].x * v[j].x + v[j].y * v[j].y) + (v[j].z * v[j].z + v[j].w * v[j].w); }
            const float rs2 = rsqrtf(wave_sum(s2) * (1.f / D) + 1e-6f);
#pragma unroll
            for (int j = 0; j < 8; ++j) { const int c = 4 * lane + 256 * j; const f32x4 g = *(const f32x4*)(a.in[I_GPF] + c), s1 = *(const f32x4*)(mod + 4 * D + c), h1 = *(const f32x4*)(mod + 3 * D + c);
                const f32x4 h = v[j] * rs2 * g * (s1 + 1.f) + h1; u32x2 w; w.x = pk2(h.x, h.y); w.y = pk2(h.z, h.w); *(u32x2*)(H + (size_t)m * D + c) = w; }
        }
        float* scr = (float*)lds + wave * (64 * 33 + 16);
        constexpr int IT_UP = (D / 64) * (2 * FF / 32), IT_DN = (FF / 64) * (D / 32);
        for (int it = gw; it < IT_UP + IT_DN; it += NGW) {
            if (it < IT_UP) { const int nb = 2 * FF / 32, kb = it / nb, n0 = 32 * (it % nb); const int nn = n0 < FF ? n0 : n0 - FF; const int dr = 256 * (nn >> 7) + (n0 < FF ? 0 : 128) + (nn & 127);
                transpose_item(a.in[I_WUP], D, 2 * FF, WUPT, 64 * kb, n0, dr, scr, lane); }
            else { const int r = it - IT_UP, nb = D / 32, kb = r / nb, n0 = 32 * (r % nb); transpose_item(a.in[I_WDN], FF, D, WDNT, 64 * kb, n0, n0, scr, lane); }
        }
    }
    SEAM(10);
    if (IN(11)) for (int rep = 0; rep < (DUP_PHASE == 11 ? 2 : 1); ++rep) {
        pg8::Gemm g{H, WUPT, M, 2 * FF, D, D}; pg8::StaticOrder S; S.init(M, 2 * FF, G, bid); EpiSwiglu E{ACT};
        pg8::gemm_phase<EpiSwiglu, pg8::StaticOrder, true, true>((PG8_LAS unsigned char*)lds, g, S, E);
    }
    SEAM(11);
    if (IN(12)) for (int rep = 0; rep < (DUP_PHASE == 12 ? 2 : 1); ++rep) {
        { pg8::Gemm g{ACT, WDNT, TP, D, FF, FF}; pg8::StaticOrder S; S.init(TP, D, G, bid); EpiF32 E{MIXOUT, D};
          pg8::gemm_phase<EpiF32, pg8::StaticOrder, true, true>((PG8_LAS unsigned char*)lds, g, S, E); }
        { const int sl = bid >> 3; pg8::Gemm g{ACT + (size_t)TP * FF + sl * 512, WDNT + sl * 512, MS, D, 512, FF}; pg8::OneUnit S{0, bid & 7, bid < 8 * KS12}; EpiF32 E{(float*)(ws + WS_PART12) + (size_t)sl * MS * D, D};
          pg8::gemm_phase<EpiF32, pg8::OneUnit, false, true>((PG8_LAS unsigned char*)lds, g, S, E); }
    }
    SEAM(12);
    if (IN(13)) for (int rep = 0; rep < (DUP_PHASE == 13 ? 2 : 1); ++rep) {
        for (int m = gw; m < M; m += NGW) {
            const float* mod = MOD + seq_of(m) * MODW; const float* fr_ = MIXOUT + (size_t)m * D;
            f32x4 v[8]; float ss = 0.f;
#pragma unroll
            for (int j = 0; j < 8; ++j) {
                if (m < TP) v[j] = *(const f32x4*)(fr_ + 4 * lane + 256 * j);
                else { const float* pr = (const float*)(ws + WS_PART12) + (size_t)(m - TP) * D + 4 * lane + 256 * j; v[j] = *(const f32x4*)pr;
#pragma unroll
                    for (int q = 1; q < KS12; ++q) v[j] += *(const f32x4*)(pr + (size_t)q * MS * D); }
                ss += (v[j].x * v[j].x + v[j].y * v[j].y) + (v[j].z * v[j].z + v[j].w * v[j].w); }
            const float rs = rsqrtf(wave_sum(ss) * (1.f / D) + 1e-6f);
#pragma unroll
            for (int j = 0; j < 8; ++j) { const int c = 4 * lane + 256 * j; const f32x4 g = *(const f32x4*)(a.in[I_GPOF] + c), gt = *(const f32x4*)(mod + 5 * D + c), x = *(const f32x4*)(out + (size_t)m * D + c);
                *(f32x4*)(out + (size_t)m * D + c) = x + gt * (v[j] * rs * g); }
        }
    }
    if (TS_PROBE >= 0) {
        xcd_barrier(xb);
        if (bid == 0 && tid == 0) TSW[14] = __builtin_amdgcn_s_memrealtime();
        if (bid == 0) { __syncthreads(); const float us = TS_PROBE >= 100 ? (float)(TSW[32 + TS_PROBE - 100] - TSW[32 + TS_PROBE - 101]) * 0.01f : (float)(TSW[1 + TS_PROBE] - TSW[TS_PROBE]) * 0.01f; const float eps = sqrtf(us * 1e-4f);
            for (int c = tid; c < RC; c += 512) out[O_SHP + c] *= (1.f + eps); }
    }
#undef IN
#undef SEAM
}

extern "C" void kernel_launch(void* const* d_in, const int* in_sizes, int n_in, void* d_out, int out_size, void* d_ws, size_t ws_size, hipStream_t stream) {
    static int grid = 0;
    if (grid == 0) {
        if (n_in != 30 || (size_t)out_size != O_END || ws_size < WS_END) { fprintf(stderr, "kernel_launch: unexpected sizes n_in %d out %d ws %zu\n", n_in, out_size, ws_size); grid = -1; return; }
        int dev = 0, cus = 0, per_cu = 0;
        (void)hipGetDevice(&dev); (void)hipDeviceGetAttribute(&cus, hipDeviceAttributeMultiprocessorCount, dev);
        if (hipFuncSetAttribute((const void*)mk_fwd, hipFuncAttributeMaxDynamicSharedMemorySize, LDS_BYTES) != hipSuccess) { fprintf(stderr, "kernel_launch: hipFuncSetAttribute failed\n"); grid = -1; return; }
        if (hipOccupancyMaxActiveBlocksPerMultiprocessor(&per_cu, (const void*)mk_fwd, 512, LDS_BYTES) != hipSuccess || per_cu < 1) { fprintf(stderr, "kernel_launch: occupancy query says %d\n", per_cu); per_cu = 1; }
        (void)hipGetLastError();
        grid = cus;
        if (grid <= 0) grid = 256;
    }
    if (grid < 0) return;
    (void)hipMemsetAsync((char*)d_ws + 65536, 0, XCD_BAR_WORDS * 4 + 512, stream);
    Args a{};
    for (int i = 0; i < 30; ++i) a.in[i] = (const float*)d_in[i];
    a.out = (float*)d_out; a.ws = (unsigned char*)d_ws;
    a.ph_lo = 0; a.ph_hi = NPHASE;
    void* args[] = {&a};
    hipError_t e = hipLaunchCooperativeKernel((const void*)mk_fwd, dim3(grid), dim3(512), args, LDS_BYTES, stream);
    if (e != hipSuccess) fprintf(stderr, "kernel_launch: cooperative launch failed: %s (grid %d)\n", hipGetErrorString(e), grid);
}
```

```cpp
#include <hip/hip_runtime.h>
#include <hip/hip_cooperative_groups.h>
#include <cstdio>
#include <cstdint>
namespace cg = cooperative_groups;
namespace pg8 {
#define PG8_LAS __attribute__((address_space(3)))
typedef unsigned short bf16_t;
typedef short bf16x8 __attribute__((ext_vector_type(8)));
typedef float f32x4 __attribute__((ext_vector_type(4)));
typedef unsigned u32x4 __attribute__((ext_vector_type(4)));
constexpr int BM = 256, BK = 64, HALF = 128, HTB = HALF * BK * 2  , STAGE_BYTES = 8 * HTB, NXCD = 8, WGM = 8;

__host__ __device__ __forceinline__ int lds_byte(int r, int c) { const int st = (r >> 4) * 2 + (c >> 5), rr = r & 15, cc = c & 31, ob = rr * 64 + cc * 2; return st * 1024 + (ob ^ (((ob >> 9) & 1) << 5)); }
__host__ __device__ __forceinline__ void stage_rc(int b, int& R, int& C) { const int st = b / 1024, sb = b % 1024, swz = sb ^ (((sb >> 9) & 1) << 5); R = (st >> 1) * 16 + swz / 64; C = (st & 1) * 32 + (swz % 64) / 2; }
__host__ __device__ __forceinline__ int perm32(int rho) { const int n = rho >> 4, i = rho & 15; return 8 * (i >> 2) + 4 * n + (i & 3); }

struct Unit { int pm, pn; };
struct Gemm { const bf16_t* A; const bf16_t* Bt; int M, N, K, ld; };

struct OneUnit {
    int pm, pn; bool active;
    __device__ __forceinline__ bool next(int i, Unit& u) const { if (i > 0 || !active) return false; u.pm = pm; u.pn = pn; return true; }
    __device__ __forceinline__ void a_ready(const Unit&) const {}
    __device__ __forceinline__ void done(const Unit&) const {}
};
struct StaticOrder {
    int nM, nN, nwg, G, c;
    __host__ __device__ void init(int M, int N, int G_, int c_) { nM = M / BM; nN = N / BM; nwg = nM * nN; G = G_; c = c_; }
    __host__ __device__ bool next(int i, Unit& u) const {
        const long L = (long)i * G + c; if (L >= nwg) return false;
        int wgid = (int)L; { const int q = nwg / NXCD, r = nwg % NXCD, xcd = wgid % NXCD, off = wgid / NXCD; wgid = (xcd < r ? xcd * (q + 1) : r * (q + 1) + (xcd - r) * q) + off; }
        const int nig = WGM * nN, gid = wgid / nig, fm = gid * WGM, gsz = (nM - fm) < WGM ? (nM - fm) : WGM;
        u.pm = fm + ((wgid % nig) % gsz); u.pn = (wgid % nig) / gsz; return true;
    }
    __device__ __forceinline__ void a_ready(const Unit&) const {}
    __device__ __forceinline__ void done(const Unit&) const {}
};

__device__ __forceinline__ unsigned cvt_pk_bf16(float lo, float hi) { unsigned r; asm volatile("v_cvt_pk_bf16_f32 %0, %1, %2" : "=v"(r) : "v"(lo), "v"(hi)); return r; }
template <class Epi, class Sched, bool ALIGN_EPI = false, bool SP2 = false>
__device__ __forceinline__ void gemm_phase(PG8_LAS unsigned char* lds, const Gemm g, const Sched& S, const Epi& E) {
    const int tid = threadIdx.x, wid = __builtin_amdgcn_readfirstlane(tid >> 6), lane = tid & 63, wr = wid >> 2, wc = wid & 3, fr = lane & 15, fq = lane >> 4;
    const int K = g.K, nt = K / BK;
    unsigned voffA[2], voffB[2];
#pragma unroll
    for (int i = 0; i < 2; ++i) { int R, C; stage_rc(tid * 16 + i * 8192, R, C); const int Rb = Epi::PERM ? ((R & ~31) + perm32(R & 31)) : R;
        voffA[i] = (unsigned)(R * g.ld + C) * 2u; voffB[i] = (unsigned)(Rb * g.ld + C) * 2u; }
    const size_t kstep = (size_t)(BK * 2);
    const size_t hstep = (size_t)HALF * g.ld * 2;
    const size_t tstep = 2 * hstep;
    const unsigned ldsw = (unsigned)wid * 1024u;
    const int aoff = lds_byte(wr * 64 + fr, fq * 8), boff = lds_byte(wc * 32 + fr, fq * 8);
#define PG8_SA(b, h) (((b) * 2 + (h)) * HTB)
#define PG8_SB(b, h) ((4 + (b) * 2 + (h)) * HTB)
#define PG8_STAGE(bufoff, gbase, voff) do { _Pragma("unroll") for (int _i = 0; _i < 2; ++_i) \
        __builtin_amdgcn_global_load_lds((const unsigned*)((const char*)(gbase) + (voff)[_i]), (PG8_LAS unsigned*)(lds + (bufoff) + ldsw + _i * 8192), 16, 0, 0); } while (0)
#define PG8_LDA(dst, b, h) do { _Pragma("unroll") for (int m = 0; m < 4; ++m) _Pragma("unroll") for (int k = 0; k < 2; ++k) dst[m][k] = *(const PG8_LAS bf16x8*)(lds + PG8_SA(b, h) + aoff + m * 2048 + k * 1024); } while (0)
#define PG8_LDB(dst, b, h) do { _Pragma("unroll") for (int n = 0; n < 2; ++n) _Pragma("unroll") for (int k = 0; k < 2; ++k) dst[n][k] = *(const PG8_LAS bf16x8*)(lds + PG8_SB(b, h) + boff + n * 2048 + k * 1024); } while (0)
#define PG8_MMA(ai, bj, At, Bt) do { __builtin_amdgcn_s_setprio(1); _Pragma("unroll") for (int m = 0; m < 4; ++m) _Pragma("unroll") for (int n = 0; n < 2; ++n) _Pragma("unroll") for (int k = 0; k < 2; ++k) \
        acc[ai][bj][m][n] = __builtin_amdgcn_mfma_f32_16x16x32_bf16(Bt[n][k], At[m][k], acc[ai][bj][m][n], 0, 0, 0); __builtin_amdgcn_s_setprio(0); } while (0)
#define PG8_WAIT_V(n) asm volatile("s_waitcnt vmcnt(" #n ")" ::: "memory")
#define PG8_WAIT_L(n) asm volatile("s_waitcnt lgkmcnt(" #n ")" ::: "memory")
#define PG8_BAR __builtin_amdgcn_s_barrier()
#define PG8_SCHED __builtin_amdgcn_sched_barrier(0)
    Unit cur, nxt; int ui = 0;
    if (!S.next(0, cur)) return;
    f32x4 acc[2][2][4][2];
#pragma unroll
    for (int a = 0; a < 2; ++a)
#pragma unroll
        for (int b = 0; b < 2; ++b)
#pragma unroll
            for (int m = 0; m < 4; ++m)
#pragma unroll
                for (int n = 0; n < 2; ++n) acc[a][b][m][n] = (f32x4){0.f, 0.f, 0.f, 0.f};
    bf16x8 At[4][2], B0[2][2], B1[2][2];
    const char* cA = (const char*)g.A + (size_t)cur.pm * tstep; const char* cB = (const char*)g.Bt + (size_t)cur.pn * tstep;
    S.a_ready(cur);
    if constexpr (SP2) {
        PG8_STAGE(PG8_SB(0, 0), cB, voffB); PG8_STAGE(PG8_SB(0, 1), cB + hstep, voffB); PG8_STAGE(PG8_SA(0, 0), cA, voffA); PG8_STAGE(PG8_SA(0, 1), cA + hstep, voffA);
        if (wr == 1) PG8_BAR;
        PG8_WAIT_V(2); PG8_BAR;
        PG8_STAGE(PG8_SB(1, 0), cB + kstep, voffB); PG8_STAGE(PG8_SA(1, 0), cA + kstep, voffA); PG8_STAGE(PG8_SB(1, 1), cB + hstep + kstep, voffB);
        PG8_WAIT_V(6); PG8_BAR;
    } else {
        PG8_STAGE(PG8_SB(0, 0), cB, voffB); PG8_STAGE(PG8_SA(0, 0), cA, voffA); PG8_STAGE(PG8_SB(0, 1), cB + hstep, voffB); PG8_STAGE(PG8_SA(0, 1), cA + hstep, voffA);
        if (wr == 1) PG8_BAR;
        PG8_WAIT_V(4); PG8_BAR;
        PG8_STAGE(PG8_SB(1, 0), cB + kstep, voffB); PG8_STAGE(PG8_SA(1, 0), cA + kstep, voffA); PG8_STAGE(PG8_SB(1, 1), cB + hstep + kstep, voffB);
        PG8_WAIT_V(6); PG8_BAR;
    }
    for (;;) {
        const bool has_next = S.next(ui + 1, nxt);
        const char* nA = has_next ? (const char*)g.A + (size_t)nxt.pm * tstep : cA; const char* nB = has_next ? (const char*)g.Bt + (size_t)nxt.pn * tstep : cB;
        for (int t = 0; t < nt; t += 2) {
            const bool last = (t == nt - 2);
            const char* a1 = cA + (size_t)(t + 1) * kstep;
            const char* a2 = last ? nA : cA + (size_t)(t + 2) * kstep; const char* b2 = last ? nB : cB + (size_t)(t + 2) * kstep;
            const char* a3 = a2 + kstep; const char* b3 = b2 + kstep;
            if (last && has_next) S.a_ready(nxt);
            if constexpr (SP2) {
            PG8_LDB(B0, 0, 0); PG8_LDB(B1, 0, 1); PG8_SCHED; PG8_LDA(At, 0, 0); PG8_STAGE(PG8_SA(1, 1), a1 + hstep, voffA);
            PG8_WAIT_V(8); PG8_WAIT_L(0); PG8_BAR; PG8_MMA(0, 0, At, B0); PG8_MMA(0, 1, At, B1); PG8_BAR; PG8_SCHED;
            PG8_LDA(At, 0, 1); PG8_STAGE(PG8_SB(0, 0), b2, voffB); PG8_STAGE(PG8_SB(0, 1), b2 + hstep, voffB); PG8_STAGE(PG8_SA(0, 0), a2, voffA);
            PG8_WAIT_V(8); PG8_WAIT_L(0); PG8_BAR; PG8_MMA(1, 0, At, B0); PG8_MMA(1, 1, At, B1); PG8_BAR; PG8_SCHED;
            PG8_LDB(B0, 1, 0); PG8_LDB(B1, 1, 1); PG8_SCHED; PG8_LDA(At, 1, 0); PG8_STAGE(PG8_SA(0, 1), a2 + hstep, voffA);
            PG8_WAIT_V(8); PG8_WAIT_L(0); PG8_BAR; PG8_MMA(0, 0, At, B0); PG8_MMA(0, 1, At, B1); PG8_BAR; PG8_SCHED;
            PG8_LDA(At, 1, 1); PG8_STAGE(PG8_SB(1, 0), b3, voffB); PG8_STAGE(PG8_SB(1, 1), b3 + hstep, voffB); PG8_STAGE(PG8_SA(1, 0), a3, voffA);
            PG8_WAIT_V(8); PG8_WAIT_L(0); PG8_BAR; PG8_MMA(1, 0, At, B0); PG8_MMA(1, 1, At, B1); PG8_BAR; PG8_SCHED;
            } else {
            PG8_LDB(B0, 0, 0); PG8_SCHED; PG8_LDA(At, 0, 0); PG8_STAGE(PG8_SA(1, 1), a1 + hstep, voffA);
            PG8_WAIT_L(8); PG8_BAR; PG8_WAIT_L(0); PG8_MMA(0, 0, At, B0); PG8_BAR; PG8_SCHED;
            PG8_LDB(B1, 0, 1); PG8_STAGE(PG8_SB(0, 0), b2, voffB);
            PG8_BAR; PG8_WAIT_L(0); PG8_MMA(0, 1, At, B1); PG8_BAR;
            PG8_LDA(At, 0, 1); PG8_STAGE(PG8_SA(0, 0), a2, voffA);
            PG8_BAR; PG8_WAIT_L(0); PG8_MMA(1, 0, At, B0); PG8_BAR; PG8_SCHED;
            PG8_STAGE(PG8_SB(0, 1), b2 + hstep, voffB);
            PG8_WAIT_V(6); PG8_BAR; PG8_MMA(1, 1, At, B1); PG8_BAR;
            PG8_LDB(B0, 1, 0); PG8_SCHED; PG8_LDA(At, 1, 0); PG8_STAGE(PG8_SA(0, 1), a2 + hstep, voffA);
            PG8_WAIT_L(8); PG8_BAR; PG8_WAIT_L(0); PG8_MMA(0, 0, At, B0); PG8_BAR; PG8_SCHED;
            PG8_LDB(B1, 1, 1); PG8_STAGE(PG8_SB(1, 0), b3, voffB);
            PG8_BAR; PG8_WAIT_L(0); PG8_MMA(0, 1, At, B1); PG8_BAR;
            PG8_LDA(At, 1, 1); PG8_STAGE(PG8_SA(1, 0), a3, voffA);
            PG8_BAR; PG8_WAIT_L(0); PG8_MMA(1, 0, At, B0); PG8_BAR; PG8_SCHED;
            PG8_STAGE(PG8_SB(1, 1), b3 + hstep, voffB);
            PG8_WAIT_V(6); PG8_BAR; PG8_MMA(1, 1, At, B1); PG8_BAR;
            }
        }
        if constexpr (ALIGN_EPI) { if (wr == 0) PG8_BAR; }
        if constexpr (!Epi::AFTER_DRAIN) { E(acc, cur, wr, wc, fr, fq); S.done(cur); }
        if (!has_next) break;
#pragma unroll
        for (int a = 0; a < 2; ++a)
#pragma unroll
            for (int b = 0; b < 2; ++b)
#pragma unroll
                for (int m = 0; m < 4; ++m)
#pragma unroll
                    for (int n = 0; n < 2; ++n) acc[a][b][m][n] = (f32x4){0.f, 0.f, 0.f, 0.f};
        cur = nxt; cA = nA; cB = nB; ++ui;
        if constexpr (ALIGN_EPI) { if (wr == 1) PG8_BAR; }
    }
    PG8_WAIT_V(0);
    if constexpr (!ALIGN_EPI) { if (wr == 0) PG8_BAR; }
    PG8_BAR;
    if constexpr (Epi::AFTER_DRAIN) { E.fused(acc, cur, wr, wc, fr, fq, lds, wid, lane); S.done(cur); }
#undef PG8_SA
#undef PG8_SB
#undef PG8_STAGE
#undef PG8_LDA
#undef PG8_LDB
#undef PG8_MMA
#undef PG8_WAIT_V
#undef PG8_WAIT_L
#undef PG8_BAR
#undef PG8_SCHED
}
}

constexpr int D = 2048, TP = 8192, NB = 16, TS = 16, MS = NB * TS, M = TP + MS;
constexpr int RW = 1024, RH = 16, RN = 64, RC = 3328;
constexpr int ED = 1024, EH = 4, EN = 256, EC = 4096, IC = RC + EC;
constexpr int FF = 5632, NSEQ = 17, MODW = 6 * D;
constexpr int LCH = 128, NCH = TP / LCH;
constexpr int RBLK = 256, NRB = TP / RBLK;
constexpr int NPHASE = 14;
constexpr size_t O_Y = 0, O_SHP = (size_t)M * D, O_WKP = O_SHP + RC, O_RTP = O_WKP + 65536, O_SHS = O_RTP + 262144, O_WKS = O_SHS + (size_t)NB * RC, O_RTS = O_WKS + (size_t)NB * 65536, O_END = O_RTS + (size_t)NB * 262144;
constexpr size_t MiB = 1u << 20;
constexpr size_t WS_MOD = 1 * MiB, WS_LORAT = 2 * MiB, WS_WOUTT = 4 * MiB, WS_WINT = 12 * MiB, WS_V = 12 * MiB, WS_H = 41 * MiB, WS_G = 41 * MiB, WS_BON = 58 * MiB,
                 WS_QKVG = 74 * MiB, WS_LOUT = 140 * MiB, WS_PU = 140 * MiB, WS_KVB = 172 * MiB, WS_ACT = 74 * MiB, WS_PREP = 190 * MiB, WS_MIXOUT = 190 * MiB,
                 WS_WUPT = 256 * MiB, WS_WDNT = 300 * MiB, WS_PART9 = 330 * MiB, WS_PART12 = 256 * MiB, WS_END = 355 * MiB;
constexpr size_t WS_ADAT = 190 * MiB, WS_SC = 239 * MiB, WS_MODP = 240 * MiB;
constexpr int KS9 = 4, KS12 = 11;
constexpr size_t PREP_STRIDE = 33 * MiB;
constexpr size_t DO_Z = 0, DO_LIN = 54 * MiB, DO_SPREV = 0, DO_MIX = 17 * MiB;
constexpr int LDS_BYTES = 147456;

typedef unsigned short bf16;
typedef float f32x2 __attribute__((ext_vector_type(2)));
typedef float f32x4 __attribute__((ext_vector_type(4)));
typedef short bf16x8 __attribute__((ext_vector_type(8)));
typedef unsigned u32x4 __attribute__((ext_vector_type(4)));
typedef unsigned u32x2 __attribute__((ext_vector_type(2)));
#define LDS_WAIT() asm volatile("s_waitcnt lgkmcnt(0)" ::: "memory")

__device__ __forceinline__ float bf2f(unsigned v) { return __builtin_bit_cast(float, v << 16); }
__device__ __forceinline__ unsigned f2bf(float f) { unsigned u = __builtin_bit_cast(unsigned, f); return (u + 0x7fffu + ((u >> 16) & 1u)) >> 16; }
__device__ __forceinline__ unsigned pk2(float lo, float hi) { return f2bf(lo) | (f2bf(hi) << 16); }
__device__ __forceinline__ float wave_sum(float v) {
#pragma unroll
    for (int o = 1; o < 64; o <<= 1) v += __shfl_xor(v, o);
    return v;
}
__device__ __forceinline__ float sigm(float x) { return 1.f / (1.f + __expf(-x)); }
__device__ __forceinline__ int seq_of(int m) { return m < TP ? 0 : 1 + ((m - TP) >> 4); }
__device__ __forceinline__ int tpos_of(int m) { return m < TP ? m : ((m - TP) & 15); }
__device__ __forceinline__ float ret_l2g(int h) { return __log2f(1.0f - exp2f(-5.0f - (float)h)); }

struct EpiProj {
    static constexpr bool PERM = true, AFTER_DRAIN = false;
    bf16* Z; bf16* Q;
    __device__ __forceinline__ void operator()(const f32x4 (&acc)[2][2][4][2], const pg8::Unit& u, int wr, int wc, int fr, int fq) const {
        const int row0 = u.pm * 256 + wr * 64 + fr, pn = u.pn, cl = wc * 32 + 8 * fq;
        if (pn < 13 || pn >= 21) {
            bf16* base = pn < 13 ? Z + pn * 256 + cl : Q + (pn - 13) * 256 + cl; const size_t ld = pn < 13 ? RC : EC;
#pragma unroll
            for (int ai = 0; ai < 2; ++ai)
#pragma unroll
                for (int m = 0; m < 4; ++m) { bf16* rp = base + (size_t)(row0 + ai * 128 + m * 16) * ld;
#pragma unroll
                    for (int bj = 0; bj < 2; ++bj) { const f32x4 v0 = acc[ai][bj][m][0], v1 = acc[ai][bj][m][1]; u32x4 w; w.x = pk2(v0[0], v0[1]); w.y = pk2(v0[2], v0[3]); w.z = pk2(v1[0], v1[1]); w.w = pk2(v1[2], v1[3]);
                        *(u32x4*)(rp + bj * 128) = w; } }
        } else {
            const int sec = pn - 13; bf16* base = Q + sec * 256 + cl; const float sc = sec >= 4 ? 0.0625f : 1.0f;
            float inv[8];
#pragma unroll
            for (int e = 0; e < 8; ++e) inv[e] = exp2f(-(float)(cl + e) * (13.287712379549449f / 128.0f)) * 0.15915494309189535f;
#pragma unroll
            for (int ai = 0; ai < 2; ++ai)
#pragma unroll
                for (int m = 0; m < 4; ++m) { const int row = row0 + ai * 128 + m * 16; bf16* rp = base + (size_t)row * EC;
                    const float pos = row < TP ? (float)row : (float)(2048 + ((row - TP) & 15));
                    float o1[8], o2[8];
#pragma unroll
                    for (int e = 0; e < 8; ++e) { float rev = pos * inv[e]; rev -= floorf(rev); const float sn = __builtin_amdgcn_sinf(rev), cs = __builtin_amdgcn_cosf(rev);
                        const float x1 = acc[ai][0][m][e >> 2][e & 3], x2 = acc[ai][1][m][e >> 2][e & 3];
                        o1[e] = (x1 * cs - x2 * sn) * sc; o2[e] = (x2 * cs + x1 * sn) * sc; }
                    u32x4 w; w.x = pk2(o1[0], o1[1]); w.y = pk2(o1[2], o1[3]); w.z = pk2(o1[4], o1[5]); w.w = pk2(o1[6], o1[7]); *(u32x4*)rp = w;
                    w.x = pk2(o2[0], o2[1]); w.y = pk2(o2[2], o2[3]); w.z = pk2(o2[4], o2[5]); w.w = pk2(o2[6], o2[7]); *(u32x4*)(rp + 128) = w; }
        }
    }
};
struct EpiBf16P {
    static constexpr bool PERM = true, AFTER_DRAIN = false;
    bf16* C; int ldc;
    __device__ __forceinline__ void operator()(const f32x4 (&acc)[2][2][4][2], const pg8::Unit& u, int wr, int wc, int fr, int fq) const {
        const int row0 = u.pm * 256 + wr * 64 + fr; bf16* base = C + u.pn * 256 + wc * 32 + 8 * fq;
#pragma unroll
        for (int ai = 0; ai < 2; ++ai)
#pragma unroll
            for (int m = 0; m < 4; ++m) { bf16* rp = base + (size_t)(row0 + ai * 128 + m * 16) * ldc;
#pragma unroll
                for (int bj = 0; bj < 2; ++bj) { const f32x4 v0 = acc[ai][bj][m][0], v1 = acc[ai][bj][m][1]; u32x4 w; w.x = pk2(v0[0], v0[1]); w.y = pk2(v0[2], v0[3]); w.z = pk2(v1[0], v1[1]); w.w = pk2(v1[2], v1[3]);
                    *(u32x4*)(rp + bj * 128) = w; } }
    }
};
struct EpiF32 {
    static constexpr bool PERM = true, AFTER_DRAIN = false;
    float* C; int ldc;
    __device__ __forceinline__ void operator()(const f32x4 (&acc)[2][2][4][2], const pg8::Unit& u, int wr, int wc, int fr, int fq) const {
        const int row0 = u.pm * 256 + wr * 64 + fr; float* base = C + u.pn * 256 + wc * 32 + 8 * fq;
#pragma unroll
        for (int ai = 0; ai < 2; ++ai)
#pragma unroll
            for (int m = 0; m < 4; ++m) { float* rp = base + (size_t)(row0 + ai * 128 + m * 16) * ldc;
#pragma unroll
                for (int bj = 0; bj < 2; ++bj) { *(f32x4*)(rp + bj * 128) = acc[ai][bj][m][0]; *(f32x4*)(rp + bj * 128 + 4) = acc[ai][bj][m][1]; } }
    }
};
struct EpiSwiglu {
    static constexpr bool PERM = true, AFTER_DRAIN = false;
    bf16* C;
    __device__ __forceinline__ void operator()(const f32x4 (&acc)[2][2][4][2], const pg8::Unit& u, int wr, int wc, int fr, int fq) const {
        const int row0 = u.pm * 256 + wr * 64 + fr; bf16* base = C + u.pn * 128 + wc * 32 + 8 * fq;
#pragma unroll
        for (int ai = 0; ai < 2; ++ai)
#pragma unroll
            for (int m = 0; m < 4; ++m) { float o[8];
#pragma unroll
                for (int e = 0; e < 8; ++e) { const float g = acc[ai][0][m][e >> 2][e & 3], up = acc[ai][1][m][e >> 2][e & 3]; o[e] = g * sigm(g) * up; }
                u32x4 w; w.x = pk2(o[0], o[1]); w.y = pk2(o[2], o[3]); w.z = pk2(o[4], o[5]); w.w = pk2(o[6], o[7]);
                *(u32x4*)(base + (size_t)(row0 + ai * 128 + m * 16) * FF) = w; }
    }
};
struct EpiMod {
    static constexpr bool PERM = true, AFTER_DRAIN = false;
    float* C; int ldc;
    __device__ __forceinline__ void operator()(const f32x4 (&acc)[2][2][4][2], const pg8::Unit& u, int wr, int wc, int fr, int fq) const {
        if (wr != 0) return;
        float* base = C + u.pn * 256 + wc * 32 + 8 * fq;
#pragma unroll
        for (int m = 0; m < 2; ++m) { const int row = 16 * m + fr; if (row < NSEQ) { float* rp = base + (size_t)row * ldc;
#pragma unroll
            for (int bj = 0; bj < 2; ++bj) { *(f32x4*)(rp + bj * 128) = acc[0][bj][m][0]; *(f32x4*)(rp + bj * 128 + 4) = acc[0][bj][m][1]; } } }
    }
};

__device__ __forceinline__ void transpose_item(const float* __restrict__ W, int K, int N, bf16* WT, int k0, int n0, int dst_row0, float* scr, int lane) {
#pragma unroll 8
    for (int i = 0; i < 32; ++i) { const int kk = 2 * i + (lane >> 5); scr[kk * 33 + (lane & 31)] = W[(size_t)(k0 + kk) * N + n0 + (lane & 31)]; }
    LDS_WAIT();
    const int c = lane & 7;
#pragma unroll
    for (int j = 0; j < 4; ++j) { const int n = (lane >> 3) + 8 * j; const float* s = scr + (8 * c) * 33 + n;
        u32x4 o; o.x = pk2(s[0 * 33], s[1 * 33]); o.y = pk2(s[2 * 33], s[3 * 33]); o.z = pk2(s[4 * 33], s[5 * 33]); o.w = pk2(s[6 * 33], s[7 * 33]);
        *(u32x4*)(WT + (size_t)(dst_row0 + n) * K + k0 + 8 * c) = o; }
    LDS_WAIT();
}

typedef const __attribute__((address_space(4))) f32x2* cf2p;
__device__ __forceinline__ cf2p to_c(const float* p) { return (cf2p)(unsigned long long)p; }
#define DPPF(old, src, ctrl, rmask) __builtin_bit_cast(float, __builtin_amdgcn_update_dpp(__builtin_bit_cast(int, (float)(old)), __builtin_bit_cast(int, (float)(src)), (ctrl), (rmask), 0xF, false))
__device__ __forceinline__ float wave_sum_u(float v) {
    v += DPPF(0.f, v, 0xB1, 0xF); v += DPPF(0.f, v, 0x4E, 0xF); v += DPPF(0.f, v, 0x124, 0xF); v += DPPF(0.f, v, 0x128, 0xF);
    v += DPPF(0.f, v, 0x142, 0xA); v += DPPF(0.f, v, 0x143, 0xC);
    return __builtin_bit_cast(float, __builtin_amdgcn_readlane(__builtin_bit_cast(int, v), 63));
}
constexpr int RW_PF = 6;
template <int MODE>
__device__ __forceinline__ void rwkv_run(f32x2 (&S)[32], const float* W, const float* NKK, const float* B, const float* K, const float* R, const bf16* Vp, int nsteps, int lane,
                                         const bf16* Gp, const float* BONp, bf16* MIXp, float lnw, float lnb) {
    constexpr int NPF = MODE == 2 ? 20 : (MODE == 0 ? 16 : 12);
    const int pa = lane >> 2; const float* pfp = (pa == 0 ? W : pa == 1 ? NKK : pa == 2 ? B : pa == 3 ? K : R) + (lane & 3) * 16;
    float vn = 0.f, gn = 0.f, bn = 0.f;
    if (MODE != 1) vn = bf2f(Vp[lane]);
    if (MODE == 2) { gn = bf2f(Gp[lane]); bn = BONp[0]; }
    if (lane < NPF) {
#pragma unroll
        for (int q = 1; q < RW_PF; ++q) if (q < nsteps) (void)*(volatile const float*)(pfp + (size_t)q * RW);
    }
    for (int t = 0; t < nsteps; ++t) {
        const size_t o = (size_t)t * RW;
        cf2p w = to_c(W + o), nk = to_c(NKK + o), b = to_c(B + o), k = to_c(K + o), r = to_c(R + o);
        const float v = vn, gv = gn, bon = bn;
        { const int t1 = t + 1 < nsteps ? t + 1 : t; const size_t o1 = (size_t)t1 * RW;
          if (MODE != 1) vn = bf2f(Vp[o1 + lane]);
          if (MODE == 2) { gn = bf2f(Gp[o1 + lane]); bn = BONp[(size_t)t1 * 16]; }
          const int tp = t + RW_PF < nsteps ? t + RW_PF : nsteps - 1;
          if (lane < NPF) (void)*(volatile const float*)(pfp + (size_t)tp * RW); }
        f32x2 a0 = {0.f, 0.f}, a1 = {0.f, 0.f};
#pragma unroll
        for (int j = 0; j < 32; j += 2) { a0 = __builtin_elementwise_fma(S[j], nk[j], a0); a1 = __builtin_elementwise_fma(S[j + 1], nk[j + 1], a1); }
        const float sa = (a0.x + a0.y) + (a1.x + a1.y);
        const f32x2 sa2 = {sa, sa}, v2 = {v, v};
        f32x2 o0 = {0.f, 0.f}, o1 = {0.f, 0.f};
#pragma unroll
        for (int j = 0; j < 32; ++j) {
            f32x2 s = S[j] * w[j];
            s = __builtin_elementwise_fma(sa2, b[j], s);
            if (MODE != 1) s = __builtin_elementwise_fma(v2, k[j], s);
            S[j] = s;
            if (MODE == 2) { if (j & 1) o1 = __builtin_elementwise_fma(s, r[j], o1); else o0 = __builtin_elementwise_fma(s, r[j], o0); }
        }
        if (MODE == 2) {
            const float ov = (o0.x + o0.y) + (o1.x + o1.y);
            const float mean = wave_sum_u(ov) * (1.f / 64.f), d = ov - mean, var = wave_sum_u(d * d) * (1.f / 64.f);
            float y = d * rsqrtf(var + 64e-5f) * lnw + lnb;
            y = (y + bon * v) * gv;
            MIXp[(size_t)t * D + lane] = (bf16)f2bf(y);
        }
    }
}

constexpr int RL_B = 8;
template <int MODE> struct RL { static constexpr int NV = MODE == 2 ? 5 : (MODE == 0 ? 4 : 3); static constexpr int REC = NV * 64, BUF = RL_B * REC + (MODE != 1 ? 256 : 0) + (MODE == 2 ? 256 + 16 : 0); };
#define SBAR() __builtin_amdgcn_sched_barrier(0)
template <int MODE>
__device__ __forceinline__ void rwkv_lds(f32x2 (&S)[32], const float* W, const float* NKK, const float* B, const float* K, const float* R, const bf16* Vp, int nsteps, int lane,
                                         const bf16* Gp, const float* BONp, bf16* MIXp, float lnw, float lnb, float* wl) {
    constexpr int NV = RL<MODE>::NV, REC = RL<MODE>::REC;
    const int ls = lane >> 4, lc = (lane & 15) * 4;
    f32x4 st[NV][2]; u32x4 sv = {0u, 0u, 0u, 0u}, sg = {0u, 0u, 0u, 0u}; float sb = 0.f;
#define RL_ISSUE(bt) do { const size_t ob = (size_t)((bt) * RL_B) * RW; \
        _Pragma("unroll") for (int q = 0; q < 2; ++q) { const size_t oo = ob + (size_t)(ls + 4 * q) * RW + lc; \
            st[0][q] = *(const f32x4*)(W + oo); st[1][q] = *(const f32x4*)(NKK + oo); st[2][q] = *(const f32x4*)(B + oo); if (NV >= 4) st[NV >= 4 ? 3 : 0][q] = *(const f32x4*)(K + oo); if (NV == 5) st[NV - 1][q] = *(const f32x4*)(R + oo); } \
        if (MODE != 1) sv = *(const u32x4*)(Vp + ob + (size_t)(lane >> 3) * RW + (lane & 7) * 8); \
        if (MODE == 2) { sg = *(const u32x4*)(Gp + ob + (size_t)(lane >> 3) * RW + (lane & 7) * 8); if (lane < RL_B) sb = BONp[(size_t)((bt) * RL_B + lane) * 16]; } } while (0)
#define RL_COMMIT() do { \
        _Pragma("unroll") for (int q = 0; q < 2; ++q) _Pragma("unroll") for (int v = 0; v < NV; ++v) *(f32x4*)(wl + (ls + 4 * q) * REC + v * 64 + lc) = st[v][q]; \
        if (MODE != 1) *(u32x4*)((bf16*)(wl + RL_B * REC) + (lane >> 3) * 64 + (lane & 7) * 8) = sv; \
        if (MODE == 2) { *(u32x4*)((bf16*)(wl + RL_B * REC + 256) + (lane >> 3) * 64 + (lane & 7) * 8) = sg; if (lane < RL_B) wl[RL_B * REC + 512 + lane] = sb; } } while (0)
    const int nb = nsteps / RL_B;
    RL_ISSUE(0); RL_COMMIT();
    for (int bt = 0; bt < nb; ++bt) {
        if (bt + 1 < nb) RL_ISSUE(bt + 1);
#pragma unroll 1
        for (int s = 0; s < RL_B; ++s) {
            const f32x2* w = (const f32x2*)(wl + s * REC); const f32x2* nk = w + 32; const f32x2* b = w + 64; const f32x2* k = w + 96; const f32x2* r = w + 128;
            float v = 0.f, gv = 0.f, bon = 0.f;
            if (MODE != 1) v = bf2f(((const bf16*)(wl + RL_B * REC))[s * 64 + lane]);
            if (MODE == 2) { gv = bf2f(((const bf16*)(wl + RL_B * REC + 256))[s * 64 + lane]); bon = wl[RL_B * REC + 512 + s]; }
            f32x2 nA[8], nB[8]; f32x2 a0 = {0.f, 0.f}, a1 = {0.f, 0.f};
#pragma unroll
            for (int p = 0; p < 8; ++p) nA[p] = nk[p];
#pragma unroll
            for (int g = 0; g < 4; ++g) {
                if (g < 3) {
#pragma unroll
                    for (int p = 0; p < 8; ++p) { if (g & 1) nA[p] = nk[8 * (g + 1) + p]; else nB[p] = nk[8 * (g + 1) + p]; } }
                SBAR();
#pragma unroll
                for (int p = 0; p < 8; p += 2) { a0 = __builtin_elementwise_fma(S[8 * g + p], (g & 1) ? nB[p] : nA[p], a0); a1 = __builtin_elementwise_fma(S[8 * g + p + 1], (g & 1) ? nB[p + 1] : nA[p + 1], a1); }
                SBAR();
            }
            const float sa = (a0.x + a0.y) + (a1.x + a1.y);
            const f32x2 sa2 = {sa, sa}, v2 = {v, v};
            f32x2 uw[2][4], ub[2][4], uk[2][4], ur[2][4]; f32x2 o0 = {0.f, 0.f}, o1 = {0.f, 0.f};
#pragma unroll
            for (int p = 0; p < 4; ++p) { uw[0][p] = w[p]; ub[0][p] = b[p]; if (MODE != 1) uk[0][p] = k[p]; if (MODE == 2) ur[0][p] = r[p]; }
#pragma unroll
            for (int g = 0; g < 8; ++g) {
                if (g < 7) {
#pragma unroll
                    for (int p = 0; p < 4; ++p) { uw[(g + 1) & 1][p] = w[4 * (g + 1) + p]; ub[(g + 1) & 1][p] = b[4 * (g + 1) + p]; if (MODE != 1) uk[(g + 1) & 1][p] = k[4 * (g + 1) + p]; if (MODE == 2) ur[(g + 1) & 1][p] = r[4 * (g + 1) + p]; } }
                SBAR();
#pragma unroll
                for (int p = 0; p < 4; ++p) { const int j = 4 * g + p;
                    f32x2 x = S[j] * uw[g & 1][p]; x = __builtin_elementwise_fma(sa2, ub[g & 1][p], x); if (MODE != 1) x = __builtin_elementwise_fma(v2, uk[g & 1][p], x); S[j] = x;
                    if (MODE == 2) { if (p & 1) o1 = __builtin_elementwise_fma(x, ur[g & 1][p], o1); else o0 = __builtin_elementwise_fma(x, ur[g & 1][p], o0); } }
                SBAR();
            }
            if (MODE == 2) {
                const float ov = (o0.x + o0.y) + (o1.x + o1.y);
                const float mean = wave_sum_u(ov) * (1.f / 64.f), d = ov - mean, var = wave_sum_u(d * d) * (1.f / 64.f);
                float y = d * rsqrtf(var + 64e-5f) * lnw + lnb;
                y = (y + bon * v) * gv;
                MIXp[(size_t)(bt * RL_B + s) * D + lane] = (bf16)f2bf(y);
            }
        }
        if (bt + 1 < nb) RL_COMMIT();
    }
#undef RL_ISSUE
#undef RL_COMMIT
}
#define LAS __attribute__((address_space(3)))

#define XB_TMO      128
#define XB_XCNT(j)  (256  + 64 * (j))
#define XB_XSUB(j)  (1280 + 64 * (j))
#define XB_XGEN(j)  (2304 + 64 * (j))
#define XB_TOP      3328
#define XB_TOPGEN   3392
#define XCD_BAR_WORDS 3456
#define XB_SPIN_CAP (1u << 18)

__device__ __forceinline__ unsigned xb_ld(unsigned* p)              { return __hip_atomic_load(p, __ATOMIC_RELAXED, __HIP_MEMORY_SCOPE_AGENT); }
__device__ __forceinline__ unsigned xb_add(unsigned* p, unsigned v) { return __hip_atomic_fetch_add(p, v, __ATOMIC_RELAXED, __HIP_MEMORY_SCOPE_AGENT); }
__device__ __forceinline__ unsigned xb_xcc_id() { return (unsigned)__builtin_amdgcn_s_getreg((3 << 11) | 20) & 0xFu; }
#define XB_SPIN(cond, bar) do { unsigned _sp = 0; while (cond) { __builtin_amdgcn_s_sleep(1); \
    if ((++_sp & 255u) == 0u) { if (xb_ld(&(bar)[XB_TMO])) break; if (_sp > XB_SPIN_CAP) { atomicAdd(&(bar)[XB_TMO], 1u); break; } } } } while (0)

struct XcdBarrier {
    unsigned* bar; unsigned x;
    volatile LAS unsigned* st;
};

__device__ __forceinline__ XcdBarrier xcd_barrier_post(unsigned* bar, volatile LAS unsigned* st) {
    XcdBarrier b; b.bar = bar; b.x = xb_xcc_id(); b.st = st;
    if (threadIdx.x == 0) (void)xb_add(&bar[XB_XCNT(b.x)], 1u);
    return b;
}
__device__ __forceinline__ void xcd_barrier_complete(unsigned* bar, unsigned x, unsigned& nloc, unsigned& nx) {
    const unsigned G = gridDim.x * gridDim.y * gridDim.z;
    unsigned sum, cnt, mine, sp = 0u;
    for (;;) {
        sum = 0u; cnt = 0u; mine = 0u;
#pragma unroll
        for (unsigned j = 0; j < 16; ++j) { const unsigned c = xb_ld(&bar[XB_XCNT(j)]); sum += c; cnt += (c > 0u) ? 1u : 0u; mine = (j == x) ? c : mine; }
        if (sum == G) break;
        __builtin_amdgcn_s_sleep(1);
        if ((++sp & 255u) == 0u) { if (xb_ld(&bar[XB_TMO])) break; if (sp > XB_SPIN_CAP) { atomicAdd(&bar[XB_TMO], 1u); break; } }
    }
    nloc = mine > 0u ? mine : 1u; nx = cnt > 0u ? cnt : 1u;
}

__device__ __forceinline__ void xcd_barrier(const XcdBarrier& b) {
    asm volatile("s_waitcnt vmcnt(0)" ::: "memory");
    __syncthreads();
    if (threadIdx.x == 0) {
        unsigned* bar = b.bar;
        __builtin_amdgcn_s_waitcnt(0);
        unsigned nloc = b.st[0], nx = b.st[1];
        if (nloc == 0u) { xcd_barrier_complete(bar, b.x, nloc, nx); b.st[0] = nloc; b.st[1] = nx; }
        const unsigned old = xb_add(&bar[XB_XSUB(b.x)], 1u);
        const unsigned gen = old / nloc;
        if (old + 1u == (gen + 1u) * nloc) {
            __builtin_amdgcn_fence(__ATOMIC_RELEASE, "agent");
            asm volatile("s_waitcnt vmcnt(0)" ::: "memory");
            const unsigned og = xb_add(&bar[XB_TOP], 1u);
            const unsigned tg = og / nx;
            if (og + 1u == (tg + 1u) * nx) xb_add(&bar[XB_TOPGEN], 1u);
            else XB_SPIN(xb_ld(&bar[XB_TOPGEN]) == tg, bar);
            __builtin_amdgcn_fence(__ATOMIC_ACQUIRE, "agent");
            xb_add(&bar[XB_XGEN(b.x)], 1u);
            asm volatile("s_waitcnt vmcnt(0)" ::: "memory");
        } else {
            XB_SPIN(xb_ld(&bar[XB_XGEN(b.x)]) == gen, bar);
            __builtin_amdgcn_fence(__ATOMIC_ACQUIRE, "agent");
            asm volatile("s_waitcnt vmcnt(0)" ::: "memory");
        }
    }
    __syncthreads();
}


struct Args { const float* in[30]; float* out; unsigned char* ws; int ph_lo, ph_hi; };
enum { I_XP = 0, I_XS, I_CP, I_CS, I_SSH, I_SWKV, I_SRET, I_ADAW, I_ADAB, I_GPM, I_GPOM, I_GPF, I_GPOF, I_WIN, I_MU, I_W0, I_W2, I_A0, I_A2, I_G2, I_KK, I_KA, I_RK, I_RLW, I_RLB, I_ELW, I_ELB, I_WOUT, I_WUP, I_WDN };

__global__ void __launch_bounds__(512, 2) mk_fwd(Args a) {
    extern __shared__ __attribute__((aligned(16))) unsigned char lds[];
    cg::grid_group grid = cg::this_grid();
    const int tid = threadIdx.x, lane = tid & 63, wave = __builtin_amdgcn_readfirstlane(tid >> 6);
    const int G = gridDim.x, bid = blockIdx.x, gw = bid * 8 + wave, NGW = G * 8;
    const int lo = a.ph_lo, hi = a.ph_hi;
    volatile LAS unsigned* xst = (volatile LAS unsigned*)((LAS unsigned char*)lds + LDS_BYTES - 16);
    if (tid < 2) xst[tid] = 0u;
    __syncthreads();
    XcdBarrier xb = xcd_barrier_post((unsigned*)(a.ws + 65536), xst);
    unsigned char* ws = a.ws; float* out = a.out; unsigned char* dob = (unsigned char*)a.out;
    float* MOD = (float*)(ws + WS_MOD);
    bf16* LORAT = (bf16*)(ws + WS_LORAT); bf16* WOUTT = (bf16*)(ws + WS_WOUTT); bf16* WINT = (bf16*)(ws + WS_WINT); bf16* WUPT = (bf16*)(ws + WS_WUPT); bf16* WDNT = (bf16*)(ws + WS_WDNT);
    bf16* H = (bf16*)(ws + WS_H); bf16* QKVG = (bf16*)(ws + WS_QKVG); bf16* LOUT = (bf16*)(ws + WS_LOUT); bf16* Z = (bf16*)(dob + DO_Z); bf16* LIN = (bf16*)(dob + DO_LIN);
    float* PW = (float*)(ws + WS_PREP); float* PNKK = (float*)(ws + WS_PREP + PREP_STRIDE); float* PB = (float*)(ws + WS_PREP + 2 * PREP_STRIDE); float* PK = (float*)(ws + WS_PREP + 3 * PREP_STRIDE); float* PR = (float*)(ws + WS_PREP + 4 * PREP_STRIDE);
    bf16* PV = (bf16*)(ws + WS_V); bf16* PG = (bf16*)(ws + WS_G); float* BON = (float*)(ws + WS_BON);
    float* PU = (float*)(ws + WS_PU); bf16* KVB = (bf16*)(ws + WS_KVB); bf16* SPREV = (bf16*)(dob + DO_SPREV); bf16* MIX = (bf16*)(dob + DO_MIX);
    float* MIXOUT = (float*)(ws + WS_MIXOUT); bf16* ACT = (bf16*)(ws + WS_ACT);
#ifndef DUP_PHASE
#define DUP_PHASE -1
#endif
#ifndef PH_MASK
#define PH_MASK 0x3fff
#endif
#define IN(k) (((PH_MASK >> (k)) & 1) && lo <= (k) && (k) < hi)
#ifndef TS_PROBE
#define TS_PROBE -1
#endif
    unsigned long long* TSW = (unsigned long long*)ws;
    if (TS_PROBE >= 0 && bid == 0 && tid == 0) TSW[0] = __builtin_amdgcn_s_memrealtime();
#define MID(n) do { if (TS_PROBE >= 0 && bid == 0) { __syncthreads(); if (tid == 0) TSW[32 + (n)] = __builtin_amdgcn_s_memrealtime(); } } while (0)
#define SEAM(k) do { if (IN(k) && IN((k) + 1)) { if ((k) == 0) grid.sync(); else xcd_barrier(xb); } if (TS_PROBE >= 0 && bid == 0 && tid == 0) TSW[1 + (k)] = __builtin_amdgcn_s_memrealtime(); } while (0)

    if (IN(0)) for (int rep = 0; rep < (DUP_PHASE == 0 ? 2 : 1); ++rep) {
        MID(0);
        float* scr = (float*)lds + wave * (64 * 33 + 16);
        constexpr int IT_WIN = (D / 64) * (IC / 32), IT_WOUT = (D / 64) * (D / 32), IT_ADA = (D / 64) * (MODW / 32);
        bf16* ADAT = (bf16*)(ws + WS_ADAT); bf16* SC = (bf16*)(ws + WS_SC);
        for (int it = gw; it < IT_WIN + IT_WOUT + IT_ADA; it += NGW) {
            if (it < IT_WIN) { const int nb = IC / 32, kb = it / nb, n0 = 32 * (it % nb); transpose_item(a.in[I_WIN], D, IC, WINT, 64 * kb, n0, n0, scr, lane); }
            else if (it < IT_WIN + IT_WOUT) { const int r = it - IT_WIN, nb = D / 32, kb = r / nb, n0 = 32 * (r % nb); transpose_item(a.in[I_WOUT], D, D, WOUTT, 64 * kb, n0, n0, scr, lane); }
            else { const int r = it - IT_WIN - IT_WOUT, nb = MODW / 32, kb = r / nb, n0 = 32 * (r % nb); transpose_item(a.in[I_ADAW], D, MODW, ADAT, 64 * kb, n0, n0, scr, lane); }
        }
        MID(1);
        for (int idx = bid * 512 + tid; idx < 3072 * 256; idx += G * 512) {
            const int n = idx >> 8, k = idx & 255, sec = n >> 10, nn = n & 1023; float v = 0.f;
            if (sec == 0 && k < 64) v = a.in[I_W2][k * RW + nn];
            else if (sec == 1 && k >= 64 && k < 128) v = a.in[I_A2][(k - 64) * RW + nn];
            else if (sec == 2 && k >= 128) v = a.in[I_G2][(k - 128) * RW + nn];
            LORAT[idx] = (bf16)f2bf(v);
        }
        for (int idx = bid * 512 + tid; idx < 256 * D; idx += G * 512) { const int r = idx / D, k = idx % D; float v = 0.f;
            if (r < NSEQ) { const float cv = r == 0 ? a.in[I_CP][k] : a.in[I_CS][(r - 1) * D + k]; v = cv * sigm(cv); }
            SC[idx] = (bf16)f2bf(v); }
        MID(2);
    }
    if (IN(0)) MID(3);
    SEAM(0);
    if (IN(1)) {
        { const int sl = bid / 48; pg8::Gemm g{(const bf16*)(ws + WS_SC) + sl * 512, (const bf16*)(ws + WS_ADAT) + sl * 512, 256, MODW, 512, D}; pg8::OneUnit S{0, bid % 48, bid < 192};
          EpiMod E{(float*)(ws + WS_MODP) + (size_t)sl * NSEQ * MODW, MODW};
          pg8::gemm_phase<EpiMod, pg8::OneUnit, false, true>((PG8_LAS unsigned char*)lds, g, S, E); }
        xcd_barrier(xb);
        const float* MODP = (const float*)(ws + WS_MODP);
        for (int idx = bid * 512 + tid; idx < NSEQ * MODW; idx += G * 512) { float v = a.in[I_ADAB][idx % MODW];
#pragma unroll
            for (int q = 0; q < 4; ++q) v += MODP[(size_t)q * NSEQ * MODW + idx];
            MOD[idx] = v; }
        xcd_barrier(xb);
    }
    if (IN(1)) for (int rep = 0; rep < (DUP_PHASE == 1 ? 2 : 1); ++rep) {
        for (int m = gw; m < M; m += NGW) {
            const float* xr = m < TP ? a.in[I_XP] + (size_t)m * D : a.in[I_XS] + (size_t)(m - TP) * D; const float* mod = MOD + seq_of(m) * MODW;
            f32x4 v[8]; float ss = 0.f;
#pragma unroll
            for (int j = 0; j < 8; ++j) { v[j] = *(const f32x4*)(xr + 4 * lane + 256 * j); ss += (v[j].x * v[j].x + v[j].y * v[j].y) + (v[j].z * v[j].z + v[j].w * v[j].w); }
            const float rs = rsqrtf(wave_sum(ss) * (1.f / D) + 1e-6f);
#pragma unroll
            for (int j = 0; j < 8; ++j) { const int c = 4 * lane + 256 * j; const f32x4 g = *(const f32x4*)(a.in[I_GPM] + c), s1 = *(const f32x4*)(mod + D + c), h1 = *(const f32x4*)(mod + c);
                const f32x4 h = v[j] * rs * g * (s1 + 1.f) + h1; u32x2 w; w.x = pk2(h.x, h.y); w.y = pk2(h.z, h.w); *(u32x2*)(H + (size_t)m * D + c) = w; }
        }
    }
    SEAM(1);
    if (IN(2)) for (int rep = 0; rep < (DUP_PHASE == 2 ? 2 : 1); ++rep) {
        pg8::Gemm g{H, WINT, M, IC, D, D}; pg8::StaticOrder S; S.init(M, IC, G, bid); EpiProj E{Z, QKVG};
        pg8::gemm_phase<EpiProj, pg8::StaticOrder, true, true>((PG8_LAS unsigned char*)lds, g, S, E);
    }
    SEAM(2);
    if (IN(3)) for (int rep = 0; rep < (DUP_PHASE == 3 ? 2 : 1); ++rep) {
        for (int idx = bid * 512 + tid; idx < M * 128; idx += G * 512) {
            const int m = idx >> 7, c2 = (idx & 127) * 2, c = 3072 + c2, tp = tpos_of(m), sq = seq_of(m);
            const unsigned zz = *(const unsigned*)(Z + (size_t)m * RC + c); float z0 = bf2f(zz & 0xffffu), z1 = bf2f(zz >> 16), p0 = 0.f, p1 = 0.f;
            if (tp > 0) { const unsigned pp = *(const unsigned*)(Z + (size_t)(m - 1) * RC + c); p0 = bf2f(pp & 0xffffu); p1 = bf2f(pp >> 16); }
            else if (sq > 0) { p0 = a.in[I_SSH][(size_t)(sq - 1) * RC + c]; p1 = a.in[I_SSH][(size_t)(sq - 1) * RC + c + 1]; }
            z0 = z0 + (p0 - z0) * a.in[I_MU][c]; z1 = z1 + (p1 - z1) * a.in[I_MU][c + 1];
            if (c2 < 64) { z0 = 1.f - 2.f / (__expf(2.f * z0) + 1.f); z1 = 1.f - 2.f / (__expf(2.f * z1) + 1.f); }
            else if (c2 >= 128) { z0 = sigm(z0); z1 = sigm(z1); }
            *(unsigned*)(LIN + (size_t)m * 256 + c2) = pk2(z0, z1);
        }
        for (int idx = bid * 512 + tid; idx < NSEQ * RC; idx += G * 512) { const int s = idx / RC, c = idx % RC; const int m = s == 0 ? TP - 1 : TP + 16 * (s - 1) + 15;
            out[(s == 0 ? O_SHP : O_SHS + (size_t)(s - 1) * RC) + c] = bf2f(Z[(size_t)m * RC + c]); }
    }
    SEAM(3);
    if (IN(4)) for (int rep = 0; rep < (DUP_PHASE == 4 ? 2 : 1); ++rep) {
        int k256 = 256; asm volatile("" : "+s"(k256));
        pg8::Gemm g{LIN, LORAT, M, 3072, k256, k256}; pg8::StaticOrder S; S.init(M, 3072, G, bid); EpiBf16P E{LOUT, 3072};
        pg8::gemm_phase<EpiBf16P, pg8::StaticOrder, true, true>((PG8_LAS unsigned char*)lds, g, S, E);
    }
    SEAM(4);
    if (IN(5)) for (int rep = 0; rep < (DUP_PHASE == 5 ? 2 : 1); ++rep) {
        float* prm = (float*)lds;
        __syncthreads();
        for (int idx = tid; idx < RW; idx += 512) { prm[idx] = a.in[I_MU][idx]; prm[RW + idx] = a.in[I_MU][RW + idx]; prm[2 * RW + idx] = a.in[I_MU][2 * RW + idx]; prm[3 * RW + idx] = a.in[I_W0][idx];
            prm[4 * RW + idx] = a.in[I_A0][idx]; prm[5 * RW + idx] = a.in[I_KK][idx]; prm[6 * RW + idx] = a.in[I_KA][idx]; prm[7 * RW + idx] = a.in[I_RK][idx]; }
        __syncthreads();
        for (int m = gw; m < M; m += NGW) {
            const int tp = tpos_of(m), sq = seq_of(m);
#pragma unroll 1
            for (int hp = 0; hp < 2; ++hp) {
                const int hd = hp * 8 + (lane >> 3), c0 = hd * 64 + (lane & 7) * 8;
                const bf16* zr = Z + (size_t)m * RC + c0; const bf16* lr = LOUT + (size_t)m * 3072 + c0; const float* sh0 = a.in[I_SSH] + (size_t)(sq > 0 ? sq - 1 : 0) * RC + c0;
                float zs[3][8];
#pragma unroll
                for (int q = 0; q < 3; ++q) {
                    const u32x4 ca = *(const u32x4*)(zr + q * RW); float pv[8];
                    if (tp > 0) { const u32x4 pa2 = *(const u32x4*)(zr - RC + q * RW);
#pragma unroll
                        for (int e = 0; e < 4; ++e) { pv[2 * e] = bf2f(pa2[e] & 0xffffu); pv[2 * e + 1] = bf2f(pa2[e] >> 16); } }
                    else if (sq > 0) { const f32x4 f0 = *(const f32x4*)(sh0 + q * RW), f1 = *(const f32x4*)(sh0 + q * RW + 4);
                        pv[0] = f0.x; pv[1] = f0.y; pv[2] = f0.z; pv[3] = f0.w; pv[4] = f1.x; pv[5] = f1.y; pv[6] = f1.z; pv[7] = f1.w; }
                    else {
#pragma unroll
                        for (int e = 0; e < 8; ++e) pv[e] = 0.f; }
                    const float* mu = prm + q * RW + c0;
#pragma unroll
                    for (int e = 0; e < 4; ++e) { const float z0 = bf2f(ca[e] & 0xffffu), z1 = bf2f(ca[e] >> 16);
                        zs[q][2 * e] = z0 + (pv[2 * e] - z0) * mu[2 * e]; zs[q][2 * e + 1] = z1 + (pv[2 * e + 1] - z1) * mu[2 * e + 1]; }
                }
                const u32x4 wa = *(const u32x4*)(lr), aa = *(const u32x4*)(lr + RW), ga = *(const u32x4*)(lr + 2 * RW);
                float wv[8], av[8], kkv[8], k2[8]; float s1 = 0.f, s2 = 0.f;
#pragma unroll
                for (int e = 0; e < 8; ++e) {
                    const float lwv = bf2f((e & 1) ? (wa[e >> 1] >> 16) : (wa[e >> 1] & 0xffffu)), lav = bf2f((e & 1) ? (aa[e >> 1] >> 16) : (aa[e >> 1] & 0xffffu));
                    wv[e] = __expf(-0.6065306597126334f * sigm(prm[3 * RW + c0 + e] + lwv));
                    av[e] = sigm(prm[4 * RW + c0 + e] + lav);
                    kkv[e] = zs[1][e] * prm[5 * RW + c0 + e]; s1 += kkv[e] * kkv[e];
                    k2[e] = zs[1][e] * (1.f + (av[e] - 1.f) * prm[6 * RW + c0 + e]); s2 += zs[0][e] * k2[e] * prm[7 * RW + c0 + e];
                }
                s1 += DPPF(0.f, s1, 0xB1, 0xF); s1 += DPPF(0.f, s1, 0x4E, 0xF); s1 += DPPF(0.f, s1, 0x141, 0xF);
                s2 += DPPF(0.f, s2, 0xB1, 0xF); s2 += DPPF(0.f, s2, 0x4E, 0xF); s2 += DPPF(0.f, s2, 0x141, 0xF);
                const float inrm = 1.f / fmaxf(sqrtf(s1), 1e-12f);
                const size_t o = (size_t)m * RW + c0;
#pragma unroll
                for (int e = 0; e < 2; ++e) {
                    const float k0 = kkv[4 * e] * inrm, k1 = kkv[4 * e + 1] * inrm, k2_ = kkv[4 * e + 2] * inrm, k3 = kkv[4 * e + 3] * inrm;
                    *(f32x4*)(PW + o + 4 * e) = (f32x4){wv[4 * e], wv[4 * e + 1], wv[4 * e + 2], wv[4 * e + 3]};
                    *(f32x4*)(PNKK + o + 4 * e) = (f32x4){-k0, -k1, -k2_, -k3};
                    *(f32x4*)(PB + o + 4 * e) = (f32x4){k0 * av[4 * e], k1 * av[4 * e + 1], k2_ * av[4 * e + 2], k3 * av[4 * e + 3]};
                    *(f32x4*)(PK + o + 4 * e) = (f32x4){k2[4 * e], k2[4 * e + 1], k2[4 * e + 2], k2[4 * e + 3]};
                    *(f32x4*)(PR + o + 4 * e) = (f32x4){zs[0][4 * e], zs[0][4 * e + 1], zs[0][4 * e + 2], zs[0][4 * e + 3]};
                }
                { u32x4 va;
#pragma unroll
                  for (int e = 0; e < 4; ++e) va[e] = pk2(zs[2][2 * e], zs[2][2 * e + 1]);
                  *(u32x4*)(PV + o) = va; *(u32x4*)(PG + o) = ga; }
                if ((lane & 7) == 0) BON[m * 16 + hd] = s2;
            }
        }
    }
    SEAM(5);
    if (IN(6)) for (int rep = 0; rep < (DUP_PHASE == 6 ? 2 : 1); ++rep) {
        MID(4);
        {
            float* wl = (float*)lds + wave * RL<0>::BUF;
            for (int task = gw; task < RH * NCH * 2; task += NGW) {
                const int part = task & 1, pair = task >> 1, h = pair / NCH, c = pair % NCH; const size_t o = (size_t)(c * LCH) * RW + h * 64;
                f32x2 S[32];
                if (part) {
#pragma unroll
                    for (int j = 0; j < 32; ++j) { S[j].x = (2 * j == lane) ? 1.f : 0.f; S[j].y = (2 * j + 1 == lane) ? 1.f : 0.f; }
                    rwkv_lds<1>(S, PW + o, PNKK + o, PB + o, PK + o, PR + o, PV + o, LCH, lane, nullptr, nullptr, nullptr, 0.f, 0.f, wl);
                } else {
#pragma unroll
                    for (int j = 0; j < 32; ++j) S[j] = (f32x2){0.f, 0.f};
                    rwkv_lds<0>(S, PW + o, PNKK + o, PB + o, PK + o, PR + o, PV + o, LCH, lane, nullptr, nullptr, nullptr, 0.f, 0.f, wl);
                }
                float* dst = PU + ((size_t)pair * 2 + (part ? 0 : 1)) * 4096 + lane * 64;
#pragma unroll
                for (int j = 0; j < 16; ++j) *(f32x4*)(dst + 4 * j) = (f32x4){S[2 * j].x, S[2 * j].y, S[2 * j + 1].x, S[2 * j + 1].y};
            }
        }
        __syncthreads();
        MID(5);
        bf16* kT = (bf16*)lds;
        bf16* vT = (bf16*)lds + 256 * 72;
        const int fr = lane & 15, fq = lane >> 4;
        for (int it = bid; it < EH * NRB * 2; it += G) {
            const int half = it & 1, blk = (it >> 1) % NRB, h = (it >> 1) / NRB; const float l2g = ret_l2g(h); const int m0 = blk * RBLK;
            f32x4 acc[2][8];
#pragma unroll
            for (int x = 0; x < 2; ++x)
#pragma unroll
                for (int y = 0; y < 8; ++y) acc[x][y] = (f32x4){0.f, 0.f, 0.f, 0.f};
            for (int ts = 0; ts < 4; ++ts) {
                __syncthreads();
#pragma unroll
                for (int i = 0; i < 4; ++i) { const int t = lane, dp = wave + 8 * i; const u32x4 raw = *(const u32x4*)(QKVG + (size_t)(m0 + ts * 64 + t) * EC + 1024 + h * 256 + dp * 8);
                    const float dec = exp2f(l2g * (float)(255 - (ts * 64 + t)));
#pragma unroll
                    for (int e = 0; e < 4; ++e) { const unsigned w = raw[e]; kT[(dp * 8 + 2 * e) * 72 + t] = (bf16)f2bf(bf2f(w & 0xffffu) * dec); kT[(dp * 8 + 2 * e + 1) * 72 + t] = (bf16)f2bf(bf2f(w >> 16) * dec); } }
#pragma unroll
                for (int i = 0; i < 2; ++i) { const int t = lane, ep = wave + 8 * i; const u32x4 raw = *(const u32x4*)(QKVG + (size_t)(m0 + ts * 64 + t) * EC + 2048 + h * 256 + half * 128 + ep * 8);
#pragma unroll
                    for (int e = 0; e < 4; ++e) { const unsigned w = raw[e]; vT[(ep * 8 + 2 * e) * 72 + t] = (bf16)(w & 0xffffu); vT[(ep * 8 + 2 * e + 1) * 72 + t] = (bf16)(w >> 16); } }
                __syncthreads();
#pragma unroll
                for (int kk = 0; kk < 2; ++kk) { bf16x8 af[2];
#pragma unroll
                    for (int x = 0; x < 2; ++x) af[x] = *(const bf16x8*)(kT + (32 * wave + 16 * x + fr) * 72 + kk * 32 + fq * 8);
#pragma unroll
                    for (int y = 0; y < 8; ++y) { const bf16x8 bfm = *(const bf16x8*)(vT + (16 * y + fr) * 72 + kk * 32 + fq * 8);
#pragma unroll
                        for (int x = 0; x < 2; ++x) acc[x][y] = __builtin_amdgcn_mfma_f32_16x16x32_bf16(af[x], bfm, acc[x][y], 0, 0, 0); } }
            }
            bf16* dst = KVB + ((size_t)(h * NRB + blk) * 256) * 256;
#pragma unroll
            for (int x = 0; x < 2; ++x)
#pragma unroll
                for (int y = 0; y < 8; ++y) { u32x2 w; w.x = pk2(acc[x][y][0], acc[x][y][1]); w.y = pk2(acc[x][y][2], acc[x][y][3]);
                    *(u32x2*)(dst + (size_t)(half * 128 + 16 * y + fr) * 256 + 32 * wave + 16 * x + fq * 4) = w; }
        }
    }
    if (IN(6)) MID(6);
    SEAM(6);
    if (IN(7)) for (int rep = 0; rep < (DUP_PHASE == 7 ? 2 : 1); ++rep) {
        const int nB = RH * 4;
        if (bid < nB || G <= nB) {
            float* Sb = (float*)lds;
            const int fr = lane & 15, fq = lane >> 4;
            for (int it = bid; it < nB; it += G) {
                const int h = it >> 2, g4 = it & 3; float* pu = PU + (size_t)(h * NCH) * 2 * 4096;
                __syncthreads();
                for (int idx = tid; idx < 16 * 65; idx += 512) Sb[idx] = 0.f;
                __syncthreads();
                if (wave < 4) {
                    float pa[16], pb[16]; f32x4 ua, ub;
#define PB_LOAD(dst, du, c) do { const float* pp = pu + (size_t)(c) * 2 * 4096; _Pragma("unroll") for (int kk = 0; kk < 16; ++kk) dst[kk] = pp[(4 * kk + fq) * 64 + 16 * wave + fr]; \
                        _Pragma("unroll") for (int jj = 0; jj < 4; ++jj) du[jj] = pp[4096 + (16 * g4 + 4 * fq + jj) * 64 + 16 * wave + fr]; } while (0)
                    PB_LOAD(pa, ua, 0); PB_LOAD(pb, ub, 1);
                    for (int c = 0; c < NCH; ++c) {
                        const float* Sc = Sb + (c & 1) * (16 * 65); float* Sn = Sb + ((c + 1) & 1) * (16 * 65);
                        f32x4 acc = ua, ac1 = {0.f, 0.f, 0.f, 0.f}, ac2 = ac1, ac3 = ac1;
#pragma unroll
                        for (int kk = 0; kk < 16; kk += 4) { acc = __builtin_amdgcn_mfma_f32_16x16x4f32(Sc[fr * 65 + 4 * kk + fq], pa[kk], acc, 0, 0, 0);
                            ac1 = __builtin_amdgcn_mfma_f32_16x16x4f32(Sc[fr * 65 + 4 * (kk + 1) + fq], pa[kk + 1], ac1, 0, 0, 0);
                            ac2 = __builtin_amdgcn_mfma_f32_16x16x4f32(Sc[fr * 65 + 4 * (kk + 2) + fq], pa[kk + 2], ac2, 0, 0, 0);
                            ac3 = __builtin_amdgcn_mfma_f32_16x16x4f32(Sc[fr * 65 + 4 * (kk + 3) + fq], pa[kk + 3], ac3, 0, 0, 0); }
                        acc = (acc + ac1) + (ac2 + ac3);
#pragma unroll
                        for (int jj = 0; jj < 4; ++jj) { Sn[(4 * fq + jj) * 65 + 16 * wave + fr] = acc[jj]; pu[(size_t)c * 2 * 4096 + 4096 + (16 * g4 + 4 * fq + jj) * 64 + 16 * wave + fr] = acc[jj]; }
                        if (c + 1 == NCH) {
#pragma unroll
                            for (int jj = 0; jj < 4; ++jj) out[O_WKP + (size_t)h * 4096 + (16 * g4 + 4 * fq + jj) * 64 + 16 * wave + fr] = acc[jj]; }
#pragma unroll
                        for (int kk = 0; kk < 16; ++kk) pa[kk] = pb[kk];
                        ua = ub;
                        if (c + 2 < NCH) PB_LOAD(pb, ub, c + 2);
                        asm volatile("s_waitcnt lgkmcnt(0)" ::: "memory");
                        __builtin_amdgcn_s_barrier();
                    }
#undef PB_LOAD
                } else {
                    for (int c = 0; c < NCH; ++c) __builtin_amdgcn_s_barrier();
                }
            }
        }
        if (bid >= nB || G <= nB) {
            const int nb2 = G <= nB ? G : G - nB, b2 = G <= nB ? bid : bid - nB;
            for (int it = b2 * 512 + tid; it < EH * 256 * 32; it += nb2 * 512) {
                const int h = it >> 13, e = (it >> 5) & 255, d0 = (it & 31) * 8; const float g256 = exp2f(256.f * ret_l2g(h));
                float acc[8];
#pragma unroll
                for (int q = 0; q < 8; ++q) acc[q] = 0.f;
                u32x4 kvr[NRB];
#pragma unroll
                for (int blk = 0; blk < NRB; ++blk) kvr[blk] = *(const u32x4*)(KVB + ((size_t)(h * NRB + blk) * 256 + e) * 256 + d0);
#pragma unroll
                for (int blk = 0; blk < NRB; ++blk) {
                    const size_t o = ((size_t)(h * NRB + blk) * 256 + e) * 256 + d0;
                    u32x4 w; w.x = pk2(acc[0], acc[1]); w.y = pk2(acc[2], acc[3]); w.z = pk2(acc[4], acc[5]); w.w = pk2(acc[6], acc[7]); *(u32x4*)(SPREV + o) = w;
                    const u32x4 kv = kvr[blk];
#pragma unroll
                    for (int q = 0; q < 4; ++q) { acc[2 * q] = acc[2 * q] * g256 + bf2f(kv[q] & 0xffffu); acc[2 * q + 1] = acc[2 * q + 1] * g256 + bf2f(kv[q] >> 16); }
                }
#pragma unroll
                for (int q = 0; q < 8; ++q) out[O_RTP + (size_t)h * 65536 + (size_t)(d0 + q) * 256 + e] = acc[q];
            }
            asm volatile("s_waitcnt vmcnt(0)" ::: "memory");
            __syncthreads();
            if (tid == 0) {
                unsigned* cw = (unsigned*)(a.ws + 65536) + XCD_BAR_WORDS + 64;
                __builtin_amdgcn_fence(__ATOMIC_RELEASE, "agent");
                asm volatile("s_waitcnt vmcnt(0)" ::: "memory");
                (void)xb_add(cw, 1u);
            }
        }
        {
            const int nscan = G <= nB ? G : G - nB;
            unsigned* cw = (unsigned*)(a.ws + 65536) + XCD_BAR_WORDS + 64; unsigned* cq = cw + 32;
            if (tid == 0) {
                unsigned sp = 0u; while (xb_ld(cw) < (unsigned)nscan) { __builtin_amdgcn_s_sleep(1); if (++sp > (1u << 22)) break; }
                __builtin_amdgcn_fence(__ATOMIC_ACQUIRE, "agent");
                asm volatile("s_waitcnt vmcnt(0)" ::: "memory");
            }
            __syncthreads();
            {
                const int fr = lane & 15, fq = lane >> 4;
                for (;;) {
                    __syncthreads();
                    if (tid == 0) xst[2] = xb_add(cq, 1u);
                    __syncthreads();
                    const int qi = (int)xst[2];
                    if (qi >= EH * (TP / 64)) break;
                    const int it = ((qi & 127) >> 5) * (TP / 64) + (qi & 31) * 4 + (3 - (qi >> 7));
                    {
                    const int h = it / (TP / 64), n = it % (TP / 64), blk = n >> 2, i = n & 3, m0 = n * 64; const float l2g = ret_l2g(h);
                    bf16* qL = (bf16*)lds; bf16* kL = qL + 64 * 264; bf16* vT = kL + 64 * 264; bf16* pL = vT + 256 * 72; float* red = (float*)(pL + 64 * 72);
#pragma unroll
                    for (int x = 0; x < 4; ++x) { const int p = tid + 512 * x, t = p >> 5, dp = p & 31; *(u32x4*)(qL + t * 264 + dp * 8) = *(const u32x4*)(QKVG + (size_t)(m0 + t) * EC + h * 256 + dp * 8); }
                    u32x4 kr[4], vr[4];
#define R3_LOADKV(jn) do { const int ms_ = (blk * 4 + (jn)) * 64; \
        _Pragma("unroll") for (int x = 0; x < 4; ++x) { const int p = tid + 512 * x; kr[x] = *(const u32x4*)(QKVG + (size_t)(ms_ + (p >> 5)) * EC + 1024 + h * 256 + (p & 31) * 8); \
            vr[x] = *(const u32x4*)(QKVG + (size_t)(ms_ + lane) * EC + 2048 + h * 256 + (wave + 8 * x) * 8); } } while (0)
                    R3_LOADKV(0);
                    __syncthreads();
                    f32x4 acc[4][2];
#pragma unroll
                    for (int x = 0; x < 4; ++x)
#pragma unroll
                        for (int y = 0; y < 2; ++y) acc[x][y] = (f32x4){0.f, 0.f, 0.f, 0.f};
                    if (blk > 0) {
                        const bf16* sp = SPREV + ((size_t)(h * NRB + blk) * 256) * 256;
#pragma unroll 2
                        for (int kk = 0; kk < 8; ++kk) { bf16x8 bfm[2];
#pragma unroll
                            for (int y = 0; y < 2; ++y) bfm[y] = *(const bf16x8*)(sp + (size_t)(32 * wave + 16 * y + fr) * 256 + kk * 32 + fq * 8);
#pragma unroll
                            for (int x = 0; x < 4; ++x) { const bf16x8 af = *(const bf16x8*)(qL + (16 * x + fr) * 264 + kk * 32 + fq * 8);
#pragma unroll
                                for (int y = 0; y < 2; ++y) acc[x][y] = __builtin_amdgcn_mfma_f32_16x16x32_bf16(af, bfm[y], acc[x][y], 0, 0, 0); } }
#pragma unroll
                        for (int x = 0; x < 4; ++x)
#pragma unroll
                            for (int jj = 0; jj < 4; ++jj) { const float qd = exp2f(l2g * (float)(64 * i + 16 * x + fq * 4 + jj + 1)); acc[x][0][jj] *= qd; acc[x][1][jj] *= qd; }
                    }
                    for (int j = 0; j <= i; ++j) {
                        __syncthreads();
#pragma unroll
                        for (int x = 0; x < 4; ++x) { const int p = tid + 512 * x, t = p >> 5, dp = p & 31; *(u32x4*)(kL + t * 264 + dp * 8) = kr[x]; }
#pragma unroll
                        for (int x = 0; x < 4; ++x) { const int t = lane, dp = wave + 8 * x;
                            const u32x4 raw = vr[x];
#pragma unroll
                            for (int e = 0; e < 4; ++e) { const unsigned w = raw[e]; vT[(dp * 8 + 2 * e) * 72 + t] = (bf16)(w & 0xffffu); vT[(dp * 8 + 2 * e + 1) * 72 + t] = (bf16)(w >> 16); } }
                        if (j < i) R3_LOADKV(j + 1);
                        __syncthreads();
                        { const int tr = wave >> 1, tc0 = (wave & 1) * 2; f32x4 sa[2] = {(f32x4){0.f, 0.f, 0.f, 0.f}, (f32x4){0.f, 0.f, 0.f, 0.f}};
#pragma unroll
                            for (int kk = 0; kk < 8; ++kk) { const bf16x8 af = *(const bf16x8*)(qL + (16 * tr + fr) * 264 + kk * 32 + fq * 8);
#pragma unroll
                                for (int y = 0; y < 2; ++y) { const bf16x8 bfm = *(const bf16x8*)(kL + (16 * (tc0 + y) + fr) * 264 + kk * 32 + fq * 8); sa[y] = __builtin_amdgcn_mfma_f32_16x16x32_bf16(af, bfm, sa[y], 0, 0, 0); } }
#pragma unroll
                            for (int y = 0; y < 2; ++y)
#pragma unroll
                                for (int jj = 0; jj < 4; ++jj) { const int t = 16 * tr + fq * 4 + jj, s = 16 * (tc0 + y) + fr; const int dist = (j < i) ? 64 * (i - j) + t - s : (t > s ? t - s : s - t);
                                    pL[t * 72 + s] = (bf16)f2bf(sa[y][jj] * exp2f(l2g * (float)dist)); } }
                        __syncthreads();
#pragma unroll
                        for (int kk = 0; kk < 2; ++kk) { bf16x8 bfm[2];
#pragma unroll
                            for (int y = 0; y < 2; ++y) bfm[y] = *(const bf16x8*)(vT + (32 * wave + 16 * y + fr) * 72 + kk * 32 + fq * 8);
#pragma unroll
                            for (int x = 0; x < 4; ++x) { const bf16x8 af = *(const bf16x8*)(pL + (16 * x + fr) * 72 + kk * 32 + fq * 8);
#pragma unroll
                                for (int y = 0; y < 2; ++y) acc[x][y] = __builtin_amdgcn_mfma_f32_16x16x32_bf16(af, bfm[y], acc[x][y], 0, 0, 0); } }
                    }
#undef R3_LOADKV
                    const int et = tid >> 3, e0 = (tid & 7) * 32;
                    u32x4 g4[4];
#pragma unroll
                    for (int q4 = 0; q4 < 4; ++q4) g4[q4] = *(const u32x4*)(QKVG + (size_t)(m0 + et) * EC + 3072 + h * 256 + e0 + 8 * q4);
                    __syncthreads();
                    float* OT = (float*)lds;
#pragma unroll
                    for (int x = 0; x < 4; ++x)
#pragma unroll
                        for (int y = 0; y < 2; ++y)
#pragma unroll
                            for (int jj = 0; jj < 4; ++jj) OT[(16 * x + fq * 4 + jj) * 260 + 32 * wave + 16 * y + fr] = acc[x][y][jj];
                    __syncthreads();
                    f32x4 ov[8]; float s1 = 0.f, s2 = 0.f;
#pragma unroll
                    for (int q8 = 0; q8 < 8; ++q8) { ov[q8] = *(const f32x4*)(OT + et * 260 + e0 + 4 * q8); s1 += (ov[q8].x + ov[q8].y) + (ov[q8].z + ov[q8].w);
                        s2 += (ov[q8].x * ov[q8].x + ov[q8].y * ov[q8].y) + (ov[q8].z * ov[q8].z + ov[q8].w * ov[q8].w); }
                    s1 += DPPF(0.f, s1, 0xB1, 0xF); s1 += DPPF(0.f, s1, 0x4E, 0xF); s1 += DPPF(0.f, s1, 0x141, 0xF);
                    s2 += DPPF(0.f, s2, 0xB1, 0xF); s2 += DPPF(0.f, s2, 0x4E, 0xF); s2 += DPPF(0.f, s2, 0x141, 0xF);
                    const float mean = s1 * (1.f / 256.f), var = s2 * (1.f / 256.f) - mean * mean, rstd = rsqrtf(var + 1e-5f);
                    const float* lwp = a.in[I_ELW] + h * 256 + e0; const float* lbp = a.in[I_ELB] + h * 256 + e0;
                    bf16* mp = MIX + (size_t)(m0 + et) * D + RW + h * 256 + e0;
#pragma unroll
                    for (int q4 = 0; q4 < 4; ++q4) { float o8[8];
#pragma unroll
                        for (int hh = 0; hh < 2; ++hh) { const f32x4 w4 = *(const f32x4*)(lwp + 8 * q4 + 4 * hh), b4 = *(const f32x4*)(lbp + 8 * q4 + 4 * hh); const f32x4 vv = ov[2 * q4 + hh];
                            const unsigned ga = g4[q4][2 * hh], gb = g4[q4][2 * hh + 1]; const float t0 = bf2f(ga & 0xffffu), t1 = bf2f(ga >> 16), t2 = bf2f(gb & 0xffffu), t3 = bf2f(gb >> 16);
                            o8[4 * hh] = ((vv.x - mean) * rstd * w4.x + b4.x) * t0 * sigm(t0); o8[4 * hh + 1] = ((vv.y - mean) * rstd * w4.y + b4.y) * t1 * sigm(t1);
                            o8[4 * hh + 2] = ((vv.z - mean) * rstd * w4.z + b4.z) * t2 * sigm(t2); o8[4 * hh + 3] = ((vv.w - mean) * rstd * w4.w + b4.w) * t3 * sigm(t3); }
                        u32x4 w; w.x = pk2(o8[0], o8[1]); w.y = pk2(o8[2], o8[3]); w.z = pk2(o8[4], o8[5]); w.w = pk2(o8[6], o8[7]); *(u32x4*)(mp + 8 * q4) = w; }

                    }
                }
            }
        }
    }
    if (IN(7)) MID(10);
    SEAM(7);
    if (IN(8)) for (int rep = 0; rep < (DUP_PHASE == 8 ? 2 : 1); ++rep) {
        MID(7);
        if (wave < 5) {
            float* wl = (float*)lds + wave * RL<2>::BUF;
            const int ntask = wave < 4 ? RH * NCH : NB * RH;
            for (int task = wave < 4 ? bid * 4 + wave : bid; task < ntask; task += (wave < 4 ? G * 4 : G)) {
                f32x2 S[32]; int h, m0, nsteps; float* sdst = nullptr;
                if (wave < 4) { h = task / NCH; const int c = task % NCH; m0 = c * LCH; nsteps = LCH;
                    if (c == 0) {
#pragma unroll
                        for (int j = 0; j < 32; ++j) S[j] = (f32x2){0.f, 0.f};
                    } else { const float* src = PU + ((size_t)(h * NCH + c - 1) * 2 + 1) * 4096 + lane * 64;
#pragma unroll
                        for (int j = 0; j < 16; ++j) { const f32x4 q = *(const f32x4*)(src + 4 * j); S[2 * j] = (f32x2){q.x, q.y}; S[2 * j + 1] = (f32x2){q.z, q.w}; } }
                } else { const int b = task / RH; h = task % RH; m0 = TP + 16 * b; nsteps = TS;
                    const float* src = a.in[I_SWKV] + ((size_t)(b * RH + h) * 64 + lane) * 64; sdst = out + O_WKS + ((size_t)(b * RH + h) * 64 + lane) * 64;
#pragma unroll
                    for (int j = 0; j < 16; ++j) { const f32x4 q = *(const f32x4*)(src + 4 * j); S[2 * j] = (f32x2){q.x, q.y}; S[2 * j + 1] = (f32x2){q.z, q.w}; } }
                const size_t o = (size_t)m0 * RW + h * 64;
                rwkv_lds<2>(S, PW + o, PNKK + o, PB + o, PK + o, PR + o, PV + o, nsteps, lane, PG + o, BON + (size_t)m0 * 16 + h, MIX + (size_t)m0 * D + h * 64,
                            a.in[I_RLW][h * 64 + lane], a.in[I_RLB][h * 64 + lane], wl);
                if (sdst) {
#pragma unroll
                    for (int j = 0; j < 16; ++j) *(f32x4*)(sdst + 4 * j) = (f32x4){S[2 * j].x, S[2 * j].y, S[2 * j + 1].x, S[2 * j + 1].y}; }
            }
        }
        MID(8);
        {
            const int nb2 = G, b2 = bid;
            const int fr = lane & 15, fq = lane >> 4;
            for (int it0 = b2; it0 < NB * EH * 4; it0 += nb2) {
                const int it = EH * (TP / 64) + it0;
                __syncthreads();
#ifndef NO_RS
                {
                    const int r = it - EH * (TP / 64), tq = r & 3, b = (r >> 2) / EH, h = (r >> 2) % EH, m0 = TP + 16 * b; const float l2g = ret_l2g(h);
                    float* qf = (float*)lds; float* kf = qf + 4 * 260; float* vf = kf + 16 * 257; float* pf = vf + 16 * 257; float* red = pf + 64;
                    for (int idx = tid; idx < 16 * 256; idx += 512) { const int t = idx >> 8, dd = idx & 255; const bf16* src = QKVG + (size_t)(m0 + t) * EC + h * 256 + dd;
                        if ((t >> 2) == tq) qf[(t & 3) * 260 + dd] = bf2f(src[0]);
                        kf[t * 257 + dd] = bf2f(src[1024]); vf[t * 257 + dd] = bf2f(src[2048]); }
                    __syncthreads();
                    if (tid < 64) { const int tl = tid >> 4, s = tid & 15, t = 4 * tq + tl; float sc = 0.f;
#pragma unroll 4
                        for (int dd = 0; dd < 256; ++dd) sc += qf[tl * 260 + dd] * kf[s * 257 + dd];
                        pf[tl * 16 + s] = sc * exp2f(l2g * (float)(t > s ? t - s : s - t)); }
                    __syncthreads();
                    const int e = tid & 255, th = tid >> 8; const float* S0 = a.in[I_SRET] + (size_t)(b * EH + h) * 65536;
                    float oc[2] = {0.f, 0.f};
#pragma unroll 4
                    for (int dd = 0; dd < 256; dd += 4) { const f32x4 qa = *(const f32x4*)(qf + (2 * th) * 260 + dd), qb = *(const f32x4*)(qf + (2 * th + 1) * 260 + dd);
                        const float s0 = S0[(size_t)dd * 256 + e], s1 = S0[(size_t)(dd + 1) * 256 + e], s2 = S0[(size_t)(dd + 2) * 256 + e], s3 = S0[(size_t)(dd + 3) * 256 + e];
                        oc[0] += qa.x * s0 + qa.y * s1 + qa.z * s2 + qa.w * s3; oc[1] += qb.x * s0 + qb.y * s1 + qb.z * s2 + qb.w * s3; }
#pragma unroll
                    for (int tt = 0; tt < 2; ++tt) { const int tl = 2 * th + tt, t = 4 * tq + tl; float v = oc[tt] * exp2f(l2g * (float)(t + 1));
#pragma unroll 4
                        for (int s = 0; s < 16; ++s) v += pf[tl * 16 + s] * vf[s * 257 + e];
                        oc[tt] = v; }
                    { const float g16 = exp2f(16.f * l2g); float* dst = out + O_RTS + (size_t)(b * EH + h) * 65536; float vd[16];
#pragma unroll
                        for (int t = 0; t < 16; ++t) vd[t] = vf[t * 257 + e] * exp2f(l2g * (float)(15 - t));
#pragma unroll 4
                        for (int dd = 64 * tq + 32 * th; dd < 64 * tq + 32 * th + 32; ++dd) { float v = g16 * S0[(size_t)dd * 256 + e];
#pragma unroll
                            for (int t = 0; t < 16; ++t) v += kf[t * 257 + dd] * vd[t];
                            dst[(size_t)dd * 256 + e] = v; } }
#pragma unroll
                    for (int tt = 0; tt < 2; ++tt) { const float s1 = wave_sum(oc[tt]), s2 = wave_sum(oc[tt] * oc[tt]); if (lane == 0) { const int tl = 2 * th + tt; red[(tl * 4 + (wave & 3)) * 2] = s1; red[(tl * 4 + (wave & 3)) * 2 + 1] = s2; } }
                    __syncthreads();
                    const float lw = a.in[I_ELW][h * 256 + e], lb = a.in[I_ELB][h * 256 + e];
#pragma unroll
                    for (int tt = 0; tt < 2; ++tt) { const int tl = 2 * th + tt, t = 4 * tq + tl; float s1 = 0.f, s2 = 0.f;
#pragma unroll
                        for (int w4 = 0; w4 < 4; ++w4) { s1 += red[(tl * 4 + w4) * 2]; s2 += red[(tl * 4 + w4) * 2 + 1]; }
                        const float mean = s1 * (1.f / 256.f), var = s2 * (1.f / 256.f) - mean * mean, rstd = rsqrtf(var + 1e-5f);
                        const float gt = bf2f(QKVG[(size_t)(m0 + t) * EC + 3072 + h * 256 + e]);
                        MIX[(size_t)(m0 + t) * D + RW + h * 256 + e] = (bf16)f2bf(((oc[tt] - mean) * rstd * lw + lb) * gt * sigm(gt)); }
                }
#else
                {}
#endif
            }
        }
    }
    if (IN(8)) MID(9);
    SEAM(8);
    if (IN(9)) for (int rep = 0; rep < (DUP_PHASE == 9 ? 2 : 1); ++rep) {
        { pg8::Gemm g{MIX, WOUTT, TP, D, D, D}; pg8::StaticOrder S; S.init(TP, D, G, bid); EpiF32 E{MIXOUT, D};
          pg8::gemm_phase<EpiF32, pg8::StaticOrder, true, true>((PG8_LAS unsigned char*)lds, g, S, E); }
        { const int sl = bid >> 3; pg8::Gemm g{MIX + (size_t)TP * D + sl * 512, WOUTT + sl * 512, MS, D, 512, D}; pg8::OneUnit S{0, bid & 7, bid < 8 * KS9}; EpiF32 E{(float*)(ws + WS_PART9) + (size_t)sl * MS * D, D};
          pg8::gemm_phase<EpiF32, pg8::OneUnit, false, true>((PG8_LAS unsigned char*)lds, g, S, E); }
    }
    SEAM(9);
    if (IN(10)) for (int rep = 0; rep < (DUP_PHASE == 10 ? 2 : 1); ++rep) {
        for (int m = gw; m < M; m += NGW) {
            const float* xr = m < TP ? a.in[I_XP] + (size_t)m * D : a.in[I_XS] + (size_t)(m - TP) * D; const float* mod = MOD + seq_of(m) * MODW; const float* mr = MIXOUT + (size_t)m * D;
            f32x4 v[8]; float ss = 0.f;
#pragma unroll
            for (int j = 0; j < 8; ++j) {
                if (m < TP) v[j] = *(const f32x4*)(mr + 4 * lane + 256 * j);
                else { const float* pr = (const float*)(ws + WS_PART9) + (size_t)(m - TP) * D + 4 * lane + 256 * j; v[j] = *(const f32x4*)pr;
#pragma unroll
                    for (int q = 1; q < KS9; ++q) v[j] += *(const f32x4*)(pr + (size_t)q * MS * D); }
                ss += (v[j].x * v[j].x + v[j].y * v[j].y) + (v[j].z * v[j].z + v[j].w * v[j].w); }
            const float rs = rsqrtf(wave_sum(ss) * (1.f / D) + 1e-6f); float s2 = 0.f;
#pragma unroll
            for (int j = 0; j < 8; ++j) { const int c = 4 * lane + 256 * j; const f32x4 g = *(const f32x4*)(a.in[I_GPOM] + c), gt = *(const f32x4*)(mod + 2 * D + c), x = *(const f32x4*)(xr + c);
                v[j] = x + gt * (v[j] * rs * g); *(f32x4*)(out + (size_t)m * D + c) = v[j]; s2 += (v[j].x * v[j].x + v[j].y * v[j].y) + (v[j].z * v[j].z + v[j].w * v[j].w); }
            const float rs2 = rsqrtf(wave_sum(s2) * (1.f / D) + 1e-6f);
#pragma unroll
            for (int j = 0; j < 8; ++j) { const int c = 4 * lane + 256 * j; const f32x4 g = *(const f32x4*)(a.in[I_GPF] + c), s1 = *(const f32x4*)(mod + 4 * D + c), h1 = *(const f32x4*)(mod + 3 * D + c);
                const f32x4 h = v[j] * rs2 * g * (s1 + 1.f) + h1; u32x2 w; w.x = pk2(h.x, h.y); w.y = pk2(h.z, h.w); *(u32x2*)(H + (size_t)m * D + c) = w; }
        }
        float* scr = (float*)lds + wave * (64 * 33 + 16);
        constexpr int IT_UP = (D / 64) * (2 * FF / 32), IT_DN = (FF / 64) * (D / 32);
        for (int it = gw; it < IT_UP + IT_DN; it += NGW) {
            if (it < IT_UP) { const int nb = 2 * FF / 32, kb = it / nb, n0 = 32 * (it % nb); const int nn = n0 < FF ? n0 : n0 - FF; const int dr = 256 * (nn >> 7) + (n0 < FF ? 0 : 128) + (nn & 127);
                transpose_item(a.in[I_WUP], D, 2 * FF, WUPT, 64 * kb, n0, dr, scr, lane); }
            else { const int r = it - IT_UP, nb = D / 32, kb = r / nb, n0 = 32 * (r % nb); transpose_item(a.in[I_WDN], FF, D, WDNT, 64 * kb, n0, n0, scr, lane); }
        }
    }
    SEAM(10);
    if (IN(11)) for (int rep = 0; rep < (DUP_PHASE == 11 ? 2 : 1); ++rep) {
        pg8::Gemm g{H, WUPT, M, 2 * FF, D, D}; pg8::StaticOrder S; S.init(M, 2 * FF, G, bid); EpiSwiglu E{ACT};
        pg8::gemm_phase<EpiSwiglu, pg8::StaticOrder, true, true>((PG8_LAS unsigned char*)lds, g, S, E);
    }
    SEAM(11);
    if (IN(12)) for (int rep = 0; rep < (DUP_PHASE == 12 ? 2 : 1); ++rep) {
        { pg8::Gemm g{ACT, WDNT, TP, D, FF, FF}; pg8::StaticOrder S; S.init(TP, D, G, bid); EpiF32 E{MIXOUT, D};
          pg8::gemm_phase<EpiF32, pg8::StaticOrder, true, true>((PG8_LAS unsigned char*)lds, g, S, E); }
        { const int sl = bid >> 3; pg8::Gemm g{ACT + (size_t)TP * FF + sl * 512, WDNT + sl * 512, MS, D, 512, FF}; pg8::OneUnit S{0, bid & 7, bid < 8 * KS12}; EpiF32 E{(float*)(ws + WS_PART12) + (size_t)sl * MS * D, D};
          pg8::gemm_phase<EpiF32, pg8::OneUnit, false, true>((PG8_LAS unsigned char*)lds, g, S, E); }
    }
    SEAM(12);
    if (IN(13)) for (int rep = 0; rep < (DUP_PHASE == 13 ? 2 : 1); ++rep) {
        for (int m = gw; m < M; m += NGW) {
            const float* mod = MOD + seq_of(m) * MODW; const float* fr_ = MIXOUT + (size_t)m * D;
            f32x4 v[8]; float ss = 0.f;
#pragma unroll
            for (int j = 0; j < 8; ++j) {
                if (m < TP) v[j] = *(const f32x4*)(fr_ + 4 * lane + 256 * j);
                else { const float* pr = (const float*)(ws + WS_PART12) + (size_t)(m - TP) * D + 4 * lane + 256 * j; v[j] = *(const f32x4*)pr;
#pragma unroll
                    for (int q = 1; q < KS12; ++q) v[j] += *(const f32x4*)(pr + (size_t)q * MS * D); }
                ss += (v[j].x * v[j].x + v[j].y * v[j].y) + (v[j].z * v[j].z + v[j].w * v[j].w); }
            const float rs = rsqrtf(wave_sum(ss) * (1.f / D) + 1e-6f);
#pragma unroll
            for (int j = 0; j < 8; ++j) { const int c = 4 * lane + 256 * j; const f32x4 g = *(const f32x4*)(a.in[I_GPOF] + c), gt = *(const f32x4*)(mod + 5 * D + c), x = *(const f32x4*)(out + (size_t)m * D + c);
                *(f32x4*)(out + (size_t)m * D + c) = x + gt * (v[j] * rs * g); }
        }
    }
    if (TS_PROBE >= 0) {
        xcd_barrier(xb);
        if (bid == 0 && tid == 0) TSW[14] = __builtin_amdgcn_s_memrealtime();
        if (bid == 0) { __syncthreads(); const float us = TS_PROBE >= 100 ? (float)(TSW[32 + TS_PROBE - 100] - TSW[32 + TS_PROBE - 101]) * 0.01f : (float)(TSW[1 + TS_PROBE] - TSW[TS_PROBE]) * 0.01f; const float eps = sqrtf(us * 1e-4f);
            for (int c = tid; c < RC; c += 512) out[O_SHP + c] *= (1.f + eps); }
    }
#undef IN
#undef SEAM
}

extern "C" void kernel_launch(void* const* d_in, const int* in_sizes, int n_in, void* d_out, int out_size, void* d_ws, size_t ws_size, hipStream_t stream) {
    static int grid = 0;
    if (grid == 0) {
        if (n_in != 30 || (size_t)out_size != O_END || ws_size < WS_END) { fprintf(stderr, "kernel_launch: unexpected sizes n_in %d out %d ws %zu\n", n_in, out_size, ws_size); grid = -1; return; }
        int dev = 0, cus = 0, per_cu = 0;
        (void)hipGetDevice(&dev); (void)hipDeviceGetAttribute(&cus, hipDeviceAttributeMultiprocessorCount, dev);
        if (hipFuncSetAttribute((const void*)mk_fwd, hipFuncAttributeMaxDynamicSharedMemorySize, LDS_BYTES) != hipSuccess) { fprintf(stderr, "kernel_launch: hipFuncSetAttribute failed\n"); grid = -1; return; }
        if (hipOccupancyMaxActiveBlocksPerMultiprocessor(&per_cu, (const void*)mk_fwd, 512, LDS_BYTES) != hipSuccess || per_cu < 1) { fprintf(stderr, "kernel_launch: occupancy query says %d\n", per_cu); per_cu = 1; }
        (void)hipGetLastError();
        grid = cus;
        if (grid <= 0) grid = 256;
    }
    if (grid < 0) return;
    (void)hipMemsetAsync((char*)d_ws + 65536, 0, XCD_BAR_WORDS * 4 + 512, stream);
    Args a{};
    for (int i = 0; i < 30; ++i) a.in[i] = (const float*)d_in[i];
    a.out = (float*)d_out; a.ws = (unsigned char*)d_ws;
    a.ph_lo = 0; a.ph_hi = NPHASE;
    void* args[] = {&a};
    hipError_t e = hipLaunchCooperativeKernel((const void*)mk_fwd, dim3(grid), dim3(512), args, LDS_BYTES, stream);
    if (e != hipSuccess) fprintf(stderr, "kernel_launch: cooperative launch failed: %s (grid %d)\n", hipGetErrorString(e), grid);
}
```

```cpp
#include <hip/hip_runtime.h>
#include <hip/hip_cooperative_groups.h>
#include <cstdio>
#include <cstdint>
namespace cg = cooperative_groups;
namespace pg8 {
#define PG8_LAS __attribute__((address_space(3)))
typedef unsigned short bf16_t;
typedef short bf16x8 __attribute__((ext_vector_type(8)));
typedef float f32x4 __attribute__((ext_vector_type(4)));
typedef unsigned u32x4 __attribute__((ext_vector_type(4)));
constexpr int BM = 256, BK = 64, HALF = 128, HTB = HALF * BK * 2  , STAGE_BYTES = 8 * HTB, NXCD = 8, WGM = 8;

__host__ __device__ __forceinline__ int lds_byte(int r, int c) { const int st = (r >> 4) * 2 + (c >> 5), rr = r & 15, cc = c & 31, ob = rr * 64 + cc * 2; return st * 1024 + (ob ^ (((ob >> 9) & 1) << 5)); }
__host__ __device__ __forceinline__ void stage_rc(int b, int& R, int& C) { const int st = b / 1024, sb = b % 1024, swz = sb ^ (((sb >> 9) & 1) << 5); R = (st >> 1) * 16 + swz / 64; C = (st & 1) * 32 + (swz % 64) / 2; }
__host__ __device__ __forceinline__ int perm32(int rho) { const int n = rho >> 4, i = rho & 15; return 8 * (i >> 2) + 4 * n + (i & 3); }

struct Unit { int pm, pn; };
struct Gemm { const bf16_t* A; const bf16_t* Bt; int M, N, K, ld; };

struct OneUnit {
    int pm, pn; bool active;
    __device__ __forceinline__ bool next(int i, Unit& u) const { if (i > 0 || !active) return false; u.pm = pm; u.pn = pn; return true; }
    __device__ __forceinline__ void a_ready(const Unit&) const {}
    __device__ __forceinline__ void done(const Unit&) const {}
};
struct StaticOrder {
    int nM, nN, nwg, G, c;
    __host__ __device__ void init(int M, int N, int G_, int c_) { nM = M / BM; nN = N / BM; nwg = nM * nN; G = G_; c = c_; }
    __host__ __device__ bool next(int i, Unit& u) const {
        const long L = (long)i * G + c; if (L >= nwg) return false;
        int wgid = (int)L; { const int q = nwg / NXCD, r = nwg % NXCD, xcd = wgid % NXCD, off = wgid / NXCD; wgid = (xcd < r ? xcd * (q + 1) : r * (q + 1) + (xcd - r) * q) + off; }
        const int nig = WGM * nN, gid = wgid / nig, fm = gid * WGM, gsz = (nM - fm) < WGM ? (nM - fm) : WGM;
        u.pm = fm + ((wgid % nig) % gsz); u.pn = (wgid % nig) / gsz; return true;
    }
    __device__ __forceinline__ void a_ready(const Unit&) const {}
    __device__ __forceinline__ void done(const Unit&) const {}
};

__device__ __forceinline__ unsigned cvt_pk_bf16(float lo, float hi) { unsigned r; asm volatile("v_cvt_pk_bf16_f32 %0, %1, %2" : "=v"(r) : "v"(lo), "v"(hi)); return r; }
template <class Epi, class Sched, bool ALIGN_EPI = false, bool SP2 = false>
__device__ __forceinline__ void gemm_phase(PG8_LAS unsigned char* lds, const Gemm g, const Sched& S, const Epi& E) {
    const int tid = threadIdx.x, wid = __builtin_amdgcn_readfirstlane(tid >> 6), lane = tid & 63, wr = wid >> 2, wc = wid & 3, fr = lane & 15, fq = lane >> 4;
    const int K = g.K, nt = K / BK;
    unsigned voffA[2], voffB[2];
#pragma unroll
    for (int i = 0; i < 2; ++i) { int R, C; stage_rc(tid * 16 + i * 8192, R, C); const int Rb = Epi::PERM ? ((R & ~31) + perm32(R & 31)) : R;
        voffA[i] = (unsigned)(R * g.ld + C) * 2u; voffB[i] = (unsigned)(Rb * g.ld + C) * 2u; }
    const size_t kstep = (size_t)(BK * 2);
    const size_t hstep = (size_t)HALF * g.ld * 2;
    const size_t tstep = 2 * hstep;
    const unsigned ldsw = (unsigned)wid * 1024u;
    const int aoff = lds_byte(wr * 64 + fr, fq * 8), boff = lds_byte(wc * 32 + fr, fq * 8);
#define PG8_SA(b, h) (((b) * 2 + (h)) * HTB)
#define PG8_SB(b, h) ((4 + (b) * 2 + (h)) * HTB)
#define PG8_STAGE(bufoff, gbase, voff) do { _Pragma("unroll") for (int _i = 0; _i < 2; ++_i) \
        __builtin_amdgcn_global_load_lds((const unsigned*)((const char*)(gbase) + (voff)[_i]), (PG8_LAS unsigned*)(lds + (bufoff) + ldsw + _i * 8192), 16, 0, 0); } while (0)
#define PG8_LDA(dst, b, h) do { _Pragma("unroll") for (int m = 0; m < 4; ++m) _Pragma("unroll") for (int k = 0; k < 2; ++k) dst[m][k] = *(const PG8_LAS bf16x8*)(lds + PG8_SA(b, h) + aoff + m * 2048 + k * 1024); } while (0)
#define PG8_LDB(dst, b, h) do { _Pragma("unroll") for (int n = 0; n < 2; ++n) _Pragma("unroll") for (int k = 0; k < 2; ++k) dst[n][k] = *(const PG8_LAS bf16x8*)(lds + PG8_SB(b, h) + boff + n * 2048 + k * 1024); } while (0)
#define PG8_MMA(ai, bj, At, Bt) do { __builtin_amdgcn_s_setprio(1); _Pragma("unroll") for (int m = 0; m < 4; ++m) _Pragma("unroll") for (int n = 0; n < 2; ++n) _Pragma("unroll") for (int k = 0; k < 2; ++k) \
        acc[ai][bj][m][n] = __builtin_amdgcn_mfma_f32_16x16x32_bf16(Bt[n][k], At[m][k], acc[ai][bj][m][n], 0, 0, 0); __builtin_amdgcn_s_setprio(0); } while (0)
#define PG8_WAIT_V(n) asm volatile("s_waitcnt vmcnt(" #n ")" ::: "memory")
#define PG8_WAIT_L(n) asm volatile("s_waitcnt lgkmcnt(" #n ")" ::: "memory")
#define PG8_BAR __builtin_amdgcn_s_barrier()
#define PG8_SCHED __builtin_amdgcn_sched_barrier(0)
    Unit cur, nxt; int ui = 0;
    if (!S.next(0, cur)) return;
    f32x4 acc[2][2][4][2];
#pragma unroll
    for (int a = 0; a < 2; ++a)
#pragma unroll
        for (int b = 0; b < 2; ++b)
#pragma unroll
            for (int m = 0; m < 4; ++m)
#pragma unroll
                for (int n = 0; n < 2; ++n) acc[a][b][m][n] = (f32x4){0.f, 0.f, 0.f, 0.f};
    bf16x8 At[4][2], B0[2][2], B1[2][2];
    const char* cA = (const char*)g.A + (size_t)cur.pm * tstep; const char* cB = (const char*)g.Bt + (size_t)cur.pn * tstep;
    S.a_ready(cur);
    if constexpr (SP2) {
        PG8_STAGE(PG8_SB(0, 0), cB, voffB); PG8_STAGE(PG8_SB(0, 1), cB + hstep, voffB); PG8_STAGE(PG8_SA(0, 0), cA, voffA); PG8_STAGE(PG8_SA(0, 1), cA + hstep, voffA);
        if (wr == 1) PG8_BAR;
        PG8_WAIT_V(2); PG8_BAR;
        PG8_STAGE(PG8_SB(1, 0), cB + kstep, voffB); PG8_STAGE(PG8_SA(1, 0), cA + kstep, voffA); PG8_STAGE(PG8_SB(1, 1), cB + hstep + kstep, voffB);
        PG8_WAIT_V(6); PG8_BAR;
    } else {
        PG8_STAGE(PG8_SB(0, 0), cB, voffB); PG8_STAGE(PG8_SA(0, 0), cA, voffA); PG8_STAGE(PG8_SB(0, 1), cB + hstep, voffB); PG8_STAGE(PG8_SA(0, 1), cA + hstep, voffA);
        if (wr == 1) PG8_BAR;
        PG8_WAIT_V(4); PG8_BAR;
        PG8_STAGE(PG8_SB(1, 0), cB + kstep, voffB); PG8_STAGE(PG8_SA(1, 0), cA + kstep, voffA); PG8_STAGE(PG8_SB(1, 1), cB + hstep + kstep, voffB);
        PG8_WAIT_V(6); PG8_BAR;
    }
    for (;;) {
        const bool has_next = S.next(ui + 1, nxt);
        const char* nA = has_next ? (const char*)g.A + (size_t)nxt.pm * tstep : cA; const char* nB = has_next ? (const char*)g.Bt + (size_t)nxt.pn * tstep : cB;
        for (int t = 0; t < nt; t += 2) {
            const bool last = (t == nt - 2);
            const char* a1 = cA + (size_t)(t + 1) * kstep;
            const char* a2 = last ? nA : cA + (size_t)(t + 2) * kstep; const char* b2 = last ? nB : cB + (size_t)(t + 2) * kstep;
            const char* a3 = a2 + kstep; const char* b3 = b2 + kstep;
            if (last && has_next) S.a_ready(nxt);
            if constexpr (SP2) {
            PG8_LDB(B0, 0, 0); PG8_LDB(B1, 0, 1); PG8_SCHED; PG8_LDA(At, 0, 0); PG8_STAGE(PG8_SA(1, 1), a1 + hstep, voffA);
            PG8_WAIT_V(8); PG8_WAIT_L(0); PG8_BAR; PG8_MMA(0, 0, At, B0); PG8_MMA(0, 1, At, B1); PG8_BAR; PG8_SCHED;
            PG8_LDA(At, 0, 1); PG8_STAGE(PG8_SB(0, 0), b2, voffB); PG8_STAGE(PG8_SB(0, 1), b2 + hstep, voffB); PG8_STAGE(PG8_SA(0, 0), a2, voffA);
            PG8_WAIT_V(8); PG8_WAIT_L(0); PG8_BAR; PG8_MMA(1, 0, At, B0); PG8_MMA(1, 1, At, B1); PG8_BAR; PG8_SCHED;
            PG8_LDB(B0, 1, 0); PG8_LDB(B1, 1, 1); PG8_SCHED; PG8_LDA(At, 1, 0); PG8_STAGE(PG8_SA(0, 1), a2 + hstep, voffA);
            PG8_WAIT_V(8); PG8_WAIT_L(0); PG8_BAR; PG8_MMA(0, 0, At, B0); PG8_MMA(0, 1, At, B1); PG8_BAR; PG8_SCHED;
            PG8_LDA(At, 1, 1); PG8_STAGE(PG8_SB(1, 0), b3, voffB); PG8_STAGE(PG8_SB(1, 1), b3 + hstep, voffB); PG8_STAGE(PG8_SA(1, 0), a3, voffA);
            PG8_WAIT_V(8); PG8_WAIT_L(0); PG8_BAR; PG8_MMA(1, 0, At, B0); PG8_MMA(1, 1, At, B1); PG8_BAR; PG8_SCHED;
            } else {
            PG8_LDB(B0, 0, 0); PG8_SCHED; PG8_LDA(At, 0, 0); PG8_STAGE(PG8_SA(1, 1), a1 + hstep, voffA);
            PG8_WAIT_L(8); PG8_BAR; PG8_WAIT_L(0); PG8_MMA(0, 0, At, B0); PG8_BAR; PG8_SCHED;
            PG8_LDB(B1, 0, 1); PG8_STAGE(PG8_SB(0, 0), b2, voffB);
            PG8_BAR; PG8_WAIT_L(0); PG8_MMA(0, 1, At, B1); PG8_BAR;
            PG8_LDA(At, 0, 1); PG8_STAGE(PG8_SA(0, 0), a2, voffA);
            PG8_BAR; PG8_WAIT_L(0); PG8_MMA(1, 0, At, B0); PG8_BAR; PG8_SCHED;
            PG8_STAGE(PG8_SB(0, 1), b2 + hstep, voffB);
            PG8_WAIT_V(6); PG8_BAR; PG8_MMA(1, 1, At, B1); PG8_BAR;
            PG8_LDB(B0, 1, 0); PG8_SCHED; PG8_LDA(At, 1, 0); PG8_STAGE(PG8_SA(0, 1), a2 + hstep, voffA);
            PG8_WAIT_L(8); PG8_BAR; PG8_WAIT_L(0); PG8_MMA(0, 0, At, B0); PG8_BAR; PG8_SCHED;
            PG8_LDB(B1, 1, 1); PG8_STAGE(PG8_SB(1, 0), b3, voffB);
            PG8_BAR; PG8_WAIT_L(0); PG8_MMA(0, 1, At, B1); PG8_BAR;
            PG8_LDA(At, 1, 1); PG8_STAGE(PG8_SA(1, 0), a3, voffA);
            PG8_BAR; PG8_WAIT_L(0); PG8_MMA(1, 0, At, B0); PG8_BAR; PG8_SCHED;
            PG8_STAGE(PG8_SB(1, 1), b3 + hstep, voffB);
            PG8_WAIT_V(6); PG8_BAR; PG8_MMA(1, 1, At, B1); PG8_BAR;
            }
        }
        if constexpr (ALIGN_EPI) { if (wr == 0) PG8_BAR; }
        if constexpr (!Epi::AFTER_DRAIN) { E(acc, cur, wr, wc, fr, fq); S.done(cur); }
        if (!has_next) break;
#pragma unroll
        for (int a = 0; a < 2; ++a)
#pragma unroll
            for (int b = 0; b < 2; ++b)
#pragma unroll
                for (int m = 0; m < 4; ++m)
#pragma unroll
                    for (int n = 0; n < 2; ++n) acc[a][b][m][n] = (f32x4){0.f, 0.f, 0.f, 0.f};
        cur = nxt; cA = nA; cB = nB; ++ui;
        if constexpr (ALIGN_EPI) { if (wr == 1) PG8_BAR; }
    }
    PG8_WAIT_V(0);
    if constexpr (!ALIGN_EPI) { if (wr == 0) PG8_BAR; }
    PG8_BAR;
    if constexpr (Epi::AFTER_DRAIN) { E.fused(acc, cur, wr, wc, fr, fq, lds, wid, lane); S.done(cur); }
#undef PG8_SA
#undef PG8_SB
#undef PG8_STAGE
#undef PG8_LDA
#undef PG8_LDB
#undef PG8_MMA
#undef PG8_WAIT_V
#undef PG8_WAIT_L
#undef PG8_BAR
#undef PG8_SCHED
}
}

constexpr int D = 2048, TP = 8192, NB = 16, TS = 16, MS = NB * TS, M = TP + MS;
constexpr int RW = 1024, RH = 16, RN = 64, RC = 3328;
constexpr int ED = 1024, EH = 4, EN = 256, EC = 4096, IC = RC + EC;
constexpr int FF = 5632, NSEQ = 17, MODW = 6 * D;
constexpr int LCH = 128, NCH = TP / LCH;
constexpr int RBLK = 256, NRB = TP / RBLK;
constexpr int NPHASE = 14;
constexpr size_t O_Y = 0, O_SHP = (size_t)M * D, O_WKP = O_SHP + RC, O_RTP = O_WKP + 65536, O_SHS = O_RTP + 262144, O_WKS = O_SHS + (size_t)NB * RC, O_RTS = O_WKS + (size_t)NB * 65536, O_END = O_RTS + (size_t)NB * 262144;
constexpr size_t MiB = 1u << 20;
constexpr size_t WS_MOD = 1 * MiB, WS_LORAT = 2 * MiB, WS_WOUTT = 4 * MiB, WS_WINT = 12 * MiB, WS_V = 12 * MiB, WS_H = 41 * MiB, WS_G = 41 * MiB, WS_BON = 58 * MiB,
                 WS_QKVG = 74 * MiB, WS_LOUT = 140 * MiB, WS_PU = 140 * MiB, WS_KVB = 172 * MiB, WS_ACT = 74 * MiB, WS_PREP = 190 * MiB, WS_MIXOUT = 190 * MiB,
                 WS_WUPT = 256 * MiB, WS_WDNT = 300 * MiB, WS_PART9 = 330 * MiB, WS_PART12 = 256 * MiB, WS_END = 355 * MiB;
constexpr size_t WS_ADAT = 190 * MiB, WS_SC = 239 * MiB, WS_MODP = 240 * MiB;
constexpr int KS9 = 4, KS12 = 11;
constexpr size_t PREP_STRIDE = 33 * MiB;
constexpr size_t DO_Z = 0, DO_LIN = 54 * MiB, DO_SPREV = 0, DO_MIX = 17 * MiB;
constexpr int LDS_BYTES = 147456;

typedef unsigned short bf16;
typedef float f32x2 __attribute__((ext_vector_type(2)));
typedef float f32x4 __attribute__((ext_vector_type(4)));
typedef short bf16x8 __attribute__((ext_vector_type(8)));
typedef unsigned u32x4 __attribute__((ext_vector_type(4)));
typedef unsigned u32x2 __attribute__((ext_vector_type(2)));
#define LDS_WAIT() asm volatile("s_waitcnt lgkmcnt(0)" ::: "memory")

__device__ __forceinline__ float bf2f(unsigned v) { return __builtin_bit_cast(float, v << 16); }
__device__ __forceinline__ unsigned f2bf(float f) { unsigned u = __builtin_bit_cast(unsigned, f); return (u + 0x7fffu + ((u >> 16) & 1u)) >> 16; }
__device__ __forceinline__ unsigned pk2(float lo, float hi) { return f2bf(lo) | (f2bf(hi) << 16); }
__device__ __forceinline__ float wave_sum(float v) {
#pragma unroll
    for (int o = 1; o < 64; o <<= 1) v += __shfl_xor(v, o);
    return v;
}
__device__ __forceinline__ float sigm(float x) { return 1.f / (1.f + __expf(-x)); }
__device__ __forceinline__ int seq_of(int m) { return m < TP ? 0 : 1 + ((m - TP) >> 4); }
__device__ __forceinline__ int tpos_of(int m) { return m < TP ? m : ((m - TP) & 15); }
__device__ __forceinline__ float ret_l2g(int h) { return __log2f(1.0f - exp2f(-5.0f - (float)h)); }

struct EpiProj {
    static constexpr bool PERM = true, AFTER_DRAIN = false;
    bf16* Z; bf16* Q;
    __device__ __forceinline__ void operator()(const f32x4 (&acc)[2][2][4][2], const pg8::Unit& u, int wr, int wc, int fr, int fq) const {
        const int row0 = u.pm * 256 + wr * 64 + fr, pn = u.pn, cl = wc * 32 + 8 * fq;
        if (pn < 13 || pn >= 21) {
            bf16* base = pn < 13 ? Z + pn * 256 + cl : Q + (pn - 13) * 256 + cl; const size_t ld = pn < 13 ? RC : EC;
#pragma unroll
            for (int ai = 0; ai < 2; ++ai)
#pragma unroll
                for (int m = 0; m < 4; ++m) { bf16* rp = base + (size_t)(row0 + ai * 128 + m * 16) * ld;
#pragma unroll
                    for (int bj = 0; bj < 2; ++bj) { const f32x4 v0 = acc[ai][bj][m][0], v1 = acc[ai][bj][m][1]; u32x4 w; w.x = pk2(v0[0], v0[1]); w.y = pk2(v0[2], v0[3]); w.z = pk2(v1[0], v1[1]); w.w = pk2(v1[2], v1[3]);
                        *(u32x4*)(rp + bj * 128) = w; } }
        } else {
            const int sec = pn - 13; bf16* base = Q + sec * 256 + cl; const float sc = sec >= 4 ? 0.0625f : 1.0f;
            float inv[8];
#pragma unroll
            for (int e = 0; e < 8; ++e) inv[e] = exp2f(-(float)(cl + e) * (13.287712379549449f / 128.0f)) * 0.15915494309189535f;
#pragma unroll
            for (int ai = 0; ai < 2; ++ai)
#pragma unroll
                for (int m = 0; m < 4; ++m) { const int row = row0 + ai * 128 + m * 16; bf16* rp = base + (size_t)row * EC;
                    const float pos = row < TP ? (float)row : (float)(2048 + ((row - TP) & 15));
                    float o1[8], o2[8];
#pragma unroll
                    for (int e = 0; e < 8; ++e) { float rev = pos * inv[e]; rev -= floorf(rev); const float sn = __builtin_amdgcn_sinf(rev), cs = __builtin_amdgcn_cosf(rev);
                        const float x1 = acc[ai][0][m][e >> 2][e & 3], x2 = acc[ai][1][m][e >> 2][e & 3];
                        o1[e] = (x1 * cs - x2 * sn) * sc; o2[e] = (x2 * cs + x1 * sn) * sc; }
                    u32x4 w; w.x = pk2(o1[0], o1[1]); w.y = pk2(o1[2], o1[3]); w.z = pk2(o1[4], o1[5]); w.w = pk2(o1[6], o1[7]); *(u32x4*)rp = w;
                    w.x = pk2(o2[0], o2[1]); w.y = pk2(o2[2], o2[3]); w.z = pk2(o2[4], o2[5]); w.w = pk2(o2[6], o2[7]); *(u32x4*)(rp + 128) = w; }
        }
    }
};
struct EpiBf16P {
    static constexpr bool PERM = true, AFTER_DRAIN = false;
    bf16* C; int ldc;
    __device__ __forceinline__ void operator()(const f32x4 (&acc)[2][2][4][2], const pg8::Unit& u, int wr, int wc, int fr, int fq) const {
        const int row0 = u.pm * 256 + wr * 64 + fr; bf16* base = C + u.pn * 256 + wc * 32 + 8 * fq;
#pragma unroll
        for (int ai = 0; ai < 2; ++ai)
#pragma unroll
            for (int m = 0; m < 4; ++m) { bf16* rp = base + (size_t)(row0 + ai * 128 + m * 16) * ldc;
#pragma unroll
                for (int bj = 0; bj < 2; ++bj) { const f32x4 v0 = acc[ai][bj][m][0], v1 = acc[ai][bj][m][1]; u32x4 w; w.x = pk2(v0[0], v0[1]); w.y = pk2(v0[2], v0[3]); w.z = pk2(v1[0], v1[1]); w.w = pk2(v1[2], v1[3]);
                    *(u32x4*)(rp + bj * 128) = w; } }
    }
};
struct EpiF32 {
    static constexpr bool PERM = true, AFTER_DRAIN = false;
    float* C; int ldc;
    __device__ __forceinline__ void operator()(const f32x4 (&acc)[2][2][4][2], const pg8::Unit& u, int wr, int wc, int fr, int fq) const {
        const int row0 = u.pm * 256 + wr * 64 + fr; float* base = C + u.pn * 256 + wc * 32 + 8 * fq;
#pragma unroll
        for (int ai = 0; ai < 2; ++ai)
#pragma unroll
            for (int m = 0; m < 4; ++m) { float* rp = base + (size_t)(row0 + ai * 128 + m * 16) * ldc;
#pragma unroll
                for (int bj = 0; bj < 2; ++bj) { *(f32x4*)(rp + bj * 128) = acc[ai][bj][m][0]; *(f32x4*)(rp + bj * 128 + 4) = acc[ai][bj][m][1]; } }
    }
};
struct EpiSwiglu {
    static constexpr bool PERM = true, AFTER_DRAIN = false;
    bf16* C;
    __device__ __forceinline__ void operator()(const f32x4 (&acc)[2][2][4][2], const pg8::Unit& u, int wr, int wc, int fr, int fq) const {
        const int row0 = u.pm * 256 + wr * 64 + fr; bf16* base = C + u.pn * 128 + wc * 32 + 8 * fq;
#pragma unroll
        for (int ai = 0; ai < 2; ++ai)
#pragma unroll
            for (int m = 0; m < 4; ++m) { float o[8];
#pragma unroll
                for (int e = 0; e < 8; ++e) { const float g = acc[ai][0][m][e >> 2][e & 3], up = acc[ai][1][m][e >> 2][e & 3]; o[e] = g * sigm(g) * up; }
                u32x4 w; w.x = pk2(o[0], o[1]); w.y = pk2(o[2], o[3]); w.z = pk2(o[4], o[5]); w.w = pk2(o[6], o[7]);
                *(u32x4*)(base + (size_t)(row0 + ai * 128 + m * 16) * FF) = w; }
    }
};
struct EpiMod {
    static constexpr bool PERM = true, AFTER_DRAIN = false;
    float* C; int ldc;
    __device__ __forceinline__ void operator()(const f32x4 (&acc)[2][2][4][2], const pg8::Unit& u, int wr, int wc, int fr, int fq) const {
        if (wr != 0) return;
        float* base = C + u.pn * 256 + wc * 32 + 8 * fq;
#pragma unroll
        for (int m = 0; m < 2; ++m) { const int row = 16 * m + fr; if (row < NSEQ) { float* rp = base + (size_t)row * ldc;
#pragma unroll
            for (int bj = 0; bj < 2; ++bj) { *(f32x4*)(rp + bj * 128) = acc[0][bj][m][0]; *(f32x4*)(rp + bj * 128 + 4) = acc[0][bj][m][1]; } } }
    }
};

__device__ __forceinline__ void transpose_item(const float* __restrict__ W, int K, int N, bf16* WT, int k0, int n0, int dst_row0, float* scr, int lane) {
#pragma unroll 8
    for (int i = 0; i < 32; ++i) { const int kk = 2 * i + (lane >> 5); scr[kk * 33 + (lane & 31)] = W[(size_t)(k0 + kk) * N + n0 + (lane & 31)]; }
    LDS_WAIT();
    const int c = lane & 7;
#pragma unroll
    for (int j = 0; j < 4; ++j) { const int n = (lane >> 3) + 8 * j; const float* s = scr + (8 * c) * 33 + n;
        u32x4 o; o.x = pk2(s[0 * 33], s[1 * 33]); o.y = pk2(s[2 * 33], s[3 * 33]); o.z = pk2(s[4 * 33], s[5 * 33]); o.w = pk2(s[6 * 33], s[7 * 33]);
        *(u32x4*)(WT + (size_t)(dst_row0 + n) * K + k0 + 8 * c) = o; }
    LDS_WAIT();
}

typedef const __attribute__((address_space(4))) f32x2* cf2p;
__device__ __forceinline__ cf2p to_c(const float* p) { return (cf2p)(unsigned long long)p; }
#define DPPF(old, src, ctrl, rmask) __builtin_bit_cast(float, __builtin_amdgcn_update_dpp(__builtin_bit_cast(int, (float)(old)), __builtin_bit_cast(int, (float)(src)), (ctrl), (rmask), 0xF, false))
__device__ __forceinline__ float wave_sum_u(float v) {
    v += DPPF(0.f, v, 0xB1, 0xF); v += DPPF(0.f, v, 0x4E, 0xF); v += DPPF(0.f, v, 0x124, 0xF); v += DPPF(0.f, v, 0x128, 0xF);
    v += DPPF(0.f, v, 0x142, 0xA); v += DPPF(0.f, v, 0x143, 0xC);
    return __builtin_bit_cast(float, __builtin_amdgcn_readlane(__builtin_bit_cast(int, v), 63));
}
constexpr int RW_PF = 6;
template <int MODE>
__device__ __forceinline__ void rwkv_run(f32x2 (&S)[32], const float* W, const float* NKK, const float* B, const float* K, const float* R, const bf16* Vp, int nsteps, int lane,
                                         const bf16* Gp, const float* BONp, bf16* MIXp, float lnw, float lnb) {
    constexpr int NPF = MODE == 2 ? 20 : (MODE == 0 ? 16 : 12);
    const int pa = lane >> 2; const float* pfp = (pa == 0 ? W : pa == 1 ? NKK : pa == 2 ? B : pa == 3 ? K : R) + (lane & 3) * 16;
    float vn = 0.f, gn = 0.f, bn = 0.f;
    if (MODE != 1) vn = bf2f(Vp[lane]);
    if (MODE == 2) { gn = bf2f(Gp[lane]); bn = BONp[0]; }
    if (lane < NPF) {
#pragma unroll
        for (int q = 1; q < RW_PF; ++q) if (q < nsteps) (void)*(volatile const float*)(pfp + (size_t)q * RW);
    }
    for (int t = 0; t < nsteps; ++t) {
        const size_t o = (size_t)t * RW;
        cf2p w = to_c(W + o), nk = to_c(NKK + o), b = to_c(B + o), k = to_c(K + o), r = to_c(R + o);
        const float v = vn, gv = gn, bon = bn;
        { const int t1 = t + 1 < nsteps ? t + 1 : t; const size_t o1 = (size_t)t1 * RW;
          if (MODE != 1) vn = bf2f(Vp[o1 + lane]);
          if (MODE == 2) { gn = bf2f(Gp[o1 + lane]); bn = BONp[(size_t)t1 * 16]; }
          const int tp = t + RW_PF < nsteps ? t + RW_PF : nsteps - 1;
          if (lane < NPF) (void)*(volatile const float*)(pfp + (size_t)tp * RW); }
        f32x2 a0 = {0.f, 0.f}, a1 = {0.f, 0.f};
#pragma unroll
        for (int j = 0; j < 32; j += 2) { a0 = __builtin_elementwise_fma(S[j], nk[j], a0); a1 = __builtin_elementwise_fma(S[j + 1], nk[j + 1], a1); }
        const float sa = (a0.x + a0.y) + (a1.x + a1.y);
        const f32x2 sa2 = {sa, sa}, v2 = {v, v};
        f32x2 o0 = {0.f, 0.f}, o1 = {0.f, 0.f};
#pragma unroll
        for (int j = 0; j < 32; ++j) {
            f32x2 s = S[j] * w[j];
            s = __builtin_elementwise_fma(sa2, b[j], s);
            if (MODE != 1) s = __builtin_elementwise_fma(v2, k[j], s);
            S[j] = s;
            if (MODE == 2) { if (j & 1) o1 = __builtin_elementwise_fma(s, r[j], o1); else o0 = __builtin_elementwise_fma(s, r[j], o0); }
        }
        if (MODE == 2) {
            const float ov = (o0.x + o0.y) + (o1.x + o1.y);
            const float mean = wave_sum_u(ov) * (1.f / 64.f), d = ov - mean, var = wave_sum_u(d * d) * (1.f / 64.f);
            float y = d * rsqrtf(var + 64e-5f) * lnw + lnb;
            y = (y + bon * v) * gv;
            MIXp[(size_t)t * D + lane] = (bf16)f2bf(y);
        }
    }
}

constexpr int RL_B = 8;
template <int MODE> struct RL { static constexpr int NV = MODE == 2 ? 5 : (MODE == 0 ? 4 : 3); static constexpr int REC = NV * 64, BUF = RL_B * REC + (MODE != 1 ? 256 : 0) + (MODE == 2 ? 256 + 16 : 0); };
#define SBAR() __builtin_amdgcn_sched_barrier(0)
template <int MODE>
__device__ __forceinline__ void rwkv_lds(f32x2 (&S)[32], const float* W, const float* NKK, const float* B, const float* K, const float* R, const bf16* Vp, int nsteps, int lane,
                                         const bf16* Gp, const float* BONp, bf16* MIXp, float lnw, float lnb, float* wl) {
    constexpr int NV = RL<MODE>::NV, REC = RL<MODE>::REC;
    const int ls = lane >> 4, lc = (lane & 15) * 4;
    f32x4 st[NV][2]; u32x4 sv = {0u, 0u, 0u, 0u}, sg = {0u, 0u, 0u, 0u}; float sb = 0.f;
#define RL_ISSUE(bt) do { const size_t ob = (size_t)((bt) * RL_B) * RW; \
        _Pragma("unroll") for (int q = 0; q < 2; ++q) { const size_t oo = ob + (size_t)(ls + 4 * q) * RW + lc; \
            st[0][q] = *(const f32x4*)(W + oo); st[1][q] = *(const f32x4*)(NKK + oo); st[2][q] = *(const f32x4*)(B + oo); if (NV >= 4) st[NV >= 4 ? 3 : 0][q] = *(const f32x4*)(K + oo); if (NV == 5) st[NV - 1][q] = *(const f32x4*)(R + oo); } \
        if (MODE != 1) sv = *(const u32x4*)(Vp + ob + (size_t)(lane >> 3) * RW + (lane & 7) * 8); \
        if (MODE == 2) { sg = *(const u32x4*)(Gp + ob + (size_t)(lane >> 3) * RW + (lane & 7) * 8); if (lane < RL_B) sb = BONp[(size_t)((bt) * RL_B + lane) * 16]; } } while (0)
#define RL_COMMIT() do { \
        _Pragma("unroll") for (int q = 0; q < 2; ++q) _Pragma("unroll") for (int v = 0; v < NV; ++v) *(f32x4*)(wl + (ls + 4 * q) * REC + v * 64 + lc) = st[v][q]; \
        if (MODE != 1) *(u32x4*)((bf16*)(wl + RL_B * REC) + (lane >> 3) * 64 + (lane & 7) * 8) = sv; \
        if (MODE == 2) { *(u32x4*)((bf16*)(wl + RL_B * REC + 256) + (lane >> 3) * 64 + (lane & 7) * 8) = sg; if (lane < RL_B) wl[RL_B * REC + 512 + lane] = sb; } } while (0)
    const int nb = nsteps / RL_B;
    RL_ISSUE(0); RL_COMMIT();
    for (int bt = 0; bt < nb; ++bt) {
        if (bt + 1 < nb) RL_ISSUE(bt + 1);
#pragma unroll 1
        for (int s = 0; s < RL_B; ++s) {
            const f32x2* w = (const f32x2*)(wl + s * REC); const f32x2* nk = w + 32; const f32x2* b = w + 64; const f32x2* k = w + 96; const f32x2* r = w + 128;
            float v = 0.f, gv = 0.f, bon = 0.f;
            if (MODE != 1) v = bf2f(((const bf16*)(wl + RL_B * REC))[s * 64 + lane]);
            if (MODE == 2) { gv = bf2f(((const bf16*)(wl + RL_B * REC + 256))[s * 64 + lane]); bon = wl[RL_B * REC + 512 + s]; }
            f32x2 nA[8], nB[8]; f32x2 a0 = {0.f, 0.f}, a1 = {0.f, 0.f};
#pragma unroll
            for (int p = 0; p < 8; ++p) nA[p] = nk[p];
#pragma unroll
            for (int g = 0; g < 4; ++g) {
                if (g < 3) {
#pragma unroll
                    for (int p = 0; p < 8; ++p) { if (g & 1) nA[p] = nk[8 * (g + 1) + p]; else nB[p] = nk[8 * (g + 1) + p]; } }
                SBAR();
#pragma unroll
                for (int p = 0; p < 8; p += 2) { a0 = __builtin_elementwise_fma(S[8 * g + p], (g & 1) ? nB[p] : nA[p], a0); a1 = __builtin_elementwise_fma(S[8 * g + p + 1], (g & 1) ? nB[p + 1] : nA[p + 1], a1); }
                SBAR();
            }
            const float sa = (a0.x + a0.y) + (a1.x + a1.y);
            const f32x2 sa2 = {sa, sa}, v2 = {v, v};
            f32x2 uw[2][4], ub[2][4], uk[2][4], ur[2][4]; f32x2 o0 = {0.f, 0.f}, o1 = {0.f, 0.f};
#pragma unroll
            for (int p = 0; p < 4; ++p) { uw[0][p] = w[p]; ub[0][p] = b[p]; if (MODE != 1) uk[0][p] = k[p]; if (MODE == 2) ur[0][p] = r[p]; }
#pragma unroll
            for (int g = 0; g < 8; ++g) {
                if (g < 7) {
#pragma unroll
                    for (int p = 0; p < 4; ++p) { uw[(g + 1) & 1][p] = w[4 * (g + 1) + p]; ub[(g + 1) & 1][p] = b[4 * (g + 1) + p]; if (MODE != 1) uk[(g + 1) & 1][p] = k[4 * (g + 1) + p]; if (MODE == 2) ur[(g + 1) & 1][p] = r[4 * (g + 1) + p]; } }
                SBAR();
#pragma unroll
                for (int p = 0; p < 4; ++p) { const int j = 4 * g + p;
                    f32x2 x = S[j] * uw[g & 1][p]; x = __builtin_elementwise_fma(sa2, ub[g & 1][p], x); if (MODE != 1) x = __builtin_elementwise_fma(v2, uk[g & 1][p], x); S[j] = x;
                    if (MODE == 2) { if (p & 1) o1 = __builtin_elementwise_fma(x, ur[g & 1][p], o1); else o0 = __builtin_elementwise_fma(x, ur[g & 1][p], o0); } }
                SBAR();
            }
            if (MODE == 2) {
                const float ov = (o0.x + o0.y) + (o1.x + o1.y);
                const float mean = wave_sum_u(ov) * (1.f / 64.f), d = ov - mean, var = wave_sum_u(d * d) * (1.f / 64.f);
                float y = d * rsqrtf(var + 64e-5f) * lnw + lnb;
                y = (y + bon * v) * gv;
                MIXp[(size_t)(bt * RL_B + s) * D + lane] = (bf16)f2bf(y);
            }
        }
        if (bt + 1 < nb) RL_COMMIT();
    }
#undef RL_ISSUE
#undef RL_COMMIT
}
#define LAS __attribute__((address_space(3)))

#define XB_TMO      128
#define XB_XCNT(j)  (256  + 64 * (j))
#define XB_XSUB(j)  (1280 + 64 * (j))
#define XB_XGEN(j)  (2304 + 64 * (j))
#define XB_TOP      3328
#define XB_TOPGEN   3392
#define XCD_BAR_WORDS 3456
#define XB_SPIN_CAP (1u << 18)

__device__ __forceinline__ unsigned xb_ld(unsigned* p)              { return __hip_atomic_load(p, __ATOMIC_RELAXED, __HIP_MEMORY_SCOPE_AGENT); }
__device__ __forceinline__ unsigned xb_add(unsigned* p, unsigned v) { return __hip_atomic_fetch_add(p, v, __ATOMIC_RELAXED, __HIP_MEMORY_SCOPE_AGENT); }
__device__ __forceinline__ unsigned xb_xcc_id() { return (unsigned)__builtin_amdgcn_s_getreg((3 << 11) | 20) & 0xFu; }
#define XB_SPIN(cond, bar) do { unsigned _sp = 0; while (cond) { __builtin_amdgcn_s_sleep(1); \
    if ((++_sp & 255u) == 0u) { if (xb_ld(&(bar)[XB_TMO])) break; if (_sp > XB_SPIN_CAP) { atomicAdd(&(bar)[XB_TMO], 1u); break; } } } } while (0)

struct XcdBarrier {
    unsigned* bar; unsigned x;
    volatile LAS unsigned* st;
};

__device__ __forceinline__ XcdBarrier xcd_barrier_post(unsigned* bar, volatile LAS unsigned* st) {
    XcdBarrier b; b.bar = bar; b.x = xb_xcc_id(); b.st = st;
    if (threadIdx.x == 0) (void)xb_add(&bar[XB_XCNT(b.x)], 1u);
    return b;
}
__device__ __forceinline__ void xcd_barrier_complete(unsigned* bar, unsigned x, unsigned& nloc, unsigned& nx) {
    const unsigned G = gridDim.x * gridDim.y * gridDim.z;
    unsigned sum, cnt, mine, sp = 0u;
    for (;;) {
        sum = 0u; cnt = 0u; mine = 0u;
#pragma unroll
        for (unsigned j = 0; j < 16; ++j) { const unsigned c = xb_ld(&bar[XB_XCNT(j)]); sum += c; cnt += (c > 0u) ? 1u : 0u; mine = (j == x) ? c : mine; }
        if (sum == G) break;
        __builtin_amdgcn_s_sleep(1);
        if ((++sp & 255u) == 0u) { if (xb_ld(&bar[XB_TMO])) break; if (sp > XB_SPIN_CAP) { atomicAdd(&bar[XB_TMO], 1u); break; } }
    }
    nloc = mine > 0u ? mine : 1u; nx = cnt > 0u ? cnt : 1u;
}

__device__ __forceinline__ void xcd_barrier(const XcdBarrier& b) {
    asm volatile("s_waitcnt vmcnt(0)" ::: "memory");
    __syncthreads();
    if (threadIdx.x == 0) {
        unsigned* bar = b.bar;
        __builtin_amdgcn_s_waitcnt(0);
        unsigned nloc = b.st[0], nx = b.st[1];
        if (nloc == 0u) { xcd_barrier_complete(bar, b.x, nloc, nx); b.st[0] = nloc; b.st[1] = nx; }
        const unsigned old = xb_add(&bar[XB_XSUB(b.x)], 1u);
        const unsigned gen = old / nloc;
        if (old + 1u == (gen + 1u) * nloc) {
            __builtin_amdgcn_fence(__ATOMIC_RELEASE, "agent");
            asm volatile("s_waitcnt vmcnt(0)" ::: "memory");
            const unsigned og = xb_add(&bar[XB_TOP], 1u);
            const unsigned tg = og / nx;
            if (og + 1u == (tg + 1u) * nx) xb_add(&bar[XB_TOPGEN], 1u);
            else XB_SPIN(xb_ld(&bar[XB_TOPGEN]) == tg, bar);
            __builtin_amdgcn_fence(__ATOMIC_ACQUIRE, "agent");
            xb_add(&bar[XB_XGEN(b.x)], 1u);
            asm volatile("s_waitcnt vmcnt(0)" ::: "memory");
        } else {
            XB_SPIN(xb_ld(&bar[XB_XGEN(b.x)]) == gen, bar);
            __builtin_amdgcn_fence(__ATOMIC_ACQUIRE, "agent");
            asm volatile("s_waitcnt vmcnt(0)" ::: "memory");
        }
    }
    __syncthreads();
}


struct Args { const float* in[30]; float* out; unsigned char* ws; int ph_lo, ph_hi; };
enum { I_XP = 0, I_XS, I_CP, I_CS, I_SSH, I_SWKV, I_SRET, I_ADAW, I_ADAB, I_GPM, I_GPOM, I_GPF, I_GPOF, I_WIN, I_MU, I_W0, I_W2, I_A0, I_A2, I_G2, I_KK, I_KA, I_RK, I_RLW, I_RLB, I_ELW, I_ELB, I_WOUT, I_WUP, I_WDN };

__global__ void __launch_bounds__(512, 2) mk_fwd(Args a) {
    extern __shared__ __attribute__((aligned(16))) unsigned char lds[];
    cg::grid_group grid = cg::this_grid();
    const int tid = threadIdx.x, lane = tid & 63, wave = __builtin_amdgcn_readfirstlane(tid >> 6);
    const int G = gridDim.x, bid = blockIdx.x, gw = bid * 8 + wave, NGW = G * 8;
    const int lo = a.ph_lo, hi = a.ph_hi;
    volatile LAS unsigned* xst = (volatile LAS unsigned*)((LAS unsigned char*)lds + LDS_BYTES - 16);
    if (tid < 2) xst[tid] = 0u;
    __syncthreads();
    XcdBarrier xb = xcd_barrier_post((unsigned*)(a.ws + 65536), xst);
    unsigned char* ws = a.ws; float* out = a.out; unsigned char* dob = (unsigned char*)a.out;
    float* MOD = (float*)(ws + WS_MOD);
    bf16* LORAT = (bf16*)(ws + WS_LORAT); bf16* WOUTT = (bf16*)(ws + WS_WOUTT); bf16* WINT = (bf16*)(ws + WS_WINT); bf16* WUPT = (bf16*)(ws + WS_WUPT); bf16* WDNT = (bf16*)(ws + WS_WDNT);
    bf16* H = (bf16*)(ws + WS_H); bf16* QKVG = (bf16*)(ws + WS_QKVG); bf16* LOUT = (bf16*)(ws + WS_LOUT); bf16* Z = (bf16*)(dob + DO_Z); bf16* LIN = (bf16*)(dob + DO_LIN);
    float* PW = (float*)(ws + WS_PREP); float* PNKK = (float*)(ws + WS_PREP + PREP_STRIDE); float* PB = (float*)(ws + WS_PREP + 2 * PREP_STRIDE); float* PK = (float*)(ws + WS_PREP + 3 * PREP_STRIDE); float* PR = (float*)(ws + WS_PREP + 4 * PREP_STRIDE);
    bf16* PV = (bf16*)(ws + WS_V); bf16* PG = (bf16*)(ws + WS_G); float* BON = (float*)(ws + WS_BON);
    float* PU = (float*)(ws + WS_PU); bf16* KVB = (bf16*)(ws + WS_KVB); bf16* SPREV = (bf16*)(dob + DO_SPREV); bf16* MIX = (bf16*)(dob + DO_MIX);
    float* MIXOUT = (float*)(ws + WS_MIXOUT); bf16* ACT = (bf16*)(ws + WS_ACT);
#ifndef DUP_PHASE
#define DUP_PHASE -1
#endif
#ifndef PH_MASK
#define PH_MASK 0x3fff
#endif
#define IN(k) (((PH_MASK >> (k)) & 1) && lo <= (k) && (k) < hi)
#ifndef TS_PROBE
#define TS_PROBE -1
#endif
    unsigned long long* TSW = (unsigned long long*)ws;
    if (TS_PROBE >= 0 && bid == 0 && tid == 0) TSW[0] = __builtin_amdgcn_s_memrealtime();
#define MID(n) do { if (TS_PROBE >= 0 && bid == 0) { __syncthreads(); if (tid == 0) TSW[32 + (n)] = __builtin_amdgcn_s_memrealtime(); } } while (0)
#define SEAM(k) do { if (IN(k) && IN((k) + 1)) { if ((k) == 0) grid.sync(); else xcd_barrier(xb); } if (TS_PROBE >= 0 && bid == 0 && tid == 0) TSW[1 + (k)] = __builtin_amdgcn_s_memrealtime(); } while (0)

    if (IN(0)) for (int rep = 0; rep < (DUP_PHASE == 0 ? 2 : 1); ++rep) {
        MID(0);
        float* scr = (float*)lds + wave * (64 * 33 + 16);
        constexpr int IT_WIN = (D / 64) * (IC / 32), IT_WOUT = (D / 64) * (D / 32), IT_ADA = (D / 64) * (MODW / 32);
        bf16* ADAT = (bf16*)(ws + WS_ADAT); bf16* SC = (bf16*)(ws + WS_SC);
        for (int it = gw; it < IT_WIN + IT_WOUT + IT_ADA; it += NGW) {
            if (it < IT_WIN) { const int nb = IC / 32, kb = it / nb, n0 = 32 * (it % nb); transpose_item(a.in[I_WIN], D, IC, WINT, 64 * kb, n0, n0, scr, lane); }
            else if (it < IT_WIN + IT_WOUT) { const int r = it - IT_WIN, nb = D / 32, kb = r / nb, n0 = 32 * (r % nb); transpose_item(a.in[I_WOUT], D, D, WOUTT, 64 * kb, n0, n0, scr, lane); }
            else { const int r = it - IT_WIN - IT_WOUT, nb = MODW / 32, kb = r / nb, n0 = 32 * (r % nb); transpose_item(a.in[I_ADAW], D, MODW, ADAT, 64 * kb, n0, n0, scr, lane); }
        }
        MID(1);
        for (int idx = bid * 512 + tid; idx < 3072 * 256; idx += G * 512) {
            const int n = idx >> 8, k = idx & 255, sec = n >> 10, nn = n & 1023; float v = 0.f;
            if (sec == 0 && k < 64) v = a.in[I_W2][k * RW + nn];
            else if (sec == 1 && k >= 64 && k < 128) v = a.in[I_A2][(k - 64) * RW + nn];
            else if (sec == 2 && k >= 128) v = a.in[I_G2][(k - 128) * RW + nn];
            LORAT[idx] = (bf16)f2bf(v);
        }
        for (int idx = bid * 512 + tid; idx < 256 * D; idx += G * 512) { const int r = idx / D, k = idx % D; float v = 0.f;
            if (r < NSEQ) { const float cv = r == 0 ? a.in[I_CP][k] : a.in[I_CS][(r - 1) * D + k]; v = cv * sigm(cv); }
            SC[idx] = (bf16)f2bf(v); }
        MID(2);
    }
    if (IN(0)) MID(3);
    SEAM(0);
    if (IN(1)) {
        { const int sl = bid / 48; pg8::Gemm g{(const bf16*)(ws + WS_SC) + sl * 512, (const bf16*)(ws + WS_ADAT) + sl * 512, 256, MODW, 512, D}; pg8::OneUnit S{0, bid % 48, bid < 192};
          EpiMod E{(float*)(ws + WS_MODP) + (size_t)sl * NSEQ * MODW, MODW};
          pg8::gemm_phase<EpiMod, pg8::OneUnit, false, true>((PG8_LAS unsigned char*)lds, g, S, E); }
        xcd_barrier(xb);
        const float* MODP = (const float*)(ws + WS_MODP);
        for (int idx = bid * 512 + tid; idx < NSEQ * MODW; idx += G * 512) { float v = a.in[I_ADAB][idx % MODW];
#pragma unroll
            for (int q = 0; q < 4; ++q) v += MODP[(size_t)q * NSEQ * MODW + idx];
            MOD[idx] = v; }
        xcd_barrier(xb);
    }
    if (IN(1)) for (int rep = 0; rep < (DUP_PHASE == 1 ? 2 : 1); ++rep) {
        for (int m = gw; m < M; m += NGW) {
            const float* xr = m < TP ? a.in[I_XP] + (size_t)m * D : a.in[I_XS] + (size_t)(m - TP) * D; const float* mod = MOD + seq_of(m) * MODW;
            f32x4 v[8]; float ss = 0.f;
#pragma unroll
            for (int j = 0; j < 8; ++j) { v[j] = *(const f32x4*)(xr + 4 * lane + 256 * j); ss += (v[j].x * v[j].x + v[j].y * v[j].y) + (v[j].z * v[j].z + v[j].w * v[j].w); }
            const float rs = rsqrtf(wave_sum(ss) * (1.f / D) + 1e-6f);
#pragma unroll
            for (int j = 0; j < 8; ++j) { const int c = 4 * lane + 256 * j; const f32x4 g = *(const f32x4*)(a.in[I_GPM] + c), s1 = *(const f32x4*)(mod + D + c), h1 = *(const f32x4*)(mod + c);
                const f32x4 h = v[j] * rs * g * (s1 + 1.f) + h1; u32x2 w; w.x = pk2(h.x, h.y); w.y = pk2(h.z, h.w); *(u32x2*)(H + (size_t)m * D + c) = w; }
        }
    }
    SEAM(1);
    if (IN(2)) for (int rep = 0; rep < (DUP_PHASE == 2 ? 2 : 1); ++rep) {
        pg8::Gemm g{H, WINT, M, IC, D, D}; pg8::StaticOrder S; S.init(M, IC, G, bid); EpiProj E{Z, QKVG};
        pg8::gemm_phase<EpiProj, pg8::StaticOrder, true, true>((PG8_LAS unsigned char*)lds, g, S, E);
    }
    SEAM(2);
    if (IN(3)) for (int rep = 0; rep < (DUP_PHASE == 3 ? 2 : 1); ++rep) {
        for (int idx = bid * 512 + tid; idx < M * 128; idx += G * 512) {
            const int m = idx >> 7, c2 = (idx & 127) * 2, c = 3072 + c2, tp = tpos_of(m), sq = seq_of(m);
            const unsigned zz = *(const unsigned*)(Z + (size_t)m * RC + c); float z0 = bf2f(zz & 0xffffu), z1 = bf2f(zz >> 16), p0 = 0.f, p1 = 0.f;
            if (tp > 0) { const unsigned pp = *(const unsigned*)(Z + (size_t)(m - 1) * RC + c); p0 = bf2f(pp & 0xffffu); p1 = bf2f(pp >> 16); }
            else if (sq > 0) { p0 = a.in[I_SSH][(size_t)(sq - 1) * RC + c]; p1 = a.in[I_SSH][(size_t)(sq - 1) * RC + c + 1]; }
            z0 = z0 + (p0 - z0) * a.in[I_MU][c]; z1 = z1 + (p1 - z1) * a.in[I_MU][c + 1];
            if (c2 < 64) { z0 = 1.f - 2.f / (__expf(2.f * z0) + 1.f); z1 = 1.f - 2.f / (__expf(2.f * z1) + 1.f); }
            else if (c2 >= 128) { z0 = sigm(z0); z1 = sigm(z1); }
            *(unsigned*)(LIN + (size_t)m * 256 + c2) = pk2(z0, z1);
        }
        for (int idx = bid * 512 + tid; idx < NSEQ * RC; idx += G * 512) { const int s = idx / RC, c = idx % RC; const int m = s == 0 ? TP - 1 : TP + 16 * (s - 1) + 15;
            out[(s == 0 ? O_SHP : O_SHS + (size_t)(s - 1) * RC) + c] = bf2f(Z[(size_t)m * RC + c]); }
    }
    SEAM(3);
    if (IN(4)) for (int rep = 0; rep < (DUP_PHASE == 4 ? 2 : 1); ++rep) {
        int k256 = 256; asm volatile("" : "+s"(k256));
        pg8::Gemm g{LIN, LORAT, M, 3072, k256, k256}; pg8::StaticOrder S; S.init(M, 3072, G, bid); EpiBf16P E{LOUT, 3072};
        pg8::gemm_phase<EpiBf16P, pg8::StaticOrder, true, true>((PG8_LAS unsigned char*)lds, g, S, E);
    }
    SEAM(4);
    if (IN(5)) for (int rep = 0; rep < (DUP_PHASE == 5 ? 2 : 1); ++rep) {
        float* prm = (float*)lds;
        __syncthreads();
        for (int idx = tid; idx < RW; idx += 512) { prm[idx] = a.in[I_MU][idx]; prm[RW + idx] = a.in[I_MU][RW + idx]; prm[2 * RW + idx] = a.in[I_MU][2 * RW + idx]; prm[3 * RW + idx] = a.in[I_W0][idx];
            prm[4 * RW + idx] = a.in[I_A0][idx]; prm[5 * RW + idx] = a.in[I_KK][idx]; prm[6 * RW + idx] = a.in[I_KA][idx]; prm[7 * RW + idx] = a.in[I_RK][idx]; }
        __syncthreads();
        for (int m = gw; m < M; m += NGW) {
            const int tp = tpos_of(m), sq = seq_of(m);
#pragma unroll 1
            for (int hp = 0; hp < 2; ++hp) {
                const int hd = hp * 8 + (lane >> 3), c0 = hd * 64 + (lane & 7) * 8;
                const bf16* zr = Z + (size_t)m * RC + c0; const bf16* lr = LOUT + (size_t)m * 3072 + c0; const float* sh0 = a.in[I_SSH] + (size_t)(sq > 0 ? sq - 1 : 0) * RC + c0;
                float zs[3][8];
#pragma unroll
                for (int q = 0; q < 3; ++q) {
                    const u32x4 ca = *(const u32x4*)(zr + q * RW); float pv[8];
                    if (tp > 0) { const u32x4 pa2 = *(const u32x4*)(zr - RC + q * RW);
#pragma unroll
                        for (int e = 0; e < 4; ++e) { pv[2 * e] = bf2f(pa2[e] & 0xffffu); pv[2 * e + 1] = bf2f(pa2[e] >> 16); } }
                    else if (sq > 0) { const f32x4 f0 = *(const f32x4*)(sh0 + q * RW), f1 = *(const f32x4*)(sh0 + q * RW + 4);
                        pv[0] = f0.x; pv[1] = f0.y; pv[2] = f0.z; pv[3] = f0.w; pv[4] = f1.x; pv[5] = f1.y; pv[6] = f1.z; pv[7] = f1.w; }
                    else {
#pragma unroll
                        for (int e = 0; e < 8; ++e) pv[e] = 0.f; }
                    const float* mu = prm + q * RW + c0;
#pragma unroll
                    for (int e = 0; e < 4; ++e) { const float z0 = bf2f(ca[e] & 0xffffu), z1 = bf2f(ca[e] >> 16);
                        zs[q][2 * e] = z0 + (pv[2 * e] - z0) * mu[2 * e]; zs[q][2 * e + 1] = z1 + (pv[2 * e + 1] - z1) * mu[2 * e + 1]; }
                }
                const u32x4 wa = *(const u32x4*)(lr), aa = *(const u32x4*)(lr + RW), ga = *(const u32x4*)(lr + 2 * RW);
                float wv[8], av[8], kkv[8], k2[8]; float s1 = 0.f, s2 = 0.f;
#pragma unroll
                for (int e = 0; e < 8; ++e) {
                    const float lwv = bf2f((e & 1) ? (wa[e >> 1] >> 16) : (wa[e >> 1] & 0xffffu)), lav = bf2f((e & 1) ? (aa[e >> 1] >> 16) : (aa[e >> 1] & 0xffffu));
                    wv[e] = __expf(-0.6065306597126334f * sigm(prm[3 * RW + c0 + e] + lwv));
                    av[e] = sigm(prm[4 * RW + c0 + e] + lav);
                    kkv[e] = zs[1][e] * prm[5 * RW + c0 + e]; s1 += kkv[e] * kkv[e];
                    k2[e] = zs[1][e] * (1.f + (av[e] - 1.f) * prm[6 * RW + c0 + e]); s2 += zs[0][e] * k2[e] * prm[7 * RW + c0 + e];
                }
                s1 += DPPF(0.f, s1, 0xB1, 0xF); s1 += DPPF(0.f, s1, 0x4E, 0xF); s1 += DPPF(0.f, s1, 0x141, 0xF);
                s2 += DPPF(0.f, s2, 0xB1, 0xF); s2 += DPPF(0.f, s2, 0x4E, 0xF); s2 += DPPF(0.f, s2, 0x141, 0xF);
                const float inrm = 1.f / fmaxf(sqrtf(s1), 1e-12f);
                const size_t o = (size_t)m * RW + c0;
#pragma unroll
                for (int e = 0; e < 2; ++e) {
                    const float k0 = kkv[4 * e] * inrm, k1 = kkv[4 * e + 1] * inrm, k2_ = kkv[4 * e + 2] * inrm, k3 = kkv[4 * e + 3] * inrm;
                    *(f32x4*)(PW + o + 4 * e) = (f32x4){wv[4 * e], wv[4 * e + 1], wv[4 * e + 2], wv[4 * e + 3]};
                    *(f32x4*)(PNKK + o + 4 * e) = (f32x4){-k0, -k1, -k2_, -k3};
                    *(f32x4*)(PB + o + 4 * e) = (f32x4){k0 * av[4 * e], k1 * av[4 * e + 1], k2_ * av[4 * e + 2], k3 * av[4 * e + 3]};
                    *(f32x4*)(PK + o + 4 * e) = (f32x4){k2[4 * e], k2[4 * e + 1], k2[4 * e + 2], k2[4 * e + 3]};
                    *(f32x4*)(PR + o + 4 * e) = (f32x4){zs[0][4 * e], zs[0][4 * e + 1], zs[0][4 * e + 2], zs[0][4 * e + 3]};
                }
                { u32x4 va;
#pragma unroll
                  for (int e = 0; e < 4; ++e) va[e] = pk2(zs[2][2 * e], zs[2][2 * e + 1]);
                  *(u32x4*)(PV + o) = va; *(u32x4*)(PG + o) = ga; }
                if ((lane & 7) == 0) BON[m * 16 + hd] = s2;
            }
        }
    }
    SEAM(5);
    if (IN(6)) for (int rep = 0; rep < (DUP_PHASE == 6 ? 2 : 1); ++rep) {
        MID(4);
        {
            float* wl = (float*)lds + wave * RL<0>::BUF;
            for (int task = gw; task < RH * NCH * 2; task += NGW) {
                const int part = task & 1, pair = task >> 1, h = pair / NCH, c = pair % NCH; const size_t o = (size_t)(c * LCH) * RW + h * 64;
                f32x2 S[32];
                if (part) {
#pragma unroll
                    for (int j = 0; j < 32; ++j) { S[j].x = (2 * j == lane) ? 1.f : 0.f; S[j].y = (2 * j + 1 == lane) ? 1.f : 0.f; }
                    rwkv_lds<1>(S, PW + o, PNKK + o, PB + o, PK + o, PR + o, PV + o, LCH, lane, nullptr, nullptr, nullptr, 0.f, 0.f, wl);
                } else {
#pragma unroll
                    for (int j = 0; j < 32; ++j) S[j] = (f32x2){0.f, 0.f};
                    rwkv_lds<0>(S, PW + o, PNKK + o, PB + o, PK + o, PR + o, PV + o, LCH, lane, nullptr, nullptr, nullptr, 0.f, 0.f, wl);
                }
                float* dst = PU + ((size_t)pair * 2 + (part ? 0 : 1)) * 4096 + lane * 64;
#pragma unroll
                for (int j = 0; j < 16; ++j) *(f32x4*)(dst + 4 * j) = (f32x4){S[2 * j].x, S[2 * j].y, S[2 * j + 1].x, S[2 * j + 1].y};
            }
        }
        __syncthreads();
        MID(5);
        bf16* kT = (bf16*)lds;
        bf16* vT = (bf16*)lds + 256 * 72;
        const int fr = lane & 15, fq = lane >> 4;
        for (int it = bid; it < EH * NRB * 2; it += G) {
            const int half = it & 1, blk = (it >> 1) % NRB, h = (it >> 1) / NRB; const float l2g = ret_l2g(h); const int m0 = blk * RBLK;
            f32x4 acc[2][8];
#pragma unroll
            for (int x = 0; x < 2; ++x)
#pragma unroll
                for (int y = 0; y < 8; ++y) acc[x][y] = (f32x4){0.f, 0.f, 0.f, 0.f};
            for (int ts = 0; ts < 4; ++ts) {
                __syncthreads();
#pragma unroll
                for (int i = 0; i < 4; ++i) { const int t = lane, dp = wave + 8 * i; const u32x4 raw = *(const u32x4*)(QKVG + (size_t)(m0 + ts * 64 + t) * EC + 1024 + h * 256 + dp * 8);
                    const float dec = exp2f(l2g * (float)(255 - (ts * 64 + t)));
#pragma unroll
                    for (int e = 0; e < 4; ++e) { const unsigned w = raw[e]; kT[(dp * 8 + 2 * e) * 72 + t] = (bf16)f2bf(bf2f(w & 0xffffu) * dec); kT[(dp * 8 + 2 * e + 1) * 72 + t] = (bf16)f2bf(bf2f(w >> 16) * dec); } }
#pragma unroll
                for (int i = 0; i < 2; ++i) { const int t = lane, ep = wave + 8 * i; const u32x4 raw = *(const u32x4*)(QKVG + (size_t)(m0 + ts * 64 + t) * EC + 2048 + h * 256 + half * 128 + ep * 8);
#pragma unroll
                    for (int e = 0; e < 4; ++e) { const unsigned w = raw[e]; vT[(ep * 8 + 2 * e) * 72 + t] = (bf16)(w & 0xffffu); vT[(ep * 8 + 2 * e + 1) * 72 + t] = (bf16)(w >> 16); } }
                __syncthreads();
#pragma unroll
                for (int kk = 0; kk < 2; ++kk) { bf16x8 af[2];
#pragma unroll
                    for (int x = 0; x < 2; ++x) af[x] = *(const bf16x8*)(kT + (32 * wave + 16 * x + fr) * 72 + kk * 32 + fq * 8);
#pragma unroll
                    for (int y = 0; y < 8; ++y) { const bf16x8 bfm = *(const bf16x8*)(vT + (16 * y + fr) * 72 + kk * 32 + fq * 8);
#pragma unroll
                        for (int x = 0; x < 2; ++x) acc[x][y] = __builtin_amdgcn_mfma_f32_16x16x32_bf16(af[x], bfm, acc[x][y], 0, 0, 0); } }
            }
            bf16* dst = KVB + ((size_t)(h * NRB + blk) * 256) * 256;
#pragma unroll
            for (int x = 0; x < 2; ++x)
#pragma unroll
                for (int y = 0; y < 8; ++y) { u32x2 w; w.x = pk2(acc[x][y][0], acc[x][y][1]); w.y = pk2(acc[x][y][2], acc[x][y][3]);
                    *(u32x2*)(dst + (size_t)(half * 128 + 16 * y + fr) * 256 + 32 * wave + 16 * x + fq * 4) = w; }
        }
    }
    if (IN(6)) MID(6);
    SEAM(6);
    if (IN(7)) for (int rep = 0; rep < (DUP_PHASE == 7 ? 2 : 1); ++rep) {
        const int nB = RH * 4;
        if (bid < nB || G <= nB) {
            float* Sb = (float*)lds;
            const int fr = lane & 15, fq = lane >> 4;
            for (int it = bid; it < nB; it += G) {
                const int h = it >> 2, g4 = it & 3; float* pu = PU + (size_t)(h * NCH) * 2 * 4096;
                __syncthreads();
                for (int idx = tid; idx < 16 * 65; idx += 512) Sb[idx] = 0.f;
                __syncthreads();
                if (wave < 4) {
                    float pa[16], pb[16]; f32x4 ua, ub;
#define PB_LOAD(dst, du, c) do { const float* pp = pu + (size_t)(c) * 2 * 4096; _Pragma("unroll") for (int kk = 0; kk < 16; ++kk) dst[kk] = pp[(4 * kk + fq) * 64 + 16 * wave + fr]; \
                        _Pragma("unroll") for (int jj = 0; jj < 4; ++jj) du[jj] = pp[4096 + (16 * g4 + 4 * fq + jj) * 64 + 16 * wave + fr]; } while (0)
                    PB_LOAD(pa, ua, 0); PB_LOAD(pb, ub, 1);
                    for (int c = 0; c < NCH; ++c) {
                        const float* Sc = Sb + (c & 1) * (16 * 65); float* Sn = Sb + ((c + 1) & 1) * (16 * 65);
                        f32x4 acc = ua, ac1 = {0.f, 0.f, 0.f, 0.f}, ac2 = ac1, ac3 = ac1;
#pragma unroll
                        for (int kk = 0; kk < 16; kk += 4) { acc = __builtin_amdgcn_mfma_f32_16x16x4f32(Sc[fr * 65 + 4 * kk + fq], pa[kk], acc, 0, 0, 0);
                            ac1 = __builtin_amdgcn_mfma_f32_16x16x4f32(Sc[fr * 65 + 4 * (kk + 1) + fq], pa[kk + 1], ac1, 0, 0, 0);
                            ac2 = __builtin_amdgcn_mfma_f32_16x16x4f32(Sc[fr * 65 + 4 * (kk + 2) + fq], pa[kk + 2], ac2, 0, 0, 0);
                            ac3 = __builtin_amdgcn_mfma_f32_16x16x4f32(Sc[fr * 65 + 4 * (kk + 3) + fq], pa[kk + 3], ac3, 0, 0, 0); }
                        acc = (acc + ac1) + (ac2 + ac3);
#pragma unroll
                        for (int jj = 0; jj < 4; ++jj) { Sn[(4 * fq + jj) * 65 + 16 * wave + fr] = acc[jj]; pu[(size_t)c * 2 * 4096 + 4096 + (16 * g4 + 4 * fq + jj) * 64 + 16 * wave + fr] = acc[jj]; }
                        if (c + 1 == NCH) {
#pragma unroll
                            for (int jj = 0; jj < 4; ++jj) out[O_WKP + (size_t)h * 4096 + (16 * g4 + 4 * fq + jj) * 64 + 16 * wave + fr] = acc[jj]; }
#pragma unroll
                        for (int kk = 0; kk < 16; ++kk) pa[kk] = pb[kk];
                        ua = ub;
                        if (c + 2 < NCH) PB_LOAD(pb, ub, c + 2);
                        asm volatile("s_waitcnt lgkmcnt(0)" ::: "memory");
                        __builtin_amdgcn_s_barrier();
                    }
#undef PB_LOAD
                } else {
                    for (int c = 0; c < NCH; ++c) __builtin_amdgcn_s_barrier();
                }
            }
        }
        if (bid >= nB || G <= nB) {
            const int nb2 = G <= nB ? G : G - nB, b2 = G <= nB ? bid : bid - nB;
            for (int it = b2 * 512 + tid; it < EH * 256 * 32; it += nb2 * 512) {
                const int h = it >> 13, e = (it >> 5) & 255, d0 = (it & 31) * 8; const float g256 = exp2f(256.f * ret_l2g(h));
                float acc[8];
#pragma unroll
                for (int q = 0; q < 8; ++q) acc[q] = 0.f;
                u32x4 kvr[NRB];
#pragma unroll
                for (int blk = 0; blk < NRB; ++blk) kvr[blk] = *(const u32x4*)(KVB + ((size_t)(h * NRB + blk) * 256 + e) * 256 + d0);
#pragma unroll
                for (int blk = 0; blk < NRB; ++blk) {
                    const size_t o = ((size_t)(h * NRB + blk) * 256 + e) * 256 + d0;
                    u32x4 w; w.x = pk2(acc[0], acc[1]); w.y = pk2(acc[2], acc[3]); w.z = pk2(acc[4], acc[5]); w.w = pk2(acc[6], acc[7]); *(u32x4*)(SPREV + o) = w;
                    const u32x4 kv = kvr[blk];
#pragma unroll
                    for (int q = 0; q < 4; ++q) { acc[2 * q] = acc[2 * q] * g256 + bf2f(kv[q] & 0xffffu); acc[2 * q + 1] = acc[2 * q + 1] * g256 + bf2f(kv[q] >> 16); }
                }
#pragma unroll
                for (int q = 0; q < 8; ++q) out[O_RTP + (size_t)h * 65536 + (size_t)(d0 + q) * 256 + e] = acc[q];
            }
            asm volatile("s_waitcnt vmcnt(0)" ::: "memory");
            __syncthreads();
            if (tid == 0) {
                unsigned* cw = (unsigned*)(a.ws + 65536) + XCD_BAR_WORDS + 64;
                __builtin_amdgcn_fence(__ATOMIC_RELEASE, "agent");
                asm volatile("s_waitcnt vmcnt(0)" ::: "memory");
                (void)xb_add(cw, 1u);
            }
        }
        {
            const int nscan = G <= nB ? G : G - nB;
            unsigned* cw = (unsigned*)(a.ws + 65536) + XCD_BAR_WORDS + 64; unsigned* cq = cw + 32;
            if (tid == 0) {
                unsigned sp = 0u; while (xb_ld(cw) < (unsigned)nscan) { __builtin_amdgcn_s_sleep(1); if (++sp > (1u << 22)) break; }
                __builtin_amdgcn_fence(__ATOMIC_ACQUIRE, "agent");
                asm volatile("s_waitcnt vmcnt(0)" ::: "memory");
            }
            __syncthreads();
            {
                const int fr = lane & 15, fq = lane >> 4;
                for (;;) {
                    __syncthreads();
                    if (tid == 0) xst[2] = xb_add(cq, 1u);
                    __syncthreads();
                    const int qi = (int)xst[2];
                    if (qi >= EH * (TP / 64)) break;
                    const int it = ((qi & 127) >> 5) * (TP / 64) + (qi & 31) * 4 + (3 - (qi >> 7));
                    {
                    const int h = it / (TP / 64), n = it % (TP / 64), blk = n >> 2, i = n & 3, m0 = n * 64; const float l2g = ret_l2g(h);
                    bf16* qL = (bf16*)lds; bf16* kL = qL + 64 * 264; bf16* vT = kL + 64 * 264; bf16* pL = vT + 256 * 72; float* red = (float*)(pL + 64 * 72);
#pragma unroll
                    for (int x = 0; x < 4; ++x) { const int p = tid + 512 * x, t = p >> 5, dp = p & 31; *(u32x4*)(qL + t * 264 + dp * 8) = *(const u32x4*)(QKVG + (size_t)(m0 + t) * EC + h * 256 + dp * 8); }
                    u32x4 kr[4], vr[4];
#define R3_LOADKV(jn) do { const int ms_ = (blk * 4 + (jn)) * 64; \
        _Pragma("unroll") for (int x = 0; x < 4; ++x) { const int p = tid + 512 * x; kr[x] = *(const u32x4*)(QKVG + (size_t)(ms_ + (p >> 5)) * EC + 1024 + h * 256 + (p & 31) * 8); \
            vr[x] = *(const u32x4*)(QKVG + (size_t)(ms_ + lane) * EC + 2048 + h * 256 + (wave + 8 * x) * 8); } } while (0)
                    R3_LOADKV(0);
                    __syncthreads();
                    f32x4 acc[4][2];
#pragma unroll
                    for (int x = 0; x < 4; ++x)
#pragma unroll
                        for (int y = 0; y < 2; ++y) acc[x][y] = (f32x4){0.f, 0.f, 0.f, 0.f};
                    if (blk > 0) {
                        const bf16* sp = SPREV + ((size_t)(h * NRB + blk) * 256) * 256;
#pragma unroll 2
                        for (int kk = 0; kk < 8; ++kk) { bf16x8 bfm[2];
#pragma unroll
                            for (int y = 0; y < 2; ++y) bfm[y] = *(const bf16x8*)(sp + (size_t)(32 * wave + 16 * y + fr) * 256 + kk * 32 + fq * 8);
#pragma unroll
                            for (int x = 0; x < 4; ++x) { const bf16x8 af = *(const bf16x8*)(qL + (16 * x + fr) * 264 + kk * 32 + fq * 8);
#pragma unroll
                                for (int y = 0; y < 2; ++y) acc[x][y] = __builtin_amdgcn_mfma_f32_16x16x32_bf16(af, bfm[y], acc[x][y], 0, 0, 0); } }
#pragma unroll
                        for (int x = 0; x < 4; ++x)
#pragma unroll
                            for (int jj = 0; jj < 4; ++jj) { const float qd = exp2f(l2g * (float)(64 * i + 16 * x + fq * 4 + jj + 1)); acc[x][0][jj] *= qd; acc[x][1][jj] *= qd; }
                    }
                    for (int j = 0; j <= i; ++j) {
                        __syncthreads();
#pragma unroll
                        for (int x = 0; x < 4; ++x) { const int p = tid + 512 * x, t = p >> 5, dp = p & 31; *(u32x4*)(kL + t * 264 + dp * 8) = kr[x]; }
#pragma unroll
                        for (int x = 0; x < 4; ++x) { const int t = lane, dp = wave + 8 * x;
                            const u32x4 raw = vr[x];
#pragma unroll
                            for (int e = 0; e < 4; ++e) { const unsigned w = raw[e]; vT[(dp * 8 + 2 * e) * 72 + t] = (bf16)(w & 0xffffu); vT[(dp * 8 + 2 * e + 1) * 72 + t] = (bf16)(w >> 16); } }
                        if (j < i) R3_LOADKV(j + 1);
                        __syncthreads();
                        { const int tr = wave >> 1, tc0 = (wave & 1) * 2; f32x4 sa[2] = {(f32x4){0.f, 0.f, 0.f, 0.f}, (f32x4){0.f, 0.f, 0.f, 0.f}};
#pragma unroll
                            for (int kk = 0; kk < 8; ++kk) { const bf16x8 af = *(const bf16x8*)(qL + (16 * tr + fr) * 264 + kk * 32 + fq * 8);
#pragma unroll
                                for (int y = 0; y < 2; ++y) { const bf16x8 bfm = *(const bf16x8*)(kL + (16 * (tc0 + y) + fr) * 264 + kk * 32 + fq * 8); sa[y] = __builtin_amdgcn_mfma_f32_16x16x32_bf16(af, bfm, sa[y], 0, 0, 0); } }
#pragma unroll
                            for (int y = 0; y < 2; ++y)
#pragma unroll
                                for (int jj = 0; jj < 4; ++jj) { const int t = 16 * tr + fq * 4 + jj, s = 16 * (tc0 + y) + fr; const int dist = (j < i) ? 64 * (i - j) + t - s : (t > s ? t - s : s - t);
                                    pL[t * 72 + s] = (bf16)f2bf(sa[y][jj] * exp2f(l2g * (float)dist)); } }
                        __syncthreads();
#pragma unroll
                        for (int kk = 0; kk < 2; ++kk) { bf16x8 bfm[2];
#pragma unroll
                            for (int y = 0; y < 2; ++y) bfm[y] = *(const bf16x8*)(vT + (32 * wave + 16 * y + fr) * 72 + kk * 32 + fq * 8);
#pragma unroll
                            for (int x = 0; x < 4; ++x) { const bf16x8 af = *(const bf16x8*)(pL + (16 * x + fr) * 72 + kk * 32 + fq * 8);
#pragma unroll
                                for (int y = 0; y < 2; ++y) acc[x][y] = __builtin_amdgcn_mfma_f32_16x16x32_bf16(af, bfm[y], acc[x][y], 0, 0, 0); } }
                    }
#undef R3_LOADKV
                    const int et = tid >> 3, e0 = (tid & 7) * 32;
                    u32x4 g4[4];
#pragma unroll
                    for (int q4 = 0; q4 < 4; ++q4) g4[q4] = *(const u32x4*)(QKVG + (size_t)(m0 + et) * EC + 3072 + h * 256 + e0 + 8 * q4);
                    __syncthreads();
                    float* OT = (float*)lds;
#pragma unroll
                    for (int x = 0; x < 4; ++x)
#pragma unroll
                        for (int y = 0; y < 2; ++y)
#pragma unroll
                            for (int jj = 0; jj < 4; ++jj) OT[(16 * x + fq * 4 + jj) * 260 + 32 * wave + 16 * y + fr] = acc[x][y][jj];
                    __syncthreads();
                    f32x4 ov[8]; float s1 = 0.f, s2 = 0.f;
#pragma unroll
                    for (int q8 = 0; q8 < 8; ++q8) { ov[q8] = *(const f32x4*)(OT + et * 260 + e0 + 4 * q8); s1 += (ov[q8].x + ov[q8].y) + (ov[q8].z + ov[q8].w);
                        s2 += (ov[q8].x * ov[q8].x + ov[q8].y * ov[q8].y) + (ov[q8].z * ov[q8].z + ov[q8].w * ov[q8].w); }
                    s1 += DPPF(0.f, s1, 0xB1, 0xF); s1 += DPPF(0.f, s1, 0x4E, 0xF); s1 += DPPF(0.f, s1, 0x141, 0xF);
                    s2 += DPPF(0.f, s2, 0xB1, 0xF); s2 += DPPF(0.f, s2, 0x4E, 0xF); s2 += DPPF(0.f, s2, 0x141, 0xF);
                    const float mean = s1 * (1.f / 256.f), var = s2 * (1.f / 256.f) - mean * mean, rstd = rsqrtf(var + 1e-5f);
                    const float* lwp = a.in[I_ELW] + h * 256 + e0; const float* lbp = a.in[I_ELB] + h * 256 + e0;
                    bf16* mp = MIX + (size_t)(m0 + et) * D + RW + h * 256 + e0;
#pragma unroll
                    for (int q4 = 0; q4 < 4; ++q4) { float o8[8];
#pragma unroll
                        for (int hh = 0; hh < 2; ++hh) { const f32x4 w4 = *(const f32x4*)(lwp + 8 * q4 + 4 * hh), b4 = *(const f32x4*)(lbp + 8 * q4 + 4 * hh); const f32x4 vv = ov[2 * q4 + hh];
                            const unsigned ga = g4[q4][2 * hh], gb = g4[q4][2 * hh + 1]; const float t0 = bf2f(ga & 0xffffu), t1 = bf2f(ga >> 16), t2 = bf2f(gb & 0xffffu), t3 = bf2f(gb >> 16);
                            o8[4 * hh] = ((vv.x - mean) * rstd * w4.x + b4.x) * t0 * sigm(t0); o8[4 * hh + 1] = ((vv.y - mean) * rstd * w4.y + b4.y) * t1 * sigm(t1);
                            o8[4 * hh + 2] = ((vv.z - mean) * rstd * w4.z + b4.z) * t2 * sigm(t2); o8[4 * hh + 3] = ((vv.w - mean) * rstd * w4.w + b4.w) * t3 * sigm(t3); }
                        u32x4 w; w.x = pk2(o8[0], o8[1]); w.y = pk2(o8[2], o8[3]); w.z = pk2(o8[4], o8[5]); w.w = pk2(o8[6], o8[7]); *(u32x4*)(mp + 8 * q4) = w; }

                    }
                }
            }
        }
    }
    if (IN(7)) MID(10);
    SEAM(7);
    if (IN(8)) for (int rep = 0; rep < (DUP_PHASE == 8 ? 2 : 1); ++rep) {
        MID(7);
        if (wave < 5) {
            float* wl = (float*)lds + wave * RL<2>::BUF;
            const int ntask = wave < 4 ? RH * NCH : NB * RH;
            for (int task = wave < 4 ? bid * 4 + wave : bid; task < ntask; task += (wave < 4 ? G * 4 : G)) {
                f32x2 S[32]; int h, m0, nsteps; float* sdst = nullptr;
                if (wave < 4) { h = task / NCH; const int c = task % NCH; m0 = c * LCH; nsteps = LCH;
                    if (c == 0) {
#pragma unroll
                        for (int j = 0; j < 32; ++j) S[j] = (f32x2){0.f, 0.f};
                    } else { const float* src = PU + ((size_t)(h * NCH + c - 1) * 2 + 1) * 4096 + lane * 64;
#pragma unroll
                        for (int j = 0; j < 16; ++j) { const f32x4 q = *(const f32x4*)(src + 4 * j); S[2 * j] = (f32x2){q.x, q.y}; S[2 * j + 1] = (f32x2){q.z, q.w}; } }
                } else { const int b = task / RH; h = task % RH; m0 = TP + 16 * b; nsteps = TS;
                    const float* src = a.in[I_SWKV] + ((size_t)(b * RH + h) * 64 + lane) * 64; sdst = out + O_WKS + ((size_t)(b * RH + h) * 64 + lane) * 64;
#pragma unroll
                    for (int j = 0; j < 16; ++j) { const f32x4 q = *(const f32x4*)(src + 4 * j); S[2 * j] = (f32x2){q.x, q.y}; S[2 * j + 1] = (f32x2){q.z, q.w}; } }
                const size_t o = (size_t)m0 * RW + h * 64;
                rwkv_lds<2>(S, PW + o, PNKK + o, PB + o, PK + o, PR + o, PV + o, nsteps, lane, PG + o, BON + (size_t)m0 * 16 + h, MIX + (size_t)m0 * D + h * 64,
                            a.in[I_RLW][h * 64 + lane], a.in[I_RLB][h * 64 + lane], wl);
                if (sdst) {
#pragma unroll
                    for (int j = 0; j < 16; ++j) *(f32x4*)(sdst + 4 * j) = (f32x4){S[2 * j].x, S[2 * j].y, S[2 * j + 1].x, S[2 * j + 1].y}; }
            }
        }
        MID(8);
        {
            const int nb2 = G, b2 = bid;
            const int fr = lane & 15, fq = lane >> 4;
            for (int it0 = b2; it0 < NB * EH * 4; it0 += nb2) {
                const int it = EH * (TP / 64) + it0;
                __syncthreads();
#ifndef NO_RS
                {
                    const int r = it - EH * (TP / 64), tq = r & 3, b = (r >> 2) / EH, h = (r >> 2) % EH, m0 = TP + 16 * b; const float l2g = ret_l2g(h);
                    float* qf = (float*)lds; float* kf = qf + 4 * 260; float* vf = kf + 16 * 257; float* pf = vf + 16 * 257; float* red = pf + 64;
                    for (int idx = tid; idx < 16 * 256; idx += 512) { const int t = idx >> 8, dd = idx & 255; const bf16* src = QKVG + (size_t)(m0 + t) * EC + h * 256 + dd;
                        if ((t >> 2) == tq) qf[(t & 3) * 260 + dd] = bf2f(src[0]);
                        kf[t * 257 + dd] = bf2f(src[1024]); vf[t * 257 + dd] = bf2f(src[2048]); }
                    __syncthreads();
                    if (tid < 64) { const int tl = tid >> 4, s = tid & 15, t = 4 * tq + tl; float sc = 0.f;
#pragma unroll 4
                        for (int dd = 0; dd < 256; ++dd) sc += qf[tl * 260 + dd] * kf[s * 257 + dd];
                        pf[tl * 16 + s] = sc * exp2f(l2g * (float)(t > s ? t - s : s - t)); }
                    __syncthreads();
                    const int e = tid & 255, th = tid >> 8; const float* S0 = a.in[I_SRET] + (size_t)(b * EH + h) * 65536;
                    float oc[2] = {0.f, 0.f};
#pragma unroll 4
                    for (int dd = 0; dd < 256; dd += 4) { const f32x4 qa = *(const f32x4*)(qf + (2 * th) * 260 + dd), qb = *(const f32x4*)(qf + (2 * th + 1) * 260 + dd);
                        const float s0 = S0[(size_t)dd * 256 + e], s1 = S0[(size_t)(dd + 1) * 256 + e], s2 = S0[(size_t)(dd + 2) * 256 + e], s3 = S0[(size_t)(dd + 3) * 256 + e];
                        oc[0] += qa.x * s0 + qa.y * s1 + qa.z * s2 + qa.w * s3; oc[1] += qb.x * s0 + qb.y * s1 + qb.z * s2 + qb.w * s3; }
#pragma unroll
                    for (int tt = 0; tt < 2; ++tt) { const int tl = 2 * th + tt, t = 4 * tq + tl; float v = oc[tt] * exp2f(l2g * (float)(t + 1));
#pragma unroll 4
                        for (int s = 0; s < 16; ++s) v += pf[tl * 16 + s] * vf[s * 257 + e];
                        oc[tt] = v; }
                    { const float g16 = exp2f(16.f * l2g); float* dst = out + O_RTS + (size_t)(b * EH + h) * 65536; float vd[16];
#pragma unroll
                        for (int t = 0; t < 16; ++t) vd[t] = vf[t * 257 + e] * exp2f(l2g * (float)(15 - t));
#pragma unroll 4
                        for (int dd = 64 * tq + 32 * th; dd < 64 * tq + 32 * th + 32; ++dd) { float v = g16 * S0[(size_t)dd * 256 + e];
#pragma unroll
                            for (int t = 0; t < 16; ++t) v += kf[t * 257 + dd] * vd[t];
                            dst[(size_t)dd * 256 + e] = v; } }
#pragma unroll
                    for (int tt = 0; tt < 2; ++tt) { const float s1 = wave_sum(oc[tt]), s2 = wave_sum(oc[tt] * oc[tt]); if (lane == 0) { const int tl = 2 * th + tt; red[(tl * 4 + (wave & 3)) * 2] = s1; red[(tl * 4 + (wave & 3)) * 2 + 1] = s2; } }
                    __syncthreads();
                    const float lw = a.in[I_ELW][h * 256 + e], lb = a.in[I_ELB][h * 256 + e];
#pragma unroll
                    for (int tt = 0; tt < 2; ++tt) { const int tl = 2 * th + tt, t = 4 * tq + tl; float s1 = 0.f, s2 = 0.f;
#pragma unroll
                        for (int w4 = 0; w4 < 4; ++w4) { s1 += red[(tl * 4 + w4) * 2]; s2 += red[(tl * 4 + w4) * 2 + 1]; }
                        const float mean = s1 * (1.f / 256.f), var = s2 * (1.f / 256.f) - mean * mean, rstd = rsqrtf(var + 1e-5f);
                        const float gt = bf2f(QKVG[(size_t)(m0 + t) * EC + 3072 + h * 256 + e]);
                        MIX[(size_t)(m0 + t) * D + RW + h * 256 + e] = (bf16)f2bf(((oc[tt] - mean) * rstd * lw + lb) * gt * sigm(gt)); }
                }
#else
                {}
#endif
            }
        }
    }
    if (IN(8)) MID(9);
    SEAM(8);
    if (IN(9)) for (int rep = 0; rep < (DUP_PHASE == 9 ? 2 : 1); ++rep) {
        { pg8::Gemm g{MIX, WOUTT, TP, D, D, D}; pg8::StaticOrder S; S.init(TP, D, G, bid); EpiF32 E{MIXOUT, D};
          pg8::gemm_phase<EpiF32, pg8::StaticOrder, true, true>((PG8_LAS unsigned char*)lds, g, S, E); }
        { const int sl = bid >> 3; pg8::Gemm g{MIX + (size_t)TP * D + sl * 512, WOUTT + sl * 512, MS, D, 512, D}; pg8::OneUnit S{0, bid & 7, bid < 8 * KS9}; EpiF32 E{(float*)(ws + WS_PART9) + (size_t)sl * MS * D, D};
          pg8::gemm_phase<EpiF32, pg8::OneUnit, false, true>((PG8_LAS unsigned char*)lds, g, S, E); }
        if (G > 8 * KS9 && bid >= 8 * KS9) {
            float* scr = (float*)lds + wave * (64 * 33 + 16);
            for (int r = (bid - 8 * KS9) * 8 + wave; r < (FF / 64) * (D / 32); r += (G - 8 * KS9) * 8) { const int nb = D / 32, kb = r / nb, n0 = 32 * (r % nb); transpose_item(a.in[I_WDN], FF, D, WDNT, 64 * kb, n0, n0, scr, lane); }
        }
    }
    SEAM(9);
    if (IN(10)) for (int rep = 0; rep < (DUP_PHASE == 10 ? 2 : 1); ++rep) {
        for (int m = gw; m < M; m += NGW) {
            const float* xr = m < TP ? a.in[I_XP] + (size_t)m * D : a.in[I_XS] + (size_t)(m - TP) * D; const float* mod = MOD + seq_of(m) * MODW; const float* mr = MIXOUT + (size_t)m * D;
            f32x4 v[8]; float ss = 0.f;
#pragma unroll
            for (int j = 0; j < 8; ++j) {
                if (m < TP) v[j] = *(const f32x4*)(mr + 4 * lane + 256 * j);
                else { const float* pr = (const float*)(ws + WS_PART9) + (size_t)(m - TP) * D + 4 * lane + 256 * j; v[j] = *(const f32x4*)pr;
#pragma unroll
                    for (int q = 1; q < KS9; ++q) v[j] += *(const f32x4*)(pr + (size_t)q * MS * D); }
                ss += (v[j].x * v[j].x + v[j].y * v[j].y) + (v[j].z * v[j].z + v[j].w * v[j].w); }
            const float rs = rsqrtf(wave_sum(ss) * (1.f / D) + 1e-6f); float s2 = 0.f;
#pragma unroll
            for (int j = 0; j < 8; ++j) { const int c = 4 * lane + 256 * j; const f32x4 g = *(const f32x4*)(a.in[I_GPOM] + c), gt = *(const f32x4*)(mod + 2 * D + c), x = *(const f32x4*)(xr + c);
                v[j] = x + gt * (v[j] * rs * g); *(f32x4*)(out + (size_t)m * D + c) = v[j]; s2 += (v[j].x * v[j].x + v[j].y * v[j].y) + (v[j].z * v[j].z + v[j].w * v[j].w); }
            const float rs2 = rsqrtf(wave_sum(s2) * (1.f / D) + 1e-6f);
#pragma unroll
            for (int j = 0; j < 8; ++j) { const int c = 4 * lane + 256 * j; const f32x4 g = *(const f32x4*)(a.in[I_GPF] + c), s1 = *(const f32x4*)(mod + 4 * D + c), h1 = *(const f32x4*)(mod + 3 * D + c);
                const f32x4 h = v[j] * rs2 * g * (s1 + 1.f) + h1; u32x2 w; w.x = pk2(h.x, h.y); w.y = pk2(h.z, h.w); *(u32x2*)(H + (size_t)m * D + c) = w; }
        }
        float* scr = (float*)lds + wave * (64 * 33 + 16);
        constexpr int IT_UP = (D / 64) * (2 * FF / 32), IT_DN = (FF / 64) * (D / 32);
        for (int it = gw; it < IT_UP + (G > 8 * KS9 ? 0 : IT_DN); it += NGW) {
            if (it < IT_UP) { const int nb = 2 * FF / 32, kb = it / nb, n0 = 32 * (it % nb); const int nn = n0 < FF ? n0 : n0 - FF; const int dr = 256 * (nn >> 7) + (n0 < FF ? 0 : 128) + (nn & 127);
                transpose_item(a.in[I_WUP], D, 2 * FF, WUPT, 64 * kb, n0, dr, scr, lane); }
            else { const int r = it - IT_UP, nb = D / 32, kb = r / nb, n0 = 32 * (r % nb); transpose_item(a.in[I_WDN], FF, D, WDNT, 64 * kb, n0, n0, scr, lane); }
        }
    }
    SEAM(10);
    if (IN(11)) for (int rep = 0; rep < (DUP_PHASE == 11 ? 2 : 1); ++rep) {
        pg8::Gemm g{H, WUPT, M, 2 * FF, D, D}; pg8::StaticOrder S; S.init(M, 2 * FF, G, bid); EpiSwiglu E{ACT};
        pg8::gemm_phase<EpiSwiglu, pg8::StaticOrder, true, true>((PG8_LAS unsigned char*)lds, g, S, E);
    }
    SEAM(11);
    if (IN(12)) for (int rep = 0; rep < (DUP_PHASE == 12 ? 2 : 1); ++rep) {
        { pg8::Gemm g{ACT, WDNT, TP, D, FF, FF}; pg8::StaticOrder S; S.init(TP, D, G, bid); EpiF32 E{MIXOUT, D};
          pg8::gemm_phase<EpiF32, pg8::StaticOrder, true, true>((PG8_LAS unsigned char*)lds, g, S, E); }
        { const int sl = bid >> 3; pg8::Gemm g{ACT + (size_t)TP * FF + sl * 512, WDNT + sl * 512, MS, D, 512, FF}; pg8::OneUnit S{0, bid & 7, bid < 8 * KS12}; EpiF32 E{(float*)(ws + WS_PART12) + (size_t)sl * MS * D, D};
          pg8::gemm_phase<EpiF32, pg8::OneUnit, false, true>((PG8_LAS unsigned char*)lds, g, S, E); }
    }
    SEAM(12);
    if (IN(13)) for (int rep = 0; rep < (DUP_PHASE == 13 ? 2 : 1); ++rep) {
        for (int m = gw; m < M; m += NGW) {
            const float* mod = MOD + seq_of(m) * MODW; const float* fr_ = MIXOUT + (size_t)m * D;
            f32x4 v[8]; float ss = 0.f;
#pragma unroll
            for (int j = 0; j < 8; ++j) {
                if (m < TP) v[j] = *(const f32x4*)(fr_ + 4 * lane + 256 * j);
                else { const float* pr = (const float*)(ws + WS_PART12) + (size_t)(m - TP) * D + 4 * lane + 256 * j; v[j] = *(const f32x4*)pr;
#pragma unroll
                    for (int q = 1; q < KS12; ++q) v[j] += *(const f32x4*)(pr + (size_t)q * MS * D); }
                ss += (v[j].x * v[j].x + v[j].y * v[j].y) + (v[j].z * v[j].z + v[j].w * v[j].w); }
            const float rs = rsqrtf(wave_sum(ss) * (1.f / D) + 1e-6f);
#pragma unroll
            for (int j = 0; j < 8; ++j) { const int c = 4 * lane + 256 * j; const f32x4 g = *(const f32x4*)(a.in[I_GPOF] + c), gt = *(const f32x4*)(mod + 5 * D + c), x = *(const f32x4*)(out + (size_t)m * D + c);
                *(f32x4*)(out + (size_t)m * D + c) = x + gt * (v[j] * rs * g); }
        }
    }
    if (TS_PROBE >= 0) {
        xcd_barrier(xb);
        if (bid == 0 && tid == 0) TSW[14] = __builtin_amdgcn_s_memrealtime();
        if (bid == 0) { __syncthreads(); const float us = TS_PROBE >= 100 ? (float)(TSW[32 + TS_PROBE - 100] - TSW[32 + TS_PROBE - 101]) * 0.01f : (float)(TSW[1 + TS_PROBE] - TSW[TS_PROBE]) * 0.01f; const float eps = sqrtf(us * 1e-4f);
            for (int c = tid; c < RC; c += 512) out[O_SHP + c] *= (1.f + eps); }
    }
#undef IN
#undef SEAM
}

extern "C" void kernel_launch(void* const* d_in, const int* in_sizes, int n_in, void* d_out, int out_size, void* d_ws, size_t ws_size, hipStream_t stream) {
    static int grid = 0;
    if (grid == 0) {
        if (n_in != 30 || (size_t)out_size != O_END || ws_size < WS_END) { fprintf(stderr, "kernel_launch: unexpected sizes n_in %d out %d ws %zu\n", n_in, out_size, ws_size); grid = -1; return; }
        int dev = 0, cus = 0, per_cu = 0;
        (void)hipGetDevice(&dev); (void)hipDeviceGetAttribute(&cus, hipDeviceAttributeMultiprocessorCount, dev);
        if (hipFuncSetAttribute((const void*)mk_fwd, hipFuncAttributeMaxDynamicSharedMemorySize, LDS_BYTES) != hipSuccess) { fprintf(stderr, "kernel_launch: hipFuncSetAttribute failed\n"); grid = -1; return; }
        if (hipOccupancyMaxActiveBlocksPerMultiprocessor(&per_cu, (const void*)mk_fwd, 512, LDS_BYTES) != hipSuccess || per_cu < 1) { fprintf(stderr, "kernel_launch: occupancy query says %d\n", per_cu); per_cu = 1; }
        (void)hipGetLastError();
        grid = cus;
        if (grid <= 0) grid = 256;
    }
    if (grid < 0) return;
    (void)hipMemsetAsync((char*)d_ws + 65536, 0, XCD_BAR_WORDS * 4 + 512, stream);
    Args a{};
    for (int i = 0; i < 30; ++i) a.in[i] = (const float*)d_in[i];
    a.out = (float*)d_out; a.ws = (unsigned char*)d_ws;
    a.ph_lo = 0; a.ph_hi = NPHASE;
    void* args[] = {&a};
    hipError_t e = hipLaunchCooperativeKernel((const void*)mk_fwd, dim3(grid), dim3(512), args, LDS_BYTES, stream);
    if (e != hipSuccess) fprintf(stderr, "kernel_launch: cooperative launch failed: %s (grid %d)\n", hipGetErrorString(e), grid);
}
```

```cpp
#include <hip/hip_runtime.h>
#include <hip/hip_cooperative_groups.h>
#include <cstdio>
#include <cstdint>
namespace cg = cooperative_groups;
namespace pg8 {
#define PG8_LAS __attribute__((address_space(3)))
typedef unsigned short bf16_t;
typedef short bf16x8 __attribute__((ext_vector_type(8)));
typedef float f32x4 __attribute__((ext_vector_type(4)));
typedef unsigned u32x4 __attribute__((ext_vector_type(4)));
constexpr int BM = 256, BK = 64, HALF = 128, HTB = HALF * BK * 2  , STAGE_BYTES = 8 * HTB, NXCD = 8, WGM = 8;

__host__ __device__ __forceinline__ int lds_byte(int r, int c) { const int st = (r >> 4) * 2 + (c >> 5), rr = r & 15, cc = c & 31, ob = rr * 64 + cc * 2; return st * 1024 + (ob ^ (((ob >> 9) & 1) << 5)); }
__host__ __device__ __forceinline__ void stage_rc(int b, int& R, int& C) { const int st = b / 1024, sb = b % 1024, swz = sb ^ (((sb >> 9) & 1) << 5); R = (st >> 1) * 16 + swz / 64; C = (st & 1) * 32 + (swz % 64) / 2; }
__host__ __device__ __forceinline__ int perm32(int rho) { const int n = rho >> 4, i = rho & 15; return 8 * (i >> 2) + 4 * n + (i & 3); }

struct Unit { int pm, pn; };
struct Gemm { const bf16_t* A; const bf16_t* Bt; int M, N, K, ld; };

struct OneUnit {
    int pm, pn; bool active;
    __device__ __forceinline__ bool next(int i, Unit& u) const { if (i > 0 || !active) return false; u.pm = pm; u.pn = pn; return true; }
    __device__ __forceinline__ void a_ready(const Unit&) const {}
    __device__ __forceinline__ void done(const Unit&) const {}
};
struct StaticOrder {
    int nM, nN, nwg, G, c;
    __host__ __device__ void init(int M, int N, int G_, int c_) { nM = M / BM; nN = N / BM; nwg = nM * nN; G = G_; c = c_; }
    __host__ __device__ bool next(int i, Unit& u) const {
        const long L = (long)i * G + c; if (L >= nwg) return false;
        int wgid = (int)L; { const int q = nwg / NXCD, r = nwg % NXCD, xcd = wgid % NXCD, off = wgid / NXCD; wgid = (xcd < r ? xcd * (q + 1) : r * (q + 1) + (xcd - r) * q) + off; }
        const int nig = WGM * nN, gid = wgid / nig, fm = gid * WGM, gsz = (nM - fm) < WGM ? (nM - fm) : WGM;
        u.pm = fm + ((wgid % nig) % gsz); u.pn = (wgid % nig) / gsz; return true;
    }
    __device__ __forceinline__ void a_ready(const Unit&) const {}
    __device__ __forceinline__ void done(const Unit&) const {}
};

__device__ __forceinline__ unsigned cvt_pk_bf16(float lo, float hi) { unsigned r; asm volatile("v_cvt_pk_bf16_f32 %0, %1, %2" : "=v"(r) : "v"(lo), "v"(hi)); return r; }
template <class Epi, class Sched, bool ALIGN_EPI = false, bool SP2 = false>
__device__ __forceinline__ void gemm_phase(PG8_LAS unsigned char* lds, const Gemm g, const Sched& S, const Epi& E) {
    const int tid = threadIdx.x, wid = __builtin_amdgcn_readfirstlane(tid >> 6), lane = tid & 63, wr = wid >> 2, wc = wid & 3, fr = lane & 15, fq = lane >> 4;
    const int K = g.K, nt = K / BK;
    unsigned voffA[2], voffB[2];
#pragma unroll
    for (int i = 0; i < 2; ++i) { int R, C; stage_rc(tid * 16 + i * 8192, R, C); const int Rb = Epi::PERM ? ((R & ~31) + perm32(R & 31)) : R;
        voffA[i] = (unsigned)(R * g.ld + C) * 2u; voffB[i] = (unsigned)(Rb * g.ld + C) * 2u; }
    const size_t kstep = (size_t)(BK * 2);
    const size_t hstep = (size_t)HALF * g.ld * 2;
    const size_t tstep = 2 * hstep;
    const unsigned ldsw = (unsigned)wid * 1024u;
    const int aoff = lds_byte(wr * 64 + fr, fq * 8), boff = lds_byte(wc * 32 + fr, fq * 8);
#define PG8_SA(b, h) (((b) * 2 + (h)) * HTB)
#define PG8_SB(b, h) ((4 + (b) * 2 + (h)) * HTB)
#define PG8_STAGE(bufoff, gbase, voff) do { _Pragma("unroll") for (int _i = 0; _i < 2; ++_i) \
        __builtin_amdgcn_global_load_lds((const unsigned*)((const char*)(gbase) + (voff)[_i]), (PG8_LAS unsigned*)(lds + (bufoff) + ldsw + _i * 8192), 16, 0, 0); } while (0)
#define PG8_LDA(dst, b, h) do { _Pragma("unroll") for (int m = 0; m < 4; ++m) _Pragma("unroll") for (int k = 0; k < 2; ++k) dst[m][k] = *(const PG8_LAS bf16x8*)(lds + PG8_SA(b, h) + aoff + m * 2048 + k * 1024); } while (0)
#define PG8_LDB(dst, b, h) do { _Pragma("unroll") for (int n = 0; n < 2; ++n) _Pragma("unroll") for (int k = 0; k < 2; ++k) dst[n][k] = *(const PG8_LAS bf16x8*)(lds + PG8_SB(b, h) + boff + n * 2048 + k * 1024); } while (0)
#define PG8_MMA(ai, bj, At, Bt) do { __builtin_amdgcn_s_setprio(1); _Pragma("unroll") for (int m = 0; m < 4; ++m) _Pragma("unroll") for (int n = 0; n < 2; ++n) _Pragma("unroll") for (int k = 0; k < 2; ++k) \
        acc[ai][bj][m][n] = __builtin_amdgcn_mfma_f32_16x16x32_bf16(Bt[n][k], At[m][k], acc[ai][bj][m][n], 0, 0, 0); __builtin_amdgcn_s_setprio(0); } while (0)
#define PG8_WAIT_V(n) asm volatile("s_waitcnt vmcnt(" #n ")" ::: "memory")
#define PG8_WAIT_L(n) asm volatile("s_waitcnt lgkmcnt(" #n ")" ::: "memory")
#define PG8_BAR __builtin_amdgcn_s_barrier()
#define PG8_SCHED __builtin_amdgcn_sched_barrier(0)
    Unit cur, nxt; int ui = 0;
    if (!S.next(0, cur)) return;
    f32x4 acc[2][2][4][2];
#pragma unroll
    for (int a = 0; a < 2; ++a)
#pragma unroll
        for (int b = 0; b < 2; ++b)
#pragma unroll
            for (int m = 0; m < 4; ++m)
#pragma unroll
                for (int n = 0; n < 2; ++n) acc[a][b][m][n] = (f32x4){0.f, 0.f, 0.f, 0.f};
    bf16x8 At[4][2], B0[2][2], B1[2][2];
    const char* cA = (const char*)g.A + (size_t)cur.pm * tstep; const char* cB = (const char*)g.Bt + (size_t)cur.pn * tstep;
    S.a_ready(cur);
    if constexpr (SP2) {
        PG8_STAGE(PG8_SB(0, 0), cB, voffB); PG8_STAGE(PG8_SB(0, 1), cB + hstep, voffB); PG8_STAGE(PG8_SA(0, 0), cA, voffA); PG8_STAGE(PG8_SA(0, 1), cA + hstep, voffA);
        if (wr == 1) PG8_BAR;
        PG8_WAIT_V(2); PG8_BAR;
        PG8_STAGE(PG8_SB(1, 0), cB + kstep, voffB); PG8_STAGE(PG8_SA(1, 0), cA + kstep, voffA); PG8_STAGE(PG8_SB(1, 1), cB + hstep + kstep, voffB);
        PG8_WAIT_V(6); PG8_BAR;
    } else {
        PG8_STAGE(PG8_SB(0, 0), cB, voffB); PG8_STAGE(PG8_SA(0, 0), cA, voffA); PG8_STAGE(PG8_SB(0, 1), cB + hstep, voffB); PG8_STAGE(PG8_SA(0, 1), cA + hstep, voffA);
        if (wr == 1) PG8_BAR;
        PG8_WAIT_V(4); PG8_BAR;
        PG8_STAGE(PG8_SB(1, 0), cB + kstep, voffB); PG8_STAGE(PG8_SA(1, 0), cA + kstep, voffA); PG8_STAGE(PG8_SB(1, 1), cB + hstep + kstep, voffB);
        PG8_WAIT_V(6); PG8_BAR;
    }
    for (;;) {
        const bool has_next = S.next(ui + 1, nxt);
        const char* nA = has_next ? (const char*)g.A + (size_t)nxt.pm * tstep : cA; const char* nB = has_next ? (const char*)g.Bt + (size_t)nxt.pn * tstep : cB;
        for (int t = 0; t < nt; t += 2) {
            const bool last = (t == nt - 2);
            const char* a1 = cA + (size_t)(t + 1) * kstep;
            const char* a2 = last ? nA : cA + (size_t)(t + 2) * kstep; const char* b2 = last ? nB : cB + (size_t)(t + 2) * kstep;
            const char* a3 = a2 + kstep; const char* b3 = b2 + kstep;
            if (last && has_next) S.a_ready(nxt);
            if constexpr (SP2) {
            PG8_LDB(B0, 0, 0); PG8_LDB(B1, 0, 1); PG8_SCHED; PG8_LDA(At, 0, 0); PG8_STAGE(PG8_SA(1, 1), a1 + hstep, voffA);
            PG8_WAIT_V(8); PG8_WAIT_L(0); PG8_BAR; PG8_MMA(0, 0, At, B0); PG8_MMA(0, 1, At, B1); PG8_BAR; PG8_SCHED;
            PG8_LDA(At, 0, 1); PG8_STAGE(PG8_SB(0, 0), b2, voffB); PG8_STAGE(PG8_SB(0, 1), b2 + hstep, voffB); PG8_STAGE(PG8_SA(0, 0), a2, voffA);
            PG8_WAIT_V(8); PG8_WAIT_L(0); PG8_BAR; PG8_MMA(1, 0, At, B0); PG8_MMA(1, 1, At, B1); PG8_BAR; PG8_SCHED;
            PG8_LDB(B0, 1, 0); PG8_LDB(B1, 1, 1); PG8_SCHED; PG8_LDA(At, 1, 0); PG8_STAGE(PG8_SA(0, 1), a2 + hstep, voffA);
            PG8_WAIT_V(8); PG8_WAIT_L(0); PG8_BAR; PG8_MMA(0, 0, At, B0); PG8_MMA(0, 1, At, B1); PG8_BAR; PG8_SCHED;
            PG8_LDA(At, 1, 1); PG8_STAGE(PG8_SB(1, 0), b3, voffB); PG8_STAGE(PG8_SB(1, 1), b3 + hstep, voffB); PG8_STAGE(PG8_SA(1, 0), a3, voffA);
            PG8_WAIT_V(8); PG8_WAIT_L(0); PG8_BAR; PG8_MMA(1, 0, At, B0); PG8_MMA(1, 1, At, B1); PG8_BAR; PG8_SCHED;
            } else {
            PG8_LDB(B0, 0, 0); PG8_SCHED; PG8_LDA(At, 0, 0); PG8_STAGE(PG8_SA(1, 1), a1 + hstep, voffA);
            PG8_WAIT_L(8); PG8_BAR; PG8_WAIT_L(0); PG8_MMA(0, 0, At, B0); PG8_BAR; PG8_SCHED;
            PG8_LDB(B1, 0, 1); PG8_STAGE(PG8_SB(0, 0), b2, voffB);
            PG8_BAR; PG8_WAIT_L(0); PG8_MMA(0, 1, At, B1); PG8_BAR;
            PG8_LDA(At, 0, 1); PG8_STAGE(PG8_SA(0, 0), a2, voffA);
            PG8_BAR; PG8_WAIT_L(0); PG8_MMA(1, 0, At, B0); PG8_BAR; PG8_SCHED;
            PG8_STAGE(PG8_SB(0, 1), b2 + hstep, voffB);
            PG8_WAIT_V(6); PG8_BAR; PG8_MMA(1, 1, At, B1); PG8_BAR;
            PG8_LDB(B0, 1, 0); PG8_SCHED; PG8_LDA(At, 1, 0); PG8_STAGE(PG8_SA(0, 1), a2 + hstep, voffA);
            PG8_WAIT_L(8); PG8_BAR; PG8_WAIT_L(0); PG8_MMA(0, 0, At, B0); PG8_BAR; PG8_SCHED;
            PG8_LDB(B1, 1, 1); PG8_STAGE(PG8_SB(1, 0), b3, voffB);
            PG8_BAR; PG8_WAIT_L(0); PG8_MMA(0, 1, At, B1); PG8_BAR;
            PG8_LDA(At, 1, 1); PG8_STAGE(PG8_SA(1, 0), a3, voffA);
            PG8_BAR; PG8_WAIT_L(0); PG8_MMA(1, 0, At, B0); PG8_BAR; PG8_SCHED;
            PG8_STAGE(PG8_SB(1, 1), b3 + hstep, voffB);
            PG8_WAIT_V(6); PG8_BAR; PG8_MMA(1, 1, At, B1); PG8_BAR;
            }
        }
        if constexpr (ALIGN_EPI) { if (wr == 0) PG8_BAR; }
        if constexpr (!Epi::AFTER_DRAIN) { E(acc, cur, wr, wc, fr, fq); S.done(cur); }
        if (!has_next) break;
#pragma unroll
        for (int a = 0; a < 2; ++a)
#pragma unroll
            for (int b = 0; b < 2; ++b)
#pragma unroll
                for (int m = 0; m < 4; ++m)
#pragma unroll
                    for (int n = 0; n < 2; ++n) acc[a][b][m][n] = (f32x4){0.f, 0.f, 0.f, 0.f};
        cur = nxt; cA = nA; cB = nB; ++ui;
        if constexpr (ALIGN_EPI) { if (wr == 1) PG8_BAR; }
    }
    PG8_WAIT_V(0);
    if constexpr (!ALIGN_EPI) { if (wr == 0) PG8_BAR; }
    PG8_BAR;
    if constexpr (Epi::AFTER_DRAIN) { E.fused(acc, cur, wr, wc, fr, fq, lds, wid, lane); S.done(cur); }
#undef PG8_SA
#undef PG8_SB
#undef PG8_STAGE
#undef PG8_LDA
#undef PG8_LDB
#undef PG8_MMA
#undef PG8_WAIT_V
#undef PG8_WAIT_L
#undef PG8_BAR
#undef PG8_SCHED
}
}

constexpr int D = 2048, TP = 8192, NB = 16, TS = 16, MS = NB * TS, M = TP + MS;
constexpr int RW = 1024, RH = 16, RN = 64, RC = 3328;
constexpr int ED = 1024, EH = 4, EN = 256, EC = 4096, IC = RC + EC;
constexpr int FF = 5632, NSEQ = 17, MODW = 6 * D;
constexpr int LCH = 128, NCH = TP / LCH;
constexpr int RBLK = 256, NRB = TP / RBLK;
constexpr int NPHASE = 14;
constexpr size_t O_Y = 0, O_SHP = (size_t)M * D, O_WKP = O_SHP + RC, O_RTP = O_WKP + 65536, O_SHS = O_RTP + 262144, O_WKS = O_SHS + (size_t)NB * RC, O_RTS = O_WKS + (size_t)NB * 65536, O_END = O_RTS + (size_t)NB * 262144;
constexpr size_t MiB = 1u << 20;
constexpr size_t WS_MOD = 1 * MiB, WS_LORAT = 2 * MiB, WS_WOUTT = 4 * MiB, WS_WINT = 12 * MiB, WS_V = 12 * MiB, WS_H = 41 * MiB, WS_G = 41 * MiB, WS_BON = 58 * MiB,
                 WS_QKVG = 74 * MiB, WS_LOUT = 140 * MiB, WS_PU = 140 * MiB, WS_KVB = 172 * MiB, WS_ACT = 74 * MiB, WS_PREP = 190 * MiB, WS_MIXOUT = 190 * MiB,
                 WS_WUPT = 256 * MiB, WS_WDNT = 300 * MiB, WS_PART9 = 330 * MiB, WS_PART12 = 256 * MiB, WS_END = 355 * MiB;
constexpr size_t WS_ADAT = 190 * MiB, WS_SC = 239 * MiB, WS_MODP = 240 * MiB;
constexpr int KS9 = 4, KS12 = 11;
constexpr size_t PREP_STRIDE = 33 * MiB;
constexpr size_t DO_Z = 0, DO_LIN = 54 * MiB, DO_SPREV = 0, DO_MIX = 17 * MiB;
constexpr int LDS_BYTES = 147456;

typedef unsigned short bf16;
typedef float f32x2 __attribute__((ext_vector_type(2)));
typedef float f32x4 __attribute__((ext_vector_type(4)));
typedef short bf16x8 __attribute__((ext_vector_type(8)));
typedef unsigned u32x4 __attribute__((ext_vector_type(4)));
typedef unsigned u32x2 __attribute__((ext_vector_type(2)));
#define LDS_WAIT() asm volatile("s_waitcnt lgkmcnt(0)" ::: "memory")

__device__ __forceinline__ float bf2f(unsigned v) { return __builtin_bit_cast(float, v << 16); }
__device__ __forceinline__ unsigned f2bf(float f) { unsigned u = __builtin_bit_cast(unsigned, f); return (u + 0x7fffu + ((u >> 16) & 1u)) >> 16; }
__device__ __forceinline__ unsigned pk2(float lo, float hi) { return f2bf(lo) | (f2bf(hi) << 16); }
__device__ __forceinline__ float wave_sum(float v) {
#pragma unroll
    for (int o = 1; o < 64; o <<= 1) v += __shfl_xor(v, o);
    return v;
}
__device__ __forceinline__ float sigm(float x) { return 1.f / (1.f + __expf(-x)); }
__device__ __forceinline__ int seq_of(int m) { return m < TP ? 0 : 1 + ((m - TP) >> 4); }
__device__ __forceinline__ int tpos_of(int m) { return m < TP ? m : ((m - TP) & 15); }
__device__ __forceinline__ float ret_l2g(int h) { return __log2f(1.0f - exp2f(-5.0f - (float)h)); }

struct EpiProj {
    static constexpr bool PERM = true, AFTER_DRAIN = false;
    bf16* Z; bf16* Q;
    __device__ __forceinline__ void operator()(const f32x4 (&acc)[2][2][4][2], const pg8::Unit& u, int wr, int wc, int fr, int fq) const {
        const int row0 = u.pm * 256 + wr * 64 + fr, pn = u.pn, cl = wc * 32 + 8 * fq;
        if (pn < 13 || pn >= 21) {
            bf16* base = pn < 13 ? Z + pn * 256 + cl : Q + (pn - 13) * 256 + cl; const size_t ld = pn < 13 ? RC : EC;
#pragma unroll
            for (int ai = 0; ai < 2; ++ai)
#pragma unroll
                for (int m = 0; m < 4; ++m) { bf16* rp = base + (size_t)(row0 + ai * 128 + m * 16) * ld;
#pragma unroll
                    for (int bj = 0; bj < 2; ++bj) { const f32x4 v0 = acc[ai][bj][m][0], v1 = acc[ai][bj][m][1]; u32x4 w; w.x = pk2(v0[0], v0[1]); w.y = pk2(v0[2], v0[3]); w.z = pk2(v1[0], v1[1]); w.w = pk2(v1[2], v1[3]);
                        *(u32x4*)(rp + bj * 128) = w; } }
        } else {
            const int sec = pn - 13; bf16* base = Q + sec * 256 + cl; const float sc = sec >= 4 ? 0.0625f : 1.0f;
            float inv[8];
#pragma unroll
            for (int e = 0; e < 8; ++e) inv[e] = exp2f(-(float)(cl + e) * (13.287712379549449f / 128.0f)) * 0.15915494309189535f;
#pragma unroll
            for (int ai = 0; ai < 2; ++ai)
#pragma unroll
                for (int m = 0; m < 4; ++m) { const int row = row0 + ai * 128 + m * 16; bf16* rp = base + (size_t)row * EC;
                    const float pos = row < TP ? (float)row : (float)(2048 + ((row - TP) & 15));
                    float o1[8], o2[8];
#pragma unroll
                    for (int e = 0; e < 8; ++e) { float rev = pos * inv[e]; rev -= floorf(rev); const float sn = __builtin_amdgcn_sinf(rev), cs = __builtin_amdgcn_cosf(rev);
                        const float x1 = acc[ai][0][m][e >> 2][e & 3], x2 = acc[ai][1][m][e >> 2][e & 3];
                        o1[e] = (x1 * cs - x2 * sn) * sc; o2[e] = (x2 * cs + x1 * sn) * sc; }
                    u32x4 w; w.x = pk2(o1[0], o1[1]); w.y = pk2(o1[2], o1[3]); w.z = pk2(o1[4], o1[5]); w.w = pk2(o1[6], o1[7]); *(u32x4*)rp = w;
                    w.x = pk2(o2[0], o2[1]); w.y = pk2(o2[2], o2[3]); w.z = pk2(o2[4], o2[5]); w.w = pk2(o2[6], o2[7]); *(u32x4*)(rp + 128) = w; }
        }
    }
};
struct EpiBf16P {
    static constexpr bool PERM = true, AFTER_DRAIN = false;
    bf16* C; int ldc;
    __device__ __forceinline__ void operator()(const f32x4 (&acc)[2][2][4][2], const pg8::Unit& u, int wr, int wc, int fr, int fq) const {
        const int row0 = u.pm * 256 + wr * 64 + fr; bf16* base = C + u.pn * 256 + wc * 32 + 8 * fq;
#pragma unroll
        for (int ai = 0; ai < 2; ++ai)
#pragma unroll
            for (int m = 0; m < 4; ++m) { bf16* rp = base + (size_t)(row0 + ai * 128 + m * 16) * ldc;
#pragma unroll
                for (int bj = 0; bj < 2; ++bj) { const f32x4 v0 = acc[ai][bj][m][0], v1 = acc[ai][bj][m][1]; u32x4 w; w.x = pk2(v0[0], v0[1]); w.y = pk2(v0[2], v0[3]); w.z = pk2(v1[0], v1[1]); w.w = pk2(v1[2], v1[3]);
                    *(u32x4*)(rp + bj * 128) = w; } }
    }
};
struct EpiF32 {
    static constexpr bool PERM = true, AFTER_DRAIN = false;
    float* C; int ldc;
    __device__ __forceinline__ void operator()(const f32x4 (&acc)[2][2][4][2], const pg8::Unit& u, int wr, int wc, int fr, int fq) const {
        const int row0 = u.pm * 256 + wr * 64 + fr; float* base = C + u.pn * 256 + wc * 32 + 8 * fq;
#pragma unroll
        for (int ai = 0; ai < 2; ++ai)
#pragma unroll
            for (int m = 0; m < 4; ++m) { float* rp = base + (size_t)(row0 + ai * 128 + m * 16) * ldc;
#pragma unroll
                for (int bj = 0; bj < 2; ++bj) { *(f32x4*)(rp + bj * 128) = acc[ai][bj][m][0]; *(f32x4*)(rp + bj * 128 + 4) = acc[ai][bj][m][1]; } }
    }
};
struct EpiSwiglu {
    static constexpr bool PERM = true, AFTER_DRAIN = false;
    bf16* C;
    __device__ __forceinline__ void operator()(const f32x4 (&acc)[2][2][4][2], const pg8::Unit& u, int wr, int wc, int fr, int fq) const {
        const int row0 = u.pm * 256 + wr * 64 + fr; bf16* base = C + u.pn * 128 + wc * 32 + 8 * fq;
#pragma unroll
        for (int ai = 0; ai < 2; ++ai)
#pragma unroll
            for (int m = 0; m < 4; ++m) { float o[8];
#pragma unroll
                for (int e = 0; e < 8; ++e) { const float g = acc[ai][0][m][e >> 2][e & 3], up = acc[ai][1][m][e >> 2][e & 3]; o[e] = g * sigm(g) * up; }
                u32x4 w; w.x = pk2(o[0], o[1]); w.y = pk2(o[2], o[3]); w.z = pk2(o[4], o[5]); w.w = pk2(o[6], o[7]);
                *(u32x4*)(base + (size_t)(row0 + ai * 128 + m * 16) * FF) = w; }
    }
};
struct EpiMod {
    static constexpr bool PERM = true, AFTER_DRAIN = false;
    float* C; int ldc;
    __device__ __forceinline__ void operator()(const f32x4 (&acc)[2][2][4][2], const pg8::Unit& u, int wr, int wc, int fr, int fq) const {
        if (wr != 0) return;
        float* base = C + u.pn * 256 + wc * 32 + 8 * fq;
#pragma unroll
        for (int m = 0; m < 2; ++m) { const int row = 16 * m + fr; if (row < NSEQ) { float* rp = base + (size_t)row * ldc;
#pragma unroll
            for (int bj = 0; bj < 2; ++bj) { *(f32x4*)(rp + bj * 128) = acc[0][bj][m][0]; *(f32x4*)(rp + bj * 128 + 4) = acc[0][bj][m][1]; } } }
    }
};

__device__ __forceinline__ void transpose_item(const float* __restrict__ W, int K, int N, bf16* WT, int k0, int n0, int dst_row0, float* scr, int lane) {
#pragma unroll 8
    for (int i = 0; i < 32; ++i) { const int kk = 2 * i + (lane >> 5); scr[kk * 33 + (lane & 31)] = W[(size_t)(k0 + kk) * N + n0 + (lane & 31)]; }
    LDS_WAIT();
    const int c = lane & 7;
#pragma unroll
    for (int j = 0; j < 4; ++j) { const int n = (lane >> 3) + 8 * j; const float* s = scr + (8 * c) * 33 + n;
        u32x4 o; o.x = pk2(s[0 * 33], s[1 * 33]); o.y = pk2(s[2 * 33], s[3 * 33]); o.z = pk2(s[4 * 33], s[5 * 33]); o.w = pk2(s[6 * 33], s[7 * 33]);
        *(u32x4*)(WT + (size_t)(dst_row0 + n) * K + k0 + 8 * c) = o; }
    LDS_WAIT();
}

typedef const __attribute__((address_space(4))) f32x2* cf2p;
__device__ __forceinline__ cf2p to_c(const float* p) { return (cf2p)(unsigned long long)p; }
#define DPPF(old, src, ctrl, rmask) __builtin_bit_cast(float, __builtin_amdgcn_update_dpp(__builtin_bit_cast(int, (float)(old)), __builtin_bit_cast(int, (float)(src)), (ctrl), (rmask), 0xF, false))
__device__ __forceinline__ float wave_sum_u(float v) {
    v += DPPF(0.f, v, 0xB1, 0xF); v += DPPF(0.f, v, 0x4E, 0xF); v += DPPF(0.f, v, 0x124, 0xF); v += DPPF(0.f, v, 0x128, 0xF);
    v += DPPF(0.f, v, 0x142, 0xA); v += DPPF(0.f, v, 0x143, 0xC);
    return __builtin_bit_cast(float, __builtin_amdgcn_readlane(__builtin_bit_cast(int, v), 63));
}
constexpr int RW_PF = 6;
template <int MODE>
__device__ __forceinline__ void rwkv_run(f32x2 (&S)[32], const float* W, const float* NKK, const float* B, const float* K, const float* R, const bf16* Vp, int nsteps, int lane,
                                         const bf16* Gp, const float* BONp, bf16* MIXp, float lnw, float lnb) {
    constexpr int NPF = MODE == 2 ? 20 : (MODE == 0 ? 16 : 12);
    const int pa = lane >> 2; const float* pfp = (pa == 0 ? W : pa == 1 ? NKK : pa == 2 ? B : pa == 3 ? K : R) + (lane & 3) * 16;
    float vn = 0.f, gn = 0.f, bn = 0.f;
    if (MODE != 1) vn = bf2f(Vp[lane]);
    if (MODE == 2) { gn = bf2f(Gp[lane]); bn = BONp[0]; }
    if (lane < NPF) {
#pragma unroll
        for (int q = 1; q < RW_PF; ++q) if (q < nsteps) (void)*(volatile const float*)(pfp + (size_t)q * RW);
    }
    for (int t = 0; t < nsteps; ++t) {
        const size_t o = (size_t)t * RW;
        cf2p w = to_c(W + o), nk = to_c(NKK + o), b = to_c(B + o), k = to_c(K + o), r = to_c(R + o);
        const float v = vn, gv = gn, bon = bn;
        { const int t1 = t + 1 < nsteps ? t + 1 : t; const size_t o1 = (size_t)t1 * RW;
          if (MODE != 1) vn = bf2f(Vp[o1 + lane]);
          if (MODE == 2) { gn = bf2f(Gp[o1 + lane]); bn = BONp[(size_t)t1 * 16]; }
          const int tp = t + RW_PF < nsteps ? t + RW_PF : nsteps - 1;
          if (lane < NPF) (void)*(volatile const float*)(pfp + (size_t)tp * RW); }
        f32x2 a0 = {0.f, 0.f}, a1 = {0.f, 0.f};
#pragma unroll
        for (int j = 0; j < 32; j += 2) { a0 = __builtin_elementwise_fma(S[j], nk[j], a0); a1 = __builtin_elementwise_fma(S[j + 1], nk[j + 1], a1); }
        const float sa = (a0.x + a0.y) + (a1.x + a1.y);
        const f32x2 sa2 = {sa, sa}, v2 = {v, v};
        f32x2 o0 = {0.f, 0.f}, o1 = {0.f, 0.f};
#pragma unroll
        for (int j = 0; j < 32; ++j) {
            f32x2 s = S[j] * w[j];
            s = __builtin_elementwise_fma(sa2, b[j], s);
            if (MODE != 1) s = __builtin_elementwise_fma(v2, k[j], s);
            S[j] = s;
            if (MODE == 2) { if (j & 1) o1 = __builtin_elementwise_fma(s, r[j], o1); else o0 = __builtin_elementwise_fma(s, r[j], o0); }
        }
        if (MODE == 2) {
            const float ov = (o0.x + o0.y) + (o1.x + o1.y);
            const float mean = wave_sum_u(ov) * (1.f / 64.f), d = ov - mean, var = wave_sum_u(d * d) * (1.f / 64.f);
            float y = d * rsqrtf(var + 64e-5f) * lnw + lnb;
            y = (y + bon * v) * gv;
            MIXp[(size_t)t * D + lane] = (bf16)f2bf(y);
        }
    }
}

constexpr int RL_B = 8;
template <int MODE> struct RL { static constexpr int NV = MODE == 2 ? 5 : (MODE == 0 ? 4 : 3); static constexpr int REC = NV * 64, BUF = RL_B * REC + (MODE != 1 ? 256 : 0) + (MODE == 2 ? 256 + 16 : 0); };
#define SBAR() __builtin_amdgcn_sched_barrier(0)
template <int MODE>
__device__ __forceinline__ void rwkv_lds(f32x2 (&S)[32], const float* W, const bf16* NKK, const bf16* B, const bf16* K, const bf16* R, const bf16* Vp, int nsteps, int lane,
                                         const bf16* Gp, const float* BONp, bf16* MIXp, float lnw, float lnb, float* wl) {
    constexpr int NV = RL<MODE>::NV, REC = RL<MODE>::REC;
    const int ls = lane >> 4, lc = (lane & 15) * 4;
    f32x4 st[2]; u32x2 sh[NV][2]; u32x4 sv = {0u, 0u, 0u, 0u}, sg = {0u, 0u, 0u, 0u}; float sb = 0.f;
#define RL_ISSUE(bt) do { const size_t ob = (size_t)((bt) * RL_B) * RW; \
        _Pragma("unroll") for (int q = 0; q < 2; ++q) { const size_t oo = ob + (size_t)(ls + 4 * q) * RW + lc; \
            st[q] = *(const f32x4*)(W + oo); sh[1][q] = *(const u32x2*)(NKK + oo); sh[2][q] = *(const u32x2*)(B + oo); if (NV >= 4) sh[NV >= 4 ? 3 : 0][q] = *(const u32x2*)(K + oo); if (NV == 5) sh[NV - 1][q] = *(const u32x2*)(R + oo); } \
        if (MODE != 1) sv = *(const u32x4*)(Vp + ob + (size_t)(lane >> 3) * RW + (lane & 7) * 8); \
        if (MODE == 2) { sg = *(const u32x4*)(Gp + ob + (size_t)(lane >> 3) * RW + (lane & 7) * 8); if (lane < RL_B) sb = BONp[(size_t)((bt) * RL_B + lane) * 16]; } } while (0)
#define RL_COMMIT() do { \
        _Pragma("unroll") for (int q = 0; q < 2; ++q) { *(f32x4*)(wl + (ls + 4 * q) * REC + lc) = st[q]; \
            _Pragma("unroll") for (int v = 1; v < NV; ++v) { const u32x2 pk_ = sh[v][q]; *(f32x4*)(wl + (ls + 4 * q) * REC + v * 64 + lc) = (f32x4){bf2f(pk_.x & 0xffffu), bf2f(pk_.x >> 16), bf2f(pk_.y & 0xffffu), bf2f(pk_.y >> 16)}; } } \
        if (MODE != 1) *(u32x4*)((bf16*)(wl + RL_B * REC) + (lane >> 3) * 64 + (lane & 7) * 8) = sv; \
        if (MODE == 2) { *(u32x4*)((bf16*)(wl + RL_B * REC + 256) + (lane >> 3) * 64 + (lane & 7) * 8) = sg; if (lane < RL_B) wl[RL_B * REC + 512 + lane] = sb; } } while (0)
    const int nb = nsteps / RL_B;
    RL_ISSUE(0); RL_COMMIT();
    for (int bt = 0; bt < nb; ++bt) {
        if (bt + 1 < nb) RL_ISSUE(bt + 1);
#pragma unroll 1
        for (int s = 0; s < RL_B; ++s) {
            const f32x2* w = (const f32x2*)(wl + s * REC); const f32x2* nk = w + 32; const f32x2* b = w + 64; const f32x2* k = w + 96; const f32x2* r = w + 128;
            float v = 0.f, gv = 0.f, bon = 0.f;
            if (MODE != 1) v = bf2f(((const bf16*)(wl + RL_B * REC))[s * 64 + lane]);
            if (MODE == 2) { gv = bf2f(((const bf16*)(wl + RL_B * REC + 256))[s * 64 + lane]); bon = wl[RL_B * REC + 512 + s]; }
            f32x2 nA[8], nB[8]; f32x2 a0 = {0.f, 0.f}, a1 = {0.f, 0.f};
#pragma unroll
            for (int p = 0; p < 8; ++p) nA[p] = nk[p];
#pragma unroll
            for (int g = 0; g < 4; ++g) {
                if (g < 3) {
#pragma unroll
                    for (int p = 0; p < 8; ++p) { if (g & 1) nA[p] = nk[8 * (g + 1) + p]; else nB[p] = nk[8 * (g + 1) + p]; } }
                SBAR();
#pragma unroll
                for (int p = 0; p < 8; p += 2) { a0 = __builtin_elementwise_fma(S[8 * g + p], (g & 1) ? nB[p] : nA[p], a0); a1 = __builtin_elementwise_fma(S[8 * g + p + 1], (g & 1) ? nB[p + 1] : nA[p + 1], a1); }
                SBAR();
            }
            const float sa = (a0.x + a0.y) + (a1.x + a1.y);
            const f32x2 sa2 = {sa, sa}, v2 = {v, v};
            f32x2 uw[2][4], ub[2][4], uk[2][4], ur[2][4]; f32x2 o0 = {0.f, 0.f}, o1 = {0.f, 0.f};
#pragma unroll
            for (int p = 0; p < 4; ++p) { uw[0][p] = w[p]; ub[0][p] = b[p]; if (MODE != 1) uk[0][p] = k[p]; if (MODE == 2) ur[0][p] = r[p]; }
#pragma unroll
            for (int g = 0; g < 8; ++g) {
                if (g < 7) {
#pragma unroll
                    for (int p = 0; p < 4; ++p) { uw[(g + 1) & 1][p] = w[4 * (g + 1) + p]; ub[(g + 1) & 1][p] = b[4 * (g + 1) + p]; if (MODE != 1) uk[(g + 1) & 1][p] = k[4 * (g + 1) + p]; if (MODE == 2) ur[(g + 1) & 1][p] = r[4 * (g + 1) + p]; } }
                SBAR();
#pragma unroll
                for (int p = 0; p < 4; ++p) { const int j = 4 * g + p;
                    f32x2 x = S[j] * uw[g & 1][p]; x = __builtin_elementwise_fma(sa2, ub[g & 1][p], x); if (MODE != 1) x = __builtin_elementwise_fma(v2, uk[g & 1][p], x); S[j] = x;
                    if (MODE == 2) { if (p & 1) o1 = __builtin_elementwise_fma(x, ur[g & 1][p], o1); else o0 = __builtin_elementwise_fma(x, ur[g & 1][p], o0); } }
                SBAR();
            }
            if (MODE == 2) {
                const float ov = (o0.x + o0.y) + (o1.x + o1.y);
                const float mean = wave_sum_u(ov) * (1.f / 64.f), d = ov - mean, var = wave_sum_u(d * d) * (1.f / 64.f);
                float y = d * rsqrtf(var + 64e-5f) * lnw + lnb;
                y = (y + bon * v) * gv;
                MIXp[(size_t)(bt * RL_B + s) * D + lane] = (bf16)f2bf(y);
            }
        }
        if (bt + 1 < nb) RL_COMMIT();
    }
#undef RL_ISSUE
#undef RL_COMMIT
}
#define LAS __attribute__((address_space(3)))

#define XB_TMO      128
#define XB_XCNT(j)  (256  + 64 * (j))
#define XB_XSUB(j)  (1280 + 64 * (j))
#define XB_XGEN(j)  (2304 + 64 * (j))
#define XB_TOP      3328
#define XB_TOPGEN   3392
#define XCD_BAR_WORDS 3456
#define XB_SPIN_CAP (1u << 18)

__device__ __forceinline__ unsigned xb_ld(unsigned* p)              { return __hip_atomic_load(p, __ATOMIC_RELAXED, __HIP_MEMORY_SCOPE_AGENT); }
__device__ __forceinline__ unsigned xb_add(unsigned* p, unsigned v) { return __hip_atomic_fetch_add(p, v, __ATOMIC_RELAXED, __HIP_MEMORY_SCOPE_AGENT); }
__device__ __forceinline__ unsigned xb_xcc_id() { return (unsigned)__builtin_amdgcn_s_getreg((3 << 11) | 20) & 0xFu; }
#define XB_SPIN(cond, bar) do { unsigned _sp = 0; while (cond) { __builtin_amdgcn_s_sleep(1); \
    if ((++_sp & 255u) == 0u) { if (xb_ld(&(bar)[XB_TMO])) break; if (_sp > XB_SPIN_CAP) { atomicAdd(&(bar)[XB_TMO], 1u); break; } } } } while (0)

struct XcdBarrier {
    unsigned* bar; unsigned x;
    volatile LAS unsigned* st;
};

__device__ __forceinline__ XcdBarrier xcd_barrier_post(unsigned* bar, volatile LAS unsigned* st) {
    XcdBarrier b; b.bar = bar; b.x = xb_xcc_id(); b.st = st;
    if (threadIdx.x == 0) (void)xb_add(&bar[XB_XCNT(b.x)], 1u);
    return b;
}
__device__ __forceinline__ void xcd_barrier_complete(unsigned* bar, unsigned x, unsigned& nloc, unsigned& nx) {
    const unsigned G = gridDim.x * gridDim.y * gridDim.z;
    unsigned sum, cnt, mine, sp = 0u;
    for (;;) {
        sum = 0u; cnt = 0u; mine = 0u;
#pragma unroll
        for (unsigned j = 0; j < 16; ++j) { const unsigned c = xb_ld(&bar[XB_XCNT(j)]); sum += c; cnt += (c > 0u) ? 1u : 0u; mine = (j == x) ? c : mine; }
        if (sum == G) break;
        __builtin_amdgcn_s_sleep(1);
        if ((++sp & 255u) == 0u) { if (xb_ld(&bar[XB_TMO])) break; if (sp > XB_SPIN_CAP) { atomicAdd(&bar[XB_TMO], 1u); break; } }
    }
    nloc = mine > 0u ? mine : 1u; nx = cnt > 0u ? cnt : 1u;
}

__device__ __forceinline__ void xcd_barrier(const XcdBarrier& b) {
    asm volatile("s_waitcnt vmcnt(0)" ::: "memory");
    __syncthreads();
    if (threadIdx.x == 0) {
        unsigned* bar = b.bar;
        __builtin_amdgcn_s_waitcnt(0);
        unsigned nloc = b.st[0], nx = b.st[1];
        if (nloc == 0u) { xcd_barrier_complete(bar, b.x, nloc, nx); b.st[0] = nloc; b.st[1] = nx; }
        const unsigned old = xb_add(&bar[XB_XSUB(b.x)], 1u);
        const unsigned gen = old / nloc;
        if (old + 1u == (gen + 1u) * nloc) {
            __builtin_amdgcn_fence(__ATOMIC_RELEASE, "agent");
            asm volatile("s_waitcnt vmcnt(0)" ::: "memory");
            const unsigned og = xb_add(&bar[XB_TOP], 1u);
            const unsigned tg = og / nx;
            if (og + 1u == (tg + 1u) * nx) xb_add(&bar[XB_TOPGEN], 1u);
            else XB_SPIN(xb_ld(&bar[XB_TOPGEN]) == tg, bar);
            __builtin_amdgcn_fence(__ATOMIC_ACQUIRE, "agent");
            xb_add(&bar[XB_XGEN(b.x)], 1u);
            asm volatile("s_waitcnt vmcnt(0)" ::: "memory");
        } else {
            XB_SPIN(xb_ld(&bar[XB_XGEN(b.x)]) == gen, bar);
            __builtin_amdgcn_fence(__ATOMIC_ACQUIRE, "agent");
            asm volatile("s_waitcnt vmcnt(0)" ::: "memory");
        }
    }
    __syncthreads();
}


struct Args { const float* in[30]; float* out; unsigned char* ws; int ph_lo, ph_hi; };
enum { I_XP = 0, I_XS, I_CP, I_CS, I_SSH, I_SWKV, I_SRET, I_ADAW, I_ADAB, I_GPM, I_GPOM, I_GPF, I_GPOF, I_WIN, I_MU, I_W0, I_W2, I_A0, I_A2, I_G2, I_KK, I_KA, I_RK, I_RLW, I_RLB, I_ELW, I_ELB, I_WOUT, I_WUP, I_WDN };

__global__ void __launch_bounds__(512, 2) mk_fwd(Args a) {
    extern __shared__ __attribute__((aligned(16))) unsigned char lds[];
    cg::grid_group grid = cg::this_grid();
    const int tid = threadIdx.x, lane = tid & 63, wave = __builtin_amdgcn_readfirstlane(tid >> 6);
    const int G = gridDim.x, bid = blockIdx.x, gw = bid * 8 + wave, NGW = G * 8;
    const int lo = a.ph_lo, hi = a.ph_hi;
    volatile LAS unsigned* xst = (volatile LAS unsigned*)((LAS unsigned char*)lds + LDS_BYTES - 16);
    if (tid < 2) xst[tid] = 0u;
    __syncthreads();
    XcdBarrier xb = xcd_barrier_post((unsigned*)(a.ws + 65536), xst);
    unsigned char* ws = a.ws; float* out = a.out; unsigned char* dob = (unsigned char*)a.out;
    float* MOD = (float*)(ws + WS_MOD);
    bf16* LORAT = (bf16*)(ws + WS_LORAT); bf16* WOUTT = (bf16*)(ws + WS_WOUTT); bf16* WINT = (bf16*)(ws + WS_WINT); bf16* WUPT = (bf16*)(ws + WS_WUPT); bf16* WDNT = (bf16*)(ws + WS_WDNT);
    bf16* H = (bf16*)(ws + WS_H); bf16* QKVG = (bf16*)(ws + WS_QKVG); bf16* LOUT = (bf16*)(ws + WS_LOUT); bf16* Z = (bf16*)(dob + DO_Z); bf16* LIN = (bf16*)(dob + DO_LIN);
    float* PW = (float*)(ws + WS_PREP); bf16* PNKK = (bf16*)(ws + WS_PREP + PREP_STRIDE); bf16* PB = (bf16*)(ws + WS_PREP + 2 * PREP_STRIDE); bf16* PK = (bf16*)(ws + WS_PREP + 3 * PREP_STRIDE); bf16* PR = (bf16*)(ws + WS_PREP + 4 * PREP_STRIDE);
    bf16* PV = (bf16*)(ws + WS_V); bf16* PG = (bf16*)(ws + WS_G); float* BON = (float*)(ws + WS_BON);
    float* PU = (float*)(ws + WS_PU); bf16* KVB = (bf16*)(ws + WS_KVB); bf16* SPREV = (bf16*)(dob + DO_SPREV); bf16* MIX = (bf16*)(dob + DO_MIX);
    float* MIXOUT = (float*)(ws + WS_MIXOUT); bf16* ACT = (bf16*)(ws + WS_ACT);
#ifndef DUP_PHASE
#define DUP_PHASE -1
#endif
#ifndef PH_MASK
#define PH_MASK 0x3fff
#endif
#define IN(k) (((PH_MASK >> (k)) & 1) && lo <= (k) && (k) < hi)
#ifndef TS_PROBE
#define TS_PROBE -1
#endif
    unsigned long long* TSW = (unsigned long long*)ws;
    if (TS_PROBE >= 0 && bid == 0 && tid == 0) TSW[0] = __builtin_amdgcn_s_memrealtime();
#define MID(n) do { if (TS_PROBE >= 0 && bid == 0) { __syncthreads(); if (tid == 0) TSW[32 + (n)] = __builtin_amdgcn_s_memrealtime(); } } while (0)
#define SEAM(k) do { if (IN(k) && IN((k) + 1)) { if ((k) == 0) grid.sync(); else xcd_barrier(xb); } if (TS_PROBE >= 0 && bid == 0 && tid == 0) TSW[1 + (k)] = __builtin_amdgcn_s_memrealtime(); } while (0)

    if (IN(0)) for (int rep = 0; rep < (DUP_PHASE == 0 ? 2 : 1); ++rep) {
        MID(0);
        float* scr = (float*)lds + wave * (64 * 33 + 16);
        constexpr int IT_WIN = (D / 64) * (IC / 32), IT_WOUT = (D / 64) * (D / 32), IT_ADA = (D / 64) * (MODW / 32);
        bf16* ADAT = (bf16*)(ws + WS_ADAT); bf16* SC = (bf16*)(ws + WS_SC);
        for (int it = gw; it < IT_WIN + IT_WOUT + IT_ADA; it += NGW) {
            if (it < IT_WIN) { const int nb = IC / 32, kb = it / nb, n0 = 32 * (it % nb); transpose_item(a.in[I_WIN], D, IC, WINT, 64 * kb, n0, n0, scr, lane); }
            else if (it < IT_WIN + IT_WOUT) { const int r = it - IT_WIN, nb = D / 32, kb = r / nb, n0 = 32 * (r % nb); transpose_item(a.in[I_WOUT], D, D, WOUTT, 64 * kb, n0, n0, scr, lane); }
            else { const int r = it - IT_WIN - IT_WOUT, nb = MODW / 32, kb = r / nb, n0 = 32 * (r % nb); transpose_item(a.in[I_ADAW], D, MODW, ADAT, 64 * kb, n0, n0, scr, lane); }
        }
        MID(1);
        for (int idx = bid * 512 + tid; idx < 3072 * 256; idx += G * 512) {
            const int n = idx >> 8, k = idx & 255, sec = n >> 10, nn = n & 1023; float v = 0.f;
            if (sec == 0 && k < 64) v = a.in[I_W2][k * RW + nn];
            else if (sec == 1 && k >= 64 && k < 128) v = a.in[I_A2][(k - 64) * RW + nn];
            else if (sec == 2 && k >= 128) v = a.in[I_G2][(k - 128) * RW + nn];
            LORAT[idx] = (bf16)f2bf(v);
        }
        for (int idx = bid * 512 + tid; idx < 256 * D; idx += G * 512) { const int r = idx / D, k = idx % D; float v = 0.f;
            if (r < NSEQ) { const float cv = r == 0 ? a.in[I_CP][k] : a.in[I_CS][(r - 1) * D + k]; v = cv * sigm(cv); }
            SC[idx] = (bf16)f2bf(v); }
        MID(2);
    }
    if (IN(0)) MID(3);
    SEAM(0);
    if (IN(1)) {
        { const int sl = bid / 48; pg8::Gemm g{(const bf16*)(ws + WS_SC) + sl * 512, (const bf16*)(ws + WS_ADAT) + sl * 512, 256, MODW, 512, D}; pg8::OneUnit S{0, bid % 48, bid < 192};
          EpiMod E{(float*)(ws + WS_MODP) + (size_t)sl * NSEQ * MODW, MODW};
          pg8::gemm_phase<EpiMod, pg8::OneUnit, false, true>((PG8_LAS unsigned char*)lds, g, S, E); }
        xcd_barrier(xb);
        const float* MODP = (const float*)(ws + WS_MODP);
        for (int idx = bid * 512 + tid; idx < NSEQ * MODW; idx += G * 512) { float v = a.in[I_ADAB][idx % MODW];
#pragma unroll
            for (int q = 0; q < 4; ++q) v += MODP[(size_t)q * NSEQ * MODW + idx];
            MOD[idx] = v; }
        xcd_barrier(xb);
    }
    if (IN(1)) for (int rep = 0; rep < (DUP_PHASE == 1 ? 2 : 1); ++rep) {
        for (int m = gw; m < M; m += NGW) {
            const float* xr = m < TP ? a.in[I_XP] + (size_t)m * D : a.in[I_XS] + (size_t)(m - TP) * D; const float* mod = MOD + seq_of(m) * MODW;
            f32x4 v[8]; float ss = 0.f;
#pragma unroll
            for (int j = 0; j < 8; ++j) { v[j] = *(const f32x4*)(xr + 4 * lane + 256 * j); ss += (v[j].x * v[j].x + v[j].y * v[j].y) + (v[j].z * v[j].z + v[j].w * v[j].w); }
            const float rs = rsqrtf(wave_sum(ss) * (1.f / D) + 1e-6f);
#pragma unroll
            for (int j = 0; j < 8; ++j) { const int c = 4 * lane + 256 * j; const f32x4 g = *(const f32x4*)(a.in[I_GPM] + c), s1 = *(const f32x4*)(mod + D + c), h1 = *(const f32x4*)(mod + c);
                const f32x4 h = v[j] * rs * g * (s1 + 1.f) + h1; u32x2 w; w.x = pk2(h.x, h.y); w.y = pk2(h.z, h.w); *(u32x2*)(H + (size_t)m * D + c) = w; }
        }
    }
    SEAM(1);
    if (IN(2)) for (int rep = 0; rep < (DUP_PHASE == 2 ? 2 : 1); ++rep) {
        pg8::Gemm g{H, WINT, M, IC, D, D}; pg8::StaticOrder S; S.init(M, IC, G, bid); EpiProj E{Z, QKVG};
        pg8::gemm_phase<EpiProj, pg8::StaticOrder, true, true>((PG8_LAS unsigned char*)lds, g, S, E);
    }
    SEAM(2);
    if (IN(3)) for (int rep = 0; rep < (DUP_PHASE == 3 ? 2 : 1); ++rep) {
        for (int idx = bid * 512 + tid; idx < M * 128; idx += G * 512) {
            const int m = idx >> 7, c2 = (idx & 127) * 2, c = 3072 + c2, tp = tpos_of(m), sq = seq_of(m);
            const unsigned zz = *(const unsigned*)(Z + (size_t)m * RC + c); float z0 = bf2f(zz & 0xffffu), z1 = bf2f(zz >> 16), p0 = 0.f, p1 = 0.f;
            if (tp > 0) { const unsigned pp = *(const unsigned*)(Z + (size_t)(m - 1) * RC + c); p0 = bf2f(pp & 0xffffu); p1 = bf2f(pp >> 16); }
            else if (sq > 0) { p0 = a.in[I_SSH][(size_t)(sq - 1) * RC + c]; p1 = a.in[I_SSH][(size_t)(sq - 1) * RC + c + 1]; }
            z0 = z0 + (p0 - z0) * a.in[I_MU][c]; z1 = z1 + (p1 - z1) * a.in[I_MU][c + 1];
            if (c2 < 64) { z0 = 1.f - 2.f / (__expf(2.f * z0) + 1.f); z1 = 1.f - 2.f / (__expf(2.f * z1) + 1.f); }
            else if (c2 >= 128) { z0 = sigm(z0); z1 = sigm(z1); }
            *(unsigned*)(LIN + (size_t)m * 256 + c2) = pk2(z0, z1);
        }
        for (int idx = bid * 512 + tid; idx < NSEQ * RC; idx += G * 512) { const int s = idx / RC, c = idx % RC; const int m = s == 0 ? TP - 1 : TP + 16 * (s - 1) + 15;
            out[(s == 0 ? O_SHP : O_SHS + (size_t)(s - 1) * RC) + c] = bf2f(Z[(size_t)m * RC + c]); }
    }
    SEAM(3);
    if (IN(4)) for (int rep = 0; rep < (DUP_PHASE == 4 ? 2 : 1); ++rep) {
        int k256 = 256; asm volatile("" : "+s"(k256));
        pg8::Gemm g{LIN, LORAT, M, 3072, k256, k256}; pg8::StaticOrder S; S.init(M, 3072, G, bid); EpiBf16P E{LOUT, 3072};
        pg8::gemm_phase<EpiBf16P, pg8::StaticOrder, true, true>((PG8_LAS unsigned char*)lds, g, S, E);
    }
    SEAM(4);
    if (IN(5)) for (int rep = 0; rep < (DUP_PHASE == 5 ? 2 : 1); ++rep) {
        float* prm = (float*)lds;
        __syncthreads();
        for (int idx = tid; idx < RW; idx += 512) { prm[idx] = a.in[I_MU][idx]; prm[RW + idx] = a.in[I_MU][RW + idx]; prm[2 * RW + idx] = a.in[I_MU][2 * RW + idx]; prm[3 * RW + idx] = a.in[I_W0][idx];
            prm[4 * RW + idx] = a.in[I_A0][idx]; prm[5 * RW + idx] = a.in[I_KK][idx]; prm[6 * RW + idx] = a.in[I_KA][idx]; prm[7 * RW + idx] = a.in[I_RK][idx]; }
        __syncthreads();
        for (int m = gw; m < M; m += NGW) {
            const int tp = tpos_of(m), sq = seq_of(m);
#pragma unroll 1
            for (int hp = 0; hp < 2; ++hp) {
                const int hd = hp * 8 + (lane >> 3), c0 = hd * 64 + (lane & 7) * 8;
                const bf16* zr = Z + (size_t)m * RC + c0; const bf16* lr = LOUT + (size_t)m * 3072 + c0; const float* sh0 = a.in[I_SSH] + (size_t)(sq > 0 ? sq - 1 : 0) * RC + c0;
                float zs[3][8];
#pragma unroll
                for (int q = 0; q < 3; ++q) {
                    const u32x4 ca = *(const u32x4*)(zr + q * RW); float pv[8];
                    if (tp > 0) { const u32x4 pa2 = *(const u32x4*)(zr - RC + q * RW);
#pragma unroll
                        for (int e = 0; e < 4; ++e) { pv[2 * e] = bf2f(pa2[e] & 0xffffu); pv[2 * e + 1] = bf2f(pa2[e] >> 16); } }
                    else if (sq > 0) { const f32x4 f0 = *(const f32x4*)(sh0 + q * RW), f1 = *(const f32x4*)(sh0 + q * RW + 4);
                        pv[0] = f0.x; pv[1] = f0.y; pv[2] = f0.z; pv[3] = f0.w; pv[4] = f1.x; pv[5] = f1.y; pv[6] = f1.z; pv[7] = f1.w; }
                    else {
#pragma unroll
                        for (int e = 0; e < 8; ++e) pv[e] = 0.f; }
                    const float* mu = prm + q * RW + c0;
#pragma unroll
                    for (int e = 0; e < 4; ++e) { const float z0 = bf2f(ca[e] & 0xffffu), z1 = bf2f(ca[e] >> 16);
                        zs[q][2 * e] = z0 + (pv[2 * e] - z0) * mu[2 * e]; zs[q][2 * e + 1] = z1 + (pv[2 * e + 1] - z1) * mu[2 * e + 1]; }
                }
                const u32x4 wa = *(const u32x4*)(lr), aa = *(const u32x4*)(lr + RW), ga = *(const u32x4*)(lr + 2 * RW);
                float wv[8], av[8], kkv[8], k2[8]; float s1 = 0.f, s2 = 0.f;
#pragma unroll
                for (int e = 0; e < 8; ++e) {
                    const float lwv = bf2f((e & 1) ? (wa[e >> 1] >> 16) : (wa[e >> 1] & 0xffffu)), lav = bf2f((e & 1) ? (aa[e >> 1] >> 16) : (aa[e >> 1] & 0xffffu));
                    wv[e] = __expf(-0.6065306597126334f * sigm(prm[3 * RW + c0 + e] + lwv));
                    av[e] = sigm(prm[4 * RW + c0 + e] + lav);
                    kkv[e] = zs[1][e] * prm[5 * RW + c0 + e]; s1 += kkv[e] * kkv[e];
                    k2[e] = zs[1][e] * (1.f + (av[e] - 1.f) * prm[6 * RW + c0 + e]); s2 += zs[0][e] * k2[e] * prm[7 * RW + c0 + e];
                }
                s1 += DPPF(0.f, s1, 0xB1, 0xF); s1 += DPPF(0.f, s1, 0x4E, 0xF); s1 += DPPF(0.f, s1, 0x141, 0xF);
                s2 += DPPF(0.f, s2, 0xB1, 0xF); s2 += DPPF(0.f, s2, 0x4E, 0xF); s2 += DPPF(0.f, s2, 0x141, 0xF);
                const float inrm = 1.f / fmaxf(sqrtf(s1), 1e-12f);
                const size_t o = (size_t)m * RW + c0;
#pragma unroll
                for (int e = 0; e < 2; ++e) {
                    const float k0 = kkv[4 * e] * inrm, k1 = kkv[4 * e + 1] * inrm, k2_ = kkv[4 * e + 2] * inrm, k3 = kkv[4 * e + 3] * inrm;
                    *(f32x4*)(PW + o + 4 * e) = (f32x4){wv[4 * e], wv[4 * e + 1], wv[4 * e + 2], wv[4 * e + 3]};
                    { u32x2 t2; t2.x = pk2(-k0, -k1); t2.y = pk2(-k2_, -k3); *(u32x2*)(PNKK + o + 4 * e) = t2;
                      t2.x = pk2(k0 * av[4 * e], k1 * av[4 * e + 1]); t2.y = pk2(k2_ * av[4 * e + 2], k3 * av[4 * e + 3]); *(u32x2*)(PB + o + 4 * e) = t2;
                      t2.x = pk2(k2[4 * e], k2[4 * e + 1]); t2.y = pk2(k2[4 * e + 2], k2[4 * e + 3]); *(u32x2*)(PK + o + 4 * e) = t2;
                      t2.x = pk2(zs[0][4 * e], zs[0][4 * e + 1]); t2.y = pk2(zs[0][4 * e + 2], zs[0][4 * e + 3]); *(u32x2*)(PR + o + 4 * e) = t2; }
                }
                { u32x4 va;
#pragma unroll
                  for (int e = 0; e < 4; ++e) va[e] = pk2(zs[2][2 * e], zs[2][2 * e + 1]);
                  *(u32x4*)(PV + o) = va; *(u32x4*)(PG + o) = ga; }
                if ((lane & 7) == 0) BON[m * 16 + hd] = s2;
            }
        }
    }
    SEAM(5);
    if (IN(6)) for (int rep = 0; rep < (DUP_PHASE == 6 ? 2 : 1); ++rep) {
        MID(4);
        {
            float* wl = (float*)lds + wave * RL<0>::BUF;
            for (int task = gw; task < RH * NCH * 2; task += NGW) {
                const int part = task & 1, pair = task >> 1, h = pair / NCH, c = pair % NCH; const size_t o = (size_t)(c * LCH) * RW + h * 64;
                f32x2 S[32];
                if (part) {
#pragma unroll
                    for (int j = 0; j < 32; ++j) { S[j].x = (2 * j == lane) ? 1.f : 0.f; S[j].y = (2 * j + 1 == lane) ? 1.f : 0.f; }
                    rwkv_lds<1>(S, PW + o, PNKK + o, PB + o, PK + o, PR + o, PV + o, LCH, lane, nullptr, nullptr, nullptr, 0.f, 0.f, wl);
                } else {
#pragma unroll
                    for (int j = 0; j < 32; ++j) S[j] = (f32x2){0.f, 0.f};
                    rwkv_lds<0>(S, PW + o, PNKK + o, PB + o, PK + o, PR + o, PV + o, LCH, lane, nullptr, nullptr, nullptr, 0.f, 0.f, wl);
                }
                float* dst = PU + ((size_t)pair * 2 + (part ? 0 : 1)) * 4096 + lane * 64;
#pragma unroll
                for (int j = 0; j < 16; ++j) *(f32x4*)(dst + 4 * j) = (f32x4){S[2 * j].x, S[2 * j].y, S[2 * j + 1].x, S[2 * j + 1].y};
            }
        }
        __syncthreads();
        MID(5);
        bf16* kT = (bf16*)lds;
        bf16* vT = (bf16*)lds + 256 * 72;
        const int fr = lane & 15, fq = lane >> 4;
        for (int it = bid; it < EH * NRB * 2; it += G) {
            const int half = it & 1, blk = (it >> 1) % NRB, h = (it >> 1) / NRB; const float l2g = ret_l2g(h); const int m0 = blk * RBLK;
            f32x4 acc[2][8];
#pragma unroll
            for (int x = 0; x < 2; ++x)
#pragma unroll
                for (int y = 0; y < 8; ++y) acc[x][y] = (f32x4){0.f, 0.f, 0.f, 0.f};
            for (int ts = 0; ts < 4; ++ts) {
                __syncthreads();
#pragma unroll
                for (int i = 0; i < 4; ++i) { const int t = lane, dp = wave + 8 * i; const u32x4 raw = *(const u32x4*)(QKVG + (size_t)(m0 + ts * 64 + t) * EC + 1024 + h * 256 + dp * 8);
                    const float dec = exp2f(l2g * (float)(255 - (ts * 64 + t)));
#pragma unroll
                    for (int e = 0; e < 4; ++e) { const unsigned w = raw[e]; kT[(dp * 8 + 2 * e) * 72 + t] = (bf16)f2bf(bf2f(w & 0xffffu) * dec); kT[(dp * 8 + 2 * e + 1) * 72 + t] = (bf16)f2bf(bf2f(w >> 16) * dec); } }
#pragma unroll
                for (int i = 0; i < 2; ++i) { const int t = lane, ep = wave + 8 * i; const u32x4 raw = *(const u32x4*)(QKVG + (size_t)(m0 + ts * 64 + t) * EC + 2048 + h * 256 + half * 128 + ep * 8);
#pragma unroll
                    for (int e = 0; e < 4; ++e) { const unsigned w = raw[e]; vT[(ep * 8 + 2 * e) * 72 + t] = (bf16)(w & 0xffffu); vT[(ep * 8 + 2 * e + 1) * 72 + t] = (bf16)(w >> 16); } }
                __syncthreads();
#pragma unroll
                for (int kk = 0; kk < 2; ++kk) { bf16x8 af[2];
#pragma unroll
                    for (int x = 0; x < 2; ++x) af[x] = *(const bf16x8*)(kT + (32 * wave + 16 * x + fr) * 72 + kk * 32 + fq * 8);
#pragma unroll
                    for (int y = 0; y < 8; ++y) { const bf16x8 bfm = *(const bf16x8*)(vT + (16 * y + fr) * 72 + kk * 32 + fq * 8);
#pragma unroll
                        for (int x = 0; x < 2; ++x) acc[x][y] = __builtin_amdgcn_mfma_f32_16x16x32_bf16(af[x], bfm, acc[x][y], 0, 0, 0); } }
            }
            bf16* dst = KVB + ((size_t)(h * NRB + blk) * 256) * 256;
#pragma unroll
            for (int x = 0; x < 2; ++x)
#pragma unroll
                for (int y = 0; y < 8; ++y) { u32x2 w; w.x = pk2(acc[x][y][0], acc[x][y][1]); w.y = pk2(acc[x][y][2], acc[x][y][3]);
                    *(u32x2*)(dst + (size_t)(half * 128 + 16 * y + fr) * 256 + 32 * wave + 16 * x + fq * 4) = w; }
        }
    }
    if (IN(6)) MID(6);
    SEAM(6);
    if (IN(7)) for (int rep = 0; rep < (DUP_PHASE == 7 ? 2 : 1); ++rep) {
        const int nB = RH * 4;
        if (bid < nB || G <= nB) {
            float* Sb = (float*)lds;
            const int fr = lane & 15, fq = lane >> 4;
            for (int it = bid; it < nB; it += G) {
                const int h = it >> 2, g4 = it & 3; float* pu = PU + (size_t)(h * NCH) * 2 * 4096;
                __syncthreads();
                for (int idx = tid; idx < 16 * 65; idx += 512) Sb[idx] = 0.f;
                __syncthreads();
                if (wave < 4) {
                    float pa[16], pb[16]; f32x4 ua, ub;
#define PB_LOAD(dst, du, c) do { const float* pp = pu + (size_t)(c) * 2 * 4096; _Pragma("unroll") for (int kk = 0; kk < 16; ++kk) dst[kk] = pp[(4 * kk + fq) * 64 + 16 * wave + fr]; \
                        _Pragma("unroll") for (int jj = 0; jj < 4; ++jj) du[jj] = pp[4096 + (16 * g4 + 4 * fq + jj) * 64 + 16 * wave + fr]; } while (0)
                    PB_LOAD(pa, ua, 0); PB_LOAD(pb, ub, 1);
                    for (int c = 0; c < NCH; ++c) {
                        const float* Sc = Sb + (c & 1) * (16 * 65); float* Sn = Sb + ((c + 1) & 1) * (16 * 65);
                        f32x4 acc = ua, ac1 = {0.f, 0.f, 0.f, 0.f}, ac2 = ac1, ac3 = ac1;
#pragma unroll
                        for (int kk = 0; kk < 16; kk += 4) { acc = __builtin_amdgcn_mfma_f32_16x16x4f32(Sc[fr * 65 + 4 * kk + fq], pa[kk], acc, 0, 0, 0);
                            ac1 = __builtin_amdgcn_mfma_f32_16x16x4f32(Sc[fr * 65 + 4 * (kk + 1) + fq], pa[kk + 1], ac1, 0, 0, 0);
                            ac2 = __builtin_amdgcn_mfma_f32_16x16x4f32(Sc[fr * 65 + 4 * (kk + 2) + fq], pa[kk + 2], ac2, 0, 0, 0);
                            ac3 = __builtin_amdgcn_mfma_f32_16x16x4f32(Sc[fr * 65 + 4 * (kk + 3) + fq], pa[kk + 3], ac3, 0, 0, 0); }
                        acc = (acc + ac1) + (ac2 + ac3);
#pragma unroll
                        for (int jj = 0; jj < 4; ++jj) { Sn[(4 * fq + jj) * 65 + 16 * wave + fr] = acc[jj]; pu[(size_t)c * 2 * 4096 + 4096 + (16 * g4 + 4 * fq + jj) * 64 + 16 * wave + fr] = acc[jj]; }
                        if (c + 1 == NCH) {
#pragma unroll
                            for (int jj = 0; jj < 4; ++jj) out[O_WKP + (size_t)h * 4096 + (16 * g4 + 4 * fq + jj) * 64 + 16 * wave + fr] = acc[jj]; }
#pragma unroll
                        for (int kk = 0; kk < 16; ++kk) pa[kk] = pb[kk];
                        ua = ub;
                        if (c + 2 < NCH) PB_LOAD(pb, ub, c + 2);
                        asm volatile("s_waitcnt lgkmcnt(0)" ::: "memory");
                        __builtin_amdgcn_s_barrier();
                    }
#undef PB_LOAD
                } else {
                    for (int c = 0; c < NCH; ++c) __builtin_amdgcn_s_barrier();
                }
            }
        }
        if (bid >= nB || G <= nB) {
            const int nb2 = G <= nB ? G : G - nB, b2 = G <= nB ? bid : bid - nB;
            for (int it = b2 * 512 + tid; it < EH * 256 * 32; it += nb2 * 512) {
                const int h = it >> 13, e = (it >> 5) & 255, d0 = (it & 31) * 8; const float g256 = exp2f(256.f * ret_l2g(h));
                float acc[8];
#pragma unroll
                for (int q = 0; q < 8; ++q) acc[q] = 0.f;
                u32x4 kvr[NRB];
#pragma unroll
                for (int blk = 0; blk < NRB; ++blk) kvr[blk] = *(const u32x4*)(KVB + ((size_t)(h * NRB + blk) * 256 + e) * 256 + d0);
#pragma unroll
                for (int blk = 0; blk < NRB; ++blk) {
                    const size_t o = ((size_t)(h * NRB + blk) * 256 + e) * 256 + d0;
                    u32x4 w; w.x = pk2(acc[0], acc[1]); w.y = pk2(acc[2], acc[3]); w.z = pk2(acc[4], acc[5]); w.w = pk2(acc[6], acc[7]); *(u32x4*)(SPREV + o) = w;
                    const u32x4 kv = kvr[blk];
#pragma unroll
                    for (int q = 0; q < 4; ++q) { acc[2 * q] = acc[2 * q] * g256 + bf2f(kv[q] & 0xffffu); acc[2 * q + 1] = acc[2 * q + 1] * g256 + bf2f(kv[q] >> 16); }
                }
#pragma unroll
                for (int q = 0; q < 8; ++q) out[O_RTP + (size_t)h * 65536 + (size_t)(d0 + q) * 256 + e] = acc[q];
            }
            asm volatile("s_waitcnt vmcnt(0)" ::: "memory");
            __syncthreads();
            if (tid == 0) {
                unsigned* cw = (unsigned*)(a.ws + 65536) + XCD_BAR_WORDS + 64;
                __builtin_amdgcn_fence(__ATOMIC_RELEASE, "agent");
                asm volatile("s_waitcnt vmcnt(0)" ::: "memory");
                (void)xb_add(cw, 1u);
            }
        }
        {
            const int nscan = G <= nB ? G : G - nB;
            unsigned* cw = (unsigned*)(a.ws + 65536) + XCD_BAR_WORDS + 64; unsigned* cq = cw + 32;
            if (tid == 0) {
                unsigned sp = 0u; while (xb_ld(cw) < (unsigned)nscan) { __builtin_amdgcn_s_sleep(1); if (++sp > (1u << 22)) break; }
                __builtin_amdgcn_fence(__ATOMIC_ACQUIRE, "agent");
                asm volatile("s_waitcnt vmcnt(0)" ::: "memory");
            }
            __syncthreads();
            {
                const int fr = lane & 15, fq = lane >> 4;
                for (;;) {
                    __syncthreads();
                    if (tid == 0) xst[2] = xb_add(cq, 1u);
                    __syncthreads();
                    const int qi = (int)xst[2];
                    if (qi >= EH * (TP / 64)) break;
                    const int it = ((qi & 127) >> 5) * (TP / 64) + (qi & 31) * 4 + (3 - (qi >> 7));
                    {
                    const int h = it / (TP / 64), n = it % (TP / 64), blk = n >> 2, i = n & 3, m0 = n * 64; const float l2g = ret_l2g(h);
                    bf16* qL = (bf16*)lds; bf16* kL = qL + 64 * 264; bf16* vT = kL + 64 * 264; bf16* pL = vT + 256 * 72; float* red = (float*)(pL + 64 * 72);
#pragma unroll
                    for (int x = 0; x < 4; ++x) { const int p = tid + 512 * x, t = p >> 5, dp = p & 31; *(u32x4*)(qL + t * 264 + dp * 8) = *(const u32x4*)(QKVG + (size_t)(m0 + t) * EC + h * 256 + dp * 8); }
                    u32x4 kr[4], vr[4];
#define R3_LOADKV(jn) do { const int ms_ = (blk * 4 + (jn)) * 64; \
        _Pragma("unroll") for (int x = 0; x < 4; ++x) { const int p = tid + 512 * x; kr[x] = *(const u32x4*)(QKVG + (size_t)(ms_ + (p >> 5)) * EC + 1024 + h * 256 + (p & 31) * 8); \
            vr[x] = *(const u32x4*)(QKVG + (size_t)(ms_ + lane) * EC + 2048 + h * 256 + (wave + 8 * x) * 8); } } while (0)
                    R3_LOADKV(0);
                    __syncthreads();
                    f32x4 acc[4][2];
#pragma unroll
                    for (int x = 0; x < 4; ++x)
#pragma unroll
                        for (int y = 0; y < 2; ++y) acc[x][y] = (f32x4){0.f, 0.f, 0.f, 0.f};
                    if (blk > 0) {
                        const bf16* sp = SPREV + ((size_t)(h * NRB + blk) * 256) * 256;
#pragma unroll 2
                        for (int kk = 0; kk < 8; ++kk) { bf16x8 bfm[2];
#pragma unroll
                            for (int y = 0; y < 2; ++y) bfm[y] = *(const bf16x8*)(sp + (size_t)(32 * wave + 16 * y + fr) * 256 + kk * 32 + fq * 8);
#pragma unroll
                            for (int x = 0; x < 4; ++x) { const bf16x8 af = *(const bf16x8*)(qL + (16 * x + fr) * 264 + kk * 32 + fq * 8);
#pragma unroll
                                for (int y = 0; y < 2; ++y) acc[x][y] = __builtin_amdgcn_mfma_f32_16x16x32_bf16(af, bfm[y], acc[x][y], 0, 0, 0); } }
#pragma unroll
                        for (int x = 0; x < 4; ++x)
#pragma unroll
                            for (int jj = 0; jj < 4; ++jj) { const float qd = exp2f(l2g * (float)(64 * i + 16 * x + fq * 4 + jj + 1)); acc[x][0][jj] *= qd; acc[x][1][jj] *= qd; }
                    }
                    for (int j = 0; j <= i; ++j) {
                        __syncthreads();
#pragma unroll
                        for (int x = 0; x < 4; ++x) { const int p = tid + 512 * x, t = p >> 5, dp = p & 31; *(u32x4*)(kL + t * 264 + dp * 8) = kr[x]; }
#pragma unroll
                        for (int x = 0; x < 4; ++x) { const int t = lane, dp = wave + 8 * x;
                            const u32x4 raw = vr[x];
#pragma unroll
                            for (int e = 0; e < 4; ++e) { const unsigned w = raw[e]; vT[(dp * 8 + 2 * e) * 72 + t] = (bf16)(w & 0xffffu); vT[(dp * 8 + 2 * e + 1) * 72 + t] = (bf16)(w >> 16); } }
                        if (j < i) R3_LOADKV(j + 1);
                        __syncthreads();
                        { const int tr = wave >> 1, tc0 = (wave & 1) * 2; f32x4 sa[2] = {(f32x4){0.f, 0.f, 0.f, 0.f}, (f32x4){0.f, 0.f, 0.f, 0.f}};
#pragma unroll
                            for (int kk = 0; kk < 8; ++kk) { const bf16x8 af = *(const bf16x8*)(qL + (16 * tr + fr) * 264 + kk * 32 + fq * 8);
#pragma unroll
                                for (int y = 0; y < 2; ++y) { const bf16x8 bfm = *(const bf16x8*)(kL + (16 * (tc0 + y) + fr) * 264 + kk * 32 + fq * 8); sa[y] = __builtin_amdgcn_mfma_f32_16x16x32_bf16(af, bfm, sa[y], 0, 0, 0); } }
#pragma unroll
                            for (int y = 0; y < 2; ++y)
#pragma unroll
                                for (int jj = 0; jj < 4; ++jj) { const int t = 16 * tr + fq * 4 + jj, s = 16 * (tc0 + y) + fr; const int dist = (j < i) ? 64 * (i - j) + t - s : (t > s ? t - s : s - t);
                                    pL[t * 72 + s] = (bf16)f2bf(sa[y][jj] * exp2f(l2g * (float)dist)); } }
                        __syncthreads();
#pragma unroll
                        for (int kk = 0; kk < 2; ++kk) { bf16x8 bfm[2];
#pragma unroll
                            for (int y = 0; y < 2; ++y) bfm[y] = *(const bf16x8*)(vT + (32 * wave + 16 * y + fr) * 72 + kk * 32 + fq * 8);
#pragma unroll
                            for (int x = 0; x < 4; ++x) { const bf16x8 af = *(const bf16x8*)(pL + (16 * x + fr) * 72 + kk * 32 + fq * 8);
#pragma unroll
                                for (int y = 0; y < 2; ++y) acc[x][y] = __builtin_amdgcn_mfma_f32_16x16x32_bf16(af, bfm[y], acc[x][y], 0, 0, 0); } }
                    }
#undef R3_LOADKV
                    const int et = tid >> 3, e0 = (tid & 7) * 32;
                    u32x4 g4[4];
#pragma unroll
                    for (int q4 = 0; q4 < 4; ++q4) g4[q4] = *(const u32x4*)(QKVG + (size_t)(m0 + et) * EC + 3072 + h * 256 + e0 + 8 * q4);
                    __syncthreads();
                    float* OT = (float*)lds;
#pragma unroll
                    for (int x = 0; x < 4; ++x)
#pragma unroll
                        for (int y = 0; y < 2; ++y)
#pragma unroll
                            for (int jj = 0; jj < 4; ++jj) OT[(16 * x + fq * 4 + jj) * 260 + 32 * wave + 16 * y + fr] = acc[x][y][jj];
                    __syncthreads();
                    f32x4 ov[8]; float s1 = 0.f, s2 = 0.f;
#pragma unroll
                    for (int q8 = 0; q8 < 8; ++q8) { ov[q8] = *(const f32x4*)(OT + et * 260 + e0 + 4 * q8); s1 += (ov[q8].x + ov[q8].y) + (ov[q8].z + ov[q8].w);
                        s2 += (ov[q8].x * ov[q8].x + ov[q8].y * ov[q8].y) + (ov[q8].z * ov[q8].z + ov[q8].w * ov[q8].w); }
                    s1 += DPPF(0.f, s1, 0xB1, 0xF); s1 += DPPF(0.f, s1, 0x4E, 0xF); s1 += DPPF(0.f, s1, 0x141, 0xF);
                    s2 += DPPF(0.f, s2, 0xB1, 0xF); s2 += DPPF(0.f, s2, 0x4E, 0xF); s2 += DPPF(0.f, s2, 0x141, 0xF);
                    const float mean = s1 * (1.f / 256.f), var = s2 * (1.f / 256.f) - mean * mean, rstd = rsqrtf(var + 1e-5f);
                    const float* lwp = a.in[I_ELW] + h * 256 + e0; const float* lbp = a.in[I_ELB] + h * 256 + e0;
                    bf16* mp = MIX + (size_t)(m0 + et) * D + RW + h * 256 + e0;
#pragma unroll
                    for (int q4 = 0; q4 < 4; ++q4) { float o8[8];
#pragma unroll
                        for (int hh = 0; hh < 2; ++hh) { const f32x4 w4 = *(const f32x4*)(lwp + 8 * q4 + 4 * hh), b4 = *(const f32x4*)(lbp + 8 * q4 + 4 * hh); const f32x4 vv = ov[2 * q4 + hh];
                            const unsigned ga = g4[q4][2 * hh], gb = g4[q4][2 * hh + 1]; const float t0 = bf2f(ga & 0xffffu), t1 = bf2f(ga >> 16), t2 = bf2f(gb & 0xffffu), t3 = bf2f(gb >> 16);
                            o8[4 * hh] = ((vv.x - mean) * rstd * w4.x + b4.x) * t0 * sigm(t0); o8[4 * hh + 1] = ((vv.y - mean) * rstd * w4.y + b4.y) * t1 * sigm(t1);
                            o8[4 * hh + 2] = ((vv.z - mean) * rstd * w4.z + b4.z) * t2 * sigm(t2); o8[4 * hh + 3] = ((vv.w - mean) * rstd * w4.w + b4.w) * t3 * sigm(t3); }
                        u32x4 w; w.x = pk2(o8[0], o8[1]); w.y = pk2(o8[2], o8[3]); w.z = pk2(o8[4], o8[5]); w.w = pk2(o8[6], o8[7]); *(u32x4*)(mp + 8 * q4) = w; }

                    }
                }
            }
        }
    }
    if (IN(7)) MID(10);
    SEAM(7);
    if (IN(8)) for (int rep = 0; rep < (DUP_PHASE == 8 ? 2 : 1); ++rep) {
        MID(7);
        if (wave < 5) {
            float* wl = (float*)lds + wave * RL<2>::BUF;
            const int ntask = wave < 4 ? RH * NCH : NB * RH;
            for (int task = wave < 4 ? bid * 4 + wave : bid; task < ntask; task += (wave < 4 ? G * 4 : G)) {
                f32x2 S[32]; int h, m0, nsteps; float* sdst = nullptr;
                if (wave < 4) { h = task / NCH; const int c = task % NCH; m0 = c * LCH; nsteps = LCH;
                    if (c == 0) {
#pragma unroll
                        for (int j = 0; j < 32; ++j) S[j] = (f32x2){0.f, 0.f};
                    } else { const float* src = PU + ((size_t)(h * NCH + c - 1) * 2 + 1) * 4096 + lane * 64;
#pragma unroll
                        for (int j = 0; j < 16; ++j) { const f32x4 q = *(const f32x4*)(src + 4 * j); S[2 * j] = (f32x2){q.x, q.y}; S[2 * j + 1] = (f32x2){q.z, q.w}; } }
                } else { const int b = task / RH; h = task % RH; m0 = TP + 16 * b; nsteps = TS;
                    const float* src = a.in[I_SWKV] + ((size_t)(b * RH + h) * 64 + lane) * 64; sdst = out + O_WKS + ((size_t)(b * RH + h) * 64 + lane) * 64;
#pragma unroll
                    for (int j = 0; j < 16; ++j) { const f32x4 q = *(const f32x4*)(src + 4 * j); S[2 * j] = (f32x2){q.x, q.y}; S[2 * j + 1] = (f32x2){q.z, q.w}; } }
                const size_t o = (size_t)m0 * RW + h * 64;
                rwkv_lds<2>(S, PW + o, PNKK + o, PB + o, PK + o, PR + o, PV + o, nsteps, lane, PG + o, BON + (size_t)m0 * 16 + h, MIX + (size_t)m0 * D + h * 64,
                            a.in[I_RLW][h * 64 + lane], a.in[I_RLB][h * 64 + lane], wl);
                if (sdst) {
#pragma unroll
                    for (int j = 0; j < 16; ++j) *(f32x4*)(sdst + 4 * j) = (f32x4){S[2 * j].x, S[2 * j].y, S[2 * j + 1].x, S[2 * j + 1].y}; }
            }
        }
        MID(8);
        {
            const int nb2 = G, b2 = bid;
            const int fr = lane & 15, fq = lane >> 4;
            for (int it0 = b2; it0 < NB * EH * 4; it0 += nb2) {
                const int it = EH * (TP / 64) + it0;
                __syncthreads();
#ifndef NO_RS
                {
                    const int r = it - EH * (TP / 64), tq = r & 3, b = (r >> 2) / EH, h = (r >> 2) % EH, m0 = TP + 16 * b; const float l2g = ret_l2g(h);
                    float* qf = (float*)lds; float* kf = qf + 4 * 260; float* vf = kf + 16 * 257; float* pf = vf + 16 * 257; float* red = pf + 64;
                    for (int idx = tid; idx < 16 * 256; idx += 512) { const int t = idx >> 8, dd = idx & 255; const bf16* src = QKVG + (size_t)(m0 + t) * EC + h * 256 + dd;
                        if ((t >> 2) == tq) qf[(t & 3) * 260 + dd] = bf2f(src[0]);
                        kf[t * 257 + dd] = bf2f(src[1024]); vf[t * 257 + dd] = bf2f(src[2048]); }
                    __syncthreads();
                    if (tid < 64) { const int tl = tid >> 4, s = tid & 15, t = 4 * tq + tl; float sc = 0.f;
#pragma unroll 4
                        for (int dd = 0; dd < 256; ++dd) sc += qf[tl * 260 + dd] * kf[s * 257 + dd];
                        pf[tl * 16 + s] = sc * exp2f(l2g * (float)(t > s ? t - s : s - t)); }
                    __syncthreads();
                    const int e = tid & 255, th = tid >> 8; const float* S0 = a.in[I_SRET] + (size_t)(b * EH + h) * 65536;
                    float oc[2] = {0.f, 0.f};
#pragma unroll 4
                    for (int dd = 0; dd < 256; dd += 4) { const f32x4 qa = *(const f32x4*)(qf + (2 * th) * 260 + dd), qb = *(const f32x4*)(qf + (2 * th + 1) * 260 + dd);
                        const float s0 = S0[(size_t)dd * 256 + e], s1 = S0[(size_t)(dd + 1) * 256 + e], s2 = S0[(size_t)(dd + 2) * 256 + e], s3 = S0[(size_t)(dd + 3) * 256 + e];
                        oc[0] += qa.x * s0 + qa.y * s1 + qa.z * s2 + qa.w * s3; oc[1] += qb.x * s0 + qb.y * s1 + qb.z * s2 + qb.w * s3; }
#pragma unroll
                    for (int tt = 0; tt < 2; ++tt) { const int tl = 2 * th + tt, t = 4 * tq + tl; float v = oc[tt] * exp2f(l2g * (float)(t + 1));
#pragma unroll 4
                        for (int s = 0; s < 16; ++s) v += pf[tl * 16 + s] * vf[s * 257 + e];
                        oc[tt] = v; }
                    { const float g16 = exp2f(16.f * l2g); float* dst = out + O_RTS + (size_t)(b * EH + h) * 65536; float vd[16];
#pragma unroll
                        for (int t = 0; t < 16; ++t) vd[t] = vf[t * 257 + e] * exp2f(l2g * (float)(15 - t));
#pragma unroll 4
                        for (int dd = 64 * tq + 32 * th; dd < 64 * tq + 32 * th + 32; ++dd) { float v = g16 * S0[(size_t)dd * 256 + e];
#pragma unroll
                            for (int t = 0; t < 16; ++t) v += kf[t * 257 + dd] * vd[t];
                            dst[(size_t)dd * 256 + e] = v; } }
#pragma unroll
                    for (int tt = 0; tt < 2; ++tt) { const float s1 = wave_sum(oc[tt]), s2 = wave_sum(oc[tt] * oc[tt]); if (lane == 0) { const int tl = 2 * th + tt; red[(tl * 4 + (wave & 3)) * 2] = s1; red[(tl * 4 + (wave & 3)) * 2 + 1] = s2; } }
                    __syncthreads();
                    const float lw = a.in[I_ELW][h * 256 + e], lb = a.in[I_ELB][h * 256 + e];
#pragma unroll
                    for (int tt = 0; tt < 2; ++tt) { const int tl = 2 * th + tt, t = 4 * tq + tl; float s1 = 0.f, s2 = 0.f;
#pragma unroll
                        for (int w4 = 0; w4 < 4; ++w4) { s1 += red[(tl * 4 + w4) * 2]; s2 += red[(tl * 4 + w4) * 2 + 1]; }
                        const float mean = s1 * (1.f / 256.f), var = s2 * (1.f / 256.f) - mean * mean, rstd = rsqrtf(var + 1e-5f);
                        const float gt = bf2f(QKVG[(size_t)(m0 + t) * EC + 3072 + h * 256 + e]);
                        MIX[(size_t)(m0 + t) * D + RW + h * 256 + e] = (bf16)f2bf(((oc[tt] - mean) * rstd * lw + lb) * gt * sigm(gt)); }
                }
#else
                {}
#endif
            }
        }
    }
    if (IN(8)) MID(9);
    SEAM(8);
    if (IN(9)) for (int rep = 0; rep < (DUP_PHASE == 9 ? 2 : 1); ++rep) {
        { pg8::Gemm g{MIX, WOUTT, TP, D, D, D}; pg8::StaticOrder S; S.init(TP, D, G, bid); EpiF32 E{MIXOUT, D};
          pg8::gemm_phase<EpiF32, pg8::StaticOrder, true, true>((PG8_LAS unsigned char*)lds, g, S, E); }
        { const int sl = bid >> 3; pg8::Gemm g{MIX + (size_t)TP * D + sl * 512, WOUTT + sl * 512, MS, D, 512, D}; pg8::OneUnit S{0, bid & 7, bid < 8 * KS9}; EpiF32 E{(float*)(ws + WS_PART9) + (size_t)sl * MS * D, D};
          pg8::gemm_phase<EpiF32, pg8::OneUnit, false, true>((PG8_LAS unsigned char*)lds, g, S, E); }
        if (G > 8 * KS9 && bid >= 8 * KS9) {
            float* scr = (float*)lds + wave * (64 * 33 + 16);
            for (int r = (bid - 8 * KS9) * 8 + wave; r < (FF / 64) * (D / 32); r += (G - 8 * KS9) * 8) { const int nb = D / 32, kb = r / nb, n0 = 32 * (r % nb); transpose_item(a.in[I_WDN], FF, D, WDNT, 64 * kb, n0, n0, scr, lane); }
        }
    }
    SEAM(9);
    if (IN(10)) for (int rep = 0; rep < (DUP_PHASE == 10 ? 2 : 1); ++rep) {
        for (int m = gw; m < M; m += NGW) {
            const float* xr = m < TP ? a.in[I_XP] + (size_t)m * D : a.in[I_XS] + (size_t)(m - TP) * D; const float* mod = MOD + seq_of(m) * MODW; const float* mr = MIXOUT + (size_t)m * D;
            f32x4 v[8]; float ss = 0.f;
#pragma unroll
            for (int j = 0; j < 8; ++j) {
                if (m < TP) v[j] = *(const f32x4*)(mr + 4 * lane + 256 * j);
                else { const float* pr = (const float*)(ws + WS_PART9) + (size_t)(m - TP) * D + 4 * lane + 256 * j; v[j] = *(const f32x4*)pr;
#pragma unroll
                    for (int q = 1; q < KS9; ++q) v[j] += *(const f32x4*)(pr + (size_t)q * MS * D); }
                ss += (v[j].x * v[j].x + v[j].y * v[j].y) + (v[j].z * v[j].z + v[j].w * v[j].w); }
            const float rs = rsqrtf(wave_sum(ss) * (1.f / D) + 1e-6f); float s2 = 0.f;
#pragma unroll
            for (int j = 0; j < 8; ++j) { const int c = 4 * lane + 256 * j; const f32x4 g = *(const f32x4*)(a.in[I_GPOM] + c), gt = *(const f32x4*)(mod + 2 * D + c), x = *(const f32x4*)(xr + c);
                v[j] = x + gt * (v[j] * rs * g); *(f32x4*)(out + (size_t)m * D + c) = v[j]; s2 += (v[j].x * v[j].x + v[j].y * v[j].y) + (v[j].z * v[j].z + v[j].w * v[j].w); }
            const float rs2 = rsqrtf(wave_sum(s2) * (1.f / D) + 1e-6f);
#pragma unroll
            for (int j = 0; j < 8; ++j) { const int c = 4 * lane + 256 * j; const f32x4 g = *(const f32x4*)(a.in[I_GPF] + c), s1 = *(const f32x4*)(mod + 4 * D + c), h1 = *(const f32x4*)(mod + 3 * D + c);
                const f32x4 h = v[j] * rs2 * g * (s1 + 1.f) + h1; u32x2 w; w.x = pk2(h.x, h.y); w.y = pk2(h.z, h.w); *(u32x2*)(H + (size_t)m * D + c) = w; }
        }
        float* scr = (float*)lds + wave * (64 * 33 + 16);
        constexpr int IT_UP = (D / 64) * (2 * FF / 32), IT_DN = (FF / 64) * (D / 32);
        for (int it = gw; it < IT_UP + (G > 8 * KS9 ? 0 : IT_DN); it += NGW) {
            if (it < IT_UP) { const int nb = 2 * FF / 32, kb = it / nb, n0 = 32 * (it % nb); const int nn = n0 < FF ? n0 : n0 - FF; const int dr = 256 * (nn >> 7) + (n0 < FF ? 0 : 128) + (nn & 127);
                transpose_item(a.in[I_WUP], D, 2 * FF, WUPT, 64 * kb, n0, dr, scr, lane); }
            else { const int r = it - IT_UP, nb = D / 32, kb = r / nb, n0 = 32 * (r % nb); transpose_item(a.in[I_WDN], FF, D, WDNT, 64 * kb, n0, n0, scr, lane); }
        }
    }
    SEAM(10);
    if (IN(11)) for (int rep = 0; rep < (DUP_PHASE == 11 ? 2 : 1); ++rep) {
        pg8::Gemm g{H, WUPT, M, 2 * FF, D, D}; pg8::StaticOrder S; S.init(M, 2 * FF, G, bid); EpiSwiglu E{ACT};
        pg8::gemm_phase<EpiSwiglu, pg8::StaticOrder, true, true>((PG8_LAS unsigned char*)lds, g, S, E);
    }
    SEAM(11);
    if (IN(12)) for (int rep = 0; rep < (DUP_PHASE == 12 ? 2 : 1); ++rep) {
        { pg8::Gemm g{ACT, WDNT, TP, D, FF, FF}; pg8::StaticOrder S; S.init(TP, D, G, bid); EpiF32 E{MIXOUT, D};
          pg8::gemm_phase<EpiF32, pg8::StaticOrder, true, true>((PG8_LAS unsigned char*)lds, g, S, E); }
        { const int sl = bid >> 3; pg8::Gemm g{ACT + (size_t)TP * FF + sl * 512, WDNT + sl * 512, MS, D, 512, FF}; pg8::OneUnit S{0, bid & 7, bid < 8 * KS12}; EpiF32 E{(float*)(ws + WS_PART12) + (size_t)sl * MS * D, D};
          pg8::gemm_phase<EpiF32, pg8::OneUnit, false, true>((PG8_LAS unsigned char*)lds, g, S, E); }
    }
    SEAM(12);
    if (IN(13)) for (int rep = 0; rep < (DUP_PHASE == 13 ? 2 : 1); ++rep) {
        for (int m = gw; m < M; m += NGW) {
            const float* mod = MOD + seq_of(m) * MODW; const float* fr_ = MIXOUT + (size_t)m * D;
            f32x4 v[8]; float ss = 0.f;
#pragma unroll
            for (int j = 0; j < 8; ++j) {
                if (m < TP) v[j] = *(const f32x4*)(fr_ + 4 * lane + 256 * j);
                else { const float* pr = (const float*)(ws + WS_PART12) + (size_t)(m - TP) * D + 4 * lane + 256 * j; v[j] = *(const f32x4*)pr;
#pragma unroll
                    for (int q = 1; q < KS12; ++q) v[j] += *(const f32x4*)(pr + (size_t)q * MS * D); }
                ss += (v[j].x * v[j].x + v[j].y * v[j].y) + (v[j].z * v[j].z + v[j].w * v[j].w); }
            const float rs = rsqrtf(wave_sum(ss) * (1.f / D) + 1e-6f);
#pragma unroll
            for (int j = 0; j < 8; ++j) { const int c = 4 * lane + 256 * j; const f32x4 g = *(const f32x4*)(a.in[I_GPOF] + c), gt = *(const f32x4*)(mod + 5 * D + c), x = *(const f32x4*)(out + (size_t)m * D + c);
                *(f32x4*)(out + (size_t)m * D + c) = x + gt * (v[j] * rs * g); }
        }
    }
    if (TS_PROBE >= 0) {
        xcd_barrier(xb);
        if (bid == 0 && tid == 0) TSW[14] = __builtin_amdgcn_s_memrealtime();
        if (bid == 0) { __syncthreads(); const float us = TS_PROBE >= 100 ? (float)(TSW[32 + TS_PROBE - 100] - TSW[32 + TS_PROBE - 101]) * 0.01f : (float)(TSW[1 + TS_PROBE] - TSW[TS_PROBE]) * 0.01f; const float eps = sqrtf(us * 1e-4f);
            for (int c = tid; c < RC; c += 512) out[O_SHP + c] *= (1.f + eps); }
    }
#undef IN
#undef SEAM
}

extern "C" void kernel_launch(void* const* d_in, const int* in_sizes, int n_in, void* d_out, int out_size, void* d_ws, size_t ws_size, hipStream_t stream) {
    static int grid = 0;
    if (grid == 0) {
        if (n_in != 30 || (size_t)out_size != O_END || ws_size < WS_END) { fprintf(stderr, "kernel_launch: unexpected sizes n_in %d out %d ws %zu\n", n_in, out_size, ws_size); grid = -1; return; }
        int dev = 0, cus = 0, per_cu = 0;
        (void)hipGetDevice(&dev); (void)hipDeviceGetAttribute(&cus, hipDeviceAttributeMultiprocessorCount, dev);
        if (hipFuncSetAttribute((const void*)mk_fwd, hipFuncAttributeMaxDynamicSharedMemorySize, LDS_BYTES) != hipSuccess) { fprintf(stderr, "kernel_launch: hipFuncSetAttribute failed\n"); grid = -1; return; }
        if (hipOccupancyMaxActiveBlocksPerMultiprocessor(&per_cu, (const void*)mk_fwd, 512, LDS_BYTES) != hipSuccess || per_cu < 1) { fprintf(stderr, "kernel_launch: occupancy query says %d\n", per_cu); per_cu = 1; }
        (void)hipGetLastError();
        grid = cus;
        if (grid <= 0) grid = 256;
    }
    if (grid < 0) return;
    (void)hipMemsetAsync((char*)d_ws + 65536, 0, XCD_BAR_WORDS * 4 + 512, stream);
    Args a{};
    for (int i = 0; i < 30; ++i) a.in[i] = (const float*)d_in[i];
    a.out = (float*)d_out; a.ws = (unsigned char*)d_ws;
    a.ph_lo = 0; a.ph_hi = NPHASE;
    void* args[] = {&a};
    hipError_t e = hipLaunchCooperativeKernel((const void*)mk_fwd, dim3(grid), dim3(512), args, LDS_BYTES, stream);
    if (e != hipSuccess) fprintf(stderr, "kernel_launch: cooperative launch failed: %s (grid %d)\n", hipGetErrorString(e), grid);
}
```

```cpp
#include <hip/hip_runtime.h>
#include <hip/hip_cooperative_groups.h>
#include <cstdio>
#include <cstdint>
namespace cg = cooperative_groups;
namespace pg8 {
#define PG8_LAS __attribute__((address_space(3)))
typedef unsigned short bf16_t;
typedef short bf16x8 __attribute__((ext_vector_type(8)));
typedef float f32x4 __attribute__((ext_vector_type(4)));
typedef unsigned u32x4 __attribute__((ext_vector_type(4)));
constexpr int BM = 256, BK = 64, HALF = 128, HTB = HALF * BK * 2  , STAGE_BYTES = 8 * HTB, NXCD = 8, WGM = 8;

__host__ __device__ __forceinline__ int lds_byte(int r, int c) { const int st = (r >> 4) * 2 + (c >> 5), rr = r & 15, cc = c & 31, ob = rr * 64 + cc * 2; return st * 1024 + (ob ^ (((ob >> 9) & 1) << 5)); }
__host__ __device__ __forceinline__ void stage_rc(int b, int& R, int& C) { const int st = b / 1024, sb = b % 1024, swz = sb ^ (((sb >> 9) & 1) << 5); R = (st >> 1) * 16 + swz / 64; C = (st & 1) * 32 + (swz % 64) / 2; }
__host__ __device__ __forceinline__ int perm32(int rho) { const int n = rho >> 4, i = rho & 15; return 8 * (i >> 2) + 4 * n + (i & 3); }

struct Unit { int pm, pn; };
struct Gemm { const bf16_t* A; const bf16_t* Bt; int M, N, K, ld; };

struct OneUnit {
    int pm, pn; bool active;
    __device__ __forceinline__ bool next(int i, Unit& u) const { if (i > 0 || !active) return false; u.pm = pm; u.pn = pn; return true; }
    __device__ __forceinline__ void a_ready(const Unit&) const {}
    __device__ __forceinline__ void done(const Unit&) const {}
};
struct StaticOrder {
    int nM, nN, nwg, G, c;
    __host__ __device__ void init(int M, int N, int G_, int c_) { nM = M / BM; nN = N / BM; nwg = nM * nN; G = G_; c = c_; }
    __host__ __device__ bool next(int i, Unit& u) const {
        const long L = (long)i * G + c; if (L >= nwg) return false;
        int wgid = (int)L; { const int q = nwg / NXCD, r = nwg % NXCD, xcd = wgid % NXCD, off = wgid / NXCD; wgid = (xcd < r ? xcd * (q + 1) : r * (q + 1) + (xcd - r) * q) + off; }
        const int nig = WGM * nN, gid = wgid / nig, fm = gid * WGM, gsz = (nM - fm) < WGM ? (nM - fm) : WGM;
        u.pm = fm + ((wgid % nig) % gsz); u.pn = (wgid % nig) / gsz; return true;
    }
    __device__ __forceinline__ void a_ready(const Unit&) const {}
    __device__ __forceinline__ void done(const Unit&) const {}
};

__device__ __forceinline__ unsigned cvt_pk_bf16(float lo, float hi) { unsigned r; asm volatile("v_cvt_pk_bf16_f32 %0, %1, %2" : "=v"(r) : "v"(lo), "v"(hi)); return r; }
template <class Epi, class Sched, bool ALIGN_EPI = false, bool SP2 = false>
__device__ __forceinline__ void gemm_phase(PG8_LAS unsigned char* lds, const Gemm g, const Sched& S, const Epi& E) {
    const int tid = threadIdx.x, wid = __builtin_amdgcn_readfirstlane(tid >> 6), lane = tid & 63, wr = wid >> 2, wc = wid & 3, fr = lane & 15, fq = lane >> 4;
    const int K = g.K, nt = K / BK;
    unsigned voffA[2], voffB[2];
#pragma unroll
    for (int i = 0; i < 2; ++i) { int R, C; stage_rc(tid * 16 + i * 8192, R, C); const int Rb = Epi::PERM ? ((R & ~31) + perm32(R & 31)) : R;
        voffA[i] = (unsigned)(R * g.ld + C) * 2u; voffB[i] = (unsigned)(Rb * g.ld + C) * 2u; }
    const size_t kstep = (size_t)(BK * 2);
    const size_t hstep = (size_t)HALF * g.ld * 2;
    const size_t tstep = 2 * hstep;
    const unsigned ldsw = (unsigned)wid * 1024u;
    const int aoff = lds_byte(wr * 64 + fr, fq * 8), boff = lds_byte(wc * 32 + fr, fq * 8);
#define PG8_SA(b, h) (((b) * 2 + (h)) * HTB)
#define PG8_SB(b, h) ((4 + (b) * 2 + (h)) * HTB)
#define PG8_STAGE(bufoff, gbase, voff) do { _Pragma("unroll") for (int _i = 0; _i < 2; ++_i) \
        __builtin_amdgcn_global_load_lds((const unsigned*)((const char*)(gbase) + (voff)[_i]), (PG8_LAS unsigned*)(lds + (bufoff) + ldsw + _i * 8192), 16, 0, 0); } while (0)
#define PG8_LDA(dst, b, h) do { _Pragma("unroll") for (int m = 0; m < 4; ++m) _Pragma("unroll") for (int k = 0; k < 2; ++k) dst[m][k] = *(const PG8_LAS bf16x8*)(lds + PG8_SA(b, h) + aoff + m * 2048 + k * 1024); } while (0)
#define PG8_LDB(dst, b, h) do { _Pragma("unroll") for (int n = 0; n < 2; ++n) _Pragma("unroll") for (int k = 0; k < 2; ++k) dst[n][k] = *(const PG8_LAS bf16x8*)(lds + PG8_SB(b, h) + boff + n * 2048 + k * 1024); } while (0)
#define PG8_MMA(ai, bj, At, Bt) do { __builtin_amdgcn_s_setprio(1); _Pragma("unroll") for (int m = 0; m < 4; ++m) _Pragma("unroll") for (int n = 0; n < 2; ++n) _Pragma("unroll") for (int k = 0; k < 2; ++k) \
        acc[ai][bj][m][n] = __builtin_amdgcn_mfma_f32_16x16x32_bf16(Bt[n][k], At[m][k], acc[ai][bj][m][n], 0, 0, 0); __builtin_amdgcn_s_setprio(0); } while (0)
#define PG8_WAIT_V(n) asm volatile("s_waitcnt vmcnt(" #n ")" ::: "memory")
#define PG8_WAIT_L(n) asm volatile("s_waitcnt lgkmcnt(" #n ")" ::: "memory")
#define PG8_BAR __builtin_amdgcn_s_barrier()
#define PG8_SCHED __builtin_amdgcn_sched_barrier(0)
    Unit cur, nxt; int ui = 0;
    if (!S.next(0, cur)) return;
    f32x4 acc[2][2][4][2];
#pragma unroll
    for (int a = 0; a < 2; ++a)
#pragma unroll
        for (int b = 0; b < 2; ++b)
#pragma unroll
            for (int m = 0; m < 4; ++m)
#pragma unroll
                for (int n = 0; n < 2; ++n) acc[a][b][m][n] = (f32x4){0.f, 0.f, 0.f, 0.f};
    bf16x8 At[4][2], B0[2][2], B1[2][2];
    const char* cA = (const char*)g.A + (size_t)cur.pm * tstep; const char* cB = (const char*)g.Bt + (size_t)cur.pn * tstep;
    S.a_ready(cur);
    if constexpr (SP2) {
        PG8_STAGE(PG8_SB(0, 0), cB, voffB); PG8_STAGE(PG8_SB(0, 1), cB + hstep, voffB); PG8_STAGE(PG8_SA(0, 0), cA, voffA); PG8_STAGE(PG8_SA(0, 1), cA + hstep, voffA);
        if (wr == 1) PG8_BAR;
        PG8_WAIT_V(2); PG8_BAR;
        PG8_STAGE(PG8_SB(1, 0), cB + kstep, voffB); PG8_STAGE(PG8_SA(1, 0), cA + kstep, voffA); PG8_STAGE(PG8_SB(1, 1), cB + hstep + kstep, voffB);
        PG8_WAIT_V(6); PG8_BAR;
    } else {
        PG8_STAGE(PG8_SB(0, 0), cB, voffB); PG8_STAGE(PG8_SA(0, 0), cA, voffA); PG8_STAGE(PG8_SB(0, 1), cB + hstep, voffB); PG8_STAGE(PG8_SA(0, 1), cA + hstep, voffA);
        if (wr == 1) PG8_BAR;
        PG8_WAIT_V(4); PG8_BAR;
        PG8_STAGE(PG8_SB(1, 0), cB + kstep, voffB); PG8_STAGE(PG8_SA(1, 0), cA + kstep, voffA); PG8_STAGE(PG8_SB(1, 1), cB + hstep + kstep, voffB);
        PG8_WAIT_V(6); PG8_BAR;
    }
    for (;;) {
        const bool has_next = S.next(ui + 1, nxt);
        const char* nA = has_next ? (const char*)g.A + (size_t)nxt.pm * tstep : cA; const char* nB = has_next ? (const char*)g.Bt + (size_t)nxt.pn * tstep : cB;
        for (int t = 0; t < nt; t += 2) {
            const bool last = (t == nt - 2);
            const char* a1 = cA + (size_t)(t + 1) * kstep;
            const char* a2 = last ? nA : cA + (size_t)(t + 2) * kstep; const char* b2 = last ? nB : cB + (size_t)(t + 2) * kstep;
            const char* a3 = a2 + kstep; const char* b3 = b2 + kstep;
            if (last && has_next) S.a_ready(nxt);
            if constexpr (SP2) {
            PG8_LDB(B0, 0, 0); PG8_LDB(B1, 0, 1); PG8_SCHED; PG8_LDA(At, 0, 0); PG8_STAGE(PG8_SA(1, 1), a1 + hstep, voffA);
            PG8_WAIT_V(8); PG8_WAIT_L(0); PG8_BAR; PG8_MMA(0, 0, At, B0); PG8_MMA(0, 1, At, B1); PG8_BAR; PG8_SCHED;
            PG8_LDA(At, 0, 1); PG8_STAGE(PG8_SB(0, 0), b2, voffB); PG8_STAGE(PG8_SB(0, 1), b2 + hstep, voffB); PG8_STAGE(PG8_SA(0, 0), a2, voffA);
            PG8_WAIT_V(8); PG8_WAIT_L(0); PG8_BAR; PG8_MMA(1, 0, At, B0); PG8_MMA(1, 1, At, B1); PG8_BAR; PG8_SCHED;
            PG8_LDB(B0, 1, 0); PG8_LDB(B1, 1, 1); PG8_SCHED; PG8_LDA(At, 1, 0); PG8_STAGE(PG8_SA(0, 1), a2 + hstep, voffA);
            PG8_WAIT_V(8); PG8_WAIT_L(0); PG8_BAR; PG8_MMA(0, 0, At, B0); PG8_MMA(0, 1, At, B1); PG8_BAR; PG8_SCHED;
            PG8_LDA(At, 1, 1); PG8_STAGE(PG8_SB(1, 0), b3, voffB); PG8_STAGE(PG8_SB(1, 1), b3 + hstep, voffB); PG8_STAGE(PG8_SA(1, 0), a3, voffA);
            PG8_WAIT_V(8); PG8_WAIT_L(0); PG8_BAR; PG8_MMA(1, 0, At, B0); PG8_MMA(1, 1, At, B1); PG8_BAR; PG8_SCHED;
            } else {
            PG8_LDB(B0, 0, 0); PG8_SCHED; PG8_LDA(At, 0, 0); PG8_STAGE(PG8_SA(1, 1), a1 + hstep, voffA);
            PG8_WAIT_L(8); PG8_BAR; PG8_WAIT_L(0); PG8_MMA(0, 0, At, B0); PG8_BAR; PG8_SCHED;
            PG8_LDB(B1, 0, 1); PG8_STAGE(PG8_SB(0, 0), b2, voffB);
            PG8_BAR; PG8_WAIT_L(0); PG8_MMA(0, 1, At, B1); PG8_BAR;
            PG8_LDA(At, 0, 1); PG8_STAGE(PG8_SA(0, 0), a2, voffA);
            PG8_BAR; PG8_WAIT_L(0); PG8_MMA(1, 0, At, B0); PG8_BAR; PG8_SCHED;
            PG8_STAGE(PG8_SB(0, 1), b2 + hstep, voffB);
            PG8_WAIT_V(6); PG8_BAR; PG8_MMA(1, 1, At, B1); PG8_BAR;
            PG8_LDB(B0, 1, 0); PG8_SCHED; PG8_LDA(At, 1, 0); PG8_STAGE(PG8_SA(0, 1), a2 + hstep, voffA);
            PG8_WAIT_L(8); PG8_BAR; PG8_WAIT_L(0); PG8_MMA(0, 0, At, B0); PG8_BAR; PG8_SCHED;
            PG8_LDB(B1, 1, 1); PG8_STAGE(PG8_SB(1, 0), b3, voffB);
            PG8_BAR; PG8_WAIT_L(0); PG8_MMA(0, 1, At, B1); PG8_BAR;
            PG8_LDA(At, 1, 1); PG8_STAGE(PG8_SA(1, 0), a3, voffA);
            PG8_BAR; PG8_WAIT_L(0); PG8_MMA(1, 0, At, B0); PG8_BAR; PG8_SCHED;
            PG8_STAGE(PG8_SB(1, 1), b3 + hstep, voffB);
            PG8_WAIT_V(6); PG8_BAR; PG8_MMA(1, 1, At, B1); PG8_BAR;
            }
        }
        if constexpr (ALIGN_EPI) { if (wr == 0) PG8_BAR; }
        if constexpr (!Epi::AFTER_DRAIN) { E(acc, cur, wr, wc, fr, fq); S.done(cur); }
        if (!has_next) break;
#pragma unroll
        for (int a = 0; a < 2; ++a)
#pragma unroll
            for (int b = 0; b < 2; ++b)
#pragma unroll
                for (int m = 0; m < 4; ++m)
#pragma unroll
                    for (int n = 0; n < 2; ++n) acc[a][b][m][n] = (f32x4){0.f, 0.f, 0.f, 0.f};
        cur = nxt; cA = nA; cB = nB; ++ui;
        if constexpr (ALIGN_EPI) { if (wr == 1) PG8_BAR; }
    }
    PG8_WAIT_V(0);
    if constexpr (!ALIGN_EPI) { if (wr == 0) PG8_BAR; }
    PG8_BAR;
    if constexpr (Epi::AFTER_DRAIN) { E.fused(acc, cur, wr, wc, fr, fq, lds, wid, lane); S.done(cur); }
#undef PG8_SA
#undef PG8_SB
#undef PG8_STAGE
#undef PG8_LDA
#undef PG8_LDB
#undef PG8_MMA
#undef PG8_WAIT_V
#undef PG8_WAIT_L
#undef PG8_BAR
#undef PG8_SCHED
}
}

constexpr int D = 2048, TP = 8192, NB = 16, TS = 16, MS = NB * TS, M = TP + MS;
constexpr int RW = 1024, RH = 16, RN = 64, RC = 3328;
constexpr int ED = 1024, EH = 4, EN = 256, EC = 4096, IC = RC + EC;
constexpr int FF = 5632, NSEQ = 17, MODW = 6 * D;
constexpr int LCH = 128, NCH = TP / LCH;
constexpr int RBLK = 256, NRB = TP / RBLK;
constexpr int NPHASE = 14;
constexpr size_t O_Y = 0, O_SHP = (size_t)M * D, O_WKP = O_SHP + RC, O_RTP = O_WKP + 65536, O_SHS = O_RTP + 262144, O_WKS = O_SHS + (size_t)NB * RC, O_RTS = O_WKS + (size_t)NB * 65536, O_END = O_RTS + (size_t)NB * 262144;
constexpr size_t MiB = 1u << 20;
constexpr size_t WS_MOD = 1 * MiB, WS_LORAT = 2 * MiB, WS_WOUTT = 4 * MiB, WS_WINT = 12 * MiB, WS_V = 12 * MiB, WS_H = 41 * MiB, WS_G = 41 * MiB, WS_BON = 58 * MiB,
                 WS_QKVG = 74 * MiB, WS_LOUT = 140 * MiB, WS_PU = 140 * MiB, WS_KVB = 172 * MiB, WS_ACT = 74 * MiB, WS_PREP = 190 * MiB, WS_MIXOUT = 190 * MiB,
                 WS_WUPT = 256 * MiB, WS_WDNT = 300 * MiB, WS_PART9 = 330 * MiB, WS_PART12 = 256 * MiB, WS_END = 355 * MiB;
constexpr size_t WS_ADAT = 190 * MiB, WS_SC = 239 * MiB, WS_MODP = 240 * MiB;
constexpr int KS9 = 4, KS12 = 11;
constexpr size_t PREP_STRIDE = 33 * MiB;
constexpr size_t DO_Z = 0, DO_LIN = 54 * MiB, DO_SPREV = 0, DO_MIX = 17 * MiB;
constexpr int LDS_BYTES = 147456;

typedef unsigned short bf16;
typedef float f32x2 __attribute__((ext_vector_type(2)));
typedef float f32x4 __attribute__((ext_vector_type(4)));
typedef short bf16x8 __attribute__((ext_vector_type(8)));
typedef unsigned u32x4 __attribute__((ext_vector_type(4)));
typedef unsigned u32x2 __attribute__((ext_vector_type(2)));
#define LDS_WAIT() asm volatile("s_waitcnt lgkmcnt(0)" ::: "memory")

__device__ __forceinline__ float bf2f(unsigned v) { return __builtin_bit_cast(float, v << 16); }
__device__ __forceinline__ unsigned f2bf(float f) { unsigned u = __builtin_bit_cast(unsigned, f); return (u + 0x7fffu + ((u >> 16) & 1u)) >> 16; }
__device__ __forceinline__ unsigned pk2(float lo, float hi) { return f2bf(lo) | (f2bf(hi) << 16); }
__device__ __forceinline__ float wave_sum(float v) {
#pragma unroll
    for (int o = 1; o < 64; o <<= 1) v += __shfl_xor(v, o);
    return v;
}
__device__ __forceinline__ float sigm(float x) { return 1.f / (1.f + __expf(-x)); }
__device__ __forceinline__ int seq_of(int m) { return m < TP ? 0 : 1 + ((m - TP) >> 4); }
__device__ __forceinline__ int tpos_of(int m) { return m < TP ? m : ((m - TP) & 15); }
__device__ __forceinline__ float ret_l2g(int h) { return __log2f(1.0f - exp2f(-5.0f - (float)h)); }

struct EpiProj {
    static constexpr bool PERM = true, AFTER_DRAIN = false;
    bf16* Z; bf16* Q;
    __device__ __forceinline__ void operator()(const f32x4 (&acc)[2][2][4][2], const pg8::Unit& u, int wr, int wc, int fr, int fq) const {
        const int row0 = u.pm * 256 + wr * 64 + fr, pn = u.pn, cl = wc * 32 + 8 * fq;
        if (pn < 13 || pn >= 21) {
            bf16* base = pn < 13 ? Z + pn * 256 + cl : Q + (pn - 13) * 256 + cl; const size_t ld = pn < 13 ? RC : EC;
#pragma unroll
            for (int ai = 0; ai < 2; ++ai)
#pragma unroll
                for (int m = 0; m < 4; ++m) { bf16* rp = base + (size_t)(row0 + ai * 128 + m * 16) * ld;
#pragma unroll
                    for (int bj = 0; bj < 2; ++bj) { const f32x4 v0 = acc[ai][bj][m][0], v1 = acc[ai][bj][m][1]; u32x4 w; w.x = pk2(v0[0], v0[1]); w.y = pk2(v0[2], v0[3]); w.z = pk2(v1[0], v1[1]); w.w = pk2(v1[2], v1[3]);
                        *(u32x4*)(rp + bj * 128) = w; } }
        } else {
            const int sec = pn - 13; bf16* base = Q + sec * 256 + cl; const float sc = sec >= 4 ? 0.0625f : 1.0f;
            float inv[8];
#pragma unroll
            for (int e = 0; e < 8; ++e) inv[e] = exp2f(-(float)(cl + e) * (13.287712379549449f / 128.0f)) * 0.15915494309189535f;
#pragma unroll
            for (int ai = 0; ai < 2; ++ai)
#pragma unroll
                for (int m = 0; m < 4; ++m) { const int row = row0 + ai * 128 + m * 16; bf16* rp = base + (size_t)row * EC;
                    const float pos = row < TP ? (float)row : (float)(2048 + ((row - TP) & 15));
                    float o1[8], o2[8];
#pragma unroll
                    for (int e = 0; e < 8; ++e) { float rev = pos * inv[e]; rev -= floorf(rev); const float sn = __builtin_amdgcn_sinf(rev), cs = __builtin_amdgcn_cosf(rev);
                        const float x1 = acc[ai][0][m][e >> 2][e & 3], x2 = acc[ai][1][m][e >> 2][e & 3];
                        o1[e] = (x1 * cs - x2 * sn) * sc; o2[e] = (x2 * cs + x1 * sn) * sc; }
                    u32x4 w; w.x = pk2(o1[0], o1[1]); w.y = pk2(o1[2], o1[3]); w.z = pk2(o1[4], o1[5]); w.w = pk2(o1[6], o1[7]); *(u32x4*)rp = w;
                    w.x = pk2(o2[0], o2[1]); w.y = pk2(o2[2], o2[3]); w.z = pk2(o2[4], o2[5]); w.w = pk2(o2[6], o2[7]); *(u32x4*)(rp + 128) = w; }
        }
    }
};
struct EpiBf16P {
    static constexpr bool PERM = true, AFTER_DRAIN = false;
    bf16* C; int ldc;
    __device__ __forceinline__ void operator()(const f32x4 (&acc)[2][2][4][2], const pg8::Unit& u, int wr, int wc, int fr, int fq) const {
        const int row0 = u.pm * 256 + wr * 64 + fr; bf16* base = C + u.pn * 256 + wc * 32 + 8 * fq;
#pragma unroll
        for (int ai = 0; ai < 2; ++ai)
#pragma unroll
            for (int m = 0; m < 4; ++m) { bf16* rp = base + (size_t)(row0 + ai * 128 + m * 16) * ldc;
#pragma unroll
                for (int bj = 0; bj < 2; ++bj) { const f32x4 v0 = acc[ai][bj][m][0], v1 = acc[ai][bj][m][1]; u32x4 w; w.x = pk2(v0[0], v0[1]); w.y = pk2(v0[2], v0[3]); w.z = pk2(v1[0], v1[1]); w.w = pk2(v1[2], v1[3]);
                    *(u32x4*)(rp + bj * 128) = w; } }
    }
};
struct EpiF32 {
    static constexpr bool PERM = true, AFTER_DRAIN = false;
    float* C; int ldc;
    __device__ __forceinline__ void operator()(const f32x4 (&acc)[2][2][4][2], const pg8::Unit& u, int wr, int wc, int fr, int fq) const {
        const int row0 = u.pm * 256 + wr * 64 + fr; float* base = C + u.pn * 256 + wc * 32 + 8 * fq;
#pragma unroll
        for (int ai = 0; ai < 2; ++ai)
#pragma unroll
            for (int m = 0; m < 4; ++m) { float* rp = base + (size_t)(row0 + ai * 128 + m * 16) * ldc;
#pragma unroll
                for (int bj = 0; bj < 2; ++bj) { *(f32x4*)(rp + bj * 128) = acc[ai][bj][m][0]; *(f32x4*)(rp + bj * 128 + 4) = acc[ai][bj][m][1]; } }
    }
};
struct EpiSwiglu {
    static constexpr bool PERM = true, AFTER_DRAIN = false;
    bf16* C;
    __device__ __forceinline__ void operator()(const f32x4 (&acc)[2][2][4][2], const pg8::Unit& u, int wr, int wc, int fr, int fq) const {
        const int row0 = u.pm * 256 + wr * 64 + fr; bf16* base = C + u.pn * 128 + wc * 32 + 8 * fq;
#pragma unroll
        for (int ai = 0; ai < 2; ++ai)
#pragma unroll
            for (int m = 0; m < 4; ++m) { float o[8];
#pragma unroll
                for (int e = 0; e < 8; ++e) { const float g = acc[ai][0][m][e >> 2][e & 3], up = acc[ai][1][m][e >> 2][e & 3]; o[e] = g * sigm(g) * up; }
                u32x4 w; w.x = pk2(o[0], o[1]); w.y = pk2(o[2], o[3]); w.z = pk2(o[4], o[5]); w.w = pk2(o[6], o[7]);
                *(u32x4*)(base + (size_t)(row0 + ai * 128 + m * 16) * FF) = w; }
    }
};
struct EpiMod {
    static constexpr bool PERM = true, AFTER_DRAIN = false;
    float* C; int ldc;
    __device__ __forceinline__ void operator()(const f32x4 (&acc)[2][2][4][2], const pg8::Unit& u, int wr, int wc, int fr, int fq) const {
        if (wr != 0) return;
        float* base = C + u.pn * 256 + wc * 32 + 8 * fq;
#pragma unroll
        for (int m = 0; m < 2; ++m) { const int row = 16 * m + fr; if (row < NSEQ) { float* rp = base + (size_t)row * ldc;
#pragma unroll
            for (int bj = 0; bj < 2; ++bj) { *(f32x4*)(rp + bj * 128) = acc[0][bj][m][0]; *(f32x4*)(rp + bj * 128 + 4) = acc[0][bj][m][1]; } } }
    }
};

__device__ __forceinline__ void transpose_item(const float* __restrict__ W, int K, int N, bf16* WT, int k0, int n0, int dst_row0, float* scr, int lane) {
#pragma unroll 8
    for (int i = 0; i < 32; ++i) { const int kk = 2 * i + (lane >> 5); scr[kk * 33 + (lane & 31)] = W[(size_t)(k0 + kk) * N + n0 + (lane & 31)]; }
    LDS_WAIT();
    const int c = lane & 7;
#pragma unroll
    for (int j = 0; j < 4; ++j) { const int n = (lane >> 3) + 8 * j; const float* s = scr + (8 * c) * 33 + n;
        u32x4 o; o.x = pk2(s[0 * 33], s[1 * 33]); o.y = pk2(s[2 * 33], s[3 * 33]); o.z = pk2(s[4 * 33], s[5 * 33]); o.w = pk2(s[6 * 33], s[7 * 33]);
        *(u32x4*)(WT + (size_t)(dst_row0 + n) * K + k0 + 8 * c) = o; }
    LDS_WAIT();
}

typedef const __attribute__((address_space(4))) f32x2* cf2p;
__device__ __forceinline__ cf2p to_c(const float* p) { return (cf2p)(unsigned long long)p; }
#define DPPF(old, src, ctrl, rmask) __builtin_bit_cast(float, __builtin_amdgcn_update_dpp(__builtin_bit_cast(int, (float)(old)), __builtin_bit_cast(int, (float)(src)), (ctrl), (rmask), 0xF, false))
__device__ __forceinline__ float wave_sum_u(float v) {
    v += DPPF(0.f, v, 0xB1, 0xF); v += DPPF(0.f, v, 0x4E, 0xF); v += DPPF(0.f, v, 0x124, 0xF); v += DPPF(0.f, v, 0x128, 0xF);
    v += DPPF(0.f, v, 0x142, 0xA); v += DPPF(0.f, v, 0x143, 0xC);
    return __builtin_bit_cast(float, __builtin_amdgcn_readlane(__builtin_bit_cast(int, v), 63));
}
constexpr int RW_PF = 6;
template <int MODE>
__device__ __forceinline__ void rwkv_run(f32x2 (&S)[32], const float* W, const float* NKK, const float* B, const float* K, const float* R, const bf16* Vp, int nsteps, int lane,
                                         const bf16* Gp, const float* BONp, bf16* MIXp, float lnw, float lnb) {
    constexpr int NPF = MODE == 2 ? 20 : (MODE == 0 ? 16 : 12);
    const int pa = lane >> 2; const float* pfp = (pa == 0 ? W : pa == 1 ? NKK : pa == 2 ? B : pa == 3 ? K : R) + (lane & 3) * 16;
    float vn = 0.f, gn = 0.f, bn = 0.f;
    if (MODE != 1) vn = bf2f(Vp[lane]);
    if (MODE == 2) { gn = bf2f(Gp[lane]); bn = BONp[0]; }
    if (lane < NPF) {
#pragma unroll
        for (int q = 1; q < RW_PF; ++q) if (q < nsteps) (void)*(volatile const float*)(pfp + (size_t)q * RW);
    }
    for (int t = 0; t < nsteps; ++t) {
        const size_t o = (size_t)t * RW;
        cf2p w = to_c(W + o), nk = to_c(NKK + o), b = to_c(B + o), k = to_c(K + o), r = to_c(R + o);
        const float v = vn, gv = gn, bon = bn;
        { const int t1 = t + 1 < nsteps ? t + 1 : t; const size_t o1 = (size_t)t1 * RW;
          if (MODE != 1) vn = bf2f(Vp[o1 + lane]);
          if (MODE == 2) { gn = bf2f(Gp[o1 + lane]); bn = BONp[(size_t)t1 * 16]; }
          const int tp = t + RW_PF < nsteps ? t + RW_PF : nsteps - 1;
          if (lane < NPF) (void)*(volatile const float*)(pfp + (size_t)tp * RW); }
        f32x2 a0 = {0.f, 0.f}, a1 = {0.f, 0.f};
#pragma unroll
        for (int j = 0; j < 32; j += 2) { a0 = __builtin_elementwise_fma(S[j], nk[j], a0); a1 = __builtin_elementwise_fma(S[j + 1], nk[j + 1], a1); }
        const float sa = (a0.x + a0.y) + (a1.x + a1.y);
        const f32x2 sa2 = {sa, sa}, v2 = {v, v};
        f32x2 o0 = {0.f, 0.f}, o1 = {0.f, 0.f};
#pragma unroll
        for (int j = 0; j < 32; ++j) {
            f32x2 s = S[j] * w[j];
            s = __builtin_elementwise_fma(sa2, b[j], s);
            if (MODE != 1) s = __builtin_elementwise_fma(v2, k[j], s);
            S[j] = s;
            if (MODE == 2) { if (j & 1) o1 = __builtin_elementwise_fma(s, r[j], o1); else o0 = __builtin_elementwise_fma(s, r[j], o0); }
        }
        if (MODE == 2) {
            const float ov = (o0.x + o0.y) + (o1.x + o1.y);
            const float mean = wave_sum_u(ov) * (1.f / 64.f), d = ov - mean, var = wave_sum_u(d * d) * (1.f / 64.f);
            float y = d * rsqrtf(var + 64e-5f) * lnw + lnb;
            y = (y + bon * v) * gv;
            MIXp[(size_t)t * D + lane] = (bf16)f2bf(y);
        }
    }
}

constexpr int RL_B = 8;
template <int MODE> struct RL { static constexpr int NV = MODE == 2 ? 5 : (MODE == 0 ? 4 : 3); static constexpr int REC = NV * 64, BUF = RL_B * REC + (MODE != 1 ? 256 : 0) + (MODE == 2 ? 256 + 16 : 0); };
#define SBAR() __builtin_amdgcn_sched_barrier(0)
template <int MODE>
__device__ __forceinline__ void rwkv_lds(f32x2 (&S)[32], const float* W, const bf16* NKK, const bf16* B, const bf16* K, const bf16* R, const bf16* Vp, int nsteps, int lane,
                                         const bf16* Gp, const float* BONp, bf16* MIXp, float lnw, float lnb, float* wl) {
    constexpr int NV = RL<MODE>::NV, REC = RL<MODE>::REC;
    const int ls = lane >> 4, lc = (lane & 15) * 4;
    f32x4 st[2]; u32x2 sh[NV][2]; u32x4 sv = {0u, 0u, 0u, 0u}, sg = {0u, 0u, 0u, 0u}; float sb = 0.f;
#define RL_ISSUE(bt) do { const size_t ob = (size_t)((bt) * RL_B) * RW; \
        _Pragma("unroll") for (int q = 0; q < 2; ++q) { const size_t oo = ob + (size_t)(ls + 4 * q) * RW + lc; \
            st[q] = *(const f32x4*)(W + oo); sh[1][q] = *(const u32x2*)(NKK + oo); sh[2][q] = *(const u32x2*)(B + oo); if (NV >= 4) sh[NV >= 4 ? 3 : 0][q] = *(const u32x2*)(K + oo); if (NV == 5) sh[NV - 1][q] = *(const u32x2*)(R + oo); } \
        if (MODE != 1) sv = *(const u32x4*)(Vp + ob + (size_t)(lane >> 3) * RW + (lane & 7) * 8); \
        if (MODE == 2) { sg = *(const u32x4*)(Gp + ob + (size_t)(lane >> 3) * RW + (lane & 7) * 8); if (lane < RL_B) sb = BONp[(size_t)((bt) * RL_B + lane) * 16]; } } while (0)
#define RL_COMMIT() do { \
        _Pragma("unroll") for (int q = 0; q < 2; ++q) { *(f32x4*)(wl + (ls + 4 * q) * REC + lc) = st[q]; \
            _Pragma("unroll") for (int v = 1; v < NV; ++v) { const u32x2 pk_ = sh[v][q]; *(f32x4*)(wl + (ls + 4 * q) * REC + v * 64 + lc) = (f32x4){bf2f(pk_.x & 0xffffu), bf2f(pk_.x >> 16), bf2f(pk_.y & 0xffffu), bf2f(pk_.y >> 16)}; } } \
        if (MODE != 1) *(u32x4*)((bf16*)(wl + RL_B * REC) + (lane >> 3) * 64 + (lane & 7) * 8) = sv; \
        if (MODE == 2) { *(u32x4*)((bf16*)(wl + RL_B * REC + 256) + (lane >> 3) * 64 + (lane & 7) * 8) = sg; if (lane < RL_B) wl[RL_B * REC + 512 + lane] = sb; } } while (0)
    const int nb = nsteps / RL_B;
    RL_ISSUE(0); RL_COMMIT();
    for (int bt = 0; bt < nb; ++bt) {
        if (bt + 1 < nb) RL_ISSUE(bt + 1);
#pragma unroll 1
        for (int s = 0; s < RL_B; ++s) {
            const f32x2* w = (const f32x2*)(wl + s * REC); const f32x2* nk = w + 32; const f32x2* b = w + 64; const f32x2* k = w + 96; const f32x2* r = w + 128;
            float v = 0.f, gv = 0.f, bon = 0.f;
            if (MODE != 1) v = bf2f(((const bf16*)(wl + RL_B * REC))[s * 64 + lane]);
            if (MODE == 2) { gv = bf2f(((const bf16*)(wl + RL_B * REC + 256))[s * 64 + lane]); bon = wl[RL_B * REC + 512 + s]; }
            f32x2 nA[8], nB[8]; f32x2 a0 = {0.f, 0.f}, a1 = {0.f, 0.f};
#pragma unroll
            for (int p = 0; p < 8; ++p) nA[p] = nk[p];
#pragma unroll
            for (int g = 0; g < 4; ++g) {
                if (g < 3) {
#pragma unroll
                    for (int p = 0; p < 8; ++p) { if (g & 1) nA[p] = nk[8 * (g + 1) + p]; else nB[p] = nk[8 * (g + 1) + p]; } }
                SBAR();
#pragma unroll
                for (int p = 0; p < 8; p += 2) { a0 = __builtin_elementwise_fma(S[8 * g + p], (g & 1) ? nB[p] : nA[p], a0); a1 = __builtin_elementwise_fma(S[8 * g + p + 1], (g & 1) ? nB[p + 1] : nA[p + 1], a1); }
                SBAR();
            }
            const float sa = (a0.x + a0.y) + (a1.x + a1.y);
            const f32x2 sa2 = {sa, sa}, v2 = {v, v};
            f32x2 uw[2][4], ub[2][4], uk[2][4], ur[2][4]; f32x2 o0 = {0.f, 0.f}, o1 = {0.f, 0.f};
#pragma unroll
            for (int p = 0; p < 4; ++p) { uw[0][p] = w[p]; ub[0][p] = b[p]; if (MODE != 1) uk[0][p] = k[p]; if (MODE == 2) ur[0][p] = r[p]; }
#pragma unroll
            for (int g = 0; g < 8; ++g) {
                if (g < 7) {
#pragma unroll
                    for (int p = 0; p < 4; ++p) { uw[(g + 1) & 1][p] = w[4 * (g + 1) + p]; ub[(g + 1) & 1][p] = b[4 * (g + 1) + p]; if (MODE != 1) uk[(g + 1) & 1][p] = k[4 * (g + 1) + p]; if (MODE == 2) ur[(g + 1) & 1][p] = r[4 * (g + 1) + p]; } }
                SBAR();
#pragma unroll
                for (int p = 0; p < 4; ++p) { const int j = 4 * g + p;
                    f32x2 x = S[j] * uw[g & 1][p]; x = __builtin_elementwise_fma(sa2, ub[g & 1][p], x); if (MODE != 1) x = __builtin_elementwise_fma(v2, uk[g & 1][p], x); S[j] = x;
                    if (MODE == 2) { if (p & 1) o1 = __builtin_elementwise_fma(x, ur[g & 1][p], o1); else o0 = __builtin_elementwise_fma(x, ur[g & 1][p], o0); } }
                SBAR();
            }
            if (MODE == 2) {
                const float ov = (o0.x + o0.y) + (o1.x + o1.y);
                const float mean = wave_sum_u(ov) * (1.f / 64.f), d = ov - mean, var = wave_sum_u(d * d) * (1.f / 64.f);
                float y = d * rsqrtf(var + 64e-5f) * lnw + lnb;
                y = (y + bon * v) * gv;
                MIXp[(size_t)(bt * RL_B + s) * D + lane] = (bf16)f2bf(y);
            }
        }
        if (bt + 1 < nb) RL_COMMIT();
    }
#undef RL_ISSUE
#undef RL_COMMIT
}
#define LAS __attribute__((address_space(3)))

#define XB_TMO      128
#define XB_XCNT(j)  (256  + 64 * (j))
#define XB_XSUB(j)  (1280 + 64 * (j))
#define XB_XGEN(j)  (2304 + 64 * (j))
#define XB_TOP      3328
#define XB_TOPGEN   3392
#define XCD_BAR_WORDS 3456
#define XB_SPIN_CAP (1u << 18)

__device__ __forceinline__ unsigned xb_ld(unsigned* p)              { return __hip_atomic_load(p, __ATOMIC_RELAXED, __HIP_MEMORY_SCOPE_AGENT); }
__device__ __forceinline__ unsigned xb_add(unsigned* p, unsigned v) { return __hip_atomic_fetch_add(p, v, __ATOMIC_RELAXED, __HIP_MEMORY_SCOPE_AGENT); }
__device__ __forceinline__ unsigned xb_xcc_id() { return (unsigned)__builtin_amdgcn_s_getreg((3 << 11) | 20) & 0xFu; }
#define XB_SPIN(cond, bar) do { unsigned _sp = 0; while (cond) { __builtin_amdgcn_s_sleep(1); \
    if ((++_sp & 255u) == 0u) { if (xb_ld(&(bar)[XB_TMO])) break; if (_sp > XB_SPIN_CAP) { atomicAdd(&(bar)[XB_TMO], 1u); break; } } } } while (0)

struct XcdBarrier {
    unsigned* bar; unsigned x;
    volatile LAS unsigned* st;
};

__device__ __forceinline__ XcdBarrier xcd_barrier_post(unsigned* bar, volatile LAS unsigned* st) {
    XcdBarrier b; b.bar = bar; b.x = xb_xcc_id(); b.st = st;
    if (threadIdx.x == 0) (void)xb_add(&bar[XB_XCNT(b.x)], 1u);
    return b;
}
__device__ __forceinline__ void xcd_barrier_complete(unsigned* bar, unsigned x, unsigned& nloc, unsigned& nx) {
    const unsigned G = gridDim.x * gridDim.y * gridDim.z;
    unsigned sum, cnt, mine, sp = 0u;
    for (;;) {
        sum = 0u; cnt = 0u; mine = 0u;
#pragma unroll
        for (unsigned j = 0; j < 16; ++j) { const unsigned c = xb_ld(&bar[XB_XCNT(j)]); sum += c; cnt += (c > 0u) ? 1u : 0u; mine = (j == x) ? c : mine; }
        if (sum == G) break;
        __builtin_amdgcn_s_sleep(1);
        if ((++sp & 255u) == 0u) { if (xb_ld(&bar[XB_TMO])) break; if (sp > XB_SPIN_CAP) { atomicAdd(&bar[XB_TMO], 1u); break; } }
    }
    nloc = mine > 0u ? mine : 1u; nx = cnt > 0u ? cnt : 1u;
}

__device__ __forceinline__ void xcd_barrier(const XcdBarrier& b) {
    asm volatile("s_waitcnt vmcnt(0)" ::: "memory");
    __syncthreads();
    if (threadIdx.x == 0) {
        unsigned* bar = b.bar;
        __builtin_amdgcn_s_waitcnt(0);
        unsigned nloc = b.st[0], nx = b.st[1];
        if (nloc == 0u) { xcd_barrier_complete(bar, b.x, nloc, nx); b.st[0] = nloc; b.st[1] = nx; }
        const unsigned old = xb_add(&bar[XB_XSUB(b.x)], 1u);
        const unsigned gen = old / nloc;
        if (old + 1u == (gen + 1u) * nloc) {
            __builtin_amdgcn_fence(__ATOMIC_RELEASE, "agent");
            asm volatile("s_waitcnt vmcnt(0)" ::: "memory");
            const unsigned og = xb_add(&bar[XB_TOP], 1u);
            const unsigned tg = og / nx;
            if (og + 1u == (tg + 1u) * nx) xb_add(&bar[XB_TOPGEN], 1u);
            else XB_SPIN(xb_ld(&bar[XB_TOPGEN]) == tg, bar);
            __builtin_amdgcn_fence(__ATOMIC_ACQUIRE, "agent");
            xb_add(&bar[XB_XGEN(b.x)], 1u);
            asm volatile("s_waitcnt vmcnt(0)" ::: "memory");
        } else {
            XB_SPIN(xb_ld(&bar[XB_XGEN(b.x)]) == gen, bar);
            __builtin_amdgcn_fence(__ATOMIC_ACQUIRE, "agent");
            asm volatile("s_waitcnt vmcnt(0)" ::: "memory");
        }
    }
    __syncthreads();
}


struct Args { const float* in[30]; float* out; unsigned char* ws; int ph_lo, ph_hi; };
enum { I_XP = 0, I_XS, I_CP, I_CS, I_SSH, I_SWKV, I_SRET, I_ADAW, I_ADAB, I_GPM, I_GPOM, I_GPF, I_GPOF, I_WIN, I_MU, I_W0, I_W2, I_A0, I_A2, I_G2, I_KK, I_KA, I_RK, I_RLW, I_RLB, I_ELW, I_ELB, I_WOUT, I_WUP, I_WDN };

__global__ void __launch_bounds__(512, 2) mk_fwd(Args a) {
    extern __shared__ __attribute__((aligned(16))) unsigned char lds[];
    cg::grid_group grid = cg::this_grid();
    const int tid = threadIdx.x, lane = tid & 63, wave = __builtin_amdgcn_readfirstlane(tid >> 6);
    const int G = gridDim.x, bid = blockIdx.x, gw = bid * 8 + wave, NGW = G * 8;
    const int lo = a.ph_lo, hi = a.ph_hi;
    volatile LAS unsigned* xst = (volatile LAS unsigned*)((LAS unsigned char*)lds + LDS_BYTES - 16);
    if (tid < 2) xst[tid] = 0u;
    __syncthreads();
    XcdBarrier xb = xcd_barrier_post((unsigned*)(a.ws + 65536), xst);
    unsigned char* ws = a.ws; float* out = a.out; unsigned char* dob = (unsigned char*)a.out;
    float* MOD = (float*)(ws + WS_MOD);
    bf16* LORAT = (bf16*)(ws + WS_LORAT); bf16* WOUTT = (bf16*)(ws + WS_WOUTT); bf16* WINT = (bf16*)(ws + WS_WINT); bf16* WUPT = (bf16*)(ws + WS_WUPT); bf16* WDNT = (bf16*)(ws + WS_WDNT);
    bf16* H = (bf16*)(ws + WS_H); bf16* QKVG = (bf16*)(ws + WS_QKVG); bf16* LOUT = (bf16*)(ws + WS_LOUT); bf16* Z = (bf16*)(dob + DO_Z); bf16* LIN = (bf16*)(dob + DO_LIN);
    float* PW = (float*)(ws + WS_PREP); bf16* PNKK = (bf16*)(ws + WS_PREP + PREP_STRIDE); bf16* PB = (bf16*)(ws + WS_PREP + 2 * PREP_STRIDE); bf16* PK = (bf16*)(ws + WS_PREP + 3 * PREP_STRIDE); bf16* PR = (bf16*)(ws + WS_PREP + 4 * PREP_STRIDE);
    bf16* PV = (bf16*)(ws + WS_V); bf16* PG = (bf16*)(ws + WS_G); float* BON = (float*)(ws + WS_BON);
    float* PU = (float*)(ws + WS_PU); bf16* KVB = (bf16*)(ws + WS_KVB); bf16* SPREV = (bf16*)(dob + DO_SPREV); bf16* MIX = (bf16*)(dob + DO_MIX);
    float* MIXOUT = (float*)(ws + WS_MIXOUT); bf16* ACT = (bf16*)(ws + WS_ACT);
#ifndef DUP_PHASE
#define DUP_PHASE -1
#endif
#ifndef PH_MASK
#define PH_MASK 0x3fff
#endif
#define IN(k) (((PH_MASK >> (k)) & 1) && lo <= (k) && (k) < hi)
#ifndef TS_PROBE
#define TS_PROBE -1
#endif
    unsigned long long* TSW = (unsigned long long*)ws;
    if (TS_PROBE >= 0 && bid == 0 && tid == 0) TSW[0] = __builtin_amdgcn_s_memrealtime();
#define MID(n) do { if (TS_PROBE >= 0 && bid == 0) { __syncthreads(); if (tid == 0) TSW[32 + (n)] = __builtin_amdgcn_s_memrealtime(); } } while (0)
#define SEAM(k) do { if (IN(k) && IN((k) + 1)) { if ((k) == 0) grid.sync(); else xcd_barrier(xb); } if (TS_PROBE >= 0 && bid == 0 && tid == 0) TSW[1 + (k)] = __builtin_amdgcn_s_memrealtime(); } while (0)

    if (IN(0)) for (int rep = 0; rep < (DUP_PHASE == 0 ? 2 : 1); ++rep) {
        MID(0);
        float* scr = (float*)lds + wave * (64 * 33 + 16);
        constexpr int IT_WIN = (D / 64) * (IC / 32), IT_WOUT = (D / 64) * (D / 32), IT_ADA = (D / 64) * (MODW / 32);
        bf16* ADAT = (bf16*)(ws + WS_ADAT); bf16* SC = (bf16*)(ws + WS_SC);
        for (int it = gw; it < IT_WIN + IT_WOUT + IT_ADA; it += NGW) {
            if (it < IT_WIN) { const int nb = IC / 32, kb = it / nb, n0 = 32 * (it % nb); transpose_item(a.in[I_WIN], D, IC, WINT, 64 * kb, n0, n0, scr, lane); }
            else if (it < IT_WIN + IT_WOUT) { const int r = it - IT_WIN, nb = D / 32, kb = r / nb, n0 = 32 * (r % nb); transpose_item(a.in[I_WOUT], D, D, WOUTT, 64 * kb, n0, n0, scr, lane); }
            else { const int r = it - IT_WIN - IT_WOUT, nb = MODW / 32, kb = r / nb, n0 = 32 * (r % nb); transpose_item(a.in[I_ADAW], D, MODW, ADAT, 64 * kb, n0, n0, scr, lane); }
        }
        MID(1);
        for (int idx = bid * 512 + tid; idx < 3072 * 256; idx += G * 512) {
            const int n = idx >> 8, k = idx & 255, sec = n >> 10, nn = n & 1023; float v = 0.f;
            if (sec == 0 && k < 64) v = a.in[I_W2][k * RW + nn];
            else if (sec == 1 && k >= 64 && k < 128) v = a.in[I_A2][(k - 64) * RW + nn];
            else if (sec == 2 && k >= 128) v = a.in[I_G2][(k - 128) * RW + nn];
            LORAT[idx] = (bf16)f2bf(v);
        }
        for (int idx = bid * 512 + tid; idx < 256 * D; idx += G * 512) { const int r = idx / D, k = idx % D; float v = 0.f;
            if (r < NSEQ) { const float cv = r == 0 ? a.in[I_CP][k] : a.in[I_CS][(r - 1) * D + k]; v = cv * sigm(cv); }
            SC[idx] = (bf16)f2bf(v); }
        MID(2);
    }
    if (IN(0)) MID(3);
    SEAM(0);
    if (IN(1)) {
        { const int sl = bid / 48; pg8::Gemm g{(const bf16*)(ws + WS_SC) + sl * 512, (const bf16*)(ws + WS_ADAT) + sl * 512, 256, MODW, 512, D}; pg8::OneUnit S{0, bid % 48, bid < 192};
          EpiMod E{(float*)(ws + WS_MODP) + (size_t)sl * NSEQ * MODW, MODW};
          pg8::gemm_phase<EpiMod, pg8::OneUnit, false, true>((PG8_LAS unsigned char*)lds, g, S, E); }
        xcd_barrier(xb);
        const float* MODP = (const float*)(ws + WS_MODP);
        for (int idx = bid * 512 + tid; idx < NSEQ * MODW; idx += G * 512) { float v = a.in[I_ADAB][idx % MODW];
#pragma unroll
            for (int q = 0; q < 4; ++q) v += MODP[(size_t)q * NSEQ * MODW + idx];
            MOD[idx] = v; }
        xcd_barrier(xb);
    }
    if (IN(1)) for (int rep = 0; rep < (DUP_PHASE == 1 ? 2 : 1); ++rep) {
        for (int m = gw; m < M; m += NGW) {
            const float* xr = m < TP ? a.in[I_XP] + (size_t)m * D : a.in[I_XS] + (size_t)(m - TP) * D; const float* mod = MOD + seq_of(m) * MODW;
            f32x4 v[8]; float ss = 0.f;
#pragma unroll
            for (int j = 0; j < 8; ++j) { v[j] = *(const f32x4*)(xr + 4 * lane + 256 * j); ss += (v[j].x * v[j].x + v[j].y * v[j].y) + (v[j].z * v[j].z + v[j].w * v[j].w); }
            const float rs = rsqrtf(wave_sum(ss) * (1.f / D) + 1e-6f);
#pragma unroll
            for (int j = 0; j < 8; ++j) { const int c = 4 * lane + 256 * j; const f32x4 g = *(const f32x4*)(a.in[I_GPM] + c), s1 = *(const f32x4*)(mod + D + c), h1 = *(const f32x4*)(mod + c);
                const f32x4 h = v[j] * rs * g * (s1 + 1.f) + h1; u32x2 w; w.x = pk2(h.x, h.y); w.y = pk2(h.z, h.w); *(u32x2*)(H + (size_t)m * D + c) = w; }
        }
    }
    SEAM(1);
    if (IN(2)) for (int rep = 0; rep < (DUP_PHASE == 2 ? 2 : 1); ++rep) {
        pg8::Gemm g{H, WINT, M, IC, D, D}; pg8::StaticOrder S; S.init(M, IC, G, bid); EpiProj E{Z, QKVG};
        pg8::gemm_phase<EpiProj, pg8::StaticOrder, true, true>((PG8_LAS unsigned char*)lds, g, S, E);
    }
    SEAM(2);
    if (IN(3)) for (int rep = 0; rep < (DUP_PHASE == 3 ? 2 : 1); ++rep) {
        for (int idx = bid * 512 + tid; idx < M * 128; idx += G * 512) {
            const int m = idx >> 7, c2 = (idx & 127) * 2, c = 3072 + c2, tp = tpos_of(m), sq = seq_of(m);
            const unsigned zz = *(const unsigned*)(Z + (size_t)m * RC + c); float z0 = bf2f(zz & 0xffffu), z1 = bf2f(zz >> 16), p0 = 0.f, p1 = 0.f;
            if (tp > 0) { const unsigned pp = *(const unsigned*)(Z + (size_t)(m - 1) * RC + c); p0 = bf2f(pp & 0xffffu); p1 = bf2f(pp >> 16); }
            else if (sq > 0) { p0 = a.in[I_SSH][(size_t)(sq - 1) * RC + c]; p1 = a.in[I_SSH][(size_t)(sq - 1) * RC + c + 1]; }
            z0 = z0 + (p0 - z0) * a.in[I_MU][c]; z1 = z1 + (p1 - z1) * a.in[I_MU][c + 1];
            if (c2 < 64) { z0 = 1.f - 2.f / (__expf(2.f * z0) + 1.f); z1 = 1.f - 2.f / (__expf(2.f * z1) + 1.f); }
            else if (c2 >= 128) { z0 = sigm(z0); z1 = sigm(z1); }
            *(unsigned*)(LIN + (size_t)m * 256 + c2) = pk2(z0, z1);
        }
        for (int idx = bid * 512 + tid; idx < NSEQ * RC; idx += G * 512) { const int s = idx / RC, c = idx % RC; const int m = s == 0 ? TP - 1 : TP + 16 * (s - 1) + 15;
            out[(s == 0 ? O_SHP : O_SHS + (size_t)(s - 1) * RC) + c] = bf2f(Z[(size_t)m * RC + c]); }
    }
    SEAM(3);
    if (IN(4)) for (int rep = 0; rep < (DUP_PHASE == 4 ? 2 : 1); ++rep) {
        int k256 = 256; asm volatile("" : "+s"(k256));
        pg8::Gemm g{LIN, LORAT, M, 3072, k256, k256}; pg8::StaticOrder S; S.init(M, 3072, G, bid); EpiBf16P E{LOUT, 3072};
        pg8::gemm_phase<EpiBf16P, pg8::StaticOrder, true, true>((PG8_LAS unsigned char*)lds, g, S, E);
    }
    SEAM(4);
    if (IN(5)) for (int rep = 0; rep < (DUP_PHASE == 5 ? 2 : 1); ++rep) {
        float* prm = (float*)lds;
        __syncthreads();
        for (int idx = tid; idx < RW; idx += 512) { prm[idx] = a.in[I_MU][idx]; prm[RW + idx] = a.in[I_MU][RW + idx]; prm[2 * RW + idx] = a.in[I_MU][2 * RW + idx]; prm[3 * RW + idx] = a.in[I_W0][idx];
            prm[4 * RW + idx] = a.in[I_A0][idx]; prm[5 * RW + idx] = a.in[I_KK][idx]; prm[6 * RW + idx] = a.in[I_KA][idx]; prm[7 * RW + idx] = a.in[I_RK][idx]; }
        __syncthreads();
        for (int m = gw; m < M; m += NGW) {
            const int tp = tpos_of(m), sq = seq_of(m);
#pragma unroll 1
            for (int hp = 0; hp < 2; ++hp) {
                const int hd = hp * 8 + (lane >> 3), c0 = hd * 64 + (lane & 7) * 8;
                const bf16* zr = Z + (size_t)m * RC + c0; const bf16* lr = LOUT + (size_t)m * 3072 + c0; const float* sh0 = a.in[I_SSH] + (size_t)(sq > 0 ? sq - 1 : 0) * RC + c0;
                float zs[3][8];
#pragma unroll
                for (int q = 0; q < 3; ++q) {
                    const u32x4 ca = *(const u32x4*)(zr + q * RW); float pv[8];
                    if (tp > 0) { const u32x4 pa2 = *(const u32x4*)(zr - RC + q * RW);
#pragma unroll
                        for (int e = 0; e < 4; ++e) { pv[2 * e] = bf2f(pa2[e] & 0xffffu); pv[2 * e + 1] = bf2f(pa2[e] >> 16); } }
                    else if (sq > 0) { const f32x4 f0 = *(const f32x4*)(sh0 + q * RW), f1 = *(const f32x4*)(sh0 + q * RW + 4);
                        pv[0] = f0.x; pv[1] = f0.y; pv[2] = f0.z; pv[3] = f0.w; pv[4] = f1.x; pv[5] = f1.y; pv[6] = f1.z; pv[7] = f1.w; }
                    else {
#pragma unroll
                        for (int e = 0; e < 8; ++e) pv[e] = 0.f; }
                    const float* mu = prm + q * RW + c0;
#pragma unroll
                    for (int e = 0; e < 4; ++e) { const float z0 = bf2f(ca[e] & 0xffffu), z1 = bf2f(ca[e] >> 16);
                        zs[q][2 * e] = z0 + (pv[2 * e] - z0) * mu[2 * e]; zs[q][2 * e + 1] = z1 + (pv[2 * e + 1] - z1) * mu[2 * e + 1]; }
                }
                const u32x4 wa = *(const u32x4*)(lr), aa = *(const u32x4*)(lr + RW), ga = *(const u32x4*)(lr + 2 * RW);
                float wv[8], av[8], kkv[8], k2[8]; float s1 = 0.f, s2 = 0.f;
#pragma unroll
                for (int e = 0; e < 8; ++e) {
                    const float lwv = bf2f((e & 1) ? (wa[e >> 1] >> 16) : (wa[e >> 1] & 0xffffu)), lav = bf2f((e & 1) ? (aa[e >> 1] >> 16) : (aa[e >> 1] & 0xffffu));
                    wv[e] = __expf(-0.6065306597126334f * sigm(prm[3 * RW + c0 + e] + lwv));
                    av[e] = sigm(prm[4 * RW + c0 + e] + lav);
                    kkv[e] = zs[1][e] * prm[5 * RW + c0 + e]; s1 += kkv[e] * kkv[e];
                    k2[e] = zs[1][e] * (1.f + (av[e] - 1.f) * prm[6 * RW + c0 + e]); s2 += zs[0][e] * k2[e] * prm[7 * RW + c0 + e];
                }
                s1 += DPPF(0.f, s1, 0xB1, 0xF); s1 += DPPF(0.f, s1, 0x4E, 0xF); s1 += DPPF(0.f, s1, 0x141, 0xF);
                s2 += DPPF(0.f, s2, 0xB1, 0xF); s2 += DPPF(0.f, s2, 0x4E, 0xF); s2 += DPPF(0.f, s2, 0x141, 0xF);
                const float inrm = 1.f / fmaxf(sqrtf(s1), 1e-12f);
                const size_t o = (size_t)m * RW + c0;
#pragma unroll
                for (int e = 0; e < 2; ++e) {
                    const float k0 = kkv[4 * e] * inrm, k1 = kkv[4 * e + 1] * inrm, k2_ = kkv[4 * e + 2] * inrm, k3 = kkv[4 * e + 3] * inrm;
                    *(f32x4*)(PW + o + 4 * e) = (f32x4){wv[4 * e], wv[4 * e + 1], wv[4 * e + 2], wv[4 * e + 3]};
                    { u32x2 t2; t2.x = pk2(-k0, -k1); t2.y = pk2(-k2_, -k3); *(u32x2*)(PNKK + o + 4 * e) = t2;
                      t2.x = pk2(k0 * av[4 * e], k1 * av[4 * e + 1]); t2.y = pk2(k2_ * av[4 * e + 2], k3 * av[4 * e + 3]); *(u32x2*)(PB + o + 4 * e) = t2;
                      t2.x = pk2(k2[4 * e], k2[4 * e + 1]); t2.y = pk2(k2[4 * e + 2], k2[4 * e + 3]); *(u32x2*)(PK + o + 4 * e) = t2;
                      t2.x = pk2(zs[0][4 * e], zs[0][4 * e + 1]); t2.y = pk2(zs[0][4 * e + 2], zs[0][4 * e + 3]); *(u32x2*)(PR + o + 4 * e) = t2; }
                }
                { u32x4 va;
#pragma unroll
                  for (int e = 0; e < 4; ++e) va[e] = pk2(zs[2][2 * e], zs[2][2 * e + 1]);
                  *(u32x4*)(PV + o) = va; *(u32x4*)(PG + o) = ga; }
                if ((lane & 7) == 0) BON[m * 16 + hd] = s2;
            }
        }
    }
    SEAM(5);
    if (IN(6)) for (int rep = 0; rep < (DUP_PHASE == 6 ? 2 : 1); ++rep) {
        MID(4);
        {
            float* wl = (float*)lds + wave * RL<0>::BUF;
            for (int task = gw; task < RH * NCH * 2; task += NGW) {
                const int part = task & 1, pair = task >> 1, h = pair / NCH, c = pair % NCH; const size_t o = (size_t)(c * LCH) * RW + h * 64;
                f32x2 S[32];
                if (part) {
#pragma unroll
                    for (int j = 0; j < 32; ++j) { S[j].x = (2 * j == lane) ? 1.f : 0.f; S[j].y = (2 * j + 1 == lane) ? 1.f : 0.f; }
                    rwkv_lds<1>(S, PW + o, PNKK + o, PB + o, PK + o, PR + o, PV + o, LCH, lane, nullptr, nullptr, nullptr, 0.f, 0.f, wl);
                } else {
#pragma unroll
                    for (int j = 0; j < 32; ++j) S[j] = (f32x2){0.f, 0.f};
                    rwkv_lds<0>(S, PW + o, PNKK + o, PB + o, PK + o, PR + o, PV + o, LCH, lane, nullptr, nullptr, nullptr, 0.f, 0.f, wl);
                }
                float* dst = PU + ((size_t)pair * 2 + (part ? 0 : 1)) * 4096 + lane * 64;
#pragma unroll
                for (int j = 0; j < 16; ++j) *(f32x4*)(dst + 4 * j) = (f32x4){S[2 * j].x, S[2 * j].y, S[2 * j + 1].x, S[2 * j + 1].y};
            }
        }
        __syncthreads();
        MID(5);
        bf16* kT = (bf16*)lds;
        bf16* vT = (bf16*)lds + 256 * 72;
        const int fr = lane & 15, fq = lane >> 4;
        for (int it = bid; it < EH * NRB * 2; it += G) {
            const int half = it & 1, blk = (it >> 1) % NRB, h = (it >> 1) / NRB; const float l2g = ret_l2g(h); const int m0 = blk * RBLK;
            f32x4 acc[2][8];
#pragma unroll
            for (int x = 0; x < 2; ++x)
#pragma unroll
                for (int y = 0; y < 8; ++y) acc[x][y] = (f32x4){0.f, 0.f, 0.f, 0.f};
            for (int ts = 0; ts < 4; ++ts) {
                __syncthreads();
#pragma unroll
                for (int i = 0; i < 4; ++i) { const int t = lane, dp = wave + 8 * i; const u32x4 raw = *(const u32x4*)(QKVG + (size_t)(m0 + ts * 64 + t) * EC + 1024 + h * 256 + dp * 8);
                    const float dec = exp2f(l2g * (float)(255 - (ts * 64 + t)));
#pragma unroll
                    for (int e = 0; e < 4; ++e) { const unsigned w = raw[e]; kT[(dp * 8 + 2 * e) * 72 + t] = (bf16)f2bf(bf2f(w & 0xffffu) * dec); kT[(dp * 8 + 2 * e + 1) * 72 + t] = (bf16)f2bf(bf2f(w >> 16) * dec); } }
#pragma unroll
                for (int i = 0; i < 2; ++i) { const int t = lane, ep = wave + 8 * i; const u32x4 raw = *(const u32x4*)(QKVG + (size_t)(m0 + ts * 64 + t) * EC + 2048 + h * 256 + half * 128 + ep * 8);
#pragma unroll
                    for (int e = 0; e < 4; ++e) { const unsigned w = raw[e]; vT[(ep * 8 + 2 * e) * 72 + t] = (bf16)(w & 0xffffu); vT[(ep * 8 + 2 * e + 1) * 72 + t] = (bf16)(w >> 16); } }
                __syncthreads();
#pragma unroll
                for (int kk = 0; kk < 2; ++kk) { bf16x8 af[2];
#pragma unroll
                    for (int x = 0; x < 2; ++x) af[x] = *(const bf16x8*)(kT + (32 * wave + 16 * x + fr) * 72 + kk * 32 + fq * 8);
#pragma unroll
                    for (int y = 0; y < 8; ++y) { const bf16x8 bfm = *(const bf16x8*)(vT + (16 * y + fr) * 72 + kk * 32 + fq * 8);
#pragma unroll
                        for (int x = 0; x < 2; ++x) acc[x][y] = __builtin_amdgcn_mfma_f32_16x16x32_bf16(af[x], bfm, acc[x][y], 0, 0, 0); } }
            }
            bf16* dst = KVB + ((size_t)(h * NRB + blk) * 256) * 256;
#pragma unroll
            for (int x = 0; x < 2; ++x)
#pragma unroll
                for (int y = 0; y < 8; ++y) { u32x2 w; w.x = pk2(acc[x][y][0], acc[x][y][1]); w.y = pk2(acc[x][y][2], acc[x][y][3]);
                    *(u32x2*)(dst + (size_t)(half * 128 + 16 * y + fr) * 256 + 32 * wave + 16 * x + fq * 4) = w; }
        }
    }
    if (IN(6)) MID(6);
    SEAM(6);
    if (IN(7)) for (int rep = 0; rep < (DUP_PHASE == 7 ? 2 : 1); ++rep) {
        const int nB = RH * 4;
        if (bid < nB || G <= nB) {
            float* Sb = (float*)lds;
            const int fr = lane & 15, fq = lane >> 4;
            for (int it = bid; it < nB; it += G) {
                const int h = it >> 2, g4 = it & 3; float* pu = PU + (size_t)(h * NCH) * 2 * 4096;
                __syncthreads();
                for (int idx = tid; idx < 16 * 65; idx += 512) Sb[idx] = 0.f;
                __syncthreads();
                if (wave < 4) {
                    float pa[16], pb[16]; f32x4 ua, ub;
#define PB_LOAD(dst, du, c) do { const float* pp = pu + (size_t)(c) * 2 * 4096; _Pragma("unroll") for (int kk = 0; kk < 16; ++kk) dst[kk] = pp[(4 * kk + fq) * 64 + 16 * wave + fr]; \
                        _Pragma("unroll") for (int jj = 0; jj < 4; ++jj) du[jj] = pp[4096 + (16 * g4 + 4 * fq + jj) * 64 + 16 * wave + fr]; } while (0)
                    PB_LOAD(pa, ua, 0); PB_LOAD(pb, ub, 1);
                    for (int c = 0; c < NCH; ++c) {
                        const float* Sc = Sb + (c & 1) * (16 * 65); float* Sn = Sb + ((c + 1) & 1) * (16 * 65);
                        f32x4 acc = ua, ac1 = {0.f, 0.f, 0.f, 0.f}, ac2 = ac1, ac3 = ac1;
#pragma unroll
                        for (int kk = 0; kk < 16; kk += 4) { acc = __builtin_amdgcn_mfma_f32_16x16x4f32(Sc[fr * 65 + 4 * kk + fq], pa[kk], acc, 0, 0, 0);
                            ac1 = __builtin_amdgcn_mfma_f32_16x16x4f32(Sc[fr * 65 + 4 * (kk + 1) + fq], pa[kk + 1], ac1, 0, 0, 0);
                            ac2 = __builtin_amdgcn_mfma_f32_16x16x4f32(Sc[fr * 65 + 4 * (kk + 2) + fq], pa[kk + 2], ac2, 0, 0, 0);
                            ac3 = __builtin_amdgcn_mfma_f32_16x16x4f32(Sc[fr * 65 + 4 * (kk + 3) + fq], pa[kk + 3], ac3, 0, 0, 0); }
                        acc = (acc + ac1) + (ac2 + ac3);
#pragma unroll
                        for (int jj = 0; jj < 4; ++jj) { Sn[(4 * fq + jj) * 65 + 16 * wave + fr] = acc[jj]; pu[(size_t)c * 2 * 4096 + 4096 + (16 * g4 + 4 * fq + jj) * 64 + 16 * wave + fr] = acc[jj]; }
                        if (c + 1 == NCH) {
#pragma unroll
                            for (int jj = 0; jj < 4; ++jj) out[O_WKP + (size_t)h * 4096 + (16 * g4 + 4 * fq + jj) * 64 + 16 * wave + fr] = acc[jj]; }
#pragma unroll
                        for (int kk = 0; kk < 16; ++kk) pa[kk] = pb[kk];
                        ua = ub;
                        if (c + 2 < NCH) PB_LOAD(pb, ub, c + 2);
                        asm volatile("s_waitcnt lgkmcnt(0)" ::: "memory");
                        __builtin_amdgcn_s_barrier();
                    }
#undef PB_LOAD
                } else {
                    for (int c = 0; c < NCH; ++c) __builtin_amdgcn_s_barrier();
                }
            }
        }
        if (bid >= nB || G <= nB) {
            const int nb2 = G <= nB ? G : G - nB, b2 = G <= nB ? bid : bid - nB;
            for (int it = b2 * 512 + tid; it < EH * 256 * 32; it += nb2 * 512) {
                const int h = it >> 13, e = (it >> 5) & 255, d0 = (it & 31) * 8; const float g256 = exp2f(256.f * ret_l2g(h));
                float acc[8];
#pragma unroll
                for (int q = 0; q < 8; ++q) acc[q] = 0.f;
                u32x4 kvr[NRB];
#pragma unroll
                for (int blk = 0; blk < NRB; ++blk) kvr[blk] = *(const u32x4*)(KVB + ((size_t)(h * NRB + blk) * 256 + e) * 256 + d0);
#pragma unroll
                for (int blk = 0; blk < NRB; ++blk) {
                    const size_t o = ((size_t)(h * NRB + blk) * 256 + e) * 256 + d0;
                    u32x4 w; w.x = pk2(acc[0], acc[1]); w.y = pk2(acc[2], acc[3]); w.z = pk2(acc[4], acc[5]); w.w = pk2(acc[6], acc[7]); *(u32x4*)(SPREV + o) = w;
                    const u32x4 kv = kvr[blk];
#pragma unroll
                    for (int q = 0; q < 4; ++q) { acc[2 * q] = acc[2 * q] * g256 + bf2f(kv[q] & 0xffffu); acc[2 * q + 1] = acc[2 * q + 1] * g256 + bf2f(kv[q] >> 16); }
                }
#pragma unroll
                for (int q = 0; q < 8; ++q) out[O_RTP + (size_t)h * 65536 + (size_t)(d0 + q) * 256 + e] = acc[q];
            }
            asm volatile("s_waitcnt vmcnt(0)" ::: "memory");
            __syncthreads();
            if (tid == 0) {
                unsigned* cw = (unsigned*)(a.ws + 65536) + XCD_BAR_WORDS + 64;
                __builtin_amdgcn_fence(__ATOMIC_RELEASE, "agent");
                asm volatile("s_waitcnt vmcnt(0)" ::: "memory");
                (void)xb_add(cw, 1u);
            }
        }
        {
            const int nscan = G <= nB ? G : G - nB;
            unsigned* cw = (unsigned*)(a.ws + 65536) + XCD_BAR_WORDS + 64; unsigned* cq = cw + 32;
            if (tid == 0) {
                unsigned sp = 0u; while (xb_ld(cw) < (unsigned)nscan) { __builtin_amdgcn_s_sleep(1); if (++sp > (1u << 22)) break; }
                __builtin_amdgcn_fence(__ATOMIC_ACQUIRE, "agent");
                asm volatile("s_waitcnt vmcnt(0)" ::: "memory");
            }
            __syncthreads();
            {
                const int fr = lane & 15, fq = lane >> 4;
                for (;;) {
                    __syncthreads();
                    if (tid == 0) xst[2] = xb_add(cq, 1u);
                    __syncthreads();
                    const int qi = (int)xst[2];
                    if (qi >= EH * (TP / 64)) break;
                    const int it = ((qi & 127) >> 5) * (TP / 64) + (qi & 31) * 4 + (3 - (qi >> 7));
                    {
                    const int h = it / (TP / 64), n = it % (TP / 64), blk = n >> 2, i = n & 3, m0 = n * 64; const float l2g = ret_l2g(h);
                    bf16* qL = (bf16*)lds; bf16* kL = qL + 64 * 264; bf16* vT = kL + 64 * 264; bf16* pL = vT + 256 * 72; float* red = (float*)(pL + 64 * 72);
#pragma unroll
                    for (int x = 0; x < 4; ++x) { const int p = tid + 512 * x, t = p >> 5, dp = p & 31; *(u32x4*)(qL + t * 264 + dp * 8) = *(const u32x4*)(QKVG + (size_t)(m0 + t) * EC + h * 256 + dp * 8); }
                    u32x4 kr[4], vr[4];
#define R3_LOADKV(jn) do { const int ms_ = (blk * 4 + (jn)) * 64; \
        _Pragma("unroll") for (int x = 0; x < 4; ++x) { const int p = tid + 512 * x; kr[x] = *(const u32x4*)(QKVG + (size_t)(ms_ + (p >> 5)) * EC + 1024 + h * 256 + (p & 31) * 8); \
            vr[x] = *(const u32x4*)(QKVG + (size_t)(ms_ + lane) * EC + 2048 + h * 256 + (wave + 8 * x) * 8); } } while (0)
                    R3_LOADKV(0);
                    __syncthreads();
                    f32x4 acc[4][2];
#pragma unroll
                    for (int x = 0; x < 4; ++x)
#pragma unroll
                        for (int y = 0; y < 2; ++y) acc[x][y] = (f32x4){0.f, 0.f, 0.f, 0.f};
                    if (blk > 0) {
                        const bf16* sp = SPREV + ((size_t)(h * NRB + blk) * 256) * 256;
#pragma unroll 2
                        for (int kk = 0; kk < 8; ++kk) { bf16x8 bfm[2];
#pragma unroll
                            for (int y = 0; y < 2; ++y) bfm[y] = *(const bf16x8*)(sp + (size_t)(32 * wave + 16 * y + fr) * 256 + kk * 32 + fq * 8);
#pragma unroll
                            for (int x = 0; x < 4; ++x) { const bf16x8 af = *(const bf16x8*)(qL + (16 * x + fr) * 264 + kk * 32 + fq * 8);
#pragma unroll
                                for (int y = 0; y < 2; ++y) acc[x][y] = __builtin_amdgcn_mfma_f32_16x16x32_bf16(af, bfm[y], acc[x][y], 0, 0, 0); } }
#pragma unroll
                        for (int x = 0; x < 4; ++x)
#pragma unroll
                            for (int jj = 0; jj < 4; ++jj) { const float qd = exp2f(l2g * (float)(64 * i + 16 * x + fq * 4 + jj + 1)); acc[x][0][jj] *= qd; acc[x][1][jj] *= qd; }
                    }
                    for (int j = 0; j <= i; ++j) {
                        __syncthreads();
#pragma unroll
                        for (int x = 0; x < 4; ++x) { const int p = tid + 512 * x, t = p >> 5, dp = p & 31; *(u32x4*)(kL + t * 264 + dp * 8) = kr[x]; }
#pragma unroll
                        for (int x = 0; x < 4; ++x) { const int t = lane, dp = wave + 8 * x;
                            const u32x4 raw = vr[x];
#pragma unroll
                            for (int e = 0; e < 4; ++e) { const unsigned w = raw[e]; vT[(dp * 8 + 2 * e) * 72 + t] = (bf16)(w & 0xffffu); vT[(dp * 8 + 2 * e + 1) * 72 + t] = (bf16)(w >> 16); } }
                        if (j < i) R3_LOADKV(j + 1);
                        __syncthreads();
                        { const int tr = wave >> 1, tc0 = (wave & 1) * 2; f32x4 sa[2] = {(f32x4){0.f, 0.f, 0.f, 0.f}, (f32x4){0.f, 0.f, 0.f, 0.f}};
#pragma unroll
                            for (int kk = 0; kk < 8; ++kk) { const bf16x8 af = *(const bf16x8*)(qL + (16 * tr + fr) * 264 + kk * 32 + fq * 8);
#pragma unroll
                                for (int y = 0; y < 2; ++y) { const bf16x8 bfm = *(const bf16x8*)(kL + (16 * (tc0 + y) + fr) * 264 + kk * 32 + fq * 8); sa[y] = __builtin_amdgcn_mfma_f32_16x16x32_bf16(af, bfm, sa[y], 0, 0, 0); } }
#pragma unroll
                            for (int y = 0; y < 2; ++y)
#pragma unroll
                                for (int jj = 0; jj < 4; ++jj) { const int t = 16 * tr + fq * 4 + jj, s = 16 * (tc0 + y) + fr; const int dist = (j < i) ? 64 * (i - j) + t - s : (t > s ? t - s : s - t);
                                    pL[t * 72 + s] = (bf16)f2bf(sa[y][jj] * exp2f(l2g * (float)dist)); } }
                        __syncthreads();
#pragma unroll
                        for (int kk = 0; kk < 2; ++kk) { bf16x8 bfm[2];
#pragma unroll
                            for (int y = 0; y < 2; ++y) bfm[y] = *(const bf16x8*)(vT + (32 * wave + 16 * y + fr) * 72 + kk * 32 + fq * 8);
#pragma unroll
                            for (int x = 0; x < 4; ++x) { const bf16x8 af = *(const bf16x8*)(pL + (16 * x + fr) * 72 + kk * 32 + fq * 8);
#pragma unroll
                                for (int y = 0; y < 2; ++y) acc[x][y] = __builtin_amdgcn_mfma_f32_16x16x32_bf16(af, bfm[y], acc[x][y], 0, 0, 0); } }
                    }
#undef R3_LOADKV
                    const int et = tid >> 3, e0 = (tid & 7) * 32;
                    u32x4 g4[4];
#pragma unroll
                    for (int q4 = 0; q4 < 4; ++q4) g4[q4] = *(const u32x4*)(QKVG + (size_t)(m0 + et) * EC + 3072 + h * 256 + e0 + 8 * q4);
                    __syncthreads();
                    float* OT = (float*)lds;
#pragma unroll
                    for (int x = 0; x < 4; ++x)
#pragma unroll
                        for (int y = 0; y < 2; ++y)
#pragma unroll
                            for (int jj = 0; jj < 4; ++jj) OT[(16 * x + fq * 4 + jj) * 260 + 32 * wave + 16 * y + fr] = acc[x][y][jj];
                    __syncthreads();
                    f32x4 ov[8]; float s1 = 0.f, s2 = 0.f;
#pragma unroll
                    for (int q8 = 0; q8 < 8; ++q8) { ov[q8] = *(const f32x4*)(OT + et * 260 + e0 + 4 * q8); s1 += (ov[q8].x + ov[q8].y) + (ov[q8].z + ov[q8].w);
                        s2 += (ov[q8].x * ov[q8].x + ov[q8].y * ov[q8].y) + (ov[q8].z * ov[q8].z + ov[q8].w * ov[q8].w); }
                    s1 += DPPF(0.f, s1, 0xB1, 0xF); s1 += DPPF(0.f, s1, 0x4E, 0xF); s1 += DPPF(0.f, s1, 0x141, 0xF);
                    s2 += DPPF(0.f, s2, 0xB1, 0xF); s2 += DPPF(0.f, s2, 0x4E, 0xF); s2 += DPPF(0.f, s2, 0x141, 0xF);
                    const float mean = s1 * (1.f / 256.f), var = s2 * (1.f / 256.f) - mean * mean, rstd = rsqrtf(var + 1e-5f);
                    const float* lwp = a.in[I_ELW] + h * 256 + e0; const float* lbp = a.in[I_ELB] + h * 256 + e0;
                    bf16* mp = MIX + (size_t)(m0 + et) * D + RW + h * 256 + e0;
#pragma unroll
                    for (int q4 = 0; q4 < 4; ++q4) { float o8[8];
#pragma unroll
                        for (int hh = 0; hh < 2; ++hh) { const f32x4 w4 = *(const f32x4*)(lwp + 8 * q4 + 4 * hh), b4 = *(const f32x4*)(lbp + 8 * q4 + 4 * hh); const f32x4 vv = ov[2 * q4 + hh];
                            const unsigned ga = g4[q4][2 * hh], gb = g4[q4][2 * hh + 1]; const float t0 = bf2f(ga & 0xffffu), t1 = bf2f(ga >> 16), t2 = bf2f(gb & 0xffffu), t3 = bf2f(gb >> 16);
                            o8[4 * hh] = ((vv.x - mean) * rstd * w4.x + b4.x) * t0 * sigm(t0); o8[4 * hh + 1] = ((vv.y - mean) * rstd * w4.y + b4.y) * t1 * sigm(t1);
                            o8[4 * hh + 2] = ((vv.z - mean) * rstd * w4.z + b4.z) * t2 * sigm(t2); o8[4 * hh + 3] = ((vv.w - mean) * rstd * w4.w + b4.w) * t3 * sigm(t3); }
                        u32x4 w; w.x = pk2(o8[0], o8[1]); w.y = pk2(o8[2], o8[3]); w.z = pk2(o8[4], o8[5]); w.w = pk2(o8[6], o8[7]); *(u32x4*)(mp + 8 * q4) = w; }

                    }
                }
            }
        }
    }
    if (IN(7)) MID(10);
    SEAM(7);
    if (IN(8)) for (int rep = 0; rep < (DUP_PHASE == 8 ? 2 : 1); ++rep) {
        MID(7);
        if (wave < 5) {
            float* wl = (float*)lds + wave * RL<2>::BUF;
            const int ntask = wave < 4 ? RH * NCH : NB * RH;
            for (int task = wave < 4 ? bid * 4 + wave : bid; task < ntask; task += (wave < 4 ? G * 4 : G)) {
                f32x2 S[32]; int h, m0, nsteps; float* sdst = nullptr;
                if (wave < 4) { h = task / NCH; const int c = task % NCH; m0 = c * LCH; nsteps = LCH;
                    if (c == 0) {
#pragma unroll
                        for (int j = 0; j < 32; ++j) S[j] = (f32x2){0.f, 0.f};
                    } else { const float* src = PU + ((size_t)(h * NCH + c - 1) * 2 + 1) * 4096 + lane * 64;
#pragma unroll
                        for (int j = 0; j < 16; ++j) { const f32x4 q = *(const f32x4*)(src + 4 * j); S[2 * j] = (f32x2){q.x, q.y}; S[2 * j + 1] = (f32x2){q.z, q.w}; } }
                } else { const int b = task / RH; h = task % RH; m0 = TP + 16 * b; nsteps = TS;
                    const float* src = a.in[I_SWKV] + ((size_t)(b * RH + h) * 64 + lane) * 64; sdst = out + O_WKS + ((size_t)(b * RH + h) * 64 + lane) * 64;
#pragma unroll
                    for (int j = 0; j < 16; ++j) { const f32x4 q = *(const f32x4*)(src + 4 * j); S[2 * j] = (f32x2){q.x, q.y}; S[2 * j + 1] = (f32x2){q.z, q.w}; } }
                const size_t o = (size_t)m0 * RW + h * 64;
                rwkv_lds<2>(S, PW + o, PNKK + o, PB + o, PK + o, PR + o, PV + o, nsteps, lane, PG + o, BON + (size_t)m0 * 16 + h, MIX + (size_t)m0 * D + h * 64,
                            a.in[I_RLW][h * 64 + lane], a.in[I_RLB][h * 64 + lane], wl);
                if (sdst) {
#pragma unroll
                    for (int j = 0; j < 16; ++j) *(f32x4*)(sdst + 4 * j) = (f32x4){S[2 * j].x, S[2 * j].y, S[2 * j + 1].x, S[2 * j + 1].y}; }
            }
        }
        MID(8);
        {
            const int nb2 = G, b2 = bid;
            const int fr = lane & 15, fq = lane >> 4;
            for (int it0 = b2; it0 < NB * EH * 4; it0 += nb2) {
                const int it = EH * (TP / 64) + it0;
                __syncthreads();
#ifndef NO_RS
                {
                    const int r = it - EH * (TP / 64), tq = r & 3, b = (r >> 2) / EH, h = (r >> 2) % EH, m0 = TP + 16 * b; const float l2g = ret_l2g(h);
                    float* qf = (float*)lds; float* kf = qf + 4 * 260; float* vf = kf + 16 * 257; float* pf = vf + 16 * 257; float* red = pf + 64;
                    for (int idx = tid; idx < 16 * 256; idx += 512) { const int t = idx >> 8, dd = idx & 255; const bf16* src = QKVG + (size_t)(m0 + t) * EC + h * 256 + dd;
                        if ((t >> 2) == tq) qf[(t & 3) * 260 + dd] = bf2f(src[0]);
                        kf[t * 257 + dd] = bf2f(src[1024]); vf[t * 257 + dd] = bf2f(src[2048]); }
                    __syncthreads();
                    if (tid < 64) { const int tl = tid >> 4, s = tid & 15, t = 4 * tq + tl; float sc = 0.f;
#pragma unroll 4
                        for (int dd = 0; dd < 256; ++dd) sc += qf[tl * 260 + dd] * kf[s * 257 + dd];
                        pf[tl * 16 + s] = sc * exp2f(l2g * (float)(t > s ? t - s : s - t)); }
                    __syncthreads();
                    const int e = tid & 255, th = tid >> 8; const float* S0 = a.in[I_SRET] + (size_t)(b * EH + h) * 65536;
                    float oc[2] = {0.f, 0.f};
#pragma unroll 4
                    for (int dd = 0; dd < 256; dd += 4) { const f32x4 qa = *(const f32x4*)(qf + (2 * th) * 260 + dd), qb = *(const f32x4*)(qf + (2 * th + 1) * 260 + dd);
                        const float s0 = S0[(size_t)dd * 256 + e], s1 = S0[(size_t)(dd + 1) * 256 + e], s2 = S0[(size_t)(dd + 2) * 256 + e], s3 = S0[(size_t)(dd + 3) * 256 + e];
                        oc[0] += qa.x * s0 + qa.y * s1 + qa.z * s2 + qa.w * s3; oc[1] += qb.x * s0 + qb.y * s1 + qb.z * s2 + qb.w * s3; }
#pragma unroll
                    for (int tt = 0; tt < 2; ++tt) { const int tl = 2 * th + tt, t = 4 * tq + tl; float v = oc[tt] * exp2f(l2g * (float)(t + 1));
#pragma unroll 4
                        for (int s = 0; s < 16; ++s) v += pf[tl * 16 + s] * vf[s * 257 + e];
                        oc[tt] = v; }
                    { const float g16 = exp2f(16.f * l2g); float* dst = out + O_RTS + (size_t)(b * EH + h) * 65536; float vd[16];
#pragma unroll
                        for (int t = 0; t < 16; ++t) vd[t] = vf[t * 257 + e] * exp2f(l2g * (float)(15 - t));
#pragma unroll 4
                        for (int dd = 64 * tq + 32 * th; dd < 64 * tq + 32 * th + 32; ++dd) { float v = g16 * S0[(size_t)dd * 256 + e];
#pragma unroll
                            for (int t = 0; t < 16; ++t) v += kf[t * 257 + dd] * vd[t];
                            dst[(size_t)dd * 256 + e] = v; } }
#pragma unroll
                    for (int tt = 0; tt < 2; ++tt) { const float s1 = wave_sum(oc[tt]), s2 = wave_sum(oc[tt] * oc[tt]); if (lane == 0) { const int tl = 2 * th + tt; red[(tl * 4 + (wave & 3)) * 2] = s1; red[(tl * 4 + (wave & 3)) * 2 + 1] = s2; } }
                    __syncthreads();
                    const float lw = a.in[I_ELW][h * 256 + e], lb = a.in[I_ELB][h * 256 + e];
#pragma unroll
                    for (int tt = 0; tt < 2; ++tt) { const int tl = 2 * th + tt, t = 4 * tq + tl; float s1 = 0.f, s2 = 0.f;
#pragma unroll
                        for (int w4 = 0; w4 < 4; ++w4) { s1 += red[(tl * 4 + w4) * 2]; s2 += red[(tl * 4 + w4) * 2 + 1]; }
                        const float mean = s1 * (1.f / 256.f), var = s2 * (1.f / 256.f) - mean * mean, rstd = rsqrtf(var + 1e-5f);
                        const float gt = bf2f(QKVG[(size_t)(m0 + t) * EC + 3072 + h * 256 + e]);
                        MIX[(size_t)(m0 + t) * D + RW + h * 256 + e] = (bf16)f2bf(((oc[tt] - mean) * rstd * lw + lb) * gt * sigm(gt)); }
                }
#else
                {}
#endif
            }
        }
    }
    if (IN(8)) MID(9);
    SEAM(8);
    if (IN(9)) for (int rep = 0; rep < (DUP_PHASE == 9 ? 2 : 1); ++rep) {
        { pg8::Gemm g{MIX, WOUTT, TP, D, D, D}; pg8::StaticOrder S; S.init(TP, D, G, bid); EpiBf16P E{(bf16*)MIXOUT, D};
          pg8::gemm_phase<EpiBf16P, pg8::StaticOrder, true, true>((PG8_LAS unsigned char*)lds, g, S, E); }
        { const int sl = bid >> 3; pg8::Gemm g{MIX + (size_t)TP * D + sl * 512, WOUTT + sl * 512, MS, D, 512, D}; pg8::OneUnit S{0, bid & 7, bid < 8 * KS9}; EpiF32 E{(float*)(ws + WS_PART9) + (size_t)sl * MS * D, D};
          pg8::gemm_phase<EpiF32, pg8::OneUnit, false, true>((PG8_LAS unsigned char*)lds, g, S, E); }
        if (G > 8 * KS9 && bid >= 8 * KS9) {
            float* scr = (float*)lds + wave * (64 * 33 + 16);
            for (int r = (bid - 8 * KS9) * 8 + wave; r < (FF / 64) * (D / 32); r += (G - 8 * KS9) * 8) { const int nb = D / 32, kb = r / nb, n0 = 32 * (r % nb); transpose_item(a.in[I_WDN], FF, D, WDNT, 64 * kb, n0, n0, scr, lane); }
        }
    }
    SEAM(9);
    if (IN(10)) for (int rep = 0; rep < (DUP_PHASE == 10 ? 2 : 1); ++rep) {
        for (int m = gw; m < M; m += NGW) {
            const float* xr = m < TP ? a.in[I_XP] + (size_t)m * D : a.in[I_XS] + (size_t)(m - TP) * D; const float* mod = MOD + seq_of(m) * MODW; const float* mr = MIXOUT + (size_t)m * D;
            f32x4 v[8]; float ss = 0.f;
#pragma unroll
            for (int j = 0; j < 8; ++j) {
                if (m < TP) { const u32x2 rw = *(const u32x2*)((const bf16*)MIXOUT + (size_t)m * D + 4 * lane + 256 * j); v[j] = (f32x4){bf2f(rw.x & 0xffffu), bf2f(rw.x >> 16), bf2f(rw.y & 0xffffu), bf2f(rw.y >> 16)}; }
                else { const float* pr = (const float*)(ws + WS_PART9) + (size_t)(m - TP) * D + 4 * lane + 256 * j; v[j] = *(const f32x4*)pr;
#pragma unroll
                    for (int q = 1; q < KS9; ++q) v[j] += *(const f32x4*)(pr + (size_t)q * MS * D); }
                ss += (v[j].x * v[j].x + v[j].y * v[j].y) + (v[j].z * v[j].z + v[j].w * v[j].w); }
            const float rs = rsqrtf(wave_sum(ss) * (1.f / D) + 1e-6f); float s2 = 0.f;
#pragma unroll
            for (int j = 0; j < 8; ++j) { const int c = 4 * lane + 256 * j; const f32x4 g = *(const f32x4*)(a.in[I_GPOM] + c), gt = *(const f32x4*)(mod + 2 * D + c), x = *(const f32x4*)(xr + c);
                v[j] = x + gt * (v[j] * rs * g); *(f32x4*)(out + (size_t)m * D + c) = v[j]; s2 += (v[j].x * v[j].x + v[j].y * v[j].y) + (v[j].z * v[j].z + v[j].w * v[j].w); }
            const float rs2 = rsqrtf(wave_sum(s2) * (1.f / D) + 1e-6f);
#pragma unroll
            for (int j = 0; j < 8; ++j) { const int c = 4 * lane + 256 * j; const f32x4 g = *(const f32x4*)(a.in[I_GPF] + c), s1 = *(const f32x4*)(mod + 4 * D + c), h1 = *(const f32x4*)(mod + 3 * D + c);
                const f32x4 h = v[j] * rs2 * g * (s1 + 1.f) + h1; u32x2 w; w.x = pk2(h.x, h.y); w.y = pk2(h.z, h.w); *(u32x2*)(H + (size_t)m * D + c) = w; }
        }
        float* scr = (float*)lds + wave * (64 * 33 + 16);
        constexpr int IT_UP = (D / 64) * (2 * FF / 32), IT_DN = (FF / 64) * (D / 32);
        for (int it = gw; it < IT_UP + (G > 8 * KS9 ? 0 : IT_DN); it += NGW) {
            if (it < IT_UP) { const int nb = 2 * FF / 32, kb = it / nb, n0 = 32 * (it % nb); const int nn = n0 < FF ? n0 : n0 - FF; const int dr = 256 * (nn >> 7) + (n0 < FF ? 0 : 128) + (nn & 127);
                transpose_item(a.in[I_WUP], D, 2 * FF, WUPT, 64 * kb, n0, dr, scr, lane); }
            else { const int r = it - IT_UP, nb = D / 32, kb = r / nb, n0 = 32 * (r % nb); transpose_item(a.in[I_WDN], FF, D, WDNT, 64 * kb, n0, n0, scr, lane); }
        }
    }
    SEAM(10);
    if (IN(11)) for (int rep = 0; rep < (DUP_PHASE == 11 ? 2 : 1); ++rep) {
        pg8::Gemm g{H, WUPT, M, 2 * FF, D, D}; pg8::StaticOrder S; S.init(M, 2 * FF, G, bid); EpiSwiglu E{ACT};
        pg8::gemm_phase<EpiSwiglu, pg8::StaticOrder, true, true>((PG8_LAS unsigned char*)lds, g, S, E);
    }
    SEAM(11);
    if (IN(12)) for (int rep = 0; rep < (DUP_PHASE == 12 ? 2 : 1); ++rep) {
        { pg8::Gemm g{ACT, WDNT, TP, D, FF, FF}; pg8::StaticOrder S; S.init(TP, D, G, bid); EpiBf16P E{(bf16*)MIXOUT, D};
          pg8::gemm_phase<EpiBf16P, pg8::StaticOrder, true, true>((PG8_LAS unsigned char*)lds, g, S, E); }
        { const int sl = bid >> 3; pg8::Gemm g{ACT + (size_t)TP * FF + sl * 512, WDNT + sl * 512, MS, D, 512, FF}; pg8::OneUnit S{0, bid & 7, bid < 8 * KS12}; EpiF32 E{(float*)(ws + WS_PART12) + (size_t)sl * MS * D, D};
          pg8::gemm_phase<EpiF32, pg8::OneUnit, false, true>((PG8_LAS unsigned char*)lds, g, S, E); }
    }
    SEAM(12);
    if (IN(13)) for (int rep = 0; rep < (DUP_PHASE == 13 ? 2 : 1); ++rep) {
        for (int m = gw; m < M; m += NGW) {
            const float* mod = MOD + seq_of(m) * MODW; const float* fr_ = MIXOUT + (size_t)m * D;
            f32x4 v[8]; float ss = 0.f;
#pragma unroll
            for (int j = 0; j < 8; ++j) {
                if (m < TP) { const u32x2 rw = *(const u32x2*)((const bf16*)MIXOUT + (size_t)m * D + 4 * lane + 256 * j); v[j] = (f32x4){bf2f(rw.x & 0xffffu), bf2f(rw.x >> 16), bf2f(rw.y & 0xffffu), bf2f(rw.y >> 16)}; }
                else { const float* pr = (const float*)(ws + WS_PART12) + (size_t)(m - TP) * D + 4 * lane + 256 * j; v[j] = *(const f32x4*)pr;
#pragma unroll
                    for (int q = 1; q < KS12; ++q) v[j] += *(const f32x4*)(pr + (size_t)q * MS * D); }
                ss += (v[j].x * v[j].x + v[j].y * v[j].y) + (v[j].z * v[j].z + v[j].w * v[j].w); }
            const float rs = rsqrtf(wave_sum(ss) * (1.f / D) + 1e-6f);
#pragma unroll
            for (int j = 0; j < 8; ++j) { const int c = 4 * lane + 256 * j; const f32x4 g = *(const f32x4*)(a.in[I_GPOF] + c), gt = *(const f32x4*)(mod + 5 * D + c), x = *(const f32x4*)(out + (size_t)m * D + c);
                *(f32x4*)(out + (size_t)m * D + c) = x + gt * (v[j] * rs * g); }
        }
    }
    if (TS_PROBE >= 0) {
        xcd_barrier(xb);
        if (bid == 0 && tid == 0) TSW[14] = __builtin_amdgcn_s_memrealtime();
        if (bid == 0) { __syncthreads(); const float us = TS_PROBE >= 100 ? (float)(TSW[32 + TS_PROBE - 100] - TSW[32 + TS_PROBE - 101]) * 0.01f : (float)(TSW[1 + TS_PROBE] - TSW[TS_PROBE]) * 0.01f; const float eps = sqrtf(us * 1e-4f);
            for (int c = tid; c < RC; c += 512) out[O_SHP + c] *= (1.f + eps); }
    }
#undef IN
#undef SEAM
}

extern "C" void kernel_launch(void* const* d_in, const int* in_sizes, int n_in, void* d_out, int out_size, void* d_ws, size_t ws_size, hipStream_t stream) {
    static int grid = 0;
    if (grid == 0) {
        if (n_in != 30 || (size_t)out_size != O_END || ws_size < WS_END) { fprintf(stderr, "kernel_launch: unexpected sizes n_in %d out %d ws %zu\n", n_in, out_size, ws_size); grid = -1; return; }
        int dev = 0, cus = 0, per_cu = 0;
        (void)hipGetDevice(&dev); (void)hipDeviceGetAttribute(&cus, hipDeviceAttributeMultiprocessorCount, dev);
        if (hipFuncSetAttribute((const void*)mk_fwd, hipFuncAttributeMaxDynamicSharedMemorySize, LDS_BYTES) != hipSuccess) { fprintf(stderr, "kernel_launch: hipFuncSetAttribute failed\n"); grid = -1; return; }
        if (hipOccupancyMaxActiveBlocksPerMultiprocessor(&per_cu, (const void*)mk_fwd, 512, LDS_BYTES) != hipSuccess || per_cu < 1) { fprintf(stderr, "kernel_launch: occupancy query says %d\n", per_cu); per_cu = 1; }
        (void)hipGetLastError();
        grid = cus;
        if (grid <= 0) grid = 256;
    }
    if (grid < 0) return;
    (void)hipMemsetAsync((char*)d_ws + 65536, 0, XCD_BAR_WORDS * 4 + 512, stream);
    Args a{};
    for (int i = 0; i < 30; ++i) a.in[i] = (const float*)d_in[i];
    a.out = (float*)d_out; a.ws = (unsigned char*)d_ws;
    a.ph_lo = 0; a.ph_hi = NPHASE;
    void* args[] = {&a};
    hipError_t e = hipLaunchCooperativeKernel((const void*)mk_fwd, dim3(grid), dim3(512), args, LDS_BYTES, stream);
    if (e != hipSuccess) fprintf(stderr, "kernel_launch: cooperative launch failed: %s (grid %d)\n", hipGetErrorString(e), grid);
}
```

```cpp
#include <hip/hip_runtime.h>
#include <hip/hip_cooperative_groups.h>
#include <cstdio>
#include <cstdint>
namespace cg = cooperative_groups;
namespace pg8 {
#define PG8_LAS __attribute__((address_space(3)))
typedef unsigned short bf16_t;
typedef short bf16x8 __attribute__((ext_vector_type(8)));
typedef float f32x4 __attribute__((ext_vector_type(4)));
typedef unsigned u32x4 __attribute__((ext_vector_type(4)));
constexpr int BM = 256, BK = 64, HALF = 128, HTB = HALF * BK * 2  , STAGE_BYTES = 8 * HTB, NXCD = 8, WGM = 8;

__host__ __device__ __forceinline__ int lds_byte(int r, int c) { const int st = (r >> 4) * 2 + (c >> 5), rr = r & 15, cc = c & 31, ob = rr * 64 + cc * 2; return st * 1024 + (ob ^ (((ob >> 9) & 1) << 5)); }
__host__ __device__ __forceinline__ void stage_rc(int b, int& R, int& C) { const int st = b / 1024, sb = b % 1024, swz = sb ^ (((sb >> 9) & 1) << 5); R = (st >> 1) * 16 + swz / 64; C = (st & 1) * 32 + (swz % 64) / 2; }
__host__ __device__ __forceinline__ int perm32(int rho) { const int n = rho >> 4, i = rho & 15; return 8 * (i >> 2) + 4 * n + (i & 3); }

struct Unit { int pm, pn; };
struct Gemm { const bf16_t* A; const bf16_t* Bt; int M, N, K, ld; };

struct OneUnit {
    int pm, pn; bool active;
    __device__ __forceinline__ bool next(int i, Unit& u) const { if (i > 0 || !active) return false; u.pm = pm; u.pn = pn; return true; }
    __device__ __forceinline__ void a_ready(const Unit&) const {}
    __device__ __forceinline__ void done(const Unit&) const {}
};
struct StaticOrder {
    int nM, nN, nwg, G, c;
    __host__ __device__ void init(int M, int N, int G_, int c_) { nM = M / BM; nN = N / BM; nwg = nM * nN; G = G_; c = c_; }
    __host__ __device__ bool next(int i, Unit& u) const {
        const long L = (long)i * G + c; if (L >= nwg) return false;
        int wgid = (int)L; { const int q = nwg / NXCD, r = nwg % NXCD, xcd = wgid % NXCD, off = wgid / NXCD; wgid = (xcd < r ? xcd * (q + 1) : r * (q + 1) + (xcd - r) * q) + off; }
        const int nig = WGM * nN, gid = wgid / nig, fm = gid * WGM, gsz = (nM - fm) < WGM ? (nM - fm) : WGM;
        u.pm = fm + ((wgid % nig) % gsz); u.pn = (wgid % nig) / gsz; return true;
    }
    __device__ __forceinline__ void a_ready(const Unit&) const {}
    __device__ __forceinline__ void done(const Unit&) const {}
};

__device__ __forceinline__ unsigned cvt_pk_bf16(float lo, float hi) { unsigned r; asm volatile("v_cvt_pk_bf16_f32 %0, %1, %2" : "=v"(r) : "v"(lo), "v"(hi)); return r; }
template <class Epi, class Sched, bool ALIGN_EPI = false, bool SP2 = false>
__device__ __forceinline__ void gemm_phase(PG8_LAS unsigned char* lds, const Gemm g, const Sched& S, const Epi& E) {
    const int tid = threadIdx.x, wid = __builtin_amdgcn_readfirstlane(tid >> 6), lane = tid & 63, wr = wid >> 2, wc = wid & 3, fr = lane & 15, fq = lane >> 4;
    const int K = g.K, nt = K / BK;
    unsigned voffA[2], voffB[2];
#pragma unroll
    for (int i = 0; i < 2; ++i) { int R, C; stage_rc(tid * 16 + i * 8192, R, C); const int Rb = Epi::PERM ? ((R & ~31) + perm32(R & 31)) : R;
        voffA[i] = (unsigned)(R * g.ld + C) * 2u; voffB[i] = (unsigned)(Rb * g.ld + C) * 2u; }
    const size_t kstep = (size_t)(BK * 2);
    const size_t hstep = (size_t)HALF * g.ld * 2;
    const size_t tstep = 2 * hstep;
    const unsigned ldsw = (unsigned)wid * 1024u;
    const int aoff = lds_byte(wr * 64 + fr, fq * 8), boff = lds_byte(wc * 32 + fr, fq * 8);
#define PG8_SA(b, h) (((b) * 2 + (h)) * HTB)
#define PG8_SB(b, h) ((4 + (b) * 2 + (h)) * HTB)
#define PG8_STAGE(bufoff, gbase, voff) do { _Pragma("unroll") for (int _i = 0; _i < 2; ++_i) \
        __builtin_amdgcn_global_load_lds((const unsigned*)((const char*)(gbase) + (voff)[_i]), (PG8_LAS unsigned*)(lds + (bufoff) + ldsw + _i * 8192), 16, 0, 0); } while (0)
#define PG8_LDA(dst, b, h) do { _Pragma("unroll") for (int m = 0; m < 4; ++m) _Pragma("unroll") for (int k = 0; k < 2; ++k) dst[m][k] = *(const PG8_LAS bf16x8*)(lds + PG8_SA(b, h) + aoff + m * 2048 + k * 1024); } while (0)
#define PG8_LDB(dst, b, h) do { _Pragma("unroll") for (int n = 0; n < 2; ++n) _Pragma("unroll") for (int k = 0; k < 2; ++k) dst[n][k] = *(const PG8_LAS bf16x8*)(lds + PG8_SB(b, h) + boff + n * 2048 + k * 1024); } while (0)
#define PG8_MMA(ai, bj, At, Bt) do { __builtin_amdgcn_s_setprio(1); _Pragma("unroll") for (int m = 0; m < 4; ++m) _Pragma("unroll") for (int n = 0; n < 2; ++n) _Pragma("unroll") for (int k = 0; k < 2; ++k) \
        acc[ai][bj][m][n] = __builtin_amdgcn_mfma_f32_16x16x32_bf16(Bt[n][k], At[m][k], acc[ai][bj][m][n], 0, 0, 0); __builtin_amdgcn_s_setprio(0); } while (0)
#define PG8_WAIT_V(n) asm volatile("s_waitcnt vmcnt(" #n ")" ::: "memory")
#define PG8_WAIT_L(n) asm volatile("s_waitcnt lgkmcnt(" #n ")" ::: "memory")
#define PG8_BAR __builtin_amdgcn_s_barrier()
#define PG8_SCHED __builtin_amdgcn_sched_barrier(0)
    Unit cur, nxt; int ui = 0;
    if (!S.next(0, cur)) return;
    f32x4 acc[2][2][4][2];
#pragma unroll
    for (int a = 0; a < 2; ++a)
#pragma unroll
        for (int b = 0; b < 2; ++b)
#pragma unroll
            for (int m = 0; m < 4; ++m)
#pragma unroll
                for (int n = 0; n < 2; ++n) acc[a][b][m][n] = (f32x4){0.f, 0.f, 0.f, 0.f};
    bf16x8 At[4][2], B0[2][2], B1[2][2];
    const char* cA = (const char*)g.A + (size_t)cur.pm * tstep; const char* cB = (const char*)g.Bt + (size_t)cur.pn * tstep;
    S.a_ready(cur);
    if constexpr (SP2) {
        PG8_STAGE(PG8_SB(0, 0), cB, voffB); PG8_STAGE(PG8_SB(0, 1), cB + hstep, voffB); PG8_STAGE(PG8_SA(0, 0), cA, voffA); PG8_STAGE(PG8_SA(0, 1), cA + hstep, voffA);
        if (wr == 1) PG8_BAR;
        PG8_WAIT_V(2); PG8_BAR;
        PG8_STAGE(PG8_SB(1, 0), cB + kstep, voffB); PG8_STAGE(PG8_SA(1, 0), cA + kstep, voffA); PG8_STAGE(PG8_SB(1, 1), cB + hstep + kstep, voffB);
        PG8_WAIT_V(6); PG8_BAR;
    } else {
        PG8_STAGE(PG8_SB(0, 0), cB, voffB); PG8_STAGE(PG8_SA(0, 0), cA, voffA); PG8_STAGE(PG8_SB(0, 1), cB + hstep, voffB); PG8_STAGE(PG8_SA(0, 1), cA + hstep, voffA);
        if (wr == 1) PG8_BAR;
        PG8_WAIT_V(4); PG8_BAR;
        PG8_STAGE(PG8_SB(1, 0), cB + kstep, voffB); PG8_STAGE(PG8_SA(1, 0), cA + kstep, voffA); PG8_STAGE(PG8_SB(1, 1), cB + hstep + kstep, voffB);
        PG8_WAIT_V(6); PG8_BAR;
    }
    for (;;) {
        const bool has_next = S.next(ui + 1, nxt);
        const char* nA = has_next ? (const char*)g.A + (size_t)nxt.pm * tstep : cA; const char* nB = has_next ? (const char*)g.Bt + (size_t)nxt.pn * tstep : cB;
        for (int t = 0; t < nt; t += 2) {
            const bool last = (t == nt - 2);
            const char* a1 = cA + (size_t)(t + 1) * kstep;
            const char* a2 = last ? nA : cA + (size_t)(t + 2) * kstep; const char* b2 = last ? nB : cB + (size_t)(t + 2) * kstep;
            const char* a3 = a2 + kstep; const char* b3 = b2 + kstep;
            if (last && has_next) S.a_ready(nxt);
            if constexpr (SP2) {
            PG8_LDB(B0, 0, 0); PG8_LDB(B1, 0, 1); PG8_SCHED; PG8_LDA(At, 0, 0); PG8_STAGE(PG8_SA(1, 1), a1 + hstep, voffA);
            PG8_WAIT_V(8); PG8_WAIT_L(0); PG8_BAR; PG8_MMA(0, 0, At, B0); PG8_MMA(0, 1, At, B1); PG8_BAR; PG8_SCHED;
            PG8_LDA(At, 0, 1); PG8_STAGE(PG8_SB(0, 0), b2, voffB); PG8_STAGE(PG8_SB(0, 1), b2 + hstep, voffB); PG8_STAGE(PG8_SA(0, 0), a2, voffA);
            PG8_WAIT_V(8); PG8_WAIT_L(0); PG8_BAR; PG8_MMA(1, 0, At, B0); PG8_MMA(1, 1, At, B1); PG8_BAR; PG8_SCHED;
            PG8_LDB(B0, 1, 0); PG8_LDB(B1, 1, 1); PG8_SCHED; PG8_LDA(At, 1, 0); PG8_STAGE(PG8_SA(0, 1), a2 + hstep, voffA);
            PG8_WAIT_V(8); PG8_WAIT_L(0); PG8_BAR; PG8_MMA(0, 0, At, B0); PG8_MMA(0, 1, At, B1); PG8_BAR; PG8_SCHED;
            PG8_LDA(At, 1, 1); PG8_STAGE(PG8_SB(1, 0), b3, voffB); PG8_STAGE(PG8_SB(1, 1), b3 + hstep, voffB); PG8_STAGE(PG8_SA(1, 0), a3, voffA);
            PG8_WAIT_V(8); PG8_WAIT_L(0); PG8_BAR; PG8_MMA(1, 0, At, B0); PG8_MMA(1, 1, At, B1); PG8_BAR; PG8_SCHED;
            } else {
            PG8_LDB(B0, 0, 0); PG8_SCHED; PG8_LDA(At, 0, 0); PG8_STAGE(PG8_SA(1, 1), a1 + hstep, voffA);
            PG8_WAIT_L(8); PG8_BAR; PG8_WAIT_L(0); PG8_MMA(0, 0, At, B0); PG8_BAR; PG8_SCHED;
            PG8_LDB(B1, 0, 1); PG8_STAGE(PG8_SB(0, 0), b2, voffB);
            PG8_BAR; PG8_WAIT_L(0); PG8_MMA(0, 1, At, B1); PG8_BAR;
            PG8_LDA(At, 0, 1); PG8_STAGE(PG8_SA(0, 0), a2, voffA);
            PG8_BAR; PG8_WAIT_L(0); PG8_MMA(1, 0, At, B0); PG8_BAR; PG8_SCHED;
            PG8_STAGE(PG8_SB(0, 1), b2 + hstep, voffB);
            PG8_WAIT_V(6); PG8_BAR; PG8_MMA(1, 1, At, B1); PG8_BAR;
            PG8_LDB(B0, 1, 0); PG8_SCHED; PG8_LDA(At, 1, 0); PG8_STAGE(PG8_SA(0, 1), a2 + hstep, voffA);
            PG8_WAIT_L(8); PG8_BAR; PG8_WAIT_L(0); PG8_MMA(0, 0, At, B0); PG8_BAR; PG8_SCHED;
            PG8_LDB(B1, 1, 1); PG8_STAGE(PG8_SB(1, 0), b3, voffB);
            PG8_BAR; PG8_WAIT_L(0); PG8_MMA(0, 1, At, B1); PG8_BAR;
            PG8_LDA(At, 1, 1); PG8_STAGE(PG8_SA(1, 0), a3, voffA);
            PG8_BAR; PG8_WAIT_L(0); PG8_MMA(1, 0, At, B0); PG8_BAR; PG8_SCHED;
            PG8_STAGE(PG8_SB(1, 1), b3 + hstep, voffB);
            PG8_WAIT_V(6); PG8_BAR; PG8_MMA(1, 1, At, B1); PG8_BAR;
            }
        }
        if constexpr (ALIGN_EPI) { if (wr == 0) PG8_BAR; }
        if constexpr (!Epi::AFTER_DRAIN) { E(acc, cur, wr, wc, fr, fq); S.done(cur); }
        if (!has_next) break;
#pragma unroll
        for (int a = 0; a < 2; ++a)
#pragma unroll
            for (int b = 0; b < 2; ++b)
#pragma unroll
                for (int m = 0; m < 4; ++m)
#pragma unroll
                    for (int n = 0; n < 2; ++n) acc[a][b][m][n] = (f32x4){0.f, 0.f, 0.f, 0.f};
        cur = nxt; cA = nA; cB = nB; ++ui;
        if constexpr (ALIGN_EPI) { if (wr == 1) PG8_BAR; }
    }
    PG8_WAIT_V(0);
    if constexpr (!ALIGN_EPI) { if (wr == 0) PG8_BAR; }
    PG8_BAR;
    if constexpr (Epi::AFTER_DRAIN) { E.fused(acc, cur, wr, wc, fr, fq, lds, wid, lane); S.done(cur); }
#undef PG8_SA
#undef PG8_SB
#undef PG8_STAGE
#undef PG8_LDA
#undef PG8_LDB
#undef PG8_MMA
#undef PG8_WAIT_V
#undef PG8_WAIT_L
#undef PG8_BAR
#undef PG8_SCHED
}
}

constexpr int D = 2048, TP = 8192, NB = 16, TS = 16, MS = NB * TS, M = TP + MS;
constexpr int RW = 1024, RH = 16, RN = 64, RC = 3328;
constexpr int ED = 1024, EH = 4, EN = 256, EC = 4096, IC = RC + EC;
constexpr int FF = 5632, NSEQ = 17, MODW = 6 * D;
constexpr int LCH = 128, NCH = TP / LCH;
constexpr int RBLK = 256, NRB = TP / RBLK;
constexpr int NPHASE = 14;
constexpr size_t O_Y = 0, O_SHP = (size_t)M * D, O_WKP = O_SHP + RC, O_RTP = O_WKP + 65536, O_SHS = O_RTP + 262144, O_WKS = O_SHS + (size_t)NB * RC, O_RTS = O_WKS + (size_t)NB * 65536, O_END = O_RTS + (size_t)NB * 262144;
constexpr size_t MiB = 1u << 20;
constexpr size_t WS_MOD = 1 * MiB, WS_LORAT = 2 * MiB, WS_WOUTT = 4 * MiB, WS_WINT = 12 * MiB, WS_V = 12 * MiB, WS_H = 41 * MiB, WS_G = 41 * MiB, WS_BON = 58 * MiB,
                 WS_QKVG = 74 * MiB, WS_LOUT = 140 * MiB, WS_PU = 140 * MiB, WS_KVB = 172 * MiB, WS_ACT = 74 * MiB, WS_PREP = 190 * MiB, WS_MIXOUT = 190 * MiB,
                 WS_WUPT = 256 * MiB, WS_WDNT = 300 * MiB, WS_PART9 = 330 * MiB, WS_PART12 = 256 * MiB, WS_END = 355 * MiB;
constexpr size_t WS_ADAT = 190 * MiB, WS_SC = 239 * MiB, WS_MODP = 240 * MiB;
constexpr int KS9 = 4, KS12 = 11;
constexpr size_t PREP_STRIDE = 33 * MiB;
constexpr size_t DO_Z = 0, DO_LIN = 54 * MiB, DO_SPREV = 0, DO_MIX = 17 * MiB;
constexpr int LDS_BYTES = 147456;

typedef unsigned short bf16;
typedef float f32x2 __attribute__((ext_vector_type(2)));
typedef float f32x4 __attribute__((ext_vector_type(4)));
typedef short bf16x8 __attribute__((ext_vector_type(8)));
typedef unsigned u32x4 __attribute__((ext_vector_type(4)));
typedef unsigned u32x2 __attribute__((ext_vector_type(2)));
#define LDS_WAIT() asm volatile("s_waitcnt lgkmcnt(0)" ::: "memory")

__device__ __forceinline__ float bf2f(unsigned v) { return __builtin_bit_cast(float, v << 16); }
__device__ __forceinline__ unsigned f2bf(float f) { unsigned u = __builtin_bit_cast(unsigned, f); return (u + 0x7fffu + ((u >> 16) & 1u)) >> 16; }
__device__ __forceinline__ unsigned pk2(float lo, float hi) { return f2bf(lo) | (f2bf(hi) << 16); }
__device__ __forceinline__ float wave_sum(float v) {
#pragma unroll
    for (int o = 1; o < 64; o <<= 1) v += __shfl_xor(v, o);
    return v;
}
__device__ __forceinline__ float sigm(float x) { return 1.f / (1.f + __expf(-x)); }
__device__ __forceinline__ int seq_of(int m) { return m < TP ? 0 : 1 + ((m - TP) >> 4); }
__device__ __forceinline__ int tpos_of(int m) { return m < TP ? m : ((m - TP) & 15); }
__device__ __forceinline__ float ret_l2g(int h) { return __log2f(1.0f - exp2f(-5.0f - (float)h)); }

struct EpiProj {
    static constexpr bool PERM = true, AFTER_DRAIN = false;
    bf16* Z; bf16* Q;
    __device__ __forceinline__ void operator()(const f32x4 (&acc)[2][2][4][2], const pg8::Unit& u, int wr, int wc, int fr, int fq) const {
        const int row0 = u.pm * 256 + wr * 64 + fr, pn = u.pn, cl = wc * 32 + 8 * fq;
        if (pn < 13 || pn >= 21) {
            bf16* base = pn < 13 ? Z + pn * 256 + cl : Q + (pn - 13) * 256 + cl; const size_t ld = pn < 13 ? RC : EC;
#pragma unroll
            for (int ai = 0; ai < 2; ++ai)
#pragma unroll
                for (int m = 0; m < 4; ++m) { bf16* rp = base + (size_t)(row0 + ai * 128 + m * 16) * ld;
#pragma unroll
                    for (int bj = 0; bj < 2; ++bj) { const f32x4 v0 = acc[ai][bj][m][0], v1 = acc[ai][bj][m][1]; u32x4 w; w.x = pk2(v0[0], v0[1]); w.y = pk2(v0[2], v0[3]); w.z = pk2(v1[0], v1[1]); w.w = pk2(v1[2], v1[3]);
                        *(u32x4*)(rp + bj * 128) = w; } }
        } else {
            const int sec = pn - 13; bf16* base = Q + sec * 256 + cl; const float sc = sec >= 4 ? 0.0625f : 1.0f;
            float inv[8];
#pragma unroll
            for (int e = 0; e < 8; ++e) inv[e] = exp2f(-(float)(cl + e) * (13.287712379549449f / 128.0f)) * 0.15915494309189535f;
#pragma unroll
            for (int ai = 0; ai < 2; ++ai)
#pragma unroll
                for (int m = 0; m < 4; ++m) { const int row = row0 + ai * 128 + m * 16; bf16* rp = base + (size_t)row * EC;
                    const float pos = row < TP ? (float)row : (float)(2048 + ((row - TP) & 15));
                    float o1[8], o2[8];
#pragma unroll
                    for (int e = 0; e < 8; ++e) { float rev = pos * inv[e]; rev -= floorf(rev); const float sn = __builtin_amdgcn_sinf(rev), cs = __builtin_amdgcn_cosf(rev);
                        const float x1 = acc[ai][0][m][e >> 2][e & 3], x2 = acc[ai][1][m][e >> 2][e & 3];
                        o1[e] = (x1 * cs - x2 * sn) * sc; o2[e] = (x2 * cs + x1 * sn) * sc; }
                    u32x4 w; w.x = pk2(o1[0], o1[1]); w.y = pk2(o1[2], o1[3]); w.z = pk2(o1[4], o1[5]); w.w = pk2(o1[6], o1[7]); *(u32x4*)rp = w;
                    w.x = pk2(o2[0], o2[1]); w.y = pk2(o2[2], o2[3]); w.z = pk2(o2[4], o2[5]); w.w = pk2(o2[6], o2[7]); *(u32x4*)(rp + 128) = w; }
        }
    }
};
struct EpiBf16P {
    static constexpr bool PERM = true, AFTER_DRAIN = false;
    bf16* C; int ldc;
    __device__ __forceinline__ void operator()(const f32x4 (&acc)[2][2][4][2], const pg8::Unit& u, int wr, int wc, int fr, int fq) const {
        const int row0 = u.pm * 256 + wr * 64 + fr; bf16* base = C + u.pn * 256 + wc * 32 + 8 * fq;
#pragma unroll
        for (int ai = 0; ai < 2; ++ai)
#pragma unroll
            for (int m = 0; m < 4; ++m) { bf16* rp = base + (size_t)(row0 + ai * 128 + m * 16) * ldc;
#pragma unroll
                for (int bj = 0; bj < 2; ++bj) { const f32x4 v0 = acc[ai][bj][m][0], v1 = acc[ai][bj][m][1]; u32x4 w; w.x = pk2(v0[0], v0[1]); w.y = pk2(v0[2], v0[3]); w.z = pk2(v1[0], v1[1]); w.w = pk2(v1[2], v1[3]);
                    *(u32x4*)(rp + bj * 128) = w; } }
    }
};
struct EpiF32 {
    static constexpr bool PERM = true, AFTER_DRAIN = false;
    float* C; int ldc;
    __device__ __forceinline__ void operator()(const f32x4 (&acc)[2][2][4][2], const pg8::Unit& u, int wr, int wc, int fr, int fq) const {
        const int row0 = u.pm * 256 + wr * 64 + fr; float* base = C + u.pn * 256 + wc * 32 + 8 * fq;
#pragma unroll
        for (int ai = 0; ai < 2; ++ai)
#pragma unroll
            for (int m = 0; m < 4; ++m) { float* rp = base + (size_t)(row0 + ai * 128 + m * 16) * ldc;
#pragma unroll
                for (int bj = 0; bj < 2; ++bj) { *(f32x4*)(rp + bj * 128) = acc[ai][bj][m][0]; *(f32x4*)(rp + bj * 128 + 4) = acc[ai][bj][m][1]; } }
    }
};
struct EpiSwiglu {
    static constexpr bool PERM = true, AFTER_DRAIN = false;
    bf16* C;
    __device__ __forceinline__ void operator()(const f32x4 (&acc)[2][2][4][2], const pg8::Unit& u, int wr, int wc, int fr, int fq) const {
        const int row0 = u.pm * 256 + wr * 64 + fr; bf16* base = C + u.pn * 128 + wc * 32 + 8 * fq;
#pragma unroll
        for (int ai = 0; ai < 2; ++ai)
#pragma unroll
            for (int m = 0; m < 4; ++m) { float o[8];
#pragma unroll
                for (int e = 0; e < 8; ++e) { const float g = acc[ai][0][m][e >> 2][e & 3], up = acc[ai][1][m][e >> 2][e & 3]; o[e] = g * sigm(g) * up; }
                u32x4 w; w.x = pk2(o[0], o[1]); w.y = pk2(o[2], o[3]); w.z = pk2(o[4], o[5]); w.w = pk2(o[6], o[7]);
                *(u32x4*)(base + (size_t)(row0 + ai * 128 + m * 16) * FF) = w; }
    }
};
struct EpiMod {
    static constexpr bool PERM = true, AFTER_DRAIN = false;
    float* C; int ldc;
    __device__ __forceinline__ void operator()(const f32x4 (&acc)[2][2][4][2], const pg8::Unit& u, int wr, int wc, int fr, int fq) const {
        if (wr != 0) return;
        float* base = C + u.pn * 256 + wc * 32 + 8 * fq;
#pragma unroll
        for (int m = 0; m < 2; ++m) { const int row = 16 * m + fr; if (row < NSEQ) { float* rp = base + (size_t)row * ldc;
#pragma unroll
            for (int bj = 0; bj < 2; ++bj) { *(f32x4*)(rp + bj * 128) = acc[0][bj][m][0]; *(f32x4*)(rp + bj * 128 + 4) = acc[0][bj][m][1]; } } }
    }
};

__device__ __forceinline__ void transpose_item(const float* __restrict__ W, int K, int N, bf16* WT, int k0, int n0, int dst_row0, float* scr, int lane) {
#pragma unroll 8
    for (int i = 0; i < 32; ++i) { const int kk = 2 * i + (lane >> 5); scr[kk * 33 + (lane & 31)] = W[(size_t)(k0 + kk) * N + n0 + (lane & 31)]; }
    LDS_WAIT();
    const int c = lane & 7;
#pragma unroll
    for (int j = 0; j < 4; ++j) { const int n = (lane >> 3) + 8 * j; const float* s = scr + (8 * c) * 33 + n;
        u32x4 o; o.x = pk2(s[0 * 33], s[1 * 33]); o.y = pk2(s[2 * 33], s[3 * 33]); o.z = pk2(s[4 * 33], s[5 * 33]); o.w = pk2(s[6 * 33], s[7 * 33]);
        *(u32x4*)(WT + (size_t)(dst_row0 + n) * K + k0 + 8 * c) = o; }
    LDS_WAIT();
}

typedef const __attribute__((address_space(4))) f32x2* cf2p;
__device__ __forceinline__ cf2p to_c(const float* p) { return (cf2p)(unsigned long long)p; }
#define DPPF(old, src, ctrl, rmask) __builtin_bit_cast(float, __builtin_amdgcn_update_dpp(__builtin_bit_cast(int, (float)(old)), __builtin_bit_cast(int, (float)(src)), (ctrl), (rmask), 0xF, false))
__device__ __forceinline__ float wave_sum_u(float v) {
    v += DPPF(0.f, v, 0xB1, 0xF); v += DPPF(0.f, v, 0x4E, 0xF); v += DPPF(0.f, v, 0x124, 0xF); v += DPPF(0.f, v, 0x128, 0xF);
    v += DPPF(0.f, v, 0x142, 0xA); v += DPPF(0.f, v, 0x143, 0xC);
    return __builtin_bit_cast(float, __builtin_amdgcn_readlane(__builtin_bit_cast(int, v), 63));
}
constexpr int RW_PF = 6;
template <int MODE>
__device__ __forceinline__ void rwkv_run(f32x2 (&S)[32], const float* W, const float* NKK, const float* B, const float* K, const float* R, const bf16* Vp, int nsteps, int lane,
                                         const bf16* Gp, const float* BONp, bf16* MIXp, float lnw, float lnb) {
    constexpr int NPF = MODE == 2 ? 20 : (MODE == 0 ? 16 : 12);
    const int pa = lane >> 2; const float* pfp = (pa == 0 ? W : pa == 1 ? NKK : pa == 2 ? B : pa == 3 ? K : R) + (lane & 3) * 16;
    float vn = 0.f, gn = 0.f, bn = 0.f;
    if (MODE != 1) vn = bf2f(Vp[lane]);
    if (MODE == 2) { gn = bf2f(Gp[lane]); bn = BONp[0]; }
    if (lane < NPF) {
#pragma unroll
        for (int q = 1; q < RW_PF; ++q) if (q < nsteps) (void)*(volatile const float*)(pfp + (size_t)q * RW);
    }
    for (int t = 0; t < nsteps; ++t) {
        const size_t o = (size_t)t * RW;
        cf2p w = to_c(W + o), nk = to_c(NKK + o), b = to_c(B + o), k = to_c(K + o), r = to_c(R + o);
        const float v = vn, gv = gn, bon = bn;
        { const int t1 = t + 1 < nsteps ? t + 1 : t; const size_t o1 = (size_t)t1 * RW;
          if (MODE != 1) vn = bf2f(Vp[o1 + lane]);
          if (MODE == 2) { gn = bf2f(Gp[o1 + lane]); bn = BONp[(size_t)t1 * 16]; }
          const int tp = t + RW_PF < nsteps ? t + RW_PF : nsteps - 1;
          if (lane < NPF) (void)*(volatile const float*)(pfp + (size_t)tp * RW); }
        f32x2 a0 = {0.f, 0.f}, a1 = {0.f, 0.f};
#pragma unroll
        for (int j = 0; j < 32; j += 2) { a0 = __builtin_elementwise_fma(S[j], nk[j], a0); a1 = __builtin_elementwise_fma(S[j + 1], nk[j + 1], a1); }
        const float sa = (a0.x + a0.y) + (a1.x + a1.y);
        const f32x2 sa2 = {sa, sa}, v2 = {v, v};
        f32x2 o0 = {0.f, 0.f}, o1 = {0.f, 0.f};
#pragma unroll
        for (int j = 0; j < 32; ++j) {
            f32x2 s = S[j] * w[j];
            s = __builtin_elementwise_fma(sa2, b[j], s);
            if (MODE != 1) s = __builtin_elementwise_fma(v2, k[j], s);
            S[j] = s;
            if (MODE == 2) { if (j & 1) o1 = __builtin_elementwise_fma(s, r[j], o1); else o0 = __builtin_elementwise_fma(s, r[j], o0); }
        }
        if (MODE == 2) {
            const float ov = (o0.x + o0.y) + (o1.x + o1.y);
            const float mean = wave_sum_u(ov) * (1.f / 64.f), d = ov - mean, var = wave_sum_u(d * d) * (1.f / 64.f);
            float y = d * rsqrtf(var + 64e-5f) * lnw + lnb;
            y = (y + bon * v) * gv;
            MIXp[(size_t)t * D + lane] = (bf16)f2bf(y);
        }
    }
}

constexpr int RL_B = 8;
template <int MODE> struct RL { static constexpr int NV = MODE == 2 ? 5 : (MODE == 0 ? 4 : 3); static constexpr int REC = NV * 64, BUF = RL_B * REC + (MODE != 1 ? 256 : 0) + (MODE == 2 ? 256 + 16 : 0); };
#define SBAR() __builtin_amdgcn_sched_barrier(0)
template <int MODE>
__device__ __forceinline__ void rwkv_lds(f32x2 (&S)[32], const float* W, const bf16* NKK, const bf16* B, const bf16* K, const bf16* R, const bf16* Vp, int nsteps, int lane,
                                         const bf16* Gp, const float* BONp, bf16* MIXp, float lnw, float lnb, float* wl) {
    constexpr int NV = RL<MODE>::NV, REC = RL<MODE>::REC;
    const int ls = lane >> 4, lc = (lane & 15) * 4;
    f32x4 st[2]; u32x2 sh[NV][2]; u32x4 sv = {0u, 0u, 0u, 0u}, sg = {0u, 0u, 0u, 0u}; float sb = 0.f;
#define RL_ISSUE(bt) do { const size_t ob = (size_t)((bt) * RL_B) * RW; \
        _Pragma("unroll") for (int q = 0; q < 2; ++q) { const size_t oo = ob + (size_t)(ls + 4 * q) * RW + lc; \
            st[q] = *(const f32x4*)(W + oo); sh[1][q] = *(const u32x2*)(NKK + oo); sh[2][q] = *(const u32x2*)(B + oo); if (NV >= 4) sh[NV >= 4 ? 3 : 0][q] = *(const u32x2*)(K + oo); if (NV == 5) sh[NV - 1][q] = *(const u32x2*)(R + oo); } \
        if (MODE != 1) sv = *(const u32x4*)(Vp + ob + (size_t)(lane >> 3) * RW + (lane & 7) * 8); \
        if (MODE == 2) { sg = *(const u32x4*)(Gp + ob + (size_t)(lane >> 3) * RW + (lane & 7) * 8); if (lane < RL_B) sb = BONp[(size_t)((bt) * RL_B + lane) * 16]; } } while (0)
#define RL_COMMIT() do { \
        _Pragma("unroll") for (int q = 0; q < 2; ++q) { *(f32x4*)(wl + (ls + 4 * q) * REC + lc) = st[q]; \
            _Pragma("unroll") for (int v = 1; v < NV; ++v) { const u32x2 pk_ = sh[v][q]; *(f32x4*)(wl + (ls + 4 * q) * REC + v * 64 + lc) = (f32x4){bf2f(pk_.x & 0xffffu), bf2f(pk_.x >> 16), bf2f(pk_.y & 0xffffu), bf2f(pk_.y >> 16)}; } } \
        if (MODE != 1) *(u32x4*)((bf16*)(wl + RL_B * REC) + (lane >> 3) * 64 + (lane & 7) * 8) = sv; \
        if (MODE == 2) { *(u32x4*)((bf16*)(wl + RL_B * REC + 256) + (lane >> 3) * 64 + (lane & 7) * 8) = sg; if (lane < RL_B) wl[RL_B * REC + 512 + lane] = sb; } } while (0)
    const int nb = nsteps / RL_B;
    RL_ISSUE(0); RL_COMMIT();
    for (int bt = 0; bt < nb; ++bt) {
        if (bt + 1 < nb) RL_ISSUE(bt + 1);
#pragma unroll 1
        for (int s = 0; s < RL_B; ++s) {
            const f32x2* w = (const f32x2*)(wl + s * REC); const f32x2* nk = w + 32; const f32x2* b = w + 64; const f32x2* k = w + 96; const f32x2* r = w + 128;
            float v = 0.f, gv = 0.f, bon = 0.f;
            if (MODE != 1) v = bf2f(((const bf16*)(wl + RL_B * REC))[s * 64 + lane]);
            if (MODE == 2) { gv = bf2f(((const bf16*)(wl + RL_B * REC + 256))[s * 64 + lane]); bon = wl[RL_B * REC + 512 + s]; }
            f32x2 nA[8], nB[8]; f32x2 a0 = {0.f, 0.f}, a1 = {0.f, 0.f};
#pragma unroll
            for (int p = 0; p < 8; ++p) nA[p] = nk[p];
#pragma unroll
            for (int g = 0; g < 4; ++g) {
                if (g < 3) {
#pragma unroll
                    for (int p = 0; p < 8; ++p) { if (g & 1) nA[p] = nk[8 * (g + 1) + p]; else nB[p] = nk[8 * (g + 1) + p]; } }
                SBAR();
#pragma unroll
                for (int p = 0; p < 8; p += 2) { a0 = __builtin_elementwise_fma(S[8 * g + p], (g & 1) ? nB[p] : nA[p], a0); a1 = __builtin_elementwise_fma(S[8 * g + p + 1], (g & 1) ? nB[p + 1] : nA[p + 1], a1); }
                SBAR();
            }
            const float sa = (a0.x + a0.y) + (a1.x + a1.y);
            const f32x2 sa2 = {sa, sa}, v2 = {v, v};
            f32x2 uw[2][4], ub[2][4], uk[2][4], ur[2][4]; f32x2 o0 = {0.f, 0.f}, o1 = {0.f, 0.f};
#pragma unroll
            for (int p = 0; p < 4; ++p) { uw[0][p] = w[p]; ub[0][p] = b[p]; if (MODE != 1) uk[0][p] = k[p]; if (MODE == 2) ur[0][p] = r[p]; }
#pragma unroll
            for (int g = 0; g < 8; ++g) {
                if (g < 7) {
#pragma unroll
                    for (int p = 0; p < 4; ++p) { uw[(g + 1) & 1][p] = w[4 * (g + 1) + p]; ub[(g + 1) & 1][p] = b[4 * (g + 1) + p]; if (MODE != 1) uk[(g + 1) & 1][p] = k[4 * (g + 1) + p]; if (MODE == 2) ur[(g + 1) & 1][p] = r[4 * (g + 1) + p]; } }
                SBAR();
#pragma unroll
                for (int p = 0; p < 4; ++p) { const int j = 4 * g + p;
                    f32x2 x = S[j] * uw[g & 1][p]; x = __builtin_elementwise_fma(sa2, ub[g & 1][p], x); if (MODE != 1) x = __builtin_elementwise_fma(v2, uk[g & 1][p], x); S[j] = x;
                    if (MODE == 2) { if (p & 1) o1 = __builtin_elementwise_fma(x, ur[g & 1][p], o1); else o0 = __builtin_elementwise_fma(x, ur[g & 1][p], o0); } }
                SBAR();
            }
            if (MODE == 2) {
                const float ov = (o0.x + o0.y) + (o1.x + o1.y);
                const float mean = wave_sum_u(ov) * (1.f / 64.f), d = ov - mean, var = wave_sum_u(d * d) * (1.f / 64.f);
                float y = d * rsqrtf(var + 64e-5f) * lnw + lnb;
                y = (y + bon * v) * gv;
                MIXp[(size_t)(bt * RL_B + s) * D + lane] = (bf16)f2bf(y);
            }
        }
        if (bt + 1 < nb) RL_COMMIT();
    }
#undef RL_ISSUE
#undef RL_COMMIT
}
#define LAS __attribute__((address_space(3)))

#define XB_TMO      128
#define XB_XCNT(j)  (256  + 64 * (j))
#define XB_XSUB(j)  (1280 + 64 * (j))
#define XB_XGEN(j)  (2304 + 64 * (j))
#define XB_TOP      3328
#define XB_TOPGEN   3392
#define XCD_BAR_WORDS 3456
#define XB_SPIN_CAP (1u << 18)

__device__ __forceinline__ unsigned xb_ld(unsigned* p)              { return __hip_atomic_load(p, __ATOMIC_RELAXED, __HIP_MEMORY_SCOPE_AGENT); }
__device__ __forceinline__ unsigned xb_add(unsigned* p, unsigned v) { return __hip_atomic_fetch_add(p, v, __ATOMIC_RELAXED, __HIP_MEMORY_SCOPE_AGENT); }
__device__ __forceinline__ unsigned xb_xcc_id() { return (unsigned)__builtin_amdgcn_s_getreg((3 << 11) | 20) & 0xFu; }
#define XB_SPIN(cond, bar) do { unsigned _sp = 0; while (cond) { __builtin_amdgcn_s_sleep(1); \
    if ((++_sp & 255u) == 0u) { if (xb_ld(&(bar)[XB_TMO])) break; if (_sp > XB_SPIN_CAP) { atomicAdd(&(bar)[XB_TMO], 1u); break; } } } } while (0)

struct XcdBarrier {
    unsigned* bar; unsigned x;
    volatile LAS unsigned* st;
};

__device__ __forceinline__ XcdBarrier xcd_barrier_post(unsigned* bar, volatile LAS unsigned* st) {
    XcdBarrier b; b.bar = bar; b.x = xb_xcc_id(); b.st = st;
    if (threadIdx.x == 0) (void)xb_add(&bar[XB_XCNT(b.x)], 1u);
    return b;
}
__device__ __forceinline__ void xcd_barrier_complete(unsigned* bar, unsigned x, unsigned& nloc, unsigned& nx) {
    const unsigned G = gridDim.x * gridDim.y * gridDim.z;
    unsigned sum, cnt, mine, sp = 0u;
    for (;;) {
        sum = 0u; cnt = 0u; mine = 0u;
#pragma unroll
        for (unsigned j = 0; j < 16; ++j) { const unsigned c = xb_ld(&bar[XB_XCNT(j)]); sum += c; cnt += (c > 0u) ? 1u : 0u; mine = (j == x) ? c : mine; }
        if (sum == G) break;
        __builtin_amdgcn_s_sleep(1);
        if ((++sp & 255u) == 0u) { if (xb_ld(&bar[XB_TMO])) break; if (sp > XB_SPIN_CAP) { atomicAdd(&bar[XB_TMO], 1u); break; } }
    }
    nloc = mine > 0u ? mine : 1u; nx = cnt > 0u ? cnt : 1u;
}

__device__ __forceinline__ void xcd_barrier(const XcdBarrier& b) {
    asm volatile("s_waitcnt vmcnt(0)" ::: "memory");
    __syncthreads();
    if (threadIdx.x == 0) {
        unsigned* bar = b.bar;
        __builtin_amdgcn_s_waitcnt(0);
        unsigned nloc = b.st[0], nx = b.st[1];
        if (nloc == 0u) { xcd_barrier_complete(bar, b.x, nloc, nx); b.st[0] = nloc; b.st[1] = nx; }
        const unsigned old = xb_add(&bar[XB_XSUB(b.x)], 1u);
        const unsigned gen = old / nloc;
        if (old + 1u == (gen + 1u) * nloc) {
            __builtin_amdgcn_fence(__ATOMIC_RELEASE, "agent");
            asm volatile("s_waitcnt vmcnt(0)" ::: "memory");
            const unsigned og = xb_add(&bar[XB_TOP], 1u);
            const unsigned tg = og / nx;
            if (og + 1u == (tg + 1u) * nx) xb_add(&bar[XB_TOPGEN], 1u);
            else XB_SPIN(xb_ld(&bar[XB_TOPGEN]) == tg, bar);
            __builtin_amdgcn_fence(__ATOMIC_ACQUIRE, "agent");
            xb_add(&bar[XB_XGEN(b.x)], 1u);
            asm volatile("s_waitcnt vmcnt(0)" ::: "memory");
        } else {
            XB_SPIN(xb_ld(&bar[XB_XGEN(b.x)]) == gen, bar);
            __builtin_amdgcn_fence(__ATOMIC_ACQUIRE, "agent");
            asm volatile("s_waitcnt vmcnt(0)" ::: "memory");
        }
    }
    __syncthreads();
}


struct Args { const float* in[30]; float* out; unsigned char* ws; int ph_lo, ph_hi; };
enum { I_XP = 0, I_XS, I_CP, I_CS, I_SSH, I_SWKV, I_SRET, I_ADAW, I_ADAB, I_GPM, I_GPOM, I_GPF, I_GPOF, I_WIN, I_MU, I_W0, I_W2, I_A0, I_A2, I_G2, I_KK, I_KA, I_RK, I_RLW, I_RLB, I_ELW, I_ELB, I_WOUT, I_WUP, I_WDN };

__global__ void __launch_bounds__(512, 2) mk_fwd(Args a) {
    extern __shared__ __attribute__((aligned(16))) unsigned char lds[];
    cg::grid_group grid = cg::this_grid();
    const int tid = threadIdx.x, lane = tid & 63, wave = __builtin_amdgcn_readfirstlane(tid >> 6);
    const int G = gridDim.x, bid = blockIdx.x, gw = bid * 8 + wave, NGW = G * 8;
    const int lo = a.ph_lo, hi = a.ph_hi;
    volatile LAS unsigned* xst = (volatile LAS unsigned*)((LAS unsigned char*)lds + LDS_BYTES - 16);
    if (tid < 2) xst[tid] = 0u;
    __syncthreads();
    XcdBarrier xb = xcd_barrier_post((unsigned*)(a.ws + 65536), xst);
    unsigned char* ws = a.ws; float* out = a.out; unsigned char* dob = (unsigned char*)a.out;
    float* MOD = (float*)(ws + WS_MOD);
    bf16* LORAT = (bf16*)(ws + WS_LORAT); bf16* WOUTT = (bf16*)(ws + WS_WOUTT); bf16* WINT = (bf16*)(ws + WS_WINT); bf16* WUPT = (bf16*)(ws + WS_WUPT); bf16* WDNT = (bf16*)(ws + WS_WDNT);
    bf16* H = (bf16*)(ws + WS_H); bf16* QKVG = (bf16*)(ws + WS_QKVG); bf16* LOUT = (bf16*)(ws + WS_LOUT); bf16* Z = (bf16*)(dob + DO_Z); bf16* LIN = (bf16*)(dob + DO_LIN);
    float* PW = (float*)(ws + WS_PREP); bf16* PNKK = (bf16*)(ws + WS_PREP + PREP_STRIDE); bf16* PB = (bf16*)(ws + WS_PREP + 2 * PREP_STRIDE); bf16* PK = (bf16*)(ws + WS_PREP + 3 * PREP_STRIDE); bf16* PR = (bf16*)(ws + WS_PREP + 4 * PREP_STRIDE);
    bf16* PV = (bf16*)(ws + WS_V); bf16* PG = (bf16*)(ws + WS_G); float* BON = (float*)(ws + WS_BON);
    float* PU = (float*)(ws + WS_PU); bf16* KVB = (bf16*)(ws + WS_KVB); bf16* SPREV = (bf16*)(dob + DO_SPREV); bf16* MIX = (bf16*)(dob + DO_MIX);
    float* MIXOUT = (float*)(ws + WS_MIXOUT); bf16* ACT = (bf16*)(ws + WS_ACT);
#ifndef DUP_PHASE
#define DUP_PHASE -1
#endif
#ifndef PH_MASK
#define PH_MASK 0x3fff
#endif
#define IN(k) (((PH_MASK >> (k)) & 1) && lo <= (k) && (k) < hi)
#ifndef TS_PROBE
#define TS_PROBE -1
#endif
    unsigned long long* TSW = (unsigned long long*)ws;
    if (TS_PROBE >= 0 && bid == 0 && tid == 0) TSW[0] = __builtin_amdgcn_s_memrealtime();
#define MID(n) do { if (TS_PROBE >= 0 && bid == 0) { __syncthreads(); if (tid == 0) TSW[32 + (n)] = __builtin_amdgcn_s_memrealtime(); } } while (0)
#define SEAM(k) do { if (IN(k) && IN((k) + 1)) { if ((k) == 0) grid.sync(); else xcd_barrier(xb); } if (TS_PROBE >= 0 && bid == 0 && tid == 0) TSW[1 + (k)] = __builtin_amdgcn_s_memrealtime(); } while (0)

    if (IN(0)) for (int rep = 0; rep < (DUP_PHASE == 0 ? 2 : 1); ++rep) {
        MID(0);
        float* scr = (float*)lds + wave * (64 * 33 + 16);
        constexpr int IT_WIN = (D / 64) * (IC / 32), IT_WOUT = (D / 64) * (D / 32), IT_ADA = (D / 64) * (MODW / 32);
        bf16* ADAT = (bf16*)(ws + WS_ADAT); bf16* SC = (bf16*)(ws + WS_SC);
        for (int it = gw; it < IT_WIN + IT_WOUT + IT_ADA; it += NGW) {
            if (it < IT_WIN) { const int nb = IC / 32, kb = it / nb, n0 = 32 * (it % nb); transpose_item(a.in[I_WIN], D, IC, WINT, 64 * kb, n0, n0, scr, lane); }
            else if (it < IT_WIN + IT_WOUT) { const int r = it - IT_WIN, nb = D / 32, kb = r / nb, n0 = 32 * (r % nb); transpose_item(a.in[I_WOUT], D, D, WOUTT, 64 * kb, n0, n0, scr, lane); }
            else { const int r = it - IT_WIN - IT_WOUT, nb = MODW / 32, kb = r / nb, n0 = 32 * (r % nb); transpose_item(a.in[I_ADAW], D, MODW, ADAT, 64 * kb, n0, n0, scr, lane); }
        }
        MID(1);
        for (int idx = bid * 512 + tid; idx < 3072 * 256; idx += G * 512) {
            const int n = idx >> 8, k = idx & 255, sec = n >> 10, nn = n & 1023; float v = 0.f;
            if (sec == 0 && k < 64) v = a.in[I_W2][k * RW + nn];
            else if (sec == 1 && k >= 64 && k < 128) v = a.in[I_A2][(k - 64) * RW + nn];
            else if (sec == 2 && k >= 128) v = a.in[I_G2][(k - 128) * RW + nn];
            LORAT[idx] = (bf16)f2bf(v);
        }
        for (int idx = bid * 512 + tid; idx < 256 * D; idx += G * 512) { const int r = idx / D, k = idx % D; float v = 0.f;
            if (r < NSEQ) { const float cv = r == 0 ? a.in[I_CP][k] : a.in[I_CS][(r - 1) * D + k]; v = cv * sigm(cv); }
            SC[idx] = (bf16)f2bf(v); }
        MID(2);
    }
    if (IN(0)) MID(3);
    SEAM(0);
    if (IN(1)) {
        { const int sl = bid / 48; pg8::Gemm g{(const bf16*)(ws + WS_SC) + sl * 512, (const bf16*)(ws + WS_ADAT) + sl * 512, 256, MODW, 512, D}; pg8::OneUnit S{0, bid % 48, bid < 192};
          EpiMod E{(float*)(ws + WS_MODP) + (size_t)sl * NSEQ * MODW, MODW};
          pg8::gemm_phase<EpiMod, pg8::OneUnit, false, true>((PG8_LAS unsigned char*)lds, g, S, E); }
        xcd_barrier(xb);
        const float* MODP = (const float*)(ws + WS_MODP);
        for (int idx = bid * 512 + tid; idx < NSEQ * MODW; idx += G * 512) { float v = a.in[I_ADAB][idx % MODW];
#pragma unroll
            for (int q = 0; q < 4; ++q) v += MODP[(size_t)q * NSEQ * MODW + idx];
            MOD[idx] = v; }
        xcd_barrier(xb);
    }
    if (IN(1)) for (int rep = 0; rep < (DUP_PHASE == 1 ? 2 : 1); ++rep) {
        for (int m = gw; m < M; m += NGW) {
            const float* xr = m < TP ? a.in[I_XP] + (size_t)m * D : a.in[I_XS] + (size_t)(m - TP) * D; const float* mod = MOD + seq_of(m) * MODW;
            f32x4 v[8]; float ss = 0.f;
#pragma unroll
            for (int j = 0; j < 8; ++j) { v[j] = *(const f32x4*)(xr + 4 * lane + 256 * j); ss += (v[j].x * v[j].x + v[j].y * v[j].y) + (v[j].z * v[j].z + v[j].w * v[j].w); }
            const float rs = rsqrtf(wave_sum(ss) * (1.f / D) + 1e-6f);
#pragma unroll
            for (int j = 0; j < 8; ++j) { const int c = 4 * lane + 256 * j; const f32x4 g = *(const f32x4*)(a.in[I_GPM] + c), s1 = *(const f32x4*)(mod + D + c), h1 = *(const f32x4*)(mod + c);
                const f32x4 h = v[j] * rs * g * (s1 + 1.f) + h1; u32x2 w; w.x = pk2(h.x, h.y); w.y = pk2(h.z, h.w); *(u32x2*)(H + (size_t)m * D + c) = w; }
        }
    }
    SEAM(1);
    if (IN(2)) for (int rep = 0; rep < (DUP_PHASE == 2 ? 2 : 1); ++rep) {
        pg8::Gemm g{H, WINT, M, IC, D, D}; pg8::StaticOrder S; S.init(M, IC, G, bid); EpiProj E{Z, QKVG};
        pg8::gemm_phase<EpiProj, pg8::StaticOrder, true, true>((PG8_LAS unsigned char*)lds, g, S, E);
    }
    SEAM(2);
    if (IN(3)) for (int rep = 0; rep < (DUP_PHASE == 3 ? 2 : 1); ++rep) {
        for (int idx = bid * 512 + tid; idx < M * 128; idx += G * 512) {
            const int m = idx >> 7, c2 = (idx & 127) * 2, c = 3072 + c2, tp = tpos_of(m), sq = seq_of(m);
            const unsigned zz = *(const unsigned*)(Z + (size_t)m * RC + c); float z0 = bf2f(zz & 0xffffu), z1 = bf2f(zz >> 16), p0 = 0.f, p1 = 0.f;
            if (tp > 0) { const unsigned pp = *(const unsigned*)(Z + (size_t)(m - 1) * RC + c); p0 = bf2f(pp & 0xffffu); p1 = bf2f(pp >> 16); }
            else if (sq > 0) { p0 = a.in[I_SSH][(size_t)(sq - 1) * RC + c]; p1 = a.in[I_SSH][(size_t)(sq - 1) * RC + c + 1]; }
            z0 = z0 + (p0 - z0) * a.in[I_MU][c]; z1 = z1 + (p1 - z1) * a.in[I_MU][c + 1];
            if (c2 < 64) { z0 = 1.f - 2.f / (__expf(2.f * z0) + 1.f); z1 = 1.f - 2.f / (__expf(2.f * z1) + 1.f); }
            else if (c2 >= 128) { z0 = sigm(z0); z1 = sigm(z1); }
            *(unsigned*)(LIN + (size_t)m * 256 + c2) = pk2(z0, z1);
        }
        for (int idx = bid * 512 + tid; idx < NSEQ * RC; idx += G * 512) { const int s = idx / RC, c = idx % RC; const int m = s == 0 ? TP - 1 : TP + 16 * (s - 1) + 15;
            out[(s == 0 ? O_SHP : O_SHS + (size_t)(s - 1) * RC) + c] = bf2f(Z[(size_t)m * RC + c]); }
    }
    SEAM(3);
    if (IN(4)) for (int rep = 0; rep < (DUP_PHASE == 4 ? 2 : 1); ++rep) {
        int k256 = 256; asm volatile("" : "+s"(k256));
        pg8::Gemm g{LIN, LORAT, M, 3072, k256, k256}; pg8::StaticOrder S; S.init(M, 3072, G, bid); EpiBf16P E{LOUT, 3072};
        pg8::gemm_phase<EpiBf16P, pg8::StaticOrder, true, true>((PG8_LAS unsigned char*)lds, g, S, E);
    }
    SEAM(4);
    if (IN(5)) for (int rep = 0; rep < (DUP_PHASE == 5 ? 2 : 1); ++rep) {
        float* prm = (float*)lds;
        __syncthreads();
        for (int idx = tid; idx < RW; idx += 512) { prm[idx] = a.in[I_MU][idx]; prm[RW + idx] = a.in[I_MU][RW + idx]; prm[2 * RW + idx] = a.in[I_MU][2 * RW + idx]; prm[3 * RW + idx] = a.in[I_W0][idx];
            prm[4 * RW + idx] = a.in[I_A0][idx]; prm[5 * RW + idx] = a.in[I_KK][idx]; prm[6 * RW + idx] = a.in[I_KA][idx]; prm[7 * RW + idx] = a.in[I_RK][idx]; }
        __syncthreads();
        for (int m = gw; m < M; m += NGW) {
            const int tp = tpos_of(m), sq = seq_of(m);
#pragma unroll 1
            for (int hp = 0; hp < 2; ++hp) {
                const int hd = hp * 8 + (lane >> 3), c0 = hd * 64 + (lane & 7) * 8;
                const bf16* zr = Z + (size_t)m * RC + c0; const bf16* lr = LOUT + (size_t)m * 3072 + c0; const float* sh0 = a.in[I_SSH] + (size_t)(sq > 0 ? sq - 1 : 0) * RC + c0;
                float zs[3][8];
#pragma unroll
                for (int q = 0; q < 3; ++q) {
                    const u32x4 ca = *(const u32x4*)(zr + q * RW); float pv[8];
                    if (tp > 0) { const u32x4 pa2 = *(const u32x4*)(zr - RC + q * RW);
#pragma unroll
                        for (int e = 0; e < 4; ++e) { pv[2 * e] = bf2f(pa2[e] & 0xffffu); pv[2 * e + 1] = bf2f(pa2[e] >> 16); } }
                    else if (sq > 0) { const f32x4 f0 = *(const f32x4*)(sh0 + q * RW), f1 = *(const f32x4*)(sh0 + q * RW + 4);
                        pv[0] = f0.x; pv[1] = f0.y; pv[2] = f0.z; pv[3] = f0.w; pv[4] = f1.x; pv[5] = f1.y; pv[6] = f1.z; pv[7] = f1.w; }
                    else {
#pragma unroll
                        for (int e = 0; e < 8; ++e) pv[e] = 0.f; }
                    const float* mu = prm + q * RW + c0;
#pragma unroll
                    for (int e = 0; e < 4; ++e) { const float z0 = bf2f(ca[e] & 0xffffu), z1 = bf2f(ca[e] >> 16);
                        zs[q][2 * e] = z0 + (pv[2 * e] - z0) * mu[2 * e]; zs[q][2 * e + 1] = z1 + (pv[2 * e + 1] - z1) * mu[2 * e + 1]; }
                }
                const u32x4 wa = *(const u32x4*)(lr), aa = *(const u32x4*)(lr + RW), ga = *(const u32x4*)(lr + 2 * RW);
                float wv[8], av[8], kkv[8], k2[8]; float s1 = 0.f, s2 = 0.f;
#pragma unroll
                for (int e = 0; e < 8; ++e) {
                    const float lwv = bf2f((e & 1) ? (wa[e >> 1] >> 16) : (wa[e >> 1] & 0xffffu)), lav = bf2f((e & 1) ? (aa[e >> 1] >> 16) : (aa[e >> 1] & 0xffffu));
                    wv[e] = __expf(-0.6065306597126334f * sigm(prm[3 * RW + c0 + e] + lwv));
                    av[e] = sigm(prm[4 * RW + c0 + e] + lav);
                    kkv[e] = zs[1][e] * prm[5 * RW + c0 + e]; s1 += kkv[e] * kkv[e];
                    k2[e] = zs[1][e] * (1.f + (av[e] - 1.f) * prm[6 * RW + c0 + e]); s2 += zs[0][e] * k2[e] * prm[7 * RW + c0 + e];
                }
                s1 += DPPF(0.f, s1, 0xB1, 0xF); s1 += DPPF(0.f, s1, 0x4E, 0xF); s1 += DPPF(0.f, s1, 0x141, 0xF);
                s2 += DPPF(0.f, s2, 0xB1, 0xF); s2 += DPPF(0.f, s2, 0x4E, 0xF); s2 += DPPF(0.f, s2, 0x141, 0xF);
                const float inrm = 1.f / fmaxf(sqrtf(s1), 1e-12f);
                const size_t o = (size_t)m * RW + c0;
#pragma unroll
                for (int e = 0; e < 2; ++e) {
                    const float k0 = kkv[4 * e] * inrm, k1 = kkv[4 * e + 1] * inrm, k2_ = kkv[4 * e + 2] * inrm, k3 = kkv[4 * e + 3] * inrm;
                    *(f32x4*)(PW + o + 4 * e) = (f32x4){wv[4 * e], wv[4 * e + 1], wv[4 * e + 2], wv[4 * e + 3]};
                    { u32x2 t2; t2.x = pk2(-k0, -k1); t2.y = pk2(-k2_, -k3); *(u32x2*)(PNKK + o + 4 * e) = t2;
                      t2.x = pk2(k0 * av[4 * e], k1 * av[4 * e + 1]); t2.y = pk2(k2_ * av[4 * e + 2], k3 * av[4 * e + 3]); *(u32x2*)(PB + o + 4 * e) = t2;
                      t2.x = pk2(k2[4 * e], k2[4 * e + 1]); t2.y = pk2(k2[4 * e + 2], k2[4 * e + 3]); *(u32x2*)(PK + o + 4 * e) = t2;
                      t2.x = pk2(zs[0][4 * e], zs[0][4 * e + 1]); t2.y = pk2(zs[0][4 * e + 2], zs[0][4 * e + 3]); *(u32x2*)(PR + o + 4 * e) = t2; }
                }
                { u32x4 va;
#pragma unroll
                  for (int e = 0; e < 4; ++e) va[e] = pk2(zs[2][2 * e], zs[2][2 * e + 1]);
                  *(u32x4*)(PV + o) = va; *(u32x4*)(PG + o) = ga; }
                if ((lane & 7) == 0) BON[m * 16 + hd] = s2;
            }
        }
    }
    SEAM(5);
    if (IN(6)) for (int rep = 0; rep < (DUP_PHASE == 6 ? 2 : 1); ++rep) {
        MID(4);
        {
            float* wl = (float*)lds + wave * RL<0>::BUF;
            for (int pair = bid * 4 + (wave & 3); pair < RH * NCH; pair += G * 4) {
                const int part = wave >> 2, h = pair / NCH, c = pair % NCH; const size_t o = (size_t)(c * LCH) * RW + h * 64;
                f32x2 S[32];
                if (part) {
#pragma unroll
                    for (int j = 0; j < 32; ++j) { S[j].x = (2 * j == lane) ? 1.f : 0.f; S[j].y = (2 * j + 1 == lane) ? 1.f : 0.f; }
                    rwkv_lds<1>(S, PW + o, PNKK + o, PB + o, PK + o, PR + o, PV + o, LCH, lane, nullptr, nullptr, nullptr, 0.f, 0.f, wl);
                } else {
#pragma unroll
                    for (int j = 0; j < 32; ++j) S[j] = (f32x2){0.f, 0.f};
                    rwkv_lds<0>(S, PW + o, PNKK + o, PB + o, PK + o, PR + o, PV + o, LCH, lane, nullptr, nullptr, nullptr, 0.f, 0.f, wl);
                }
                float* dst = PU + ((size_t)pair * 2 + (part ? 0 : 1)) * 4096 + lane * 64;
#pragma unroll
                for (int j = 0; j < 16; ++j) *(f32x4*)(dst + 4 * j) = (f32x4){S[2 * j].x, S[2 * j].y, S[2 * j + 1].x, S[2 * j + 1].y};
            }
        }
        __syncthreads();
        MID(5);
        bf16* kT = (bf16*)lds;
        bf16* vT = (bf16*)lds + 256 * 72;
        const int fr = lane & 15, fq = lane >> 4;
        for (int it = bid; it < EH * NRB * 2; it += G) {
            const int half = it & 1, blk = (it >> 1) % NRB, h = (it >> 1) / NRB; const float l2g = ret_l2g(h); const int m0 = blk * RBLK;
            f32x4 acc[2][8];
#pragma unroll
            for (int x = 0; x < 2; ++x)
#pragma unroll
                for (int y = 0; y < 8; ++y) acc[x][y] = (f32x4){0.f, 0.f, 0.f, 0.f};
            for (int ts = 0; ts < 4; ++ts) {
                __syncthreads();
#pragma unroll
                for (int i = 0; i < 4; ++i) { const int t = lane, dp = wave + 8 * i; const u32x4 raw = *(const u32x4*)(QKVG + (size_t)(m0 + ts * 64 + t) * EC + 1024 + h * 256 + dp * 8);
                    const float dec = exp2f(l2g * (float)(255 - (ts * 64 + t)));
#pragma unroll
                    for (int e = 0; e < 4; ++e) { const unsigned w = raw[e]; kT[(dp * 8 + 2 * e) * 72 + t] = (bf16)f2bf(bf2f(w & 0xffffu) * dec); kT[(dp * 8 + 2 * e + 1) * 72 + t] = (bf16)f2bf(bf2f(w >> 16) * dec); } }
#pragma unroll
                for (int i = 0; i < 2; ++i) { const int t = lane, ep = wave + 8 * i; const u32x4 raw = *(const u32x4*)(QKVG + (size_t)(m0 + ts * 64 + t) * EC + 2048 + h * 256 + half * 128 + ep * 8);
#pragma unroll
                    for (int e = 0; e < 4; ++e) { const unsigned w = raw[e]; vT[(ep * 8 + 2 * e) * 72 + t] = (bf16)(w & 0xffffu); vT[(ep * 8 + 2 * e + 1) * 72 + t] = (bf16)(w >> 16); } }
                __syncthreads();
#pragma unroll
                for (int kk = 0; kk < 2; ++kk) { bf16x8 af[2];
#pragma unroll
                    for (int x = 0; x < 2; ++x) af[x] = *(const bf16x8*)(kT + (32 * wave + 16 * x + fr) * 72 + kk * 32 + fq * 8);
#pragma unroll
                    for (int y = 0; y < 8; ++y) { const bf16x8 bfm = *(const bf16x8*)(vT + (16 * y + fr) * 72 + kk * 32 + fq * 8);
#pragma unroll
                        for (int x = 0; x < 2; ++x) acc[x][y] = __builtin_amdgcn_mfma_f32_16x16x32_bf16(af[x], bfm, acc[x][y], 0, 0, 0); } }
            }
            bf16* dst = KVB + ((size_t)(h * NRB + blk) * 256) * 256;
#pragma unroll
            for (int x = 0; x < 2; ++x)
#pragma unroll
                for (int y = 0; y < 8; ++y) { u32x2 w; w.x = pk2(acc[x][y][0], acc[x][y][1]); w.y = pk2(acc[x][y][2], acc[x][y][3]);
                    *(u32x2*)(dst + (size_t)(half * 128 + 16 * y + fr) * 256 + 32 * wave + 16 * x + fq * 4) = w; }
        }
    }
    if (IN(6)) MID(6);
    SEAM(6);
    if (IN(7)) for (int rep = 0; rep < (DUP_PHASE == 7 ? 2 : 1); ++rep) {
        const int nB = RH * 4;
        if (bid < nB || G <= nB) {
            float* Sb = (float*)lds;
            const int fr = lane & 15, fq = lane >> 4;
            for (int it = bid; it < nB; it += G) {
                const int h = it >> 2, g4 = it & 3; float* pu = PU + (size_t)(h * NCH) * 2 * 4096;
                __syncthreads();
                for (int idx = tid; idx < 16 * 65; idx += 512) Sb[idx] = 0.f;
                __syncthreads();
                if (wave < 4) {
                    float pa[16], pb[16]; f32x4 ua, ub;
#define PB_LOAD(dst, du, c) do { const float* pp = pu + (size_t)(c) * 2 * 4096; _Pragma("unroll") for (int kk = 0; kk < 16; ++kk) dst[kk] = pp[(4 * kk + fq) * 64 + 16 * wave + fr]; \
                        _Pragma("unroll") for (int jj = 0; jj < 4; ++jj) du[jj] = pp[4096 + (16 * g4 + 4 * fq + jj) * 64 + 16 * wave + fr]; } while (0)
                    PB_LOAD(pa, ua, 0); PB_LOAD(pb, ub, 1);
                    for (int c = 0; c < NCH; ++c) {
                        const float* Sc = Sb + (c & 1) * (16 * 65); float* Sn = Sb + ((c + 1) & 1) * (16 * 65);
                        f32x4 acc = ua, ac1 = {0.f, 0.f, 0.f, 0.f}, ac2 = ac1, ac3 = ac1;
#pragma unroll
                        for (int kk = 0; kk < 16; kk += 4) { acc = __builtin_amdgcn_mfma_f32_16x16x4f32(Sc[fr * 65 + 4 * kk + fq], pa[kk], acc, 0, 0, 0);
                            ac1 = __builtin_amdgcn_mfma_f32_16x16x4f32(Sc[fr * 65 + 4 * (kk + 1) + fq], pa[kk + 1], ac1, 0, 0, 0);
                            ac2 = __builtin_amdgcn_mfma_f32_16x16x4f32(Sc[fr * 65 + 4 * (kk + 2) + fq], pa[kk + 2], ac2, 0, 0, 0);
                            ac3 = __builtin_amdgcn_mfma_f32_16x16x4f32(Sc[fr * 65 + 4 * (kk + 3) + fq], pa[kk + 3], ac3, 0, 0, 0); }
                        acc = (acc + ac1) + (ac2 + ac3);
#pragma unroll
                        for (int jj = 0; jj < 4; ++jj) { Sn[(4 * fq + jj) * 65 + 16 * wave + fr] = acc[jj]; pu[(size_t)c * 2 * 4096 + 4096 + (16 * g4 + 4 * fq + jj) * 64 + 16 * wave + fr] = acc[jj]; }
                        if (c + 1 == NCH) {
#pragma unroll
                            for (int jj = 0; jj < 4; ++jj) out[O_WKP + (size_t)h * 4096 + (16 * g4 + 4 * fq + jj) * 64 + 16 * wave + fr] = acc[jj]; }
#pragma unroll
                        for (int kk = 0; kk < 16; ++kk) pa[kk] = pb[kk];
                        ua = ub;
                        if (c + 2 < NCH) PB_LOAD(pb, ub, c + 2);
                        asm volatile("s_waitcnt lgkmcnt(0)" ::: "memory");
                        __builtin_amdgcn_s_barrier();
                    }
#undef PB_LOAD
                } else {
                    for (int c = 0; c < NCH; ++c) __builtin_amdgcn_s_barrier();
                }
            }
        }
        if (bid >= nB || G <= nB) {
            const int nb2 = G <= nB ? G : G - nB, b2 = G <= nB ? bid : bid - nB;
            for (int it = b2 * 512 + tid; it < EH * 256 * 32; it += nb2 * 512) {
                const int h = it >> 13, e = (it >> 5) & 255, d0 = (it & 31) * 8; const float g256 = exp2f(256.f * ret_l2g(h));
                float acc[8];
#pragma unroll
                for (int q = 0; q < 8; ++q) acc[q] = 0.f;
                u32x4 kvr[NRB];
#pragma unroll
                for (int blk = 0; blk < NRB; ++blk) kvr[blk] = *(const u32x4*)(KVB + ((size_t)(h * NRB + blk) * 256 + e) * 256 + d0);
#pragma unroll
                for (int blk = 0; blk < NRB; ++blk) {
                    const size_t o = ((size_t)(h * NRB + blk) * 256 + e) * 256 + d0;
                    u32x4 w; w.x = pk2(acc[0], acc[1]); w.y = pk2(acc[2], acc[3]); w.z = pk2(acc[4], acc[5]); w.w = pk2(acc[6], acc[7]); *(u32x4*)(SPREV + o) = w;
                    const u32x4 kv = kvr[blk];
#pragma unroll
                    for (int q = 0; q < 4; ++q) { acc[2 * q] = acc[2 * q] * g256 + bf2f(kv[q] & 0xffffu); acc[2 * q + 1] = acc[2 * q + 1] * g256 + bf2f(kv[q] >> 16); }
                }
#pragma unroll
                for (int q = 0; q < 8; ++q) out[O_RTP + (size_t)h * 65536 + (size_t)(d0 + q) * 256 + e] = acc[q];
            }
            asm volatile("s_waitcnt vmcnt(0)" ::: "memory");
            __syncthreads();
            if (tid == 0) {
                unsigned* cw = (unsigned*)(a.ws + 65536) + XCD_BAR_WORDS + 64;
                __builtin_amdgcn_fence(__ATOMIC_RELEASE, "agent");
                asm volatile("s_waitcnt vmcnt(0)" ::: "memory");
                (void)xb_add(cw, 1u);
            }
        }
        {
            const int nscan = G <= nB ? G : G - nB;
            unsigned* cw = (unsigned*)(a.ws + 65536) + XCD_BAR_WORDS + 64; unsigned* cq = cw + 32;
            if (tid == 0) {
                unsigned sp = 0u; while (xb_ld(cw) < (unsigned)nscan) { __builtin_amdgcn_s_sleep(1); if (++sp > (1u << 22)) break; }
                __builtin_amdgcn_fence(__ATOMIC_ACQUIRE, "agent");
                asm volatile("s_waitcnt vmcnt(0)" ::: "memory");
            }
            __syncthreads();
            {
                const int fr = lane & 15, fq = lane >> 4;
                for (;;) {
                    __syncthreads();
                    if (tid == 0) xst[2] = xb_add(cq, 1u);
                    __syncthreads();
                    const int qi = (int)xst[2];
                    if (qi >= EH * (TP / 64)) break;
                    const int it = ((qi & 127) >> 5) * (TP / 64) + (qi & 31) * 4 + (3 - (qi >> 7));
                    {
                    const int h = it / (TP / 64), n = it % (TP / 64), blk = n >> 2, i = n & 3, m0 = n * 64; const float l2g = ret_l2g(h);
                    bf16* qL = (bf16*)lds; bf16* kL = qL + 64 * 264; bf16* vT = kL + 64 * 264; bf16* pL = vT + 256 * 72; float* red = (float*)(pL + 64 * 72);
#pragma unroll
                    for (int x = 0; x < 4; ++x) { const int p = tid + 512 * x, t = p >> 5, dp = p & 31; *(u32x4*)(qL + t * 264 + dp * 8) = *(const u32x4*)(QKVG + (size_t)(m0 + t) * EC + h * 256 + dp * 8); }
                    u32x4 kr[4], vr[4];
#define R3_LOADKV(jn) do { const int ms_ = (blk * 4 + (jn)) * 64; \
        _Pragma("unroll") for (int x = 0; x < 4; ++x) { const int p = tid + 512 * x; kr[x] = *(const u32x4*)(QKVG + (size_t)(ms_ + (p >> 5)) * EC + 1024 + h * 256 + (p & 31) * 8); \
            vr[x] = *(const u32x4*)(QKVG + (size_t)(ms_ + lane) * EC + 2048 + h * 256 + (wave + 8 * x) * 8); } } while (0)
                    R3_LOADKV(0);
                    __syncthreads();
                    f32x4 acc[4][2];
#pragma unroll
                    for (int x = 0; x < 4; ++x)
#pragma unroll
                        for (int y = 0; y < 2; ++y) acc[x][y] = (f32x4){0.f, 0.f, 0.f, 0.f};
                    if (blk > 0) {
                        const bf16* sp = SPREV + ((size_t)(h * NRB + blk) * 256) * 256;
#pragma unroll 2
                        for (int kk = 0; kk < 8; ++kk) { bf16x8 bfm[2];
#pragma unroll
                            for (int y = 0; y < 2; ++y) bfm[y] = *(const bf16x8*)(sp + (size_t)(32 * wave + 16 * y + fr) * 256 + kk * 32 + fq * 8);
#pragma unroll
                            for (int x = 0; x < 4; ++x) { const bf16x8 af = *(const bf16x8*)(qL + (16 * x + fr) * 264 + kk * 32 + fq * 8);
#pragma unroll
                                for (int y = 0; y < 2; ++y) acc[x][y] = __builtin_amdgcn_mfma_f32_16x16x32_bf16(af, bfm[y], acc[x][y], 0, 0, 0); } }
#pragma unroll
                        for (int x = 0; x < 4; ++x)
#pragma unroll
                            for (int jj = 0; jj < 4; ++jj) { const float qd = exp2f(l2g * (float)(64 * i + 16 * x + fq * 4 + jj + 1)); acc[x][0][jj] *= qd; acc[x][1][jj] *= qd; }
                    }
                    for (int j = 0; j <= i; ++j) {
                        __syncthreads();
#pragma unroll
                        for (int x = 0; x < 4; ++x) { const int p = tid + 512 * x, t = p >> 5, dp = p & 31; *(u32x4*)(kL + t * 264 + dp * 8) = kr[x]; }
#pragma unroll
                        for (int x = 0; x < 4; ++x) { const int t = lane, dp = wave + 8 * x;
                            const u32x4 raw = vr[x];
#pragma unroll
                            for (int e = 0; e < 4; ++e) { const unsigned w = raw[e]; vT[(dp * 8 + 2 * e) * 72 + t] = (bf16)(w & 0xffffu); vT[(dp * 8 + 2 * e + 1) * 72 + t] = (bf16)(w >> 16); } }
                        if (j < i) R3_LOADKV(j + 1);
                        __syncthreads();
                        { const int tr = wave >> 1, tc0 = (wave & 1) * 2; f32x4 sa[2] = {(f32x4){0.f, 0.f, 0.f, 0.f}, (f32x4){0.f, 0.f, 0.f, 0.f}};
#pragma unroll
                            for (int kk = 0; kk < 8; ++kk) { const bf16x8 af = *(const bf16x8*)(qL + (16 * tr + fr) * 264 + kk * 32 + fq * 8);
#pragma unroll
                                for (int y = 0; y < 2; ++y) { const bf16x8 bfm = *(const bf16x8*)(kL + (16 * (tc0 + y) + fr) * 264 + kk * 32 + fq * 8); sa[y] = __builtin_amdgcn_mfma_f32_16x16x32_bf16(af, bfm, sa[y], 0, 0, 0); } }
#pragma unroll
                            for (int y = 0; y < 2; ++y)
#pragma unroll
                                for (int jj = 0; jj < 4; ++jj) { const int t = 16 * tr + fq * 4 + jj, s = 16 * (tc0 + y) + fr; const int dist = (j < i) ? 64 * (i - j) + t - s : (t > s ? t - s : s - t);
                                    pL[t * 72 + s] = (bf16)f2bf(sa[y][jj] * exp2f(l2g * (float)dist)); } }
                        __syncthreads();
#pragma unroll
                        for (int kk = 0; kk < 2; ++kk) { bf16x8 bfm[2];
#pragma unroll
                            for (int y = 0; y < 2; ++y) bfm[y] = *(const bf16x8*)(vT + (32 * wave + 16 * y + fr) * 72 + kk * 32 + fq * 8);
#pragma unroll
                            for (int x = 0; x < 4; ++x) { const bf16x8 af = *(const bf16x8*)(pL + (16 * x + fr) * 72 + kk * 32 + fq * 8);
#pragma unroll
                                for (int y = 0; y < 2; ++y) acc[x][y] = __builtin_amdgcn_mfma_f32_16x16x32_bf16(af, bfm[y], acc[x][y], 0, 0, 0); } }
                    }
#undef R3_LOADKV
                    const int et = tid >> 3, e0 = (tid & 7) * 32;
                    u32x4 g4[4];
#pragma unroll
                    for (int q4 = 0; q4 < 4; ++q4) g4[q4] = *(const u32x4*)(QKVG + (size_t)(m0 + et) * EC + 3072 + h * 256 + e0 + 8 * q4);
                    __syncthreads();
                    float* OT = (float*)lds;
#pragma unroll
                    for (int x = 0; x < 4; ++x)
#pragma unroll
                        for (int y = 0; y < 2; ++y)
#pragma unroll
                            for (int jj = 0; jj < 4; ++jj) OT[(16 * x + fq * 4 + jj) * 260 + 32 * wave + 16 * y + fr] = acc[x][y][jj];
                    __syncthreads();
                    f32x4 ov[8]; float s1 = 0.f, s2 = 0.f;
#pragma unroll
                    for (int q8 = 0; q8 < 8; ++q8) { ov[q8] = *(const f32x4*)(OT + et * 260 + e0 + 4 * q8); s1 += (ov[q8].x + ov[q8].y) + (ov[q8].z + ov[q8].w);
                        s2 += (ov[q8].x * ov[q8].x + ov[q8].y * ov[q8].y) + (ov[q8].z * ov[q8].z + ov[q8].w * ov[q8].w); }
                    s1 += DPPF(0.f, s1, 0xB1, 0xF); s1 += DPPF(0.f, s1, 0x4E, 0xF); s1 += DPPF(0.f, s1, 0x141, 0xF);
                    s2 += DPPF(0.f, s2, 0xB1, 0xF); s2 += DPPF(0.f, s2, 0x4E, 0xF); s2 += DPPF(0.f, s2, 0x141, 0xF);
                    const float mean = s1 * (1.f / 256.f), var = s2 * (1.f / 256.f) - mean * mean, rstd = rsqrtf(var + 1e-5f);
                    const float* lwp = a.in[I_ELW] + h * 256 + e0; const float* lbp = a.in[I_ELB] + h * 256 + e0;
                    bf16* mp = MIX + (size_t)(m0 + et) * D + RW + h * 256 + e0;
#pragma unroll
                    for (int q4 = 0; q4 < 4; ++q4) { float o8[8];
#pragma unroll
                        for (int hh = 0; hh < 2; ++hh) { const f32x4 w4 = *(const f32x4*)(lwp + 8 * q4 + 4 * hh), b4 = *(const f32x4*)(lbp + 8 * q4 + 4 * hh); const f32x4 vv = ov[2 * q4 + hh];
                            const unsigned ga = g4[q4][2 * hh], gb = g4[q4][2 * hh + 1]; const float t0 = bf2f(ga & 0xffffu), t1 = bf2f(ga >> 16), t2 = bf2f(gb & 0xffffu), t3 = bf2f(gb >> 16);
                            o8[4 * hh] = ((vv.x - mean) * rstd * w4.x + b4.x) * t0 * sigm(t0); o8[4 * hh + 1] = ((vv.y - mean) * rstd * w4.y + b4.y) * t1 * sigm(t1);
                            o8[4 * hh + 2] = ((vv.z - mean) * rstd * w4.z + b4.z) * t2 * sigm(t2); o8[4 * hh + 3] = ((vv.w - mean) * rstd * w4.w + b4.w) * t3 * sigm(t3); }
                        u32x4 w; w.x = pk2(o8[0], o8[1]); w.y = pk2(o8[2], o8[3]); w.z = pk2(o8[4], o8[5]); w.w = pk2(o8[6], o8[7]); *(u32x4*)(mp + 8 * q4) = w; }

                    }
                }
            }
        }
    }
    if (IN(7)) MID(10);
    SEAM(7);
    if (IN(8)) for (int rep = 0; rep < (DUP_PHASE == 8 ? 2 : 1); ++rep) {
        MID(7);
        if (wave < 5) {
            float* wl = (float*)lds + wave * RL<2>::BUF;
            const int ntask = wave < 4 ? RH * NCH : NB * RH;
            for (int task = wave < 4 ? bid * 4 + wave : bid; task < ntask; task += (wave < 4 ? G * 4 : G)) {
                f32x2 S[32]; int h, m0, nsteps; float* sdst = nullptr;
                if (wave < 4) { h = task / NCH; const int c = task % NCH; m0 = c * LCH; nsteps = LCH;
                    if (c == 0) {
#pragma unroll
                        for (int j = 0; j < 32; ++j) S[j] = (f32x2){0.f, 0.f};
                    } else { const float* src = PU + ((size_t)(h * NCH + c - 1) * 2 + 1) * 4096 + lane * 64;
#pragma unroll
                        for (int j = 0; j < 16; ++j) { const f32x4 q = *(const f32x4*)(src + 4 * j); S[2 * j] = (f32x2){q.x, q.y}; S[2 * j + 1] = (f32x2){q.z, q.w}; } }
                } else { const int b = task / RH; h = task % RH; m0 = TP + 16 * b; nsteps = TS;
                    const float* src = a.in[I_SWKV] + ((size_t)(b * RH + h) * 64 + lane) * 64; sdst = out + O_WKS + ((size_t)(b * RH + h) * 64 + lane) * 64;
#pragma unroll
                    for (int j = 0; j < 16; ++j) { const f32x4 q = *(const f32x4*)(src + 4 * j); S[2 * j] = (f32x2){q.x, q.y}; S[2 * j + 1] = (f32x2){q.z, q.w}; } }
                const size_t o = (size_t)m0 * RW + h * 64;
                rwkv_lds<2>(S, PW + o, PNKK + o, PB + o, PK + o, PR + o, PV + o, nsteps, lane, PG + o, BON + (size_t)m0 * 16 + h, MIX + (size_t)m0 * D + h * 64,
                            a.in[I_RLW][h * 64 + lane], a.in[I_RLB][h * 64 + lane], wl);
                if (sdst) {
#pragma unroll
                    for (int j = 0; j < 16; ++j) *(f32x4*)(sdst + 4 * j) = (f32x4){S[2 * j].x, S[2 * j].y, S[2 * j + 1].x, S[2 * j + 1].y}; }
            }
        }
        MID(8);
        {
            const int nb2 = G, b2 = bid;
            const int fr = lane & 15, fq = lane >> 4;
            for (int it0 = b2; it0 < NB * EH * 4; it0 += nb2) {
                const int it = EH * (TP / 64) + it0;
                __syncthreads();
#ifndef NO_RS
                {
                    const int r = it - EH * (TP / 64), tq = r & 3, b = (r >> 2) / EH, h = (r >> 2) % EH, m0 = TP + 16 * b; const float l2g = ret_l2g(h);
                    float* qf = (float*)lds; float* kf = qf + 4 * 260; float* vf = kf + 16 * 257; float* pf = vf + 16 * 257; float* red = pf + 64;
                    for (int idx = tid; idx < 16 * 256; idx += 512) { const int t = idx >> 8, dd = idx & 255; const bf16* src = QKVG + (size_t)(m0 + t) * EC + h * 256 + dd;
                        if ((t >> 2) == tq) qf[(t & 3) * 260 + dd] = bf2f(src[0]);
                        kf[t * 257 + dd] = bf2f(src[1024]); vf[t * 257 + dd] = bf2f(src[2048]); }
                    __syncthreads();
                    if (tid < 64) { const int tl = tid >> 4, s = tid & 15, t = 4 * tq + tl; float sc = 0.f;
#pragma unroll 4
                        for (int dd = 0; dd < 256; ++dd) sc += qf[tl * 260 + dd] * kf[s * 257 + dd];
                        pf[tl * 16 + s] = sc * exp2f(l2g * (float)(t > s ? t - s : s - t)); }
                    __syncthreads();
                    const int e = tid & 255, th = tid >> 8; const float* S0 = a.in[I_SRET] + (size_t)(b * EH + h) * 65536;
                    float oc[2] = {0.f, 0.f};
#pragma unroll 4
                    for (int dd = 0; dd < 256; dd += 4) { const f32x4 qa = *(const f32x4*)(qf + (2 * th) * 260 + dd), qb = *(const f32x4*)(qf + (2 * th + 1) * 260 + dd);
                        const float s0 = S0[(size_t)dd * 256 + e], s1 = S0[(size_t)(dd + 1) * 256 + e], s2 = S0[(size_t)(dd + 2) * 256 + e], s3 = S0[(size_t)(dd + 3) * 256 + e];
                        oc[0] += qa.x * s0 + qa.y * s1 + qa.z * s2 + qa.w * s3; oc[1] += qb.x * s0 + qb.y * s1 + qb.z * s2 + qb.w * s3; }
#pragma unroll
                    for (int tt = 0; tt < 2; ++tt) { const int tl = 2 * th + tt, t = 4 * tq + tl; float v = oc[tt] * exp2f(l2g * (float)(t + 1));
#pragma unroll 4
                        for (int s = 0; s < 16; ++s) v += pf[tl * 16 + s] * vf[s * 257 + e];
                        oc[tt] = v; }
                    { const float g16 = exp2f(16.f * l2g); float* dst = out + O_RTS + (size_t)(b * EH + h) * 65536; float vd[16];
#pragma unroll
                        for (int t = 0; t < 16; ++t) vd[t] = vf[t * 257 + e] * exp2f(l2g * (float)(15 - t));
#pragma unroll 4
                        for (int dd = 64 * tq + 32 * th; dd < 64 * tq + 32 * th + 32; ++dd) { float v = g16 * S0[(size_t)dd * 256 + e];
#pragma unroll
                            for (int t = 0; t < 16; ++t) v += kf[t * 257 + dd] * vd[t];
                            dst[(size_t)dd * 256 + e] = v; } }
#pragma unroll
                    for (int tt = 0; tt < 2; ++tt) { const float s1 = wave_sum(oc[tt]), s2 = wave_sum(oc[tt] * oc[tt]); if (lane == 0) { const int tl = 2 * th + tt; red[(tl * 4 + (wave & 3)) * 2] = s1; red[(tl * 4 + (wave & 3)) * 2 + 1] = s2; } }
                    __syncthreads();
                    const float lw = a.in[I_ELW][h * 256 + e], lb = a.in[I_ELB][h * 256 + e];
#pragma unroll
                    for (int tt = 0; tt < 2; ++tt) { const int tl = 2 * th + tt, t = 4 * tq + tl; float s1 = 0.f, s2 = 0.f;
#pragma unroll
                        for (int w4 = 0; w4 < 4; ++w4) { s1 += red[(tl * 4 + w4) * 2]; s2 += red[(tl * 4 + w4) * 2 + 1]; }
                        const float mean = s1 * (1.f / 256.f), var = s2 * (1.f / 256.f) - mean * mean, rstd = rsqrtf(var + 1e-5f);
                        const float gt = bf2f(QKVG[(size_t)(m0 + t) * EC + 3072 + h * 256 + e]);
                        MIX[(size_t)(m0 + t) * D + RW + h * 256 + e] = (bf16)f2bf(((oc[tt] - mean) * rstd * lw + lb) * gt * sigm(gt)); }
                }
#else
                {}
#endif
            }
        }
    }
    if (IN(8)) MID(9);
    SEAM(8);
    if (IN(9)) for (int rep = 0; rep < (DUP_PHASE == 9 ? 2 : 1); ++rep) {
        { pg8::Gemm g{MIX, WOUTT, TP, D, D, D}; pg8::StaticOrder S; S.init(TP, D, G, bid); EpiBf16P E{(bf16*)MIXOUT, D};
          pg8::gemm_phase<EpiBf16P, pg8::StaticOrder, true, true>((PG8_LAS unsigned char*)lds, g, S, E); }
        { const int sl = bid >> 3; pg8::Gemm g{MIX + (size_t)TP * D + sl * 512, WOUTT + sl * 512, MS, D, 512, D}; pg8::OneUnit S{0, bid & 7, bid < 8 * KS9}; EpiF32 E{(float*)(ws + WS_PART9) + (size_t)sl * MS * D, D};
          pg8::gemm_phase<EpiF32, pg8::OneUnit, false, true>((PG8_LAS unsigned char*)lds, g, S, E); }
        if (G > 8 * KS9 && bid >= 8 * KS9) {
            float* scr = (float*)lds + wave * (64 * 33 + 16);
            for (int r = (bid - 8 * KS9) * 8 + wave; r < (FF / 64) * (D / 32); r += (G - 8 * KS9) * 8) { const int nb = D / 32, kb = r / nb, n0 = 32 * (r % nb); transpose_item(a.in[I_WDN], FF, D, WDNT, 64 * kb, n0, n0, scr, lane); }
        }
    }
    SEAM(9);
    if (IN(10)) for (int rep = 0; rep < (DUP_PHASE == 10 ? 2 : 1); ++rep) {
        for (int m = gw; m < M; m += NGW) {
            const float* xr = m < TP ? a.in[I_XP] + (size_t)m * D : a.in[I_XS] + (size_t)(m - TP) * D; const float* mod = MOD + seq_of(m) * MODW; const float* mr = MIXOUT + (size_t)m * D;
            f32x4 v[8]; float ss = 0.f;
#pragma unroll
            for (int j = 0; j < 8; ++j) {
                if (m < TP) { const u32x2 rw = *(const u32x2*)((const bf16*)MIXOUT + (size_t)m * D + 4 * lane + 256 * j); v[j] = (f32x4){bf2f(rw.x & 0xffffu), bf2f(rw.x >> 16), bf2f(rw.y & 0xffffu), bf2f(rw.y >> 16)}; }
                else { const float* pr = (const float*)(ws + WS_PART9) + (size_t)(m - TP) * D + 4 * lane + 256 * j; v[j] = *(const f32x4*)pr;
#pragma unroll
                    for (int q = 1; q < KS9; ++q) v[j] += *(const f32x4*)(pr + (size_t)q * MS * D); }
                ss += (v[j].x * v[j].x + v[j].y * v[j].y) + (v[j].z * v[j].z + v[j].w * v[j].w); }
            const float rs = rsqrtf(wave_sum(ss) * (1.f / D) + 1e-6f); float s2 = 0.f;
#pragma unroll
            for (int j = 0; j < 8; ++j) { const int c = 4 * lane + 256 * j; const f32x4 g = *(const f32x4*)(a.in[I_GPOM] + c), gt = *(const f32x4*)(mod + 2 * D + c), x = *(const f32x4*)(xr + c);
                v[j] = x + gt * (v[j] * rs * g); *(f32x4*)(out + (size_t)m * D + c) = v[j]; s2 += (v[j].x * v[j].x + v[j].y * v[j].y) + (v[j].z * v[j].z + v[j].w * v[j].w); }
            const float rs2 = rsqrtf(wave_sum(s2) * (1.f / D) + 1e-6f);
#pragma unroll
            for (int j = 0; j < 8; ++j) { const int c = 4 * lane + 256 * j; const f32x4 g = *(const f32x4*)(a.in[I_GPF] + c), s1 = *(const f32x4*)(mod + 4 * D + c), h1 = *(const f32x4*)(mod + 3 * D + c);
                const f32x4 h = v[j] * rs2 * g * (s1 + 1.f) + h1; u32x2 w; w.x = pk2(h.x, h.y); w.y = pk2(h.z, h.w); *(u32x2*)(H + (size_t)m * D + c) = w; }
        }
        float* scr = (float*)lds + wave * (64 * 33 + 16);
        constexpr int IT_UP = (D / 64) * (2 * FF / 32), IT_DN = (FF / 64) * (D / 32);
        for (int it = gw; it < IT_UP + (G > 8 * KS9 ? 0 : IT_DN); it += NGW) {
            if (it < IT_UP) { const int nb = 2 * FF / 32, kb = it / nb, n0 = 32 * (it % nb); const int nn = n0 < FF ? n0 : n0 - FF; const int dr = 256 * (nn >> 7) + (n0 < FF ? 0 : 128) + (nn & 127);
                transpose_item(a.in[I_WUP], D, 2 * FF, WUPT, 64 * kb, n0, dr, scr, lane); }
            else { const int r = it - IT_UP, nb = D / 32, kb = r / nb, n0 = 32 * (r % nb); transpose_item(a.in[I_WDN], FF, D, WDNT, 64 * kb, n0, n0, scr, lane); }
        }
    }
    SEAM(10);
    if (IN(11)) for (int rep = 0; rep < (DUP_PHASE == 11 ? 2 : 1); ++rep) {
        pg8::Gemm g{H, WUPT, M, 2 * FF, D, D}; pg8::StaticOrder S; S.init(M, 2 * FF, G, bid); EpiSwiglu E{ACT};
        pg8::gemm_phase<EpiSwiglu, pg8::StaticOrder, true, true>((PG8_LAS unsigned char*)lds, g, S, E);
    }
    SEAM(11);
    if (IN(12)) for (int rep = 0; rep < (DUP_PHASE == 12 ? 2 : 1); ++rep) {
        { pg8::Gemm g{ACT, WDNT, TP, D, FF, FF}; pg8::StaticOrder S; S.init(TP, D, G, bid); EpiBf16P E{(bf16*)MIXOUT, D};
          pg8::gemm_phase<EpiBf16P, pg8::StaticOrder, true, true>((PG8_LAS unsigned char*)lds, g, S, E); }
        { const int sl = bid >> 3; pg8::Gemm g{ACT + (size_t)TP * FF + sl * 512, WDNT + sl * 512, MS, D, 512, FF}; pg8::OneUnit S{0, bid & 7, bid < 8 * KS12}; EpiF32 E{(float*)(ws + WS_PART12) + (size_t)sl * MS * D, D};
          pg8::gemm_phase<EpiF32, pg8::OneUnit, false, true>((PG8_LAS unsigned char*)lds, g, S, E); }
    }
    SEAM(12);
    if (IN(13)) for (int rep = 0; rep < (DUP_PHASE == 13 ? 2 : 1); ++rep) {
        for (int m = gw; m < M; m += NGW) {
            const float* mod = MOD + seq_of(m) * MODW; const float* fr_ = MIXOUT + (size_t)m * D;
            f32x4 v[8]; float ss = 0.f;
#pragma unroll
            for (int j = 0; j < 8; ++j) {
                if (m < TP) { const u32x2 rw = *(const u32x2*)((const bf16*)MIXOUT + (size_t)m * D + 4 * lane + 256 * j); v[j] = (f32x4){bf2f(rw.x & 0xffffu), bf2f(rw.x >> 16), bf2f(rw.y & 0xffffu), bf2f(rw.y >> 16)}; }
                else { const float* pr = (const float*)(ws + WS_PART12) + (size_t)(m - TP) * D + 4 * lane + 256 * j; v[j] = *(const f32x4*)pr;
#pragma unroll
                    for (int q = 1; q < KS12; ++q) v[j] += *(const f32x4*)(pr + (size_t)q * MS * D); }
                ss += (v[j].x * v[j].x + v[j].y * v[j].y) + (v[j].z * v[j].z + v[j].w * v[j].w); }
            const float rs = rsqrtf(wave_sum(ss) * (1.f / D) + 1e-6f);
#pragma unroll
            for (int j = 0; j < 8; ++j) { const int c = 4 * lane + 256 * j; const f32x4 g = *(const f32x4*)(a.in[I_GPOF] + c), gt = *(const f32x4*)(mod + 5 * D + c), x = *(const f32x4*)(out + (size_t)m * D + c);
                *(f32x4*)(out + (size_t)m * D + c) = x + gt * (v[j] * rs * g); }
        }
    }
    if (TS_PROBE >= 0) {
        xcd_barrier(xb);
        if (bid == 0 && tid == 0) TSW[14] = __builtin_amdgcn_s_memrealtime();
        if (bid == 0) { __syncthreads(); const float us = TS_PROBE >= 100 ? (float)(TSW[32 + TS_PROBE - 100] - TSW[32 + TS_PROBE - 101]) * 0.01f : (float)(TSW[1 + TS_PROBE] - TSW[TS_PROBE]) * 0.01f; const float eps = sqrtf(us * 1e-4f);
            for (int c = tid; c < RC; c += 512) out[O_SHP + c] *= (1.f + eps); }
    }
#undef IN
#undef SEAM
}

extern "C" void kernel_launch(void* const* d_in, const int* in_sizes, int n_in, void* d_out, int out_size, void* d_ws, size_t ws_size, hipStream_t stream) {
    static int grid = 0;
    if (grid == 0) {
        if (n_in != 30 || (size_t)out_size != O_END || ws_size < WS_END) { fprintf(stderr, "kernel_launch: unexpected sizes n_in %d out %d ws %zu\n", n_in, out_size, ws_size); grid = -1; return; }
        int dev = 0, cus = 0, per_cu = 0;
        (void)hipGetDevice(&dev); (void)hipDeviceGetAttribute(&cus, hipDeviceAttributeMultiprocessorCount, dev);
        if (hipFuncSetAttribute((const void*)mk_fwd, hipFuncAttributeMaxDynamicSharedMemorySize, LDS_BYTES) != hipSuccess) { fprintf(stderr, "kernel_launch: hipFuncSetAttribute failed\n"); grid = -1; return; }
        if (hipOccupancyMaxActiveBlocksPerMultiprocessor(&per_cu, (const void*)mk_fwd, 512, LDS_BYTES) != hipSuccess || per_cu < 1) { fprintf(stderr, "kernel_launch: occupancy query says %d\n", per_cu); per_cu = 1; }
        (void)hipGetLastError();
        grid = cus;
        if (grid <= 0) grid = 256;
    }
    if (grid < 0) return;
    (void)hipMemsetAsync((char*)d_ws + 65536, 0, XCD_BAR_WORDS * 4 + 512, stream);
    Args a{};
    for (int i = 0; i < 30; ++i) a.in[i] = (const float*)d_in[i];
    a.out = (float*)d_out; a.ws = (unsigned char*)d_ws;
    a.ph_lo = 0; a.ph_hi = NPHASE;
    void* args[] = {&a};
    hipError_t e = hipLaunchCooperativeKernel((const void*)mk_fwd, dim3(grid), dim3(512), args, LDS_BYTES, stream);
    if (e != hipSuccess) fprintf(stderr, "kernel_launch: cooperative launch failed: %s (grid %d)\n", hipGetErrorString(e), grid);
}
```
